# Optimizing an MI355X kernel written in HIP

```python
import math
import jax
import jax.numpy as jnp
from jax import lax
import numpy as np

D_MODEL = 1024
BATCH = 8
SEQ = 2048
DEPTH = 2

GRID_W = 64
CTX_LEN = 256
NORM_EPS = 1e-6
NA_HEADS = 8
NA_HEAD_DIM = 64
NA_WIDTH = NA_HEADS * NA_HEAD_DIM
WIN_ROWS = 8
WIN_COLS = 16
CONV_CH = D_MODEL // 2
CONV_K = 31
MIX_IN = 3 * NA_WIDTH + 2 * CONV_CH
MIX_OUT = NA_WIDTH + CONV_CH
SSM_WIDTH = D_MODEL
SSM_GROUP = 16
SSM_GROUPS = SSM_WIDTH // SSM_GROUP
SSM_STATE = 64
FFN_DIM = 2816
N_EXPERTS = 8
TOP_K = 2
EXPERT_DIM = 3584

kernel_name = 'hybrid_natten_conformer_s5_moe_dit'


def _f32(t):
    return t.astype(jnp.float32)


def rmsnorm(x, g):
    xf = _f32(x)
    y = xf * lax.rsqrt(jnp.mean(xf * xf, axis=-1, keepdims=True) + NORM_EPS)
    return (y * _f32(g)).astype(x.dtype)


def layernorm(x, g, b):
    xf = _f32(x)
    mu = jnp.mean(xf, axis=-1, keepdims=True)
    var = jnp.mean(jnp.square(xf - mu), axis=-1, keepdims=True)
    return ((xf - mu) * lax.rsqrt(var + NORM_EPS) * _f32(g) + _f32(b)).astype(x.dtype)


def adaln(cond, w, b):
    return jnp.split(jax.nn.silu(cond) @ w + b, 6, axis=-1)


def modulate(h, shift, scale):
    return h * (1 + scale[:, None, :]) + shift[:, None, :]


def swiglu(h, w1, w3, w2):
    return (jax.nn.silu(h @ w1) * (h @ w3)) @ w2


def neighbourhood_attention(q, k, v, k_ctx, v_ctx, rpb):
    B, L, H, Dh = q.shape
    rows = L // GRID_W
    kr = min(WIN_ROWS, rows)
    qg = q.reshape(B, rows, GRID_W, H, Dh)
    kg = k.reshape(B, rows, GRID_W, H, Dh)
    vg = v.reshape(B, rows, GRID_W, H, Dh)
    r = jnp.arange(rows)
    row_idx = jnp.clip(r - kr // 2, 0, rows - kr)[:, None] + jnp.arange(kr)
    k_band = kg[:, row_idx]
    v_band = vg[:, row_idx]
    col = jnp.arange(GRID_W)
    col_start = jnp.clip(col - WIN_COLS // 2, 0, GRID_W - WIN_COLS)
    col_ok = (col[None, :] >= col_start[:, None]) & (col[None, :] < col_start[:, None] + WIN_COLS)
    dr = row_idx - r[:, None]
    dc = col[None, :] - col[:, None]
    ri = (dr + WIN_ROWS - 1)[:, None, :, None]
    ci = jnp.clip(dc + WIN_COLS - 1, 0, 2 * WIN_COLS - 2)[None, :, None, :]
    bias = _f32(rpb[:, ri, ci])
    scale = NA_HEAD_DIM ** -0.5
    s_band = _f32(jnp.einsum('brqhd,brkchd->bhrqkc', qg, k_band)) * scale + bias
    s_band = jnp.where(col_ok[:, None, :], s_band, -jnp.inf)
    s_ctx = _f32(jnp.einsum('brqhd,bnhd->bhrqn', qg, k_ctx)) * scale
    nb = kr * GRID_W
    s = jnp.concatenate([s_band.reshape(B, H, rows, GRID_W, nb), s_ctx], axis=-1)
    p = jax.nn.softmax(s, axis=-1).astype(v.dtype)
    p_band = p[..., :nb].reshape(B, H, rows, GRID_W, kr, GRID_W)
    o = jnp.einsum('bhrqkc,brkchd->brqhd', p_band, v_band) + jnp.einsum('bhrqn,bnhd->brqhd', p[..., nb:], v_ctx)
    return o.reshape(B, L, H * Dh)


def context_attention(q, k, v):
    s = _f32(jnp.einsum('bnhd,bmhd->bhnm', q, k)) * (NA_HEAD_DIM ** -0.5)
    p = jax.nn.softmax(s, axis=-1).astype(v.dtype)
    o = jnp.einsum('bhnm,bmhd->bnhd', p, v)
    return o.reshape(o.shape[0], o.shape[1], NA_WIDTH)


def conv_module(a, g, dw_w, dw_b, ln_g, ln_b):
    u = a * jax.nn.sigmoid(g)
    u = lax.conv_general_dilated(u, dw_w[:, None, :], window_strides=(1,), padding=[(CONV_K // 2, CONV_K // 2)], dimension_numbers=('NWC', 'WIO', 'NWC'), feature_group_count=CONV_CH) + dw_b
    return jax.nn.silu(layernorm(u, ln_g, ln_b))


def na_conv_mixer(h_lat, h_ctx, w_in, q_g, k_g, rpb, dw_w, dw_b, ln_g, ln_b, w_out, with_ctx):
    def project(h):
        q, k, v, a, g = jnp.split(h @ w_in, [NA_WIDTH, 2 * NA_WIDTH, 3 * NA_WIDTH, 3 * NA_WIDTH + CONV_CH], axis=-1)
        heads = lambda t: t.reshape(t.shape[0], t.shape[1], NA_HEADS, NA_HEAD_DIM)
        return rmsnorm(heads(q), q_g), rmsnorm(heads(k), k_g), heads(v), a, g
    ql, kl, vl, al, gl = project(h_lat)
    qc, kc, vc, ac, gc = project(h_ctx)
    y_lat = jnp.concatenate([neighbourhood_attention(ql, kl, vl, kc, vc, rpb), conv_module(al, gl, dw_w, dw_b, ln_g, ln_b)], axis=-1) @ w_out
    if not with_ctx:
        return y_lat, None
    y_ctx = jnp.concatenate([context_attention(qc, kc, vc), conv_module(ac, gc, dw_w, dw_b, ln_g, ln_b)], axis=-1) @ w_out
    return y_lat, y_ctx


def s5_discretise(a_re, a_im, log_dt, b_re, b_im):
    lam = lax.complex(_f32(a_re), _f32(a_im))
    dt = jnp.exp(_f32(log_dt))[:, None]
    lam_bar = jnp.exp(lam * dt)
    b = lax.complex(_f32(b_re), _f32(b_im))
    return lam_bar, ((lam_bar - 1) / lam)[..., None] * b


def diag_scan(bu, lam_bar, reverse):
    a = jnp.broadcast_to(lam_bar, (1,) + bu.shape[1:])
    def combine(e1, e2):
        a1, b1 = e1
        a2, b2 = e2
        return a1 * a2, a2 * b1 + b2
    return lax.associative_scan(combine, (a, bu), reverse=reverse, axis=1)


def s5_mixer(h_lat, h_ctx, w_in, a_re, a_im, log_dt, b_re, b_im, c_re, c_im, d_skip, w_out, with_ctx):
    u_lat = _f32(h_lat @ w_in)
    u_ctx = _f32(h_ctx @ w_in)
    ul = u_lat.reshape(u_lat.shape[0], u_lat.shape[1], SSM_GROUPS, SSM_GROUP)
    uc = u_ctx.reshape(u_ctx.shape[0], u_ctx.shape[1], SSM_GROUPS, SSM_GROUP)
    lat_dirs, ctx_dirs = [], []
    for direction, reverse in ((0, False), (1, True)):
        lam_bar, b_bar = s5_discretise(a_re[direction], a_im[direction], log_dt[direction], b_re[direction], b_im[direction])
        c_mat = lax.complex(_f32(c_re[direction]), _f32(c_im[direction]))
        _, st_ctx = diag_scan(jnp.einsum('bngq,gpq->bngp', uc, b_bar), lam_bar, reverse)
        s0 = st_ctx[:, 0] if reverse else st_ctx[:, -1]
        powers, st_lat = diag_scan(jnp.einsum('blgq,gpq->blgp', ul, b_bar), lam_bar, reverse)
        st_lat = st_lat + powers * s0[:, None]
        lat_dirs.append(jnp.einsum('blgp,gqp->blgq', st_lat, c_mat).real)
        if with_ctx:
            ctx_dirs.append(jnp.einsum('bngp,gqp->bngq', st_ctx, c_mat).real)
    d = _f32(d_skip).reshape(SSM_GROUPS, SSM_GROUP)
    def readout(ys, u, dtype):
        y = jax.nn.gelu(ys[0] + ys[1] + d * u)
        y = y.reshape(y.shape[0], y.shape[1], SSM_WIDTH).astype(dtype)
        z = y @ w_out
        return z[..., :D_MODEL] * jax.nn.sigmoid(z[..., D_MODEL:])
    y_lat = readout(lat_dirs, ul, h_lat.dtype)
    if not with_ctx:
        return y_lat, None
    return y_lat, readout(ctx_dirs, uc, h_ctx.dtype)


def moe_swiglu(h, w_router, w1, w3, w2):
    shp = h.shape
    t = h.reshape(-1, shp[-1])
    logits = _f32(t @ w_router)
    top_val, top_idx = lax.top_k(logits, TOP_K)
    top_w = jax.nn.softmax(top_val, axis=-1)
    gate = jnp.einsum('tk,tke->te', top_w, jax.nn.one_hot(top_idx, N_EXPERTS, dtype=jnp.float32)).astype(h.dtype)
    out = gate[:, 0:1] * swiglu(t, w1[0], w3[0], w2[0])
    for e in range(1, N_EXPERTS):
        out = out + gate[:, e:e + 1] * swiglu(t, w1[e], w3[e], w2[e])
    return out.reshape(shp)


def setup_inputs(seed: int = 0) -> dict:
    key = jax.random.key(seed)
    ks = iter(jax.random.split(key, 48))
    def nrm(shape, std):
        return jax.random.normal(next(ks), shape, jnp.float32) * std
    D = D_MODEL
    ne, no = (DEPTH + 1) // 2, DEPTH // 2
    G, P, Q = SSM_GROUPS, SSM_STATE, SSM_GROUP
    x = nrm((BATCH, SEQ, D), 1.0)
    c = nrm((BATCH, D), 1.0)
    ctx = nrm((BATCH, CTX_LEN, D), 1.0)
    c_ctx = nrm((D,), 1.0)
    ada_w = nrm((DEPTH, D, 6 * D), 0.5 * D ** -0.5)
    ada_b = nrm((DEPTH, 6 * D), 0.01)
    norm1_g = 1.0 + nrm((DEPTH, D), 0.01)
    norm2_g = 1.0 + nrm((DEPTH, D), 0.01)
    mix_w_in = nrm((ne, D, MIX_IN), D ** -0.5)
    q_norm_g = 1.0 + nrm((ne, NA_HEAD_DIM), 0.01)
    k_norm_g = 1.0 + nrm((ne, NA_HEAD_DIM), 0.01)
    na_rpb = nrm((ne, NA_HEADS, 2 * WIN_ROWS - 1, 2 * WIN_COLS - 1), 0.02)
    conv_dw_w = nrm((ne, CONV_K, CONV_CH), CONV_K ** -0.5)
    conv_dw_b = nrm((ne, CONV_CH), 0.01)
    conv_ln_g = 1.0 + nrm((ne, CONV_CH), 0.01)
    conv_ln_b = nrm((ne, CONV_CH), 0.01)
    mix_w_out = nrm((ne, MIX_OUT, D), MIX_OUT ** -0.5)
    ffn_w1 = nrm((ne, D, FFN_DIM), D ** -0.5)
    ffn_w3 = nrm((ne, D, FFN_DIM), D ** -0.5)
    ffn_w2 = nrm((ne, FFN_DIM, D), FFN_DIM ** -0.5)
    ssm_w_in = nrm((no, D, SSM_WIDTH), D ** -0.5)
    ssm_a_re = -0.5 + nrm((no, 2, G, P), 0.01)
    ssm_a_im = math.pi * jnp.arange(P, dtype=jnp.float32) + nrm((no, 2, G, P), 0.01)
    ssm_log_dt = jax.random.uniform(next(ks), (no, 2, G), jnp.float32, math.log(1e-3), math.log(1e-1))
    ssm_b_re = nrm((no, 2, G, P, Q), (2 * Q) ** -0.5)
    ssm_b_im = nrm((no, 2, G, P, Q), (2 * Q) ** -0.5)
    ssm_c_re = nrm((no, 2, G, Q, P), (2 * P) ** -0.5)
    ssm_c_im = nrm((no, 2, G, Q, P), (2 * P) ** -0.5)
    ssm_d = nrm((no, SSM_WIDTH), 1.0)
    ssm_w_out = nrm((no, SSM_WIDTH, 2 * D), SSM_WIDTH ** -0.5)
    moe_router = nrm((no, D, N_EXPERTS), D ** -0.5)
    moe_w1 = nrm((no, N_EXPERTS, D, EXPERT_DIM), D ** -0.5)
    moe_w3 = nrm((no, N_EXPERTS, D, EXPERT_DIM), D ** -0.5)
    moe_w2 = nrm((no, N_EXPERTS, EXPERT_DIM, D), EXPERT_DIM ** -0.5)
    return {'x': x, 'c': c, 'ctx': ctx, 'c_ctx': c_ctx, 'ada_w': ada_w, 'ada_b': ada_b, 'norm1_g': norm1_g, 'norm2_g': norm2_g, 'mix_w_in': mix_w_in, 'q_norm_g': q_norm_g, 'k_norm_g': k_norm_g, 'na_rpb': na_rpb, 'conv_dw_w': conv_dw_w, 'conv_dw_b': conv_dw_b, 'conv_ln_g': conv_ln_g, 'conv_ln_b': conv_ln_b, 'mix_w_out': mix_w_out, 'ffn_w1': ffn_w1, 'ffn_w3': ffn_w3, 'ffn_w2': ffn_w2, 'ssm_w_in': ssm_w_in, 'ssm_a_re': ssm_a_re, 'ssm_a_im': ssm_a_im, 'ssm_log_dt': ssm_log_dt, 'ssm_b_re': ssm_b_re, 'ssm_b_im': ssm_b_im, 'ssm_c_re': ssm_c_re, 'ssm_c_im': ssm_c_im, 'ssm_d': ssm_d, 'ssm_w_out': ssm_w_out, 'moe_router': moe_router, 'moe_w1': moe_w1, 'moe_w3': moe_w3, 'moe_w2': moe_w2}


def reference(x, c, ctx, c_ctx, ada_w, ada_b, norm1_g, norm2_g, mix_w_in, q_norm_g, k_norm_g, na_rpb, conv_dw_w, conv_dw_b, conv_ln_g, conv_ln_b, mix_w_out, ffn_w1, ffn_w3, ffn_w2, ssm_w_in, ssm_a_re, ssm_a_im, ssm_log_dt, ssm_b_re, ssm_b_im, ssm_c_re, ssm_c_im, ssm_d, ssm_w_out, moe_router, moe_w1, moe_w3, moe_w2):
    x_lat, x_ctx = x, ctx
    for l in range(DEPTH):
        i = l // 2
        with_ctx = l < DEPTH - 1
        sh1, sc1, g1, sh2, sc2, g2 = adaln(c, ada_w[l], ada_b[l])
        csh1, csc1, cg1, csh2, csc2, cg2 = adaln(c_ctx[None, :], ada_w[l], ada_b[l])
        h_lat = modulate(rmsnorm(x_lat, norm1_g[l]), sh1, sc1)
        h_ctx = modulate(rmsnorm(x_ctx, norm1_g[l]), csh1, csc1)
        if l % 2 == 0:
            y_lat, y_ctx = na_conv_mixer(h_lat, h_ctx, mix_w_in[i], q_norm_g[i], k_norm_g[i], na_rpb[i], conv_dw_w[i], conv_dw_b[i], conv_ln_g[i], conv_ln_b[i], mix_w_out[i], with_ctx)
            def ffn(h):
                return swiglu(h, ffn_w1[i], ffn_w3[i], ffn_w2[i])
        else:
            y_lat, y_ctx = s5_mixer(h_lat, h_ctx, ssm_w_in[i], ssm_a_re[i], ssm_a_im[i], ssm_log_dt[i], ssm_b_re[i], ssm_b_im[i], ssm_c_re[i], ssm_c_im[i], ssm_d[i], ssm_w_out[i], with_ctx)
            def ffn(h):
                return moe_swiglu(h, moe_router[i], moe_w1[i], moe_w3[i], moe_w2[i])
        x_lat = x_lat + g1[:, None, :] * y_lat
        x_lat = x_lat + g2[:, None, :] * ffn(modulate(rmsnorm(x_lat, norm2_g[l]), sh2, sc2))
        if with_ctx:
            x_ctx = x_ctx + cg1[:, None, :] * y_ctx
            x_ctx = x_ctx + cg2[:, None, :] * ffn(modulate(rmsnorm(x_ctx, norm2_g[l]), csh2, csc2))
    return x_lat
```

```cpp
#include <hip/hip_runtime.h>
#include <cstdio>
#include <cstdint>
#ifndef MK_N_LAUNCHES
#define MK_N_LAUNCHES 1
#endif
#ifndef MK_REPEAT_SUB
#define MK_REPEAT_SUB 63
#endif
#ifndef MK_REPEAT_MASK
#define MK_REPEAT_MASK 0u
#endif
namespace pg8 {
#define PG8_LAS __attribute__((address_space(3)))
typedef unsigned short bf16_t;
typedef short bf16x8 __attribute__((ext_vector_type(8)));
typedef float f32x4 __attribute__((ext_vector_type(4)));
typedef unsigned u32x4 __attribute__((ext_vector_type(4)));
typedef unsigned u32x2 __attribute__((ext_vector_type(2)));
constexpr int BM = 256, BK = 64, HALF = 128, HTB = HALF * BK * 2  , STAGE_BYTES = 8 * HTB, NXCD = 8, WGM = 8;

__host__ __device__ __forceinline__ int lds_byte(int r, int c) { const int st = (r >> 4) * 2 + (c >> 5), rr = r & 15, cc = c & 31, ob = rr * 64 + cc * 2; return st * 1024 + (ob ^ (((ob >> 9) & 1) << 5)); }
__host__ __device__ __forceinline__ void stage_rc(int b, int& R, int& C) { const int st = b / 1024, sb = b % 1024, swz = sb ^ (((sb >> 9) & 1) << 5); R = (st >> 1) * 16 + swz / 64; C = (st & 1) * 32 + (swz % 64) / 2; }
__host__ __device__ __forceinline__ int perm32(int rho) { const int n = rho >> 4, i = rho & 15; return 8 * (i >> 2) + 4 * n + (i & 3); }

struct Unit { int pm, pn, k0, idx; };
struct Gemm { const bf16_t* A; const bf16_t* Bt; int M, N, K, lda, ldb; const int* rowsrc; };

struct StaticOrder {
    int nM, nN, nwg, G, c;
    __host__ __device__ void init(int M, int N, int G_, int c_) { nM = M / BM; nN = N / BM; nwg = nM * nN; G = G_; c = c_; }
    __host__ __device__ bool next(int i, Unit& u) const {
        const long L = (long)i * G + c; if (L >= nwg) return false;
        int wgid = (int)L; { const int q = nwg / NXCD, r = nwg % NXCD, xcd = wgid % NXCD, off = wgid / NXCD; wgid = (xcd < r ? xcd * (q + 1) : r * (q + 1) + (xcd - r) * q) + off; }
        const int nig = WGM * nN, gid = wgid / nig, fm = gid * WGM, gsz = (nM - fm) < WGM ? (nM - fm) : WGM;
        u.pm = fm + ((wgid % nig) % gsz); u.pn = (wgid % nig) / gsz; u.k0 = 0; u.idx = i; return true;
    }
    __device__ __forceinline__ void a_ready(const Unit&) const {}
    __device__ __forceinline__ void done(const Unit&) const {}
};

constexpr int ML_ = 16384, MC_ = 2048, MT_ = ML_ + MC_, DM_ = 1024;
__device__ __forceinline__ unsigned cvt_pk_bf16(float lo, float hi) { unsigned r; asm volatile("v_cvt_pk_bf16_f32 %0, %1, %2" : "=v"(r) : "v"(lo), "v"(hi)); return r; }
__device__ __forceinline__ float sigm(float x) { return __builtin_amdgcn_rcpf(1.0f + __expf(-x)); }
__device__ __forceinline__ float gelu_tanh(float x) { const float u = 1.5957691216f * (x + 0.044715f * x * x * x); return x * sigm(u); }
__device__ __forceinline__ u32x4 pack8(const f32x4 a, const f32x4 b) { u32x4 w; w.x = cvt_pk_bf16(a[0], a[1]); w.y = cvt_pk_bf16(a[2], a[3]); w.z = cvt_pk_bf16(b[0], b[1]); w.w = cvt_pk_bf16(b[2], b[3]); return w; }


struct EpiQKVU {
    static constexpr bool PERM = true, AFTER_DRAIN = false;
    bf16_t* O; const float* gq; const float* gk; float eps;
    __device__ __forceinline__ void operator()(const f32x4 (&acc)[2][2][4][2], const Unit& u, int wr, int wc, int fr, int fq) const {
        const int row0 = u.pm * BM + wr * 64 + fr; const int pn = u.pn;
        if (pn < 6) {
            const bool nrm = pn < 4; const float* gp = (pn < 2) ? gq : gk;
            f32x4 gn[2][2];
#pragma unroll
            for (int bj = 0; bj < 2; ++bj)
#pragma unroll
                for (int n = 0; n < 2; ++n) gn[bj][n] = nrm ? *(const f32x4*)(gp + 32 * bj + 8 * fq + 4 * n) : (f32x4){1.f, 1.f, 1.f, 1.f};
#pragma unroll
            for (int ai = 0; ai < 2; ++ai)
#pragma unroll
                for (int m = 0; m < 4; ++m) {
                    float sc = 1.f;
                    if (nrm) { float ss = 0.f;
#pragma unroll
                        for (int bj = 0; bj < 2; ++bj)
#pragma unroll
                            for (int n = 0; n < 2; ++n) { const f32x4 x = acc[ai][bj][m][n]; ss += (x[0] * x[0] + x[1] * x[1]) + (x[2] * x[2] + x[3] * x[3]); }
                        ss += __shfl_xor(ss, 16); ss += __shfl_xor(ss, 32);
                        sc = rsqrtf(ss * (1.0f / 64.0f) + eps); }
                    bf16_t* rowp = O + (size_t)(row0 + ai * HALF + m * 16) * 2048 + 256 * pn + 64 * wc + 8 * fq;
#pragma unroll
                    for (int bj = 0; bj < 2; ++bj) { const f32x4 v0 = acc[ai][bj][m][0] * gn[bj][0] * sc, v1 = acc[ai][bj][m][1] * gn[bj][1] * sc; *(u32x4*)(rowp + 32 * bj) = pack8(v0, v1); }
                }
        } else {
            const int cb = 1536 + 128 * (pn - 6) + 32 * wc + 8 * fq;
#pragma unroll
            for (int ai = 0; ai < 2; ++ai)
#pragma unroll
                for (int m = 0; m < 4; ++m) {
                    f32x4 v[2];
#pragma unroll
                    for (int n = 0; n < 2; ++n) { const f32x4 a = acc[ai][0][m][n], g = acc[ai][1][m][n]; v[n] = (f32x4){a[0] * sigm(g[0]), a[1] * sigm(g[1]), a[2] * sigm(g[2]), a[3] * sigm(g[3])}; }
                    *(u32x4*)(O + (size_t)(row0 + ai * HALF + m * 16) * 2048 + cb) = pack8(v[0], v[1]);
                }
        }
    }
};
struct EpiResid {
    static constexpr bool PERM = false, AFTER_DRAIN = false;
    const float* baseL; const float* baseC; float* XL; float* XC; const float* gate;
    __device__ __forceinline__ void operator()(const f32x4 (&acc)[2][2][4][2], const Unit& u, int wr, int wc, int fr, int fq) const {
        const int R0 = u.pm * BM, row0 = R0 + wr * 64 + fr, col0 = u.pn * BM + wc * 32 + 4 * fq;
        const int modrow = R0 < ML_ ? (R0 >> 11) : 8;
        const float* gp = gate + (size_t)modrow * 6144 + col0;
        const float* bp = R0 < ML_ ? baseL : baseC - (size_t)ML_ * DM_;
        float* xo = R0 < ML_ ? XL : XC - (size_t)ML_ * DM_;
        f32x4 gv[2][2];
#pragma unroll
        for (int bj = 0; bj < 2; ++bj)
#pragma unroll
            for (int n = 0; n < 2; ++n) gv[bj][n] = *(const f32x4*)(gp + bj * HALF + n * 16);
#pragma unroll
        for (int ai = 0; ai < 2; ++ai)
#pragma unroll
            for (int m = 0; m < 4; ++m) { const size_t ro = (size_t)(row0 + ai * HALF + m * 16) * DM_ + col0;
#pragma unroll
                for (int bj = 0; bj < 2; ++bj)
#pragma unroll
                    for (int n = 0; n < 2; ++n) { const f32x4 xv = *(const f32x4*)(bp + ro + bj * HALF + n * 16); *(f32x4*)(xo + ro + bj * HALF + n * 16) = xv + gv[bj][n] * acc[ai][bj][m][n]; } }
    }
};
__device__ __forceinline__ void unpack8(const u32x4 w, f32x4& a, f32x4& b) {
    a = (f32x4){__builtin_bit_cast(float, w.x << 16), __builtin_bit_cast(float, w.x & 0xffff0000u), __builtin_bit_cast(float, w.y << 16), __builtin_bit_cast(float, w.y & 0xffff0000u)};
    b = (f32x4){__builtin_bit_cast(float, w.z << 16), __builtin_bit_cast(float, w.z & 0xffff0000u), __builtin_bit_cast(float, w.w << 16), __builtin_bit_cast(float, w.w & 0xffff0000u)}; }
template <bool BASE_F32> struct EpiResidN {
    static constexpr bool PERM = true, AFTER_DRAIN = false;
    const void* baseL; const void* baseC; bf16_t* XL; bf16_t* XC; const float* gate; bf16_t* Hn; float* rowss; const float* ngain; const float* nscale;
    __device__ __forceinline__ void operator()(const f32x4 (&acc)[2][2][4][2], const Unit& u, int wr, int wc, int fr, int fq) const {
        const int R0 = u.pm * BM, row0 = R0 + wr * 64 + fr, col0 = u.pn * BM + wc * 32 + 8 * fq;
        const int modrow = R0 < ML_ ? (R0 >> 11) : 8, rsub = R0 < ML_ ? 0 : ML_;
        const float* gp = gate + (size_t)modrow * 6144 + col0; const float* sp = nscale + (size_t)modrow * 6144 + col0;
        const void* bp = R0 < ML_ ? baseL : baseC; bf16_t* xo = R0 < ML_ ? XL : XC;
        f32x4 gv[2][2], gs[2][2];
#pragma unroll
        for (int bj = 0; bj < 2; ++bj)
#pragma unroll
            for (int n = 0; n < 2; ++n) { gv[bj][n] = *(const f32x4*)(gp + bj * HALF + n * 4); gs[bj][n] = *(const f32x4*)(ngain + col0 + bj * HALF + n * 4) * (*(const f32x4*)(sp + bj * HALF + n * 4) + 1.0f); }
#pragma unroll
        for (int ai = 0; ai < 2; ++ai)
#pragma unroll
            for (int m = 0; m < 4; ++m) { const int row = row0 + ai * HALF + m * 16; const size_t ro = (size_t)(row - rsub) * DM_ + col0; float ss = 0.f;
#pragma unroll
                for (int bj = 0; bj < 2; ++bj) { f32x4 x0, x1;
                    if constexpr (BASE_F32) { x0 = *(const f32x4*)((const float*)bp + ro + bj * HALF); x1 = *(const f32x4*)((const float*)bp + ro + bj * HALF + 4); }
                    else unpack8(*(const u32x4*)((const bf16_t*)bp + ro + bj * HALF), x0, x1);
                    const u32x4 xw = pack8(x0 + gv[bj][0] * acc[ai][bj][m][0], x1 + gv[bj][1] * acc[ai][bj][m][1]); *(u32x4*)(xo + ro + bj * HALF) = xw;
                    f32x4 r0, r1; unpack8(xw, r0, r1);
                    ss += ((r0[0] * r0[0] + r0[1] * r0[1]) + (r0[2] * r0[2] + r0[3] * r0[3])) + ((r1[0] * r1[0] + r1[1] * r1[1]) + (r1[2] * r1[2] + r1[3] * r1[3]));
                    *(u32x4*)(Hn + (size_t)row * DM_ + col0 + bj * HALF) = pack8(r0 * gs[bj][0], r1 * gs[bj][1]); }
                ss += __shfl_xor(ss, 16); ss += __shfl_xor(ss, 32);
                if (fq == 0) rowss[(size_t)row * 16 + u.pn * 4 + wc] = ss; }
    }
};
__device__ __forceinline__ float row_rstd(const float* rowss, int row, float eps) {
    const f32x4* p = (const f32x4*)(rowss + (size_t)row * 16); const f32x4 a = p[0], b = p[1], c = p[2], d = p[3];
    const float s = (((a[0] + a[1]) + (a[2] + a[3])) + ((b[0] + b[1]) + (b[2] + b[3]))) + (((c[0] + c[1]) + (c[2] + c[3])) + ((d[0] + d[1]) + (d[2] + d[3])));
    return rsqrtf(s * (1.0f / 1024.0f) + eps); }
template <class Sched> __device__ __forceinline__ void rstd_prepass(const Sched& S, const float* rowss, PG8_LAS float* rt, float eps, int tid) {
    Unit u; int n = 0; while (n < 8 && S.next(n, u)) ++n;
#pragma unroll
    for (int q = 0; q < 4; ++q) { const int r = tid + 512 * q, i = r >> 8;
        if (i < n) { S.next(i, u); rt[r] = row_rstd(rowss, u.pm * BM + (r & 255), eps); } }
    __syncthreads();
}
struct EpiSwiGLUN {
    static constexpr bool PERM = true, AFTER_DRAIN = false;
    bf16_t* O; int ldo; const PG8_LAS float* rt; const float* shw; int nphys;
    __device__ __forceinline__ void operator()(const f32x4 (&acc)[2][2][4][2], const Unit& u, int wr, int wc, int fr, int fq) const {
        const int R0 = u.pm * BM, row0 = R0 + wr * 64 + fr, colp = u.pn * BM + wc * 32 + 8 * fq, col0 = u.pn * HALF + wc * 32 + 8 * fq;
        const float* sp = shw + (size_t)(R0 < ML_ ? (R0 >> 11) : 8) * nphys + colp;
        f32x4 s1[2], s3[2];
#pragma unroll
        for (int n = 0; n < 2; ++n) { s1[n] = *(const f32x4*)(sp + 4 * n); s3[n] = *(const f32x4*)(sp + HALF + 4 * n); }
#pragma unroll
        for (int ai = 0; ai < 2; ++ai)
#pragma unroll
            for (int m = 0; m < 4; ++m) { const int row = row0 + ai * HALF + m * 16; const float rs = rt[u.idx * BM + (row - R0)];
                f32x4 v[2];
#pragma unroll
                for (int n = 0; n < 2; ++n) { const f32x4 a = acc[ai][0][m][n] * rs + s1[n], b = acc[ai][1][m][n] * rs + s3[n]; v[n] = (f32x4){a[0] * sigm(a[0]) * b[0], a[1] * sigm(a[1]) * b[1], a[2] * sigm(a[2]) * b[2], a[3] * sigm(a[3]) * b[3]}; }
                *(u32x4*)(O + (size_t)row * ldo + col0) = pack8(v[0], v[1]);
            }
    }
};
struct EpiSwiGLU {
    static constexpr bool PERM = true, AFTER_DRAIN = false;
    bf16_t* O; int ldo, nN, row_sub; int skip;
    __device__ __forceinline__ void operator()(const f32x4 (&acc)[2][2][4][2], const Unit& u, int wr, int wc, int fr, int fq) const {
        if (skip) {
#pragma unroll
            for (int ai = 0; ai < 2; ++ai)
#pragma unroll
                for (int bj = 0; bj < 2; ++bj)
#pragma unroll
                    for (int m = 0; m < 4; ++m)
#pragma unroll
                        for (int n = 0; n < 2; ++n) asm volatile("" :: "v"(acc[ai][bj][m][n]));
            return; }
        const int row0 = u.pm * BM + wr * 64 + fr - row_sub, col0 = (u.pn % nN) * HALF + wc * 32 + 8 * fq;
#pragma unroll
        for (int ai = 0; ai < 2; ++ai)
#pragma unroll
            for (int m = 0; m < 4; ++m) {
                f32x4 v[2];
#pragma unroll
                for (int n = 0; n < 2; ++n) { const f32x4 a = acc[ai][0][m][n], b = acc[ai][1][m][n]; v[n] = (f32x4){a[0] * sigm(a[0]) * b[0], a[1] * sigm(a[1]) * b[1], a[2] * sigm(a[2]) * b[2], a[3] * sigm(a[3]) * b[3]}; }
                *(u32x4*)(O + (size_t)(row0 + ai * HALF + m * 16) * ldo + col0) = pack8(v[0], v[1]);
            }
    }
};
struct EpiGLURes {
    static constexpr bool PERM = true, AFTER_DRAIN = false;
    bf16_t* X; const float* gate;
    __device__ __forceinline__ void operator()(const f32x4 (&acc)[2][2][4][2], const Unit& u, int wr, int wc, int fr, int fq) const {
        const int R0 = u.pm * BM, row0 = R0 + wr * 64 + fr, col0 = u.pn * HALF + wc * 32 + 8 * fq;
        const float* gp = gate + (size_t)(R0 >> 11) * 6144 + col0;
        f32x4 gv[2];
#pragma unroll
        for (int n = 0; n < 2; ++n) gv[n] = *(const f32x4*)(gp + n * 4);
#pragma unroll
        for (int ai = 0; ai < 2; ++ai)
#pragma unroll
            for (int m = 0; m < 4; ++m) { bf16_t* xp = X + (size_t)(row0 + ai * HALF + m * 16) * DM_ + col0; f32x4 x0, x1, y[2];
                unpack8(*(const u32x4*)xp, x0, x1);
#pragma unroll
                for (int n = 0; n < 2; ++n) { const f32x4 z1 = acc[ai][0][m][n], z2 = acc[ai][1][m][n]; y[n] = (f32x4){z1[0] * sigm(z2[0]), z1[1] * sigm(z2[1]), z1[2] * sigm(z2[2]), z1[3] * sigm(z2[3])}; }
                *(u32x4*)xp = pack8(x0 + gv[0] * y[0], x1 + gv[1] * y[1]); }
    }
};
struct EpiUC {
    static constexpr bool PERM = true, AFTER_DRAIN = false;
    bf16_t* UC; const PG8_LAS float* rt; const float* shw;
    __device__ __forceinline__ void operator()(const f32x4 (&acc)[2][2][4][2], const Unit& u, int wr, int wc, int fr, int fq) const {
        const int R0 = u.pm * BM, row0 = R0 + wr * 64 + fr, col0 = u.pn * BM + wc * 32 + 8 * fq;
        const float* sp = shw + (size_t)(R0 < ML_ ? (R0 >> 11) : 8) * DM_ + col0;
        f32x4 sv[2][2];
#pragma unroll
        for (int bj = 0; bj < 2; ++bj)
#pragma unroll
            for (int n = 0; n < 2; ++n) sv[bj][n] = *(const f32x4*)(sp + bj * HALF + 4 * n);
#pragma unroll
        for (int ai = 0; ai < 2; ++ai)
#pragma unroll
            for (int m = 0; m < 4; ++m) { const int row = row0 + ai * HALF + m * 16; int bc, j; const float rs = rt[u.idx * BM + (row - R0)];
                if (row < ML_) { bc = (row >> 11) * 64 + ((row & 2047) >> 5); j = row & 31; } else { const int r2 = row - ML_; bc = 512 + (r2 >> 8) * 8 + ((r2 & 255) >> 5); j = r2 & 31; }
#pragma unroll
                for (int bj = 0; bj < 2; ++bj) { const int col = col0 + bj * HALF, g = col >> 4, qi = col & 15;
                    *(u32x4*)(UC + ((size_t)(g * 768 + bc) * 768 + j * 16 + qi)) = pack8(acc[ai][bj][m][0] * rs + sv[bj][0], acc[ai][bj][m][1] * rs + sv[bj][1]); } }
    }
};
struct EpiE {
    static constexpr bool PERM = false, AFTER_DRAIN = false;
    float* E;
    __device__ __forceinline__ void operator()(const f32x4 (&acc)[2][2][4][2], const Unit& u, int wr, int wc, int fr, int fq) const {
        const int row0 = u.pm * BM + wr * 64 + fr, col0 = wc * 32 + 4 * fq;
#pragma unroll
        for (int ai = 0; ai < 2; ++ai)
#pragma unroll
            for (int m = 0; m < 4; ++m) { float* rp = E + (size_t)(row0 + ai * HALF + m * 16) * 256 + col0;
#pragma unroll
                for (int bj = 0; bj < 2; ++bj)
#pragma unroll
                    for (int n = 0; n < 2; ++n) *(f32x4*)(rp + bj * HALF + n * 16) = acc[ai][bj][m][n]; }
    }
};
struct EpiY {
    static constexpr bool PERM = true, AFTER_DRAIN = false;
    bf16_t* Y;
    __device__ __forceinline__ void operator()(const f32x4 (&acc)[2][2][4][2], const Unit& u, int wr, int wc, int fr, int fq) const {
        const int g = u.pm / 3, pml = u.pm - 3 * g, pnl = u.pn & 1;
        const int bc0 = pml * BM + wr * 64 + fr, n0 = pnl * BM + wc * 32 + 8 * fq;
#pragma unroll
        for (int ai = 0; ai < 2; ++ai)
#pragma unroll
            for (int m = 0; m < 4; ++m) { const int bc = bc0 + ai * HALF + m * 16, tok0 = (bc >> 6) * 2048 + (bc & 63) * 32;
#pragma unroll
                for (int bj = 0; bj < 2; ++bj) { const int n = n0 + bj * HALF, tin = n >> 4, qo = n & 15; const f32x4 a = acc[ai][bj][m][0], b = acc[ai][bj][m][1];
                    const f32x4 ya = (f32x4){gelu_tanh(a[0]), gelu_tanh(a[1]), gelu_tanh(a[2]), gelu_tanh(a[3])}, yb = (f32x4){gelu_tanh(b[0]), gelu_tanh(b[1]), gelu_tanh(b[2]), gelu_tanh(b[3])};
                    *(u32x4*)(Y + (size_t)(tok0 + tin) * DM_ + g * 16 + qo) = pack8(ya, yb); } }
    }
};
struct EpiMoE2 {
    static constexpr bool PERM = true, AFTER_DRAIN = false;
    bf16_t* Y2; const float* rowgate; const int* rowinfo;
    __device__ __forceinline__ void operator()(const f32x4 (&acc)[2][2][4][2], const Unit& u, int wr, int wc, int fr, int fq) const {
        const int row0 = u.pm * BM + wr * 64 + fr, col0 = (u.pn & 3) * BM + wc * 32 + 8 * fq;
#pragma unroll
        for (int ai = 0; ai < 2; ++ai)
#pragma unroll
            for (int m = 0; m < 4; ++m) { const int row = row0 + ai * HALF + m * 16; const float gt = rowgate[row]; const int ri = rowinfo[row];
                if (ri >= 0) {
#pragma unroll
                    for (int bj = 0; bj < 2; ++bj) *(u32x4*)(Y2 + (size_t)ri * DM_ + col0 + bj * HALF) = pack8(acc[ai][bj][m][0] * gt, acc[ai][bj][m][1] * gt); } }
    }
};
struct OrderS5E { int G, c;
    __device__ __forceinline__ bool next(int i, Unit& u) const {
        if (G == 256) { if (i > 0) return false; const int x = c & 7, j = c >> 3; if (j >= 24) return false; const int g = 8 * (j / 3) + x; u.pm = 3 * g + (j % 3); u.pn = g; u.k0 = 0; u.idx = i; return true; }
        const int L = i * G + c; if (L >= 192) return false; u.pm = L; u.pn = L / 3; u.k0 = 0; u.idx = i; return true; }
    __device__ __forceinline__ void a_ready(const Unit&) const {}
    __device__ __forceinline__ void done(const Unit&) const {} };
struct OrderS5Y { int G, c;
    __device__ __forceinline__ bool next(int i, Unit& u) const {
        if (G == 256) { if (i > 0) return false; const int x = c & 7, j = c >> 3, g = 8 * (j >> 2) + x; u.pm = 3 * g + ((j >> 1) & 1); u.pn = 2 * g + (j & 1); u.k0 = 0; u.idx = i; return true; }
        const int L = i * G + c; if (L >= 256) return false; const int g = L >> 2; u.pm = 3 * g + ((L >> 1) & 1); u.pn = 2 * g + (L & 1); u.k0 = 0; u.idx = i; return true; }
    __device__ __forceinline__ void a_ready(const Unit&) const {}
    __device__ __forceinline__ void done(const Unit&) const {} };
struct OrderMoE { int G, c, nN, tmax, fix; int toff[9];
    __device__ __forceinline__ bool next(int i, Unit& u) const {
        int pm, pnl; const int nt = toff[8] < tmax ? toff[8] : tmax;
        if (G == 256) {
            const int x = c & 7, j = c >> 3, nCB = nN >> 2, b = i * 8 + x, nRB = (nt + 7) >> 3; if (b >= nRB * nCB) return false;
            const int rb = b / nCB, cbk = b - rb * nCB; pm = 8 * rb + (j & 7); pnl = 4 * cbk + (j >> 3);
        } else { const int L = i * G + c; pm = L / nN; pnl = L - pm * nN; }
        if (pm >= nt) return false;
        int e = 0;
#pragma unroll
        for (int k = 1; k < 8; ++k) e += (pm >= toff[k]) ? 1 : 0;
        u.pm = fix ? 0 : pm; u.pn = fix ? pnl & 3 : e * nN + pnl; u.k0 = 0; u.idx = i; return true; }
    __device__ __forceinline__ void a_ready(const Unit&) const {}
    __device__ __forceinline__ void done(const Unit&) const {} };
struct OrderMoEx { int G, c; int toff[9];
    __device__ __forceinline__ bool next(int i, Unit& u) const {
        const int s = i * G + c, tl = s >> 4, pm = 128 + tl; if (pm >= toff[8]) return false;
        int e = 0;
#pragma unroll
        for (int k = 1; k < 8; ++k) e += (pm >= toff[k]) ? 1 : 0;
        u.pm = pm; u.pn = e * 4 + ((s >> 2) & 3); u.k0 = (s & 3) * 896; u.idx = i; return true; }
    __device__ __forceinline__ void a_ready(const Unit&) const {}
    __device__ __forceinline__ void done(const Unit&) const {} };
struct EpiMoE2x {
    static constexpr bool PERM = false, AFTER_DRAIN = false;
    float* P; const float* rowgate;
    __device__ __forceinline__ void operator()(const f32x4 (&acc)[2][2][4][2], const Unit& u, int wr, int wc, int fr, int fq) const {
        const int ks = u.k0 / 896, tl = u.pm - 128, r0 = wr * 64 + fr, col0 = (u.pn & 3) * BM + wc * 32 + 4 * fq;
        float* pb = P + ((size_t)(ks * 8 + tl) * 256) * DM_;
        const __amdgpu_buffer_rsrc_t grs = __builtin_amdgcn_make_buffer_rsrc((void*)rowgate, 0, 136 * 256 * 4, 0x00020000);
#pragma unroll
        for (int ai = 0; ai < 2; ++ai)
#pragma unroll
            for (int m = 0; m < 4; ++m) { const int r = r0 + ai * HALF + m * 16; const float gt = __builtin_bit_cast(float, __builtin_amdgcn_raw_buffer_load_b32(grs, (u.pm * BM + r) * 4, 0, 0));
#pragma unroll
                for (int bj = 0; bj < 2; ++bj)
#pragma unroll
                    for (int n = 0; n < 2; ++n) *(f32x4*)(pb + (size_t)r * DM_ + col0 + bj * HALF + n * 16) = acc[ai][bj][m][n] * gt; }
    }
};
template <class Epi, class Sched, bool ALIGN_EPI = false, bool SP2 = false, bool GATHER = false>
__device__ __forceinline__ void gemm_phase(PG8_LAS unsigned char* lds, const Gemm g, const Sched& S, const Epi& E) {
    const int tid = threadIdx.x, wid = __builtin_amdgcn_readfirstlane(tid >> 6), lane = tid & 63, wr = wid >> 2, wc = wid & 3, fr = lane & 15, fq = lane >> 4;
    const int K = g.K, nt = K / BK;
    unsigned voffA[2], voffB[2]; int RA[2]; unsigned CA[2];
    static_assert(!GATHER || SP2, "the gathered A operand is wired into the SP2 loop only");
#pragma unroll
    for (int i = 0; i < 2; ++i) { int R, C; stage_rc(tid * 16 + i * 8192, R, C); const int Rb = Epi::PERM ? ((R & ~31) + perm32(R & 31)) : R;
        voffA[i] = (unsigned)(R * g.lda + C) * 2u; voffB[i] = (unsigned)(Rb * g.ldb + C) * 2u; RA[i] = R; CA[i] = (unsigned)C * 2u; }
    const size_t kstep = (size_t)(BK * 2);
    const size_t hstepA = (size_t)HALF * g.lda * 2, hstepB = (size_t)HALF * g.ldb * 2;
    const size_t tstepA = 2 * hstepA, tstepB = 2 * hstepB;
    const unsigned ldsw = (unsigned)wid * 1024u;
    const int aoff = lds_byte(wr * 64 + fr, fq * 8), boff = lds_byte(wc * 32 + fr, fq * 8);
#define PG8_SA(b, h) (((b) * 2 + (h)) * HTB)
#define PG8_SB(b, h) ((4 + (b) * 2 + (h)) * HTB)
#define PG8_STAGE(bufoff, gbase, voff) do { _Pragma("unroll") for (int _i = 0; _i < 2; ++_i) \
        __builtin_amdgcn_global_load_lds((const unsigned*)((const char*)(gbase) + (voff)[_i]), (PG8_LAS unsigned*)(lds + (bufoff) + ldsw + _i * 8192), 16, 0, 0); } while (0)
#define PG8_LDA(dst, b, h) do { _Pragma("unroll") for (int m = 0; m < 4; ++m) _Pragma("unroll") for (int k = 0; k < 2; ++k) dst[m][k] = *(const PG8_LAS bf16x8*)(lds + PG8_SA(b, h) + aoff + m * 2048 + k * 1024); } while (0)
#define PG8_LDB(dst, b, h) do { _Pragma("unroll") for (int n = 0; n < 2; ++n) _Pragma("unroll") for (int k = 0; k < 2; ++k) dst[n][k] = *(const PG8_LAS bf16x8*)(lds + PG8_SB(b, h) + boff + n * 2048 + k * 1024); } while (0)
#define PG8_MMA(ai, bj, At, Bt) do { __builtin_amdgcn_s_setprio(1); _Pragma("unroll") for (int m = 0; m < 4; ++m) _Pragma("unroll") for (int n = 0; n < 2; ++n) _Pragma("unroll") for (int k = 0; k < 2; ++k) \
        acc[ai][bj][m][n] = __builtin_amdgcn_mfma_f32_16x16x32_bf16(Bt[n][k], At[m][k], acc[ai][bj][m][n], 0, 0, 0); __builtin_amdgcn_s_setprio(0); } while (0)
#define PG8_WAIT_V(n) asm volatile("s_waitcnt vmcnt(" #n ")" ::: "memory")
#define PG8_WAIT_L(n) asm volatile("s_waitcnt lgkmcnt(" #n ")" ::: "memory")
#define PG8_BAR __builtin_amdgcn_s_barrier()
#define PG8_SCHED __builtin_amdgcn_sched_barrier(0)
#define PG8_GIDX(d0, d1, un) do { _Pragma("unroll") for (int _i = 0; _i < 2; ++_i) { const int* _rp = g.rowsrc + (un).pm * BM + RA[_i]; d0[_i] = (unsigned)_rp[0] * (unsigned)(g.lda * 2) + CA[_i]; d1[_i] = (unsigned)_rp[HALF] * (unsigned)(g.lda * 2) + CA[_i]; } } while (0)
    Unit cur, nxt; int ui = 0;
    if (!S.next(0, cur)) return;
    f32x4 acc[2][2][4][2];
#pragma unroll
    for (int a = 0; a < 2; ++a)
#pragma unroll
        for (int b = 0; b < 2; ++b)
#pragma unroll
            for (int m = 0; m < 4; ++m)
#pragma unroll
                for (int n = 0; n < 2; ++n) acc[a][b][m][n] = (f32x4){0.f, 0.f, 0.f, 0.f};
    bf16x8 At[4][2], B0[2][2], B1[2][2];
    const char* cA = (const char*)g.A + (size_t)cur.pm * tstepA + (size_t)cur.k0 * 2; const char* cB = (const char*)g.Bt + (size_t)cur.pn * tstepB + (size_t)cur.k0 * 2;
    S.a_ready(cur);
    unsigned cv0[2] = {0u, 0u}, cv1[2] = {0u, 0u}, nv0[2] = {0u, 0u}, nv1[2] = {0u, 0u}; const char* gA = (const char*)g.A;
    if constexpr (GATHER) { PG8_GIDX(cv0, cv1, cur); nv0[0] = cv0[0]; nv0[1] = cv0[1]; nv1[0] = cv1[0]; nv1[1] = cv1[1]; }
    if constexpr (SP2) {
        PG8_STAGE(PG8_SB(0, 0), cB, voffB); PG8_STAGE(PG8_SB(0, 1), cB + hstepB, voffB);
        if constexpr (GATHER) { PG8_STAGE(PG8_SA(0, 0), gA, cv0); PG8_STAGE(PG8_SA(0, 1), gA, cv1); } else { PG8_STAGE(PG8_SA(0, 0), cA, voffA); PG8_STAGE(PG8_SA(0, 1), cA + hstepA, voffA); }
        if (wr == 1) PG8_BAR;
        PG8_WAIT_V(2); PG8_BAR;
        PG8_STAGE(PG8_SB(1, 0), cB + kstep, voffB); if constexpr (GATHER) PG8_STAGE(PG8_SA(1, 0), gA + kstep, cv0); else PG8_STAGE(PG8_SA(1, 0), cA + kstep, voffA); PG8_STAGE(PG8_SB(1, 1), cB + hstepB + kstep, voffB);
        PG8_WAIT_V(6); PG8_BAR;
    } else {
        PG8_STAGE(PG8_SB(0, 0), cB, voffB); PG8_STAGE(PG8_SA(0, 0), cA, voffA); PG8_STAGE(PG8_SB(0, 1), cB + hstepB, voffB); PG8_STAGE(PG8_SA(0, 1), cA + hstepA, voffA);
        if (wr == 1) PG8_BAR;
        PG8_WAIT_V(4); PG8_BAR;
        PG8_STAGE(PG8_SB(1, 0), cB + kstep, voffB); PG8_STAGE(PG8_SA(1, 0), cA + kstep, voffA); PG8_STAGE(PG8_SB(1, 1), cB + hstepB + kstep, voffB);
        PG8_WAIT_V(6); PG8_BAR;
    }
    for (;;) {
        const bool has_next = S.next(ui + 1, nxt);
        const char* nA = has_next ? (const char*)g.A + (size_t)nxt.pm * tstepA + (size_t)nxt.k0 * 2 : cA; const char* nB = has_next ? (const char*)g.Bt + (size_t)nxt.pn * tstepB + (size_t)nxt.k0 * 2 : cB;
        for (int t = 0; t < nt; t += 2) {
            const bool last = (t == nt - 2);
            const char* a1 = cA + (size_t)(t + 1) * kstep;
            const char* a2 = last ? nA : cA + (size_t)(t + 2) * kstep; const char* b2 = last ? nB : cB + (size_t)(t + 2) * kstep;
            const char* a3 = a2 + kstep; const char* b3 = b2 + kstep;
            if (last && has_next) S.a_ready(nxt);
            if constexpr (GATHER) { if (t == nt - 4 && has_next) PG8_GIDX(nv0, nv1, nxt); }
            const char* g1 = gA + (size_t)(t + 1) * kstep; const char* g2 = last ? gA : gA + (size_t)(t + 2) * kstep; const char* g3 = g2 + kstep;
            unsigned x0[2], x1[2]; x0[0] = last ? nv0[0] : cv0[0]; x0[1] = last ? nv0[1] : cv0[1]; x1[0] = last ? nv1[0] : cv1[0]; x1[1] = last ? nv1[1] : cv1[1];
            if constexpr (SP2) {
            PG8_LDB(B0, 0, 0); PG8_LDB(B1, 0, 1); PG8_SCHED; PG8_LDA(At, 0, 0); if constexpr (GATHER) PG8_STAGE(PG8_SA(1, 1), g1, cv1); else PG8_STAGE(PG8_SA(1, 1), a1 + hstepA, voffA);
            PG8_WAIT_V(8); PG8_WAIT_L(0); PG8_BAR; PG8_MMA(0, 0, At, B0); PG8_MMA(0, 1, At, B1); PG8_BAR; PG8_SCHED;
            PG8_LDA(At, 0, 1); PG8_STAGE(PG8_SB(0, 0), b2, voffB); PG8_STAGE(PG8_SB(0, 1), b2 + hstepB, voffB); if constexpr (GATHER) PG8_STAGE(PG8_SA(0, 0), g2, x0); else PG8_STAGE(PG8_SA(0, 0), a2, voffA);
            PG8_WAIT_V(8); PG8_WAIT_L(0); PG8_BAR; PG8_MMA(1, 0, At, B0); PG8_MMA(1, 1, At, B1); PG8_BAR; PG8_SCHED;
            PG8_LDB(B0, 1, 0); PG8_LDB(B1, 1, 1); PG8_SCHED; PG8_LDA(At, 1, 0); if constexpr (GATHER) PG8_STAGE(PG8_SA(0, 1), g2, x1); else PG8_STAGE(PG8_SA(0, 1), a2 + hstepA, voffA);
            PG8_WAIT_V(8); PG8_WAIT_L(0); PG8_BAR; PG8_MMA(0, 0, At, B0); PG8_MMA(0, 1, At, B1); PG8_BAR; PG8_SCHED;
            PG8_LDA(At, 1, 1); PG8_STAGE(PG8_SB(1, 0), b3, voffB); PG8_STAGE(PG8_SB(1, 1), b3 + hstepB, voffB); if constexpr (GATHER) PG8_STAGE(PG8_SA(1, 0), g3, x0); else PG8_STAGE(PG8_SA(1, 0), a3, voffA);
            PG8_WAIT_V(8); PG8_WAIT_L(0); PG8_BAR; PG8_MMA(1, 0, At, B0); PG8_MMA(1, 1, At, B1); PG8_BAR; PG8_SCHED;
            } else {
            PG8_LDB(B0, 0, 0); PG8_SCHED; PG8_LDA(At, 0, 0); PG8_STAGE(PG8_SA(1, 1), a1 + hstepA, voffA);
            PG8_WAIT_L(8); PG8_BAR; PG8_WAIT_L(0); PG8_MMA(0, 0, At, B0); PG8_BAR; PG8_SCHED;
            PG8_LDB(B1, 0, 1); PG8_STAGE(PG8_SB(0, 0), b2, voffB);
            PG8_BAR; PG8_WAIT_L(0); PG8_MMA(0, 1, At, B1); PG8_BAR;
            PG8_LDA(At, 0, 1); PG8_STAGE(PG8_SA(0, 0), a2, voffA);
            PG8_BAR; PG8_WAIT_L(0); PG8_MMA(1, 0, At, B0); PG8_BAR; PG8_SCHED;
            PG8_STAGE(PG8_SB(0, 1), b2 + hstepB, voffB);
            PG8_WAIT_V(6); PG8_BAR; PG8_MMA(1, 1, At, B1); PG8_BAR;
            PG8_LDB(B0, 1, 0); PG8_SCHED; PG8_LDA(At, 1, 0); PG8_STAGE(PG8_SA(0, 1), a2 + hstepA, voffA);
            PG8_WAIT_L(8); PG8_BAR; PG8_WAIT_L(0); PG8_MMA(0, 0, At, B0); PG8_BAR; PG8_SCHED;
            PG8_LDB(B1, 1, 1); PG8_STAGE(PG8_SB(1, 0), b3, voffB);
            PG8_BAR; PG8_WAIT_L(0); PG8_MMA(0, 1, At, B1); PG8_BAR;
            PG8_LDA(At, 1, 1); PG8_STAGE(PG8_SA(1, 0), a3, voffA);
            PG8_BAR; PG8_WAIT_L(0); PG8_MMA(1, 0, At, B0); PG8_BAR; PG8_SCHED;
            PG8_STAGE(PG8_SB(1, 1), b3 + hstepB, voffB);
            PG8_WAIT_V(6); PG8_BAR; PG8_MMA(1, 1, At, B1); PG8_BAR;
            }
        }
        if constexpr (ALIGN_EPI) { if (wr == 0) PG8_BAR; }
        if constexpr (!Epi::AFTER_DRAIN) { E(acc, cur, wr, wc, fr, fq); S.done(cur); }
        if (!has_next) break;
#pragma unroll
        for (int a = 0; a < 2; ++a)
#pragma unroll
            for (int b = 0; b < 2; ++b)
#pragma unroll
                for (int m = 0; m < 4; ++m)
#pragma unroll
                    for (int n = 0; n < 2; ++n) acc[a][b][m][n] = (f32x4){0.f, 0.f, 0.f, 0.f};
        cur = nxt; cA = nA; cB = nB; ++ui;
        if constexpr (GATHER) { cv0[0] = nv0[0]; cv0[1] = nv0[1]; cv1[0] = nv1[0]; cv1[1] = nv1[1]; }
        if constexpr (ALIGN_EPI) { if (wr == 1) PG8_BAR; }
    }
    PG8_WAIT_V(0);
    if constexpr (!ALIGN_EPI) { if (wr == 0) PG8_BAR; }
    PG8_BAR;
    if constexpr (Epi::AFTER_DRAIN) { E.fused(acc, cur, wr, wc, fr, fq, lds, wid, lane); S.done(cur); }
#undef PG8_SA
#undef PG8_SB
#undef PG8_STAGE
#undef PG8_LDA
#undef PG8_LDB
#undef PG8_MMA
#undef PG8_WAIT_V
#undef PG8_WAIT_L
#undef PG8_BAR
#undef PG8_SCHED
#undef PG8_GIDX
}
}

constexpr int NB = 8, SEQ = 2048, NCTX = 256, D = 1024;
constexpr int ML = NB * SEQ, MC = NB * NCTX, MT = ML + MC;
constexpr int MIXIN = 2560, FFN = 2816, NE = 8, ED = 3584;
constexpr float EPS = 1e-6f;
constexpr int NWAVES = 8;
constexpr int MOE_TILES = 136;

constexpr size_t MiB = 1u << 20;
constexpr size_t WS_CTL = 0, CTL_ZERO_BYTES = 65536;
constexpr size_t WS_MOD = 65536, WS_MODP = 1 * MiB; constexpr int MOD_N = 2 * 9 * 6144;
constexpr size_t WS_ROWSS = 3 * MiB, WS_SHW13 = 4608 * 1024, WS_SHWS = WS_SHW13 + 9 * 5632 * 4;
constexpr size_t WS_TOK = 5 * MiB;
constexpr size_t TOK_E = 0, TOK_W = 128 * 1024, TOK_RANK = 256 * 1024, TOK_POS = 384 * 1024, TOK_WGBASE = 512 * 1024, TOK_ROWGATE = 576 * 1024, TOK_ROWSRC = 720 * 1024, TOK_ROWINFO = 864 * 1024;
constexpr size_t WS_MW13 = 6 * MiB, WS_MW2 = 118 * MiB;
constexpr size_t WS_XL = 174 * MiB, WS_H = 238 * MiB, WS_XC = 274 * MiB;
constexpr size_t WS_WIN = 282 * MiB, WS_WOUT = 287 * MiB, WS_W13 = 289 * MiB, WS_W2 = 300 * MiB, WS_SIN = 306 * MiB, WS_SOUT = 308 * MiB;
constexpr size_t WS_BTOUT = 312 * MiB, WS_WEND = 360 * MiB, WS_R = 376 * MiB, WS_END = 512 * MiB;
constexpr size_t WS_QKVU = WS_R, WS_MIX = WS_R + 72 * MiB, WS_ACT = WS_R;
constexpr size_t WS_UC = WS_R, WS_E = WS_R + 72 * MiB, WS_Y = WS_R + 72 * MiB;
constexpr size_t WS_PX = WS_H;
constexpr size_t WS_ACTM = 274 * MiB;
static_assert(WS_ACTM + (size_t)MOE_TILES * 256 * ED * 2 <= WS_END && WS_XC + (size_t)MC * D * 4 <= WS_WIN && WS_H + (size_t)MT * D * 2 <= WS_XC && WS_MW2 + (size_t)NE * D * ED * 2 <= WS_XL, "d_ws map");
constexpr int CW_TMO = 0, CW_CODE = 1, CW_BAR = 4096, CW_GCNT = 8192, CW_CVT = 9216;

constexpr int RING_OFF = 0, RING_BYTES = 131072;
constexpr int LDSCTL_OFF = 155648, MISC_OFF = LDSCTL_OFF + 320;
constexpr int LDS_BYTES = 159744;
static_assert(MISC_OFF + 128 <= LDS_BYTES, "LDS map");

#define GAS __attribute__((address_space(1)))
#define LAS __attribute__((address_space(3)))
typedef unsigned short bf16;
typedef unsigned v4u __attribute__((ext_vector_type(4)));
typedef unsigned v2u __attribute__((ext_vector_type(2)));
typedef float f32x4 __attribute__((ext_vector_type(4)));
typedef float f32x2 __attribute__((ext_vector_type(2)));
typedef float f32x16 __attribute__((ext_vector_type(16)));
typedef short bf16x8 __attribute__((ext_vector_type(8)));
typedef GAS unsigned gu32;
#define RLX_AGENT __ATOMIC_RELAXED, __HIP_MEMORY_SCOPE_AGENT
#define LDS_WAIT() asm volatile("s_waitcnt lgkmcnt(0)" ::: "memory")
#define VM_WAIT() asm volatile("s_waitcnt vmcnt(0)" ::: "memory")
__device__ __forceinline__ unsigned f2bf(float f) { unsigned u = __builtin_bit_cast(unsigned, f); return (u + 0x7fffu + ((u >> 16) & 1u)) >> 16; }
__device__ __forceinline__ unsigned pk2(float lo, float hi) { return f2bf(lo) | (f2bf(hi) << 16); }
__device__ __forceinline__ float bf2f(unsigned short h) { return __builtin_bit_cast(float, (unsigned)h << 16); }
__device__ __forceinline__ float bflo(unsigned w) { return __builtin_bit_cast(float, w << 16); }
__device__ __forceinline__ float bfhi(unsigned w) { return __builtin_bit_cast(float, w & 0xffff0000u); }
__device__ __forceinline__ float sigm(float x) { return __builtin_amdgcn_rcpf(1.0f + __expf(-x)); }
__device__ __forceinline__ float wave_sum(float v) {
#pragma unroll
    for (int o = 1; o < 64; o <<= 1) v += __shfl_xor(v, o);
    return v;
}
__device__ __forceinline__ float wave_max(float v) {
#pragma unroll
    for (int o = 1; o < 64; o <<= 1) v = fmaxf(v, __shfl_xor(v, o));
    return v;
}
#define XB_TMO      128
#define XB_XCNT(j)  (256  + 64 * (j))
#define XB_XSUB(j)  (1280 + 64 * (j))
#define XB_XGEN(j)  (2304 + 64 * (j))
#define XB_TOP      3328
#define XB_TOPGEN   3392
#define XCD_BAR_WORDS 3456
#define XB_SPIN_CAP (1u << 18)

__device__ __forceinline__ unsigned xb_ld(unsigned* p)              { return __hip_atomic_load(p, __ATOMIC_RELAXED, __HIP_MEMORY_SCOPE_AGENT); }
__device__ __forceinline__ unsigned xb_add(unsigned* p, unsigned v) { return __hip_atomic_fetch_add(p, v, __ATOMIC_RELAXED, __HIP_MEMORY_SCOPE_AGENT); }
__device__ __forceinline__ unsigned xb_xcc_id() { return (unsigned)__builtin_amdgcn_s_getreg((3 << 11) | 20) & 0xFu; }
#define XB_SPIN(cond, bar) do { unsigned _sp = 0; while (cond) { __builtin_amdgcn_s_sleep(1); \
    if ((++_sp & 255u) == 0u) { if (xb_ld(&(bar)[XB_TMO])) break; if (_sp > XB_SPIN_CAP) { atomicAdd(&(bar)[XB_TMO], 1u); break; } } } } while (0)

struct XcdBarrier {
    unsigned* bar; unsigned x;
    volatile LAS unsigned* st;
};

__device__ __forceinline__ XcdBarrier xcd_barrier_post(unsigned* bar, volatile LAS unsigned* st) {
    XcdBarrier b; b.bar = bar; b.x = xb_xcc_id(); b.st = st;
    if (threadIdx.x == 0) (void)xb_add(&bar[XB_XCNT(b.x)], 1u);
    return b;
}
__device__ __forceinline__ void xcd_barrier_complete(unsigned* bar, unsigned x, unsigned& nloc, unsigned& nx) {
    const unsigned G = gridDim.x * gridDim.y * gridDim.z;
    unsigned sum, cnt, mine, sp = 0u;
    for (;;) {
        sum = 0u; cnt = 0u; mine = 0u;
#pragma unroll
        for (unsigned j = 0; j < 16; ++j) { const unsigned c = xb_ld(&bar[XB_XCNT(j)]); sum += c; cnt += (c > 0u) ? 1u : 0u; mine = (j == x) ? c : mine; }
        if (sum == G) break;
        __builtin_amdgcn_s_sleep(1);
        if ((++sp & 255u) == 0u) { if (xb_ld(&bar[XB_TMO])) break; if (sp > XB_SPIN_CAP) { atomicAdd(&bar[XB_TMO], 1u); break; } }
    }
    nloc = mine > 0u ? mine : 1u; nx = cnt > 0u ? cnt : 1u;
}

__device__ __forceinline__ void xcd_barrier(const XcdBarrier& b) {
    asm volatile("s_waitcnt vmcnt(0)" ::: "memory");
    __syncthreads();
    if (threadIdx.x == 0) {
        unsigned* bar = b.bar;
        __builtin_amdgcn_s_waitcnt(0);
        unsigned nloc = b.st[0], nx = b.st[1];
        if (nloc == 0u) { xcd_barrier_complete(bar, b.x, nloc, nx); b.st[0] = nloc; b.st[1] = nx; }
        const unsigned old = xb_add(&bar[XB_XSUB(b.x)], 1u);
        const unsigned gen = old / nloc;
        if (old + 1u == (gen + 1u) * nloc) {
            __builtin_amdgcn_fence(__ATOMIC_RELEASE, "agent");
            asm volatile("s_waitcnt vmcnt(0)" ::: "memory");
            const unsigned og = xb_add(&bar[XB_TOP], 1u);
            const unsigned tg = og / nx;
            if (og + 1u == (tg + 1u) * nx) xb_add(&bar[XB_TOPGEN], 1u);
            else XB_SPIN(xb_ld(&bar[XB_TOPGEN]) == tg, bar);
            __builtin_amdgcn_fence(__ATOMIC_ACQUIRE, "agent");
            xb_add(&bar[XB_XGEN(b.x)], 1u);
            asm volatile("s_waitcnt vmcnt(0)" ::: "memory");
        } else {
            XB_SPIN(xb_ld(&bar[XB_XGEN(b.x)]) == gen, bar);
            __builtin_amdgcn_fence(__ATOMIC_ACQUIRE, "agent");
            asm volatile("s_waitcnt vmcnt(0)" ::: "memory");
        }
    }
    __syncthreads();
}
enum { I_X = 0, I_C, I_CTX, I_CCTX, I_ADAW, I_ADAB, I_N1G, I_N2G, I_MIXWIN, I_QG, I_KG, I_RPB, I_DWW, I_DWB, I_LNG, I_LNB, I_MIXWOUT, I_FW1, I_FW3, I_FW2,
       I_SWIN, I_ARE, I_AIM, I_LOGDT, I_BRE, I_BIM, I_CRE, I_CIM, I_SD, I_SWOUT, I_ROUTER, I_MW1, I_MW3, I_MW2, N_IN };
struct Args { const float* in[N_IN]; float* out; unsigned char* ws; int ph_lo, ph_hi, sub, pad; };

typedef short s16x4 __attribute__((ext_vector_type(4)));
typedef float f32x2_t __attribute__((ext_vector_type(2)));
typedef __bf16 bf16x2_t __attribute__((ext_vector_type(2)));
__device__ __forceinline__ unsigned cvtpk(float lo, float hi) { const f32x2_t v = {lo, hi}; const bf16x2_t b = __builtin_convertvector(v, bf16x2_t); return __builtin_bit_cast(unsigned, b); }
__device__ __forceinline__ s16x4 vtr(const LAS unsigned char* p) { return __builtin_bit_cast(s16x4, __builtin_amdgcn_ds_read_tr16_b64_v4i16((LAS s16x4*)p)); }
__device__ __forceinline__ void p0_adaln(const Args& A, int unit, LAS unsigned char* lds, int tid, int wave, int lane) {
    const int l = unit / 96, rem = unit % 96, cb = rem >> 2, kq = rem & 3;
    LAS float* sc = (LAS float*)lds;
    LAS float* part = sc + 9 * 256;
    const float* c = A.in[I_C]; const float* cc = A.in[I_CCTX];
    for (int i = tid; i < 9 * 256; i += NWAVES * 64) { const int r = i >> 8, k = 256 * kq + (i & 255); const float v = r < 8 ? c[r * 1024 + k] : cc[k]; sc[i] = v * sigm(v); }
    __syncthreads();
    const float* wp = A.in[I_ADAW] + (size_t)l * 1024 * 6144 + (size_t)(256 * kq + 32 * wave) * 6144 + 256 * cb + 4 * lane;
    float acc[9][4];
#pragma unroll
    for (int r = 0; r < 9; ++r)
#pragma unroll
        for (int j = 0; j < 4; ++j) acc[r][j] = 0.f;
#pragma unroll 8
    for (int it = 0; it < 32; ++it) {
        const f32x4 wv = *(const f32x4*)(wp + (size_t)it * 6144); const int k = 32 * wave + it;
#pragma unroll
        for (int r = 0; r < 9; ++r) { const float s = sc[r * 256 + k];
#pragma unroll
            for (int j = 0; j < 4; ++j) acc[r][j] += s * wv[j]; }
    }
#pragma unroll
    for (int r = 0; r < 9; ++r) *(LAS f32x4*)(part + (wave * 9 + r) * 256 + 4 * lane) = (f32x4){acc[r][0], acc[r][1], acc[r][2], acc[r][3]};
    __syncthreads();
    float* modp = (float*)(A.ws + WS_MODP) + (size_t)kq * MOD_N;
    for (int i = tid; i < 9 * 256; i += NWAVES * 64) { const int r = i >> 8, col = i & 255; float s = 0.f;
#pragma unroll
        for (int w = 0; w < 8; ++w) s += part[(w * 9 + r) * 256 + col];
        if (kq == 0) s += A.in[I_ADAB][l * 6144 + 256 * cb + col];
        modp[((size_t)l * 9 + r) * 6144 + 256 * cb + col] = s; }
    __syncthreads();
}
constexpr int KTS = 260;
__device__ __forceinline__ void p0_s5gen(const Args& A, int g, int part, LAS unsigned char* lds, int tid) {
    LAS f32x2* POW = (LAS f32x2*)lds;
    LAS float* BBr = (LAS float*)(POW + 2 * 64 * 33 + 8);
    LAS float* BBi = BBr + 2 * 64 * 16;
    LAS f32x2* CC = (LAS f32x2*)(BBi + 2 * 64 * 16);
    LAS f32x2* CT = CC + 2 * 16 * 66 + 8;
    LAS float* KT = (LAS float*)(CT + 2 * 64 * 16);
    LAS f32x2* FF = (LAS f32x2*)(KT + 63 * KTS);
#define PWI(d_, p_, m_) (((d_) * 64 + (p_)) * 33 + (m_) + ((p_) >> 5) + (d_) * 4)
#define CCI(d_, q_, p_) (((d_) * 16 + (q_)) * 66 + (p_) + ((p_) >> 5) + (d_) * 4)
    if (tid < 128) { const int d = tid >> 6, p = tid & 63, ix = (d * 64 + g) * 64 + p;
        const float ar = A.in[I_ARE][ix], ai = A.in[I_AIM][ix], dt = __expf(A.in[I_LOGDT][d * 64 + g]);
        const float zr = ar * dt, zi = ai * dt, mag = __expf(zr); const float lr = mag * cosf(zi), li = mag * sinf(zi);
        float pr = 1.f, pi = 0.f;
        for (int m = 0; m <= 32; ++m) { POW[PWI(d, p, m)] = (f32x2){pr, pi}; const float nr = pr * lr - pi * li, ni = pr * li + pi * lr; pr = nr; pi = ni; }
        const float nr = lr - 1.f, ni = li, den = 1.f / (ar * ar + ai * ai);
        FF[d * 64 + p] = (f32x2){(nr * ar + ni * ai) * den, (ni * ar - nr * ai) * den}; }
    __syncthreads();
    for (int i = tid; i < 2048; i += NWAVES * 64) { const int d = i >> 10, p = (i >> 4) & 63, q = i & 15; const int ix = ((d * 64 + g) * 64 + p) * 16 + q;
        const float br = A.in[I_BRE][ix], bi = A.in[I_BIM][ix]; const f32x2 f = FF[d * 64 + p];
        BBr[(d * 64 + p) * 16 + q] = f.x * br - f.y * bi; BBi[(d * 64 + p) * 16 + q] = f.x * bi + f.y * br; }
    for (int i = tid; i < 2048; i += NWAVES * 64) { const int d = i >> 10, q = (i >> 6) & 15, p = i & 63; const int ix = ((d * 64 + g) * 16 + q) * 64 + p;
        const f32x2 cv2 = (f32x2){A.in[I_CRE][ix], A.in[I_CIM][ix]}; CC[CCI(d, q, p)] = cv2; CT[(d * 64 + p) * 16 + q] = cv2; }
    __syncthreads();
    bf16* BtOut = (bf16*)(A.ws + WS_BTOUT) + (size_t)g * 512 * 768;
    bf16* WEnd = (bf16*)(A.ws + WS_WEND) + (size_t)g * 256 * 512;
    if (part == 0) {
#pragma unroll 1
    for (int d = 0; d < 2; ++d) {
        const int dl = tid >> 4, qo = tid & 15; float acc[16];
#pragma unroll
        for (int i = 0; i < 16; ++i) acc[i] = 0.f;
#pragma unroll 2
        for (int p = 0; p < 64; ++p) { const f32x2 c = CT[(d * 64 + p) * 16 + qo], w = POW[PWI(d, p, dl)]; const float tr = c.x * w.x - c.y * w.y, ti = c.x * w.y + c.y * w.x;
            const LAS f32x4* br = (const LAS f32x4*)(BBr + (d * 64 + p) * 16); const LAS f32x4* bi = (const LAS f32x4*)(BBi + (d * 64 + p) * 16);
#pragma unroll
            for (int q4 = 0; q4 < 4; ++q4) { const f32x4 r4 = br[q4], i4 = bi[q4];
#pragma unroll
                for (int j = 0; j < 4; ++j) acc[4 * q4 + j] += tr * r4[j] - ti * i4[j]; } }
        if (d == 0) {
            { const float dsk = (dl == 0) ? A.in[I_SD][g * 16 + qo] : 0.f;
#pragma unroll
              for (int i = 0; i < 16; ++i) acc[i] += (i == qo) ? dsk : 0.f; }
#pragma unroll
            for (int i = 0; i < 4; ++i) *(LAS f32x4*)(KT + (31 + dl) * KTS + qo * 16 + 4 * i) = (f32x4){acc[4 * i], acc[4 * i + 1], acc[4 * i + 2], acc[4 * i + 3]};
        } else {
#pragma unroll
            for (int i = 0; i < 4; ++i) { LAS f32x4* kp = (LAS f32x4*)(KT + (31 - dl) * KTS + qo * 16 + 4 * i); f32x4 v = (f32x4){acc[4 * i], acc[4 * i + 1], acc[4 * i + 2], acc[4 * i + 3]}; if (dl == 0) v = v + *kp; *kp = v; }
        }
        __syncthreads();
    }
    for (int pc = tid; pc < 512 * 64; pc += NWAVES * 64) {
        const int n = pc >> 6, kp = pc & 63, t = n >> 4, qo = n & 15, j = kp >> 1, qi0 = (kp & 1) * 8; const LAS float* s = KT + (t - j + 31) * KTS + qo * 16 + qi0;
        const f32x4 s0 = *(const LAS f32x4*)s, s1 = *(const LAS f32x4*)(s + 4);
        v4u o; o.x = cvtpk(s0.x, s0.y); o.y = cvtpk(s0.z, s0.w); o.z = cvtpk(s1.x, s1.y); o.w = cvtpk(s1.z, s1.w);
        *(v4u*)(BtOut + (size_t)n * 768 + kp * 8) = o; }
    } else {
    for (int pc = tid; pc < 512 * 32; pc += NWAVES * 64) {
        const int n = pc >> 5, kp = pc & 31, t = n >> 4, qo = n & 15, d = kp >> 4, ri = (kp >> 3) & 1, p0 = (kp & 7) * 8, m = d == 0 ? t + 1 : 32 - t; float v[8];
#pragma unroll
        for (int i = 0; i < 8; ++i) { const f32x2 c = CC[CCI(d, qo, p0 + i)], w = POW[PWI(d, p0 + i, m)]; v[i] = ri == 0 ? (c.x * w.x - c.y * w.y) : -(c.x * w.y + c.y * w.x); }
        v4u o; o.x = cvtpk(v[0], v[1]); o.y = cvtpk(v[2], v[3]); o.z = cvtpk(v[4], v[5]); o.w = cvtpk(v[6], v[7]);
        *(v4u*)(BtOut + (size_t)n * 768 + 512 + kp * 8) = o; }
    for (int pc = tid; pc < 256 * 64; pc += NWAVES * 64) {
        const int n = pc >> 6, kp = pc & 63, d = n >> 7, ri = (n >> 6) & 1, p = n & 63, j = kp >> 1, qi0 = (kp & 1) * 8, m = d == 0 ? 31 - j : j; const f32x2 w = POW[PWI(d, p, m)]; float v[8];
#pragma unroll
        for (int i = 0; i < 8; ++i) { const float br = BBr[(d * 64 + p) * 16 + qi0 + i], bi = BBi[(d * 64 + p) * 16 + qi0 + i]; v[i] = ri == 0 ? (w.x * br - w.y * bi) : (w.x * bi + w.y * br); }
        v4u o; o.x = cvtpk(v[0], v[1]); o.y = cvtpk(v[2], v[3]); o.z = cvtpk(v[4], v[5]); o.w = cvtpk(v[6], v[7]);
        *(v4u*)(WEnd + (size_t)n * 512 + kp * 8) = o; }
    }
    __syncthreads();
#undef PWI
#undef CCI
}
__device__ __forceinline__ void cvt_item(const float* W, int K, int N, int ldw, bf16* WT, int mode, int item, LAS float* scr, int lane) {
    const int nblk = N / 32, kb = item / nblk, nb = item - kb * nblk, k0 = 64 * kb, n0 = 32 * nb;
    int r0 = n0;
    if (mode == 1) r0 = 256 * (n0 >> 7) + (n0 & 127);
    else if (mode == 2) r0 = 256 * (n0 >> 7) + 128 + (n0 & 127);
    else if (mode == 3) { if (n0 < 1536) { const int pn = n0 >> 8, rem = n0 & 255; r0 = 256 * pn + 128 * ((rem & 63) >> 5) + 32 * (rem >> 6); }
                          else if (n0 < 2048) { const int n1 = n0 - 1536; r0 = 256 * (6 + (n1 >> 7)) + (n1 & 127); }
                          else { const int n1 = n0 - 2048; r0 = 256 * (6 + (n1 >> 7)) + 128 + (n1 & 127); } }
    { f32x4 v[8];
#pragma unroll
      for (int i = 0; i < 8; ++i) v[i] = *(const f32x4*)(W + (size_t)(k0 + 8 * i + (lane >> 3)) * ldw + n0 + 4 * (lane & 7));
#pragma unroll
      for (int i = 0; i < 8; ++i) { LAS float* d = scr + (8 * i + (lane >> 3)) * 33 + 4 * (lane & 7); d[0] = v[i].x; d[1] = v[i].y; d[2] = v[i].z; d[3] = v[i].w; } }
    LDS_WAIT(); asm volatile("" ::: "memory");
    const int c = lane & 7;
#pragma unroll
    for (int j = 0; j < 4; ++j) { const int n = (lane >> 3) + 8 * j; const LAS float* s = scr + (8 * c) * 33 + n;
        v4u o; o.x = cvtpk(s[0 * 33], s[1 * 33]); o.y = cvtpk(s[2 * 33], s[3 * 33]); o.z = cvtpk(s[4 * 33], s[5 * 33]); o.w = cvtpk(s[6 * 33], s[7 * 33]);
        *(GAS v4u*)(WT + (size_t)(r0 + n) * K + k0 + 8 * c) = o; }
    LDS_WAIT(); asm volatile("" ::: "memory");
}
constexpr int CV_IM = 16 * 112, CV_IM2 = 56 * 32, CV_NMOE = NE * (2 * CV_IM + CV_IM2);
__device__ __forceinline__ void p0_convert(const Args& A, LAS unsigned char* lds, int gw, int NGW, int wave, int lane) {
    LAS float* scr = (LAS float*)(lds + wave * 16384);
    unsigned char* ws = A.ws;
    constexpr int I0 = 16 * 80, I1 = 16 * 32, I2 = 16 * 88, I3 = 44 * 32, I4 = 16 * 32, I5 = 16 * 32;
    constexpr int NSMALL = I0 + I1 + 2 * I2 + I3 + I4 + 2 * I5;
    for (int it = gw; it < NSMALL; it += NGW) {
        int r = it;
        if (r < I0) { cvt_item(A.in[I_MIXWIN], D, MIXIN, MIXIN, (bf16*)(ws + WS_WIN), 3, r, scr, lane); continue; } r -= I0;
        if (r < I1) { cvt_item(A.in[I_MIXWOUT], D, D, D, (bf16*)(ws + WS_WOUT), 0, r, scr, lane); continue; } r -= I1;
        if (r < I2) { cvt_item(A.in[I_FW1], D, FFN, FFN, (bf16*)(ws + WS_W13), 1, r, scr, lane); continue; } r -= I2;
        if (r < I2) { cvt_item(A.in[I_FW3], D, FFN, FFN, (bf16*)(ws + WS_W13), 2, r, scr, lane); continue; } r -= I2;
        if (r < I3) { cvt_item(A.in[I_FW2], FFN, D, D, (bf16*)(ws + WS_W2), 0, r, scr, lane); continue; } r -= I3;
        if (r < I4) { cvt_item(A.in[I_SWIN], D, D, D, (bf16*)(ws + WS_SIN), 0, r, scr, lane); continue; } r -= I4;
        if (r < I5) { cvt_item(A.in[I_SWOUT], D, D, 2 * D, (bf16*)(ws + WS_SOUT), 1, r, scr, lane); continue; } r -= I5;
        cvt_item(A.in[I_SWOUT] + D, D, D, 2 * D, (bf16*)(ws + WS_SOUT), 2, r, scr, lane);
    }
}
__device__ __forceinline__ void moe_convert(const Args& A, LAS unsigned char* lds, int first, int count, int widx, int nw, int wave, int lane) {
    LAS float* scr = (LAS float*)(lds + wave * 16384);
    unsigned char* ws = A.ws;
    const int last = (first + count) < CV_NMOE ? (first + count) : CV_NMOE;
    for (int it = first + widx; it < last; it += nw) {
        int r = it; const int e = r / (2 * CV_IM + CV_IM2); r -= e * (2 * CV_IM + CV_IM2);
        if (r < CV_IM) { cvt_item(A.in[I_MW1] + (size_t)e * D * ED, D, ED, ED, (bf16*)(ws + WS_MW13) + (size_t)e * 2 * ED * D, 1, r, scr, lane); continue; } r -= CV_IM;
        if (r < CV_IM) { cvt_item(A.in[I_MW3] + (size_t)e * D * ED, D, ED, ED, (bf16*)(ws + WS_MW13) + (size_t)e * 2 * ED * D, 2, r, scr, lane); continue; } r -= CV_IM;
        cvt_item(A.in[I_MW2] + (size_t)e * ED * D, ED, D, D, (bf16*)(ws + WS_MW2) + (size_t)e * D * ED, 0, r, scr, lane);
    }
}
__device__ __forceinline__ void shw_rows(const bf16* WT, int N, const float* sh, float* out, int widx, int nw, LAS unsigned char* lds, int tid, int lane) {
    LAS float* shl = (LAS float*)lds;
    __syncthreads();
    for (int i = tid; i < 9 * 1024; i += NWAVES * 64) shl[i] = sh[(size_t)(i >> 10) * 6144 + (i & 1023)];
    __syncthreads();
    for (int p = widx; p < N; p += nw) {
        const v4u w0 = *(const v4u*)(WT + (size_t)p * D + 16 * lane), w1 = *(const v4u*)(WT + (size_t)p * D + 16 * lane + 8);
        const float w[16] = {bflo(w0.x), bfhi(w0.x), bflo(w0.y), bfhi(w0.y), bflo(w0.z), bfhi(w0.z), bflo(w0.w), bfhi(w0.w), bflo(w1.x), bfhi(w1.x), bflo(w1.y), bfhi(w1.y), bflo(w1.z), bfhi(w1.z), bflo(w1.w), bfhi(w1.w)};
        float s[9];
#pragma unroll
        for (int b = 0; b < 9; ++b) { const LAS f32x4* sp = (const LAS f32x4*)(shl + b * 1024 + 16 * lane); float a = 0.f;
#pragma unroll
            for (int q = 0; q < 4; ++q) { const f32x4 v = sp[q]; a += (v.x * w[4 * q] + v.y * w[4 * q + 1]) + (v.z * w[4 * q + 2] + v.w * w[4 * q + 3]); }
            s[b] = a; }
#pragma unroll
        for (int b = 0; b < 9; ++b) s[b] = wave_sum(s[b]);
        if (lane < 9) { float v = s[0];
#pragma unroll
            for (int b = 1; b < 9; ++b) v = (lane == b) ? s[b] : v;
            out[(size_t)lane * N + p] = v; }
    }
    __syncthreads();
}
__device__ __forceinline__ void moe_convert_dyn(const Args& A, LAS unsigned char* lds, unsigned cap, int wave, int lane) {
    LAS float* scr = (LAS float*)(lds + wave * 16384);
    unsigned char* ws = A.ws; unsigned* ctr = (unsigned*)(ws + WS_CTL) + CW_CVT;
    for (;;) {
        unsigned cur = 0u; if (lane == 0) cur = __hip_atomic_load(ctr, RLX_AGENT); cur = (unsigned)__builtin_amdgcn_readfirstlane((int)cur);
        if (cur >= cap) break;
        unsigned i0 = 0u; if (lane == 0) i0 = __hip_atomic_fetch_add(ctr, 8u, RLX_AGENT); i0 = (unsigned)__builtin_amdgcn_readfirstlane((int)i0);
        if (i0 >= (unsigned)CV_NMOE) break;
        for (int k = 0; k < 8; ++k) { int r = (int)i0 + k; if (r >= CV_NMOE) break;
            const int e = r / (2 * CV_IM + CV_IM2); r -= e * (2 * CV_IM + CV_IM2);
            if (r < CV_IM) { cvt_item(A.in[I_MW1] + (size_t)e * D * ED, D, ED, ED, (bf16*)(ws + WS_MW13) + (size_t)e * 2 * ED * D, 1, r, scr, lane); continue; } r -= CV_IM;
            if (r < CV_IM) { cvt_item(A.in[I_MW3] + (size_t)e * D * ED, D, ED, ED, (bf16*)(ws + WS_MW13) + (size_t)e * 2 * ED * D, 2, r, scr, lane); continue; } r -= CV_IM;
            cvt_item(A.in[I_MW2] + (size_t)e * ED * D, ED, D, D, (bf16*)(ws + WS_MW2) + (size_t)e * D * ED, 0, r, scr, lane); }
    }
}
template <int NPART> __device__ __forceinline__ void norm_row_finish(const f32x4 (&v)[4], int row, const float* gain, const float* mod, int shc, int scc, bf16* H, int lane) {
    const float* mp = mod + (size_t)(row < ML ? (row >> 11) : 8) * 6144; float ss = 0.f;
#pragma unroll
    for (int j = 0; j < 4; ++j) ss += (v[j].x * v[j].x + v[j].y * v[j].y) + (v[j].z * v[j].z + v[j].w * v[j].w);
    const float rstd = rsqrtf(wave_sum(ss) * (1.0f / D) + EPS);
#pragma unroll
    for (int j = 0; j < 4; ++j) { const int k = 4 * lane + 256 * j; const f32x4 gg = *(const f32x4*)(gain + k); f32x4 sc = *(const f32x4*)(mp + scc * 1024 + k), sh = *(const f32x4*)(mp + shc * 1024 + k);
#pragma unroll
        for (int q = 1; q < NPART; ++q) { sc = sc + *(const f32x4*)(mp + (size_t)q * MOD_N + scc * 1024 + k); sh = sh + *(const f32x4*)(mp + (size_t)q * MOD_N + shc * 1024 + k); }
        const f32x4 h = v[j] * rstd * gg * (sc + 1.0f) + sh;
        v2u o; o.x = cvtpk(h.x, h.y); o.y = cvtpk(h.z, h.w); *(v2u*)(H + (size_t)row * D + k) = o; }
}
__device__ __forceinline__ void norm_rows_lds(const float* xL, const float* xC, int nrows, const float* gain, const LAS float* ms, bf16* H, int gw, int NGW, int lane) {
    for (int row = gw; row < nrows; row += 2 * NGW) {
        const int row1 = row + NGW; const bool two = row1 < nrows; const int r1 = two ? row1 : row;
        const float* xa = row < ML ? xL + (size_t)row * D : xC + (size_t)(row - ML) * D; const float* xb = r1 < ML ? xL + (size_t)r1 * D : xC + (size_t)(r1 - ML) * D;
        f32x4 vv[2][4];
#pragma unroll
        for (int j = 0; j < 4; ++j) { vv[0][j] = *(const f32x4*)(xa + 4 * lane + 256 * j); vv[1][j] = *(const f32x4*)(xb + 4 * lane + 256 * j); }
#pragma unroll
        for (int u = 0; u < 2; ++u) { if (u == 1 && !two) break; const int rw = u ? row1 : row; const LAS float* mp = ms + (rw < ML ? (rw >> 11) : 8) * 2048; float ss = 0.f;
#pragma unroll
            for (int j = 0; j < 4; ++j) ss += (vv[u][j].x * vv[u][j].x + vv[u][j].y * vv[u][j].y) + (vv[u][j].z * vv[u][j].z + vv[u][j].w * vv[u][j].w);
            const float rstd = rsqrtf(wave_sum(ss) * (1.0f / D) + EPS);
#pragma unroll
            for (int j = 0; j < 4; ++j) { const int k = 4 * lane + 256 * j; const f32x4 gg = *(const f32x4*)(gain + k), sh = *(const LAS f32x4*)(mp + k), sc = *(const LAS f32x4*)(mp + 1024 + k);
                const f32x4 h = vv[u][j] * rstd * gg * (sc + 1.0f) + sh;
                v2u o; o.x = cvtpk(h.x, h.y); o.y = cvtpk(h.z, h.w); *(v2u*)(H + (size_t)rw * D + k) = o; } }
    }
}
template <int NPART> __device__ __forceinline__ void norm_rows(const float* xL, const float* xC, int nrows, const float* gain, const float* mod, int shc, int scc, bf16* H, int gw, int NGW, int lane) {
    for (int row = gw; row < nrows; row += 2 * NGW) {
        const int row1 = row + NGW; const bool two = row1 < nrows; const int r1 = two ? row1 : row;
        const float* xa = row < ML ? xL + (size_t)row * D : xC + (size_t)(row - ML) * D; const float* xb = r1 < ML ? xL + (size_t)r1 * D : xC + (size_t)(r1 - ML) * D;
        f32x4 va[4], vb[4];
#pragma unroll
        for (int j = 0; j < 4; ++j) { va[j] = *(const f32x4*)(xa + 4 * lane + 256 * j); vb[j] = *(const f32x4*)(xb + 4 * lane + 256 * j); }
        norm_row_finish<NPART>(va, row, gain, mod, shc, scc, H, lane);
        if (two) norm_row_finish<NPART>(vb, row1, gain, mod, shc, scc, H, lane);
    }
}
constexpr int VSTR = 144;
__device__ __forceinline__ void attn_unit(const bf16* QKVU, bf16* MIX, int wu, LAS unsigned char* vl, LAS unsigned char* ql, const LAS float* rpbl, float bnd, int lane) {
    const bool isctx = wu >= 2048;
    int b, h, r = 0, qrow0;
    if (!isctx) { h = wu & 7; r = (wu >> 3) & 31; b = wu >> 8; qrow0 = b * SEQ + r * 64; }
    else { const int w = wu - 2048; h = w & 7; b = w >> 5; qrow0 = ML + b * NCTX + 64 * ((w >> 3) & 3); }
    const int c = lane & 31, hh = lane >> 5;
    const int rs = r < 4 ? 0 : (r > 28 ? 24 : r - 4);
    const int csA = c < 8 ? 0 : c - 8;
    const int csB = c > 24 ? 48 : c + 24;
    const LAS unsigned char* vtb = vl + (4 * hh + ((lane & 15) >> 2)) * VSTR + 32 * ((lane >> 4) & 1) + 8 * (lane & 3);
    LAS unsigned char* qs = ql + c * 128 + 16 * hh;
    { const bf16* qp = QKVU + (size_t)(qrow0 + c) * 2048 + h * 64 + 8 * hh;
#pragma unroll
      for (int s = 0; s < 4; ++s) { *(LAS bf16x8*)(qs + 32 * s) = *(const bf16x8*)(qp + 16 * s); *(LAS bf16x8*)(qs + 4096 + 32 * s) = *(const bf16x8*)(qp + (size_t)32 * 2048 + 16 * s); } }
    f32x16 oA0, oA1, oB0, oB1;
#pragma unroll
    for (int i = 0; i < 16; ++i) { oA0[i] = 0.f; oA1[i] = 0.f; oB0[i] = 0.f; oB1[i] = 0.f; }
    float lsA = 0.f, lsB = 0.f;
    const int nblk = isctx ? 8 : 24;
    const bf16* kbase = QKVU + 512 + h * 64 + 8 * hh + (size_t)c * 2048;
    const bf16* vbase = QKVU + 1024 + h * 64 + 8 * (lane & 7) + (size_t)(lane >> 3) * 2048;
#define ATT_KROW0(kb_) (((!isctx) && (kb_) < 16) ? (b * SEQ + (rs + ((kb_) >> 1)) * 64 + 32 * ((kb_) & 1)) : (ML + b * NCTX + 32 * (isctx ? (kb_) : (kb_) - 16)))
#define ATT_LOADK(KF, kb_) do { const int kq_ = (kb_) < nblk ? (kb_) : nblk - 1; const size_t ro_ = (size_t)ATT_KROW0(kq_) * 2048; \
        _Pragma("unroll") for (int s_ = 0; s_ < 4; ++s_) KF[s_] = *(const bf16x8*)(kbase + ro_ + 16 * s_); } while (0)
#define ATT_LOADV(VF, kb_) do { const int kq_ = (kb_) < nblk ? (kb_) : nblk - 1; const size_t ro_ = (size_t)ATT_KROW0(kq_) * 2048; \
        _Pragma("unroll") for (int i_ = 0; i_ < 4; ++i_) VF[i_] = *(const v4u*)(vbase + ro_ + (size_t)i_ * 8 * 2048); } while (0)
#define ATT_PACK(PF, P) do { _Pragma("unroll") for (int s = 0; s < 2; ++s) { v4u w; w.x = cvtpk(P[8 * s], P[8 * s + 1]); w.y = cvtpk(P[8 * s + 2], P[8 * s + 3]); w.z = cvtpk(P[8 * s + 4], P[8 * s + 5]); w.w = cvtpk(P[8 * s + 6], P[8 * s + 7]); PF[s] = __builtin_bit_cast(bf16x8, w); } } while (0)
#define ATT_BLOCK(KF, VF, kb_) do { const int kb = (kb_); const bool live = kb < nblk; const bool band = (!isctx) && kb < 16; const int kr = rs + (kb >> 1); \
        _Pragma("unroll") for (int i = 0; i < 4; ++i) { const int id = lane + 64 * i; *(LAS v4u*)(vl + (id >> 3) * VSTR + (id & 7) * 16) = VF[i]; } \
        ATT_LOADV(VF, kb + 1);              \
        f32x16 sA, sB; \
        _Pragma("unroll") for (int i = 0; i < 16; ++i) { sA[i] = 0.f; sB[i] = 0.f; } \
        _Pragma("unroll") for (int s = 0; s < 4; ++s) { sA = __builtin_amdgcn_mfma_f32_32x32x16_bf16(KF[s], *(const LAS bf16x8*)(qs + 32 * s), sA, 0, 0, 0); \
                                                        sB = __builtin_amdgcn_mfma_f32_32x32x16_bf16(KF[s], *(const LAS bf16x8*)(qs + 4096 + 32 * s), sB, 0, 0, 0); } \
        ATT_LOADK(KF, kb + 1);              \
        float pA[16], pB[16]; \
        if (band) { const int kc0 = 32 * (kb & 1) + 4 * hh; const LAS float* rb = rpbl + h * 465 + (kr - r + 7) * 31 + (kc0 - c); \
              \
            float bA[16], bB[16]; \
            _Pragma("unroll") for (int i = 0; i < 16; ++i) { bA[i] = rb[15 + (i & 3) + 8 * (i >> 2)]; bB[i] = rb[(i & 3) + 8 * (i >> 2) - 17]; } \
            const int tA = kc0 - csA, tB = kc0 - csB; \
            _Pragma("unroll") for (int i = 0; i < 16; ++i) { const int o = (i & 3) + 8 * (i >> 2); \
                { const bool ok = (unsigned)(tA + o) < 16u; const float e = __builtin_amdgcn_exp2f(sA[i] * 0.18033688f + bA[i]); pA[i] = ok ? e : 0.f; } \
                { const bool ok = (unsigned)(tB + o) < 16u; const float e = __builtin_amdgcn_exp2f(sB[i] * 0.18033688f + bB[i]); pB[i] = ok ? e : 0.f; } } \
        } else { \
            _Pragma("unroll") for (int i = 0; i < 16; ++i) { const float ea = __builtin_amdgcn_exp2f(sA[i] * 0.18033688f - bnd), eb = __builtin_amdgcn_exp2f(sB[i] * 0.18033688f - bnd); pA[i] = live ? ea : 0.f; pB[i] = live ? eb : 0.f; } } \
        _Pragma("unroll") for (int i = 0; i < 16; ++i) { lsA += pA[i]; lsB += pB[i]; } \
        bf16x8 fA[2], fB[2]; ATT_PACK(fA, pA); ATT_PACK(fB, pB); \
        LDS_WAIT(); \
        _Pragma("unroll") for (int dt = 0; dt < 2; ++dt) \
            _Pragma("unroll") for (int s = 0; s < 2; ++s) { \
                const s16x4 lo = vtr(vtb + (16 * s) * VSTR + 64 * dt), hi = vtr(vtb + (16 * s + 8) * VSTR + 64 * dt); \
                const bf16x8 af = (bf16x8){lo[0], lo[1], lo[2], lo[3], hi[0], hi[1], hi[2], hi[3]}; \
                if (dt == 0) { oA0 = __builtin_amdgcn_mfma_f32_32x32x16_bf16(af, fA[s], oA0, 0, 0, 0); oB0 = __builtin_amdgcn_mfma_f32_32x32x16_bf16(af, fB[s], oB0, 0, 0, 0); } \
                else { oA1 = __builtin_amdgcn_mfma_f32_32x32x16_bf16(af, fA[s], oA1, 0, 0, 0); oB1 = __builtin_amdgcn_mfma_f32_32x32x16_bf16(af, fB[s], oB1, 0, 0, 0); } } \
        } while (0)
    bf16x8 kA[4]; v4u vA[4];
    ATT_LOADK(kA, 0); ATT_LOADV(vA, 0);
    for (int kb1 = 0; kb1 < nblk; ++kb1) ATT_BLOCK(kA, vA, kb1);
#undef ATT_KROW0
#undef ATT_LOADK
#undef ATT_LOADV
#undef ATT_PACK
#undef ATT_BLOCK
    lsA += __shfl_xor(lsA, 32); lsB += __shfl_xor(lsB, 32);
    const float iA = 1.0f / lsA, iB = 1.0f / lsB;
    bf16* op = MIX + (size_t)(qrow0 + c) * D + h * 64 + 4 * hh; bf16* oq = op + (size_t)32 * D;
#pragma unroll
    for (int i4 = 0; i4 < 4; ++i4) {
        v2u w0; w0.x = cvtpk(oA0[4 * i4] * iA, oA0[4 * i4 + 1] * iA); w0.y = cvtpk(oA0[4 * i4 + 2] * iA, oA0[4 * i4 + 3] * iA); *(v2u*)(op + 8 * i4) = w0;
        v2u w1; w1.x = cvtpk(oA1[4 * i4] * iA, oA1[4 * i4 + 1] * iA); w1.y = cvtpk(oA1[4 * i4 + 2] * iA, oA1[4 * i4 + 3] * iA); *(v2u*)(op + 32 + 8 * i4) = w1;
        v2u w2; w2.x = cvtpk(oB0[4 * i4] * iB, oB0[4 * i4 + 1] * iB); w2.y = cvtpk(oB0[4 * i4 + 2] * iB, oB0[4 * i4 + 3] * iB); *(v2u*)(oq + 8 * i4) = w2;
        v2u w3; w3.x = cvtpk(oB1[4 * i4] * iB, oB1[4 * i4 + 1] * iB); w3.y = cvtpk(oB1[4 * i4 + 2] * iB, oB1[4 * i4 + 3] * iB); *(v2u*)(oq + 32 + 8 * i4) = w3; }
}
template <int P0, int NP> __device__ __forceinline__ void conv_chunk(float (&acc)[32], const float (&w)[31], const __amdgpu_buffer_rsrc_t rsrc, int voff, int t0, int len) {
    float v[NP];
#pragma unroll
    for (int i = 0; i < NP; ++i) { const int t = t0 - 15 + P0 + i, tc = t < 0 ? 0 : (t >= len ? len - 1 : t); const int so = __builtin_amdgcn_readfirstlane(tc * 4096);
        const float x = bf2f(__builtin_amdgcn_raw_buffer_load_b16(rsrc, voff, so, 0)); v[i] = (t == tc) ? x : 0.f; }
#pragma unroll
    for (int i = 0; i < NP; ++i)
#pragma unroll
        for (int tt = 0; tt < 32; ++tt) { if (P0 + i - tt >= 0 && P0 + i - tt <= 30) acc[tt] += v[i] * w[(P0 + i - tt >= 0 && P0 + i - tt <= 30) ? P0 + i - tt : 0]; }
}
__device__ __forceinline__ void conv_item(const Args& A, const bf16* QKVU, bf16* MIX, int item, LAS float* cv, int tid, int wave, int lane) {
    __syncthreads();
    int rowbase, len, t0;
    if (item < 512) { rowbase = (item >> 6) * SEQ; len = SEQ; t0 = 32 * (item & 63); } else { const int i2 = item - 512; rowbase = ML + (i2 >> 3) * NCTX; len = NCTX; t0 = 32 * (i2 & 7); }
    const int ch = tid;
    float w[31], acc[32];
    { const __amdgpu_buffer_rsrc_t wrs = __builtin_amdgcn_make_buffer_rsrc((void*)A.in[I_DWW], 0, 31 * 512 * 4, 0x00020000);
#pragma unroll
      for (int k = 0; k < 31; ++k) w[k] = __builtin_bit_cast(float, __builtin_amdgcn_raw_buffer_load_b32(wrs, 4 * ch, k * 2048, 0)); }
    const float bias = A.in[I_DWB][ch];
#pragma unroll
    for (int t = 0; t < 32; ++t) acc[t] = bias;
    const __amdgpu_buffer_rsrc_t rsrc = __builtin_amdgcn_make_buffer_rsrc((void*)(QKVU + (size_t)rowbase * 2048 + 1536), 0, len * 4096, 0x00020000);
    conv_chunk<0, 16>(acc, w, rsrc, 2 * ch, t0, len); conv_chunk<16, 16>(acc, w, rsrc, 2 * ch, t0, len); conv_chunk<32, 16>(acc, w, rsrc, 2 * ch, t0, len); conv_chunk<48, 14>(acc, w, rsrc, 2 * ch, t0, len);
#pragma unroll
    for (int t = 0; t < 32; ++t) cv[t * 512 + ch] = acc[t];
    __syncthreads();
    const f32x4 g0 = *(const f32x4*)(A.in[I_LNG] + 8 * lane), g1 = *(const f32x4*)(A.in[I_LNG] + 8 * lane + 4), b0 = *(const f32x4*)(A.in[I_LNB] + 8 * lane), b1 = *(const f32x4*)(A.in[I_LNB] + 8 * lane + 4);
#pragma unroll
    for (int q = 0; q < 4; ++q) { const int tt = 4 * wave + q;
        f32x4 x0 = *(const LAS f32x4*)(cv + tt * 512 + 8 * lane), x1 = *(const LAS f32x4*)(cv + tt * 512 + 8 * lane + 4);
        const float mean = wave_sum((x0.x + x0.y) + (x0.z + x0.w) + (x1.x + x1.y) + (x1.z + x1.w)) * (1.0f / 512.0f);
        x0 = x0 - mean; x1 = x1 - mean;
        const float var = wave_sum((x0.x * x0.x + x0.y * x0.y) + (x0.z * x0.z + x0.w * x0.w) + (x1.x * x1.x + x1.y * x1.y) + (x1.z * x1.z + x1.w * x1.w)) * (1.0f / 512.0f);
        const float rstd = rsqrtf(var + EPS);
        f32x4 y0 = x0 * rstd * g0 + b0, y1 = x1 * rstd * g1 + b1;
        y0 = (f32x4){y0.x * sigm(y0.x), y0.y * sigm(y0.y), y0.z * sigm(y0.z), y0.w * sigm(y0.w)}; y1 = (f32x4){y1.x * sigm(y1.x), y1.y * sigm(y1.y), y1.z * sigm(y1.z), y1.w * sigm(y1.w)};
        v4u o; o.x = cvtpk(y0.x, y0.y); o.y = cvtpk(y0.z, y0.w); o.z = cvtpk(y1.x, y1.y); o.w = cvtpk(y1.z, y1.w);
        *(v4u*)(MIX + (size_t)(rowbase + t0 + tt) * D + 512 + 8 * lane) = o; }
    __syncthreads();
}
__device__ __forceinline__ void s5_scan(const Args& A, int gt) {
    if (gt >= NB * 64 * 2 * 64) return;
    const int p = gt & 63, d = (gt >> 6) & 1, g = (gt >> 7) & 63, b = gt >> 13;
    const int ix = (d * 64 + g) * 64 + p;
    const float ar = A.in[I_ARE][ix], ai = A.in[I_AIM][ix], dt = __expf(A.in[I_LOGDT][d * 64 + g]);
    const float zr = ar * dt, zi = ai * dt, mag = __expf(zr); float lr = mag * cosf(zi), li = mag * sinf(zi);
#pragma unroll
    for (int k = 0; k < 5; ++k) { const float nr = lr * lr - li * li, ni = 2.f * lr * li; lr = nr; li = ni; }
    const float* E = (const float*)(A.ws + WS_E) + (size_t)g * 768 * 256 + d * 128 + p;
    bf16* UC = (bf16*)(A.ws + WS_UC) + (size_t)g * 768 * 768 + 512 + d * 128 + p;
    float sr = 0.f, si = 0.f;
    for (int s0 = 0; s0 < 72; s0 += 24) {
        float er[24], ei[24]; int bcs[24];
#pragma unroll
        for (int k = 0; k < 24; ++k) { const int step = s0 + k; int bc;
            if (step < 8) bc = 512 + 8 * b + (d == 0 ? step : 7 - step); else bc = 64 * b + (d == 0 ? step - 8 : 71 - step);
            bcs[k] = bc; er[k] = E[(size_t)bc * 256]; ei[k] = E[(size_t)bc * 256 + 64]; }
#pragma unroll
        for (int k = 0; k < 24; ++k) {
            if (s0 + k >= 8) { UC[(size_t)bcs[k] * 768] = (bf16)f2bf(sr); UC[(size_t)bcs[k] * 768 + 64] = (bf16)f2bf(si); }
            const float nr = lr * sr - li * si + er[k], ni = lr * si + li * sr + ei[k]; sr = nr; si = ni; }
    }
}
__device__ __forceinline__ void moe_route(const Args& A, const bf16* X, const float* mod, bf16* H, int chunk, LAS unsigned* lcnt, int tid, int wave, int lane) {
    unsigned char* tok = A.ws + WS_TOK;
    int* tokE = (int*)(tok + TOK_E); float* tokW = (float*)(tok + TOK_W); int* tokRank = (int*)(tok + TOK_RANK); int* wgbase = (int*)(tok + TOK_WGBASE);
    if (tid < 8) lcnt[tid] = 0u;
    __syncthreads();
    const float* gain = A.in[I_N2G] + D; const float* wr = A.in[I_ROUTER];
    for (int q2 = 0; q2 < 8; q2 += 2) {
        f32x4 vv[2][4];
#pragma unroll
        for (int u = 0; u < 2; ++u) { const bf16* xr = X + (size_t)(chunk * 64 + wave * 8 + q2 + u) * D;
#pragma unroll
            for (int j = 0; j < 4; ++j) { const v2u xw = *(const v2u*)(xr + 4 * lane + 256 * j); vv[u][j] = (f32x4){bflo(xw.x), bfhi(xw.x), bflo(xw.y), bfhi(xw.y)}; } }
#pragma unroll
        for (int u = 0; u < 2; ++u) {
        const int row = chunk * 64 + wave * 8 + q2 + u; const float* mp = mod + (size_t)(row >> 11) * 6144;
        float ss = 0.f;
#pragma unroll
        for (int j = 0; j < 4; ++j) ss += (vv[u][j].x * vv[u][j].x + vv[u][j].y * vv[u][j].y) + (vv[u][j].z * vv[u][j].z + vv[u][j].w * vv[u][j].w);
        const float rstd = rsqrtf(wave_sum(ss) * (1.0f / D) + EPS);
        float lg[8];
#pragma unroll
        for (int e = 0; e < 8; ++e) lg[e] = 0.f;
#pragma unroll
        for (int j = 0; j < 4; ++j) { const int k = 4 * lane + 256 * j; const f32x4 gg = *(const f32x4*)(gain + k), sc = *(const f32x4*)(mp + 4 * 1024 + k), sh = *(const f32x4*)(mp + 3 * 1024 + k);
            const f32x4 h = vv[u][j] * rstd * gg * (sc + 1.0f) + sh;
            v2u o; o.x = cvtpk(h.x, h.y); o.y = cvtpk(h.z, h.w); *(v2u*)(H + (size_t)row * D + k) = o;
#pragma unroll
            for (int i = 0; i < 4; ++i) { const f32x4 w0 = *(const f32x4*)(wr + (size_t)(k + i) * 8), w1 = *(const f32x4*)(wr + (size_t)(k + i) * 8 + 4); const float hv = h[i];
                lg[0] += hv * w0.x; lg[1] += hv * w0.y; lg[2] += hv * w0.z; lg[3] += hv * w0.w; lg[4] += hv * w1.x; lg[5] += hv * w1.y; lg[6] += hv * w1.z; lg[7] += hv * w1.w; } }
#pragma unroll
        for (int e = 0; e < 8; ++e) lg[e] = wave_sum(lg[e]);
        int e0 = 0; float v0 = lg[0];
#pragma unroll
        for (int e = 1; e < 8; ++e) if (lg[e] > v0) { v0 = lg[e]; e0 = e; }
        int e1 = -1; float v1 = -3.0e38f;
#pragma unroll
        for (int e = 0; e < 8; ++e) if (e != e0 && lg[e] > v1) { v1 = lg[e]; e1 = e; }
        const float ex = __expf(v1 - v0), w0 = 1.0f / (1.0f + ex), w1 = ex * w0;
        if (lane == 0) { const unsigned r0 = __hip_atomic_fetch_add(&lcnt[e0], 1u, __ATOMIC_RELAXED, __HIP_MEMORY_SCOPE_WORKGROUP), r1 = __hip_atomic_fetch_add(&lcnt[e1], 1u, __ATOMIC_RELAXED, __HIP_MEMORY_SCOPE_WORKGROUP);
            tokE[2 * row] = e0; tokE[2 * row + 1] = e1; tokW[2 * row] = w0; tokW[2 * row + 1] = w1; tokRank[2 * row] = (int)r0; tokRank[2 * row + 1] = (int)r1; }
        }
    }
    __syncthreads();
    if (tid < 8) { const unsigned n = lcnt[tid]; const unsigned base = __hip_atomic_fetch_add((unsigned*)(A.ws + WS_CTL) + CW_GCNT + 64 * tid, n, RLX_AGENT); wgbase[chunk * 8 + tid] = (int)base; }
    __syncthreads();
}
constexpr int NPHASE = 17;
__device__ __forceinline__ void moe_offsets(const unsigned char* ws, int (&toff)[9]) {
    const unsigned* gc = (const unsigned*)(ws + WS_CTL) + CW_GCNT; int acc = 0;
#pragma unroll
    for (int e = 0; e < 8; ++e) { toff[e] = acc; const unsigned n = __hip_atomic_load(gc + 64 * e, RLX_AGENT); acc += (int)((n + 255u) >> 8); }
    toff[8] = acc;
}
#define TAIL_CONVERT(nunits, first, count) do { const int rounds_ = ((nunits) + G - 1) / G, nlast_ = (nunits) - (rounds_ - 1) * G; \
        if (bx >= nlast_) moe_convert(args, lds, (first), (count), (bx - nlast_) * NWAVES + wave, (G - nlast_) * NWAVES, wave, lane); } while (0)
constexpr unsigned CVC4 = 4000, CVC5 = 12000, CVC6 = 29500, CVC7 = 38000, CVC8 = 40000;
__global__ void __launch_bounds__(NWAVES * 64, 2) fwd_kernel(Args args) {
    extern __shared__ __attribute__((aligned(16))) unsigned char lds_raw[];
    LAS unsigned char* lds = (LAS unsigned char*)lds_raw;
    volatile LAS unsigned* MISC = (volatile LAS unsigned*)(lds + MISC_OFF);
    const int tid = threadIdx.x, lane = tid & 63, wave = __builtin_amdgcn_readfirstlane(tid >> 6);
    const int G = gridDim.x, bx = blockIdx.x;
    const int gw = bx * NWAVES + wave, NGW = G * NWAVES;
    unsigned char* ws = args.ws;
    for (int u = tid; u < (LDS_BYTES - LDSCTL_OFF) / 4; u += NWAVES * 64) ((LAS unsigned*)(lds + LDSCTL_OFF))[u] = 0u;
    __syncthreads();
    const int lo = args.ph_lo, hi = args.ph_hi;
    XcdBarrier bar; bar.bar = (unsigned*)(ws + WS_CTL) + CW_BAR; bar.x = 0; bar.st = nullptr;
    if (hi - lo > 1) bar = xcd_barrier_post((unsigned*)(ws + WS_CTL) + CW_BAR, MISC + 8);
#define IN(k) (lo <= (k) && (k) < hi)
#define SEAM(k) do { if (IN((k) + 1)) xcd_barrier(bar); } while (0)
    float* mod = (float*)(ws + WS_MOD);
    bf16* XL = (bf16*)(ws + WS_XL); bf16* XC = (bf16*)(ws + WS_XC);
    bf16* H = (bf16*)(ws + WS_H);

    if (IN(0)) {
        for (int u = bx; u < 192; u += G) { if (args.sub & 1) p0_adaln(args, u, lds, tid, wave, lane); }
        if (args.sub & 4) p0_convert(args, lds, gw, NGW, wave, lane);
        SEAM(0);
    }
    if (IN(1)) {
        { const float* modp = (const float*)(ws + WS_MODP);
          for (int i = bx * (NWAVES * 64) + tid; i < MOD_N; i += G * NWAVES * 64) mod[i] = ((modp[i] + modp[MOD_N + i]) + modp[2 * MOD_N + i]) + modp[3 * MOD_N + i]; }
        { const float* modp = (const float*)(ws + WS_MODP); LAS float* ms = (LAS float*)lds;
          for (int i = tid; i < 9 * 2048; i += NWAVES * 64) { const int r = i >> 11, o = r * 6144 + (i & 2047); ms[i] = ((modp[o] + modp[MOD_N + o]) + modp[2 * MOD_N + o]) + modp[3 * MOD_N + o]; }
          __syncthreads(); norm_rows_lds(args.in[I_X], args.in[I_CTX], MT, args.in[I_N1G], ms, H, gw, NGW, lane); }
        SEAM(1); }
    if (IN(2)) {
        pg8::Gemm g{H, (const bf16*)(ws + WS_WIN), MT, MIXIN, D, D, D}; pg8::StaticOrder S; S.init(MT, MIXIN, G, bx);
        pg8::EpiQKVU E{(bf16*)(ws + WS_QKVU), args.in[I_QG], args.in[I_KG], EPS};
        pg8::gemm_phase<pg8::EpiQKVU, pg8::StaticOrder, true, true>(lds + RING_OFF, g, S, E);
        SEAM(2);
    }
    if (IN(3)) {
        const bf16* QKVU = (const bf16*)(ws + WS_QKVU); bf16* MIX = (bf16*)(ws + WS_MIX);
        LAS float* rpbl = (LAS float*)(lds + 40960); LAS float* cv = (LAS float*)(lds + 57344);
        float mq = 0.f, mk = 0.f, mb = 0.f;
        mq = fabsf(args.in[I_QG][lane]); mk = fabsf(args.in[I_KG][lane]);
        for (int i = lane; i < 8 * 465; i += 64) mb = fmaxf(mb, fabsf(args.in[I_RPB][i]));
        const float bnd = (8.2f * wave_max(mq) * wave_max(mk) + wave_max(mb)) * 1.44269504f;
        for (int i = tid; i < 8 * 465; i += NWAVES * 64) rpbl[i] = args.in[I_RPB][i] * 1.44269504f - bnd;
        __syncthreads();
        const int nbw = (G % 8 == 0) ? G / 8 : G, xb0 = (G % 8 == 0) ? (bx & 7) : 0, xbn = (G % 8 == 0) ? xb0 + 1 : 8, j0 = (G % 8 == 0) ? (bx >> 3) : bx;
        for (int x = xb0; x < xbn; ++x)
            for (int k = j0; k < 128; k += nbw) {
                if (k < 36) {
                    if (!(args.sub & (k < 32 ? 8 : 16))) continue;
                    const int wu = k < 32 ? (x * 32 + k) * 8 + wave : 2048 + (x * 4 + (k - 32)) * 8 + wave;
                    attn_unit(QKVU, MIX, wu, lds + wave * 5120, lds + 57344 + wave * 8192, rpbl, bnd, lane);
                } else {
                    if (!(args.sub & 32)) continue;
                    const int ci = k < 64 ? k - 36 : (k < 96 ? k - 36 : (k >= 100 && k < 112 ? k - 40 : -1)); if (ci < 0) continue;
                    conv_item(args, QKVU, MIX, ci < 64 ? x * 64 + ci : 512 + x * 8 + (ci - 64), cv, tid, wave, lane);
                }
            }
        SEAM(3);
    }
    if (IN(4)) {
        pg8::Gemm g{(const bf16*)(ws + WS_MIX), (const bf16*)(ws + WS_WOUT), MT, D, D, D, D}; pg8::StaticOrder S; S.init(MT, D, G, bx);
        pg8::EpiResidN<true> E{args.in[I_X], args.in[I_CTX], XL, XC, mod + 2 * 1024, H, (float*)(ws + WS_ROWSS), args.in[I_N2G], mod + 4 * 1024};
        pg8::gemm_phase<pg8::EpiResidN<true>, pg8::StaticOrder, true, true>(lds + RING_OFF, g, S, E);
        {
            const int nun = (MT / 256) * (D / 256), rounds = (nun + G - 1) / G, nlast = nun - (rounds - 1) * G, nidle = G - nlast, ii = bx - nlast;
            if (ii >= 0) {
                if (args.sub & 2) for (int u = ii; u < 128; u += nidle) p0_s5gen(args, u >> 1, u & 1, lds, tid);
                const bool cvw = (nidle > 128) ? (ii >= 128) : true;
                const int cw = (nidle > 128) ? (ii - 128) * NWAVES + wave : ii * NWAVES + wave, cn = (nidle > 128) ? (nidle - 128) * NWAVES : nidle * NWAVES;
                if (cvw) {
                    shw_rows((const bf16*)(ws + WS_W13), 2 * FFN, mod + 3 * 1024, (float*)(ws + WS_SHW13), cw, cn, lds, tid, lane);
                    shw_rows((const bf16*)(ws + WS_SIN), D, mod + 9 * 6144, (float*)(ws + WS_SHWS), cw, cn, lds, tid, lane);
                    moe_convert_dyn(args, lds, CVC4, wave, lane); }
            }
            if (nidle <= 0) { for (int u = bx; u < 128; u += G) p0_s5gen(args, u >> 1, u & 1, lds, tid);
                shw_rows((const bf16*)(ws + WS_W13), 2 * FFN, mod + 3 * 1024, (float*)(ws + WS_SHW13), gw, NGW, lds, tid, lane); shw_rows((const bf16*)(ws + WS_SIN), D, mod + 9 * 6144, (float*)(ws + WS_SHWS), gw, NGW, lds, tid, lane);
                moe_convert_dyn(args, lds, CVC4, wave, lane); }
        }
        SEAM(4);
    }
    if (IN(5)) {
        pg8::Gemm g{H, (const bf16*)(ws + WS_W13), MT, 2 * FFN, D, D, D}; pg8::StaticOrder S; S.init(MT, 2 * FFN, G, bx);
        LAS float* rt = (LAS float*)(lds + RING_BYTES); pg8::rstd_prepass(S, (const float*)(ws + WS_ROWSS), rt, EPS, tid);
        pg8::EpiSwiGLUN E{(bf16*)(ws + WS_ACT), FFN, rt, (const float*)(ws + WS_SHW13), 2 * FFN};
        pg8::gemm_phase<pg8::EpiSwiGLUN, pg8::StaticOrder, true, true>(lds + RING_OFF, g, S, E);
        moe_convert_dyn(args, lds, CVC5, wave, lane);
        SEAM(5);
    }
    if (IN(6)) {
        pg8::Gemm g{(const bf16*)(ws + WS_ACT), (const bf16*)(ws + WS_W2), MT, D, FFN, FFN, FFN}; pg8::StaticOrder S; S.init(MT, D, G, bx);
        pg8::EpiResidN<false> E{XL, XC, XL, XC, mod + 5 * 1024, H, (float*)(ws + WS_ROWSS), args.in[I_N1G] + D, mod + 9 * 6144 + 1 * 1024};
        pg8::gemm_phase<pg8::EpiResidN<false>, pg8::StaticOrder, true, true>(lds + RING_OFF, g, S, E);
        moe_convert_dyn(args, lds, CVC6, wave, lane);
        SEAM(6);
    }
    float* mod1 = mod + 9 * 6144;
    if (IN(7)) {
        pg8::Gemm g{H, (const bf16*)(ws + WS_SIN), MT, D, D, D, D}; pg8::StaticOrder S; S.init(MT, D, G, bx);
        LAS float* rt = (LAS float*)(lds + RING_BYTES); pg8::rstd_prepass(S, (const float*)(ws + WS_ROWSS), rt, EPS, tid);
        pg8::EpiUC E{(bf16*)(ws + WS_UC), rt, (const float*)(ws + WS_SHWS)};
        pg8::gemm_phase<pg8::EpiUC, pg8::StaticOrder, true, true>(lds + RING_OFF, g, S, E);
        moe_convert_dyn(args, lds, CVC7, wave, lane);
        SEAM(7);
    }
    if (IN(8)) {
        pg8::Gemm g{(const bf16*)(ws + WS_UC), (const bf16*)(ws + WS_WEND), 64 * 768, 64 * 256, 512, 768, 512}; pg8::OrderS5E S{G, bx};
        pg8::EpiE E{(float*)(ws + WS_E)};
        pg8::gemm_phase<pg8::EpiE, pg8::OrderS5E, true, true>(lds + RING_OFF, g, S, E);
        moe_convert_dyn(args, lds, CVC8, wave, lane);
        SEAM(8);
    }
    if (IN(9)) { s5_scan(args, bx * (NWAVES * 64) + tid);
        moe_convert_dyn(args, lds, CV_NMOE, wave, lane);
        SEAM(9); }
    if (IN(10)) {
        pg8::Gemm g{(const bf16*)(ws + WS_UC), (const bf16*)(ws + WS_BTOUT), 64 * 768, 64 * 512, 768, 768, 768}; pg8::OrderS5Y S{G, bx};
        pg8::EpiY E{(bf16*)(ws + WS_Y)};
        pg8::gemm_phase<pg8::EpiY, pg8::OrderS5Y, true, true>(lds + RING_OFF, g, S, E);
        SEAM(10);
    }
    if (IN(11)) {
        pg8::Gemm g{(const bf16*)(ws + WS_Y), (const bf16*)(ws + WS_SOUT), ML, 2 * D, D, D, D}; pg8::StaticOrder S; S.init(ML, 2 * D, G, bx);
        pg8::EpiGLURes E{XL, mod1 + 2 * 1024};
        pg8::gemm_phase<pg8::EpiGLURes, pg8::StaticOrder, true, true>(lds + RING_OFF, g, S, E);
        SEAM(11);
    }
    unsigned char* tok = ws + WS_TOK;
    if (IN(12)) {
        int* rowsrc = (int*)(tok + TOK_ROWSRC); int* rowinfo = (int*)(tok + TOK_ROWINFO); float* rowgate = (float*)(tok + TOK_ROWGATE);
        for (int i = bx * (NWAVES * 64) + tid; i < MOE_TILES * 256; i += G * NWAVES * 64) { rowsrc[i] = 0; rowinfo[i] = -1; rowgate[i] = 0.f; }
        for (int ch = bx; ch < ML / 64; ch += G) moe_route(args, XL, mod1, H, ch, (LAS unsigned*)lds, tid, wave, lane);
        SEAM(12);
    }
    if (IN(13)) {
        int toff[9]; moe_offsets(ws, toff);
        const int* tokE = (const int*)(tok + TOK_E); const float* tokW = (const float*)(tok + TOK_W); const int* tokRank = (const int*)(tok + TOK_RANK); const int* wgbase = (const int*)(tok + TOK_WGBASE);
        int* rowsrc = (int*)(tok + TOK_ROWSRC); int* rowinfo = (int*)(tok + TOK_ROWINFO); float* rowgate = (float*)(tok + TOK_ROWGATE); int* tokPos = (int*)(tok + TOK_POS);
        for (int i = bx * (NWAVES * 64) + tid; i < 2 * ML; i += G * NWAVES * 64) { const int t = i >> 1, e = tokE[i]; int to = 0;
#pragma unroll
            for (int q = 0; q < 8; ++q) to = (e == q) ? toff[q] : to;
            const int pos = to * 256 + wgbase[(t >> 6) * 8 + e] + tokRank[i];
            rowsrc[pos] = t; rowinfo[pos] = i; rowgate[pos] = tokW[i]; tokPos[i] = pos; }
        SEAM(13);
    }
    if (IN(14)) {
        pg8::OrderMoE S; S.G = G; S.c = bx; S.nN = 2 * ED / 256; S.tmax = 1 << 30; S.fix = (args.sub >> 7) & 1; moe_offsets(ws, S.toff);
        pg8::Gemm g{H, (const bf16*)(ws + WS_MW13), MOE_TILES * 256, NE * 2 * ED, D, D, D, (const int*)(tok + TOK_ROWSRC)};
        pg8::EpiSwiGLU E{(bf16*)(ws + WS_ACTM), ED, 2 * ED / 256, 0, (args.sub >> 6) & 1};
        pg8::gemm_phase<pg8::EpiSwiGLU, pg8::OrderMoE, true, true, true>(lds + RING_OFF, g, S, E);
        SEAM(14);
    }
    if (IN(15)) {
        pg8::OrderMoE S; S.G = G; S.c = bx; S.nN = D / 256; S.tmax = 128; S.fix = 0; moe_offsets(ws, S.toff);
        pg8::Gemm g{(const bf16*)(ws + WS_ACTM), (const bf16*)(ws + WS_MW2), MOE_TILES * 256, NE * D, ED, ED, ED};
        pg8::EpiMoE2 E{(bf16*)args.out, (const float*)(tok + TOK_ROWGATE), (const int*)(tok + TOK_ROWINFO)};
        pg8::gemm_phase<pg8::EpiMoE2, pg8::OrderMoE, true, true>(lds + RING_OFF, g, S, E);
        pg8::OrderMoEx Sx; Sx.G = G; Sx.c = bx; moe_offsets(ws, Sx.toff);
        pg8::Gemm gx{(const bf16*)(ws + WS_ACTM), (const bf16*)(ws + WS_MW2), MOE_TILES * 256, NE * D, 896, ED, ED};
        pg8::EpiMoE2x Ex{(float*)(ws + WS_PX), (const float*)(tok + TOK_ROWGATE)};
        pg8::gemm_phase<pg8::EpiMoE2x, pg8::OrderMoEx, true, false>(lds + RING_OFF, gx, Sx, Ex);
        SEAM(15);
    }
    if (IN(16)) {
        const unsigned bad = __hip_atomic_load((unsigned*)(ws + WS_CTL) + CW_BAR + XB_TMO, RLX_AGENT);
        const int* tokPos = (const int*)(tok + TOK_POS); const float* PX = (const float*)(ws + WS_PX);
        for (int tb = gw; tb < ML; tb += 2 * NGW) {
            const int tt[2] = {tb, (tb + NGW < ML) ? tb + NGW : tb}; const int ntk = (tb + NGW < ML) ? 2 : 1;
            v2u a[2][4], b[2][4], xw[2][4]; f32x4 gv[2][4]; int p0[2], p1[2];
#pragma unroll
            for (int u = 0; u < 2; ++u) { const int t = tt[u]; const bf16* y0 = (const bf16*)(args.out + (size_t)t * D); const bf16* y1 = y0 + D; const float* gp = mod1 + (size_t)(t >> 11) * 6144 + 5 * 1024;
                p0[u] = tokPos[2 * t] - 128 * 256; p1[u] = tokPos[2 * t + 1] - 128 * 256;
#pragma unroll
                for (int j = 0; j < 4; ++j) { const int c = 4 * lane + 256 * j; a[u][j] = *(const v2u*)(y0 + c); b[u][j] = *(const v2u*)(y1 + c); xw[u][j] = *(const v2u*)(XL + (size_t)t * D + c); gv[u][j] = *(const f32x4*)(gp + c); } }
            asm volatile("s_waitcnt vmcnt(0)" ::: "memory");
#pragma unroll
            for (int u = 0; u < 2; ++u) { if (u < ntk) { const int t = tt[u];
#pragma unroll
                for (int j = 0; j < 4; ++j) { const int c = 4 * lane + 256 * j;
                    f32x4 ya = (f32x4){bflo(a[u][j].x), bfhi(a[u][j].x), bflo(a[u][j].y), bfhi(a[u][j].y)}, yb = (f32x4){bflo(b[u][j].x), bfhi(b[u][j].x), bflo(b[u][j].y), bfhi(b[u][j].y)};
                    if (p0[u] >= 0) { const float* q = PX + (size_t)p0[u] * D + c; ya = ((*(const f32x4*)q + *(const f32x4*)(q + (size_t)2048 * D)) + *(const f32x4*)(q + (size_t)4096 * D)) + *(const f32x4*)(q + (size_t)6144 * D); }
                    if (p1[u] >= 0) { const float* q = PX + (size_t)p1[u] * D + c; yb = ((*(const f32x4*)q + *(const f32x4*)(q + (size_t)2048 * D)) + *(const f32x4*)(q + (size_t)4096 * D)) + *(const f32x4*)(q + (size_t)6144 * D); }
                    const f32x4 xv = (f32x4){bflo(xw[u][j].x), bfhi(xw[u][j].x), bflo(xw[u][j].y), bfhi(xw[u][j].y)};
                    f32x4 o = xv + gv[u][j] * (ya + yb); if (bad) o = (f32x4){__builtin_nanf(""), __builtin_nanf(""), __builtin_nanf(""), __builtin_nanf("")};
                    *(f32x4*)(args.out + (size_t)t * D + c) = o; } } }
        }
    }
#undef IN
#undef SEAM
}

extern "C" void kernel_launch(void* const* d_in, const int* in_sizes, int n_in, void* d_out, int out_size, void* d_ws, size_t ws_size, hipStream_t stream) {
    static int grid = 0;
    if (grid == 0) {
        if (n_in != N_IN || out_size != ML * D || ws_size < WS_END) { fprintf(stderr, "kernel_launch: unexpected problem (n_in %d, out %d, ws %zu); nothing launched\n", n_in, out_size, ws_size); grid = -1; return; }
        int dev = 0, cus = 0, per_cu = 0;
        if (hipGetDevice(&dev) != hipSuccess || hipDeviceGetAttribute(&cus, hipDeviceAttributeMultiprocessorCount, dev) != hipSuccess) { grid = -1; return; }
        if (hipFuncSetAttribute((const void*)fwd_kernel, hipFuncAttributeMaxDynamicSharedMemorySize, LDS_BYTES) != hipSuccess) { fprintf(stderr, "kernel_launch: hipFuncSetAttribute failed\n"); grid = -1; return; }
        if (hipOccupancyMaxActiveBlocksPerMultiprocessor(&per_cu, (const void*)fwd_kernel, NWAVES * 64, LDS_BYTES) != hipSuccess || per_cu < 1) { fprintf(stderr, "kernel_launch: occupancy query says %d blocks per CU\n", per_cu); (void)hipGetLastError(); grid = -1; return; }
        grid = cus;
    }
    if (grid < 0) return;
    if (hipMemsetAsync((char*)d_ws + WS_CTL, 0, CTL_ZERO_BYTES, stream) != hipSuccess) return;
    Args a{};
    for (int i = 0; i < N_IN; ++i) a.in[i] = (const float*)d_in[i];
    a.out = (float*)d_out; a.ws = (unsigned char*)d_ws; a.sub = 63;
#if MK_N_LAUNCHES == 1
    a.ph_lo = 0; a.ph_hi = NPHASE;
    hipLaunchKernelGGL(fwd_kernel, dim3(grid), dim3(NWAVES * 64), LDS_BYTES, stream, a);
#else
    for (int p = 0; p < NPHASE; ++p) { const int nrep = ((MK_REPEAT_MASK >> p) & 1u) ? 2 : 1;
        for (int r = 0; r < nrep; ++r) { a.ph_lo = p; a.ph_hi = p + 1; a.sub = (r == 0) ? 63 : MK_REPEAT_SUB; hipLaunchKernelGGL(fwd_kernel, dim3(grid), dim3(NWAVES * 64), LDS_BYTES, stream, a); } }
#endif
}
```

```cpp
#include <hip/hip_runtime.h>
#include <cstdio>
#include <cstdint>
#ifndef MK_N_LAUNCHES
#define MK_N_LAUNCHES 1
#endif
#ifndef MK_REPEAT_SUB
#define MK_REPEAT_SUB 63
#endif
#ifndef MK_REPEAT_MASK
#define MK_REPEAT_MASK 0u
#endif
namespace pg8 {
#define PG8_LAS __attribute__((address_space(3)))
typedef unsigned short bf16_t;
typedef short bf16x8 __attribute__((ext_vector_type(8)));
typedef float f32x4 __attribute__((ext_vector_type(4)));
typedef unsigned u32x4 __attribute__((ext_vector_type(4)));
typedef unsigned u32x2 __attribute__((ext_vector_type(2)));
constexpr int BM = 256, BK = 64, HALF = 128, HTB = HALF * BK * 2  , STAGE_BYTES = 8 * HTB, NXCD = 8, WGM = 8;

__host__ __device__ __forceinline__ int lds_byte(int r, int c) { const int st = (r >> 4) * 2 + (c >> 5), rr = r & 15, cc = c & 31, ob = rr * 64 + cc * 2; return st * 1024 + (ob ^ (((ob >> 9) & 1) << 5)); }
__host__ __device__ __forceinline__ void stage_rc(int b, int& R, int& C) { const int st = b / 1024, sb = b % 1024, swz = sb ^ (((sb >> 9) & 1) << 5); R = (st >> 1) * 16 + swz / 64; C = (st & 1) * 32 + (swz % 64) / 2; }
__host__ __device__ __forceinline__ int perm32(int rho) { const int n = rho >> 4, i = rho & 15; return 8 * (i >> 2) + 4 * n + (i & 3); }

struct Unit { int pm, pn, k0, idx; };
struct Gemm { const bf16_t* A; const bf16_t* Bt; int M, N, K, lda, ldb; const int* rowsrc; };

struct StaticOrder {
    int nM, nN, nwg, G, c;
    __host__ __device__ void init(int M, int N, int G_, int c_) { nM = M / BM; nN = N / BM; nwg = nM * nN; G = G_; c = c_; }
    __host__ __device__ bool next(int i, Unit& u) const {
        const long L = (long)i * G + c; if (L >= nwg) return false;
        int wgid = (int)L; { const int q = nwg / NXCD, r = nwg % NXCD, xcd = wgid % NXCD, off = wgid / NXCD; wgid = (xcd < r ? xcd * (q + 1) : r * (q + 1) + (xcd - r) * q) + off; }
        const int nig = WGM * nN, gid = wgid / nig, fm = gid * WGM, gsz = (nM - fm) < WGM ? (nM - fm) : WGM;
        u.pm = fm + ((wgid % nig) % gsz); u.pn = (wgid % nig) / gsz; u.k0 = 0; u.idx = i; return true;
    }
    __device__ __forceinline__ void a_ready(const Unit&) const {}
    __device__ __forceinline__ void done(const Unit&) const {}
};

constexpr int ML_ = 16384, MC_ = 2048, MT_ = ML_ + MC_, DM_ = 1024;
__device__ __forceinline__ unsigned cvt_pk_bf16(float lo, float hi) { unsigned r; asm volatile("v_cvt_pk_bf16_f32 %0, %1, %2" : "=v"(r) : "v"(lo), "v"(hi)); return r; }
__device__ __forceinline__ float sigm(float x) { return __builtin_amdgcn_rcpf(1.0f + __expf(-x)); }
__device__ __forceinline__ float gelu_tanh(float x) { const float u = 1.5957691216f * (x + 0.044715f * x * x * x); return x * sigm(u); }
__device__ __forceinline__ u32x4 pack8(const f32x4 a, const f32x4 b) { u32x4 w; w.x = cvt_pk_bf16(a[0], a[1]); w.y = cvt_pk_bf16(a[2], a[3]); w.z = cvt_pk_bf16(b[0], b[1]); w.w = cvt_pk_bf16(b[2], b[3]); return w; }


struct EpiQKVU {
    static constexpr bool PERM = true, AFTER_DRAIN = false;
    bf16_t* O; const float* gq; const float* gk; float eps;
    __device__ __forceinline__ void operator()(const f32x4 (&acc)[2][2][4][2], const Unit& u, int wr, int wc, int fr, int fq) const {
        const int row0 = u.pm * BM + wr * 64 + fr; const int pn = u.pn;
        if (pn < 6) {
            const bool nrm = pn < 4; const float* gp = (pn < 2) ? gq : gk;
            f32x4 gn[2][2];
#pragma unroll
            for (int bj = 0; bj < 2; ++bj)
#pragma unroll
                for (int n = 0; n < 2; ++n) gn[bj][n] = nrm ? *(const f32x4*)(gp + 32 * bj + 8 * fq + 4 * n) : (f32x4){1.f, 1.f, 1.f, 1.f};
#pragma unroll
            for (int ai = 0; ai < 2; ++ai)
#pragma unroll
                for (int m = 0; m < 4; ++m) {
                    float sc = 1.f;
                    if (nrm) { float ss = 0.f;
#pragma unroll
                        for (int bj = 0; bj < 2; ++bj)
#pragma unroll
                            for (int n = 0; n < 2; ++n) { const f32x4 x = acc[ai][bj][m][n]; ss += (x[0] * x[0] + x[1] * x[1]) + (x[2] * x[2] + x[3] * x[3]); }
                        ss += __shfl_xor(ss, 16); ss += __shfl_xor(ss, 32);
                        sc = rsqrtf(ss * (1.0f / 64.0f) + eps); }
                    bf16_t* rowp = O + (size_t)(row0 + ai * HALF + m * 16) * 2048 + 256 * pn + 64 * wc + 8 * fq;
#pragma unroll
                    for (int bj = 0; bj < 2; ++bj) { const f32x4 v0 = acc[ai][bj][m][0] * gn[bj][0] * sc, v1 = acc[ai][bj][m][1] * gn[bj][1] * sc; *(u32x4*)(rowp + 32 * bj) = pack8(v0, v1); }
                }
        } else {
            const int cb = 1536 + 128 * (pn - 6) + 32 * wc + 8 * fq;
#pragma unroll
            for (int ai = 0; ai < 2; ++ai)
#pragma unroll
                for (int m = 0; m < 4; ++m) {
                    f32x4 v[2];
#pragma unroll
                    for (int n = 0; n < 2; ++n) { const f32x4 a = acc[ai][0][m][n], g = acc[ai][1][m][n]; v[n] = (f32x4){a[0] * sigm(g[0]), a[1] * sigm(g[1]), a[2] * sigm(g[2]), a[3] * sigm(g[3])}; }
                    *(u32x4*)(O + (size_t)(row0 + ai * HALF + m * 16) * 2048 + cb) = pack8(v[0], v[1]);
                }
        }
    }
};
struct EpiResid {
    static constexpr bool PERM = false, AFTER_DRAIN = false;
    const float* baseL; const float* baseC; float* XL; float* XC; const float* gate;
    __device__ __forceinline__ void operator()(const f32x4 (&acc)[2][2][4][2], const Unit& u, int wr, int wc, int fr, int fq) const {
        const int R0 = u.pm * BM, row0 = R0 + wr * 64 + fr, col0 = u.pn * BM + wc * 32 + 4 * fq;
        const int modrow = R0 < ML_ ? (R0 >> 11) : 8;
        const float* gp = gate + (size_t)modrow * 6144 + col0;
        const float* bp = R0 < ML_ ? baseL : baseC - (size_t)ML_ * DM_;
        float* xo = R0 < ML_ ? XL : XC - (size_t)ML_ * DM_;
        f32x4 gv[2][2];
#pragma unroll
        for (int bj = 0; bj < 2; ++bj)
#pragma unroll
            for (int n = 0; n < 2; ++n) gv[bj][n] = *(const f32x4*)(gp + bj * HALF + n * 16);
#pragma unroll
        for (int ai = 0; ai < 2; ++ai)
#pragma unroll
            for (int m = 0; m < 4; ++m) { const size_t ro = (size_t)(row0 + ai * HALF + m * 16) * DM_ + col0;
#pragma unroll
                for (int bj = 0; bj < 2; ++bj)
#pragma unroll
                    for (int n = 0; n < 2; ++n) { const f32x4 xv = *(const f32x4*)(bp + ro + bj * HALF + n * 16); *(f32x4*)(xo + ro + bj * HALF + n * 16) = xv + gv[bj][n] * acc[ai][bj][m][n]; } }
    }
};
__device__ __forceinline__ void unpack8(const u32x4 w, f32x4& a, f32x4& b) {
    a = (f32x4){__builtin_bit_cast(float, w.x << 16), __builtin_bit_cast(float, w.x & 0xffff0000u), __builtin_bit_cast(float, w.y << 16), __builtin_bit_cast(float, w.y & 0xffff0000u)};
    b = (f32x4){__builtin_bit_cast(float, w.z << 16), __builtin_bit_cast(float, w.z & 0xffff0000u), __builtin_bit_cast(float, w.w << 16), __builtin_bit_cast(float, w.w & 0xffff0000u)}; }
template <bool BASE_F32> struct EpiResidN {
    static constexpr bool PERM = true, AFTER_DRAIN = false;
    const void* baseL; const void* baseC; bf16_t* XL; bf16_t* XC; const float* gate; bf16_t* Hn; float* rowss; const float* ngain; const float* nscale;
    __device__ __forceinline__ void operator()(const f32x4 (&acc)[2][2][4][2], const Unit& u, int wr, int wc, int fr, int fq) const {
        const int R0 = u.pm * BM, row0 = R0 + wr * 64 + fr, col0 = u.pn * BM + wc * 32 + 8 * fq;
        const int modrow = R0 < ML_ ? (R0 >> 11) : 8, rsub = R0 < ML_ ? 0 : ML_;
        const float* gp = gate + (size_t)modrow * 6144 + col0; const float* sp = nscale + (size_t)modrow * 6144 + col0;
        const void* bp = R0 < ML_ ? baseL : baseC; bf16_t* xo = R0 < ML_ ? XL : XC;
        f32x4 gv[2][2], gs[2][2];
#pragma unroll
        for (int bj = 0; bj < 2; ++bj)
#pragma unroll
            for (int n = 0; n < 2; ++n) { gv[bj][n] = *(const f32x4*)(gp + bj * HALF + n * 4); gs[bj][n] = *(const f32x4*)(ngain + col0 + bj * HALF + n * 4) * (*(const f32x4*)(sp + bj * HALF + n * 4) + 1.0f); }
#pragma unroll
        for (int ai = 0; ai < 2; ++ai)
#pragma unroll
            for (int m = 0; m < 4; ++m) { const int row = row0 + ai * HALF + m * 16; const size_t ro = (size_t)(row - rsub) * DM_ + col0; float ss = 0.f;
#pragma unroll
                for (int bj = 0; bj < 2; ++bj) { f32x4 x0, x1;
                    if constexpr (BASE_F32) { x0 = *(const f32x4*)((const float*)bp + ro + bj * HALF); x1 = *(const f32x4*)((const float*)bp + ro + bj * HALF + 4); }
                    else unpack8(*(const u32x4*)((const bf16_t*)bp + ro + bj * HALF), x0, x1);
                    const u32x4 xw = pack8(x0 + gv[bj][0] * acc[ai][bj][m][0], x1 + gv[bj][1] * acc[ai][bj][m][1]); *(u32x4*)(xo + ro + bj * HALF) = xw;
                    f32x4 r0, r1; unpack8(xw, r0, r1);
                    ss += ((r0[0] * r0[0] + r0[1] * r0[1]) + (r0[2] * r0[2] + r0[3] * r0[3])) + ((r1[0] * r1[0] + r1[1] * r1[1]) + (r1[2] * r1[2] + r1[3] * r1[3]));
                    *(u32x4*)(Hn + (size_t)row * DM_ + col0 + bj * HALF) = pack8(r0 * gs[bj][0], r1 * gs[bj][1]); }
                ss += __shfl_xor(ss, 16); ss += __shfl_xor(ss, 32);
                if (fq == 0) rowss[(size_t)row * 16 + u.pn * 4 + wc] = ss; }
    }
};
__device__ __forceinline__ float row_rstd(const float* rowss, int row, float eps) {
    const f32x4* p = (const f32x4*)(rowss + (size_t)row * 16); const f32x4 a = p[0], b = p[1], c = p[2], d = p[3];
    const float s = (((a[0] + a[1]) + (a[2] + a[3])) + ((b[0] + b[1]) + (b[2] + b[3]))) + (((c[0] + c[1]) + (c[2] + c[3])) + ((d[0] + d[1]) + (d[2] + d[3])));
    return rsqrtf(s * (1.0f / 1024.0f) + eps); }
template <class Sched> __device__ __forceinline__ void rstd_prepass(const Sched& S, const float* rowss, PG8_LAS float* rt, float eps, int tid) {
    Unit u; int n = 0; while (n < 8 && S.next(n, u)) ++n;
#pragma unroll
    for (int q = 0; q < 4; ++q) { const int r = tid + 512 * q, i = r >> 8;
        if (i < n) { S.next(i, u); rt[r] = row_rstd(rowss, u.pm * BM + (r & 255), eps); } }
    __syncthreads();
}
struct EpiSwiGLUN {
    static constexpr bool PERM = true, AFTER_DRAIN = false;
    bf16_t* O; int ldo; const PG8_LAS float* rt; const float* shw; int nphys;
    __device__ __forceinline__ void operator()(const f32x4 (&acc)[2][2][4][2], const Unit& u, int wr, int wc, int fr, int fq) const {
        const int R0 = u.pm * BM, row0 = R0 + wr * 64 + fr, colp = u.pn * BM + wc * 32 + 8 * fq, col0 = u.pn * HALF + wc * 32 + 8 * fq;
        const float* sp = shw + (size_t)(R0 < ML_ ? (R0 >> 11) : 8) * nphys + colp;
        f32x4 s1[2], s3[2];
#pragma unroll
        for (int n = 0; n < 2; ++n) { s1[n] = *(const f32x4*)(sp + 4 * n); s3[n] = *(const f32x4*)(sp + HALF + 4 * n); }
#pragma unroll
        for (int ai = 0; ai < 2; ++ai)
#pragma unroll
            for (int m = 0; m < 4; ++m) { const int row = row0 + ai * HALF + m * 16; const float rs = rt[u.idx * BM + (row - R0)];
                f32x4 v[2];
#pragma unroll
                for (int n = 0; n < 2; ++n) { const f32x4 a = acc[ai][0][m][n] * rs + s1[n], b = acc[ai][1][m][n] * rs + s3[n]; v[n] = (f32x4){a[0] * sigm(a[0]) * b[0], a[1] * sigm(a[1]) * b[1], a[2] * sigm(a[2]) * b[2], a[3] * sigm(a[3]) * b[3]}; }
                *(u32x4*)(O + (size_t)row * ldo + col0) = pack8(v[0], v[1]);
            }
    }
};
struct EpiSwiGLU {
    static constexpr bool PERM = true, AFTER_DRAIN = false;
    bf16_t* O; int ldo, nN, row_sub; int skip;
    __device__ __forceinline__ void operator()(const f32x4 (&acc)[2][2][4][2], const Unit& u, int wr, int wc, int fr, int fq) const {
        if (skip) {
#pragma unroll
            for (int ai = 0; ai < 2; ++ai)
#pragma unroll
                for (int bj = 0; bj < 2; ++bj)
#pragma unroll
                    for (int m = 0; m < 4; ++m)
#pragma unroll
                        for (int n = 0; n < 2; ++n) asm volatile("" :: "v"(acc[ai][bj][m][n]));
            return; }
        const int row0 = u.pm * BM + wr * 64 + fr - row_sub, col0 = (u.pn % nN) * HALF + wc * 32 + 8 * fq;
#pragma unroll
        for (int ai = 0; ai < 2; ++ai)
#pragma unroll
            for (int m = 0; m < 4; ++m) {
                f32x4 v[2];
#pragma unroll
                for (int n = 0; n < 2; ++n) { const f32x4 a = acc[ai][0][m][n], b = acc[ai][1][m][n]; v[n] = (f32x4){a[0] * sigm(a[0]) * b[0], a[1] * sigm(a[1]) * b[1], a[2] * sigm(a[2]) * b[2], a[3] * sigm(a[3]) * b[3]}; }
                *(u32x4*)(O + (size_t)(row0 + ai * HALF + m * 16) * ldo + col0) = pack8(v[0], v[1]);
            }
    }
};
struct EpiGLURes {
    static constexpr bool PERM = true, AFTER_DRAIN = false;
    bf16_t* X; const float* gate;
    __device__ __forceinline__ void operator()(const f32x4 (&acc)[2][2][4][2], const Unit& u, int wr, int wc, int fr, int fq) const {
        const int R0 = u.pm * BM, row0 = R0 + wr * 64 + fr, col0 = u.pn * HALF + wc * 32 + 8 * fq;
        const float* gp = gate + (size_t)(R0 >> 11) * 6144 + col0;
        f32x4 gv[2];
#pragma unroll
        for (int n = 0; n < 2; ++n) gv[n] = *(const f32x4*)(gp + n * 4);
#pragma unroll
        for (int ai = 0; ai < 2; ++ai)
#pragma unroll
            for (int m = 0; m < 4; ++m) { bf16_t* xp = X + (size_t)(row0 + ai * HALF + m * 16) * DM_ + col0; f32x4 x0, x1, y[2];
                unpack8(*(const u32x4*)xp, x0, x1);
#pragma unroll
                for (int n = 0; n < 2; ++n) { const f32x4 z1 = acc[ai][0][m][n], z2 = acc[ai][1][m][n]; y[n] = (f32x4){z1[0] * sigm(z2[0]), z1[1] * sigm(z2[1]), z1[2] * sigm(z2[2]), z1[3] * sigm(z2[3])}; }
                *(u32x4*)xp = pack8(x0 + gv[0] * y[0], x1 + gv[1] * y[1]); }
    }
};
struct EpiUC {
    static constexpr bool PERM = true, AFTER_DRAIN = false;
    bf16_t* UC; const PG8_LAS float* rt; const float* shw;
    __device__ __forceinline__ void operator()(const f32x4 (&acc)[2][2][4][2], const Unit& u, int wr, int wc, int fr, int fq) const {
        const int R0 = u.pm * BM, row0 = R0 + wr * 64 + fr, col0 = u.pn * BM + wc * 32 + 8 * fq;
        const float* sp = shw + (size_t)(R0 < ML_ ? (R0 >> 11) : 8) * DM_ + col0;
        f32x4 sv[2][2];
#pragma unroll
        for (int bj = 0; bj < 2; ++bj)
#pragma unroll
            for (int n = 0; n < 2; ++n) sv[bj][n] = *(const f32x4*)(sp + bj * HALF + 4 * n);
#pragma unroll
        for (int ai = 0; ai < 2; ++ai)
#pragma unroll
            for (int m = 0; m < 4; ++m) { const int row = row0 + ai * HALF + m * 16; int bc, j; const float rs = rt[u.idx * BM + (row - R0)];
                if (row < ML_) { bc = (row >> 11) * 64 + ((row & 2047) >> 5); j = row & 31; } else { const int r2 = row - ML_; bc = 512 + (r2 >> 8) * 8 + ((r2 & 255) >> 5); j = r2 & 31; }
#pragma unroll
                for (int bj = 0; bj < 2; ++bj) { const int col = col0 + bj * HALF, g = col >> 4, qi = col & 15;
                    *(u32x4*)(UC + ((size_t)(g * 768 + bc) * 768 + j * 16 + qi)) = pack8(acc[ai][bj][m][0] * rs + sv[bj][0], acc[ai][bj][m][1] * rs + sv[bj][1]); } }
    }
};
struct EpiE {
    static constexpr bool PERM = false, AFTER_DRAIN = false;
    float* E;
    __device__ __forceinline__ void operator()(const f32x4 (&acc)[2][2][4][2], const Unit& u, int wr, int wc, int fr, int fq) const {
        const int row0 = u.pm * BM + wr * 64 + fr, col0 = wc * 32 + 4 * fq;
#pragma unroll
        for (int ai = 0; ai < 2; ++ai)
#pragma unroll
            for (int m = 0; m < 4; ++m) { float* rp = E + (size_t)(row0 + ai * HALF + m * 16) * 256 + col0;
#pragma unroll
                for (int bj = 0; bj < 2; ++bj)
#pragma unroll
                    for (int n = 0; n < 2; ++n) *(f32x4*)(rp + bj * HALF + n * 16) = acc[ai][bj][m][n]; }
    }
};
struct EpiY {
    static constexpr bool PERM = true, AFTER_DRAIN = false;
    bf16_t* Y;
    __device__ __forceinline__ void operator()(const f32x4 (&acc)[2][2][4][2], const Unit& u, int wr, int wc, int fr, int fq) const {
        const int g = u.pm / 3, pml = u.pm - 3 * g, pnl = u.pn & 1;
        const int bc0 = pml * BM + wr * 64 + fr, n0 = pnl * BM + wc * 32 + 8 * fq;
#pragma unroll
        for (int ai = 0; ai < 2; ++ai)
#pragma unroll
            for (int m = 0; m < 4; ++m) { const int bc = bc0 + ai * HALF + m * 16, tok0 = (bc >> 6) * 2048 + (bc & 63) * 32;
#pragma unroll
                for (int bj = 0; bj < 2; ++bj) { const int n = n0 + bj * HALF, tin = n >> 4, qo = n & 15; const f32x4 a = acc[ai][bj][m][0], b = acc[ai][bj][m][1];
                    const f32x4 ya = (f32x4){gelu_tanh(a[0]), gelu_tanh(a[1]), gelu_tanh(a[2]), gelu_tanh(a[3])}, yb = (f32x4){gelu_tanh(b[0]), gelu_tanh(b[1]), gelu_tanh(b[2]), gelu_tanh(b[3])};
                    *(u32x4*)(Y + (size_t)(tok0 + tin) * DM_ + g * 16 + qo) = pack8(ya, yb); } }
    }
};
struct EpiMoE2 {
    static constexpr bool PERM = true, AFTER_DRAIN = false;
    bf16_t* Y2; const float* rowgate; const int* rowinfo;
    __device__ __forceinline__ void operator()(const f32x4 (&acc)[2][2][4][2], const Unit& u, int wr, int wc, int fr, int fq) const {
        const int row0 = u.pm * BM + wr * 64 + fr, col0 = (u.pn & 3) * BM + wc * 32 + 8 * fq;
#pragma unroll
        for (int ai = 0; ai < 2; ++ai)
#pragma unroll
            for (int m = 0; m < 4; ++m) { const int row = row0 + ai * HALF + m * 16; const float gt = rowgate[row]; const int ri = rowinfo[row];
                if (ri >= 0) {
#pragma unroll
                    for (int bj = 0; bj < 2; ++bj) *(u32x4*)(Y2 + (size_t)ri * DM_ + col0 + bj * HALF) = pack8(acc[ai][bj][m][0] * gt, acc[ai][bj][m][1] * gt); } }
    }
};
struct OrderS5E { int G, c;
    __device__ __forceinline__ bool next(int i, Unit& u) const {
        if (G == 256) { if (i > 0) return false; const int x = c & 7, j = c >> 3; if (j >= 24) return false; const int g = 8 * (j / 3) + x; u.pm = 3 * g + (j % 3); u.pn = g; u.k0 = 0; u.idx = i; return true; }
        const int L = i * G + c; if (L >= 192) return false; u.pm = L; u.pn = L / 3; u.k0 = 0; u.idx = i; return true; }
    __device__ __forceinline__ void a_ready(const Unit&) const {}
    __device__ __forceinline__ void done(const Unit&) const {} };
struct OrderS5Y { int G, c;
    __device__ __forceinline__ bool next(int i, Unit& u) const {
        if (G == 256) { if (i > 0) return false; const int x = c & 7, j = c >> 3, g = 8 * (j >> 2) + x; u.pm = 3 * g + ((j >> 1) & 1); u.pn = 2 * g + (j & 1); u.k0 = 0; u.idx = i; return true; }
        const int L = i * G + c; if (L >= 256) return false; const int g = L >> 2; u.pm = 3 * g + ((L >> 1) & 1); u.pn = 2 * g + (L & 1); u.k0 = 0; u.idx = i; return true; }
    __device__ __forceinline__ void a_ready(const Unit&) const {}
    __device__ __forceinline__ void done(const Unit&) const {} };
struct OrderMoE { int G, c, nN, tmax, fix; int toff[9];
    __device__ __forceinline__ bool next(int i, Unit& u) const {
        int pm, pnl; const int nt = toff[8] < tmax ? toff[8] : tmax;
        if (G == 256) {
            const int x = c & 7, j = c >> 3, nCB = nN >> 2, b = i * 8 + x, nRB = (nt + 7) >> 3; if (b >= nRB * nCB) return false;
            const int rb = b / nCB, cbk = b - rb * nCB; pm = 8 * rb + (j & 7); pnl = 4 * cbk + (j >> 3);
        } else { const int L = i * G + c; pm = L / nN; pnl = L - pm * nN; }
        if (pm >= nt) return false;
        int e = 0;
#pragma unroll
        for (int k = 1; k < 8; ++k) e += (pm >= toff[k]) ? 1 : 0;
        u.pm = fix ? 0 : pm; u.pn = fix ? pnl & 3 : e * nN + pnl; u.k0 = 0; u.idx = i; return true; }
    __device__ __forceinline__ void a_ready(const Unit&) const {}
    __device__ __forceinline__ void done(const Unit&) const {} };
struct OrderMoEx { int G, c; int toff[9];
    __device__ __forceinline__ bool next(int i, Unit& u) const {
        const int s = i * G + c, tl = s >> 4, pm = 128 + tl; if (pm >= toff[8]) return false;
        int e = 0;
#pragma unroll
        for (int k = 1; k < 8; ++k) e += (pm >= toff[k]) ? 1 : 0;
        u.pm = pm; u.pn = e * 4 + ((s >> 2) & 3); u.k0 = (s & 3) * 896; u.idx = i; return true; }
    __device__ __forceinline__ void a_ready(const Unit&) const {}
    __device__ __forceinline__ void done(const Unit&) const {} };
struct EpiMoE2x {
    static constexpr bool PERM = false, AFTER_DRAIN = false;
    float* P; const float* rowgate;
    __device__ __forceinline__ void operator()(const f32x4 (&acc)[2][2][4][2], const Unit& u, int wr, int wc, int fr, int fq) const {
        const int ks = u.k0 / 896, tl = u.pm - 128, r0 = wr * 64 + fr, col0 = (u.pn & 3) * BM + wc * 32 + 4 * fq;
        float* pb = P + ((size_t)(ks * 8 + tl) * 256) * DM_;
        const __amdgpu_buffer_rsrc_t grs = __builtin_amdgcn_make_buffer_rsrc((void*)rowgate, 0, 136 * 256 * 4, 0x00020000);
#pragma unroll
        for (int ai = 0; ai < 2; ++ai)
#pragma unroll
            for (int m = 0; m < 4; ++m) { const int r = r0 + ai * HALF + m * 16; const float gt = __builtin_bit_cast(float, __builtin_amdgcn_raw_buffer_load_b32(grs, (u.pm * BM + r) * 4, 0, 0));
#pragma unroll
                for (int bj = 0; bj < 2; ++bj)
#pragma unroll
                    for (int n = 0; n < 2; ++n) *(f32x4*)(pb + (size_t)r * DM_ + col0 + bj * HALF + n * 16) = acc[ai][bj][m][n] * gt; }
    }
};
template <class Epi, class Sched, bool ALIGN_EPI = false, bool SP2 = false, bool GATHER = false>
__device__ __forceinline__ void gemm_phase(PG8_LAS unsigned char* lds, const Gemm g, const Sched& S, const Epi& E) {
    const int tid = threadIdx.x, wid = __builtin_amdgcn_readfirstlane(tid >> 6), lane = tid & 63, wr = wid >> 2, wc = wid & 3, fr = lane & 15, fq = lane >> 4;
    const int K = g.K, nt = K / BK;
    unsigned voffA[2], voffB[2]; int RA[2]; unsigned CA[2];
    static_assert(!GATHER || SP2, "the gathered A operand is wired into the SP2 loop only");
#pragma unroll
    for (int i = 0; i < 2; ++i) { int R, C; stage_rc(tid * 16 + i * 8192, R, C); const int Rb = Epi::PERM ? ((R & ~31) + perm32(R & 31)) : R;
        voffA[i] = (unsigned)(R * g.lda + C) * 2u; voffB[i] = (unsigned)(Rb * g.ldb + C) * 2u; RA[i] = R; CA[i] = (unsigned)C * 2u; }
    const size_t kstep = (size_t)(BK * 2);
    const size_t hstepA = (size_t)HALF * g.lda * 2, hstepB = (size_t)HALF * g.ldb * 2;
    const size_t tstepA = 2 * hstepA, tstepB = 2 * hstepB;
    const unsigned ldsw = (unsigned)wid * 1024u;
    const int aoff = lds_byte(wr * 64 + fr, fq * 8), boff = lds_byte(wc * 32 + fr, fq * 8);
#define PG8_SA(b, h) (((b) * 2 + (h)) * HTB)
#define PG8_SB(b, h) ((4 + (b) * 2 + (h)) * HTB)
#define PG8_STAGE(bufoff, gbase, voff) do { _Pragma("unroll") for (int _i = 0; _i < 2; ++_i) \
        __builtin_amdgcn_global_load_lds((const unsigned*)((const char*)(gbase) + (voff)[_i]), (PG8_LAS unsigned*)(lds + (bufoff) + ldsw + _i * 8192), 16, 0, 0); } while (0)
#define PG8_LDA(dst, b, h) do { _Pragma("unroll") for (int m = 0; m < 4; ++m) _Pragma("unroll") for (int k = 0; k < 2; ++k) dst[m][k] = *(const PG8_LAS bf16x8*)(lds + PG8_SA(b, h) + aoff + m * 2048 + k * 1024); } while (0)
#define PG8_LDB(dst, b, h) do { _Pragma("unroll") for (int n = 0; n < 2; ++n) _Pragma("unroll") for (int k = 0; k < 2; ++k) dst[n][k] = *(const PG8_LAS bf16x8*)(lds + PG8_SB(b, h) + boff + n * 2048 + k * 1024); } while (0)
#define PG8_MMA(ai, bj, At, Bt) do { __builtin_amdgcn_s_setprio(1); _Pragma("unroll") for (int m = 0; m < 4; ++m) _Pragma("unroll") for (int n = 0; n < 2; ++n) _Pragma("unroll") for (int k = 0; k < 2; ++k) \
        acc[ai][bj][m][n] = __builtin_amdgcn_mfma_f32_16x16x32_bf16(Bt[n][k], At[m][k], acc[ai][bj][m][n], 0, 0, 0); __builtin_amdgcn_s_setprio(0); } while (0)
#define PG8_WAIT_V(n) asm volatile("s_waitcnt vmcnt(" #n ")" ::: "memory")
#define PG8_WAIT_L(n) asm volatile("s_waitcnt lgkmcnt(" #n ")" ::: "memory")
#define PG8_BAR __builtin_amdgcn_s_barrier()
#define PG8_SCHED __builtin_amdgcn_sched_barrier(0)
#define PG8_GIDX(d0, d1, un) do { _Pragma("unroll") for (int _i = 0; _i < 2; ++_i) { const int* _rp = g.rowsrc + (un).pm * BM + RA[_i]; d0[_i] = (unsigned)_rp[0] * (unsigned)(g.lda * 2) + CA[_i]; d1[_i] = (unsigned)_rp[HALF] * (unsigned)(g.lda * 2) + CA[_i]; } } while (0)
    Unit cur, nxt; int ui = 0;
    if (!S.next(0, cur)) return;
    f32x4 acc[2][2][4][2];
#pragma unroll
    for (int a = 0; a < 2; ++a)
#pragma unroll
        for (int b = 0; b < 2; ++b)
#pragma unroll
            for (int m = 0; m < 4; ++m)
#pragma unroll
                for (int n = 0; n < 2; ++n) acc[a][b][m][n] = (f32x4){0.f, 0.f, 0.f, 0.f};
    bf16x8 At[4][2], B0[2][2], B1[2][2];
    const char* cA = (const char*)g.A + (size_t)cur.pm * tstepA + (size_t)cur.k0 * 2; const char* cB = (const char*)g.Bt + (size_t)cur.pn * tstepB + (size_t)cur.k0 * 2;
    S.a_ready(cur);
    unsigned cv0[2] = {0u, 0u}, cv1[2] = {0u, 0u}, nv0[2] = {0u, 0u}, nv1[2] = {0u, 0u}; const char* gA = (const char*)g.A;
    if constexpr (GATHER) { PG8_GIDX(cv0, cv1, cur); nv0[0] = cv0[0]; nv0[1] = cv0[1]; nv1[0] = cv1[0]; nv1[1] = cv1[1]; }
    if constexpr (SP2) {
        PG8_STAGE(PG8_SB(0, 0), cB, voffB); PG8_STAGE(PG8_SB(0, 1), cB + hstepB, voffB);
        if constexpr (GATHER) { PG8_STAGE(PG8_SA(0, 0), gA, cv0); PG8_STAGE(PG8_SA(0, 1), gA, cv1); } else { PG8_STAGE(PG8_SA(0, 0), cA, voffA); PG8_STAGE(PG8_SA(0, 1), cA + hstepA, voffA); }
        if (wr == 1) PG8_BAR;
        PG8_WAIT_V(2); PG8_BAR;
        PG8_STAGE(PG8_SB(1, 0), cB + kstep, voffB); if constexpr (GATHER) PG8_STAGE(PG8_SA(1, 0), gA + kstep, cv0); else PG8_STAGE(PG8_SA(1, 0), cA + kstep, voffA); PG8_STAGE(PG8_SB(1, 1), cB + hstepB + kstep, voffB);
        PG8_WAIT_V(6); PG8_BAR;
    } else {
        PG8_STAGE(PG8_SB(0, 0), cB, voffB); PG8_STAGE(PG8_SA(0, 0), cA, voffA); PG8_STAGE(PG8_SB(0, 1), cB + hstepB, voffB); PG8_STAGE(PG8_SA(0, 1), cA + hstepA, voffA);
        if (wr == 1) PG8_BAR;
        PG8_WAIT_V(4); PG8_BAR;
        PG8_STAGE(PG8_SB(1, 0), cB + kstep, voffB); PG8_STAGE(PG8_SA(1, 0), cA + kstep, voffA); PG8_STAGE(PG8_SB(1, 1), cB + hstepB + kstep, voffB);
        PG8_WAIT_V(6); PG8_BAR;
    }
    for (;;) {
        const bool has_next = S.next(ui + 1, nxt);
        const char* nA = has_next ? (const char*)g.A + (size_t)nxt.pm * tstepA + (size_t)nxt.k0 * 2 : cA; const char* nB = has_next ? (const char*)g.Bt + (size_t)nxt.pn * tstepB + (size_t)nxt.k0 * 2 : cB;
        for (int t = 0; t < nt; t += 2) {
            const bool last = (t == nt - 2);
            const char* a1 = cA + (size_t)(t + 1) * kstep;
            const char* a2 = last ? nA : cA + (size_t)(t + 2) * kstep; const char* b2 = last ? nB : cB + (size_t)(t + 2) * kstep;
            const char* a3 = a2 + kstep; const char* b3 = b2 + kstep;
            if (last && has_next) S.a_ready(nxt);
            if constexpr (GATHER) { if (t == nt - 4 && has_next) PG8_GIDX(nv0, nv1, nxt); }
            const char* g1 = gA + (size_t)(t + 1) * kstep; const char* g2 = last ? gA : gA + (size_t)(t + 2) * kstep; const char* g3 = g2 + kstep;
            unsigned x0[2], x1[2]; x0[0] = last ? nv0[0] : cv0[0]; x0[1] = last ? nv0[1] : cv0[1]; x1[0] = last ? nv1[0] : cv1[0]; x1[1] = last ? nv1[1] : cv1[1];
            if constexpr (SP2) {
            PG8_LDB(B0, 0, 0); PG8_LDB(B1, 0, 1); PG8_SCHED; PG8_LDA(At, 0, 0); if constexpr (GATHER) PG8_STAGE(PG8_SA(1, 1), g1, cv1); else PG8_STAGE(PG8_SA(1, 1), a1 + hstepA, voffA);
            PG8_WAIT_V(8); PG8_WAIT_L(0); PG8_BAR; PG8_MMA(0, 0, At, B0); PG8_MMA(0, 1, At, B1); PG8_BAR; PG8_SCHED;
            PG8_LDA(At, 0, 1); PG8_STAGE(PG8_SB(0, 0), b2, voffB); PG8_STAGE(PG8_SB(0, 1), b2 + hstepB, voffB); if constexpr (GATHER) PG8_STAGE(PG8_SA(0, 0), g2, x0); else PG8_STAGE(PG8_SA(0, 0), a2, voffA);
            PG8_WAIT_V(8); PG8_WAIT_L(0); PG8_BAR; PG8_MMA(1, 0, At, B0); PG8_MMA(1, 1, At, B1); PG8_BAR; PG8_SCHED;
            PG8_LDB(B0, 1, 0); PG8_LDB(B1, 1, 1); PG8_SCHED; PG8_LDA(At, 1, 0); if constexpr (GATHER) PG8_STAGE(PG8_SA(0, 1), g2, x1); else PG8_STAGE(PG8_SA(0, 1), a2 + hstepA, voffA);
            PG8_WAIT_V(8); PG8_WAIT_L(0); PG8_BAR; PG8_MMA(0, 0, At, B0); PG8_MMA(0, 1, At, B1); PG8_BAR; PG8_SCHED;
            PG8_LDA(At, 1, 1); PG8_STAGE(PG8_SB(1, 0), b3, voffB); PG8_STAGE(PG8_SB(1, 1), b3 + hstepB, voffB); if constexpr (GATHER) PG8_STAGE(PG8_SA(1, 0), g3, x0); else PG8_STAGE(PG8_SA(1, 0), a3, voffA);
            PG8_WAIT_V(8); PG8_WAIT_L(0); PG8_BAR; PG8_MMA(1, 0, At, B0); PG8_MMA(1, 1, At, B1); PG8_BAR; PG8_SCHED;
            } else {
            PG8_LDB(B0, 0, 0); PG8_SCHED; PG8_LDA(At, 0, 0); PG8_STAGE(PG8_SA(1, 1), a1 + hstepA, voffA);
            PG8_WAIT_L(8); PG8_BAR; PG8_WAIT_L(0); PG8_MMA(0, 0, At, B0); PG8_BAR; PG8_SCHED;
            PG8_LDB(B1, 0, 1); PG8_STAGE(PG8_SB(0, 0), b2, voffB);
            PG8_BAR; PG8_WAIT_L(0); PG8_MMA(0, 1, At, B1); PG8_BAR;
            PG8_LDA(At, 0, 1); PG8_STAGE(PG8_SA(0, 0), a2, voffA);
            PG8_BAR; PG8_WAIT_L(0); PG8_MMA(1, 0, At, B0); PG8_BAR; PG8_SCHED;
            PG8_STAGE(PG8_SB(0, 1), b2 + hstepB, voffB);
            PG8_WAIT_V(6); PG8_BAR; PG8_MMA(1, 1, At, B1); PG8_BAR;
            PG8_LDB(B0, 1, 0); PG8_SCHED; PG8_LDA(At, 1, 0); PG8_STAGE(PG8_SA(0, 1), a2 + hstepA, voffA);
            PG8_WAIT_L(8); PG8_BAR; PG8_WAIT_L(0); PG8_MMA(0, 0, At, B0); PG8_BAR; PG8_SCHED;
            PG8_LDB(B1, 1, 1); PG8_STAGE(PG8_SB(1, 0), b3, voffB);
            PG8_BAR; PG8_WAIT_L(0); PG8_MMA(0, 1, At, B1); PG8_BAR;
            PG8_LDA(At, 1, 1); PG8_STAGE(PG8_SA(1, 0), a3, voffA);
            PG8_BAR; PG8_WAIT_L(0); PG8_MMA(1, 0, At, B0); PG8_BAR; PG8_SCHED;
            PG8_STAGE(PG8_SB(1, 1), b3 + hstepB, voffB);
            PG8_WAIT_V(6); PG8_BAR; PG8_MMA(1, 1, At, B1); PG8_BAR;
            }
        }
        if constexpr (ALIGN_EPI) { if (wr == 0) PG8_BAR; }
        if constexpr (!Epi::AFTER_DRAIN) { E(acc, cur, wr, wc, fr, fq); S.done(cur); }
        if (!has_next) break;
#pragma unroll
        for (int a = 0; a < 2; ++a)
#pragma unroll
            for (int b = 0; b < 2; ++b)
#pragma unroll
                for (int m = 0; m < 4; ++m)
#pragma unroll
                    for (int n = 0; n < 2; ++n) acc[a][b][m][n] = (f32x4){0.f, 0.f, 0.f, 0.f};
        cur = nxt; cA = nA; cB = nB; ++ui;
        if constexpr (GATHER) { cv0[0] = nv0[0]; cv0[1] = nv0[1]; cv1[0] = nv1[0]; cv1[1] = nv1[1]; }
        if constexpr (ALIGN_EPI) { if (wr == 1) PG8_BAR; }
    }
    PG8_WAIT_V(0);
    if constexpr (!ALIGN_EPI) { if (wr == 0) PG8_BAR; }
    PG8_BAR;
    if constexpr (Epi::AFTER_DRAIN) { E.fused(acc, cur, wr, wc, fr, fq, lds, wid, lane); S.done(cur); }
#undef PG8_SA
#undef PG8_SB
#undef PG8_STAGE
#undef PG8_LDA
#undef PG8_LDB
#undef PG8_MMA
#undef PG8_WAIT_V
#undef PG8_WAIT_L
#undef PG8_BAR
#undef PG8_SCHED
#undef PG8_GIDX
}
}

constexpr int NB = 8, SEQ = 2048, NCTX = 256, D = 1024;
constexpr int ML = NB * SEQ, MC = NB * NCTX, MT = ML + MC;
constexpr int MIXIN = 2560, FFN = 2816, NE = 8, ED = 3584;
constexpr float EPS = 1e-6f;
constexpr int NWAVES = 8;
constexpr int MOE_TILES = 136;

constexpr size_t MiB = 1u << 20;
constexpr size_t WS_CTL = 0, CTL_ZERO_BYTES = 65536;
constexpr size_t WS_MOD = 65536, WS_MODP = 1 * MiB; constexpr int MOD_N = 2 * 9 * 6144;
constexpr size_t WS_ROWSS = 3 * MiB, WS_SHW13 = 4608 * 1024, WS_SHWS = WS_SHW13 + 9 * 5632 * 4;
constexpr size_t WS_TOK = 5 * MiB;
constexpr size_t TOK_E = 0, TOK_W = 128 * 1024, TOK_RANK = 256 * 1024, TOK_POS = 384 * 1024, TOK_WGBASE = 512 * 1024, TOK_ROWGATE = 576 * 1024, TOK_ROWSRC = 720 * 1024, TOK_ROWINFO = 864 * 1024;
constexpr size_t WS_MW13 = 6 * MiB, WS_MW2 = 118 * MiB;
constexpr size_t WS_XL = 174 * MiB, WS_H = 238 * MiB, WS_XC = 274 * MiB;
constexpr size_t WS_WIN = 282 * MiB, WS_WOUT = 287 * MiB, WS_W13 = 289 * MiB, WS_W2 = 300 * MiB, WS_SIN = 306 * MiB, WS_SOUT = 308 * MiB;
constexpr size_t WS_BTOUT = 312 * MiB, WS_WEND = 360 * MiB, WS_R = 376 * MiB, WS_END = 512 * MiB;
constexpr size_t WS_QKVU = WS_R, WS_MIX = WS_R + 72 * MiB, WS_ACT = WS_R;
constexpr size_t WS_UC = WS_R, WS_E = WS_R + 72 * MiB, WS_Y = WS_R + 72 * MiB;
constexpr size_t WS_PX = WS_H;
constexpr size_t WS_ACTM = 274 * MiB;
static_assert(WS_ACTM + (size_t)MOE_TILES * 256 * ED * 2 <= WS_END && WS_XC + (size_t)MC * D * 4 <= WS_WIN && WS_H + (size_t)MT * D * 2 <= WS_XC && WS_MW2 + (size_t)NE * D * ED * 2 <= WS_XL, "d_ws map");
constexpr int CW_TMO = 0, CW_CODE = 1, CW_BAR = 4096, CW_GCNT = 8192;

constexpr int RING_OFF = 0, RING_BYTES = 131072;
constexpr int LDSCTL_OFF = 155648, MISC_OFF = LDSCTL_OFF + 320;
constexpr int LDS_BYTES = 159744;
static_assert(MISC_OFF + 128 <= LDS_BYTES, "LDS map");

#define GAS __attribute__((address_space(1)))
#define LAS __attribute__((address_space(3)))
typedef unsigned short bf16;
typedef unsigned v4u __attribute__((ext_vector_type(4)));
typedef unsigned v2u __attribute__((ext_vector_type(2)));
typedef float f32x4 __attribute__((ext_vector_type(4)));
typedef float f32x2 __attribute__((ext_vector_type(2)));
typedef float f32x16 __attribute__((ext_vector_type(16)));
typedef short bf16x8 __attribute__((ext_vector_type(8)));
typedef GAS unsigned gu32;
#define RLX_AGENT __ATOMIC_RELAXED, __HIP_MEMORY_SCOPE_AGENT
#define LDS_WAIT() asm volatile("s_waitcnt lgkmcnt(0)" ::: "memory")
#define VM_WAIT() asm volatile("s_waitcnt vmcnt(0)" ::: "memory")
__device__ __forceinline__ unsigned f2bf(float f) { unsigned u = __builtin_bit_cast(unsigned, f); return (u + 0x7fffu + ((u >> 16) & 1u)) >> 16; }
__device__ __forceinline__ unsigned pk2(float lo, float hi) { return f2bf(lo) | (f2bf(hi) << 16); }
__device__ __forceinline__ float bf2f(unsigned short h) { return __builtin_bit_cast(float, (unsigned)h << 16); }
__device__ __forceinline__ float bflo(unsigned w) { return __builtin_bit_cast(float, w << 16); }
__device__ __forceinline__ float bfhi(unsigned w) { return __builtin_bit_cast(float, w & 0xffff0000u); }
__device__ __forceinline__ float sigm(float x) { return __builtin_amdgcn_rcpf(1.0f + __expf(-x)); }
__device__ __forceinline__ float wave_sum(float v) {
#pragma unroll
    for (int o = 1; o < 64; o <<= 1) v += __shfl_xor(v, o);
    return v;
}
__device__ __forceinline__ float wave_max(float v) {
#pragma unroll
    for (int o = 1; o < 64; o <<= 1) v = fmaxf(v, __shfl_xor(v, o));
    return v;
}
#define XB_TMO      128
#define XB_XCNT(j)  (256  + 64 * (j))
#define XB_XSUB(j)  (1280 + 64 * (j))
#define XB_XGEN(j)  (2304 + 64 * (j))
#define XB_TOP      3328
#define XB_TOPGEN   3392
#define XCD_BAR_WORDS 3456
#define XB_SPIN_CAP (1u << 18)

__device__ __forceinline__ unsigned xb_ld(unsigned* p)              { return __hip_atomic_load(p, __ATOMIC_RELAXED, __HIP_MEMORY_SCOPE_AGENT); }
__device__ __forceinline__ unsigned xb_add(unsigned* p, unsigned v) { return __hip_atomic_fetch_add(p, v, __ATOMIC_RELAXED, __HIP_MEMORY_SCOPE_AGENT); }
__device__ __forceinline__ unsigned xb_xcc_id() { return (unsigned)__builtin_amdgcn_s_getreg((3 << 11) | 20) & 0xFu; }
#define XB_SPIN(cond, bar) do { unsigned _sp = 0; while (cond) { __builtin_amdgcn_s_sleep(1); \
    if ((++_sp & 255u) == 0u) { if (xb_ld(&(bar)[XB_TMO])) break; if (_sp > XB_SPIN_CAP) { atomicAdd(&(bar)[XB_TMO], 1u); break; } } } } while (0)

struct XcdBarrier {
    unsigned* bar; unsigned x;
    volatile LAS unsigned* st;
};

__device__ __forceinline__ XcdBarrier xcd_barrier_post(unsigned* bar, volatile LAS unsigned* st) {
    XcdBarrier b; b.bar = bar; b.x = xb_xcc_id(); b.st = st;
    if (threadIdx.x == 0) (void)xb_add(&bar[XB_XCNT(b.x)], 1u);
    return b;
}
__device__ __forceinline__ void xcd_barrier_complete(unsigned* bar, unsigned x, unsigned& nloc, unsigned& nx) {
    const unsigned G = gridDim.x * gridDim.y * gridDim.z;
    unsigned sum, cnt, mine, sp = 0u;
    for (;;) {
        sum = 0u; cnt = 0u; mine = 0u;
#pragma unroll
        for (unsigned j = 0; j < 16; ++j) { const unsigned c = xb_ld(&bar[XB_XCNT(j)]); sum += c; cnt += (c > 0u) ? 1u : 0u; mine = (j == x) ? c : mine; }
        if (sum == G) break;
        __builtin_amdgcn_s_sleep(1);
        if ((++sp & 255u) == 0u) { if (xb_ld(&bar[XB_TMO])) break; if (sp > XB_SPIN_CAP) { atomicAdd(&bar[XB_TMO], 1u); break; } }
    }
    nloc = mine > 0u ? mine : 1u; nx = cnt > 0u ? cnt : 1u;
}

__device__ __forceinline__ void xcd_barrier(const XcdBarrier& b) {
    asm volatile("s_waitcnt vmcnt(0)" ::: "memory");
    __syncthreads();
    if (threadIdx.x == 0) {
        unsigned* bar = b.bar;
        __builtin_amdgcn_s_waitcnt(0);
        unsigned nloc = b.st[0], nx = b.st[1];
        if (nloc == 0u) { xcd_barrier_complete(bar, b.x, nloc, nx); b.st[0] = nloc; b.st[1] = nx; }
        const unsigned old = xb_add(&bar[XB_XSUB(b.x)], 1u);
        const unsigned gen = old / nloc;
        if (old + 1u == (gen + 1u) * nloc) {
            __builtin_amdgcn_fence(__ATOMIC_RELEASE, "agent");
            asm volatile("s_waitcnt vmcnt(0)" ::: "memory");
            const unsigned og = xb_add(&bar[XB_TOP], 1u);
            const unsigned tg = og / nx;
            if (og + 1u == (tg + 1u) * nx) xb_add(&bar[XB_TOPGEN], 1u);
            else XB_SPIN(xb_ld(&bar[XB_TOPGEN]) == tg, bar);
            __builtin_amdgcn_fence(__ATOMIC_ACQUIRE, "agent");
            xb_add(&bar[XB_XGEN(b.x)], 1u);
            asm volatile("s_waitcnt vmcnt(0)" ::: "memory");
        } else {
            XB_SPIN(xb_ld(&bar[XB_XGEN(b.x)]) == gen, bar);
            __builtin_amdgcn_fence(__ATOMIC_ACQUIRE, "agent");
            asm volatile("s_waitcnt vmcnt(0)" ::: "memory");
        }
    }
    __syncthreads();
}
enum { I_X = 0, I_C, I_CTX, I_CCTX, I_ADAW, I_ADAB, I_N1G, I_N2G, I_MIXWIN, I_QG, I_KG, I_RPB, I_DWW, I_DWB, I_LNG, I_LNB, I_MIXWOUT, I_FW1, I_FW3, I_FW2,
       I_SWIN, I_ARE, I_AIM, I_LOGDT, I_BRE, I_BIM, I_CRE, I_CIM, I_SD, I_SWOUT, I_ROUTER, I_MW1, I_MW3, I_MW2, N_IN };
struct Args { const float* in[N_IN]; float* out; unsigned char* ws; int ph_lo, ph_hi, sub, pad; };

typedef short s16x4 __attribute__((ext_vector_type(4)));
typedef float f32x2_t __attribute__((ext_vector_type(2)));
typedef __bf16 bf16x2_t __attribute__((ext_vector_type(2)));
__device__ __forceinline__ unsigned cvtpk(float lo, float hi) { const f32x2_t v = {lo, hi}; const bf16x2_t b = __builtin_convertvector(v, bf16x2_t); return __builtin_bit_cast(unsigned, b); }
__device__ __forceinline__ s16x4 vtr(const LAS unsigned char* p) { return __builtin_bit_cast(s16x4, __builtin_amdgcn_ds_read_tr16_b64_v4i16((LAS s16x4*)p)); }
__device__ __forceinline__ void p0_adaln(const Args& A, int unit, LAS unsigned char* lds, int tid, int wave, int lane) {
    const int l = unit / 96, rem = unit % 96, cb = rem >> 2, kq = rem & 3;
    LAS float* sc = (LAS float*)lds;
    LAS float* part = sc + 9 * 256;
    const float* c = A.in[I_C]; const float* cc = A.in[I_CCTX];
    for (int i = tid; i < 9 * 256; i += NWAVES * 64) { const int r = i >> 8, k = 256 * kq + (i & 255); const float v = r < 8 ? c[r * 1024 + k] : cc[k]; sc[i] = v * sigm(v); }
    __syncthreads();
    const float* wp = A.in[I_ADAW] + (size_t)l * 1024 * 6144 + (size_t)(256 * kq + 32 * wave) * 6144 + 256 * cb + 4 * lane;
    float acc[9][4];
#pragma unroll
    for (int r = 0; r < 9; ++r)
#pragma unroll
        for (int j = 0; j < 4; ++j) acc[r][j] = 0.f;
#pragma unroll 8
    for (int it = 0; it < 32; ++it) {
        const f32x4 wv = *(const f32x4*)(wp + (size_t)it * 6144); const int k = 32 * wave + it;
#pragma unroll
        for (int r = 0; r < 9; ++r) { const float s = sc[r * 256 + k];
#pragma unroll
            for (int j = 0; j < 4; ++j) acc[r][j] += s * wv[j]; }
    }
#pragma unroll
    for (int r = 0; r < 9; ++r) *(LAS f32x4*)(part + (wave * 9 + r) * 256 + 4 * lane) = (f32x4){acc[r][0], acc[r][1], acc[r][2], acc[r][3]};
    __syncthreads();
    float* modp = (float*)(A.ws + WS_MODP) + (size_t)kq * MOD_N;
    for (int i = tid; i < 9 * 256; i += NWAVES * 64) { const int r = i >> 8, col = i & 255; float s = 0.f;
#pragma unroll
        for (int w = 0; w < 8; ++w) s += part[(w * 9 + r) * 256 + col];
        if (kq == 0) s += A.in[I_ADAB][l * 6144 + 256 * cb + col];
        modp[((size_t)l * 9 + r) * 6144 + 256 * cb + col] = s; }
    __syncthreads();
}
constexpr int KTS = 260;
__device__ __forceinline__ void p0_s5gen(const Args& A, int g, int part, LAS unsigned char* lds, int tid) {
    LAS f32x2* POW = (LAS f32x2*)lds;
    LAS float* BBr = (LAS float*)(POW + 2 * 64 * 33 + 8);
    LAS float* BBi = BBr + 2 * 64 * 16;
    LAS f32x2* CC = (LAS f32x2*)(BBi + 2 * 64 * 16);
    LAS f32x2* CT = CC + 2 * 16 * 66 + 8;
    LAS float* KT = (LAS float*)(CT + 2 * 64 * 16);
    LAS f32x2* FF = (LAS f32x2*)(KT + 63 * KTS);
#define PWI(d_, p_, m_) (((d_) * 64 + (p_)) * 33 + (m_) + ((p_) >> 5) + (d_) * 4)
#define CCI(d_, q_, p_) (((d_) * 16 + (q_)) * 66 + (p_) + ((p_) >> 5) + (d_) * 4)
    if (tid < 128) { const int d = tid >> 6, p = tid & 63, ix = (d * 64 + g) * 64 + p;
        const float ar = A.in[I_ARE][ix], ai = A.in[I_AIM][ix], dt = __expf(A.in[I_LOGDT][d * 64 + g]);
        const float zr = ar * dt, zi = ai * dt, mag = __expf(zr); const float lr = mag * cosf(zi), li = mag * sinf(zi);
        float pr = 1.f, pi = 0.f;
        for (int m = 0; m <= 32; ++m) { POW[PWI(d, p, m)] = (f32x2){pr, pi}; const float nr = pr * lr - pi * li, ni = pr * li + pi * lr; pr = nr; pi = ni; }
        const float nr = lr - 1.f, ni = li, den = 1.f / (ar * ar + ai * ai);
        FF[d * 64 + p] = (f32x2){(nr * ar + ni * ai) * den, (ni * ar - nr * ai) * den}; }
    __syncthreads();
    for (int i = tid; i < 2048; i += NWAVES * 64) { const int d = i >> 10, p = (i >> 4) & 63, q = i & 15; const int ix = ((d * 64 + g) * 64 + p) * 16 + q;
        const float br = A.in[I_BRE][ix], bi = A.in[I_BIM][ix]; const f32x2 f = FF[d * 64 + p];
        BBr[(d * 64 + p) * 16 + q] = f.x * br - f.y * bi; BBi[(d * 64 + p) * 16 + q] = f.x * bi + f.y * br; }
    for (int i = tid; i < 2048; i += NWAVES * 64) { const int d = i >> 10, q = (i >> 6) & 15, p = i & 63; const int ix = ((d * 64 + g) * 16 + q) * 64 + p;
        const f32x2 cv2 = (f32x2){A.in[I_CRE][ix], A.in[I_CIM][ix]}; CC[CCI(d, q, p)] = cv2; CT[(d * 64 + p) * 16 + q] = cv2; }
    __syncthreads();
    bf16* BtOut = (bf16*)(A.ws + WS_BTOUT) + (size_t)g * 512 * 768;
    bf16* WEnd = (bf16*)(A.ws + WS_WEND) + (size_t)g * 256 * 512;
    if (part == 0) {
#pragma unroll 1
    for (int d = 0; d < 2; ++d) {
        const int dl = tid >> 4, qo = tid & 15; float acc[16];
#pragma unroll
        for (int i = 0; i < 16; ++i) acc[i] = 0.f;
#pragma unroll 2
        for (int p = 0; p < 64; ++p) { const f32x2 c = CT[(d * 64 + p) * 16 + qo], w = POW[PWI(d, p, dl)]; const float tr = c.x * w.x - c.y * w.y, ti = c.x * w.y + c.y * w.x;
            const LAS f32x4* br = (const LAS f32x4*)(BBr + (d * 64 + p) * 16); const LAS f32x4* bi = (const LAS f32x4*)(BBi + (d * 64 + p) * 16);
#pragma unroll
            for (int q4 = 0; q4 < 4; ++q4) { const f32x4 r4 = br[q4], i4 = bi[q4];
#pragma unroll
                for (int j = 0; j < 4; ++j) acc[4 * q4 + j] += tr * r4[j] - ti * i4[j]; } }
        if (d == 0) {
            { const float dsk = (dl == 0) ? A.in[I_SD][g * 16 + qo] : 0.f;
#pragma unroll
              for (int i = 0; i < 16; ++i) acc[i] += (i == qo) ? dsk : 0.f; }
#pragma unroll
            for (int i = 0; i < 4; ++i) *(LAS f32x4*)(KT + (31 + dl) * KTS + qo * 16 + 4 * i) = (f32x4){acc[4 * i], acc[4 * i + 1], acc[4 * i + 2], acc[4 * i + 3]};
        } else {
#pragma unroll
            for (int i = 0; i < 4; ++i) { LAS f32x4* kp = (LAS f32x4*)(KT + (31 - dl) * KTS + qo * 16 + 4 * i); f32x4 v = (f32x4){acc[4 * i], acc[4 * i + 1], acc[4 * i + 2], acc[4 * i + 3]}; if (dl == 0) v = v + *kp; *kp = v; }
        }
        __syncthreads();
    }
    for (int pc = tid; pc < 512 * 64; pc += NWAVES * 64) {
        const int n = pc >> 6, kp = pc & 63, t = n >> 4, qo = n & 15, j = kp >> 1, qi0 = (kp & 1) * 8; const LAS float* s = KT + (t - j + 31) * KTS + qo * 16 + qi0;
        const f32x4 s0 = *(const LAS f32x4*)s, s1 = *(const LAS f32x4*)(s + 4);
        v4u o; o.x = cvtpk(s0.x, s0.y); o.y = cvtpk(s0.z, s0.w); o.z = cvtpk(s1.x, s1.y); o.w = cvtpk(s1.z, s1.w);
        *(v4u*)(BtOut + (size_t)n * 768 + kp * 8) = o; }
    } else {
    for (int pc = tid; pc < 512 * 32; pc += NWAVES * 64) {
        const int n = pc >> 5, kp = pc & 31, t = n >> 4, qo = n & 15, d = kp >> 4, ri = (kp >> 3) & 1, p0 = (kp & 7) * 8, m = d == 0 ? t + 1 : 32 - t; float v[8];
#pragma unroll
        for (int i = 0; i < 8; ++i) { const f32x2 c = CC[CCI(d, qo, p0 + i)], w = POW[PWI(d, p0 + i, m)]; v[i] = ri == 0 ? (c.x * w.x - c.y * w.y) : -(c.x * w.y + c.y * w.x); }
        v4u o; o.x = cvtpk(v[0], v[1]); o.y = cvtpk(v[2], v[3]); o.z = cvtpk(v[4], v[5]); o.w = cvtpk(v[6], v[7]);
        *(v4u*)(BtOut + (size_t)n * 768 + 512 + kp * 8) = o; }
    for (int pc = tid; pc < 256 * 64; pc += NWAVES * 64) {
        const int n = pc >> 6, kp = pc & 63, d = n >> 7, ri = (n >> 6) & 1, p = n & 63, j = kp >> 1, qi0 = (kp & 1) * 8, m = d == 0 ? 31 - j : j; const f32x2 w = POW[PWI(d, p, m)]; float v[8];
#pragma unroll
        for (int i = 0; i < 8; ++i) { const float br = BBr[(d * 64 + p) * 16 + qi0 + i], bi = BBi[(d * 64 + p) * 16 + qi0 + i]; v[i] = ri == 0 ? (w.x * br - w.y * bi) : (w.x * bi + w.y * br); }
        v4u o; o.x = cvtpk(v[0], v[1]); o.y = cvtpk(v[2], v[3]); o.z = cvtpk(v[4], v[5]); o.w = cvtpk(v[6], v[7]);
        *(v4u*)(WEnd + (size_t)n * 512 + kp * 8) = o; }
    }
    __syncthreads();
#undef PWI
#undef CCI
}
__device__ __forceinline__ void cvt_item(const float* W, int K, int N, int ldw, bf16* WT, int mode, int item, LAS float* scr, int lane) {
    const int nblk = N / 32, kb = item / nblk, nb = item - kb * nblk, k0 = 64 * kb, n0 = 32 * nb;
    int r0 = n0;
    if (mode == 1) r0 = 256 * (n0 >> 7) + (n0 & 127);
    else if (mode == 2) r0 = 256 * (n0 >> 7) + 128 + (n0 & 127);
    else if (mode == 3) { if (n0 < 1536) { const int pn = n0 >> 8, rem = n0 & 255; r0 = 256 * pn + 128 * ((rem & 63) >> 5) + 32 * (rem >> 6); }
                          else if (n0 < 2048) { const int n1 = n0 - 1536; r0 = 256 * (6 + (n1 >> 7)) + (n1 & 127); }
                          else { const int n1 = n0 - 2048; r0 = 256 * (6 + (n1 >> 7)) + 128 + (n1 & 127); } }
    { f32x4 v[8];
#pragma unroll
      for (int i = 0; i < 8; ++i) v[i] = *(const f32x4*)(W + (size_t)(k0 + 8 * i + (lane >> 3)) * ldw + n0 + 4 * (lane & 7));
#pragma unroll
      for (int i = 0; i < 8; ++i) { LAS float* d = scr + (8 * i + (lane >> 3)) * 33 + 4 * (lane & 7); d[0] = v[i].x; d[1] = v[i].y; d[2] = v[i].z; d[3] = v[i].w; } }
    LDS_WAIT(); asm volatile("" ::: "memory");
    const int c = lane & 7;
#pragma unroll
    for (int j = 0; j < 4; ++j) { const int n = (lane >> 3) + 8 * j; const LAS float* s = scr + (8 * c) * 33 + n;
        v4u o; o.x = cvtpk(s[0 * 33], s[1 * 33]); o.y = cvtpk(s[2 * 33], s[3 * 33]); o.z = cvtpk(s[4 * 33], s[5 * 33]); o.w = cvtpk(s[6 * 33], s[7 * 33]);
        *(GAS v4u*)(WT + (size_t)(r0 + n) * K + k0 + 8 * c) = o; }
    LDS_WAIT(); asm volatile("" ::: "memory");
}
constexpr int CV_IM = 16 * 112, CV_IM2 = 56 * 32, CV_NMOE = NE * (2 * CV_IM + CV_IM2);
__device__ __forceinline__ void p0_convert(const Args& A, LAS unsigned char* lds, int gw, int NGW, int wave, int lane) {
    LAS float* scr = (LAS float*)(lds + wave * 16384);
    unsigned char* ws = A.ws;
    constexpr int I0 = 16 * 80, I1 = 16 * 32, I2 = 16 * 88, I3 = 44 * 32, I4 = 16 * 32, I5 = 16 * 32;
    constexpr int NSMALL = I0 + I1 + 2 * I2 + I3 + I4 + 2 * I5;
    for (int it = gw; it < NSMALL; it += NGW) {
        int r = it;
        if (r < I0) { cvt_item(A.in[I_MIXWIN], D, MIXIN, MIXIN, (bf16*)(ws + WS_WIN), 3, r, scr, lane); continue; } r -= I0;
        if (r < I1) { cvt_item(A.in[I_MIXWOUT], D, D, D, (bf16*)(ws + WS_WOUT), 0, r, scr, lane); continue; } r -= I1;
        if (r < I2) { cvt_item(A.in[I_FW1], D, FFN, FFN, (bf16*)(ws + WS_W13), 1, r, scr, lane); continue; } r -= I2;
        if (r < I2) { cvt_item(A.in[I_FW3], D, FFN, FFN, (bf16*)(ws + WS_W13), 2, r, scr, lane); continue; } r -= I2;
        if (r < I3) { cvt_item(A.in[I_FW2], FFN, D, D, (bf16*)(ws + WS_W2), 0, r, scr, lane); continue; } r -= I3;
        if (r < I4) { cvt_item(A.in[I_SWIN], D, D, D, (bf16*)(ws + WS_SIN), 0, r, scr, lane); continue; } r -= I4;
        if (r < I5) { cvt_item(A.in[I_SWOUT], D, D, 2 * D, (bf16*)(ws + WS_SOUT), 1, r, scr, lane); continue; } r -= I5;
        cvt_item(A.in[I_SWOUT] + D, D, D, 2 * D, (bf16*)(ws + WS_SOUT), 2, r, scr, lane);
    }
}
__device__ __forceinline__ void moe_convert(const Args& A, LAS unsigned char* lds, int first, int count, int widx, int nw, int wave, int lane) {
    LAS float* scr = (LAS float*)(lds + wave * 16384);
    unsigned char* ws = A.ws;
    const int last = (first + count) < CV_NMOE ? (first + count) : CV_NMOE;
    for (int it = first + widx; it < last; it += nw) {
        int r = it; const int e = r / (2 * CV_IM + CV_IM2); r -= e * (2 * CV_IM + CV_IM2);
        if (r < CV_IM) { cvt_item(A.in[I_MW1] + (size_t)e * D * ED, D, ED, ED, (bf16*)(ws + WS_MW13) + (size_t)e * 2 * ED * D, 1, r, scr, lane); continue; } r -= CV_IM;
        if (r < CV_IM) { cvt_item(A.in[I_MW3] + (size_t)e * D * ED, D, ED, ED, (bf16*)(ws + WS_MW13) + (size_t)e * 2 * ED * D, 2, r, scr, lane); continue; } r -= CV_IM;
        cvt_item(A.in[I_MW2] + (size_t)e * ED * D, ED, D, D, (bf16*)(ws + WS_MW2) + (size_t)e * D * ED, 0, r, scr, lane);
    }
}
__device__ __forceinline__ void shw_rows(const bf16* WT, int N, const float* sh, float* out, int widx, int nw, LAS unsigned char* lds, int tid, int lane) {
    LAS float* shl = (LAS float*)lds;
    __syncthreads();
    for (int i = tid; i < 9 * 1024; i += NWAVES * 64) shl[i] = sh[(size_t)(i >> 10) * 6144 + (i & 1023)];
    __syncthreads();
    for (int p = widx; p < N; p += nw) {
        const v4u w0 = *(const v4u*)(WT + (size_t)p * D + 16 * lane), w1 = *(const v4u*)(WT + (size_t)p * D + 16 * lane + 8);
        const float w[16] = {bflo(w0.x), bfhi(w0.x), bflo(w0.y), bfhi(w0.y), bflo(w0.z), bfhi(w0.z), bflo(w0.w), bfhi(w0.w), bflo(w1.x), bfhi(w1.x), bflo(w1.y), bfhi(w1.y), bflo(w1.z), bfhi(w1.z), bflo(w1.w), bfhi(w1.w)};
        float s[9];
#pragma unroll
        for (int b = 0; b < 9; ++b) { const LAS f32x4* sp = (const LAS f32x4*)(shl + b * 1024 + 16 * lane); float a = 0.f;
#pragma unroll
            for (int q = 0; q < 4; ++q) { const f32x4 v = sp[q]; a += (v.x * w[4 * q] + v.y * w[4 * q + 1]) + (v.z * w[4 * q + 2] + v.w * w[4 * q + 3]); }
            s[b] = a; }
#pragma unroll
        for (int b = 0; b < 9; ++b) s[b] = wave_sum(s[b]);
        if (lane < 9) { float v = s[0];
#pragma unroll
            for (int b = 1; b < 9; ++b) v = (lane == b) ? s[b] : v;
            out[(size_t)lane * N + p] = v; }
    }
    __syncthreads();
}
template <int NPART> __device__ __forceinline__ void norm_row_finish(const f32x4 (&v)[4], int row, const float* gain, const float* mod, int shc, int scc, bf16* H, int lane) {
    const float* mp = mod + (size_t)(row < ML ? (row >> 11) : 8) * 6144; float ss = 0.f;
#pragma unroll
    for (int j = 0; j < 4; ++j) ss += (v[j].x * v[j].x + v[j].y * v[j].y) + (v[j].z * v[j].z + v[j].w * v[j].w);
    const float rstd = rsqrtf(wave_sum(ss) * (1.0f / D) + EPS);
#pragma unroll
    for (int j = 0; j < 4; ++j) { const int k = 4 * lane + 256 * j; const f32x4 gg = *(const f32x4*)(gain + k); f32x4 sc = *(const f32x4*)(mp + scc * 1024 + k), sh = *(const f32x4*)(mp + shc * 1024 + k);
#pragma unroll
        for (int q = 1; q < NPART; ++q) { sc = sc + *(const f32x4*)(mp + (size_t)q * MOD_N + scc * 1024 + k); sh = sh + *(const f32x4*)(mp + (size_t)q * MOD_N + shc * 1024 + k); }
        const f32x4 h = v[j] * rstd * gg * (sc + 1.0f) + sh;
        v2u o; o.x = cvtpk(h.x, h.y); o.y = cvtpk(h.z, h.w); *(v2u*)(H + (size_t)row * D + k) = o; }
}
__device__ __forceinline__ void norm_rows_lds(const float* xL, const float* xC, int nrows, const float* gain, const LAS float* ms, bf16* H, int gw, int NGW, int lane) {
    for (int row = gw; row < nrows; row += 2 * NGW) {
        const int row1 = row + NGW; const bool two = row1 < nrows; const int r1 = two ? row1 : row;
        const float* xa = row < ML ? xL + (size_t)row * D : xC + (size_t)(row - ML) * D; const float* xb = r1 < ML ? xL + (size_t)r1 * D : xC + (size_t)(r1 - ML) * D;
        f32x4 vv[2][4];
#pragma unroll
        for (int j = 0; j < 4; ++j) { vv[0][j] = *(const f32x4*)(xa + 4 * lane + 256 * j); vv[1][j] = *(const f32x4*)(xb + 4 * lane + 256 * j); }
#pragma unroll
        for (int u = 0; u < 2; ++u) { if (u == 1 && !two) break; const int rw = u ? row1 : row; const LAS float* mp = ms + (rw < ML ? (rw >> 11) : 8) * 2048; float ss = 0.f;
#pragma unroll
            for (int j = 0; j < 4; ++j) ss += (vv[u][j].x * vv[u][j].x + vv[u][j].y * vv[u][j].y) + (vv[u][j].z * vv[u][j].z + vv[u][j].w * vv[u][j].w);
            const float rstd = rsqrtf(wave_sum(ss) * (1.0f / D) + EPS);
#pragma unroll
            for (int j = 0; j < 4; ++j) { const int k = 4 * lane + 256 * j; const f32x4 gg = *(const f32x4*)(gain + k), sh = *(const LAS f32x4*)(mp + k), sc = *(const LAS f32x4*)(mp + 1024 + k);
                const f32x4 h = vv[u][j] * rstd * gg * (sc + 1.0f) + sh;
                v2u o; o.x = cvtpk(h.x, h.y); o.y = cvtpk(h.z, h.w); *(v2u*)(H + (size_t)rw * D + k) = o; } }
    }
}
template <int NPART> __device__ __forceinline__ void norm_rows(const float* xL, const float* xC, int nrows, const float* gain, const float* mod, int shc, int scc, bf16* H, int gw, int NGW, int lane) {
    for (int row = gw; row < nrows; row += 2 * NGW) {
        const int row1 = row + NGW; const bool two = row1 < nrows; const int r1 = two ? row1 : row;
        const float* xa = row < ML ? xL + (size_t)row * D : xC + (size_t)(row - ML) * D; const float* xb = r1 < ML ? xL + (size_t)r1 * D : xC + (size_t)(r1 - ML) * D;
        f32x4 va[4], vb[4];
#pragma unroll
        for (int j = 0; j < 4; ++j) { va[j] = *(const f32x4*)(xa + 4 * lane + 256 * j); vb[j] = *(const f32x4*)(xb + 4 * lane + 256 * j); }
        norm_row_finish<NPART>(va, row, gain, mod, shc, scc, H, lane);
        if (two) norm_row_finish<NPART>(vb, row1, gain, mod, shc, scc, H, lane);
    }
}
constexpr int VSTR = 144;
__device__ __forceinline__ void attn_unit(const bf16* QKVU, bf16* MIX, int wu, LAS unsigned char* vl, LAS unsigned char* ql, const LAS float* rpbl, float bnd, int lane) {
    const bool isctx = wu >= 2048;
    int b, h, r = 0, qrow0;
    if (!isctx) { h = wu & 7; r = (wu >> 3) & 31; b = wu >> 8; qrow0 = b * SEQ + r * 64; }
    else { const int w = wu - 2048; h = w & 7; b = w >> 5; qrow0 = ML + b * NCTX + 64 * ((w >> 3) & 3); }
    const int c = lane & 31, hh = lane >> 5;
    const int rs = r < 4 ? 0 : (r > 28 ? 24 : r - 4);
    const int csA = c < 8 ? 0 : c - 8;
    const int csB = c > 24 ? 48 : c + 24;
    const LAS unsigned char* vtb = vl + (4 * hh + ((lane & 15) >> 2)) * VSTR + 32 * ((lane >> 4) & 1) + 8 * (lane & 3);
    LAS unsigned char* qs = ql + c * 128 + 16 * hh;
    { const bf16* qp = QKVU + (size_t)(qrow0 + c) * 2048 + h * 64 + 8 * hh;
#pragma unroll
      for (int s = 0; s < 4; ++s) { *(LAS bf16x8*)(qs + 32 * s) = *(const bf16x8*)(qp + 16 * s); *(LAS bf16x8*)(qs + 4096 + 32 * s) = *(const bf16x8*)(qp + (size_t)32 * 2048 + 16 * s); } }
    f32x16 oA0, oA1, oB0, oB1;
#pragma unroll
    for (int i = 0; i < 16; ++i) { oA0[i] = 0.f; oA1[i] = 0.f; oB0[i] = 0.f; oB1[i] = 0.f; }
    float lsA = 0.f, lsB = 0.f;
    const int nblk = isctx ? 8 : 24;
    const bf16* kbase = QKVU + 512 + h * 64 + 8 * hh + (size_t)c * 2048;
    const bf16* vbase = QKVU + 1024 + h * 64 + 8 * (lane & 7) + (size_t)(lane >> 3) * 2048;
#define ATT_KROW0(kb_) (((!isctx) && (kb_) < 16) ? (b * SEQ + (rs + ((kb_) >> 1)) * 64 + 32 * ((kb_) & 1)) : (ML + b * NCTX + 32 * (isctx ? (kb_) : (kb_) - 16)))
#define ATT_LOADK(KF, kb_) do { const int kq_ = (kb_) < nblk ? (kb_) : nblk - 1; const size_t ro_ = (size_t)ATT_KROW0(kq_) * 2048; \
        _Pragma("unroll") for (int s_ = 0; s_ < 4; ++s_) KF[s_] = *(const bf16x8*)(kbase + ro_ + 16 * s_); } while (0)
#define ATT_LOADV(VF, kb_) do { const int kq_ = (kb_) < nblk ? (kb_) : nblk - 1; const size_t ro_ = (size_t)ATT_KROW0(kq_) * 2048; \
        _Pragma("unroll") for (int i_ = 0; i_ < 4; ++i_) VF[i_] = *(const v4u*)(vbase + ro_ + (size_t)i_ * 8 * 2048); } while (0)
#define ATT_PACK(PF, P) do { _Pragma("unroll") for (int s = 0; s < 2; ++s) { v4u w; w.x = cvtpk(P[8 * s], P[8 * s + 1]); w.y = cvtpk(P[8 * s + 2], P[8 * s + 3]); w.z = cvtpk(P[8 * s + 4], P[8 * s + 5]); w.w = cvtpk(P[8 * s + 6], P[8 * s + 7]); PF[s] = __builtin_bit_cast(bf16x8, w); } } while (0)
#define ATT_BLOCK(KF, VF, kb_) do { const int kb = (kb_); const bool live = kb < nblk; const bool band = (!isctx) && kb < 16; const int kr = rs + (kb >> 1); \
        _Pragma("unroll") for (int i = 0; i < 4; ++i) { const int id = lane + 64 * i; *(LAS v4u*)(vl + (id >> 3) * VSTR + (id & 7) * 16) = VF[i]; } \
        ATT_LOADV(VF, kb + 1);              \
        f32x16 sA, sB; \
        _Pragma("unroll") for (int i = 0; i < 16; ++i) { sA[i] = 0.f; sB[i] = 0.f; } \
        _Pragma("unroll") for (int s = 0; s < 4; ++s) { sA = __builtin_amdgcn_mfma_f32_32x32x16_bf16(KF[s], *(const LAS bf16x8*)(qs + 32 * s), sA, 0, 0, 0); \
                                                        sB = __builtin_amdgcn_mfma_f32_32x32x16_bf16(KF[s], *(const LAS bf16x8*)(qs + 4096 + 32 * s), sB, 0, 0, 0); } \
        ATT_LOADK(KF, kb + 1);              \
        float pA[16], pB[16]; \
        if (band) { const int kc0 = 32 * (kb & 1) + 4 * hh; const LAS float* rb = rpbl + h * 465 + (kr - r + 7) * 31 + (kc0 - c); \
              \
            float bA[16], bB[16]; \
            _Pragma("unroll") for (int i = 0; i < 16; ++i) { bA[i] = rb[15 + (i & 3) + 8 * (i >> 2)]; bB[i] = rb[(i & 3) + 8 * (i >> 2) - 17]; } \
            const int tA = kc0 - csA, tB = kc0 - csB; \
            _Pragma("unroll") for (int i = 0; i < 16; ++i) { const int o = (i & 3) + 8 * (i >> 2); \
                { const bool ok = (unsigned)(tA + o) < 16u; const float e = __builtin_amdgcn_exp2f(sA[i] * 0.18033688f + bA[i]); pA[i] = ok ? e : 0.f; } \
                { const bool ok = (unsigned)(tB + o) < 16u; const float e = __builtin_amdgcn_exp2f(sB[i] * 0.18033688f + bB[i]); pB[i] = ok ? e : 0.f; } } \
        } else { \
            _Pragma("unroll") for (int i = 0; i < 16; ++i) { const float ea = __builtin_amdgcn_exp2f(sA[i] * 0.18033688f - bnd), eb = __builtin_amdgcn_exp2f(sB[i] * 0.18033688f - bnd); pA[i] = live ? ea : 0.f; pB[i] = live ? eb : 0.f; } } \
        _Pragma("unroll") for (int i = 0; i < 16; ++i) { lsA += pA[i]; lsB += pB[i]; } \
        bf16x8 fA[2], fB[2]; ATT_PACK(fA, pA); ATT_PACK(fB, pB); \
        LDS_WAIT(); \
        _Pragma("unroll") for (int dt = 0; dt < 2; ++dt) \
            _Pragma("unroll") for (int s = 0; s < 2; ++s) { \
                const s16x4 lo = vtr(vtb + (16 * s) * VSTR + 64 * dt), hi = vtr(vtb + (16 * s + 8) * VSTR + 64 * dt); \
                const bf16x8 af = (bf16x8){lo[0], lo[1], lo[2], lo[3], hi[0], hi[1], hi[2], hi[3]}; \
                if (dt == 0) { oA0 = __builtin_amdgcn_mfma_f32_32x32x16_bf16(af, fA[s], oA0, 0, 0, 0); oB0 = __builtin_amdgcn_mfma_f32_32x32x16_bf16(af, fB[s], oB0, 0, 0, 0); } \
                else { oA1 = __builtin_amdgcn_mfma_f32_32x32x16_bf16(af, fA[s], oA1, 0, 0, 0); oB1 = __builtin_amdgcn_mfma_f32_32x32x16_bf16(af, fB[s], oB1, 0, 0, 0); } } \
        } while (0)
    bf16x8 kA[4]; v4u vA[4];
    ATT_LOADK(kA, 0); ATT_LOADV(vA, 0);
    for (int kb1 = 0; kb1 < nblk; ++kb1) ATT_BLOCK(kA, vA, kb1);
#undef ATT_KROW0
#undef ATT_LOADK
#undef ATT_LOADV
#undef ATT_PACK
#undef ATT_BLOCK
    lsA += __shfl_xor(lsA, 32); lsB += __shfl_xor(lsB, 32);
    const float iA = 1.0f / lsA, iB = 1.0f / lsB;
    bf16* op = MIX + (size_t)(qrow0 + c) * D + h * 64 + 4 * hh; bf16* oq = op + (size_t)32 * D;
#pragma unroll
    for (int i4 = 0; i4 < 4; ++i4) {
        v2u w0; w0.x = cvtpk(oA0[4 * i4] * iA, oA0[4 * i4 + 1] * iA); w0.y = cvtpk(oA0[4 * i4 + 2] * iA, oA0[4 * i4 + 3] * iA); *(v2u*)(op + 8 * i4) = w0;
        v2u w1; w1.x = cvtpk(oA1[4 * i4] * iA, oA1[4 * i4 + 1] * iA); w1.y = cvtpk(oA1[4 * i4 + 2] * iA, oA1[4 * i4 + 3] * iA); *(v2u*)(op + 32 + 8 * i4) = w1;
        v2u w2; w2.x = cvtpk(oB0[4 * i4] * iB, oB0[4 * i4 + 1] * iB); w2.y = cvtpk(oB0[4 * i4 + 2] * iB, oB0[4 * i4 + 3] * iB); *(v2u*)(oq + 8 * i4) = w2;
        v2u w3; w3.x = cvtpk(oB1[4 * i4] * iB, oB1[4 * i4 + 1] * iB); w3.y = cvtpk(oB1[4 * i4 + 2] * iB, oB1[4 * i4 + 3] * iB); *(v2u*)(oq + 32 + 8 * i4) = w3; }
}
template <int P0, int NP> __device__ __forceinline__ void conv_chunk(float (&acc)[32], const float (&w)[31], const __amdgpu_buffer_rsrc_t rsrc, int voff, int t0, int len) {
    float v[NP];
#pragma unroll
    for (int i = 0; i < NP; ++i) { const int t = t0 - 15 + P0 + i, tc = t < 0 ? 0 : (t >= len ? len - 1 : t); const int so = __builtin_amdgcn_readfirstlane(tc * 4096);
        const float x = bf2f(__builtin_amdgcn_raw_buffer_load_b16(rsrc, voff, so, 0)); v[i] = (t == tc) ? x : 0.f; }
#pragma unroll
    for (int i = 0; i < NP; ++i)
#pragma unroll
        for (int tt = 0; tt < 32; ++tt) { if (P0 + i - tt >= 0 && P0 + i - tt <= 30) acc[tt] += v[i] * w[(P0 + i - tt >= 0 && P0 + i - tt <= 30) ? P0 + i - tt : 0]; }
}
__device__ __forceinline__ void conv_item(const Args& A, const bf16* QKVU, bf16* MIX, int item, LAS float* cv, int tid, int wave, int lane) {
    __syncthreads();
    int rowbase, len, t0;
    if (item < 512) { rowbase = (item >> 6) * SEQ; len = SEQ; t0 = 32 * (item & 63); } else { const int i2 = item - 512; rowbase = ML + (i2 >> 3) * NCTX; len = NCTX; t0 = 32 * (i2 & 7); }
    const int ch = tid;
    float w[31], acc[32];
    { const __amdgpu_buffer_rsrc_t wrs = __builtin_amdgcn_make_buffer_rsrc((void*)A.in[I_DWW], 0, 31 * 512 * 4, 0x00020000);
#pragma unroll
      for (int k = 0; k < 31; ++k) w[k] = __builtin_bit_cast(float, __builtin_amdgcn_raw_buffer_load_b32(wrs, 4 * ch, k * 2048, 0)); }
    const float bias = A.in[I_DWB][ch];
#pragma unroll
    for (int t = 0; t < 32; ++t) acc[t] = bias;
    const __amdgpu_buffer_rsrc_t rsrc = __builtin_amdgcn_make_buffer_rsrc((void*)(QKVU + (size_t)rowbase * 2048 + 1536), 0, len * 4096, 0x00020000);
    conv_chunk<0, 16>(acc, w, rsrc, 2 * ch, t0, len); conv_chunk<16, 16>(acc, w, rsrc, 2 * ch, t0, len); conv_chunk<32, 16>(acc, w, rsrc, 2 * ch, t0, len); conv_chunk<48, 14>(acc, w, rsrc, 2 * ch, t0, len);
#pragma unroll
    for (int t = 0; t < 32; ++t) cv[t * 512 + ch] = acc[t];
    __syncthreads();
    const f32x4 g0 = *(const f32x4*)(A.in[I_LNG] + 8 * lane), g1 = *(const f32x4*)(A.in[I_LNG] + 8 * lane + 4), b0 = *(const f32x4*)(A.in[I_LNB] + 8 * lane), b1 = *(const f32x4*)(A.in[I_LNB] + 8 * lane + 4);
#pragma unroll
    for (int q = 0; q < 4; ++q) { const int tt = 4 * wave + q;
        f32x4 x0 = *(const LAS f32x4*)(cv + tt * 512 + 8 * lane), x1 = *(const LAS f32x4*)(cv + tt * 512 + 8 * lane + 4);
        const float mean = wave_sum((x0.x + x0.y) + (x0.z + x0.w) + (x1.x + x1.y) + (x1.z + x1.w)) * (1.0f / 512.0f);
        x0 = x0 - mean; x1 = x1 - mean;
        const float var = wave_sum((x0.x * x0.x + x0.y * x0.y) + (x0.z * x0.z + x0.w * x0.w) + (x1.x * x1.x + x1.y * x1.y) + (x1.z * x1.z + x1.w * x1.w)) * (1.0f / 512.0f);
        const float rstd = rsqrtf(var + EPS);
        f32x4 y0 = x0 * rstd * g0 + b0, y1 = x1 * rstd * g1 + b1;
        y0 = (f32x4){y0.x * sigm(y0.x), y0.y * sigm(y0.y), y0.z * sigm(y0.z), y0.w * sigm(y0.w)}; y1 = (f32x4){y1.x * sigm(y1.x), y1.y * sigm(y1.y), y1.z * sigm(y1.z), y1.w * sigm(y1.w)};
        v4u o; o.x = cvtpk(y0.x, y0.y); o.y = cvtpk(y0.z, y0.w); o.z = cvtpk(y1.x, y1.y); o.w = cvtpk(y1.z, y1.w);
        *(v4u*)(MIX + (size_t)(rowbase + t0 + tt) * D + 512 + 8 * lane) = o; }
    __syncthreads();
}
__device__ __forceinline__ void s5_scan(const Args& A, int gt) {
    if (gt >= NB * 64 * 2 * 64) return;
    const int p = gt & 63, d = (gt >> 6) & 1, g = (gt >> 7) & 63, b = gt >> 13;
    const int ix = (d * 64 + g) * 64 + p;
    const float ar = A.in[I_ARE][ix], ai = A.in[I_AIM][ix], dt = __expf(A.in[I_LOGDT][d * 64 + g]);
    const float zr = ar * dt, zi = ai * dt, mag = __expf(zr); float lr = mag * cosf(zi), li = mag * sinf(zi);
#pragma unroll
    for (int k = 0; k < 5; ++k) { const float nr = lr * lr - li * li, ni = 2.f * lr * li; lr = nr; li = ni; }
    const float* E = (const float*)(A.ws + WS_E) + (size_t)g * 768 * 256 + d * 128 + p;
    bf16* UC = (bf16*)(A.ws + WS_UC) + (size_t)g * 768 * 768 + 512 + d * 128 + p;
    float sr = 0.f, si = 0.f;
    for (int s0 = 0; s0 < 72; s0 += 24) {
        float er[24], ei[24]; int bcs[24];
#pragma unroll
        for (int k = 0; k < 24; ++k) { const int step = s0 + k; int bc;
            if (step < 8) bc = 512 + 8 * b + (d == 0 ? step : 7 - step); else bc = 64 * b + (d == 0 ? step - 8 : 71 - step);
            bcs[k] = bc; er[k] = E[(size_t)bc * 256]; ei[k] = E[(size_t)bc * 256 + 64]; }
#pragma unroll
        for (int k = 0; k < 24; ++k) {
            if (s0 + k >= 8) { UC[(size_t)bcs[k] * 768] = (bf16)f2bf(sr); UC[(size_t)bcs[k] * 768 + 64] = (bf16)f2bf(si); }
            const float nr = lr * sr - li * si + er[k], ni = lr * si + li * sr + ei[k]; sr = nr; si = ni; }
    }
}
__device__ __forceinline__ void moe_route(const Args& A, const bf16* X, const float* mod, bf16* H, int chunk, LAS unsigned* lcnt, int tid, int wave, int lane) {
    unsigned char* tok = A.ws + WS_TOK;
    int* tokE = (int*)(tok + TOK_E); float* tokW = (float*)(tok + TOK_W); int* tokRank = (int*)(tok + TOK_RANK); int* wgbase = (int*)(tok + TOK_WGBASE);
    if (tid < 8) lcnt[tid] = 0u;
    __syncthreads();
    const float* gain = A.in[I_N2G] + D; const float* wr = A.in[I_ROUTER];
    for (int q2 = 0; q2 < 8; q2 += 2) {
        f32x4 vv[2][4];
#pragma unroll
        for (int u = 0; u < 2; ++u) { const bf16* xr = X + (size_t)(chunk * 64 + wave * 8 + q2 + u) * D;
#pragma unroll
            for (int j = 0; j < 4; ++j) { const v2u xw = *(const v2u*)(xr + 4 * lane + 256 * j); vv[u][j] = (f32x4){bflo(xw.x), bfhi(xw.x), bflo(xw.y), bfhi(xw.y)}; } }
#pragma unroll
        for (int u = 0; u < 2; ++u) {
        const int row = chunk * 64 + wave * 8 + q2 + u; const float* mp = mod + (size_t)(row >> 11) * 6144;
        float ss = 0.f;
#pragma unroll
        for (int j = 0; j < 4; ++j) ss += (vv[u][j].x * vv[u][j].x + vv[u][j].y * vv[u][j].y) + (vv[u][j].z * vv[u][j].z + vv[u][j].w * vv[u][j].w);
        const float rstd = rsqrtf(wave_sum(ss) * (1.0f / D) + EPS);
        float lg[8];
#pragma unroll
        for (int e = 0; e < 8; ++e) lg[e] = 0.f;
#pragma unroll
        for (int j = 0; j < 4; ++j) { const int k = 4 * lane + 256 * j; const f32x4 gg = *(const f32x4*)(gain + k), sc = *(const f32x4*)(mp + 4 * 1024 + k), sh = *(const f32x4*)(mp + 3 * 1024 + k);
            const f32x4 h = vv[u][j] * rstd * gg * (sc + 1.0f) + sh;
            v2u o; o.x = cvtpk(h.x, h.y); o.y = cvtpk(h.z, h.w); *(v2u*)(H + (size_t)row * D + k) = o;
#pragma unroll
            for (int i = 0; i < 4; ++i) { const f32x4 w0 = *(const f32x4*)(wr + (size_t)(k + i) * 8), w1 = *(const f32x4*)(wr + (size_t)(k + i) * 8 + 4); const float hv = h[i];
                lg[0] += hv * w0.x; lg[1] += hv * w0.y; lg[2] += hv * w0.z; lg[3] += hv * w0.w; lg[4] += hv * w1.x; lg[5] += hv * w1.y; lg[6] += hv * w1.z; lg[7] += hv * w1.w; } }
#pragma unroll
        for (int e = 0; e < 8; ++e) lg[e] = wave_sum(lg[e]);
        int e0 = 0; float v0 = lg[0];
#pragma unroll
        for (int e = 1; e < 8; ++e) if (lg[e] > v0) { v0 = lg[e]; e0 = e; }
        int e1 = -1; float v1 = -3.0e38f;
#pragma unroll
        for (int e = 0; e < 8; ++e) if (e != e0 && lg[e] > v1) { v1 = lg[e]; e1 = e; }
        const float ex = __expf(v1 - v0), w0 = 1.0f / (1.0f + ex), w1 = ex * w0;
        if (lane == 0) { const unsigned r0 = __hip_atomic_fetch_add(&lcnt[e0], 1u, __ATOMIC_RELAXED, __HIP_MEMORY_SCOPE_WORKGROUP), r1 = __hip_atomic_fetch_add(&lcnt[e1], 1u, __ATOMIC_RELAXED, __HIP_MEMORY_SCOPE_WORKGROUP);
            tokE[2 * row] = e0; tokE[2 * row + 1] = e1; tokW[2 * row] = w0; tokW[2 * row + 1] = w1; tokRank[2 * row] = (int)r0; tokRank[2 * row + 1] = (int)r1; }
        }
    }
    __syncthreads();
    if (tid < 8) { const unsigned n = lcnt[tid]; const unsigned base = __hip_atomic_fetch_add((unsigned*)(A.ws + WS_CTL) + CW_GCNT + 64 * tid, n, RLX_AGENT); wgbase[chunk * 8 + tid] = (int)base; }
    __syncthreads();
}
constexpr int NPHASE = 17;
__device__ __forceinline__ void moe_offsets(const unsigned char* ws, int (&toff)[9]) {
    const unsigned* gc = (const unsigned*)(ws + WS_CTL) + CW_GCNT; int acc = 0;
#pragma unroll
    for (int e = 0; e < 8; ++e) { toff[e] = acc; const unsigned n = __hip_atomic_load(gc + 64 * e, RLX_AGENT); acc += (int)((n + 255u) >> 8); }
    toff[8] = acc;
}
#define TAIL_CONVERT(nunits, first, count) do { const int rounds_ = ((nunits) + G - 1) / G, nlast_ = (nunits) - (rounds_ - 1) * G; \
        if (bx >= nlast_) moe_convert(args, lds, (first), (count), (bx - nlast_) * NWAVES + wave, (G - nlast_) * NWAVES, wave, lane); } while (0)
constexpr int CVQ4 = 4000, CVQ6 = 8000, CVQ7 = 17500, CVQ9 = 8500, CVQS1 = 2000, CVQS2 = CV_NMOE - CVQ4 - CVQ6 - CVQ7 - CVQ9 - CVQS1;
__global__ void __launch_bounds__(NWAVES * 64, 2) fwd_kernel(Args args) {
    extern __shared__ __attribute__((aligned(16))) unsigned char lds_raw[];
    LAS unsigned char* lds = (LAS unsigned char*)lds_raw;
    volatile LAS unsigned* MISC = (volatile LAS unsigned*)(lds + MISC_OFF);
    const int tid = threadIdx.x, lane = tid & 63, wave = __builtin_amdgcn_readfirstlane(tid >> 6);
    const int G = gridDim.x, bx = blockIdx.x;
    const int gw = bx * NWAVES + wave, NGW = G * NWAVES;
    unsigned char* ws = args.ws;
    for (int u = tid; u < (LDS_BYTES - LDSCTL_OFF) / 4; u += NWAVES * 64) ((LAS unsigned*)(lds + LDSCTL_OFF))[u] = 0u;
    __syncthreads();
    const int lo = args.ph_lo, hi = args.ph_hi;
    XcdBarrier bar; bar.bar = (unsigned*)(ws + WS_CTL) + CW_BAR; bar.x = 0; bar.st = nullptr;
    if (hi - lo > 1) bar = xcd_barrier_post((unsigned*)(ws + WS_CTL) + CW_BAR, MISC + 8);
#define IN(k) (lo <= (k) && (k) < hi)
#define SEAM(k) do { if (IN((k) + 1)) xcd_barrier(bar); } while (0)
    float* mod = (float*)(ws + WS_MOD);
    bf16* XL = (bf16*)(ws + WS_XL); bf16* XC = (bf16*)(ws + WS_XC);
    bf16* H = (bf16*)(ws + WS_H);

    if (IN(0)) {
        for (int u = bx; u < 192; u += G) { if (args.sub & 1) p0_adaln(args, u, lds, tid, wave, lane); }
        if (args.sub & 4) p0_convert(args, lds, gw, NGW, wave, lane);
        SEAM(0);
    }
    if (IN(1)) {
        { const float* modp = (const float*)(ws + WS_MODP);
          for (int i = bx * (NWAVES * 64) + tid; i < MOD_N; i += G * NWAVES * 64) mod[i] = ((modp[i] + modp[MOD_N + i]) + modp[2 * MOD_N + i]) + modp[3 * MOD_N + i]; }
        { const float* modp = (const float*)(ws + WS_MODP); LAS float* ms = (LAS float*)lds;
          for (int i = tid; i < 9 * 2048; i += NWAVES * 64) { const int r = i >> 11, o = r * 6144 + (i & 2047); ms[i] = ((modp[o] + modp[MOD_N + o]) + modp[2 * MOD_N + o]) + modp[3 * MOD_N + o]; }
          __syncthreads(); norm_rows_lds(args.in[I_X], args.in[I_CTX], MT, args.in[I_N1G], ms, H, gw, NGW, lane); }
        SEAM(1); }
    if (IN(2)) {
        pg8::Gemm g{H, (const bf16*)(ws + WS_WIN), MT, MIXIN, D, D, D}; pg8::StaticOrder S; S.init(MT, MIXIN, G, bx);
        pg8::EpiQKVU E{(bf16*)(ws + WS_QKVU), args.in[I_QG], args.in[I_KG], EPS};
        pg8::gemm_phase<pg8::EpiQKVU, pg8::StaticOrder, true, true>(lds + RING_OFF, g, S, E);
        SEAM(2);
    }
    if (IN(3)) {
        const bf16* QKVU = (const bf16*)(ws + WS_QKVU); bf16* MIX = (bf16*)(ws + WS_MIX);
        LAS float* rpbl = (LAS float*)(lds + 40960); LAS float* cv = (LAS float*)(lds + 57344);
        float mq = 0.f, mk = 0.f, mb = 0.f;
        mq = fabsf(args.in[I_QG][lane]); mk = fabsf(args.in[I_KG][lane]);
        for (int i = lane; i < 8 * 465; i += 64) mb = fmaxf(mb, fabsf(args.in[I_RPB][i]));
        const float bnd = (8.2f * wave_max(mq) * wave_max(mk) + wave_max(mb)) * 1.44269504f;
        for (int i = tid; i < 8 * 465; i += NWAVES * 64) rpbl[i] = args.in[I_RPB][i] * 1.44269504f - bnd;
        __syncthreads();
        const int nbw = (G % 8 == 0) ? G / 8 : G, xb0 = (G % 8 == 0) ? (bx & 7) : 0, xbn = (G % 8 == 0) ? xb0 + 1 : 8, j0 = (G % 8 == 0) ? (bx >> 3) : bx;
        for (int x = xb0; x < xbn; ++x)
            for (int k = j0; k < 128; k += nbw) {
                if (k < 36) {
                    if (!(args.sub & (k < 32 ? 8 : 16))) continue;
                    const int wu = k < 32 ? (x * 32 + k) * 8 + wave : 2048 + (x * 4 + (k - 32)) * 8 + wave;
                    attn_unit(QKVU, MIX, wu, lds + wave * 5120, lds + 57344 + wave * 8192, rpbl, bnd, lane);
                } else {
                    if (!(args.sub & 32)) continue;
                    const int ci = k < 64 ? k - 36 : (k < 96 ? k - 36 : (k >= 100 && k < 112 ? k - 40 : -1)); if (ci < 0) continue;
                    conv_item(args, QKVU, MIX, ci < 64 ? x * 64 + ci : 512 + x * 8 + (ci - 64), cv, tid, wave, lane);
                }
            }
        {
            const bool mine = (G == 256) ? ((bx >> 3) >= 16) : true; const int cw = (G == 256) ? (((bx >> 3) - 16) * 8 + (bx & 7)) * NWAVES + wave : gw, cn = (G == 256) ? 128 * NWAVES : NGW;
            if (mine) { shw_rows((const bf16*)(ws + WS_W13), 2 * FFN, mod + 3 * 1024, (float*)(ws + WS_SHW13), cw, cn, lds, tid, lane);
                        shw_rows((const bf16*)(ws + WS_SIN), D, mod + 9 * 6144, (float*)(ws + WS_SHWS), cw, cn, lds, tid, lane); }
        }
        SEAM(3);
    }
    if (IN(4)) {
        pg8::Gemm g{(const bf16*)(ws + WS_MIX), (const bf16*)(ws + WS_WOUT), MT, D, D, D, D}; pg8::StaticOrder S; S.init(MT, D, G, bx);
        pg8::EpiResidN<true> E{args.in[I_X], args.in[I_CTX], XL, XC, mod + 2 * 1024, H, (float*)(ws + WS_ROWSS), args.in[I_N2G], mod + 4 * 1024};
        pg8::gemm_phase<pg8::EpiResidN<true>, pg8::StaticOrder, true, true>(lds + RING_OFF, g, S, E);
        {
            const int nun = (MT / 256) * (D / 256), rounds = (nun + G - 1) / G, nlast = nun - (rounds - 1) * G, nidle = G - nlast, ii = bx - nlast;
            if (ii >= 0) {
                if (args.sub & 2) for (int u = ii; u < 128; u += nidle) p0_s5gen(args, u >> 1, u & 1, lds, tid);
                const bool cvw = (nidle > 128) ? (ii >= 128) : true;
                const int cw = (nidle > 128) ? (ii - 128) * NWAVES + wave : ii * NWAVES + wave, cn = (nidle > 128) ? (nidle - 128) * NWAVES : nidle * NWAVES;
                if (cvw) {
                    moe_convert(args, lds, 0, CVQ4, cw, cn, wave, lane); }
            }
            if (nidle <= 0) { for (int u = bx; u < 128; u += G) p0_s5gen(args, u >> 1, u & 1, lds, tid);
                moe_convert(args, lds, 0, CVQ4, gw, NGW, wave, lane); }
        }
        SEAM(4);
    }
    if (IN(5)) {
        pg8::Gemm g{H, (const bf16*)(ws + WS_W13), MT, 2 * FFN, D, D, D}; pg8::StaticOrder S; S.init(MT, 2 * FFN, G, bx);
        LAS float* rt = (LAS float*)(lds + RING_BYTES); pg8::rstd_prepass(S, (const float*)(ws + WS_ROWSS), rt, EPS, tid);
        pg8::EpiSwiGLUN E{(bf16*)(ws + WS_ACT), FFN, rt, (const float*)(ws + WS_SHW13), 2 * FFN};
        pg8::gemm_phase<pg8::EpiSwiGLUN, pg8::StaticOrder, true, true>(lds + RING_OFF, g, S, E);
        TAIL_CONVERT((MT / 256) * (2 * FFN / 256), CVQ4, CVQ6);
        SEAM(5);
    }
    if (IN(6)) {
        pg8::Gemm g{(const bf16*)(ws + WS_ACT), (const bf16*)(ws + WS_W2), MT, D, FFN, FFN, FFN}; pg8::StaticOrder S; S.init(MT, D, G, bx);
        pg8::EpiResidN<false> E{XL, XC, XL, XC, mod + 5 * 1024, H, (float*)(ws + WS_ROWSS), args.in[I_N1G] + D, mod + 9 * 6144 + 1 * 1024};
        pg8::gemm_phase<pg8::EpiResidN<false>, pg8::StaticOrder, true, true>(lds + RING_OFF, g, S, E);
        TAIL_CONVERT((MT / 256) * (D / 256), CVQ4 + CVQ6, CVQ7);
        SEAM(6);
    }
    float* mod1 = mod + 9 * 6144;
    if (IN(7)) {
        pg8::Gemm g{H, (const bf16*)(ws + WS_SIN), MT, D, D, D, D}; pg8::StaticOrder S; S.init(MT, D, G, bx);
        LAS float* rt = (LAS float*)(lds + RING_BYTES); pg8::rstd_prepass(S, (const float*)(ws + WS_ROWSS), rt, EPS, tid);
        pg8::EpiUC E{(bf16*)(ws + WS_UC), rt, (const float*)(ws + WS_SHWS)};
        pg8::gemm_phase<pg8::EpiUC, pg8::StaticOrder, true, true>(lds + RING_OFF, g, S, E);
        TAIL_CONVERT((MT / 256) * (D / 256), CVQ4 + CVQ6 + CVQ7, CVQ9);
        SEAM(7);
    }
    if (IN(8)) {
        pg8::Gemm g{(const bf16*)(ws + WS_UC), (const bf16*)(ws + WS_WEND), 64 * 768, 64 * 256, 512, 768, 512}; pg8::OrderS5E S{G, bx};
        pg8::EpiE E{(float*)(ws + WS_E)};
        pg8::gemm_phase<pg8::EpiE, pg8::OrderS5E, true, true>(lds + RING_OFF, g, S, E);
        if (G == 256) { if ((bx >> 3) >= 24) moe_convert(args, lds, CVQ4 + CVQ6 + CVQ7 + CVQ9, CVQS1, (((bx >> 3) - 24) * 8 + (bx & 7)) * NWAVES + wave, 64 * NWAVES, wave, lane); }
        else moe_convert(args, lds, CVQ4 + CVQ6 + CVQ7 + CVQ9, CVQS1, gw, NGW, wave, lane);
        SEAM(8);
    }
    if (IN(9)) { s5_scan(args, bx * (NWAVES * 64) + tid);
        if (G > 128) { if (bx >= 128) moe_convert(args, lds, CVQ4 + CVQ6 + CVQ7 + CVQ9 + CVQS1, CVQS2, (bx - 128) * NWAVES + wave, (G - 128) * NWAVES, wave, lane); }
        else moe_convert(args, lds, CVQ4 + CVQ6 + CVQ7 + CVQ9 + CVQS1, CVQS2, gw, NGW, wave, lane);
        SEAM(9); }
    if (IN(10)) {
        pg8::Gemm g{(const bf16*)(ws + WS_UC), (const bf16*)(ws + WS_BTOUT), 64 * 768, 64 * 512, 768, 768, 768}; pg8::OrderS5Y S{G, bx};
        pg8::EpiY E{(bf16*)(ws + WS_Y)};
        pg8::gemm_phase<pg8::EpiY, pg8::OrderS5Y, true, true>(lds + RING_OFF, g, S, E);
        SEAM(10);
    }
    if (IN(11)) {
        pg8::Gemm g{(const bf16*)(ws + WS_Y), (const bf16*)(ws + WS_SOUT), ML, 2 * D, D, D, D}; pg8::StaticOrder S; S.init(ML, 2 * D, G, bx);
        pg8::EpiGLURes E{XL, mod1 + 2 * 1024};
        pg8::gemm_phase<pg8::EpiGLURes, pg8::StaticOrder, true, true>(lds + RING_OFF, g, S, E);
        SEAM(11);
    }
    unsigned char* tok = ws + WS_TOK;
    if (IN(12)) {
        int* rowsrc = (int*)(tok + TOK_ROWSRC); int* rowinfo = (int*)(tok + TOK_ROWINFO); float* rowgate = (float*)(tok + TOK_ROWGATE);
        for (int i = bx * (NWAVES * 64) + tid; i < MOE_TILES * 256; i += G * NWAVES * 64) { rowsrc[i] = 0; rowinfo[i] = -1; rowgate[i] = 0.f; }
        for (int ch = bx; ch < ML / 64; ch += G) moe_route(args, XL, mod1, H, ch, (LAS unsigned*)lds, tid, wave, lane);
        SEAM(12);
    }
    if (IN(13)) {
        int toff[9]; moe_offsets(ws, toff);
        const int* tokE = (const int*)(tok + TOK_E); const float* tokW = (const float*)(tok + TOK_W); const int* tokRank = (const int*)(tok + TOK_RANK); const int* wgbase = (const int*)(tok + TOK_WGBASE);
        int* rowsrc = (int*)(tok + TOK_ROWSRC); int* rowinfo = (int*)(tok + TOK_ROWINFO); float* rowgate = (float*)(tok + TOK_ROWGATE); int* tokPos = (int*)(tok + TOK_POS);
        for (int i = bx * (NWAVES * 64) + tid; i < 2 * ML; i += G * NWAVES * 64) { const int t = i >> 1, e = tokE[i]; int to = 0;
#pragma unroll
            for (int q = 0; q < 8; ++q) to = (e == q) ? toff[q] : to;
            const int pos = to * 256 + wgbase[(t >> 6) * 8 + e] + tokRank[i];
            rowsrc[pos] = t; rowinfo[pos] = i; rowgate[pos] = tokW[i]; tokPos[i] = pos; }
        SEAM(13);
    }
    if (IN(14)) {
        pg8::OrderMoE S; S.G = G; S.c = bx; S.nN = 2 * ED / 256; S.tmax = 1 << 30; S.fix = (args.sub >> 7) & 1; moe_offsets(ws, S.toff);
        pg8::Gemm g{H, (const bf16*)(ws + WS_MW13), MOE_TILES * 256, NE * 2 * ED, D, D, D, (const int*)(tok + TOK_ROWSRC)};
        pg8::EpiSwiGLU E{(bf16*)(ws + WS_ACTM), ED, 2 * ED / 256, 0, (args.sub >> 6) & 1};
        pg8::gemm_phase<pg8::EpiSwiGLU, pg8::OrderMoE, true, true, true>(lds + RING_OFF, g, S, E);
        SEAM(14);
    }
    if (IN(15)) {
        pg8::OrderMoE S; S.G = G; S.c = bx; S.nN = D / 256; S.tmax = 128; S.fix = 0; moe_offsets(ws, S.toff);
        pg8::Gemm g{(const bf16*)(ws + WS_ACTM), (const bf16*)(ws + WS_MW2), MOE_TILES * 256, NE * D, ED, ED, ED};
        pg8::EpiMoE2 E{(bf16*)args.out, (const float*)(tok + TOK_ROWGATE), (const int*)(tok + TOK_ROWINFO)};
        pg8::gemm_phase<pg8::EpiMoE2, pg8::OrderMoE, true, true>(lds + RING_OFF, g, S, E);
        pg8::OrderMoEx Sx; Sx.G = G; Sx.c = bx; moe_offsets(ws, Sx.toff);
        pg8::Gemm gx{(const bf16*)(ws + WS_ACTM), (const bf16*)(ws + WS_MW2), MOE_TILES * 256, NE * D, 896, ED, ED};
        pg8::EpiMoE2x Ex{(float*)(ws + WS_PX), (const float*)(tok + TOK_ROWGATE)};
        pg8::gemm_phase<pg8::EpiMoE2x, pg8::OrderMoEx, true, false>(lds + RING_OFF, gx, Sx, Ex);
        SEAM(15);
    }
    if (IN(16)) {
        const unsigned bad = __hip_atomic_load((unsigned*)(ws + WS_CTL) + CW_BAR + XB_TMO, RLX_AGENT);
        const int* tokPos = (const int*)(tok + TOK_POS); const float* PX = (const float*)(ws + WS_PX);
        for (int tb = gw; tb < ML; tb += 2 * NGW) {
            const int tt[2] = {tb, (tb + NGW < ML) ? tb + NGW : tb}; const int ntk = (tb + NGW < ML) ? 2 : 1;
            v2u a[2][4], b[2][4], xw[2][4]; f32x4 gv[2][4]; int p0[2], p1[2];
#pragma unroll
            for (int u = 0; u < 2; ++u) { const int t = tt[u]; const bf16* y0 = (const bf16*)(args.out + (size_t)t * D); const bf16* y1 = y0 + D; const float* gp = mod1 + (size_t)(t >> 11) * 6144 + 5 * 1024;
                p0[u] = tokPos[2 * t] - 128 * 256; p1[u] = tokPos[2 * t + 1] - 128 * 256;
#pragma unroll
                for (int j = 0; j < 4; ++j) { const int c = 4 * lane + 256 * j; a[u][j] = *(const v2u*)(y0 + c); b[u][j] = *(const v2u*)(y1 + c); xw[u][j] = *(const v2u*)(XL + (size_t)t * D + c); gv[u][j] = *(const f32x4*)(gp + c); } }
            asm volatile("s_waitcnt vmcnt(0)" ::: "memory");
#pragma unroll
            for (int u = 0; u < 2; ++u) { if (u < ntk) { const int t = tt[u];
#pragma unroll
                for (int j = 0; j < 4; ++j) { const int c = 4 * lane + 256 * j;
                    f32x4 ya = (f32x4){bflo(a[u][j].x), bfhi(a[u][j].x), bflo(a[u][j].y), bfhi(a[u][j].y)}, yb = (f32x4){bflo(b[u][j].x), bfhi(b[u][j].x), bflo(b[u][j].y), bfhi(b[u][j].y)};
                    if (p0[u] >= 0) { const float* q = PX + (size_t)p0[u] * D + c; ya = ((*(const f32x4*)q + *(const f32x4*)(q + (size_t)2048 * D)) + *(const f32x4*)(q + (size_t)4096 * D)) + *(const f32x4*)(q + (size_t)6144 * D); }
                    if (p1[u] >= 0) { const float* q = PX + (size_t)p1[u] * D + c; yb = ((*(const f32x4*)q + *(const f32x4*)(q + (size_t)2048 * D)) + *(const f32x4*)(q + (size_t)4096 * D)) + *(const f32x4*)(q + (size_t)6144 * D); }
                    const f32x4 xv = (f32x4){bflo(xw[u][j].x), bfhi(xw[u][j].x), bflo(xw[u][j].y), bfhi(xw[u][j].y)};
                    f32x4 o = xv + gv[u][j] * (ya + yb); if (bad) o = (f32x4){__builtin_nanf(""), __builtin_nanf(""), __builtin_nanf(""), __builtin_nanf("")};
                    *(f32x4*)(args.out + (size_t)t * D + c) = o; } } }
        }
    }
#undef IN
#undef SEAM
}

extern "C" void kernel_launch(void* const* d_in, const int* in_sizes, int n_in, void* d_out, int out_size, void* d_ws, size_t ws_size, hipStream_t stream) {
    static int grid = 0;
    if (grid == 0) {
        if (n_in != N_IN || out_size != ML * D || ws_size < WS_END) { fprintf(stderr, "kernel_launch: unexpected problem (n_in %d, out %d, ws %zu); nothing launched\n", n_in, out_size, ws_size); grid = -1; return; }
        int dev = 0, cus = 0, per_cu = 0;
        if (hipGetDevice(&dev) != hipSuccess || hipDeviceGetAttribute(&cus, hipDeviceAttributeMultiprocessorCount, dev) != hipSuccess) { grid = -1; return; }
        if (hipFuncSetAttribute((const void*)fwd_kernel, hipFuncAttributeMaxDynamicSharedMemorySize, LDS_BYTES) != hipSuccess) { fprintf(stderr, "kernel_launch: hipFuncSetAttribute failed\n"); grid = -1; return; }
        if (hipOccupancyMaxActiveBlocksPerMultiprocessor(&per_cu, (const void*)fwd_kernel, NWAVES * 64, LDS_BYTES) != hipSuccess || per_cu < 1) { fprintf(stderr, "kernel_launch: occupancy query says %d blocks per CU\n", per_cu); (void)hipGetLastError(); grid = -1; return; }
        grid = cus;
    }
    if (grid < 0) return;
    if (hipMemsetAsync((char*)d_ws + WS_CTL, 0, CTL_ZERO_BYTES, stream) != hipSuccess) return;
    Args a{};
    for (int i = 0; i < N_IN; ++i) a.in[i] = (const float*)d_in[i];
    a.out = (float*)d_out; a.ws = (unsigned char*)d_ws; a.sub = 63;
#if MK_N_LAUNCHES == 1
    a.ph_lo = 0; a.ph_hi = NPHASE;
    hipLaunchKernelGGL(fwd_kernel, dim3(grid), dim3(NWAVES * 64), LDS_BYTES, stream, a);
#else
    for (int p = 0; p < NPHASE; ++p) { const int nrep = ((MK_REPEAT_MASK >> p) & 1u) ? 2 : 1;
        for (int r = 0; r < nrep; ++r) { a.ph_lo = p; a.ph_hi = p + 1; a.sub = (r == 0) ? 63 : MK_REPEAT_SUB; hipLaunchKernelGGL(fwd_kernel, dim3(grid), dim3(NWAVES * 64), LDS_BYTES, stream, a); } }
#endif
}
```

```cpp
#include <hip/hip_runtime.h>
#include <cstdio>
#include <cstdint>
#ifndef MK_N_LAUNCHES
#define MK_N_LAUNCHES 1
#endif
#ifndef MK_REPEAT_SUB
#define MK_REPEAT_SUB 63
#endif
#ifndef MK_REPEAT_MASK
#define MK_REPEAT_MASK 0u
#endif
namespace pg8 {
#define PG8_LAS __attribute__((address_space(3)))
typedef unsigned short bf16_t;
typedef short bf16x8 __attribute__((ext_vector_type(8)));
typedef float f32x4 __attribute__((ext_vector_type(4)));
typedef unsigned u32x4 __attribute__((ext_vector_type(4)));
typedef unsigned u32x2 __attribute__((ext_vector_type(2)));
typedef int i32x4 __attribute__((ext_vector_type(4)));
__device__ __forceinline__ f32x4 mma16(bf16x8 a, bf16x8 b, f32x4 c) { return __builtin_amdgcn_mfma_f32_16x16x32_bf16(a, b, c, 0, 0, 0); }
__device__ __forceinline__ i32x4 mma16(bf16x8 a, bf16x8 b, i32x4 c) { return __builtin_amdgcn_mfma_i32_16x16x64_i8(__builtin_bit_cast(i32x4, a), __builtin_bit_cast(i32x4, b), c, 0, 0, 0); }
constexpr int BM = 256, BK = 64, HALF = 128, HTB = HALF * BK * 2  , STAGE_BYTES = 8 * HTB, NXCD = 8, WGM = 8;

__host__ __device__ __forceinline__ int lds_byte(int r, int c) { const int st = (r >> 4) * 2 + (c >> 5), rr = r & 15, cc = c & 31, ob = rr * 64 + cc * 2; return st * 1024 + (ob ^ (((ob >> 9) & 1) << 5)); }
__host__ __device__ __forceinline__ void stage_rc(int b, int& R, int& C) { const int st = b / 1024, sb = b % 1024, swz = sb ^ (((sb >> 9) & 1) << 5); R = (st >> 1) * 16 + swz / 64; C = (st & 1) * 32 + (swz % 64) / 2; }
__host__ __device__ __forceinline__ int perm32(int rho) { const int n = rho >> 4, i = rho & 15; return 8 * (i >> 2) + 4 * n + (i & 3); }

struct Unit { int pm, pn, k0, idx; };
struct Gemm { const bf16_t* A; const bf16_t* Bt; int M, N, K, lda, ldb; const int* rowsrc; };

struct StaticOrder {
    int nM, nN, nwg, G, c;
    __host__ __device__ void init(int M, int N, int G_, int c_) { nM = M / BM; nN = N / BM; nwg = nM * nN; G = G_; c = c_; }
    __host__ __device__ bool next(int i, Unit& u) const {
        const long L = (long)i * G + c; if (L >= nwg) return false;
        int wgid = (int)L; { const int q = nwg / NXCD, r = nwg % NXCD, xcd = wgid % NXCD, off = wgid / NXCD; wgid = (xcd < r ? xcd * (q + 1) : r * (q + 1) + (xcd - r) * q) + off; }
        const int nig = WGM * nN, gid = wgid / nig, fm = gid * WGM, gsz = (nM - fm) < WGM ? (nM - fm) : WGM;
        u.pm = fm + ((wgid % nig) % gsz); u.pn = (wgid % nig) / gsz; u.k0 = 0; u.idx = i; return true;
    }
    __device__ __forceinline__ void a_ready(const Unit&) const {}
    __device__ __forceinline__ void done(const Unit&) const {}
};

constexpr int ML_ = 16384, MC_ = 2048, MT_ = ML_ + MC_, DM_ = 1024;
__device__ __forceinline__ unsigned cvt_pk_bf16(float lo, float hi) { unsigned r; asm volatile("v_cvt_pk_bf16_f32 %0, %1, %2" : "=v"(r) : "v"(lo), "v"(hi)); return r; }
__device__ __forceinline__ float sigm(float x) { return __builtin_amdgcn_rcpf(1.0f + __expf(-x)); }
__device__ __forceinline__ float gelu_tanh(float x) { const float u = 1.5957691216f * (x + 0.044715f * x * x * x); return x * sigm(u); }
__device__ __forceinline__ u32x4 pack8(const f32x4 a, const f32x4 b) { u32x4 w; w.x = cvt_pk_bf16(a[0], a[1]); w.y = cvt_pk_bf16(a[2], a[3]); w.z = cvt_pk_bf16(b[0], b[1]); w.w = cvt_pk_bf16(b[2], b[3]); return w; }


struct EpiQKVU {
    typedef f32x4 acc_t; static constexpr bool PERM = true, AFTER_DRAIN = false;
    bf16_t* O; const float* gq; const float* gk; float eps;
    __device__ __forceinline__ void operator()(const f32x4 (&acc)[2][2][4][2], const Unit& u, int wr, int wc, int fr, int fq) const {
        const int row0 = u.pm * BM + wr * 64 + fr; const int pn = u.pn;
        if (pn < 6) {
            const bool nrm = pn < 4; const float* gp = (pn < 2) ? gq : gk;
            f32x4 gn[2][2];
#pragma unroll
            for (int bj = 0; bj < 2; ++bj)
#pragma unroll
                for (int n = 0; n < 2; ++n) gn[bj][n] = nrm ? *(const f32x4*)(gp + 32 * bj + 8 * fq + 4 * n) : (f32x4){1.f, 1.f, 1.f, 1.f};
#pragma unroll
            for (int ai = 0; ai < 2; ++ai)
#pragma unroll
                for (int m = 0; m < 4; ++m) {
                    float sc = 1.f;
                    if (nrm) { float ss = 0.f;
#pragma unroll
                        for (int bj = 0; bj < 2; ++bj)
#pragma unroll
                            for (int n = 0; n < 2; ++n) { const f32x4 x = acc[ai][bj][m][n]; ss += (x[0] * x[0] + x[1] * x[1]) + (x[2] * x[2] + x[3] * x[3]); }
                        ss += __shfl_xor(ss, 16); ss += __shfl_xor(ss, 32);
                        sc = rsqrtf(ss * (1.0f / 64.0f) + eps); }
                    bf16_t* rowp = O + (size_t)(row0 + ai * HALF + m * 16) * 2048 + 256 * pn + 64 * wc + 8 * fq;
#pragma unroll
                    for (int bj = 0; bj < 2; ++bj) { const f32x4 v0 = acc[ai][bj][m][0] * gn[bj][0] * sc, v1 = acc[ai][bj][m][1] * gn[bj][1] * sc; *(u32x4*)(rowp + 32 * bj) = pack8(v0, v1); }
                }
        } else {
            const int cb = 1536 + 128 * (pn - 6) + 32 * wc + 8 * fq;
#pragma unroll
            for (int ai = 0; ai < 2; ++ai)
#pragma unroll
                for (int m = 0; m < 4; ++m) {
                    f32x4 v[2];
#pragma unroll
                    for (int n = 0; n < 2; ++n) { const f32x4 a = acc[ai][0][m][n], g = acc[ai][1][m][n]; v[n] = (f32x4){a[0] * sigm(g[0]), a[1] * sigm(g[1]), a[2] * sigm(g[2]), a[3] * sigm(g[3])}; }
                    *(u32x4*)(O + (size_t)(row0 + ai * HALF + m * 16) * 2048 + cb) = pack8(v[0], v[1]);
                }
        }
    }
};
struct EpiResid {
    typedef f32x4 acc_t; static constexpr bool PERM = false, AFTER_DRAIN = false;
    const float* baseL; const float* baseC; float* XL; float* XC; const float* gate;
    __device__ __forceinline__ void operator()(const f32x4 (&acc)[2][2][4][2], const Unit& u, int wr, int wc, int fr, int fq) const {
        const int R0 = u.pm * BM, row0 = R0 + wr * 64 + fr, col0 = u.pn * BM + wc * 32 + 4 * fq;
        const int modrow = R0 < ML_ ? (R0 >> 11) : 8;
        const float* gp = gate + (size_t)modrow * 6144 + col0;
        const float* bp = R0 < ML_ ? baseL : baseC - (size_t)ML_ * DM_;
        float* xo = R0 < ML_ ? XL : XC - (size_t)ML_ * DM_;
        f32x4 gv[2][2];
#pragma unroll
        for (int bj = 0; bj < 2; ++bj)
#pragma unroll
            for (int n = 0; n < 2; ++n) gv[bj][n] = *(const f32x4*)(gp + bj * HALF + n * 16);
#pragma unroll
        for (int ai = 0; ai < 2; ++ai)
#pragma unroll
            for (int m = 0; m < 4; ++m) { const size_t ro = (size_t)(row0 + ai * HALF + m * 16) * DM_ + col0;
#pragma unroll
                for (int bj = 0; bj < 2; ++bj)
#pragma unroll
                    for (int n = 0; n < 2; ++n) { const f32x4 xv = *(const f32x4*)(bp + ro + bj * HALF + n * 16); *(f32x4*)(xo + ro + bj * HALF + n * 16) = xv + gv[bj][n] * acc[ai][bj][m][n]; } }
    }
};
__device__ __forceinline__ void unpack8(const u32x4 w, f32x4& a, f32x4& b) {
    a = (f32x4){__builtin_bit_cast(float, w.x << 16), __builtin_bit_cast(float, w.x & 0xffff0000u), __builtin_bit_cast(float, w.y << 16), __builtin_bit_cast(float, w.y & 0xffff0000u)};
    b = (f32x4){__builtin_bit_cast(float, w.z << 16), __builtin_bit_cast(float, w.z & 0xffff0000u), __builtin_bit_cast(float, w.w << 16), __builtin_bit_cast(float, w.w & 0xffff0000u)}; }
template <bool BASE_F32> struct EpiResidN {
    typedef f32x4 acc_t; static constexpr bool PERM = true, AFTER_DRAIN = false;
    const void* baseL; const void* baseC; bf16_t* XL; bf16_t* XC; const float* gate; bf16_t* Hn; float* rowss; const float* ngain; const float* nscale;
    __device__ __forceinline__ void operator()(const f32x4 (&acc)[2][2][4][2], const Unit& u, int wr, int wc, int fr, int fq) const {
        const int R0 = u.pm * BM, row0 = R0 + wr * 64 + fr, col0 = u.pn * BM + wc * 32 + 8 * fq;
        const int modrow = R0 < ML_ ? (R0 >> 11) : 8, rsub = R0 < ML_ ? 0 : ML_;
        const float* gp = gate + (size_t)modrow * 6144 + col0; const float* sp = nscale + (size_t)modrow * 6144 + col0;
        const void* bp = R0 < ML_ ? baseL : baseC; bf16_t* xo = R0 < ML_ ? XL : XC;
        f32x4 gv[2][2], gs[2][2];
#pragma unroll
        for (int bj = 0; bj < 2; ++bj)
#pragma unroll
            for (int n = 0; n < 2; ++n) { gv[bj][n] = *(const f32x4*)(gp + bj * HALF + n * 4); gs[bj][n] = *(const f32x4*)(ngain + col0 + bj * HALF + n * 4) * (*(const f32x4*)(sp + bj * HALF + n * 4) + 1.0f); }
#pragma unroll
        for (int ai = 0; ai < 2; ++ai)
#pragma unroll
            for (int m = 0; m < 4; ++m) { const int row = row0 + ai * HALF + m * 16; const size_t ro = (size_t)(row - rsub) * DM_ + col0; float ss = 0.f;
#pragma unroll
                for (int bj = 0; bj < 2; ++bj) { f32x4 x0, x1;
                    if constexpr (BASE_F32) { x0 = *(const f32x4*)((const float*)bp + ro + bj * HALF); x1 = *(const f32x4*)((const float*)bp + ro + bj * HALF + 4); }
                    else unpack8(*(const u32x4*)((const bf16_t*)bp + ro + bj * HALF), x0, x1);
                    const u32x4 xw = pack8(x0 + gv[bj][0] * acc[ai][bj][m][0], x1 + gv[bj][1] * acc[ai][bj][m][1]); *(u32x4*)(xo + ro + bj * HALF) = xw;
                    f32x4 r0, r1; unpack8(xw, r0, r1);
                    ss += ((r0[0] * r0[0] + r0[1] * r0[1]) + (r0[2] * r0[2] + r0[3] * r0[3])) + ((r1[0] * r1[0] + r1[1] * r1[1]) + (r1[2] * r1[2] + r1[3] * r1[3]));
                    *(u32x4*)(Hn + (size_t)row * DM_ + col0 + bj * HALF) = pack8(r0 * gs[bj][0], r1 * gs[bj][1]); }
                ss += __shfl_xor(ss, 16); ss += __shfl_xor(ss, 32);
                if (fq == 0) rowss[(size_t)row * 16 + u.pn * 4 + wc] = ss; }
    }
};
__device__ __forceinline__ float row_rstd(const float* rowss, int row, float eps) {
    const f32x4* p = (const f32x4*)(rowss + (size_t)row * 16); const f32x4 a = p[0], b = p[1], c = p[2], d = p[3];
    const float s = (((a[0] + a[1]) + (a[2] + a[3])) + ((b[0] + b[1]) + (b[2] + b[3]))) + (((c[0] + c[1]) + (c[2] + c[3])) + ((d[0] + d[1]) + (d[2] + d[3])));
    return rsqrtf(s * (1.0f / 1024.0f) + eps); }
template <class Sched> __device__ __forceinline__ void rstd_prepass(const Sched& S, const float* rowss, PG8_LAS float* rt, float eps, int tid) {
    Unit u; int n = 0; while (n < 8 && S.next(n, u)) ++n;
#pragma unroll
    for (int q = 0; q < 4; ++q) { const int r = tid + 512 * q, i = r >> 8;
        if (i < n) { S.next(i, u); rt[r] = row_rstd(rowss, u.pm * BM + (r & 255), eps); } }
    __syncthreads();
}
struct EpiSwiGLUN {
    typedef f32x4 acc_t; static constexpr bool PERM = true, AFTER_DRAIN = false;
    bf16_t* O; int ldo; const PG8_LAS float* rt; const float* shw; int nphys;
    __device__ __forceinline__ void operator()(const f32x4 (&acc)[2][2][4][2], const Unit& u, int wr, int wc, int fr, int fq) const {
        const int R0 = u.pm * BM, row0 = R0 + wr * 64 + fr, colp = u.pn * BM + wc * 32 + 8 * fq, col0 = u.pn * HALF + wc * 32 + 8 * fq;
        const float* sp = shw + (size_t)(R0 < ML_ ? (R0 >> 11) : 8) * nphys + colp;
        f32x4 s1[2], s3[2];
#pragma unroll
        for (int n = 0; n < 2; ++n) { s1[n] = *(const f32x4*)(sp + 4 * n); s3[n] = *(const f32x4*)(sp + HALF + 4 * n); }
#pragma unroll
        for (int ai = 0; ai < 2; ++ai)
#pragma unroll
            for (int m = 0; m < 4; ++m) { const int row = row0 + ai * HALF + m * 16; const float rs = rt[u.idx * BM + (row - R0)];
                f32x4 v[2];
#pragma unroll
                for (int n = 0; n < 2; ++n) { const f32x4 a = acc[ai][0][m][n] * rs + s1[n], b = acc[ai][1][m][n] * rs + s3[n]; v[n] = (f32x4){a[0] * sigm(a[0]) * b[0], a[1] * sigm(a[1]) * b[1], a[2] * sigm(a[2]) * b[2], a[3] * sigm(a[3]) * b[3]}; }
                *(u32x4*)(O + (size_t)row * ldo + col0) = pack8(v[0], v[1]);
            }
    }
};
struct EpiSwiGLU {
    typedef f32x4 acc_t; static constexpr bool PERM = true, AFTER_DRAIN = false;
    bf16_t* O; int ldo, nN, row_sub; int skip;
    __device__ __forceinline__ void operator()(const f32x4 (&acc)[2][2][4][2], const Unit& u, int wr, int wc, int fr, int fq) const {
        if (skip) {
#pragma unroll
            for (int ai = 0; ai < 2; ++ai)
#pragma unroll
                for (int bj = 0; bj < 2; ++bj)
#pragma unroll
                    for (int m = 0; m < 4; ++m)
#pragma unroll
                        for (int n = 0; n < 2; ++n) asm volatile("" :: "v"(acc[ai][bj][m][n]));
            return; }
        const int row0 = u.pm * BM + wr * 64 + fr - row_sub, col0 = (u.pn % nN) * HALF + wc * 32 + 8 * fq;
#pragma unroll
        for (int ai = 0; ai < 2; ++ai)
#pragma unroll
            for (int m = 0; m < 4; ++m) {
                f32x4 v[2];
#pragma unroll
                for (int n = 0; n < 2; ++n) { const f32x4 a = acc[ai][0][m][n], b = acc[ai][1][m][n]; v[n] = (f32x4){a[0] * sigm(a[0]) * b[0], a[1] * sigm(a[1]) * b[1], a[2] * sigm(a[2]) * b[2], a[3] * sigm(a[3]) * b[3]}; }
                *(u32x4*)(O + (size_t)(row0 + ai * HALF + m * 16) * ldo + col0) = pack8(v[0], v[1]);
            }
    }
};
struct EpiSwiGLUq {
    typedef i32x4 acc_t; static constexpr bool PERM = true, AFTER_DRAIN = false;
    bf16_t* O; int ldo, nN; const float* posscale; const float* colscale;
    __device__ __forceinline__ void operator()(const i32x4 (&acc)[2][2][4][2], const Unit& u, int wr, int wc, int fr, int fq) const {
        const int row0 = u.pm * BM + wr * 64 + fr, col0 = (u.pn % nN) * HALF + wc * 32 + 8 * fq; const float* cp = colscale + (size_t)u.pn * BM + wc * 32 + 8 * fq;
        f32x4 c1[2], c3[2];
#pragma unroll
        for (int n = 0; n < 2; ++n) { c1[n] = *(const f32x4*)(cp + 4 * n); c3[n] = *(const f32x4*)(cp + HALF + 4 * n); }
#pragma unroll
        for (int ai = 0; ai < 2; ++ai)
#pragma unroll
            for (int m = 0; m < 4; ++m) { const int row = row0 + ai * HALF + m * 16; const float rs = posscale[row];
                f32x4 v[2];
#pragma unroll
                for (int n = 0; n < 2; ++n) { const i32x4 ia = acc[ai][0][m][n], ib = acc[ai][1][m][n];
                    const f32x4 a = (f32x4){(float)ia[0], (float)ia[1], (float)ia[2], (float)ia[3]} * c1[n] * rs, b = (f32x4){(float)ib[0], (float)ib[1], (float)ib[2], (float)ib[3]} * c3[n] * rs;
                    v[n] = (f32x4){a[0] * sigm(a[0]) * b[0], a[1] * sigm(a[1]) * b[1], a[2] * sigm(a[2]) * b[2], a[3] * sigm(a[3]) * b[3]}; }
                *(u32x4*)(O + (size_t)row * ldo + col0) = pack8(v[0], v[1]);
            }
    }
};
struct EpiGLURes {
    typedef f32x4 acc_t; static constexpr bool PERM = true, AFTER_DRAIN = false;
    bf16_t* X; const float* gate;
    __device__ __forceinline__ void operator()(const f32x4 (&acc)[2][2][4][2], const Unit& u, int wr, int wc, int fr, int fq) const {
        const int R0 = u.pm * BM, row0 = R0 + wr * 64 + fr, col0 = u.pn * HALF + wc * 32 + 8 * fq;
        const float* gp = gate + (size_t)(R0 >> 11) * 6144 + col0;
        f32x4 gv[2];
#pragma unroll
        for (int n = 0; n < 2; ++n) gv[n] = *(const f32x4*)(gp + n * 4);
#pragma unroll
        for (int ai = 0; ai < 2; ++ai)
#pragma unroll
            for (int m = 0; m < 4; ++m) { bf16_t* xp = X + (size_t)(row0 + ai * HALF + m * 16) * DM_ + col0; f32x4 x0, x1, y[2];
                unpack8(*(const u32x4*)xp, x0, x1);
#pragma unroll
                for (int n = 0; n < 2; ++n) { const f32x4 z1 = acc[ai][0][m][n], z2 = acc[ai][1][m][n]; y[n] = (f32x4){z1[0] * sigm(z2[0]), z1[1] * sigm(z2[1]), z1[2] * sigm(z2[2]), z1[3] * sigm(z2[3])}; }
                *(u32x4*)xp = pack8(x0 + gv[0] * y[0], x1 + gv[1] * y[1]); }
    }
};
struct EpiUC {
    typedef f32x4 acc_t; static constexpr bool PERM = true, AFTER_DRAIN = false;
    bf16_t* UC; const PG8_LAS float* rt; const float* shw;
    __device__ __forceinline__ void operator()(const f32x4 (&acc)[2][2][4][2], const Unit& u, int wr, int wc, int fr, int fq) const {
        const int R0 = u.pm * BM, row0 = R0 + wr * 64 + fr, col0 = u.pn * BM + wc * 32 + 8 * fq;
        const float* sp = shw + (size_t)(R0 < ML_ ? (R0 >> 11) : 8) * DM_ + col0;
        f32x4 sv[2][2];
#pragma unroll
        for (int bj = 0; bj < 2; ++bj)
#pragma unroll
            for (int n = 0; n < 2; ++n) sv[bj][n] = *(const f32x4*)(sp + bj * HALF + 4 * n);
#pragma unroll
        for (int ai = 0; ai < 2; ++ai)
#pragma unroll
            for (int m = 0; m < 4; ++m) { const int row = row0 + ai * HALF + m * 16; int bc, j; const float rs = rt[u.idx * BM + (row - R0)];
                if (row < ML_) { bc = (row >> 11) * 64 + ((row & 2047) >> 5); j = row & 31; } else { const int r2 = row - ML_; bc = 512 + (r2 >> 8) * 8 + ((r2 & 255) >> 5); j = r2 & 31; }
#pragma unroll
                for (int bj = 0; bj < 2; ++bj) { const int col = col0 + bj * HALF, g = col >> 4, qi = col & 15;
                    *(u32x4*)(UC + ((size_t)(g * 768 + bc) * 768 + j * 16 + qi)) = pack8(acc[ai][bj][m][0] * rs + sv[bj][0], acc[ai][bj][m][1] * rs + sv[bj][1]); } }
    }
};
struct EpiE {
    typedef f32x4 acc_t; static constexpr bool PERM = false, AFTER_DRAIN = false;
    float* E;
    __device__ __forceinline__ void operator()(const f32x4 (&acc)[2][2][4][2], const Unit& u, int wr, int wc, int fr, int fq) const {
        const int row0 = u.pm * BM + wr * 64 + fr, col0 = wc * 32 + 4 * fq;
#pragma unroll
        for (int ai = 0; ai < 2; ++ai)
#pragma unroll
            for (int m = 0; m < 4; ++m) { float* rp = E + (size_t)(row0 + ai * HALF + m * 16) * 256 + col0;
#pragma unroll
                for (int bj = 0; bj < 2; ++bj)
#pragma unroll
                    for (int n = 0; n < 2; ++n) *(f32x4*)(rp + bj * HALF + n * 16) = acc[ai][bj][m][n]; }
    }
};
struct EpiY {
    typedef f32x4 acc_t; static constexpr bool PERM = true, AFTER_DRAIN = false;
    bf16_t* Y;
    __device__ __forceinline__ void operator()(const f32x4 (&acc)[2][2][4][2], const Unit& u, int wr, int wc, int fr, int fq) const {
        const int g = u.pm / 3, pml = u.pm - 3 * g, pnl = u.pn & 1;
        const int bc0 = pml * BM + wr * 64 + fr, n0 = pnl * BM + wc * 32 + 8 * fq;
#pragma unroll
        for (int ai = 0; ai < 2; ++ai)
#pragma unroll
            for (int m = 0; m < 4; ++m) { const int bc = bc0 + ai * HALF + m * 16, tok0 = (bc >> 6) * 2048 + (bc & 63) * 32;
#pragma unroll
                for (int bj = 0; bj < 2; ++bj) { const int n = n0 + bj * HALF, tin = n >> 4, qo = n & 15; const f32x4 a = acc[ai][bj][m][0], b = acc[ai][bj][m][1];
                    const f32x4 ya = (f32x4){gelu_tanh(a[0]), gelu_tanh(a[1]), gelu_tanh(a[2]), gelu_tanh(a[3])}, yb = (f32x4){gelu_tanh(b[0]), gelu_tanh(b[1]), gelu_tanh(b[2]), gelu_tanh(b[3])};
                    *(u32x4*)(Y + (size_t)(tok0 + tin) * DM_ + g * 16 + qo) = pack8(ya, yb); } }
    }
};
struct EpiMoE2 {
    typedef f32x4 acc_t; static constexpr bool PERM = true, AFTER_DRAIN = false;
    bf16_t* Y2; const float* rowgate; const int* rowinfo;
    __device__ __forceinline__ void operator()(const f32x4 (&acc)[2][2][4][2], const Unit& u, int wr, int wc, int fr, int fq) const {
        const int row0 = u.pm * BM + wr * 64 + fr, col0 = (u.pn & 3) * BM + wc * 32 + 8 * fq;
#pragma unroll
        for (int ai = 0; ai < 2; ++ai)
#pragma unroll
            for (int m = 0; m < 4; ++m) { const int row = row0 + ai * HALF + m * 16; const float gt = rowgate[row]; const int ri = rowinfo[row];
                if (ri >= 0) {
#pragma unroll
                    for (int bj = 0; bj < 2; ++bj) *(u32x4*)(Y2 + (size_t)ri * DM_ + col0 + bj * HALF) = pack8(acc[ai][bj][m][0] * gt, acc[ai][bj][m][1] * gt); } }
    }
};
struct OrderS5E { int G, c;
    __device__ __forceinline__ bool next(int i, Unit& u) const {
        if (G == 256) { if (i > 0) return false; const int x = c & 7, j = c >> 3; if (j >= 24) return false; const int g = 8 * (j / 3) + x; u.pm = 3 * g + (j % 3); u.pn = g; u.k0 = 0; u.idx = i; return true; }
        const int L = i * G + c; if (L >= 192) return false; u.pm = L; u.pn = L / 3; u.k0 = 0; u.idx = i; return true; }
    __device__ __forceinline__ void a_ready(const Unit&) const {}
    __device__ __forceinline__ void done(const Unit&) const {} };
struct OrderS5Y { int G, c;
    __device__ __forceinline__ bool next(int i, Unit& u) const {
        if (G == 256) { if (i > 0) return false; const int x = c & 7, j = c >> 3, g = 8 * (j >> 2) + x; u.pm = 3 * g + ((j >> 1) & 1); u.pn = 2 * g + (j & 1); u.k0 = 0; u.idx = i; return true; }
        const int L = i * G + c; if (L >= 256) return false; const int g = L >> 2; u.pm = 3 * g + ((L >> 1) & 1); u.pn = 2 * g + (L & 1); u.k0 = 0; u.idx = i; return true; }
    __device__ __forceinline__ void a_ready(const Unit&) const {}
    __device__ __forceinline__ void done(const Unit&) const {} };
struct OrderMoE { int G, c, nN, tmax, fix; int toff[9];
    __device__ __forceinline__ bool next(int i, Unit& u) const {
        int pm, pnl; const int nt = toff[8] < tmax ? toff[8] : tmax;
        if (G == 256) {
            const int x = c & 7, j = c >> 3, nCB = nN >> 2, b = i * 8 + x, nRB = (nt + 7) >> 3; if (b >= nRB * nCB) return false;
            const int rb = b / nCB, cbk = b - rb * nCB; pm = 8 * rb + (j & 7); pnl = 4 * cbk + (j >> 3);
        } else { const int L = i * G + c; pm = L / nN; pnl = L - pm * nN; }
        if (pm >= nt) return false;
        int e = 0;
#pragma unroll
        for (int k = 1; k < 8; ++k) e += (pm >= toff[k]) ? 1 : 0;
        u.pm = fix ? 0 : pm; u.pn = fix ? pnl & 3 : e * nN + pnl; u.k0 = 0; u.idx = i; return true; }
    __device__ __forceinline__ void a_ready(const Unit&) const {}
    __device__ __forceinline__ void done(const Unit&) const {} };
struct OrderMoEx { int G, c; int toff[9];
    __device__ __forceinline__ bool next(int i, Unit& u) const {
        const int s = i * G + c, tl = s >> 4, pm = 128 + tl; if (pm >= toff[8]) return false;
        int e = 0;
#pragma unroll
        for (int k = 1; k < 8; ++k) e += (pm >= toff[k]) ? 1 : 0;
        u.pm = pm; u.pn = e * 4 + ((s >> 2) & 3); u.k0 = (s & 3) * 896; u.idx = i; return true; }
    __device__ __forceinline__ void a_ready(const Unit&) const {}
    __device__ __forceinline__ void done(const Unit&) const {} };
struct EpiMoE2x {
    typedef f32x4 acc_t; static constexpr bool PERM = false, AFTER_DRAIN = false;
    float* P; const float* rowgate;
    __device__ __forceinline__ void operator()(const f32x4 (&acc)[2][2][4][2], const Unit& u, int wr, int wc, int fr, int fq) const {
        const int ks = u.k0 / 896, tl = u.pm - 128, r0 = wr * 64 + fr, col0 = (u.pn & 3) * BM + wc * 32 + 4 * fq;
        float* pb = P + ((size_t)(ks * 8 + tl) * 256) * DM_;
        const __amdgpu_buffer_rsrc_t grs = __builtin_amdgcn_make_buffer_rsrc((void*)rowgate, 0, 136 * 256 * 4, 0x00020000);
#pragma unroll
        for (int ai = 0; ai < 2; ++ai)
#pragma unroll
            for (int m = 0; m < 4; ++m) { const int r = r0 + ai * HALF + m * 16; const float gt = __builtin_bit_cast(float, __builtin_amdgcn_raw_buffer_load_b32(grs, (u.pm * BM + r) * 4, 0, 0));
#pragma unroll
                for (int bj = 0; bj < 2; ++bj)
#pragma unroll
                    for (int n = 0; n < 2; ++n) *(f32x4*)(pb + (size_t)r * DM_ + col0 + bj * HALF + n * 16) = acc[ai][bj][m][n] * gt; }
    }
};
template <class Epi, class Sched, bool ALIGN_EPI = false, bool SP2 = false, bool GATHER = false>
__device__ __forceinline__ void gemm_phase(PG8_LAS unsigned char* lds, const Gemm g, const Sched& S, const Epi& E) {
    const int tid = threadIdx.x, wid = __builtin_amdgcn_readfirstlane(tid >> 6), lane = tid & 63, wr = wid >> 2, wc = wid & 3, fr = lane & 15, fq = lane >> 4;
    const int K = g.K, nt = K / BK;
    unsigned voffA[2], voffB[2]; int RA[2]; unsigned CA[2];
    static_assert(!GATHER || SP2, "the gathered A operand is wired into the SP2 loop only");
#pragma unroll
    for (int i = 0; i < 2; ++i) { int R, C; stage_rc(tid * 16 + i * 8192, R, C); const int Rb = Epi::PERM ? ((R & ~31) + perm32(R & 31)) : R;
        voffA[i] = (unsigned)(R * g.lda + C) * 2u; voffB[i] = (unsigned)(Rb * g.ldb + C) * 2u; RA[i] = R; CA[i] = (unsigned)C * 2u; }
    const size_t kstep = (size_t)(BK * 2);
    const size_t hstepA = (size_t)HALF * g.lda * 2, hstepB = (size_t)HALF * g.ldb * 2;
    const size_t tstepA = 2 * hstepA, tstepB = 2 * hstepB;
    const unsigned ldsw = (unsigned)wid * 1024u;
    const int aoff = lds_byte(wr * 64 + fr, fq * 8), boff = lds_byte(wc * 32 + fr, fq * 8);
#define PG8_SA(b, h) (((b) * 2 + (h)) * HTB)
#define PG8_SB(b, h) ((4 + (b) * 2 + (h)) * HTB)
#define PG8_STAGE(bufoff, gbase, voff) do { _Pragma("unroll") for (int _i = 0; _i < 2; ++_i) \
        __builtin_amdgcn_global_load_lds((const unsigned*)((const char*)(gbase) + (voff)[_i]), (PG8_LAS unsigned*)(lds + (bufoff) + ldsw + _i * 8192), 16, 0, 0); } while (0)
#define PG8_LDA(dst, b, h) do { _Pragma("unroll") for (int m = 0; m < 4; ++m) _Pragma("unroll") for (int k = 0; k < 2; ++k) dst[m][k] = *(const PG8_LAS bf16x8*)(lds + PG8_SA(b, h) + aoff + m * 2048 + k * 1024); } while (0)
#define PG8_LDB(dst, b, h) do { _Pragma("unroll") for (int n = 0; n < 2; ++n) _Pragma("unroll") for (int k = 0; k < 2; ++k) dst[n][k] = *(const PG8_LAS bf16x8*)(lds + PG8_SB(b, h) + boff + n * 2048 + k * 1024); } while (0)
#define PG8_MMA(ai, bj, At, Bt) do { __builtin_amdgcn_s_setprio(1); _Pragma("unroll") for (int m = 0; m < 4; ++m) _Pragma("unroll") for (int n = 0; n < 2; ++n) _Pragma("unroll") for (int k = 0; k < 2; ++k) \
        acc[ai][bj][m][n] = mma16(Bt[n][k], At[m][k], acc[ai][bj][m][n]); __builtin_amdgcn_s_setprio(0); } while (0)
#define PG8_WAIT_V(n) asm volatile("s_waitcnt vmcnt(" #n ")" ::: "memory")
#define PG8_WAIT_L(n) asm volatile("s_waitcnt lgkmcnt(" #n ")" ::: "memory")
#define PG8_BAR __builtin_amdgcn_s_barrier()
#define PG8_SCHED __builtin_amdgcn_sched_barrier(0)
#define PG8_GIDX(d0, d1, un) do { _Pragma("unroll") for (int _i = 0; _i < 2; ++_i) { const int* _rp = g.rowsrc + (un).pm * BM + RA[_i]; d0[_i] = (unsigned)_rp[0] * (unsigned)(g.lda * 2) + CA[_i]; d1[_i] = (unsigned)_rp[HALF] * (unsigned)(g.lda * 2) + CA[_i]; } } while (0)
    Unit cur, nxt; int ui = 0;
    if (!S.next(0, cur)) return;
    typedef typename Epi::acc_t acc_t;
    acc_t acc[2][2][4][2];
#pragma unroll
    for (int a = 0; a < 2; ++a)
#pragma unroll
        for (int b = 0; b < 2; ++b)
#pragma unroll
            for (int m = 0; m < 4; ++m)
#pragma unroll
                for (int n = 0; n < 2; ++n) acc[a][b][m][n] = (acc_t){0, 0, 0, 0};
    bf16x8 At[4][2], B0[2][2], B1[2][2];
    const char* cA = (const char*)g.A + (size_t)cur.pm * tstepA + (size_t)cur.k0 * 2; const char* cB = (const char*)g.Bt + (size_t)cur.pn * tstepB + (size_t)cur.k0 * 2;
    S.a_ready(cur);
    unsigned cv0[2] = {0u, 0u}, cv1[2] = {0u, 0u}, nv0[2] = {0u, 0u}, nv1[2] = {0u, 0u}; const char* gA = (const char*)g.A;
    if constexpr (GATHER) { PG8_GIDX(cv0, cv1, cur); nv0[0] = cv0[0]; nv0[1] = cv0[1]; nv1[0] = cv1[0]; nv1[1] = cv1[1]; }
    if constexpr (SP2) {
        PG8_STAGE(PG8_SB(0, 0), cB, voffB); PG8_STAGE(PG8_SB(0, 1), cB + hstepB, voffB);
        if constexpr (GATHER) { PG8_STAGE(PG8_SA(0, 0), gA, cv0); PG8_STAGE(PG8_SA(0, 1), gA, cv1); } else { PG8_STAGE(PG8_SA(0, 0), cA, voffA); PG8_STAGE(PG8_SA(0, 1), cA + hstepA, voffA); }
        if (wr == 1) PG8_BAR;
        PG8_WAIT_V(2); PG8_BAR;
        PG8_STAGE(PG8_SB(1, 0), cB + kstep, voffB); if constexpr (GATHER) PG8_STAGE(PG8_SA(1, 0), gA + kstep, cv0); else PG8_STAGE(PG8_SA(1, 0), cA + kstep, voffA); PG8_STAGE(PG8_SB(1, 1), cB + hstepB + kstep, voffB);
        PG8_WAIT_V(6); PG8_BAR;
    } else {
        PG8_STAGE(PG8_SB(0, 0), cB, voffB); PG8_STAGE(PG8_SA(0, 0), cA, voffA); PG8_STAGE(PG8_SB(0, 1), cB + hstepB, voffB); PG8_STAGE(PG8_SA(0, 1), cA + hstepA, voffA);
        if (wr == 1) PG8_BAR;
        PG8_WAIT_V(4); PG8_BAR;
        PG8_STAGE(PG8_SB(1, 0), cB + kstep, voffB); PG8_STAGE(PG8_SA(1, 0), cA + kstep, voffA); PG8_STAGE(PG8_SB(1, 1), cB + hstepB + kstep, voffB);
        PG8_WAIT_V(6); PG8_BAR;
    }
    for (;;) {
        const bool has_next = S.next(ui + 1, nxt);
        const char* nA = has_next ? (const char*)g.A + (size_t)nxt.pm * tstepA + (size_t)nxt.k0 * 2 : cA; const char* nB = has_next ? (const char*)g.Bt + (size_t)nxt.pn * tstepB + (size_t)nxt.k0 * 2 : cB;
        for (int t = 0; t < nt; t += 2) {
            const bool last = (t == nt - 2);
            const char* a1 = cA + (size_t)(t + 1) * kstep;
            const char* a2 = last ? nA : cA + (size_t)(t + 2) * kstep; const char* b2 = last ? nB : cB + (size_t)(t + 2) * kstep;
            const char* a3 = a2 + kstep; const char* b3 = b2 + kstep;
            if (last && has_next) S.a_ready(nxt);
            if constexpr (GATHER) { if (t == nt - 4 && has_next) PG8_GIDX(nv0, nv1, nxt); }
            const char* g1 = gA + (size_t)(t + 1) * kstep; const char* g2 = last ? gA : gA + (size_t)(t + 2) * kstep; const char* g3 = g2 + kstep;
            unsigned x0[2], x1[2]; x0[0] = last ? nv0[0] : cv0[0]; x0[1] = last ? nv0[1] : cv0[1]; x1[0] = last ? nv1[0] : cv1[0]; x1[1] = last ? nv1[1] : cv1[1];
            if constexpr (SP2) {
            PG8_LDB(B0, 0, 0); PG8_LDB(B1, 0, 1); PG8_SCHED; PG8_LDA(At, 0, 0); if constexpr (GATHER) PG8_STAGE(PG8_SA(1, 1), g1, cv1); else PG8_STAGE(PG8_SA(1, 1), a1 + hstepA, voffA);
            PG8_WAIT_V(8); PG8_WAIT_L(0); PG8_BAR; PG8_MMA(0, 0, At, B0); PG8_MMA(0, 1, At, B1); PG8_BAR; PG8_SCHED;
            PG8_LDA(At, 0, 1); PG8_STAGE(PG8_SB(0, 0), b2, voffB); PG8_STAGE(PG8_SB(0, 1), b2 + hstepB, voffB); if constexpr (GATHER) PG8_STAGE(PG8_SA(0, 0), g2, x0); else PG8_STAGE(PG8_SA(0, 0), a2, voffA);
            PG8_WAIT_V(8); PG8_WAIT_L(0); PG8_BAR; PG8_MMA(1, 0, At, B0); PG8_MMA(1, 1, At, B1); PG8_BAR; PG8_SCHED;
            PG8_LDB(B0, 1, 0); PG8_LDB(B1, 1, 1); PG8_SCHED; PG8_LDA(At, 1, 0); if constexpr (GATHER) PG8_STAGE(PG8_SA(0, 1), g2, x1); else PG8_STAGE(PG8_SA(0, 1), a2 + hstepA, voffA);
            PG8_WAIT_V(8); PG8_WAIT_L(0); PG8_BAR; PG8_MMA(0, 0, At, B0); PG8_MMA(0, 1, At, B1); PG8_BAR; PG8_SCHED;
            PG8_LDA(At, 1, 1); PG8_STAGE(PG8_SB(1, 0), b3, voffB); PG8_STAGE(PG8_SB(1, 1), b3 + hstepB, voffB); if constexpr (GATHER) PG8_STAGE(PG8_SA(1, 0), g3, x0); else PG8_STAGE(PG8_SA(1, 0), a3, voffA);
            PG8_WAIT_V(8); PG8_WAIT_L(0); PG8_BAR; PG8_MMA(1, 0, At, B0); PG8_MMA(1, 1, At, B1); PG8_BAR; PG8_SCHED;
            } else {
            PG8_LDB(B0, 0, 0); PG8_SCHED; PG8_LDA(At, 0, 0); PG8_STAGE(PG8_SA(1, 1), a1 + hstepA, voffA);
            PG8_WAIT_L(8); PG8_BAR; PG8_WAIT_L(0); PG8_MMA(0, 0, At, B0); PG8_BAR; PG8_SCHED;
            PG8_LDB(B1, 0, 1); PG8_STAGE(PG8_SB(0, 0), b2, voffB);
            PG8_BAR; PG8_WAIT_L(0); PG8_MMA(0, 1, At, B1); PG8_BAR;
            PG8_LDA(At, 0, 1); PG8_STAGE(PG8_SA(0, 0), a2, voffA);
            PG8_BAR; PG8_WAIT_L(0); PG8_MMA(1, 0, At, B0); PG8_BAR; PG8_SCHED;
            PG8_STAGE(PG8_SB(0, 1), b2 + hstepB, voffB);
            PG8_WAIT_V(6); PG8_BAR; PG8_MMA(1, 1, At, B1); PG8_BAR;
            PG8_LDB(B0, 1, 0); PG8_SCHED; PG8_LDA(At, 1, 0); PG8_STAGE(PG8_SA(0, 1), a2 + hstepA, voffA);
            PG8_WAIT_L(8); PG8_BAR; PG8_WAIT_L(0); PG8_MMA(0, 0, At, B0); PG8_BAR; PG8_SCHED;
            PG8_LDB(B1, 1, 1); PG8_STAGE(PG8_SB(1, 0), b3, voffB);
            PG8_BAR; PG8_WAIT_L(0); PG8_MMA(0, 1, At, B1); PG8_BAR;
            PG8_LDA(At, 1, 1); PG8_STAGE(PG8_SA(1, 0), a3, voffA);
            PG8_BAR; PG8_WAIT_L(0); PG8_MMA(1, 0, At, B0); PG8_BAR; PG8_SCHED;
            PG8_STAGE(PG8_SB(1, 1), b3 + hstepB, voffB);
            PG8_WAIT_V(6); PG8_BAR; PG8_MMA(1, 1, At, B1); PG8_BAR;
            }
        }
        if constexpr (ALIGN_EPI) { if (wr == 0) PG8_BAR; }
        if constexpr (!Epi::AFTER_DRAIN) { E(acc, cur, wr, wc, fr, fq); S.done(cur); }
        if (!has_next) break;
#pragma unroll
        for (int a = 0; a < 2; ++a)
#pragma unroll
            for (int b = 0; b < 2; ++b)
#pragma unroll
                for (int m = 0; m < 4; ++m)
#pragma unroll
                    for (int n = 0; n < 2; ++n) acc[a][b][m][n] = (acc_t){0, 0, 0, 0};
        cur = nxt; cA = nA; cB = nB; ++ui;
        if constexpr (GATHER) { cv0[0] = nv0[0]; cv0[1] = nv0[1]; cv1[0] = nv1[0]; cv1[1] = nv1[1]; }
        if constexpr (ALIGN_EPI) { if (wr == 1) PG8_BAR; }
    }
    PG8_WAIT_V(0);
    if constexpr (!ALIGN_EPI) { if (wr == 0) PG8_BAR; }
    PG8_BAR;
    if constexpr (Epi::AFTER_DRAIN) { E.fused(acc, cur, wr, wc, fr, fq, lds, wid, lane); S.done(cur); }
#undef PG8_SA
#undef PG8_SB
#undef PG8_STAGE
#undef PG8_LDA
#undef PG8_LDB
#undef PG8_MMA
#undef PG8_WAIT_V
#undef PG8_WAIT_L
#undef PG8_BAR
#undef PG8_SCHED
#undef PG8_GIDX
}
}

constexpr int NB = 8, SEQ = 2048, NCTX = 256, D = 1024;
constexpr int ML = NB * SEQ, MC = NB * NCTX, MT = ML + MC;
constexpr int MIXIN = 2560, FFN = 2816, NE = 8, ED = 3584;
constexpr float EPS = 1e-6f;
constexpr int NWAVES = 8;
constexpr int MOE_TILES = 136;

constexpr size_t MiB = 1u << 20;
constexpr size_t WS_CTL = 0, CTL_ZERO_BYTES = 65536;
constexpr size_t WS_MOD = 65536, WS_MODP = 1 * MiB; constexpr int MOD_N = 2 * 9 * 6144;
constexpr size_t WS_ROWSS = 3 * MiB, WS_SHW13 = 4608 * 1024, WS_SHWS = WS_SHW13 + 9 * 5632 * 4;
constexpr size_t WS_ROWSC = 2800 * 1024, WS_POSSC = 2864 * 1024, WS_COLMAX = 4864 * 1024, WS_COLSC = WS_COLMAX;
constexpr size_t WS_TOK = 5 * MiB;
constexpr size_t TOK_E = 0, TOK_W = 128 * 1024, TOK_RANK = 256 * 1024, TOK_POS = 384 * 1024, TOK_WGBASE = 512 * 1024, TOK_ROWGATE = 576 * 1024, TOK_ROWSRC = 720 * 1024, TOK_ROWINFO = 864 * 1024;
constexpr size_t WS_MW13 = 6 * MiB, WS_MW2 = 118 * MiB;
constexpr size_t WS_XL = 174 * MiB, WS_H = 238 * MiB, WS_XC = 274 * MiB;
constexpr size_t WS_WIN = 282 * MiB, WS_WOUT = 287 * MiB, WS_W13 = 289 * MiB, WS_W2 = 300 * MiB, WS_SIN = 306 * MiB, WS_SOUT = 308 * MiB;
constexpr size_t WS_BTOUT = 312 * MiB, WS_WEND = 360 * MiB, WS_R = 376 * MiB, WS_END = 512 * MiB;
constexpr size_t WS_QKVU = WS_R, WS_MIX = WS_R + 72 * MiB, WS_ACT = WS_R;
constexpr size_t WS_UC = WS_R, WS_E = WS_R + 72 * MiB, WS_Y = WS_R + 72 * MiB;
constexpr size_t WS_PX = WS_H;
constexpr size_t WS_ACTM = 274 * MiB;
static_assert(WS_ACTM + (size_t)MOE_TILES * 256 * ED * 2 <= WS_END && WS_XC + (size_t)MC * D * 4 <= WS_WIN && WS_H + (size_t)MT * D * 2 <= WS_XC && WS_MW2 + (size_t)NE * D * ED * 2 <= WS_XL, "d_ws map");
constexpr int CW_TMO = 0, CW_CODE = 1, CW_BAR = 4096, CW_GCNT = 8192;

constexpr int RING_OFF = 0, RING_BYTES = 131072;
constexpr int LDSCTL_OFF = 155648, MISC_OFF = LDSCTL_OFF + 320;
constexpr int LDS_BYTES = 159744;
static_assert(MISC_OFF + 128 <= LDS_BYTES, "LDS map");

#define GAS __attribute__((address_space(1)))
#define LAS __attribute__((address_space(3)))
typedef unsigned short bf16;
typedef unsigned v4u __attribute__((ext_vector_type(4)));
typedef unsigned v2u __attribute__((ext_vector_type(2)));
typedef float f32x4 __attribute__((ext_vector_type(4)));
typedef float f32x2 __attribute__((ext_vector_type(2)));
typedef float f32x16 __attribute__((ext_vector_type(16)));
typedef short bf16x8 __attribute__((ext_vector_type(8)));
typedef GAS unsigned gu32;
#define RLX_AGENT __ATOMIC_RELAXED, __HIP_MEMORY_SCOPE_AGENT
#define LDS_WAIT() asm volatile("s_waitcnt lgkmcnt(0)" ::: "memory")
#define VM_WAIT() asm volatile("s_waitcnt vmcnt(0)" ::: "memory")
__device__ __forceinline__ unsigned f2bf(float f) { unsigned u = __builtin_bit_cast(unsigned, f); return (u + 0x7fffu + ((u >> 16) & 1u)) >> 16; }
__device__ __forceinline__ unsigned pk2(float lo, float hi) { return f2bf(lo) | (f2bf(hi) << 16); }
__device__ __forceinline__ float bf2f(unsigned short h) { return __builtin_bit_cast(float, (unsigned)h << 16); }
__device__ __forceinline__ float bflo(unsigned w) { return __builtin_bit_cast(float, w << 16); }
__device__ __forceinline__ float bfhi(unsigned w) { return __builtin_bit_cast(float, w & 0xffff0000u); }
__device__ __forceinline__ float sigm(float x) { return __builtin_amdgcn_rcpf(1.0f + __expf(-x)); }
__device__ __forceinline__ float wave_sum(float v) {
#pragma unroll
    for (int o = 1; o < 64; o <<= 1) v += __shfl_xor(v, o);
    return v;
}
__device__ __forceinline__ float wave_max(float v) {
#pragma unroll
    for (int o = 1; o < 64; o <<= 1) v = fmaxf(v, __shfl_xor(v, o));
    return v;
}
#define XB_TMO      128
#define XB_XCNT(j)  (256  + 64 * (j))
#define XB_XSUB(j)  (1280 + 64 * (j))
#define XB_XGEN(j)  (2304 + 64 * (j))
#define XB_TOP      3328
#define XB_TOPGEN   3392
#define XCD_BAR_WORDS 3456
#define XB_SPIN_CAP (1u << 18)

__device__ __forceinline__ unsigned xb_ld(unsigned* p)              { return __hip_atomic_load(p, __ATOMIC_RELAXED, __HIP_MEMORY_SCOPE_AGENT); }
__device__ __forceinline__ unsigned xb_add(unsigned* p, unsigned v) { return __hip_atomic_fetch_add(p, v, __ATOMIC_RELAXED, __HIP_MEMORY_SCOPE_AGENT); }
__device__ __forceinline__ unsigned xb_xcc_id() { return (unsigned)__builtin_amdgcn_s_getreg((3 << 11) | 20) & 0xFu; }
#define XB_SPIN(cond, bar) do { unsigned _sp = 0; while (cond) { __builtin_amdgcn_s_sleep(1); \
    if ((++_sp & 255u) == 0u) { if (xb_ld(&(bar)[XB_TMO])) break; if (_sp > XB_SPIN_CAP) { atomicAdd(&(bar)[XB_TMO], 1u); break; } } } } while (0)

struct XcdBarrier {
    unsigned* bar; unsigned x;
    volatile LAS unsigned* st;
};

__device__ __forceinline__ XcdBarrier xcd_barrier_post(unsigned* bar, volatile LAS unsigned* st) {
    XcdBarrier b; b.bar = bar; b.x = xb_xcc_id(); b.st = st;
    if (threadIdx.x == 0) (void)xb_add(&bar[XB_XCNT(b.x)], 1u);
    return b;
}
__device__ __forceinline__ void xcd_barrier_complete(unsigned* bar, unsigned x, unsigned& nloc, unsigned& nx) {
    const unsigned G = gridDim.x * gridDim.y * gridDim.z;
    unsigned sum, cnt, mine, sp = 0u;
    for (;;) {
        sum = 0u; cnt = 0u; mine = 0u;
#pragma unroll
        for (unsigned j = 0; j < 16; ++j) { const unsigned c = xb_ld(&bar[XB_XCNT(j)]); sum += c; cnt += (c > 0u) ? 1u : 0u; mine = (j == x) ? c : mine; }
        if (sum == G) break;
        __builtin_amdgcn_s_sleep(1);
        if ((++sp & 255u) == 0u) { if (xb_ld(&bar[XB_TMO])) break; if (sp > XB_SPIN_CAP) { atomicAdd(&bar[XB_TMO], 1u); break; } }
    }
    nloc = mine > 0u ? mine : 1u; nx = cnt > 0u ? cnt : 1u;
}

__device__ __forceinline__ void xcd_barrier(const XcdBarrier& b) {
    asm volatile("s_waitcnt vmcnt(0)" ::: "memory");
    __syncthreads();
    if (threadIdx.x == 0) {
        unsigned* bar = b.bar;
        __builtin_amdgcn_s_waitcnt(0);
        unsigned nloc = b.st[0], nx = b.st[1];
        if (nloc == 0u) { xcd_barrier_complete(bar, b.x, nloc, nx); b.st[0] = nloc; b.st[1] = nx; }
        const unsigned old = xb_add(&bar[XB_XSUB(b.x)], 1u);
        const unsigned gen = old / nloc;
        if (old + 1u == (gen + 1u) * nloc) {
            __builtin_amdgcn_fence(__ATOMIC_RELEASE, "agent");
            asm volatile("s_waitcnt vmcnt(0)" ::: "memory");
            const unsigned og = xb_add(&bar[XB_TOP], 1u);
            const unsigned tg = og / nx;
            if (og + 1u == (tg + 1u) * nx) xb_add(&bar[XB_TOPGEN], 1u);
            else XB_SPIN(xb_ld(&bar[XB_TOPGEN]) == tg, bar);
            __builtin_amdgcn_fence(__ATOMIC_ACQUIRE, "agent");
            xb_add(&bar[XB_XGEN(b.x)], 1u);
            asm volatile("s_waitcnt vmcnt(0)" ::: "memory");
        } else {
            XB_SPIN(xb_ld(&bar[XB_XGEN(b.x)]) == gen, bar);
            __builtin_amdgcn_fence(__ATOMIC_ACQUIRE, "agent");
            asm volatile("s_waitcnt vmcnt(0)" ::: "memory");
        }
    }
    __syncthreads();
}
enum { I_X = 0, I_C, I_CTX, I_CCTX, I_ADAW, I_ADAB, I_N1G, I_N2G, I_MIXWIN, I_QG, I_KG, I_RPB, I_DWW, I_DWB, I_LNG, I_LNB, I_MIXWOUT, I_FW1, I_FW3, I_FW2,
       I_SWIN, I_ARE, I_AIM, I_LOGDT, I_BRE, I_BIM, I_CRE, I_CIM, I_SD, I_SWOUT, I_ROUTER, I_MW1, I_MW3, I_MW2, N_IN };
struct Args { const float* in[N_IN]; float* out; unsigned char* ws; int ph_lo, ph_hi, sub, pad; };

typedef short s16x4 __attribute__((ext_vector_type(4)));
typedef float f32x2_t __attribute__((ext_vector_type(2)));
typedef __bf16 bf16x2_t __attribute__((ext_vector_type(2)));
__device__ __forceinline__ unsigned cvtpk(float lo, float hi) { const f32x2_t v = {lo, hi}; const bf16x2_t b = __builtin_convertvector(v, bf16x2_t); return __builtin_bit_cast(unsigned, b); }
__device__ __forceinline__ s16x4 vtr(const LAS unsigned char* p) { return __builtin_bit_cast(s16x4, __builtin_amdgcn_ds_read_tr16_b64_v4i16((LAS s16x4*)p)); }
__device__ __forceinline__ void p0_adaln(const Args& A, int unit, LAS unsigned char* lds, int tid, int wave, int lane) {
    const int l = unit / 96, rem = unit % 96, cb = rem >> 2, kq = rem & 3;
    LAS float* sc = (LAS float*)lds;
    LAS float* part = sc + 9 * 256;
    const float* c = A.in[I_C]; const float* cc = A.in[I_CCTX];
    for (int i = tid; i < 9 * 256; i += NWAVES * 64) { const int r = i >> 8, k = 256 * kq + (i & 255); const float v = r < 8 ? c[r * 1024 + k] : cc[k]; sc[i] = v * sigm(v); }
    __syncthreads();
    const float* wp = A.in[I_ADAW] + (size_t)l * 1024 * 6144 + (size_t)(256 * kq + 32 * wave) * 6144 + 256 * cb + 4 * lane;
    float acc[9][4];
#pragma unroll
    for (int r = 0; r < 9; ++r)
#pragma unroll
        for (int j = 0; j < 4; ++j) acc[r][j] = 0.f;
#pragma unroll 8
    for (int it = 0; it < 32; ++it) {
        const f32x4 wv = *(const f32x4*)(wp + (size_t)it * 6144); const int k = 32 * wave + it;
#pragma unroll
        for (int r = 0; r < 9; ++r) { const float s = sc[r * 256 + k];
#pragma unroll
            for (int j = 0; j < 4; ++j) acc[r][j] += s * wv[j]; }
    }
#pragma unroll
    for (int r = 0; r < 9; ++r) *(LAS f32x4*)(part + (wave * 9 + r) * 256 + 4 * lane) = (f32x4){acc[r][0], acc[r][1], acc[r][2], acc[r][3]};
    __syncthreads();
    float* modp = (float*)(A.ws + WS_MODP) + (size_t)kq * MOD_N;
    for (int i = tid; i < 9 * 256; i += NWAVES * 64) { const int r = i >> 8, col = i & 255; float s = 0.f;
#pragma unroll
        for (int w = 0; w < 8; ++w) s += part[(w * 9 + r) * 256 + col];
        if (kq == 0) s += A.in[I_ADAB][l * 6144 + 256 * cb + col];
        modp[((size_t)l * 9 + r) * 6144 + 256 * cb + col] = s; }
    __syncthreads();
}
constexpr int KTS = 260;
__device__ __forceinline__ void p0_s5gen(const Args& A, int g, int part, LAS unsigned char* lds, int tid) {
    LAS f32x2* POW = (LAS f32x2*)lds;
    LAS float* BBr = (LAS float*)(POW + 2 * 64 * 33 + 8);
    LAS float* BBi = BBr + 2 * 64 * 16;
    LAS f32x2* CC = (LAS f32x2*)(BBi + 2 * 64 * 16);
    LAS f32x2* CT = CC + 2 * 16 * 66 + 8;
    LAS float* KT = (LAS float*)(CT + 2 * 64 * 16);
    LAS f32x2* FF = (LAS f32x2*)(KT + 63 * KTS);
#define PWI(d_, p_, m_) (((d_) * 64 + (p_)) * 33 + (m_) + ((p_) >> 5) + (d_) * 4)
#define CCI(d_, q_, p_) (((d_) * 16 + (q_)) * 66 + (p_) + ((p_) >> 5) + (d_) * 4)
    if (tid < 128) { const int d = tid >> 6, p = tid & 63, ix = (d * 64 + g) * 64 + p;
        const float ar = A.in[I_ARE][ix], ai = A.in[I_AIM][ix], dt = __expf(A.in[I_LOGDT][d * 64 + g]);
        const float zr = ar * dt, zi = ai * dt, mag = __expf(zr); const float lr = mag * cosf(zi), li = mag * sinf(zi);
        float pr = 1.f, pi = 0.f;
        for (int m = 0; m <= 32; ++m) { POW[PWI(d, p, m)] = (f32x2){pr, pi}; const float nr = pr * lr - pi * li, ni = pr * li + pi * lr; pr = nr; pi = ni; }
        const float nr = lr - 1.f, ni = li, den = 1.f / (ar * ar + ai * ai);
        FF[d * 64 + p] = (f32x2){(nr * ar + ni * ai) * den, (ni * ar - nr * ai) * den}; }
    __syncthreads();
    for (int i = tid; i < 2048; i += NWAVES * 64) { const int d = i >> 10, p = (i >> 4) & 63, q = i & 15; const int ix = ((d * 64 + g) * 64 + p) * 16 + q;
        const float br = A.in[I_BRE][ix], bi = A.in[I_BIM][ix]; const f32x2 f = FF[d * 64 + p];
        BBr[(d * 64 + p) * 16 + q] = f.x * br - f.y * bi; BBi[(d * 64 + p) * 16 + q] = f.x * bi + f.y * br; }
    for (int i = tid; i < 2048; i += NWAVES * 64) { const int d = i >> 10, q = (i >> 6) & 15, p = i & 63; const int ix = ((d * 64 + g) * 16 + q) * 64 + p;
        const f32x2 cv2 = (f32x2){A.in[I_CRE][ix], A.in[I_CIM][ix]}; CC[CCI(d, q, p)] = cv2; CT[(d * 64 + p) * 16 + q] = cv2; }
    __syncthreads();
    bf16* BtOut = (bf16*)(A.ws + WS_BTOUT) + (size_t)g * 512 * 768;
    bf16* WEnd = (bf16*)(A.ws + WS_WEND) + (size_t)g * 256 * 512;
    if (part == 0) {
#pragma unroll 1
    for (int d = 0; d < 2; ++d) {
        const int dl = tid >> 4, qo = tid & 15; float acc[16];
#pragma unroll
        for (int i = 0; i < 16; ++i) acc[i] = 0.f;
#pragma unroll 2
        for (int p = 0; p < 64; ++p) { const f32x2 c = CT[(d * 64 + p) * 16 + qo], w = POW[PWI(d, p, dl)]; const float tr = c.x * w.x - c.y * w.y, ti = c.x * w.y + c.y * w.x;
            const LAS f32x4* br = (const LAS f32x4*)(BBr + (d * 64 + p) * 16); const LAS f32x4* bi = (const LAS f32x4*)(BBi + (d * 64 + p) * 16);
#pragma unroll
            for (int q4 = 0; q4 < 4; ++q4) { const f32x4 r4 = br[q4], i4 = bi[q4];
#pragma unroll
                for (int j = 0; j < 4; ++j) acc[4 * q4 + j] += tr * r4[j] - ti * i4[j]; } }
        if (d == 0) {
            { const float dsk = (dl == 0) ? A.in[I_SD][g * 16 + qo] : 0.f;
#pragma unroll
              for (int i = 0; i < 16; ++i) acc[i] += (i == qo) ? dsk : 0.f; }
#pragma unroll
            for (int i = 0; i < 4; ++i) *(LAS f32x4*)(KT + (31 + dl) * KTS + qo * 16 + 4 * i) = (f32x4){acc[4 * i], acc[4 * i + 1], acc[4 * i + 2], acc[4 * i + 3]};
        } else {
#pragma unroll
            for (int i = 0; i < 4; ++i) { LAS f32x4* kp = (LAS f32x4*)(KT + (31 - dl) * KTS + qo * 16 + 4 * i); f32x4 v = (f32x4){acc[4 * i], acc[4 * i + 1], acc[4 * i + 2], acc[4 * i + 3]}; if (dl == 0) v = v + *kp; *kp = v; }
        }
        __syncthreads();
    }
    for (int pc = tid; pc < 512 * 64; pc += NWAVES * 64) {
        const int n = pc >> 6, kp = pc & 63, t = n >> 4, qo = n & 15, j = kp >> 1, qi0 = (kp & 1) * 8; const LAS float* s = KT + (t - j + 31) * KTS + qo * 16 + qi0;
        const f32x4 s0 = *(const LAS f32x4*)s, s1 = *(const LAS f32x4*)(s + 4);
        v4u o; o.x = cvtpk(s0.x, s0.y); o.y = cvtpk(s0.z, s0.w); o.z = cvtpk(s1.x, s1.y); o.w = cvtpk(s1.z, s1.w);
        *(v4u*)(BtOut + (size_t)n * 768 + kp * 8) = o; }
    } else {
    for (int pc = tid; pc < 512 * 32; pc += NWAVES * 64) {
        const int n = pc >> 5, kp = pc & 31, t = n >> 4, qo = n & 15, d = kp >> 4, ri = (kp >> 3) & 1, p0 = (kp & 7) * 8, m = d == 0 ? t + 1 : 32 - t; float v[8];
#pragma unroll
        for (int i = 0; i < 8; ++i) { const f32x2 c = CC[CCI(d, qo, p0 + i)], w = POW[PWI(d, p0 + i, m)]; v[i] = ri == 0 ? (c.x * w.x - c.y * w.y) : -(c.x * w.y + c.y * w.x); }
        v4u o; o.x = cvtpk(v[0], v[1]); o.y = cvtpk(v[2], v[3]); o.z = cvtpk(v[4], v[5]); o.w = cvtpk(v[6], v[7]);
        *(v4u*)(BtOut + (size_t)n * 768 + 512 + kp * 8) = o; }
    for (int pc = tid; pc < 256 * 64; pc += NWAVES * 64) {
        const int n = pc >> 6, kp = pc & 63, d = n >> 7, ri = (n >> 6) & 1, p = n & 63, j = kp >> 1, qi0 = (kp & 1) * 8, m = d == 0 ? 31 - j : j; const f32x2 w = POW[PWI(d, p, m)]; float v[8];
#pragma unroll
        for (int i = 0; i < 8; ++i) { const float br = BBr[(d * 64 + p) * 16 + qi0 + i], bi = BBi[(d * 64 + p) * 16 + qi0 + i]; v[i] = ri == 0 ? (w.x * br - w.y * bi) : (w.x * bi + w.y * br); }
        v4u o; o.x = cvtpk(v[0], v[1]); o.y = cvtpk(v[2], v[3]); o.z = cvtpk(v[4], v[5]); o.w = cvtpk(v[6], v[7]);
        *(v4u*)(WEnd + (size_t)n * 512 + kp * 8) = o; }
    }
    __syncthreads();
#undef PWI
#undef CCI
}
__device__ __forceinline__ void cvt_item(const float* W, int K, int N, int ldw, bf16* WT, int mode, int item, LAS float* scr, int lane, unsigned* colmax = nullptr) {
    const int nblk = N / 32, kb = item / nblk, nb = item - kb * nblk, k0 = 64 * kb, n0 = 32 * nb;
    int r0 = n0;
    if (mode == 1) r0 = 256 * (n0 >> 7) + (n0 & 127);
    else if (mode == 2) r0 = 256 * (n0 >> 7) + 128 + (n0 & 127);
    else if (mode == 3) { if (n0 < 1536) { const int pn = n0 >> 8, rem = n0 & 255; r0 = 256 * pn + 128 * ((rem & 63) >> 5) + 32 * (rem >> 6); }
                          else if (n0 < 2048) { const int n1 = n0 - 1536; r0 = 256 * (6 + (n1 >> 7)) + (n1 & 127); }
                          else { const int n1 = n0 - 2048; r0 = 256 * (6 + (n1 >> 7)) + 128 + (n1 & 127); } }
    { f32x4 v[8];
#pragma unroll
      for (int i = 0; i < 8; ++i) v[i] = *(const f32x4*)(W + (size_t)(k0 + 8 * i + (lane >> 3)) * ldw + n0 + 4 * (lane & 7));
#pragma unroll
      for (int i = 0; i < 8; ++i) { LAS float* d = scr + (8 * i + (lane >> 3)) * 33 + 4 * (lane & 7); d[0] = v[i].x; d[1] = v[i].y; d[2] = v[i].z; d[3] = v[i].w; } }
    LDS_WAIT(); asm volatile("" ::: "memory");
    const int c = lane & 7;
#pragma unroll
    for (int j = 0; j < 4; ++j) { const int n = (lane >> 3) + 8 * j; const LAS float* s = scr + (8 * c) * 33 + n;
        v4u o; o.x = cvtpk(s[0 * 33], s[1 * 33]); o.y = cvtpk(s[2 * 33], s[3 * 33]); o.z = cvtpk(s[4 * 33], s[5 * 33]); o.w = cvtpk(s[6 * 33], s[7 * 33]);
        *(GAS v4u*)(WT + (size_t)(r0 + n) * K + k0 + 8 * c) = o;
        if (colmax) { float mx = fmaxf(fmaxf(fmaxf(fabsf(s[0 * 33]), fabsf(s[1 * 33])), fmaxf(fabsf(s[2 * 33]), fabsf(s[3 * 33]))), fmaxf(fmaxf(fabsf(s[4 * 33]), fabsf(s[5 * 33])), fmaxf(fabsf(s[6 * 33]), fabsf(s[7 * 33]))));
            mx = fmaxf(mx, __shfl_xor(mx, 1)); mx = fmaxf(mx, __shfl_xor(mx, 2)); mx = fmaxf(mx, __shfl_xor(mx, 4));
            if (c == 0) __hip_atomic_fetch_max(colmax + r0 + n, __builtin_bit_cast(unsigned, mx), RLX_AGENT); } }
    LDS_WAIT(); asm volatile("" ::: "memory");
}
constexpr int CV_IM = 16 * 112, CV_IM2 = 56 * 32, CV_NMOE = NE * (2 * CV_IM + CV_IM2);
__device__ __forceinline__ void p0_convert(const Args& A, LAS unsigned char* lds, int gw, int NGW, int wave, int lane) {
    LAS float* scr = (LAS float*)(lds + wave * 16384);
    unsigned char* ws = A.ws;
    constexpr int I0 = 16 * 80, I1 = 16 * 32, I2 = 16 * 88, I3 = 44 * 32, I4 = 16 * 32, I5 = 16 * 32;
    constexpr int NSMALL = I0 + I1 + 2 * I2 + I3 + I4 + 2 * I5;
    for (int it = gw; it < NSMALL; it += NGW) {
        int r = it;
        if (r < I0) { cvt_item(A.in[I_MIXWIN], D, MIXIN, MIXIN, (bf16*)(ws + WS_WIN), 3, r, scr, lane); continue; } r -= I0;
        if (r < I1) { cvt_item(A.in[I_MIXWOUT], D, D, D, (bf16*)(ws + WS_WOUT), 0, r, scr, lane); continue; } r -= I1;
        if (r < I2) { cvt_item(A.in[I_FW1], D, FFN, FFN, (bf16*)(ws + WS_W13), 1, r, scr, lane); continue; } r -= I2;
        if (r < I2) { cvt_item(A.in[I_FW3], D, FFN, FFN, (bf16*)(ws + WS_W13), 2, r, scr, lane); continue; } r -= I2;
        if (r < I3) { cvt_item(A.in[I_FW2], FFN, D, D, (bf16*)(ws + WS_W2), 0, r, scr, lane); continue; } r -= I3;
        if (r < I4) { cvt_item(A.in[I_SWIN], D, D, D, (bf16*)(ws + WS_SIN), 0, r, scr, lane); continue; } r -= I4;
        if (r < I5) { cvt_item(A.in[I_SWOUT], D, D, 2 * D, (bf16*)(ws + WS_SOUT), 1, r, scr, lane); continue; } r -= I5;
        cvt_item(A.in[I_SWOUT] + D, D, D, 2 * D, (bf16*)(ws + WS_SOUT), 2, r, scr, lane);
    }
}
__device__ __forceinline__ void moe_convert(const Args& A, LAS unsigned char* lds, int first, int count, int widx, int nw, int wave, int lane) {
    LAS float* scr = (LAS float*)(lds + wave * 16384);
    unsigned char* ws = A.ws;
    const int last = (first + count) < CV_NMOE ? (first + count) : CV_NMOE;
    for (int it = first + widx; it < last; it += nw) {
        int r = it; const int e = r / (2 * CV_IM + CV_IM2); r -= e * (2 * CV_IM + CV_IM2);
        if (r < CV_IM) { cvt_item(A.in[I_MW1] + (size_t)e * D * ED, D, ED, ED, (bf16*)(ws + WS_MW13) + (size_t)e * 2 * ED * D, 1, r, scr, lane, (unsigned*)(ws + WS_COLMAX) + e * 2 * ED); continue; } r -= CV_IM;
        if (r < CV_IM) { cvt_item(A.in[I_MW3] + (size_t)e * D * ED, D, ED, ED, (bf16*)(ws + WS_MW13) + (size_t)e * 2 * ED * D, 2, r, scr, lane, (unsigned*)(ws + WS_COLMAX) + e * 2 * ED); continue; } r -= CV_IM;
        cvt_item(A.in[I_MW2] + (size_t)e * ED * D, ED, D, D, (bf16*)(ws + WS_MW2) + (size_t)e * D * ED, 0, r, scr, lane);
    }
}
__device__ __forceinline__ void shw_rows(const bf16* WT, int N, const float* sh, float* out, int widx, int nw, LAS unsigned char* lds, int tid, int lane) {
    LAS float* shl = (LAS float*)lds;
    __syncthreads();
    for (int i = tid; i < 9 * 1024; i += NWAVES * 64) shl[i] = sh[(size_t)(i >> 10) * 6144 + (i & 1023)];
    __syncthreads();
    for (int p = widx; p < N; p += nw) {
        const v4u w0 = *(const v4u*)(WT + (size_t)p * D + 16 * lane), w1 = *(const v4u*)(WT + (size_t)p * D + 16 * lane + 8);
        const float w[16] = {bflo(w0.x), bfhi(w0.x), bflo(w0.y), bfhi(w0.y), bflo(w0.z), bfhi(w0.z), bflo(w0.w), bfhi(w0.w), bflo(w1.x), bfhi(w1.x), bflo(w1.y), bfhi(w1.y), bflo(w1.z), bfhi(w1.z), bflo(w1.w), bfhi(w1.w)};
        float s[9];
#pragma unroll
        for (int b = 0; b < 9; ++b) { const LAS f32x4* sp = (const LAS f32x4*)(shl + b * 1024 + 16 * lane); float a = 0.f;
#pragma unroll
            for (int q = 0; q < 4; ++q) { const f32x4 v = sp[q]; a += (v.x * w[4 * q] + v.y * w[4 * q + 1]) + (v.z * w[4 * q + 2] + v.w * w[4 * q + 3]); }
            s[b] = a; }
#pragma unroll
        for (int b = 0; b < 9; ++b) s[b] = wave_sum(s[b]);
        if (lane < 9) { float v = s[0];
#pragma unroll
            for (int b = 1; b < 9; ++b) v = (lane == b) ? s[b] : v;
            out[(size_t)lane * N + p] = v; }
    }
    __syncthreads();
}
__device__ __forceinline__ unsigned q8pack(float a, float b, float c, float d) { const int ia = (int)rintf(a), ib = (int)rintf(b), ic = (int)rintf(c), id = (int)rintf(d);
    return (unsigned)(ia & 255) | ((unsigned)(ib & 255) << 8) | ((unsigned)(ic & 255) << 16) | ((unsigned)(id & 255) << 24); }
__device__ __forceinline__ void quant_rows_inplace(bf16* W, unsigned* colmax, int nrows, int gw, int NGW, int lane) {
    for (int r0 = gw; r0 < nrows; r0 += 2 * NGW) {
        const int r1 = (r0 + NGW < nrows) ? r0 + NGW : r0; const int nr = (r0 + NGW < nrows) ? 2 : 1;
        v4u a[2][2]; float mx[2];
#pragma unroll
        for (int u = 0; u < 2; ++u) { const int r = u ? r1 : r0; const bf16* rp = W + (size_t)r * 1024 + 16 * lane; a[u][0] = *(const v4u*)rp; a[u][1] = *(const v4u*)(rp + 8); mx[u] = __builtin_bit_cast(float, colmax[r]); }
        asm volatile("s_waitcnt vmcnt(0)" ::: "memory");
#pragma unroll
        for (int u = 0; u < 2; ++u) { if (u < nr) { const int r = u ? r1 : r0; const float inv = mx[u] > 0.f ? 127.0f / mx[u] : 0.f; v4u o;
            o.x = q8pack(bflo(a[u][0].x) * inv, bfhi(a[u][0].x) * inv, bflo(a[u][0].y) * inv, bfhi(a[u][0].y) * inv); o.y = q8pack(bflo(a[u][0].z) * inv, bfhi(a[u][0].z) * inv, bflo(a[u][0].w) * inv, bfhi(a[u][0].w) * inv);
            o.z = q8pack(bflo(a[u][1].x) * inv, bfhi(a[u][1].x) * inv, bflo(a[u][1].y) * inv, bfhi(a[u][1].y) * inv); o.w = q8pack(bflo(a[u][1].z) * inv, bfhi(a[u][1].z) * inv, bflo(a[u][1].w) * inv, bfhi(a[u][1].w) * inv);
            *(v4u*)((unsigned char*)(W + (size_t)r * 1024) + 16 * lane) = o;
            if (lane == 0) ((float*)colmax)[r] = mx[u] * (1.0f / 127.0f); } }
    }
}
template <int NPART> __device__ __forceinline__ void norm_row_finish(const f32x4 (&v)[4], int row, const float* gain, const float* mod, int shc, int scc, bf16* H, int lane) {
    const float* mp = mod + (size_t)(row < ML ? (row >> 11) : 8) * 6144; float ss = 0.f;
#pragma unroll
    for (int j = 0; j < 4; ++j) ss += (v[j].x * v[j].x + v[j].y * v[j].y) + (v[j].z * v[j].z + v[j].w * v[j].w);
    const float rstd = rsqrtf(wave_sum(ss) * (1.0f / D) + EPS);
#pragma unroll
    for (int j = 0; j < 4; ++j) { const int k = 4 * lane + 256 * j; const f32x4 gg = *(const f32x4*)(gain + k); f32x4 sc = *(const f32x4*)(mp + scc * 1024 + k), sh = *(const f32x4*)(mp + shc * 1024 + k);
#pragma unroll
        for (int q = 1; q < NPART; ++q) { sc = sc + *(const f32x4*)(mp + (size_t)q * MOD_N + scc * 1024 + k); sh = sh + *(const f32x4*)(mp + (size_t)q * MOD_N + shc * 1024 + k); }
        const f32x4 h = v[j] * rstd * gg * (sc + 1.0f) + sh;
        v2u o; o.x = cvtpk(h.x, h.y); o.y = cvtpk(h.z, h.w); *(v2u*)(H + (size_t)row * D + k) = o; }
}
__device__ __forceinline__ void norm_rows_lds(const float* xL, const float* xC, int nrows, const float* gain, const LAS float* ms, bf16* H, int gw, int NGW, int lane) {
    for (int row = gw; row < nrows; row += 2 * NGW) {
        const int row1 = row + NGW; const bool two = row1 < nrows; const int r1 = two ? row1 : row;
        const float* xa = row < ML ? xL + (size_t)row * D : xC + (size_t)(row - ML) * D; const float* xb = r1 < ML ? xL + (size_t)r1 * D : xC + (size_t)(r1 - ML) * D;
        f32x4 vv[2][4];
#pragma unroll
        for (int j = 0; j < 4; ++j) { vv[0][j] = *(const f32x4*)(xa + 4 * lane + 256 * j); vv[1][j] = *(const f32x4*)(xb + 4 * lane + 256 * j); }
#pragma unroll
        for (int u = 0; u < 2; ++u) { if (u == 1 && !two) break; const int rw = u ? row1 : row; const LAS float* mp = ms + (rw < ML ? (rw >> 11) : 8) * 2048; float ss = 0.f;
#pragma unroll
            for (int j = 0; j < 4; ++j) ss += (vv[u][j].x * vv[u][j].x + vv[u][j].y * vv[u][j].y) + (vv[u][j].z * vv[u][j].z + vv[u][j].w * vv[u][j].w);
            const float rstd = rsqrtf(wave_sum(ss) * (1.0f / D) + EPS);
#pragma unroll
            for (int j = 0; j < 4; ++j) { const int k = 4 * lane + 256 * j; const f32x4 gg = *(const f32x4*)(gain + k), sh = *(const LAS f32x4*)(mp + k), sc = *(const LAS f32x4*)(mp + 1024 + k);
                const f32x4 h = vv[u][j] * rstd * gg * (sc + 1.0f) + sh;
                v2u o; o.x = cvtpk(h.x, h.y); o.y = cvtpk(h.z, h.w); *(v2u*)(H + (size_t)rw * D + k) = o; } }
    }
}
template <int NPART> __device__ __forceinline__ void norm_rows(const float* xL, const float* xC, int nrows, const float* gain, const float* mod, int shc, int scc, bf16* H, int gw, int NGW, int lane) {
    for (int row = gw; row < nrows; row += 2 * NGW) {
        const int row1 = row + NGW; const bool two = row1 < nrows; const int r1 = two ? row1 : row;
        const float* xa = row < ML ? xL + (size_t)row * D : xC + (size_t)(row - ML) * D; const float* xb = r1 < ML ? xL + (size_t)r1 * D : xC + (size_t)(r1 - ML) * D;
        f32x4 va[4], vb[4];
#pragma unroll
        for (int j = 0; j < 4; ++j) { va[j] = *(const f32x4*)(xa + 4 * lane + 256 * j); vb[j] = *(const f32x4*)(xb + 4 * lane + 256 * j); }
        norm_row_finish<NPART>(va, row, gain, mod, shc, scc, H, lane);
        if (two) norm_row_finish<NPART>(vb, row1, gain, mod, shc, scc, H, lane);
    }
}
constexpr int VSTR = 144;
__device__ __forceinline__ void attn_unit(const bf16* QKVU, bf16* MIX, int wu, LAS unsigned char* vl, LAS unsigned char* ql, const LAS float* rpbl, float bnd, int lane) {
    const bool isctx = wu >= 2048;
    int b, h, r = 0, qrow0;
    if (!isctx) { h = wu & 7; r = (wu >> 3) & 31; b = wu >> 8; qrow0 = b * SEQ + r * 64; }
    else { const int w = wu - 2048; h = w & 7; b = w >> 5; qrow0 = ML + b * NCTX + 64 * ((w >> 3) & 3); }
    const int c = lane & 31, hh = lane >> 5;
    const int rs = r < 4 ? 0 : (r > 28 ? 24 : r - 4);
    const int csA = c < 8 ? 0 : c - 8;
    const int csB = c > 24 ? 48 : c + 24;
    const LAS unsigned char* vtb = vl + (4 * hh + ((lane & 15) >> 2)) * VSTR + 32 * ((lane >> 4) & 1) + 8 * (lane & 3);
    LAS unsigned char* qs = ql + c * 128 + 16 * hh;
    { const bf16* qp = QKVU + (size_t)(qrow0 + c) * 2048 + h * 64 + 8 * hh;
#pragma unroll
      for (int s = 0; s < 4; ++s) { *(LAS bf16x8*)(qs + 32 * s) = *(const bf16x8*)(qp + 16 * s); *(LAS bf16x8*)(qs + 4096 + 32 * s) = *(const bf16x8*)(qp + (size_t)32 * 2048 + 16 * s); } }
    f32x16 oA0, oA1, oB0, oB1;
#pragma unroll
    for (int i = 0; i < 16; ++i) { oA0[i] = 0.f; oA1[i] = 0.f; oB0[i] = 0.f; oB1[i] = 0.f; }
    float lsA = 0.f, lsB = 0.f;
    const int nblk = isctx ? 8 : 24;
    const bf16* kbase = QKVU + 512 + h * 64 + 8 * hh + (size_t)c * 2048;
    const bf16* vbase = QKVU + 1024 + h * 64 + 8 * (lane & 7) + (size_t)(lane >> 3) * 2048;
#define ATT_KROW0(kb_) (((!isctx) && (kb_) < 16) ? (b * SEQ + (rs + ((kb_) >> 1)) * 64 + 32 * ((kb_) & 1)) : (ML + b * NCTX + 32 * (isctx ? (kb_) : (kb_) - 16)))
#define ATT_LOADK(KF, kb_) do { const int kq_ = (kb_) < nblk ? (kb_) : nblk - 1; const size_t ro_ = (size_t)ATT_KROW0(kq_) * 2048; \
        _Pragma("unroll") for (int s_ = 0; s_ < 4; ++s_) KF[s_] = *(const bf16x8*)(kbase + ro_ + 16 * s_); } while (0)
#define ATT_LOADV(VF, kb_) do { const int kq_ = (kb_) < nblk ? (kb_) : nblk - 1; const size_t ro_ = (size_t)ATT_KROW0(kq_) * 2048; \
        _Pragma("unroll") for (int i_ = 0; i_ < 4; ++i_) VF[i_] = *(const v4u*)(vbase + ro_ + (size_t)i_ * 8 * 2048); } while (0)
#define ATT_PACK(PF, P) do { _Pragma("unroll") for (int s = 0; s < 2; ++s) { v4u w; w.x = cvtpk(P[8 * s], P[8 * s + 1]); w.y = cvtpk(P[8 * s + 2], P[8 * s + 3]); w.z = cvtpk(P[8 * s + 4], P[8 * s + 5]); w.w = cvtpk(P[8 * s + 6], P[8 * s + 7]); PF[s] = __builtin_bit_cast(bf16x8, w); } } while (0)
#define ATT_BLOCK(KF, VF, kb_) do { const int kb = (kb_); const bool live = kb < nblk; const bool band = (!isctx) && kb < 16; const int kr = rs + (kb >> 1); \
        _Pragma("unroll") for (int i = 0; i < 4; ++i) { const int id = lane + 64 * i; *(LAS v4u*)(vl + (id >> 3) * VSTR + (id & 7) * 16) = VF[i]; } \
        ATT_LOADV(VF, kb + 1);              \
        f32x16 sA, sB; \
        _Pragma("unroll") for (int i = 0; i < 16; ++i) { sA[i] = 0.f; sB[i] = 0.f; } \
        _Pragma("unroll") for (int s = 0; s < 4; ++s) { sA = __builtin_amdgcn_mfma_f32_32x32x16_bf16(KF[s], *(const LAS bf16x8*)(qs + 32 * s), sA, 0, 0, 0); \
                                                        sB = __builtin_amdgcn_mfma_f32_32x32x16_bf16(KF[s], *(const LAS bf16x8*)(qs + 4096 + 32 * s), sB, 0, 0, 0); } \
        ATT_LOADK(KF, kb + 1);              \
        float pA[16], pB[16]; \
        if (band) { const int kc0 = 32 * (kb & 1) + 4 * hh; const LAS float* rb = rpbl + h * 465 + (kr - r + 7) * 31 + (kc0 - c); \
              \
            float bA[16], bB[16]; \
            _Pragma("unroll") for (int i = 0; i < 16; ++i) { bA[i] = rb[15 + (i & 3) + 8 * (i >> 2)]; bB[i] = rb[(i & 3) + 8 * (i >> 2) - 17]; } \
            const int tA = kc0 - csA, tB = kc0 - csB; \
            _Pragma("unroll") for (int i = 0; i < 16; ++i) { const int o = (i & 3) + 8 * (i >> 2); \
                { const bool ok = (unsigned)(tA + o) < 16u; const float e = __builtin_amdgcn_exp2f(sA[i] * 0.18033688f + bA[i]); pA[i] = ok ? e : 0.f; } \
                { const bool ok = (unsigned)(tB + o) < 16u; const float e = __builtin_amdgcn_exp2f(sB[i] * 0.18033688f + bB[i]); pB[i] = ok ? e : 0.f; } } \
        } else { \
            _Pragma("unroll") for (int i = 0; i < 16; ++i) { const float ea = __builtin_amdgcn_exp2f(sA[i] * 0.18033688f - bnd), eb = __builtin_amdgcn_exp2f(sB[i] * 0.18033688f - bnd); pA[i] = live ? ea : 0.f; pB[i] = live ? eb : 0.f; } } \
        _Pragma("unroll") for (int i = 0; i < 16; ++i) { lsA += pA[i]; lsB += pB[i]; } \
        bf16x8 fA[2], fB[2]; ATT_PACK(fA, pA); ATT_PACK(fB, pB); \
        LDS_WAIT(); \
        _Pragma("unroll") for (int dt = 0; dt < 2; ++dt) \
            _Pragma("unroll") for (int s = 0; s < 2; ++s) { \
                const s16x4 lo = vtr(vtb + (16 * s) * VSTR + 64 * dt), hi = vtr(vtb + (16 * s + 8) * VSTR + 64 * dt); \
                const bf16x8 af = (bf16x8){lo[0], lo[1], lo[2], lo[3], hi[0], hi[1], hi[2], hi[3]}; \
                if (dt == 0) { oA0 = __builtin_amdgcn_mfma_f32_32x32x16_bf16(af, fA[s], oA0, 0, 0, 0); oB0 = __builtin_amdgcn_mfma_f32_32x32x16_bf16(af, fB[s], oB0, 0, 0, 0); } \
                else { oA1 = __builtin_amdgcn_mfma_f32_32x32x16_bf16(af, fA[s], oA1, 0, 0, 0); oB1 = __builtin_amdgcn_mfma_f32_32x32x16_bf16(af, fB[s], oB1, 0, 0, 0); } } \
        } while (0)
    bf16x8 kA[4]; v4u vA[4];
    ATT_LOADK(kA, 0); ATT_LOADV(vA, 0);
    for (int kb1 = 0; kb1 < nblk; ++kb1) ATT_BLOCK(kA, vA, kb1);
#undef ATT_KROW0
#undef ATT_LOADK
#undef ATT_LOADV
#undef ATT_PACK
#undef ATT_BLOCK
    lsA += __shfl_xor(lsA, 32); lsB += __shfl_xor(lsB, 32);
    const float iA = 1.0f / lsA, iB = 1.0f / lsB;
    bf16* op = MIX + (size_t)(qrow0 + c) * D + h * 64 + 4 * hh; bf16* oq = op + (size_t)32 * D;
#pragma unroll
    for (int i4 = 0; i4 < 4; ++i4) {
        v2u w0; w0.x = cvtpk(oA0[4 * i4] * iA, oA0[4 * i4 + 1] * iA); w0.y = cvtpk(oA0[4 * i4 + 2] * iA, oA0[4 * i4 + 3] * iA); *(v2u*)(op + 8 * i4) = w0;
        v2u w1; w1.x = cvtpk(oA1[4 * i4] * iA, oA1[4 * i4 + 1] * iA); w1.y = cvtpk(oA1[4 * i4 + 2] * iA, oA1[4 * i4 + 3] * iA); *(v2u*)(op + 32 + 8 * i4) = w1;
        v2u w2; w2.x = cvtpk(oB0[4 * i4] * iB, oB0[4 * i4 + 1] * iB); w2.y = cvtpk(oB0[4 * i4 + 2] * iB, oB0[4 * i4 + 3] * iB); *(v2u*)(oq + 8 * i4) = w2;
        v2u w3; w3.x = cvtpk(oB1[4 * i4] * iB, oB1[4 * i4 + 1] * iB); w3.y = cvtpk(oB1[4 * i4 + 2] * iB, oB1[4 * i4 + 3] * iB); *(v2u*)(oq + 32 + 8 * i4) = w3; }
}
template <int P0, int NP> __device__ __forceinline__ void conv_chunk(float (&acc)[32], const float (&w)[31], const __amdgpu_buffer_rsrc_t rsrc, int voff, int t0, int len) {
    float v[NP];
#pragma unroll
    for (int i = 0; i < NP; ++i) { const int t = t0 - 15 + P0 + i, tc = t < 0 ? 0 : (t >= len ? len - 1 : t); const int so = __builtin_amdgcn_readfirstlane(tc * 4096);
        const float x = bf2f(__builtin_amdgcn_raw_buffer_load_b16(rsrc, voff, so, 0)); v[i] = (t == tc) ? x : 0.f; }
#pragma unroll
    for (int i = 0; i < NP; ++i)
#pragma unroll
        for (int tt = 0; tt < 32; ++tt) { if (P0 + i - tt >= 0 && P0 + i - tt <= 30) acc[tt] += v[i] * w[(P0 + i - tt >= 0 && P0 + i - tt <= 30) ? P0 + i - tt : 0]; }
}
__device__ __forceinline__ void conv_item(const Args& A, const bf16* QKVU, bf16* MIX, int item, LAS float* cv, int tid, int wave, int lane) {
    __syncthreads();
    int rowbase, len, t0;
    if (item < 512) { rowbase = (item >> 6) * SEQ; len = SEQ; t0 = 32 * (item & 63); } else { const int i2 = item - 512; rowbase = ML + (i2 >> 3) * NCTX; len = NCTX; t0 = 32 * (i2 & 7); }
    const int ch = tid;
    float w[31], acc[32];
    { const __amdgpu_buffer_rsrc_t wrs = __builtin_amdgcn_make_buffer_rsrc((void*)A.in[I_DWW], 0, 31 * 512 * 4, 0x00020000);
#pragma unroll
      for (int k = 0; k < 31; ++k) w[k] = __builtin_bit_cast(float, __builtin_amdgcn_raw_buffer_load_b32(wrs, 4 * ch, k * 2048, 0)); }
    const float bias = A.in[I_DWB][ch];
#pragma unroll
    for (int t = 0; t < 32; ++t) acc[t] = bias;
    const __amdgpu_buffer_rsrc_t rsrc = __builtin_amdgcn_make_buffer_rsrc((void*)(QKVU + (size_t)rowbase * 2048 + 1536), 0, len * 4096, 0x00020000);
    conv_chunk<0, 16>(acc, w, rsrc, 2 * ch, t0, len); conv_chunk<16, 16>(acc, w, rsrc, 2 * ch, t0, len); conv_chunk<32, 16>(acc, w, rsrc, 2 * ch, t0, len); conv_chunk<48, 14>(acc, w, rsrc, 2 * ch, t0, len);
#pragma unroll
    for (int t = 0; t < 32; ++t) cv[t * 512 + ch] = acc[t];
    __syncthreads();
    const f32x4 g0 = *(const f32x4*)(A.in[I_LNG] + 8 * lane), g1 = *(const f32x4*)(A.in[I_LNG] + 8 * lane + 4), b0 = *(const f32x4*)(A.in[I_LNB] + 8 * lane), b1 = *(const f32x4*)(A.in[I_LNB] + 8 * lane + 4);
#pragma unroll
    for (int q = 0; q < 4; ++q) { const int tt = 4 * wave + q;
        f32x4 x0 = *(const LAS f32x4*)(cv + tt * 512 + 8 * lane), x1 = *(const LAS f32x4*)(cv + tt * 512 + 8 * lane + 4);
        const float mean = wave_sum((x0.x + x0.y) + (x0.z + x0.w) + (x1.x + x1.y) + (x1.z + x1.w)) * (1.0f / 512.0f);
        x0 = x0 - mean; x1 = x1 - mean;
        const float var = wave_sum((x0.x * x0.x + x0.y * x0.y) + (x0.z * x0.z + x0.w * x0.w) + (x1.x * x1.x + x1.y * x1.y) + (x1.z * x1.z + x1.w * x1.w)) * (1.0f / 512.0f);
        const float rstd = rsqrtf(var + EPS);
        f32x4 y0 = x0 * rstd * g0 + b0, y1 = x1 * rstd * g1 + b1;
        y0 = (f32x4){y0.x * sigm(y0.x), y0.y * sigm(y0.y), y0.z * sigm(y0.z), y0.w * sigm(y0.w)}; y1 = (f32x4){y1.x * sigm(y1.x), y1.y * sigm(y1.y), y1.z * sigm(y1.z), y1.w * sigm(y1.w)};
        v4u o; o.x = cvtpk(y0.x, y0.y); o.y = cvtpk(y0.z, y0.w); o.z = cvtpk(y1.x, y1.y); o.w = cvtpk(y1.z, y1.w);
        *(v4u*)(MIX + (size_t)(rowbase + t0 + tt) * D + 512 + 8 * lane) = o; }
    __syncthreads();
}
__device__ __forceinline__ void s5_scan(const Args& A, int gt) {
    if (gt >= NB * 64 * 2 * 64) return;
    const int p = gt & 63, d = (gt >> 6) & 1, g = (gt >> 7) & 63, b = gt >> 13;
    const int ix = (d * 64 + g) * 64 + p;
    const float ar = A.in[I_ARE][ix], ai = A.in[I_AIM][ix], dt = __expf(A.in[I_LOGDT][d * 64 + g]);
    const float zr = ar * dt, zi = ai * dt, mag = __expf(zr); float lr = mag * cosf(zi), li = mag * sinf(zi);
#pragma unroll
    for (int k = 0; k < 5; ++k) { const float nr = lr * lr - li * li, ni = 2.f * lr * li; lr = nr; li = ni; }
    const float* E = (const float*)(A.ws + WS_E) + (size_t)g * 768 * 256 + d * 128 + p;
    bf16* UC = (bf16*)(A.ws + WS_UC) + (size_t)g * 768 * 768 + 512 + d * 128 + p;
    float sr = 0.f, si = 0.f;
    for (int s0 = 0; s0 < 72; s0 += 24) {
        float er[24], ei[24]; int bcs[24];
#pragma unroll
        for (int k = 0; k < 24; ++k) { const int step = s0 + k; int bc;
            if (step < 8) bc = 512 + 8 * b + (d == 0 ? step : 7 - step); else bc = 64 * b + (d == 0 ? step - 8 : 71 - step);
            bcs[k] = bc; er[k] = E[(size_t)bc * 256]; ei[k] = E[(size_t)bc * 256 + 64]; }
#pragma unroll
        for (int k = 0; k < 24; ++k) {
            if (s0 + k >= 8) { UC[(size_t)bcs[k] * 768] = (bf16)f2bf(sr); UC[(size_t)bcs[k] * 768 + 64] = (bf16)f2bf(si); }
            const float nr = lr * sr - li * si + er[k], ni = lr * si + li * sr + ei[k]; sr = nr; si = ni; }
    }
}
__device__ __forceinline__ void moe_route(const Args& A, const bf16* X, const float* mod, bf16* H, int chunk, LAS unsigned* lcnt, int tid, int wave, int lane) {
    unsigned char* tok = A.ws + WS_TOK;
    int* tokE = (int*)(tok + TOK_E); float* tokW = (float*)(tok + TOK_W); int* tokRank = (int*)(tok + TOK_RANK); int* wgbase = (int*)(tok + TOK_WGBASE);
    if (tid < 8) lcnt[tid] = 0u;
    __syncthreads();
    const float* gain = A.in[I_N2G] + D; const float* wr = A.in[I_ROUTER];
    for (int q2 = 0; q2 < 8; q2 += 2) {
        f32x4 vv[2][4];
#pragma unroll
        for (int u = 0; u < 2; ++u) { const bf16* xr = X + (size_t)(chunk * 64 + wave * 8 + q2 + u) * D;
#pragma unroll
            for (int j = 0; j < 4; ++j) { const v2u xw = *(const v2u*)(xr + 4 * lane + 256 * j); vv[u][j] = (f32x4){bflo(xw.x), bfhi(xw.x), bflo(xw.y), bfhi(xw.y)}; } }
#pragma unroll
        for (int u = 0; u < 2; ++u) {
        const int row = chunk * 64 + wave * 8 + q2 + u; const float* mp = mod + (size_t)(row >> 11) * 6144;
        float ss = 0.f;
#pragma unroll
        for (int j = 0; j < 4; ++j) ss += (vv[u][j].x * vv[u][j].x + vv[u][j].y * vv[u][j].y) + (vv[u][j].z * vv[u][j].z + vv[u][j].w * vv[u][j].w);
        const float rstd = rsqrtf(wave_sum(ss) * (1.0f / D) + EPS);
        float lg[8]; f32x4 hq[4];
#pragma unroll
        for (int e = 0; e < 8; ++e) lg[e] = 0.f;
#pragma unroll
        for (int j = 0; j < 4; ++j) { const int k = 4 * lane + 256 * j; const f32x4 gg = *(const f32x4*)(gain + k), sc = *(const f32x4*)(mp + 4 * 1024 + k), sh = *(const f32x4*)(mp + 3 * 1024 + k);
            const f32x4 h = vv[u][j] * rstd * gg * (sc + 1.0f) + sh; hq[j] = h;
#pragma unroll
            for (int i = 0; i < 4; ++i) { const f32x4 w0 = *(const f32x4*)(wr + (size_t)(k + i) * 8), w1 = *(const f32x4*)(wr + (size_t)(k + i) * 8 + 4); const float hv = h[i];
                lg[0] += hv * w0.x; lg[1] += hv * w0.y; lg[2] += hv * w0.z; lg[3] += hv * w0.w; lg[4] += hv * w1.x; lg[5] += hv * w1.y; lg[6] += hv * w1.z; lg[7] += hv * w1.w; } }
        {
            float am = 0.f;
#pragma unroll
            for (int j = 0; j < 4; ++j) am = fmaxf(am, fmaxf(fmaxf(fabsf(hq[j].x), fabsf(hq[j].y)), fmaxf(fabsf(hq[j].z), fabsf(hq[j].w))));
            am = wave_max(am); const float inv = am > 0.f ? 127.0f / am : 0.f;
#pragma unroll
            for (int j = 0; j < 4; ++j) *(unsigned*)((unsigned char*)H + (size_t)row * D + 4 * lane + 256 * j) = q8pack(hq[j].x * inv, hq[j].y * inv, hq[j].z * inv, hq[j].w * inv);
            if (lane == 0) ((float*)(A.ws + WS_ROWSC))[row] = am * (1.0f / 127.0f); }
#pragma unroll
        for (int e = 0; e < 8; ++e) lg[e] = wave_sum(lg[e]);
        int e0 = 0; float v0 = lg[0];
#pragma unroll
        for (int e = 1; e < 8; ++e) if (lg[e] > v0) { v0 = lg[e]; e0 = e; }
        int e1 = -1; float v1 = -3.0e38f;
#pragma unroll
        for (int e = 0; e < 8; ++e) if (e != e0 && lg[e] > v1) { v1 = lg[e]; e1 = e; }
        const float ex = __expf(v1 - v0), w0 = 1.0f / (1.0f + ex), w1 = ex * w0;
        if (lane == 0) { const unsigned r0 = __hip_atomic_fetch_add(&lcnt[e0], 1u, __ATOMIC_RELAXED, __HIP_MEMORY_SCOPE_WORKGROUP), r1 = __hip_atomic_fetch_add(&lcnt[e1], 1u, __ATOMIC_RELAXED, __HIP_MEMORY_SCOPE_WORKGROUP);
            tokE[2 * row] = e0; tokE[2 * row + 1] = e1; tokW[2 * row] = w0; tokW[2 * row + 1] = w1; tokRank[2 * row] = (int)r0; tokRank[2 * row + 1] = (int)r1; }
        }
    }
    __syncthreads();
    if (tid < 8) { const unsigned n = lcnt[tid]; const unsigned base = __hip_atomic_fetch_add((unsigned*)(A.ws + WS_CTL) + CW_GCNT + 64 * tid, n, RLX_AGENT); wgbase[chunk * 8 + tid] = (int)base; }
    __syncthreads();
}
constexpr int NPHASE = 17;
__device__ __forceinline__ void moe_offsets(const unsigned char* ws, int (&toff)[9]) {
    const unsigned* gc = (const unsigned*)(ws + WS_CTL) + CW_GCNT; int acc = 0;
#pragma unroll
    for (int e = 0; e < 8; ++e) { toff[e] = acc; const unsigned n = __hip_atomic_load(gc + 64 * e, RLX_AGENT); acc += (int)((n + 255u) >> 8); }
    toff[8] = acc;
}
#define TAIL_CONVERT(nunits, first, count) do { const int rounds_ = ((nunits) + G - 1) / G, nlast_ = (nunits) - (rounds_ - 1) * G; \
        if (bx >= nlast_) moe_convert(args, lds, (first), (count), (bx - nlast_) * NWAVES + wave, (G - nlast_) * NWAVES, wave, lane); } while (0)
constexpr int CVQ4 = 4000, CVQ6 = 8000, CVQ7 = 17500, CVQ9 = 8500, CVQS1 = 2000, CVQS2 = CV_NMOE - CVQ4 - CVQ6 - CVQ7 - CVQ9 - CVQS1;
__global__ void __launch_bounds__(NWAVES * 64, 2) fwd_kernel(Args args) {
    extern __shared__ __attribute__((aligned(16))) unsigned char lds_raw[];
    LAS unsigned char* lds = (LAS unsigned char*)lds_raw;
    volatile LAS unsigned* MISC = (volatile LAS unsigned*)(lds + MISC_OFF);
    const int tid = threadIdx.x, lane = tid & 63, wave = __builtin_amdgcn_readfirstlane(tid >> 6);
    const int G = gridDim.x, bx = blockIdx.x;
    const int gw = bx * NWAVES + wave, NGW = G * NWAVES;
    unsigned char* ws = args.ws;
    for (int u = tid; u < (LDS_BYTES - LDSCTL_OFF) / 4; u += NWAVES * 64) ((LAS unsigned*)(lds + LDSCTL_OFF))[u] = 0u;
    __syncthreads();
    const int lo = args.ph_lo, hi = args.ph_hi;
    XcdBarrier bar; bar.bar = (unsigned*)(ws + WS_CTL) + CW_BAR; bar.x = 0; bar.st = nullptr;
    if (hi - lo > 1) bar = xcd_barrier_post((unsigned*)(ws + WS_CTL) + CW_BAR, MISC + 8);
#define IN(k) (lo <= (k) && (k) < hi)
#define SEAM(k) do { if (IN((k) + 1)) xcd_barrier(bar); } while (0)
    float* mod = (float*)(ws + WS_MOD);
    bf16* XL = (bf16*)(ws + WS_XL); bf16* XC = (bf16*)(ws + WS_XC);
    bf16* H = (bf16*)(ws + WS_H);

    if (IN(0)) {
        for (int i = bx * (NWAVES * 64) + tid; i < NE * 2 * ED; i += G * NWAVES * 64) ((unsigned*)(ws + WS_COLMAX))[i] = 0u;
        for (int u = bx; u < 192; u += G) { if (args.sub & 1) p0_adaln(args, u, lds, tid, wave, lane); }
        if (args.sub & 4) p0_convert(args, lds, gw, NGW, wave, lane);
        SEAM(0);
    }
    if (IN(1)) {
        { const float* modp = (const float*)(ws + WS_MODP);
          for (int i = bx * (NWAVES * 64) + tid; i < MOD_N; i += G * NWAVES * 64) mod[i] = ((modp[i] + modp[MOD_N + i]) + modp[2 * MOD_N + i]) + modp[3 * MOD_N + i]; }
        { const float* modp = (const float*)(ws + WS_MODP); LAS float* ms = (LAS float*)lds;
          for (int i = tid; i < 9 * 2048; i += NWAVES * 64) { const int r = i >> 11, o = r * 6144 + (i & 2047); ms[i] = ((modp[o] + modp[MOD_N + o]) + modp[2 * MOD_N + o]) + modp[3 * MOD_N + o]; }
          __syncthreads(); norm_rows_lds(args.in[I_X], args.in[I_CTX], MT, args.in[I_N1G], ms, H, gw, NGW, lane); }
        SEAM(1); }
    if (IN(2)) {
        pg8::Gemm g{H, (const bf16*)(ws + WS_WIN), MT, MIXIN, D, D, D}; pg8::StaticOrder S; S.init(MT, MIXIN, G, bx);
        pg8::EpiQKVU E{(bf16*)(ws + WS_QKVU), args.in[I_QG], args.in[I_KG], EPS};
        pg8::gemm_phase<pg8::EpiQKVU, pg8::StaticOrder, true, true>(lds + RING_OFF, g, S, E);
        SEAM(2);
    }
    if (IN(3)) {
        const bf16* QKVU = (const bf16*)(ws + WS_QKVU); bf16* MIX = (bf16*)(ws + WS_MIX);
        LAS float* rpbl = (LAS float*)(lds + 40960); LAS float* cv = (LAS float*)(lds + 57344);
        float mq = 0.f, mk = 0.f, mb = 0.f;
        mq = fabsf(args.in[I_QG][lane]); mk = fabsf(args.in[I_KG][lane]);
        for (int i = lane; i < 8 * 465; i += 64) mb = fmaxf(mb, fabsf(args.in[I_RPB][i]));
        const float bnd = (8.2f * wave_max(mq) * wave_max(mk) + wave_max(mb)) * 1.44269504f;
        for (int i = tid; i < 8 * 465; i += NWAVES * 64) rpbl[i] = args.in[I_RPB][i] * 1.44269504f - bnd;
        __syncthreads();
        const int nbw = (G % 8 == 0) ? G / 8 : G, xb0 = (G % 8 == 0) ? (bx & 7) : 0, xbn = (G % 8 == 0) ? xb0 + 1 : 8, j0 = (G % 8 == 0) ? (bx >> 3) : bx;
        for (int x = xb0; x < xbn; ++x)
            for (int k = j0; k < 128; k += nbw) {
                if (k < 36) {
                    if (!(args.sub & (k < 32 ? 8 : 16))) continue;
                    const int wu = k < 32 ? (x * 32 + k) * 8 + wave : 2048 + (x * 4 + (k - 32)) * 8 + wave;
                    attn_unit(QKVU, MIX, wu, lds + wave * 5120, lds + 57344 + wave * 8192, rpbl, bnd, lane);
                } else {
                    if (!(args.sub & 32)) continue;
                    const int ci = k < 64 ? k - 36 : (k < 96 ? k - 36 : (k >= 100 && k < 112 ? k - 40 : -1)); if (ci < 0) continue;
                    conv_item(args, QKVU, MIX, ci < 64 ? x * 64 + ci : 512 + x * 8 + (ci - 64), cv, tid, wave, lane);
                }
            }
        SEAM(3);
    }
    if (IN(4)) {
        pg8::Gemm g{(const bf16*)(ws + WS_MIX), (const bf16*)(ws + WS_WOUT), MT, D, D, D, D}; pg8::StaticOrder S; S.init(MT, D, G, bx);
        pg8::EpiResidN<true> E{args.in[I_X], args.in[I_CTX], XL, XC, mod + 2 * 1024, H, (float*)(ws + WS_ROWSS), args.in[I_N2G], mod + 4 * 1024};
        pg8::gemm_phase<pg8::EpiResidN<true>, pg8::StaticOrder, true, true>(lds + RING_OFF, g, S, E);
        {
            const int nun = (MT / 256) * (D / 256), rounds = (nun + G - 1) / G, nlast = nun - (rounds - 1) * G, nidle = G - nlast, ii = bx - nlast;
            if (ii >= 0) {
                if (args.sub & 2) for (int u = ii; u < 128; u += nidle) p0_s5gen(args, u >> 1, u & 1, lds, tid);
                const bool cvw = (nidle > 128) ? (ii >= 128) : true;
                const int cw = (nidle > 128) ? (ii - 128) * NWAVES + wave : ii * NWAVES + wave, cn = (nidle > 128) ? (nidle - 128) * NWAVES : nidle * NWAVES;
                if (cvw) {
                    shw_rows((const bf16*)(ws + WS_W13), 2 * FFN, mod + 3 * 1024, (float*)(ws + WS_SHW13), cw, cn, lds, tid, lane);
                    shw_rows((const bf16*)(ws + WS_SIN), D, mod + 9 * 6144, (float*)(ws + WS_SHWS), cw, cn, lds, tid, lane);
                    moe_convert(args, lds, 0, CVQ4, cw, cn, wave, lane); }
            }
            if (nidle <= 0) { for (int u = bx; u < 128; u += G) p0_s5gen(args, u >> 1, u & 1, lds, tid);
                shw_rows((const bf16*)(ws + WS_W13), 2 * FFN, mod + 3 * 1024, (float*)(ws + WS_SHW13), gw, NGW, lds, tid, lane); shw_rows((const bf16*)(ws + WS_SIN), D, mod + 9 * 6144, (float*)(ws + WS_SHWS), gw, NGW, lds, tid, lane);
                moe_convert(args, lds, 0, CVQ4, gw, NGW, wave, lane); }
        }
        SEAM(4);
    }
    if (IN(5)) {
        pg8::Gemm g{H, (const bf16*)(ws + WS_W13), MT, 2 * FFN, D, D, D}; pg8::StaticOrder S; S.init(MT, 2 * FFN, G, bx);
        LAS float* rt = (LAS float*)(lds + RING_BYTES); pg8::rstd_prepass(S, (const float*)(ws + WS_ROWSS), rt, EPS, tid);
        pg8::EpiSwiGLUN E{(bf16*)(ws + WS_ACT), FFN, rt, (const float*)(ws + WS_SHW13), 2 * FFN};
        pg8::gemm_phase<pg8::EpiSwiGLUN, pg8::StaticOrder, true, true>(lds + RING_OFF, g, S, E);
        TAIL_CONVERT((MT / 256) * (2 * FFN / 256), CVQ4, CVQ6);
        SEAM(5);
    }
    if (IN(6)) {
        pg8::Gemm g{(const bf16*)(ws + WS_ACT), (const bf16*)(ws + WS_W2), MT, D, FFN, FFN, FFN}; pg8::StaticOrder S; S.init(MT, D, G, bx);
        pg8::EpiResidN<false> E{XL, XC, XL, XC, mod + 5 * 1024, H, (float*)(ws + WS_ROWSS), args.in[I_N1G] + D, mod + 9 * 6144 + 1 * 1024};
        pg8::gemm_phase<pg8::EpiResidN<false>, pg8::StaticOrder, true, true>(lds + RING_OFF, g, S, E);
        TAIL_CONVERT((MT / 256) * (D / 256), CVQ4 + CVQ6, CVQ7);
        SEAM(6);
    }
    float* mod1 = mod + 9 * 6144;
    if (IN(7)) {
        pg8::Gemm g{H, (const bf16*)(ws + WS_SIN), MT, D, D, D, D}; pg8::StaticOrder S; S.init(MT, D, G, bx);
        LAS float* rt = (LAS float*)(lds + RING_BYTES); pg8::rstd_prepass(S, (const float*)(ws + WS_ROWSS), rt, EPS, tid);
        pg8::EpiUC E{(bf16*)(ws + WS_UC), rt, (const float*)(ws + WS_SHWS)};
        pg8::gemm_phase<pg8::EpiUC, pg8::StaticOrder, true, true>(lds + RING_OFF, g, S, E);
        TAIL_CONVERT((MT / 256) * (D / 256), CVQ4 + CVQ6 + CVQ7, CVQ9);
        SEAM(7);
    }
    if (IN(8)) {
        pg8::Gemm g{(const bf16*)(ws + WS_UC), (const bf16*)(ws + WS_WEND), 64 * 768, 64 * 256, 512, 768, 512}; pg8::OrderS5E S{G, bx};
        pg8::EpiE E{(float*)(ws + WS_E)};
        pg8::gemm_phase<pg8::EpiE, pg8::OrderS5E, true, true>(lds + RING_OFF, g, S, E);
        if (G == 256) { if ((bx >> 3) >= 24) moe_convert(args, lds, CVQ4 + CVQ6 + CVQ7 + CVQ9, CVQS1, (((bx >> 3) - 24) * 8 + (bx & 7)) * NWAVES + wave, 64 * NWAVES, wave, lane); }
        else moe_convert(args, lds, CVQ4 + CVQ6 + CVQ7 + CVQ9, CVQS1, gw, NGW, wave, lane);
        SEAM(8);
    }
    if (IN(9)) { s5_scan(args, bx * (NWAVES * 64) + tid);
        if (G > 128) { if (bx >= 128) moe_convert(args, lds, CVQ4 + CVQ6 + CVQ7 + CVQ9 + CVQS1, CVQS2, (bx - 128) * NWAVES + wave, (G - 128) * NWAVES, wave, lane); }
        else moe_convert(args, lds, CVQ4 + CVQ6 + CVQ7 + CVQ9 + CVQS1, CVQS2, gw, NGW, wave, lane);
        SEAM(9); }
    if (IN(10)) {
        pg8::Gemm g{(const bf16*)(ws + WS_UC), (const bf16*)(ws + WS_BTOUT), 64 * 768, 64 * 512, 768, 768, 768}; pg8::OrderS5Y S{G, bx};
        pg8::EpiY E{(bf16*)(ws + WS_Y)};
        pg8::gemm_phase<pg8::EpiY, pg8::OrderS5Y, true, true>(lds + RING_OFF, g, S, E);
        SEAM(10);
    }
    if (IN(11)) {
        pg8::Gemm g{(const bf16*)(ws + WS_Y), (const bf16*)(ws + WS_SOUT), ML, 2 * D, D, D, D}; pg8::StaticOrder S; S.init(ML, 2 * D, G, bx);
        pg8::EpiGLURes E{XL, mod1 + 2 * 1024};
        pg8::gemm_phase<pg8::EpiGLURes, pg8::StaticOrder, true, true>(lds + RING_OFF, g, S, E);
        SEAM(11);
    }
    unsigned char* tok = ws + WS_TOK;
    if (IN(12)) {
        int* rowsrc = (int*)(tok + TOK_ROWSRC); int* rowinfo = (int*)(tok + TOK_ROWINFO); float* rowgate = (float*)(tok + TOK_ROWGATE);
        for (int i = bx * (NWAVES * 64) + tid; i < MOE_TILES * 256; i += G * NWAVES * 64) { rowsrc[i] = 0; rowinfo[i] = -1; rowgate[i] = 0.f; ((float*)(ws + WS_POSSC))[i] = 0.f; }
        for (int ch = bx; ch < ML / 64; ch += G) moe_route(args, XL, mod1, H, ch, (LAS unsigned*)lds, tid, wave, lane);
        SEAM(12);
    }
    if (IN(13)) {
        int toff[9]; moe_offsets(ws, toff);
        const int* tokE = (const int*)(tok + TOK_E); const float* tokW = (const float*)(tok + TOK_W); const int* tokRank = (const int*)(tok + TOK_RANK); const int* wgbase = (const int*)(tok + TOK_WGBASE);
        int* rowsrc = (int*)(tok + TOK_ROWSRC); int* rowinfo = (int*)(tok + TOK_ROWINFO); float* rowgate = (float*)(tok + TOK_ROWGATE); int* tokPos = (int*)(tok + TOK_POS);
        for (int i = bx * (NWAVES * 64) + tid; i < 2 * ML; i += G * NWAVES * 64) { const int t = i >> 1, e = tokE[i]; int to = 0;
#pragma unroll
            for (int q = 0; q < 8; ++q) to = (e == q) ? toff[q] : to;
            const int pos = to * 256 + wgbase[(t >> 6) * 8 + e] + tokRank[i];
            rowsrc[pos] = t; rowinfo[pos] = i; rowgate[pos] = tokW[i]; tokPos[i] = pos; ((float*)(ws + WS_POSSC))[pos] = ((const float*)(ws + WS_ROWSC))[t]; }
        quant_rows_inplace((bf16*)(ws + WS_MW13), (unsigned*)(ws + WS_COLMAX), NE * 2 * ED, gw, NGW, lane);
        SEAM(13);
    }
    if (IN(14)) {
        pg8::OrderMoE S; S.G = G; S.c = bx; S.nN = 2 * ED / 256; S.tmax = 1 << 30; S.fix = (args.sub >> 7) & 1; moe_offsets(ws, S.toff);
        pg8::Gemm g{H, (const bf16*)(ws + WS_MW13), MOE_TILES * 256, NE * 2 * ED, D / 2, D / 2, D, (const int*)(tok + TOK_ROWSRC)};
        pg8::EpiSwiGLUq E{(bf16*)(ws + WS_ACTM), ED, 2 * ED / 256, (const float*)(ws + WS_POSSC), (const float*)(ws + WS_COLSC)};
        pg8::gemm_phase<pg8::EpiSwiGLUq, pg8::OrderMoE, true, true, true>(lds + RING_OFF, g, S, E);
        SEAM(14);
    }
    if (IN(15)) {
        pg8::OrderMoE S; S.G = G; S.c = bx; S.nN = D / 256; S.tmax = 128; S.fix = 0; moe_offsets(ws, S.toff);
        pg8::Gemm g{(const bf16*)(ws + WS_ACTM), (const bf16*)(ws + WS_MW2), MOE_TILES * 256, NE * D, ED, ED, ED};
        pg8::EpiMoE2 E{(bf16*)args.out, (const float*)(tok + TOK_ROWGATE), (const int*)(tok + TOK_ROWINFO)};
        pg8::gemm_phase<pg8::EpiMoE2, pg8::OrderMoE, true, true>(lds + RING_OFF, g, S, E);
        pg8::OrderMoEx Sx; Sx.G = G; Sx.c = bx; moe_offsets(ws, Sx.toff);
        pg8::Gemm gx{(const bf16*)(ws + WS_ACTM), (const bf16*)(ws + WS_MW2), MOE_TILES * 256, NE * D, 896, ED, ED};
        pg8::EpiMoE2x Ex{(float*)(ws + WS_PX), (const float*)(tok + TOK_ROWGATE)};
        pg8::gemm_phase<pg8::EpiMoE2x, pg8::OrderMoEx, true, false>(lds + RING_OFF, gx, Sx, Ex);
        SEAM(15);
    }
    if (IN(16)) {
        const unsigned bad = __hip_atomic_load((unsigned*)(ws + WS_CTL) + CW_BAR + XB_TMO, RLX_AGENT);
        const int* tokPos = (const int*)(tok + TOK_POS); const float* PX = (const float*)(ws + WS_PX);
        for (int tb = gw; tb < ML; tb += 2 * NGW) {
            const int tt[2] = {tb, (tb + NGW < ML) ? tb + NGW : tb}; const int ntk = (tb + NGW < ML) ? 2 : 1;
            v2u a[2][4], b[2][4], xw[2][4]; f32x4 gv[2][4]; int p0[2], p1[2];
#pragma unroll
            for (int u = 0; u < 2; ++u) { const int t = tt[u]; const bf16* y0 = (const bf16*)(args.out + (size_t)t * D); const bf16* y1 = y0 + D; const float* gp = mod1 + (size_t)(t >> 11) * 6144 + 5 * 1024;
                p0[u] = tokPos[2 * t] - 128 * 256; p1[u] = tokPos[2 * t + 1] - 128 * 256;
#pragma unroll
                for (int j = 0; j < 4; ++j) { const int c = 4 * lane + 256 * j; a[u][j] = *(const v2u*)(y0 + c); b[u][j] = *(const v2u*)(y1 + c); xw[u][j] = *(const v2u*)(XL + (size_t)t * D + c); gv[u][j] = *(const f32x4*)(gp + c); } }
            asm volatile("s_waitcnt vmcnt(0)" ::: "memory");
#pragma unroll
            for (int u = 0; u < 2; ++u) { if (u < ntk) { const int t = tt[u];
#pragma unroll
                for (int j = 0; j < 4; ++j) { const int c = 4 * lane + 256 * j;
                    f32x4 ya = (f32x4){bflo(a[u][j].x), bfhi(a[u][j].x), bflo(a[u][j].y), bfhi(a[u][j].y)}, yb = (f32x4){bflo(b[u][j].x), bfhi(b[u][j].x), bflo(b[u][j].y), bfhi(b[u][j].y)};
                    if (p0[u] >= 0) { const float* q = PX + (size_t)p0[u] * D + c; ya = ((*(const f32x4*)q + *(const f32x4*)(q + (size_t)2048 * D)) + *(const f32x4*)(q + (size_t)4096 * D)) + *(const f32x4*)(q + (size_t)6144 * D); }
                    if (p1[u] >= 0) { const float* q = PX + (size_t)p1[u] * D + c; yb = ((*(const f32x4*)q + *(const f32x4*)(q + (size_t)2048 * D)) + *(const f32x4*)(q + (size_t)4096 * D)) + *(const f32x4*)(q + (size_t)6144 * D); }
                    const f32x4 xv = (f32x4){bflo(xw[u][j].x), bfhi(xw[u][j].x), bflo(xw[u][j].y), bfhi(xw[u][j].y)};
                    f32x4 o = xv + gv[u][j] * (ya + yb); if (bad) o = (f32x4){__builtin_nanf(""), __builtin_nanf(""), __builtin_nanf(""), __builtin_nanf("")};
                    *(f32x4*)(args.out + (size_t)t * D + c) = o; } } }
        }
    }
#undef IN
#undef SEAM
}

extern "C" void kernel_launch(void* const* d_in, const int* in_sizes, int n_in, void* d_out, int out_size, void* d_ws, size_t ws_size, hipStream_t stream) {
    static int grid = 0;
    if (grid == 0) {
        if (n_in != N_IN || out_size != ML * D || ws_size < WS_END) { fprintf(stderr, "kernel_launch: unexpected problem (n_in %d, out %d, ws %zu); nothing launched\n", n_in, out_size, ws_size); grid = -1; return; }
        int dev = 0, cus = 0, per_cu = 0;
        if (hipGetDevice(&dev) != hipSuccess || hipDeviceGetAttribute(&cus, hipDeviceAttributeMultiprocessorCount, dev) != hipSuccess) { grid = -1; return; }
        if (hipFuncSetAttribute((const void*)fwd_kernel, hipFuncAttributeMaxDynamicSharedMemorySize, LDS_BYTES) != hipSuccess) { fprintf(stderr, "kernel_launch: hipFuncSetAttribute failed\n"); grid = -1; return; }
        if (hipOccupancyMaxActiveBlocksPerMultiprocessor(&per_cu, (const void*)fwd_kernel, NWAVES * 64, LDS_BYTES) != hipSuccess || per_cu < 1) { fprintf(stderr, "kernel_launch: occupancy query says %d blocks per CU\n", per_cu); (void)hipGetLastError(); grid = -1; return; }
        grid = cus;
    }
    if (grid < 0) return;
    if (hipMemsetAsync((char*)d_ws + WS_CTL, 0, CTL_ZERO_BYTES, stream) != hipSuccess) return;
    Args a{};
    for (int i = 0; i < N_IN; ++i) a.in[i] = (const float*)d_in[i];
    a.out = (float*)d_out; a.ws = (unsigned char*)d_ws; a.sub = 63;
#if MK_N_LAUNCHES == 1
    a.ph_lo = 0; a.ph_hi = NPHASE;
    hipLaunchKernelGGL(fwd_kernel, dim3(grid), dim3(NWAVES * 64), LDS_BYTES, stream, a);
#else
    for (int p = 0; p < NPHASE; ++p) { const int nrep = ((MK_REPEAT_MASK >> p) & 1u) ? 2 : 1;
        for (int r = 0; r < nrep; ++r) { a.ph_lo = p; a.ph_hi = p + 1; a.sub = (r == 0) ? 63 : MK_REPEAT_SUB; hipLaunchKernelGGL(fwd_kernel, dim3(grid), dim3(NWAVES * 64), LDS_BYTES, stream, a); } }
#endif
}
```

```cpp
#include <hip/hip_runtime.h>
#include <cstdio>
#include <cstdint>
#ifndef MK_N_LAUNCHES
#define MK_N_LAUNCHES 1
#endif
#ifndef MK_REPEAT_SUB
#define MK_REPEAT_SUB 63
#endif
#ifndef MK_REPEAT_MASK
#define MK_REPEAT_MASK 0u
#endif
namespace pg8 {
#define PG8_LAS __attribute__((address_space(3)))
typedef unsigned short bf16_t;
typedef short bf16x8 __attribute__((ext_vector_type(8)));
typedef float f32x4 __attribute__((ext_vector_type(4)));
typedef unsigned u32x4 __attribute__((ext_vector_type(4)));
typedef unsigned u32x2 __attribute__((ext_vector_type(2)));
typedef int i32x4 __attribute__((ext_vector_type(4)));
__device__ __forceinline__ f32x4 mma16(bf16x8 a, bf16x8 b, f32x4 c) { return __builtin_amdgcn_mfma_f32_16x16x32_bf16(a, b, c, 0, 0, 0); }
__device__ __forceinline__ i32x4 mma16(bf16x8 a, bf16x8 b, i32x4 c) { return __builtin_amdgcn_mfma_i32_16x16x64_i8(__builtin_bit_cast(i32x4, a), __builtin_bit_cast(i32x4, b), c, 0, 0, 0); }
constexpr int BM = 256, BK = 64, HALF = 128, HTB = HALF * BK * 2  , STAGE_BYTES = 8 * HTB, NXCD = 8, WGM = 8;

__host__ __device__ __forceinline__ int lds_byte(int r, int c) { const int st = (r >> 4) * 2 + (c >> 5), rr = r & 15, cc = c & 31, ob = rr * 64 + cc * 2; return st * 1024 + (ob ^ (((ob >> 9) & 1) << 5)); }
__host__ __device__ __forceinline__ void stage_rc(int b, int& R, int& C) { const int st = b / 1024, sb = b % 1024, swz = sb ^ (((sb >> 9) & 1) << 5); R = (st >> 1) * 16 + swz / 64; C = (st & 1) * 32 + (swz % 64) / 2; }
__host__ __device__ __forceinline__ int perm32(int rho) { const int n = rho >> 4, i = rho & 15; return 8 * (i >> 2) + 4 * n + (i & 3); }

struct Unit { int pm, pn, k0, idx; };
struct Gemm { const bf16_t* A; const bf16_t* Bt; int M, N, K, lda, ldb; const int* rowsrc; };

struct StaticOrder {
    int nM, nN, nwg, G, c;
    __host__ __device__ void init(int M, int N, int G_, int c_) { nM = M / BM; nN = N / BM; nwg = nM * nN; G = G_; c = c_; }
    __host__ __device__ bool next(int i, Unit& u) const {
        const long L = (long)i * G + c; if (L >= nwg) return false;
        int wgid = (int)L; { const int q = nwg / NXCD, r = nwg % NXCD, xcd = wgid % NXCD, off = wgid / NXCD; wgid = (xcd < r ? xcd * (q + 1) : r * (q + 1) + (xcd - r) * q) + off; }
        const int nig = WGM * nN, gid = wgid / nig, fm = gid * WGM, gsz = (nM - fm) < WGM ? (nM - fm) : WGM;
        u.pm = fm + ((wgid % nig) % gsz); u.pn = (wgid % nig) / gsz; u.k0 = 0; u.idx = i; return true;
    }
    __device__ __forceinline__ void a_ready(const Unit&) const {}
    __device__ __forceinline__ void done(const Unit&) const {}
};

constexpr int ML_ = 16384, MC_ = 2048, MT_ = ML_ + MC_, DM_ = 1024;
__device__ __forceinline__ unsigned cvt_pk_bf16(float lo, float hi) { unsigned r; asm volatile("v_cvt_pk_bf16_f32 %0, %1, %2" : "=v"(r) : "v"(lo), "v"(hi)); return r; }
__device__ __forceinline__ float sigm(float x) { return __builtin_amdgcn_rcpf(1.0f + __expf(-x)); }
__device__ __forceinline__ float gelu_tanh(float x) { const float u = 1.5957691216f * (x + 0.044715f * x * x * x); return x * sigm(u); }
__device__ __forceinline__ u32x4 pack8(const f32x4 a, const f32x4 b) { u32x4 w; w.x = cvt_pk_bf16(a[0], a[1]); w.y = cvt_pk_bf16(a[2], a[3]); w.z = cvt_pk_bf16(b[0], b[1]); w.w = cvt_pk_bf16(b[2], b[3]); return w; }


struct EpiQKVU {
    typedef f32x4 acc_t; static constexpr bool PERM = true, AFTER_DRAIN = false;
    bf16_t* O; const float* gq; const float* gk; float eps;
    __device__ __forceinline__ void operator()(const f32x4 (&acc)[2][2][4][2], const Unit& u, int wr, int wc, int fr, int fq) const {
        const int row0 = u.pm * BM + wr * 64 + fr; const int pn = u.pn;
        if (pn < 6) {
            const bool nrm = pn < 4; const float* gp = (pn < 2) ? gq : gk;
            f32x4 gn[2][2];
#pragma unroll
            for (int bj = 0; bj < 2; ++bj)
#pragma unroll
                for (int n = 0; n < 2; ++n) gn[bj][n] = nrm ? *(const f32x4*)(gp + 32 * bj + 8 * fq + 4 * n) : (f32x4){1.f, 1.f, 1.f, 1.f};
#pragma unroll
            for (int ai = 0; ai < 2; ++ai)
#pragma unroll
                for (int m = 0; m < 4; ++m) {
                    float sc = 1.f;
                    if (nrm) { float ss = 0.f;
#pragma unroll
                        for (int bj = 0; bj < 2; ++bj)
#pragma unroll
                            for (int n = 0; n < 2; ++n) { const f32x4 x = acc[ai][bj][m][n]; ss += (x[0] * x[0] + x[1] * x[1]) + (x[2] * x[2] + x[3] * x[3]); }
                        ss += __shfl_xor(ss, 16); ss += __shfl_xor(ss, 32);
                        sc = rsqrtf(ss * (1.0f / 64.0f) + eps); }
                    bf16_t* rowp = O + (size_t)(row0 + ai * HALF + m * 16) * 2048 + 256 * pn + 64 * wc + 8 * fq;
#pragma unroll
                    for (int bj = 0; bj < 2; ++bj) { const f32x4 v0 = acc[ai][bj][m][0] * gn[bj][0] * sc, v1 = acc[ai][bj][m][1] * gn[bj][1] * sc; *(u32x4*)(rowp + 32 * bj) = pack8(v0, v1); }
                }
        } else {
            const int cb = 1536 + 128 * (pn - 6) + 32 * wc + 8 * fq;
#pragma unroll
            for (int ai = 0; ai < 2; ++ai)
#pragma unroll
                for (int m = 0; m < 4; ++m) {
                    f32x4 v[2];
#pragma unroll
                    for (int n = 0; n < 2; ++n) { const f32x4 a = acc[ai][0][m][n], g = acc[ai][1][m][n]; v[n] = (f32x4){a[0] * sigm(g[0]), a[1] * sigm(g[1]), a[2] * sigm(g[2]), a[3] * sigm(g[3])}; }
                    *(u32x4*)(O + (size_t)(row0 + ai * HALF + m * 16) * 2048 + cb) = pack8(v[0], v[1]);
                }
        }
    }
};
struct EpiQKVUq {
    typedef i32x4 acc_t; static constexpr bool PERM = true, AFTER_DRAIN = false;
    bf16_t* O; const float* gq; const float* gk; float eps; const float* rowfac; const float* colscale;
    __device__ __forceinline__ void operator()(const i32x4 (&acc)[2][2][4][2], const Unit& u, int wr, int wc, int fr, int fq) const {
        const int row0 = u.pm * BM + wr * 64 + fr; const int pn = u.pn;
        f32x4 cs[2][2];
#pragma unroll
        for (int bj = 0; bj < 2; ++bj)
#pragma unroll
            for (int n = 0; n < 2; ++n) cs[bj][n] = *(const f32x4*)(colscale + pn * BM + bj * HALF + wc * 32 + 8 * fq + 4 * n);
#define QF(ai_, bj_, m_, n_, rf_) ((f32x4){(float)acc[ai_][bj_][m_][n_][0], (float)acc[ai_][bj_][m_][n_][1], (float)acc[ai_][bj_][m_][n_][2], (float)acc[ai_][bj_][m_][n_][3]} * cs[bj_][n_] * (rf_))
        if (pn < 6) {
            const bool nrm = pn < 4; const float* gp = (pn < 2) ? gq : gk;
            f32x4 gn[2][2];
#pragma unroll
            for (int bj = 0; bj < 2; ++bj)
#pragma unroll
                for (int n = 0; n < 2; ++n) gn[bj][n] = nrm ? *(const f32x4*)(gp + 32 * bj + 8 * fq + 4 * n) : (f32x4){1.f, 1.f, 1.f, 1.f};
#pragma unroll
            for (int ai = 0; ai < 2; ++ai)
#pragma unroll
                for (int m = 0; m < 4; ++m) {
                    float sc = 1.f; const float rf = rowfac[row0 + ai * HALF + m * 16];
                    f32x4 xf[2][2];
#pragma unroll
                    for (int bj = 0; bj < 2; ++bj)
#pragma unroll
                        for (int n = 0; n < 2; ++n) xf[bj][n] = QF(ai, bj, m, n, rf);
                    if (nrm) { float ss = 0.f;
#pragma unroll
                        for (int bj = 0; bj < 2; ++bj)
#pragma unroll
                            for (int n = 0; n < 2; ++n) { const f32x4 x = xf[bj][n]; ss += (x[0] * x[0] + x[1] * x[1]) + (x[2] * x[2] + x[3] * x[3]); }
                        ss += __shfl_xor(ss, 16); ss += __shfl_xor(ss, 32);
                        sc = rsqrtf(ss * (1.0f / 64.0f) + eps); }
                    bf16_t* rowp = O + (size_t)(row0 + ai * HALF + m * 16) * 2048 + 256 * pn + 64 * wc + 8 * fq;
#pragma unroll
                    for (int bj = 0; bj < 2; ++bj) { const f32x4 v0 = xf[bj][0] * gn[bj][0] * sc, v1 = xf[bj][1] * gn[bj][1] * sc; *(u32x4*)(rowp + 32 * bj) = pack8(v0, v1); }
                }
        } else {
            const int cb = 1536 + 128 * (pn - 6) + 32 * wc + 8 * fq;
#pragma unroll
            for (int ai = 0; ai < 2; ++ai)
#pragma unroll
                for (int m = 0; m < 4; ++m) { const float rf = rowfac[row0 + ai * HALF + m * 16];
                    f32x4 v[2];
#pragma unroll
                    for (int n = 0; n < 2; ++n) { const f32x4 a = QF(ai, 0, m, n, rf), g = QF(ai, 1, m, n, rf); v[n] = (f32x4){a[0] * sigm(g[0]), a[1] * sigm(g[1]), a[2] * sigm(g[2]), a[3] * sigm(g[3])}; }
                    *(u32x4*)(O + (size_t)(row0 + ai * HALF + m * 16) * 2048 + cb) = pack8(v[0], v[1]);
                }
        }
    }
};
#undef QF
struct EpiResid {
    typedef f32x4 acc_t; static constexpr bool PERM = false, AFTER_DRAIN = false;
    const float* baseL; const float* baseC; float* XL; float* XC; const float* gate;
    __device__ __forceinline__ void operator()(const f32x4 (&acc)[2][2][4][2], const Unit& u, int wr, int wc, int fr, int fq) const {
        const int R0 = u.pm * BM, row0 = R0 + wr * 64 + fr, col0 = u.pn * BM + wc * 32 + 4 * fq;
        const int modrow = R0 < ML_ ? (R0 >> 11) : 8;
        const float* gp = gate + (size_t)modrow * 6144 + col0;
        const float* bp = R0 < ML_ ? baseL : baseC - (size_t)ML_ * DM_;
        float* xo = R0 < ML_ ? XL : XC - (size_t)ML_ * DM_;
        f32x4 gv[2][2];
#pragma unroll
        for (int bj = 0; bj < 2; ++bj)
#pragma unroll
            for (int n = 0; n < 2; ++n) gv[bj][n] = *(const f32x4*)(gp + bj * HALF + n * 16);
#pragma unroll
        for (int ai = 0; ai < 2; ++ai)
#pragma unroll
            for (int m = 0; m < 4; ++m) { const size_t ro = (size_t)(row0 + ai * HALF + m * 16) * DM_ + col0;
#pragma unroll
                for (int bj = 0; bj < 2; ++bj)
#pragma unroll
                    for (int n = 0; n < 2; ++n) { const f32x4 xv = *(const f32x4*)(bp + ro + bj * HALF + n * 16); *(f32x4*)(xo + ro + bj * HALF + n * 16) = xv + gv[bj][n] * acc[ai][bj][m][n]; } }
    }
};
__device__ __forceinline__ void unpack8(const u32x4 w, f32x4& a, f32x4& b) {
    a = (f32x4){__builtin_bit_cast(float, w.x << 16), __builtin_bit_cast(float, w.x & 0xffff0000u), __builtin_bit_cast(float, w.y << 16), __builtin_bit_cast(float, w.y & 0xffff0000u)};
    b = (f32x4){__builtin_bit_cast(float, w.z << 16), __builtin_bit_cast(float, w.z & 0xffff0000u), __builtin_bit_cast(float, w.w << 16), __builtin_bit_cast(float, w.w & 0xffff0000u)}; }
template <bool BASE_F32> struct EpiResidN {
    typedef f32x4 acc_t; static constexpr bool PERM = true, AFTER_DRAIN = false;
    const void* baseL; const void* baseC; bf16_t* XL; bf16_t* XC; const float* gate; bf16_t* Hn; float* rowss; const float* ngain; const float* nscale;
    __device__ __forceinline__ void operator()(const f32x4 (&acc)[2][2][4][2], const Unit& u, int wr, int wc, int fr, int fq) const {
        const int R0 = u.pm * BM, row0 = R0 + wr * 64 + fr, col0 = u.pn * BM + wc * 32 + 8 * fq;
        const int modrow = R0 < ML_ ? (R0 >> 11) : 8, rsub = R0 < ML_ ? 0 : ML_;
        const float* gp = gate + (size_t)modrow * 6144 + col0; const float* sp = nscale + (size_t)modrow * 6144 + col0;
        const void* bp = R0 < ML_ ? baseL : baseC; bf16_t* xo = R0 < ML_ ? XL : XC;
        f32x4 gv[2][2], gs[2][2];
#pragma unroll
        for (int bj = 0; bj < 2; ++bj)
#pragma unroll
            for (int n = 0; n < 2; ++n) { gv[bj][n] = *(const f32x4*)(gp + bj * HALF + n * 4); gs[bj][n] = *(const f32x4*)(ngain + col0 + bj * HALF + n * 4) * (*(const f32x4*)(sp + bj * HALF + n * 4) + 1.0f); }
#pragma unroll
        for (int ai = 0; ai < 2; ++ai)
#pragma unroll
            for (int m = 0; m < 4; ++m) { const int row = row0 + ai * HALF + m * 16; const size_t ro = (size_t)(row - rsub) * DM_ + col0; float ss = 0.f;
#pragma unroll
                for (int bj = 0; bj < 2; ++bj) { f32x4 x0, x1;
                    if constexpr (BASE_F32) { x0 = *(const f32x4*)((const float*)bp + ro + bj * HALF); x1 = *(const f32x4*)((const float*)bp + ro + bj * HALF + 4); }
                    else unpack8(*(const u32x4*)((const bf16_t*)bp + ro + bj * HALF), x0, x1);
                    const u32x4 xw = pack8(x0 + gv[bj][0] * acc[ai][bj][m][0], x1 + gv[bj][1] * acc[ai][bj][m][1]); *(u32x4*)(xo + ro + bj * HALF) = xw;
                    f32x4 r0, r1; unpack8(xw, r0, r1);
                    ss += ((r0[0] * r0[0] + r0[1] * r0[1]) + (r0[2] * r0[2] + r0[3] * r0[3])) + ((r1[0] * r1[0] + r1[1] * r1[1]) + (r1[2] * r1[2] + r1[3] * r1[3]));
                    *(u32x4*)(Hn + (size_t)row * DM_ + col0 + bj * HALF) = pack8(r0 * gs[bj][0], r1 * gs[bj][1]); }
                ss += __shfl_xor(ss, 16); ss += __shfl_xor(ss, 32);
                if (fq == 0) rowss[(size_t)row * 16 + u.pn * 4 + wc] = ss; }
    }
};
__device__ __forceinline__ float row_rstd(const float* rowss, int row, float eps) {
    const f32x4* p = (const f32x4*)(rowss + (size_t)row * 16); const f32x4 a = p[0], b = p[1], c = p[2], d = p[3];
    const float s = (((a[0] + a[1]) + (a[2] + a[3])) + ((b[0] + b[1]) + (b[2] + b[3]))) + (((c[0] + c[1]) + (c[2] + c[3])) + ((d[0] + d[1]) + (d[2] + d[3])));
    return rsqrtf(s * (1.0f / 1024.0f) + eps); }
template <class Sched> __device__ __forceinline__ void rstd_prepass(const Sched& S, const float* rowss, PG8_LAS float* rt, float eps, int tid) {
    Unit u; int n = 0; while (n < 8 && S.next(n, u)) ++n;
#pragma unroll
    for (int q = 0; q < 4; ++q) { const int r = tid + 512 * q, i = r >> 8;
        if (i < n) { S.next(i, u); rt[r] = row_rstd(rowss, u.pm * BM + (r & 255), eps); } }
    __syncthreads();
}
struct EpiSwiGLUN {
    typedef f32x4 acc_t; static constexpr bool PERM = true, AFTER_DRAIN = false;
    bf16_t* O; int ldo; const PG8_LAS float* rt; const float* shw; int nphys;
    __device__ __forceinline__ void operator()(const f32x4 (&acc)[2][2][4][2], const Unit& u, int wr, int wc, int fr, int fq) const {
        const int R0 = u.pm * BM, row0 = R0 + wr * 64 + fr, colp = u.pn * BM + wc * 32 + 8 * fq, col0 = u.pn * HALF + wc * 32 + 8 * fq;
        const float* sp = shw + (size_t)(R0 < ML_ ? (R0 >> 11) : 8) * nphys + colp;
        f32x4 s1[2], s3[2];
#pragma unroll
        for (int n = 0; n < 2; ++n) { s1[n] = *(const f32x4*)(sp + 4 * n); s3[n] = *(const f32x4*)(sp + HALF + 4 * n); }
#pragma unroll
        for (int ai = 0; ai < 2; ++ai)
#pragma unroll
            for (int m = 0; m < 4; ++m) { const int row = row0 + ai * HALF + m * 16; const float rs = rt[u.idx * BM + (row - R0)];
                f32x4 v[2];
#pragma unroll
                for (int n = 0; n < 2; ++n) { const f32x4 a = acc[ai][0][m][n] * rs + s1[n], b = acc[ai][1][m][n] * rs + s3[n]; v[n] = (f32x4){a[0] * sigm(a[0]) * b[0], a[1] * sigm(a[1]) * b[1], a[2] * sigm(a[2]) * b[2], a[3] * sigm(a[3]) * b[3]}; }
                *(u32x4*)(O + (size_t)row * ldo + col0) = pack8(v[0], v[1]);
            }
    }
};
struct EpiSwiGLU {
    typedef f32x4 acc_t; static constexpr bool PERM = true, AFTER_DRAIN = false;
    bf16_t* O; int ldo, nN, row_sub; int skip;
    __device__ __forceinline__ void operator()(const f32x4 (&acc)[2][2][4][2], const Unit& u, int wr, int wc, int fr, int fq) const {
        if (skip) {
#pragma unroll
            for (int ai = 0; ai < 2; ++ai)
#pragma unroll
                for (int bj = 0; bj < 2; ++bj)
#pragma unroll
                    for (int m = 0; m < 4; ++m)
#pragma unroll
                        for (int n = 0; n < 2; ++n) asm volatile("" :: "v"(acc[ai][bj][m][n]));
            return; }
        const int row0 = u.pm * BM + wr * 64 + fr - row_sub, col0 = (u.pn % nN) * HALF + wc * 32 + 8 * fq;
#pragma unroll
        for (int ai = 0; ai < 2; ++ai)
#pragma unroll
            for (int m = 0; m < 4; ++m) {
                f32x4 v[2];
#pragma unroll
                for (int n = 0; n < 2; ++n) { const f32x4 a = acc[ai][0][m][n], b = acc[ai][1][m][n]; v[n] = (f32x4){a[0] * sigm(a[0]) * b[0], a[1] * sigm(a[1]) * b[1], a[2] * sigm(a[2]) * b[2], a[3] * sigm(a[3]) * b[3]}; }
                *(u32x4*)(O + (size_t)(row0 + ai * HALF + m * 16) * ldo + col0) = pack8(v[0], v[1]);
            }
    }
};
struct EpiSwiGLUq {
    typedef i32x4 acc_t; static constexpr bool PERM = true, AFTER_DRAIN = false;
    bf16_t* O; int ldo, nN; const float* posscale; const float* colscale;
    __device__ __forceinline__ void operator()(const i32x4 (&acc)[2][2][4][2], const Unit& u, int wr, int wc, int fr, int fq) const {
        const int row0 = u.pm * BM + wr * 64 + fr, col0 = (u.pn % nN) * HALF + wc * 32 + 8 * fq; const float* cp = colscale + (size_t)u.pn * BM + wc * 32 + 8 * fq;
        f32x4 c1[2], c3[2];
#pragma unroll
        for (int n = 0; n < 2; ++n) { c1[n] = *(const f32x4*)(cp + 4 * n); c3[n] = *(const f32x4*)(cp + HALF + 4 * n); }
#pragma unroll
        for (int ai = 0; ai < 2; ++ai)
#pragma unroll
            for (int m = 0; m < 4; ++m) { const int row = row0 + ai * HALF + m * 16; const float rs = posscale[row];
                f32x4 v[2];
#pragma unroll
                for (int n = 0; n < 2; ++n) { const i32x4 ia = acc[ai][0][m][n], ib = acc[ai][1][m][n];
                    const f32x4 a = (f32x4){(float)ia[0], (float)ia[1], (float)ia[2], (float)ia[3]} * c1[n] * rs, b = (f32x4){(float)ib[0], (float)ib[1], (float)ib[2], (float)ib[3]} * c3[n] * rs;
                    v[n] = (f32x4){a[0] * sigm(a[0]) * b[0], a[1] * sigm(a[1]) * b[1], a[2] * sigm(a[2]) * b[2], a[3] * sigm(a[3]) * b[3]}; }
                *(u32x4*)(O + (size_t)row * ldo + col0) = pack8(v[0], v[1]);
            }
    }
};
struct EpiGLURes {
    typedef f32x4 acc_t; static constexpr bool PERM = true, AFTER_DRAIN = false;
    bf16_t* X; const float* gate;
    __device__ __forceinline__ void operator()(const f32x4 (&acc)[2][2][4][2], const Unit& u, int wr, int wc, int fr, int fq) const {
        const int R0 = u.pm * BM, row0 = R0 + wr * 64 + fr, col0 = u.pn * HALF + wc * 32 + 8 * fq;
        const float* gp = gate + (size_t)(R0 >> 11) * 6144 + col0;
        f32x4 gv[2];
#pragma unroll
        for (int n = 0; n < 2; ++n) gv[n] = *(const f32x4*)(gp + n * 4);
#pragma unroll
        for (int ai = 0; ai < 2; ++ai)
#pragma unroll
            for (int m = 0; m < 4; ++m) { bf16_t* xp = X + (size_t)(row0 + ai * HALF + m * 16) * DM_ + col0; f32x4 x0, x1, y[2];
                unpack8(*(const u32x4*)xp, x0, x1);
#pragma unroll
                for (int n = 0; n < 2; ++n) { const f32x4 z1 = acc[ai][0][m][n], z2 = acc[ai][1][m][n]; y[n] = (f32x4){z1[0] * sigm(z2[0]), z1[1] * sigm(z2[1]), z1[2] * sigm(z2[2]), z1[3] * sigm(z2[3])}; }
                *(u32x4*)xp = pack8(x0 + gv[0] * y[0], x1 + gv[1] * y[1]); }
    }
};
struct EpiUC {
    typedef f32x4 acc_t; static constexpr bool PERM = true, AFTER_DRAIN = false;
    bf16_t* UC; const PG8_LAS float* rt; const float* shw;
    __device__ __forceinline__ void operator()(const f32x4 (&acc)[2][2][4][2], const Unit& u, int wr, int wc, int fr, int fq) const {
        const int R0 = u.pm * BM, row0 = R0 + wr * 64 + fr, col0 = u.pn * BM + wc * 32 + 8 * fq;
        const float* sp = shw + (size_t)(R0 < ML_ ? (R0 >> 11) : 8) * DM_ + col0;
        f32x4 sv[2][2];
#pragma unroll
        for (int bj = 0; bj < 2; ++bj)
#pragma unroll
            for (int n = 0; n < 2; ++n) sv[bj][n] = *(const f32x4*)(sp + bj * HALF + 4 * n);
#pragma unroll
        for (int ai = 0; ai < 2; ++ai)
#pragma unroll
            for (int m = 0; m < 4; ++m) { const int row = row0 + ai * HALF + m * 16; int bc, j; const float rs = rt[u.idx * BM + (row - R0)];
                if (row < ML_) { bc = (row >> 11) * 64 + ((row & 2047) >> 5); j = row & 31; } else { const int r2 = row - ML_; bc = 512 + (r2 >> 8) * 8 + ((r2 & 255) >> 5); j = r2 & 31; }
#pragma unroll
                for (int bj = 0; bj < 2; ++bj) { const int col = col0 + bj * HALF, g = col >> 4, qi = col & 15;
                    *(u32x4*)(UC + ((size_t)(g * 768 + bc) * 768 + j * 16 + qi)) = pack8(acc[ai][bj][m][0] * rs + sv[bj][0], acc[ai][bj][m][1] * rs + sv[bj][1]); } }
    }
};
struct EpiE {
    typedef f32x4 acc_t; static constexpr bool PERM = false, AFTER_DRAIN = false;
    float* E;
    __device__ __forceinline__ void operator()(const f32x4 (&acc)[2][2][4][2], const Unit& u, int wr, int wc, int fr, int fq) const {
        const int row0 = u.pm * BM + wr * 64 + fr, col0 = wc * 32 + 4 * fq;
#pragma unroll
        for (int ai = 0; ai < 2; ++ai)
#pragma unroll
            for (int m = 0; m < 4; ++m) { float* rp = E + (size_t)(row0 + ai * HALF + m * 16) * 256 + col0;
#pragma unroll
                for (int bj = 0; bj < 2; ++bj)
#pragma unroll
                    for (int n = 0; n < 2; ++n) *(f32x4*)(rp + bj * HALF + n * 16) = acc[ai][bj][m][n]; }
    }
};
struct EpiY {
    typedef f32x4 acc_t; static constexpr bool PERM = true, AFTER_DRAIN = false;
    bf16_t* Y;
    __device__ __forceinline__ void operator()(const f32x4 (&acc)[2][2][4][2], const Unit& u, int wr, int wc, int fr, int fq) const {
        const int g = u.pm / 3, pml = u.pm - 3 * g, pnl = u.pn & 1;
        const int bc0 = pml * BM + wr * 64 + fr, n0 = pnl * BM + wc * 32 + 8 * fq;
#pragma unroll
        for (int ai = 0; ai < 2; ++ai)
#pragma unroll
            for (int m = 0; m < 4; ++m) { const int bc = bc0 + ai * HALF + m * 16, tok0 = (bc >> 6) * 2048 + (bc & 63) * 32;
#pragma unroll
                for (int bj = 0; bj < 2; ++bj) { const int n = n0 + bj * HALF, tin = n >> 4, qo = n & 15; const f32x4 a = acc[ai][bj][m][0], b = acc[ai][bj][m][1];
                    const f32x4 ya = (f32x4){gelu_tanh(a[0]), gelu_tanh(a[1]), gelu_tanh(a[2]), gelu_tanh(a[3])}, yb = (f32x4){gelu_tanh(b[0]), gelu_tanh(b[1]), gelu_tanh(b[2]), gelu_tanh(b[3])};
                    *(u32x4*)(Y + (size_t)(tok0 + tin) * DM_ + g * 16 + qo) = pack8(ya, yb); } }
    }
};
struct EpiMoE2 {
    typedef f32x4 acc_t; static constexpr bool PERM = true, AFTER_DRAIN = false;
    bf16_t* Y2; const float* rowgate; const int* rowinfo;
    __device__ __forceinline__ void operator()(const f32x4 (&acc)[2][2][4][2], const Unit& u, int wr, int wc, int fr, int fq) const {
        const int row0 = u.pm * BM + wr * 64 + fr, col0 = (u.pn & 3) * BM + wc * 32 + 8 * fq;
#pragma unroll
        for (int ai = 0; ai < 2; ++ai)
#pragma unroll
            for (int m = 0; m < 4; ++m) { const int row = row0 + ai * HALF + m * 16; const float gt = rowgate[row]; const int ri = rowinfo[row];
                if (ri >= 0) {
#pragma unroll
                    for (int bj = 0; bj < 2; ++bj) *(u32x4*)(Y2 + (size_t)ri * DM_ + col0 + bj * HALF) = pack8(acc[ai][bj][m][0] * gt, acc[ai][bj][m][1] * gt); } }
    }
};
struct OrderS5E { int G, c;
    __device__ __forceinline__ bool next(int i, Unit& u) const {
        if (G == 256) { if (i > 0) return false; const int x = c & 7, j = c >> 3; if (j >= 24) return false; const int g = 8 * (j / 3) + x; u.pm = 3 * g + (j % 3); u.pn = g; u.k0 = 0; u.idx = i; return true; }
        const int L = i * G + c; if (L >= 192) return false; u.pm = L; u.pn = L / 3; u.k0 = 0; u.idx = i; return true; }
    __device__ __forceinline__ void a_ready(const Unit&) const {}
    __device__ __forceinline__ void done(const Unit&) const {} };
struct OrderS5Y { int G, c;
    __device__ __forceinline__ bool next(int i, Unit& u) const {
        if (G == 256) { if (i > 0) return false; const int x = c & 7, j = c >> 3, g = 8 * (j >> 2) + x; u.pm = 3 * g + ((j >> 1) & 1); u.pn = 2 * g + (j & 1); u.k0 = 0; u.idx = i; return true; }
        const int L = i * G + c; if (L >= 256) return false; const int g = L >> 2; u.pm = 3 * g + ((L >> 1) & 1); u.pn = 2 * g + (L & 1); u.k0 = 0; u.idx = i; return true; }
    __device__ __forceinline__ void a_ready(const Unit&) const {}
    __device__ __forceinline__ void done(const Unit&) const {} };
struct OrderMoE { int G, c, nN, tmax, fix; int toff[9];
    __device__ __forceinline__ bool next(int i, Unit& u) const {
        int pm, pnl; const int nt = toff[8] < tmax ? toff[8] : tmax;
        if (G == 256) {
            const int x = c & 7, j = c >> 3, nCB = nN >> 2, b = i * 8 + x, nRB = (nt + 7) >> 3; if (b >= nRB * nCB) return false;
            const int rb = b / nCB, cbk = b - rb * nCB; pm = 8 * rb + (j & 7); pnl = 4 * cbk + (j >> 3);
        } else { const int L = i * G + c; pm = L / nN; pnl = L - pm * nN; }
        if (pm >= nt) return false;
        int e = 0;
#pragma unroll
        for (int k = 1; k < 8; ++k) e += (pm >= toff[k]) ? 1 : 0;
        u.pm = fix ? 0 : pm; u.pn = fix ? pnl & 3 : e * nN + pnl; u.k0 = 0; u.idx = i; return true; }
    __device__ __forceinline__ void a_ready(const Unit&) const {}
    __device__ __forceinline__ void done(const Unit&) const {} };
struct OrderMoEx { int G, c; int toff[9];
    __device__ __forceinline__ bool next(int i, Unit& u) const {
        const int s = i * G + c, tl = s >> 4, pm = 128 + tl; if (pm >= toff[8]) return false;
        int e = 0;
#pragma unroll
        for (int k = 1; k < 8; ++k) e += (pm >= toff[k]) ? 1 : 0;
        u.pm = pm; u.pn = e * 4 + ((s >> 2) & 3); u.k0 = (s & 3) * 896; u.idx = i; return true; }
    __device__ __forceinline__ void a_ready(const Unit&) const {}
    __device__ __forceinline__ void done(const Unit&) const {} };
struct EpiMoE2x {
    typedef f32x4 acc_t; static constexpr bool PERM = false, AFTER_DRAIN = false;
    float* P; const float* rowgate;
    __device__ __forceinline__ void operator()(const f32x4 (&acc)[2][2][4][2], const Unit& u, int wr, int wc, int fr, int fq) const {
        const int ks = u.k0 / 896, tl = u.pm - 128, r0 = wr * 64 + fr, col0 = (u.pn & 3) * BM + wc * 32 + 4 * fq;
        float* pb = P + ((size_t)(ks * 8 + tl) * 256) * DM_;
        const __amdgpu_buffer_rsrc_t grs = __builtin_amdgcn_make_buffer_rsrc((void*)rowgate, 0, 136 * 256 * 4, 0x00020000);
#pragma unroll
        for (int ai = 0; ai < 2; ++ai)
#pragma unroll
            for (int m = 0; m < 4; ++m) { const int r = r0 + ai * HALF + m * 16; const float gt = __builtin_bit_cast(float, __builtin_amdgcn_raw_buffer_load_b32(grs, (u.pm * BM + r) * 4, 0, 0));
#pragma unroll
                for (int bj = 0; bj < 2; ++bj)
#pragma unroll
                    for (int n = 0; n < 2; ++n) *(f32x4*)(pb + (size_t)r * DM_ + col0 + bj * HALF + n * 16) = acc[ai][bj][m][n] * gt; }
    }
};
template <class Epi, class Sched, bool ALIGN_EPI = false, bool SP2 = false, bool GATHER = false>
__device__ __forceinline__ void gemm_phase(PG8_LAS unsigned char* lds, const Gemm g, const Sched& S, const Epi& E) {
    const int tid = threadIdx.x, wid = __builtin_amdgcn_readfirstlane(tid >> 6), lane = tid & 63, wr = wid >> 2, wc = wid & 3, fr = lane & 15, fq = lane >> 4;
    const int K = g.K, nt = K / BK;
    unsigned voffA[2], voffB[2]; int RA[2]; unsigned CA[2];
    static_assert(!GATHER || SP2, "the gathered A operand is wired into the SP2 loop only");
#pragma unroll
    for (int i = 0; i < 2; ++i) { int R, C; stage_rc(tid * 16 + i * 8192, R, C); const int Rb = Epi::PERM ? ((R & ~31) + perm32(R & 31)) : R;
        voffA[i] = (unsigned)(R * g.lda + C) * 2u; voffB[i] = (unsigned)(Rb * g.ldb + C) * 2u; RA[i] = R; CA[i] = (unsigned)C * 2u; }
    const size_t kstep = (size_t)(BK * 2);
    const size_t hstepA = (size_t)HALF * g.lda * 2, hstepB = (size_t)HALF * g.ldb * 2;
    const size_t tstepA = 2 * hstepA, tstepB = 2 * hstepB;
    const unsigned ldsw = (unsigned)wid * 1024u;
    const int aoff = lds_byte(wr * 64 + fr, fq * 8), boff = lds_byte(wc * 32 + fr, fq * 8);
#define PG8_SA(b, h) (((b) * 2 + (h)) * HTB)
#define PG8_SB(b, h) ((4 + (b) * 2 + (h)) * HTB)
#define PG8_STAGE(bufoff, gbase, voff) do { _Pragma("unroll") for (int _i = 0; _i < 2; ++_i) \
        __builtin_amdgcn_global_load_lds((const unsigned*)((const char*)(gbase) + (voff)[_i]), (PG8_LAS unsigned*)(lds + (bufoff) + ldsw + _i * 8192), 16, 0, 0); } while (0)
#define PG8_LDA(dst, b, h) do { _Pragma("unroll") for (int m = 0; m < 4; ++m) _Pragma("unroll") for (int k = 0; k < 2; ++k) dst[m][k] = *(const PG8_LAS bf16x8*)(lds + PG8_SA(b, h) + aoff + m * 2048 + k * 1024); } while (0)
#define PG8_LDB(dst, b, h) do { _Pragma("unroll") for (int n = 0; n < 2; ++n) _Pragma("unroll") for (int k = 0; k < 2; ++k) dst[n][k] = *(const PG8_LAS bf16x8*)(lds + PG8_SB(b, h) + boff + n * 2048 + k * 1024); } while (0)
#define PG8_MMA(ai, bj, At, Bt) do { __builtin_amdgcn_s_setprio(1); _Pragma("unroll") for (int m = 0; m < 4; ++m) _Pragma("unroll") for (int n = 0; n < 2; ++n) _Pragma("unroll") for (int k = 0; k < 2; ++k) \
        acc[ai][bj][m][n] = mma16(Bt[n][k], At[m][k], acc[ai][bj][m][n]); __builtin_amdgcn_s_setprio(0); } while (0)
#define PG8_WAIT_V(n) asm volatile("s_waitcnt vmcnt(" #n ")" ::: "memory")
#define PG8_WAIT_L(n) asm volatile("s_waitcnt lgkmcnt(" #n ")" ::: "memory")
#define PG8_BAR __builtin_amdgcn_s_barrier()
#define PG8_SCHED __builtin_amdgcn_sched_barrier(0)
#define PG8_GIDX(d0, d1, un) do { _Pragma("unroll") for (int _i = 0; _i < 2; ++_i) { const int* _rp = g.rowsrc + (un).pm * BM + RA[_i]; d0[_i] = (unsigned)_rp[0] * (unsigned)(g.lda * 2) + CA[_i]; d1[_i] = (unsigned)_rp[HALF] * (unsigned)(g.lda * 2) + CA[_i]; } } while (0)
    Unit cur, nxt; int ui = 0;
    if (!S.next(0, cur)) return;
    typedef typename Epi::acc_t acc_t;
    acc_t acc[2][2][4][2];
#pragma unroll
    for (int a = 0; a < 2; ++a)
#pragma unroll
        for (int b = 0; b < 2; ++b)
#pragma unroll
            for (int m = 0; m < 4; ++m)
#pragma unroll
                for (int n = 0; n < 2; ++n) acc[a][b][m][n] = (acc_t){0, 0, 0, 0};
    bf16x8 At[4][2], B0[2][2], B1[2][2];
    const char* cA = (const char*)g.A + (size_t)cur.pm * tstepA + (size_t)cur.k0 * 2; const char* cB = (const char*)g.Bt + (size_t)cur.pn * tstepB + (size_t)cur.k0 * 2;
    S.a_ready(cur);
    unsigned cv0[2] = {0u, 0u}, cv1[2] = {0u, 0u}, nv0[2] = {0u, 0u}, nv1[2] = {0u, 0u}; const char* gA = (const char*)g.A;
    if constexpr (GATHER) { PG8_GIDX(cv0, cv1, cur); nv0[0] = cv0[0]; nv0[1] = cv0[1]; nv1[0] = cv1[0]; nv1[1] = cv1[1]; }
    if constexpr (SP2) {
        PG8_STAGE(PG8_SB(0, 0), cB, voffB); PG8_STAGE(PG8_SB(0, 1), cB + hstepB, voffB);
        if constexpr (GATHER) { PG8_STAGE(PG8_SA(0, 0), gA, cv0); PG8_STAGE(PG8_SA(0, 1), gA, cv1); } else { PG8_STAGE(PG8_SA(0, 0), cA, voffA); PG8_STAGE(PG8_SA(0, 1), cA + hstepA, voffA); }
        if (wr == 1) PG8_BAR;
        PG8_WAIT_V(2); PG8_BAR;
        PG8_STAGE(PG8_SB(1, 0), cB + kstep, voffB); if constexpr (GATHER) PG8_STAGE(PG8_SA(1, 0), gA + kstep, cv0); else PG8_STAGE(PG8_SA(1, 0), cA + kstep, voffA); PG8_STAGE(PG8_SB(1, 1), cB + hstepB + kstep, voffB);
        PG8_WAIT_V(6); PG8_BAR;
    } else {
        PG8_STAGE(PG8_SB(0, 0), cB, voffB); PG8_STAGE(PG8_SA(0, 0), cA, voffA); PG8_STAGE(PG8_SB(0, 1), cB + hstepB, voffB); PG8_STAGE(PG8_SA(0, 1), cA + hstepA, voffA);
        if (wr == 1) PG8_BAR;
        PG8_WAIT_V(4); PG8_BAR;
        PG8_STAGE(PG8_SB(1, 0), cB + kstep, voffB); PG8_STAGE(PG8_SA(1, 0), cA + kstep, voffA); PG8_STAGE(PG8_SB(1, 1), cB + hstepB + kstep, voffB);
        PG8_WAIT_V(6); PG8_BAR;
    }
    for (;;) {
        const bool has_next = S.next(ui + 1, nxt);
        const char* nA = has_next ? (const char*)g.A + (size_t)nxt.pm * tstepA + (size_t)nxt.k0 * 2 : cA; const char* nB = has_next ? (const char*)g.Bt + (size_t)nxt.pn * tstepB + (size_t)nxt.k0 * 2 : cB;
        for (int t = 0; t < nt; t += 2) {
            const bool last = (t == nt - 2);
            const char* a1 = cA + (size_t)(t + 1) * kstep;
            const char* a2 = last ? nA : cA + (size_t)(t + 2) * kstep; const char* b2 = last ? nB : cB + (size_t)(t + 2) * kstep;
            const char* a3 = a2 + kstep; const char* b3 = b2 + kstep;
            if (last && has_next) S.a_ready(nxt);
            if constexpr (GATHER) { if (t == nt - 4 && has_next) PG8_GIDX(nv0, nv1, nxt); }
            const char* g1 = gA + (size_t)(t + 1) * kstep; const char* g2 = last ? gA : gA + (size_t)(t + 2) * kstep; const char* g3 = g2 + kstep;
            unsigned x0[2], x1[2]; x0[0] = last ? nv0[0] : cv0[0]; x0[1] = last ? nv0[1] : cv0[1]; x1[0] = last ? nv1[0] : cv1[0]; x1[1] = last ? nv1[1] : cv1[1];
            if constexpr (SP2) {
            PG8_LDB(B0, 0, 0); PG8_LDB(B1, 0, 1); PG8_SCHED; PG8_LDA(At, 0, 0); if constexpr (GATHER) PG8_STAGE(PG8_SA(1, 1), g1, cv1); else PG8_STAGE(PG8_SA(1, 1), a1 + hstepA, voffA);
            PG8_WAIT_V(8); PG8_WAIT_L(0); PG8_BAR; PG8_MMA(0, 0, At, B0); PG8_MMA(0, 1, At, B1); PG8_BAR; PG8_SCHED;
            PG8_LDA(At, 0, 1); PG8_STAGE(PG8_SB(0, 0), b2, voffB); PG8_STAGE(PG8_SB(0, 1), b2 + hstepB, voffB); if constexpr (GATHER) PG8_STAGE(PG8_SA(0, 0), g2, x0); else PG8_STAGE(PG8_SA(0, 0), a2, voffA);
            PG8_WAIT_V(8); PG8_WAIT_L(0); PG8_BAR; PG8_MMA(1, 0, At, B0); PG8_MMA(1, 1, At, B1); PG8_BAR; PG8_SCHED;
            PG8_LDB(B0, 1, 0); PG8_LDB(B1, 1, 1); PG8_SCHED; PG8_LDA(At, 1, 0); if constexpr (GATHER) PG8_STAGE(PG8_SA(0, 1), g2, x1); else PG8_STAGE(PG8_SA(0, 1), a2 + hstepA, voffA);
            PG8_WAIT_V(8); PG8_WAIT_L(0); PG8_BAR; PG8_MMA(0, 0, At, B0); PG8_MMA(0, 1, At, B1); PG8_BAR; PG8_SCHED;
            PG8_LDA(At, 1, 1); PG8_STAGE(PG8_SB(1, 0), b3, voffB); PG8_STAGE(PG8_SB(1, 1), b3 + hstepB, voffB); if constexpr (GATHER) PG8_STAGE(PG8_SA(1, 0), g3, x0); else PG8_STAGE(PG8_SA(1, 0), a3, voffA);
            PG8_WAIT_V(8); PG8_WAIT_L(0); PG8_BAR; PG8_MMA(1, 0, At, B0); PG8_MMA(1, 1, At, B1); PG8_BAR; PG8_SCHED;
            } else {
            PG8_LDB(B0, 0, 0); PG8_SCHED; PG8_LDA(At, 0, 0); PG8_STAGE(PG8_SA(1, 1), a1 + hstepA, voffA);
            PG8_WAIT_L(8); PG8_BAR; PG8_WAIT_L(0); PG8_MMA(0, 0, At, B0); PG8_BAR; PG8_SCHED;
            PG8_LDB(B1, 0, 1); PG8_STAGE(PG8_SB(0, 0), b2, voffB);
            PG8_BAR; PG8_WAIT_L(0); PG8_MMA(0, 1, At, B1); PG8_BAR;
            PG8_LDA(At, 0, 1); PG8_STAGE(PG8_SA(0, 0), a2, voffA);
            PG8_BAR; PG8_WAIT_L(0); PG8_MMA(1, 0, At, B0); PG8_BAR; PG8_SCHED;
            PG8_STAGE(PG8_SB(0, 1), b2 + hstepB, voffB);
            PG8_WAIT_V(6); PG8_BAR; PG8_MMA(1, 1, At, B1); PG8_BAR;
            PG8_LDB(B0, 1, 0); PG8_SCHED; PG8_LDA(At, 1, 0); PG8_STAGE(PG8_SA(0, 1), a2 + hstepA, voffA);
            PG8_WAIT_L(8); PG8_BAR; PG8_WAIT_L(0); PG8_MMA(0, 0, At, B0); PG8_BAR; PG8_SCHED;
            PG8_LDB(B1, 1, 1); PG8_STAGE(PG8_SB(1, 0), b3, voffB);
            PG8_BAR; PG8_WAIT_L(0); PG8_MMA(0, 1, At, B1); PG8_BAR;
            PG8_LDA(At, 1, 1); PG8_STAGE(PG8_SA(1, 0), a3, voffA);
            PG8_BAR; PG8_WAIT_L(0); PG8_MMA(1, 0, At, B0); PG8_BAR; PG8_SCHED;
            PG8_STAGE(PG8_SB(1, 1), b3 + hstepB, voffB);
            PG8_WAIT_V(6); PG8_BAR; PG8_MMA(1, 1, At, B1); PG8_BAR;
            }
        }
        if constexpr (ALIGN_EPI) { if (wr == 0) PG8_BAR; }
        if constexpr (!Epi::AFTER_DRAIN) { E(acc, cur, wr, wc, fr, fq); S.done(cur); }
        if (!has_next) break;
#pragma unroll
        for (int a = 0; a < 2; ++a)
#pragma unroll
            for (int b = 0; b < 2; ++b)
#pragma unroll
                for (int m = 0; m < 4; ++m)
#pragma unroll
                    for (int n = 0; n < 2; ++n) acc[a][b][m][n] = (acc_t){0, 0, 0, 0};
        cur = nxt; cA = nA; cB = nB; ++ui;
        if constexpr (GATHER) { cv0[0] = nv0[0]; cv0[1] = nv0[1]; cv1[0] = nv1[0]; cv1[1] = nv1[1]; }
        if constexpr (ALIGN_EPI) { if (wr == 1) PG8_BAR; }
    }
    PG8_WAIT_V(0);
    if constexpr (!ALIGN_EPI) { if (wr == 0) PG8_BAR; }
    PG8_BAR;
    if constexpr (Epi::AFTER_DRAIN) { E.fused(acc, cur, wr, wc, fr, fq, lds, wid, lane); S.done(cur); }
#undef PG8_SA
#undef PG8_SB
#undef PG8_STAGE
#undef PG8_LDA
#undef PG8_LDB
#undef PG8_MMA
#undef PG8_WAIT_V
#undef PG8_WAIT_L
#undef PG8_BAR
#undef PG8_SCHED
#undef PG8_GIDX
}
}

constexpr int NB = 8, SEQ = 2048, NCTX = 256, D = 1024;
constexpr int ML = NB * SEQ, MC = NB * NCTX, MT = ML + MC;
constexpr int MIXIN = 2560, FFN = 2816, NE = 8, ED = 3584;
constexpr float EPS = 1e-6f;
constexpr int NWAVES = 8;
constexpr int MOE_TILES = 136;

constexpr size_t MiB = 1u << 20;
constexpr size_t WS_CTL = 0, CTL_ZERO_BYTES = 65536;
constexpr size_t WS_MOD = 65536, WS_MODP = 1 * MiB; constexpr int MOD_N = 2 * 9 * 6144;
constexpr size_t WS_ROWSS = 3 * MiB, WS_SHW13 = 4608 * 1024, WS_SHWS = WS_SHW13 + 9 * 5632 * 4;
constexpr size_t WS_ROWSC = 2800 * 1024, WS_POSSC = 2864 * 1024, WS_COLMAX = 4864 * 1024, WS_COLSC = WS_COLMAX;
constexpr size_t WS_COLSCD = WS_COLMAX + (size_t)NE * 2 * ED * 4, WS_PMAX = 376 * MiB, WS_ROWFAC1 = WS_POSSC;
constexpr size_t WS_TOK = 5 * MiB;
constexpr size_t TOK_E = 0, TOK_W = 128 * 1024, TOK_RANK = 256 * 1024, TOK_POS = 384 * 1024, TOK_WGBASE = 512 * 1024, TOK_ROWGATE = 576 * 1024, TOK_ROWSRC = 720 * 1024, TOK_ROWINFO = 864 * 1024;
constexpr size_t WS_MW13 = 6 * MiB, WS_MW2 = 118 * MiB;
constexpr size_t WS_XL = 174 * MiB, WS_H = 238 * MiB, WS_XC = 274 * MiB;
constexpr size_t WS_WIN = 282 * MiB, WS_WOUT = 287 * MiB, WS_W13 = 289 * MiB, WS_W2 = 300 * MiB, WS_SIN = 306 * MiB, WS_SOUT = 308 * MiB;
constexpr size_t WS_BTOUT = 312 * MiB, WS_WEND = 360 * MiB, WS_R = 376 * MiB, WS_END = 512 * MiB;
constexpr size_t WS_QKVU = WS_R, WS_MIX = WS_R + 72 * MiB, WS_ACT = WS_R;
constexpr size_t WS_UC = WS_R, WS_E = WS_R + 72 * MiB, WS_Y = WS_R + 72 * MiB;
constexpr size_t WS_PX = WS_H;
constexpr size_t WS_ACTM = 274 * MiB;
static_assert(WS_ACTM + (size_t)MOE_TILES * 256 * ED * 2 <= WS_END && WS_XC + (size_t)MC * D * 4 <= WS_WIN && WS_H + (size_t)MT * D * 2 <= WS_XC && WS_MW2 + (size_t)NE * D * ED * 2 <= WS_XL, "d_ws map");
constexpr int CW_TMO = 0, CW_CODE = 1, CW_BAR = 4096, CW_GCNT = 8192;

constexpr int RING_OFF = 0, RING_BYTES = 131072;
constexpr int LDSCTL_OFF = 155648, MISC_OFF = LDSCTL_OFF + 320;
constexpr int LDS_BYTES = 159744;
static_assert(MISC_OFF + 128 <= LDS_BYTES, "LDS map");

#define GAS __attribute__((address_space(1)))
#define LAS __attribute__((address_space(3)))
typedef unsigned short bf16;
typedef unsigned v4u __attribute__((ext_vector_type(4)));
typedef unsigned v2u __attribute__((ext_vector_type(2)));
typedef float f32x4 __attribute__((ext_vector_type(4)));
typedef float f32x2 __attribute__((ext_vector_type(2)));
typedef float f32x16 __attribute__((ext_vector_type(16)));
typedef short bf16x8 __attribute__((ext_vector_type(8)));
typedef GAS unsigned gu32;
#define RLX_AGENT __ATOMIC_RELAXED, __HIP_MEMORY_SCOPE_AGENT
#define LDS_WAIT() asm volatile("s_waitcnt lgkmcnt(0)" ::: "memory")
#define VM_WAIT() asm volatile("s_waitcnt vmcnt(0)" ::: "memory")
__device__ __forceinline__ unsigned f2bf(float f) { unsigned u = __builtin_bit_cast(unsigned, f); return (u + 0x7fffu + ((u >> 16) & 1u)) >> 16; }
__device__ __forceinline__ unsigned pk2(float lo, float hi) { return f2bf(lo) | (f2bf(hi) << 16); }
__device__ __forceinline__ float bf2f(unsigned short h) { return __builtin_bit_cast(float, (unsigned)h << 16); }
__device__ __forceinline__ float bflo(unsigned w) { return __builtin_bit_cast(float, w << 16); }
__device__ __forceinline__ float bfhi(unsigned w) { return __builtin_bit_cast(float, w & 0xffff0000u); }
__device__ __forceinline__ float sigm(float x) { return __builtin_amdgcn_rcpf(1.0f + __expf(-x)); }
__device__ __forceinline__ float wave_sum(float v) {
#pragma unroll
    for (int o = 1; o < 64; o <<= 1) v += __shfl_xor(v, o);
    return v;
}
__device__ __forceinline__ float wave_max(float v) {
#pragma unroll
    for (int o = 1; o < 64; o <<= 1) v = fmaxf(v, __shfl_xor(v, o));
    return v;
}
#define XB_TMO      128
#define XB_XCNT(j)  (256  + 64 * (j))
#define XB_XSUB(j)  (1280 + 64 * (j))
#define XB_XGEN(j)  (2304 + 64 * (j))
#define XB_TOP      3328
#define XB_TOPGEN   3392
#define XCD_BAR_WORDS 3456
#define XB_SPIN_CAP (1u << 18)

__device__ __forceinline__ unsigned xb_ld(unsigned* p)              { return __hip_atomic_load(p, __ATOMIC_RELAXED, __HIP_MEMORY_SCOPE_AGENT); }
__device__ __forceinline__ unsigned xb_add(unsigned* p, unsigned v) { return __hip_atomic_fetch_add(p, v, __ATOMIC_RELAXED, __HIP_MEMORY_SCOPE_AGENT); }
__device__ __forceinline__ unsigned xb_xcc_id() { return (unsigned)__builtin_amdgcn_s_getreg((3 << 11) | 20) & 0xFu; }
#define XB_SPIN(cond, bar) do { unsigned _sp = 0; while (cond) { __builtin_amdgcn_s_sleep(1); \
    if ((++_sp & 255u) == 0u) { if (xb_ld(&(bar)[XB_TMO])) break; if (_sp > XB_SPIN_CAP) { atomicAdd(&(bar)[XB_TMO], 1u); break; } } } } while (0)

struct XcdBarrier {
    unsigned* bar; unsigned x;
    volatile LAS unsigned* st;
};

__device__ __forceinline__ XcdBarrier xcd_barrier_post(unsigned* bar, volatile LAS unsigned* st) {
    XcdBarrier b; b.bar = bar; b.x = xb_xcc_id(); b.st = st;
    if (threadIdx.x == 0) (void)xb_add(&bar[XB_XCNT(b.x)], 1u);
    return b;
}
__device__ __forceinline__ void xcd_barrier_complete(unsigned* bar, unsigned x, unsigned& nloc, unsigned& nx) {
    const unsigned G = gridDim.x * gridDim.y * gridDim.z;
    unsigned sum, cnt, mine, sp = 0u;
    for (;;) {
        sum = 0u; cnt = 0u; mine = 0u;
#pragma unroll
        for (unsigned j = 0; j < 16; ++j) { const unsigned c = xb_ld(&bar[XB_XCNT(j)]); sum += c; cnt += (c > 0u) ? 1u : 0u; mine = (j == x) ? c : mine; }
        if (sum == G) break;
        __builtin_amdgcn_s_sleep(1);
        if ((++sp & 255u) == 0u) { if (xb_ld(&bar[XB_TMO])) break; if (sp > XB_SPIN_CAP) { atomicAdd(&bar[XB_TMO], 1u); break; } }
    }
    nloc = mine > 0u ? mine : 1u; nx = cnt > 0u ? cnt : 1u;
}

__device__ __forceinline__ void xcd_barrier(const XcdBarrier& b) {
    asm volatile("s_waitcnt vmcnt(0)" ::: "memory");
    __syncthreads();
    if (threadIdx.x == 0) {
        unsigned* bar = b.bar;
        __builtin_amdgcn_s_waitcnt(0);
        unsigned nloc = b.st[0], nx = b.st[1];
        if (nloc == 0u) { xcd_barrier_complete(bar, b.x, nloc, nx); b.st[0] = nloc; b.st[1] = nx; }
        const unsigned old = xb_add(&bar[XB_XSUB(b.x)], 1u);
        const unsigned gen = old / nloc;
        if (old + 1u == (gen + 1u) * nloc) {
            __builtin_amdgcn_fence(__ATOMIC_RELEASE, "agent");
            asm volatile("s_waitcnt vmcnt(0)" ::: "memory");
            const unsigned og = xb_add(&bar[XB_TOP], 1u);
            const unsigned tg = og / nx;
            if (og + 1u == (tg + 1u) * nx) xb_add(&bar[XB_TOPGEN], 1u);
            else XB_SPIN(xb_ld(&bar[XB_TOPGEN]) == tg, bar);
            __builtin_amdgcn_fence(__ATOMIC_ACQUIRE, "agent");
            xb_add(&bar[XB_XGEN(b.x)], 1u);
            asm volatile("s_waitcnt vmcnt(0)" ::: "memory");
        } else {
            XB_SPIN(xb_ld(&bar[XB_XGEN(b.x)]) == gen, bar);
            __builtin_amdgcn_fence(__ATOMIC_ACQUIRE, "agent");
            asm volatile("s_waitcnt vmcnt(0)" ::: "memory");
        }
    }
    __syncthreads();
}
enum { I_X = 0, I_C, I_CTX, I_CCTX, I_ADAW, I_ADAB, I_N1G, I_N2G, I_MIXWIN, I_QG, I_KG, I_RPB, I_DWW, I_DWB, I_LNG, I_LNB, I_MIXWOUT, I_FW1, I_FW3, I_FW2,
       I_SWIN, I_ARE, I_AIM, I_LOGDT, I_BRE, I_BIM, I_CRE, I_CIM, I_SD, I_SWOUT, I_ROUTER, I_MW1, I_MW3, I_MW2, N_IN };
struct Args { const float* in[N_IN]; float* out; unsigned char* ws; int ph_lo, ph_hi, sub, pad; };

typedef short s16x4 __attribute__((ext_vector_type(4)));
typedef float f32x2_t __attribute__((ext_vector_type(2)));
typedef __bf16 bf16x2_t __attribute__((ext_vector_type(2)));
__device__ __forceinline__ unsigned cvtpk(float lo, float hi) { const f32x2_t v = {lo, hi}; const bf16x2_t b = __builtin_convertvector(v, bf16x2_t); return __builtin_bit_cast(unsigned, b); }
__device__ __forceinline__ s16x4 vtr(const LAS unsigned char* p) { return __builtin_bit_cast(s16x4, __builtin_amdgcn_ds_read_tr16_b64_v4i16((LAS s16x4*)p)); }
__device__ __forceinline__ void p0_adaln(const Args& A, int unit, LAS unsigned char* lds, int tid, int wave, int lane) {
    const int l = unit / 96, rem = unit % 96, cb = rem >> 2, kq = rem & 3;
    LAS float* sc = (LAS float*)lds;
    LAS float* part = sc + 9 * 256;
    const float* c = A.in[I_C]; const float* cc = A.in[I_CCTX];
    for (int i = tid; i < 9 * 256; i += NWAVES * 64) { const int r = i >> 8, k = 256 * kq + (i & 255); const float v = r < 8 ? c[r * 1024 + k] : cc[k]; sc[i] = v * sigm(v); }
    __syncthreads();
    const float* wp = A.in[I_ADAW] + (size_t)l * 1024 * 6144 + (size_t)(256 * kq + 32 * wave) * 6144 + 256 * cb + 4 * lane;
    float acc[9][4];
#pragma unroll
    for (int r = 0; r < 9; ++r)
#pragma unroll
        for (int j = 0; j < 4; ++j) acc[r][j] = 0.f;
#pragma unroll 8
    for (int it = 0; it < 32; ++it) {
        const f32x4 wv = *(const f32x4*)(wp + (size_t)it * 6144); const int k = 32 * wave + it;
#pragma unroll
        for (int r = 0; r < 9; ++r) { const float s = sc[r * 256 + k];
#pragma unroll
            for (int j = 0; j < 4; ++j) acc[r][j] += s * wv[j]; }
    }
#pragma unroll
    for (int r = 0; r < 9; ++r) *(LAS f32x4*)(part + (wave * 9 + r) * 256 + 4 * lane) = (f32x4){acc[r][0], acc[r][1], acc[r][2], acc[r][3]};
    __syncthreads();
    float* modp = (float*)(A.ws + WS_MODP) + (size_t)kq * MOD_N;
    for (int i = tid; i < 9 * 256; i += NWAVES * 64) { const int r = i >> 8, col = i & 255; float s = 0.f;
#pragma unroll
        for (int w = 0; w < 8; ++w) s += part[(w * 9 + r) * 256 + col];
        if (kq == 0) s += A.in[I_ADAB][l * 6144 + 256 * cb + col];
        modp[((size_t)l * 9 + r) * 6144 + 256 * cb + col] = s; }
    __syncthreads();
}
constexpr int KTS = 260;
__device__ __forceinline__ void p0_s5gen(const Args& A, int g, int part, LAS unsigned char* lds, int tid) {
    LAS f32x2* POW = (LAS f32x2*)lds;
    LAS float* BBr = (LAS float*)(POW + 2 * 64 * 33 + 8);
    LAS float* BBi = BBr + 2 * 64 * 16;
    LAS f32x2* CC = (LAS f32x2*)(BBi + 2 * 64 * 16);
    LAS f32x2* CT = CC + 2 * 16 * 66 + 8;
    LAS float* KT = (LAS float*)(CT + 2 * 64 * 16);
    LAS f32x2* FF = (LAS f32x2*)(KT + 63 * KTS);
#define PWI(d_, p_, m_) (((d_) * 64 + (p_)) * 33 + (m_) + ((p_) >> 5) + (d_) * 4)
#define CCI(d_, q_, p_) (((d_) * 16 + (q_)) * 66 + (p_) + ((p_) >> 5) + (d_) * 4)
    if (tid < 128) { const int d = tid >> 6, p = tid & 63, ix = (d * 64 + g) * 64 + p;
        const float ar = A.in[I_ARE][ix], ai = A.in[I_AIM][ix], dt = __expf(A.in[I_LOGDT][d * 64 + g]);
        const float zr = ar * dt, zi = ai * dt, mag = __expf(zr); const float lr = mag * cosf(zi), li = mag * sinf(zi);
        float pr = 1.f, pi = 0.f;
        for (int m = 0; m <= 32; ++m) { POW[PWI(d, p, m)] = (f32x2){pr, pi}; const float nr = pr * lr - pi * li, ni = pr * li + pi * lr; pr = nr; pi = ni; }
        const float nr = lr - 1.f, ni = li, den = 1.f / (ar * ar + ai * ai);
        FF[d * 64 + p] = (f32x2){(nr * ar + ni * ai) * den, (ni * ar - nr * ai) * den}; }
    __syncthreads();
    for (int i = tid; i < 2048; i += NWAVES * 64) { const int d = i >> 10, p = (i >> 4) & 63, q = i & 15; const int ix = ((d * 64 + g) * 64 + p) * 16 + q;
        const float br = A.in[I_BRE][ix], bi = A.in[I_BIM][ix]; const f32x2 f = FF[d * 64 + p];
        BBr[(d * 64 + p) * 16 + q] = f.x * br - f.y * bi; BBi[(d * 64 + p) * 16 + q] = f.x * bi + f.y * br; }
    for (int i = tid; i < 2048; i += NWAVES * 64) { const int d = i >> 10, q = (i >> 6) & 15, p = i & 63; const int ix = ((d * 64 + g) * 16 + q) * 64 + p;
        const f32x2 cv2 = (f32x2){A.in[I_CRE][ix], A.in[I_CIM][ix]}; CC[CCI(d, q, p)] = cv2; CT[(d * 64 + p) * 16 + q] = cv2; }
    __syncthreads();
    bf16* BtOut = (bf16*)(A.ws + WS_BTOUT) + (size_t)g * 512 * 768;
    bf16* WEnd = (bf16*)(A.ws + WS_WEND) + (size_t)g * 256 * 512;
    if (part == 0) {
#pragma unroll 1
    for (int d = 0; d < 2; ++d) {
        const int dl = tid >> 4, qo = tid & 15; float acc[16];
#pragma unroll
        for (int i = 0; i < 16; ++i) acc[i] = 0.f;
#pragma unroll 2
        for (int p = 0; p < 64; ++p) { const f32x2 c = CT[(d * 64 + p) * 16 + qo], w = POW[PWI(d, p, dl)]; const float tr = c.x * w.x - c.y * w.y, ti = c.x * w.y + c.y * w.x;
            const LAS f32x4* br = (const LAS f32x4*)(BBr + (d * 64 + p) * 16); const LAS f32x4* bi = (const LAS f32x4*)(BBi + (d * 64 + p) * 16);
#pragma unroll
            for (int q4 = 0; q4 < 4; ++q4) { const f32x4 r4 = br[q4], i4 = bi[q4];
#pragma unroll
                for (int j = 0; j < 4; ++j) acc[4 * q4 + j] += tr * r4[j] - ti * i4[j]; } }
        if (d == 0) {
            { const float dsk = (dl == 0) ? A.in[I_SD][g * 16 + qo] : 0.f;
#pragma unroll
              for (int i = 0; i < 16; ++i) acc[i] += (i == qo) ? dsk : 0.f; }
#pragma unroll
            for (int i = 0; i < 4; ++i) *(LAS f32x4*)(KT + (31 + dl) * KTS + qo * 16 + 4 * i) = (f32x4){acc[4 * i], acc[4 * i + 1], acc[4 * i + 2], acc[4 * i + 3]};
        } else {
#pragma unroll
            for (int i = 0; i < 4; ++i) { LAS f32x4* kp = (LAS f32x4*)(KT + (31 - dl) * KTS + qo * 16 + 4 * i); f32x4 v = (f32x4){acc[4 * i], acc[4 * i + 1], acc[4 * i + 2], acc[4 * i + 3]}; if (dl == 0) v = v + *kp; *kp = v; }
        }
        __syncthreads();
    }
    for (int pc = tid; pc < 512 * 64; pc += NWAVES * 64) {
        const int n = pc >> 6, kp = pc & 63, t = n >> 4, qo = n & 15, j = kp >> 1, qi0 = (kp & 1) * 8; const LAS float* s = KT + (t - j + 31) * KTS + qo * 16 + qi0;
        const f32x4 s0 = *(const LAS f32x4*)s, s1 = *(const LAS f32x4*)(s + 4);
        v4u o; o.x = cvtpk(s0.x, s0.y); o.y = cvtpk(s0.z, s0.w); o.z = cvtpk(s1.x, s1.y); o.w = cvtpk(s1.z, s1.w);
        *(v4u*)(BtOut + (size_t)n * 768 + kp * 8) = o; }
    } else {
    for (int pc = tid; pc < 512 * 32; pc += NWAVES * 64) {
        const int n = pc >> 5, kp = pc & 31, t = n >> 4, qo = n & 15, d = kp >> 4, ri = (kp >> 3) & 1, p0 = (kp & 7) * 8, m = d == 0 ? t + 1 : 32 - t; float v[8];
#pragma unroll
        for (int i = 0; i < 8; ++i) { const f32x2 c = CC[CCI(d, qo, p0 + i)], w = POW[PWI(d, p0 + i, m)]; v[i] = ri == 0 ? (c.x * w.x - c.y * w.y) : -(c.x * w.y + c.y * w.x); }
        v4u o; o.x = cvtpk(v[0], v[1]); o.y = cvtpk(v[2], v[3]); o.z = cvtpk(v[4], v[5]); o.w = cvtpk(v[6], v[7]);
        *(v4u*)(BtOut + (size_t)n * 768 + 512 + kp * 8) = o; }
    for (int pc = tid; pc < 256 * 64; pc += NWAVES * 64) {
        const int n = pc >> 6, kp = pc & 63, d = n >> 7, ri = (n >> 6) & 1, p = n & 63, j = kp >> 1, qi0 = (kp & 1) * 8, m = d == 0 ? 31 - j : j; const f32x2 w = POW[PWI(d, p, m)]; float v[8];
#pragma unroll
        for (int i = 0; i < 8; ++i) { const float br = BBr[(d * 64 + p) * 16 + qi0 + i], bi = BBi[(d * 64 + p) * 16 + qi0 + i]; v[i] = ri == 0 ? (w.x * br - w.y * bi) : (w.x * bi + w.y * br); }
        v4u o; o.x = cvtpk(v[0], v[1]); o.y = cvtpk(v[2], v[3]); o.z = cvtpk(v[4], v[5]); o.w = cvtpk(v[6], v[7]);
        *(v4u*)(WEnd + (size_t)n * 512 + kp * 8) = o; }
    }
    __syncthreads();
#undef PWI
#undef CCI
}
__device__ __forceinline__ void cvt_item(const float* W, int K, int N, int ldw, bf16* WT, int mode, int item, LAS float* scr, int lane, unsigned* colmax = nullptr, float* pmax = nullptr) {
    const int nblk = N / 32, kb = item / nblk, nb = item - kb * nblk, k0 = 64 * kb, n0 = 32 * nb;
    int r0 = n0;
    if (mode == 1) r0 = 256 * (n0 >> 7) + (n0 & 127);
    else if (mode == 2) r0 = 256 * (n0 >> 7) + 128 + (n0 & 127);
    else if (mode == 3) { if (n0 < 1536) { const int pn = n0 >> 8, rem = n0 & 255; r0 = 256 * pn + 128 * ((rem & 63) >> 5) + 32 * (rem >> 6); }
                          else if (n0 < 2048) { const int n1 = n0 - 1536; r0 = 256 * (6 + (n1 >> 7)) + (n1 & 127); }
                          else { const int n1 = n0 - 2048; r0 = 256 * (6 + (n1 >> 7)) + 128 + (n1 & 127); } }
    { f32x4 v[8];
#pragma unroll
      for (int i = 0; i < 8; ++i) v[i] = *(const f32x4*)(W + (size_t)(k0 + 8 * i + (lane >> 3)) * ldw + n0 + 4 * (lane & 7));
#pragma unroll
      for (int i = 0; i < 8; ++i) { LAS float* d = scr + (8 * i + (lane >> 3)) * 33 + 4 * (lane & 7); d[0] = v[i].x; d[1] = v[i].y; d[2] = v[i].z; d[3] = v[i].w; } }
    LDS_WAIT(); asm volatile("" ::: "memory");
    const int c = lane & 7;
#pragma unroll
    for (int j = 0; j < 4; ++j) { const int n = (lane >> 3) + 8 * j; const LAS float* s = scr + (8 * c) * 33 + n;
        v4u o; o.x = cvtpk(s[0 * 33], s[1 * 33]); o.y = cvtpk(s[2 * 33], s[3 * 33]); o.z = cvtpk(s[4 * 33], s[5 * 33]); o.w = cvtpk(s[6 * 33], s[7 * 33]);
        *(GAS v4u*)(WT + (size_t)(r0 + n) * K + k0 + 8 * c) = o;
        if (colmax || pmax) { float mx = fmaxf(fmaxf(fmaxf(fabsf(s[0 * 33]), fabsf(s[1 * 33])), fmaxf(fabsf(s[2 * 33]), fabsf(s[3 * 33]))), fmaxf(fmaxf(fabsf(s[4 * 33]), fabsf(s[5 * 33])), fmaxf(fabsf(s[6 * 33]), fabsf(s[7 * 33]))));
            mx = fmaxf(mx, __shfl_xor(mx, 1)); mx = fmaxf(mx, __shfl_xor(mx, 2)); mx = fmaxf(mx, __shfl_xor(mx, 4));
            if (c == 0) { if (colmax) __hip_atomic_fetch_max(colmax + r0 + n, __builtin_bit_cast(unsigned, mx), RLX_AGENT); else pmax[(size_t)(r0 + n) * (K / 64) + kb] = mx; } } }
    LDS_WAIT(); asm volatile("" ::: "memory");
}
constexpr int CV_IM = 16 * 112, CV_IM2 = 56 * 32, CV_NMOE = NE * (2 * CV_IM + CV_IM2);
__device__ __forceinline__ void p0_convert(const Args& A, LAS unsigned char* lds, int gw, int NGW, int wave, int lane) {
    LAS float* scr = (LAS float*)(lds + wave * 16384);
    unsigned char* ws = A.ws;
    constexpr int I0 = 16 * 80, I1 = 16 * 32, I2 = 16 * 88, I3 = 44 * 32, I4 = 16 * 32, I5 = 16 * 32;
    constexpr int NSMALL = I0 + I1 + 2 * I2 + I3 + I4 + 2 * I5;
    for (int it = gw; it < NSMALL; it += NGW) {
        int r = it;
        if (r < I0) { cvt_item(A.in[I_MIXWIN], D, MIXIN, MIXIN, (bf16*)(ws + WS_WIN), 3, r, scr, lane, nullptr, (float*)(ws + WS_PMAX)); continue; } r -= I0;
        if (r < I1) { cvt_item(A.in[I_MIXWOUT], D, D, D, (bf16*)(ws + WS_WOUT), 0, r, scr, lane); continue; } r -= I1;
        if (r < I2) { cvt_item(A.in[I_FW1], D, FFN, FFN, (bf16*)(ws + WS_W13), 1, r, scr, lane, nullptr, (float*)(ws + WS_PMAX) + MIXIN * 16); continue; } r -= I2;
        if (r < I2) { cvt_item(A.in[I_FW3], D, FFN, FFN, (bf16*)(ws + WS_W13), 2, r, scr, lane, nullptr, (float*)(ws + WS_PMAX) + MIXIN * 16); continue; } r -= I2;
        if (r < I3) { cvt_item(A.in[I_FW2], FFN, D, D, (bf16*)(ws + WS_W2), 0, r, scr, lane); continue; } r -= I3;
        if (r < I4) { cvt_item(A.in[I_SWIN], D, D, D, (bf16*)(ws + WS_SIN), 0, r, scr, lane); continue; } r -= I4;
        if (r < I5) { cvt_item(A.in[I_SWOUT], D, D, 2 * D, (bf16*)(ws + WS_SOUT), 1, r, scr, lane); continue; } r -= I5;
        cvt_item(A.in[I_SWOUT] + D, D, D, 2 * D, (bf16*)(ws + WS_SOUT), 2, r, scr, lane);
    }
}
__device__ __forceinline__ void moe_convert(const Args& A, LAS unsigned char* lds, int first, int count, int widx, int nw, int wave, int lane) {
    LAS float* scr = (LAS float*)(lds + wave * 16384);
    unsigned char* ws = A.ws;
    const int last = (first + count) < CV_NMOE ? (first + count) : CV_NMOE;
    for (int it = first + widx; it < last; it += nw) {
        int r = it; const int e = r / (2 * CV_IM + CV_IM2); r -= e * (2 * CV_IM + CV_IM2);
        if (r < CV_IM) { cvt_item(A.in[I_MW1] + (size_t)e * D * ED, D, ED, ED, (bf16*)(ws + WS_MW13) + (size_t)e * 2 * ED * D, 1, r, scr, lane, (unsigned*)(ws + WS_COLMAX) + e * 2 * ED); continue; } r -= CV_IM;
        if (r < CV_IM) { cvt_item(A.in[I_MW3] + (size_t)e * D * ED, D, ED, ED, (bf16*)(ws + WS_MW13) + (size_t)e * 2 * ED * D, 2, r, scr, lane, (unsigned*)(ws + WS_COLMAX) + e * 2 * ED); continue; } r -= CV_IM;
        cvt_item(A.in[I_MW2] + (size_t)e * ED * D, ED, D, D, (bf16*)(ws + WS_MW2) + (size_t)e * D * ED, 0, r, scr, lane);
    }
}
__device__ __forceinline__ void shw_rows(const bf16* WT, int N, const float* sh, float* out, int widx, int nw, LAS unsigned char* lds, int tid, int lane) {
    LAS float* shl = (LAS float*)lds;
    __syncthreads();
    for (int i = tid; i < 9 * 1024; i += NWAVES * 64) shl[i] = sh[(size_t)(i >> 10) * 6144 + (i & 1023)];
    __syncthreads();
    for (int p = widx; p < N; p += nw) {
        const v4u w0 = *(const v4u*)(WT + (size_t)p * D + 16 * lane), w1 = *(const v4u*)(WT + (size_t)p * D + 16 * lane + 8);
        const float w[16] = {bflo(w0.x), bfhi(w0.x), bflo(w0.y), bfhi(w0.y), bflo(w0.z), bfhi(w0.z), bflo(w0.w), bfhi(w0.w), bflo(w1.x), bfhi(w1.x), bflo(w1.y), bfhi(w1.y), bflo(w1.z), bfhi(w1.z), bflo(w1.w), bfhi(w1.w)};
        float s[9];
#pragma unroll
        for (int b = 0; b < 9; ++b) { const LAS f32x4* sp = (const LAS f32x4*)(shl + b * 1024 + 16 * lane); float a = 0.f;
#pragma unroll
            for (int q = 0; q < 4; ++q) { const f32x4 v = sp[q]; a += (v.x * w[4 * q] + v.y * w[4 * q + 1]) + (v.z * w[4 * q + 2] + v.w * w[4 * q + 3]); }
            s[b] = a; }
#pragma unroll
        for (int b = 0; b < 9; ++b) s[b] = wave_sum(s[b]);
        if (lane < 9) { float v = s[0];
#pragma unroll
            for (int b = 1; b < 9; ++b) v = (lane == b) ? s[b] : v;
            out[(size_t)lane * N + p] = v; }
    }
    __syncthreads();
}
__device__ __forceinline__ unsigned q8pack(float a, float b, float c, float d) { const int ia = (int)rintf(a), ib = (int)rintf(b), ic = (int)rintf(c), id = (int)rintf(d);
    return (unsigned)(ia & 255) | ((unsigned)(ib & 255) << 8) | ((unsigned)(ic & 255) << 16) | ((unsigned)(id & 255) << 24); }
__device__ __forceinline__ void quant_rows_inplace(bf16* W, unsigned* colmax, int nrows, int gw, int NGW, int lane) {
    for (int r0 = gw; r0 < nrows; r0 += 2 * NGW) {
        const int r1 = (r0 + NGW < nrows) ? r0 + NGW : r0; const int nr = (r0 + NGW < nrows) ? 2 : 1;
        v4u a[2][2]; float mx[2];
#pragma unroll
        for (int u = 0; u < 2; ++u) { const int r = u ? r1 : r0; const bf16* rp = W + (size_t)r * 1024 + 16 * lane; a[u][0] = *(const v4u*)rp; a[u][1] = *(const v4u*)(rp + 8); mx[u] = __builtin_bit_cast(float, colmax[r]); }
        asm volatile("s_waitcnt vmcnt(0)" ::: "memory");
#pragma unroll
        for (int u = 0; u < 2; ++u) { if (u < nr) { const int r = u ? r1 : r0; const float inv = mx[u] > 0.f ? 127.0f / mx[u] : 0.f; v4u o;
            o.x = q8pack(bflo(a[u][0].x) * inv, bfhi(a[u][0].x) * inv, bflo(a[u][0].y) * inv, bfhi(a[u][0].y) * inv); o.y = q8pack(bflo(a[u][0].z) * inv, bfhi(a[u][0].z) * inv, bflo(a[u][0].w) * inv, bfhi(a[u][0].w) * inv);
            o.z = q8pack(bflo(a[u][1].x) * inv, bfhi(a[u][1].x) * inv, bflo(a[u][1].y) * inv, bfhi(a[u][1].y) * inv); o.w = q8pack(bflo(a[u][1].z) * inv, bfhi(a[u][1].z) * inv, bflo(a[u][1].w) * inv, bfhi(a[u][1].w) * inv);
            *(v4u*)((unsigned char*)(W + (size_t)r * 1024) + 16 * lane) = o;
            if (lane == 0) ((float*)colmax)[r] = mx[u] * (1.0f / 127.0f); } }
    }
}
__device__ __forceinline__ void quant_rows_inplace_p(bf16* W, const float* pmax, float* colscale, int nrows, int gw, int NGW, int lane) {
    for (int r = gw; r < nrows; r += NGW) {
        const bf16* rp = W + (size_t)r * 1024 + 16 * lane; const v4u a0 = *(const v4u*)rp, a1 = *(const v4u*)(rp + 8);
        const float mx = wave_max(pmax[(size_t)r * 16 + (lane & 15)]);
        asm volatile("s_waitcnt vmcnt(0)" ::: "memory");
        const float inv = mx > 0.f ? 127.0f / mx : 0.f; v4u o;
        o.x = q8pack(bflo(a0.x) * inv, bfhi(a0.x) * inv, bflo(a0.y) * inv, bfhi(a0.y) * inv); o.y = q8pack(bflo(a0.z) * inv, bfhi(a0.z) * inv, bflo(a0.w) * inv, bfhi(a0.w) * inv);
        o.z = q8pack(bflo(a1.x) * inv, bfhi(a1.x) * inv, bflo(a1.y) * inv, bfhi(a1.y) * inv); o.w = q8pack(bflo(a1.z) * inv, bfhi(a1.z) * inv, bflo(a1.w) * inv, bfhi(a1.w) * inv);
        *(v4u*)((unsigned char*)(W + (size_t)r * 1024) + 16 * lane) = o;
        if (lane == 0) colscale[r] = mx * (1.0f / 127.0f);
    }
}
template <int NPART> __device__ __forceinline__ void norm_row_finish(const f32x4 (&v)[4], int row, const float* gain, const float* mod, int shc, int scc, bf16* H, int lane) {
    const float* mp = mod + (size_t)(row < ML ? (row >> 11) : 8) * 6144; float ss = 0.f;
#pragma unroll
    for (int j = 0; j < 4; ++j) ss += (v[j].x * v[j].x + v[j].y * v[j].y) + (v[j].z * v[j].z + v[j].w * v[j].w);
    const float rstd = rsqrtf(wave_sum(ss) * (1.0f / D) + EPS);
#pragma unroll
    for (int j = 0; j < 4; ++j) { const int k = 4 * lane + 256 * j; const f32x4 gg = *(const f32x4*)(gain + k); f32x4 sc = *(const f32x4*)(mp + scc * 1024 + k), sh = *(const f32x4*)(mp + shc * 1024 + k);
#pragma unroll
        for (int q = 1; q < NPART; ++q) { sc = sc + *(const f32x4*)(mp + (size_t)q * MOD_N + scc * 1024 + k); sh = sh + *(const f32x4*)(mp + (size_t)q * MOD_N + shc * 1024 + k); }
        const f32x4 h = v[j] * rstd * gg * (sc + 1.0f) + sh;
        v2u o; o.x = cvtpk(h.x, h.y); o.y = cvtpk(h.z, h.w); *(v2u*)(H + (size_t)row * D + k) = o; }
}
__device__ __forceinline__ void norm_rows_lds(const float* xL, const float* xC, int nrows, const float* gain, const LAS float* ms, bf16* H, float* rowfac, int gw, int NGW, int lane) {
    for (int row = gw; row < nrows; row += 2 * NGW) {
        const int row1 = row + NGW; const bool two = row1 < nrows; const int r1 = two ? row1 : row;
        const float* xa = row < ML ? xL + (size_t)row * D : xC + (size_t)(row - ML) * D; const float* xb = r1 < ML ? xL + (size_t)r1 * D : xC + (size_t)(r1 - ML) * D;
        f32x4 vv[2][4];
#pragma unroll
        for (int j = 0; j < 4; ++j) { vv[0][j] = *(const f32x4*)(xa + 4 * lane + 256 * j); vv[1][j] = *(const f32x4*)(xb + 4 * lane + 256 * j); }
#pragma unroll
        for (int u = 0; u < 2; ++u) { if (u == 1 && !two) break; const int rw = u ? row1 : row; const LAS float* mp = ms + (rw < ML ? (rw >> 11) : 8) * 2048; float ss = 0.f;
#pragma unroll
            for (int j = 0; j < 4; ++j) ss += (vv[u][j].x * vv[u][j].x + vv[u][j].y * vv[u][j].y) + (vv[u][j].z * vv[u][j].z + vv[u][j].w * vv[u][j].w);
            const float rstd = rsqrtf(wave_sum(ss) * (1.0f / D) + EPS);
            f32x4 hq[4]; float am = 0.f;
#pragma unroll
            for (int j = 0; j < 4; ++j) { const int k = 4 * lane + 256 * j; const f32x4 gg = *(const f32x4*)(gain + k), sh = *(const LAS f32x4*)(mp + k), sc = *(const LAS f32x4*)(mp + 1024 + k);
                const f32x4 h = vv[u][j] * rstd * gg * (sc + 1.0f) + sh; hq[j] = h; am = fmaxf(am, fmaxf(fmaxf(fabsf(h.x), fabsf(h.y)), fmaxf(fabsf(h.z), fabsf(h.w)))); }
            am = wave_max(am); const float inv = am > 0.f ? 127.0f / am : 0.f;
#pragma unroll
            for (int j = 0; j < 4; ++j) *(unsigned*)((unsigned char*)H + (size_t)rw * D + 4 * lane + 256 * j) = q8pack(hq[j].x * inv, hq[j].y * inv, hq[j].z * inv, hq[j].w * inv);
            if (lane == 0) rowfac[rw] = am * (1.0f / 127.0f); }
    }
}
template <int NPART> __device__ __forceinline__ void norm_rows(const float* xL, const float* xC, int nrows, const float* gain, const float* mod, int shc, int scc, bf16* H, int gw, int NGW, int lane) {
    for (int row = gw; row < nrows; row += 2 * NGW) {
        const int row1 = row + NGW; const bool two = row1 < nrows; const int r1 = two ? row1 : row;
        const float* xa = row < ML ? xL + (size_t)row * D : xC + (size_t)(row - ML) * D; const float* xb = r1 < ML ? xL + (size_t)r1 * D : xC + (size_t)(r1 - ML) * D;
        f32x4 va[4], vb[4];
#pragma unroll
        for (int j = 0; j < 4; ++j) { va[j] = *(const f32x4*)(xa + 4 * lane + 256 * j); vb[j] = *(const f32x4*)(xb + 4 * lane + 256 * j); }
        norm_row_finish<NPART>(va, row, gain, mod, shc, scc, H, lane);
        if (two) norm_row_finish<NPART>(vb, row1, gain, mod, shc, scc, H, lane);
    }
}
constexpr int VSTR = 144;
__device__ __forceinline__ void attn_unit(const bf16* QKVU, bf16* MIX, int wu, LAS unsigned char* vl, LAS unsigned char* ql, const LAS float* rpbl, float bnd, int lane) {
    const bool isctx = wu >= 2048;
    int b, h, r = 0, qrow0;
    if (!isctx) { h = wu & 7; r = (wu >> 3) & 31; b = wu >> 8; qrow0 = b * SEQ + r * 64; }
    else { const int w = wu - 2048; h = w & 7; b = w >> 5; qrow0 = ML + b * NCTX + 64 * ((w >> 3) & 3); }
    const int c = lane & 31, hh = lane >> 5;
    const int rs = r < 4 ? 0 : (r > 28 ? 24 : r - 4);
    const int csA = c < 8 ? 0 : c - 8;
    const int csB = c > 24 ? 48 : c + 24;
    const LAS unsigned char* vtb = vl + (4 * hh + ((lane & 15) >> 2)) * VSTR + 32 * ((lane >> 4) & 1) + 8 * (lane & 3);
    LAS unsigned char* qs = ql + c * 128 + 16 * hh;
    { const bf16* qp = QKVU + (size_t)(qrow0 + c) * 2048 + h * 64 + 8 * hh;
#pragma unroll
      for (int s = 0; s < 4; ++s) { *(LAS bf16x8*)(qs + 32 * s) = *(const bf16x8*)(qp + 16 * s); *(LAS bf16x8*)(qs + 4096 + 32 * s) = *(const bf16x8*)(qp + (size_t)32 * 2048 + 16 * s); } }
    f32x16 oA0, oA1, oB0, oB1;
#pragma unroll
    for (int i = 0; i < 16; ++i) { oA0[i] = 0.f; oA1[i] = 0.f; oB0[i] = 0.f; oB1[i] = 0.f; }
    float lsA = 0.f, lsB = 0.f;
    const int nblk = isctx ? 8 : 24;
    const bf16* kbase = QKVU + 512 + h * 64 + 8 * hh + (size_t)c * 2048;
    const bf16* vbase = QKVU + 1024 + h * 64 + 8 * (lane & 7) + (size_t)(lane >> 3) * 2048;
#define ATT_KROW0(kb_) (((!isctx) && (kb_) < 16) ? (b * SEQ + (rs + ((kb_) >> 1)) * 64 + 32 * ((kb_) & 1)) : (ML + b * NCTX + 32 * (isctx ? (kb_) : (kb_) - 16)))
#define ATT_LOADK(KF, kb_) do { const int kq_ = (kb_) < nblk ? (kb_) : nblk - 1; const size_t ro_ = (size_t)ATT_KROW0(kq_) * 2048; \
        _Pragma("unroll") for (int s_ = 0; s_ < 4; ++s_) KF[s_] = *(const bf16x8*)(kbase + ro_ + 16 * s_); } while (0)
#define ATT_LOADV(VF, kb_) do { const int kq_ = (kb_) < nblk ? (kb_) : nblk - 1; const size_t ro_ = (size_t)ATT_KROW0(kq_) * 2048; \
        _Pragma("unroll") for (int i_ = 0; i_ < 4; ++i_) VF[i_] = *(const v4u*)(vbase + ro_ + (size_t)i_ * 8 * 2048); } while (0)
#define ATT_PACK(PF, P) do { _Pragma("unroll") for (int s = 0; s < 2; ++s) { v4u w; w.x = cvtpk(P[8 * s], P[8 * s + 1]); w.y = cvtpk(P[8 * s + 2], P[8 * s + 3]); w.z = cvtpk(P[8 * s + 4], P[8 * s + 5]); w.w = cvtpk(P[8 * s + 6], P[8 * s + 7]); PF[s] = __builtin_bit_cast(bf16x8, w); } } while (0)
#define ATT_BLOCK(KF, VF, kb_) do { const int kb = (kb_); const bool live = kb < nblk; const bool band = (!isctx) && kb < 16; const int kr = rs + (kb >> 1); \
        _Pragma("unroll") for (int i = 0; i < 4; ++i) { const int id = lane + 64 * i; *(LAS v4u*)(vl + (id >> 3) * VSTR + (id & 7) * 16) = VF[i]; } \
        ATT_LOADV(VF, kb + 1);              \
        f32x16 sA, sB; \
        _Pragma("unroll") for (int i = 0; i < 16; ++i) { sA[i] = 0.f; sB[i] = 0.f; } \
        _Pragma("unroll") for (int s = 0; s < 4; ++s) { sA = __builtin_amdgcn_mfma_f32_32x32x16_bf16(KF[s], *(const LAS bf16x8*)(qs + 32 * s), sA, 0, 0, 0); \
                                                        sB = __builtin_amdgcn_mfma_f32_32x32x16_bf16(KF[s], *(const LAS bf16x8*)(qs + 4096 + 32 * s), sB, 0, 0, 0); } \
        ATT_LOADK(KF, kb + 1);              \
        float pA[16], pB[16]; \
        if (band) { const int kc0 = 32 * (kb & 1) + 4 * hh; const LAS float* rb = rpbl + h * 465 + (kr - r + 7) * 31 + (kc0 - c); \
              \
            float bA[16], bB[16]; \
            _Pragma("unroll") for (int i = 0; i < 16; ++i) { bA[i] = rb[15 + (i & 3) + 8 * (i >> 2)]; bB[i] = rb[(i & 3) + 8 * (i >> 2) - 17]; } \
            const int tA = kc0 - csA, tB = kc0 - csB; \
            _Pragma("unroll") for (int i = 0; i < 16; ++i) { const int o = (i & 3) + 8 * (i >> 2); \
                { const bool ok = (unsigned)(tA + o) < 16u; const float e = __builtin_amdgcn_exp2f(sA[i] * 0.18033688f + bA[i]); pA[i] = ok ? e : 0.f; } \
                { const bool ok = (unsigned)(tB + o) < 16u; const float e = __builtin_amdgcn_exp2f(sB[i] * 0.18033688f + bB[i]); pB[i] = ok ? e : 0.f; } } \
        } else { \
            _Pragma("unroll") for (int i = 0; i < 16; ++i) { const float ea = __builtin_amdgcn_exp2f(sA[i] * 0.18033688f - bnd), eb = __builtin_amdgcn_exp2f(sB[i] * 0.18033688f - bnd); pA[i] = live ? ea : 0.f; pB[i] = live ? eb : 0.f; } } \
        _Pragma("unroll") for (int i = 0; i < 16; ++i) { lsA += pA[i]; lsB += pB[i]; } \
        bf16x8 fA[2], fB[2]; ATT_PACK(fA, pA); ATT_PACK(fB, pB); \
        LDS_WAIT(); \
        _Pragma("unroll") for (int dt = 0; dt < 2; ++dt) \
            _Pragma("unroll") for (int s = 0; s < 2; ++s) { \
                const s16x4 lo = vtr(vtb + (16 * s) * VSTR + 64 * dt), hi = vtr(vtb + (16 * s + 8) * VSTR + 64 * dt); \
                const bf16x8 af = (bf16x8){lo[0], lo[1], lo[2], lo[3], hi[0], hi[1], hi[2], hi[3]}; \
                if (dt == 0) { oA0 = __builtin_amdgcn_mfma_f32_32x32x16_bf16(af, fA[s], oA0, 0, 0, 0); oB0 = __builtin_amdgcn_mfma_f32_32x32x16_bf16(af, fB[s], oB0, 0, 0, 0); } \
                else { oA1 = __builtin_amdgcn_mfma_f32_32x32x16_bf16(af, fA[s], oA1, 0, 0, 0); oB1 = __builtin_amdgcn_mfma_f32_32x32x16_bf16(af, fB[s], oB1, 0, 0, 0); } } \
        } while (0)
    bf16x8 kA[4]; v4u vA[4];
    ATT_LOADK(kA, 0); ATT_LOADV(vA, 0);
    for (int kb1 = 0; kb1 < nblk; ++kb1) ATT_BLOCK(kA, vA, kb1);
#undef ATT_KROW0
#undef ATT_LOADK
#undef ATT_LOADV
#undef ATT_PACK
#undef ATT_BLOCK
    lsA += __shfl_xor(lsA, 32); lsB += __shfl_xor(lsB, 32);
    const float iA = 1.0f / lsA, iB = 1.0f / lsB;
    bf16* op = MIX + (size_t)(qrow0 + c) * D + h * 64 + 4 * hh; bf16* oq = op + (size_t)32 * D;
#pragma unroll
    for (int i4 = 0; i4 < 4; ++i4) {
        v2u w0; w0.x = cvtpk(oA0[4 * i4] * iA, oA0[4 * i4 + 1] * iA); w0.y = cvtpk(oA0[4 * i4 + 2] * iA, oA0[4 * i4 + 3] * iA); *(v2u*)(op + 8 * i4) = w0;
        v2u w1; w1.x = cvtpk(oA1[4 * i4] * iA, oA1[4 * i4 + 1] * iA); w1.y = cvtpk(oA1[4 * i4 + 2] * iA, oA1[4 * i4 + 3] * iA); *(v2u*)(op + 32 + 8 * i4) = w1;
        v2u w2; w2.x = cvtpk(oB0[4 * i4] * iB, oB0[4 * i4 + 1] * iB); w2.y = cvtpk(oB0[4 * i4 + 2] * iB, oB0[4 * i4 + 3] * iB); *(v2u*)(oq + 8 * i4) = w2;
        v2u w3; w3.x = cvtpk(oB1[4 * i4] * iB, oB1[4 * i4 + 1] * iB); w3.y = cvtpk(oB1[4 * i4 + 2] * iB, oB1[4 * i4 + 3] * iB); *(v2u*)(oq + 32 + 8 * i4) = w3; }
}
template <int P0, int NP> __device__ __forceinline__ void conv_chunk(float (&acc)[32], const float (&w)[31], const __amdgpu_buffer_rsrc_t rsrc, int voff, int t0, int len) {
    float v[NP];
#pragma unroll
    for (int i = 0; i < NP; ++i) { const int t = t0 - 15 + P0 + i, tc = t < 0 ? 0 : (t >= len ? len - 1 : t); const int so = __builtin_amdgcn_readfirstlane(tc * 4096);
        const float x = bf2f(__builtin_amdgcn_raw_buffer_load_b16(rsrc, voff, so, 0)); v[i] = (t == tc) ? x : 0.f; }
#pragma unroll
    for (int i = 0; i < NP; ++i)
#pragma unroll
        for (int tt = 0; tt < 32; ++tt) { if (P0 + i - tt >= 0 && P0 + i - tt <= 30) acc[tt] += v[i] * w[(P0 + i - tt >= 0 && P0 + i - tt <= 30) ? P0 + i - tt : 0]; }
}
__device__ __forceinline__ void conv_item(const Args& A, const bf16* QKVU, bf16* MIX, int item, LAS float* cv, int tid, int wave, int lane) {
    __syncthreads();
    int rowbase, len, t0;
    if (item < 512) { rowbase = (item >> 6) * SEQ; len = SEQ; t0 = 32 * (item & 63); } else { const int i2 = item - 512; rowbase = ML + (i2 >> 3) * NCTX; len = NCTX; t0 = 32 * (i2 & 7); }
    const int ch = tid;
    float w[31], acc[32];
    { const __amdgpu_buffer_rsrc_t wrs = __builtin_amdgcn_make_buffer_rsrc((void*)A.in[I_DWW], 0, 31 * 512 * 4, 0x00020000);
#pragma unroll
      for (int k = 0; k < 31; ++k) w[k] = __builtin_bit_cast(float, __builtin_amdgcn_raw_buffer_load_b32(wrs, 4 * ch, k * 2048, 0)); }
    const float bias = A.in[I_DWB][ch];
#pragma unroll
    for (int t = 0; t < 32; ++t) acc[t] = bias;
    const __amdgpu_buffer_rsrc_t rsrc = __builtin_amdgcn_make_buffer_rsrc((void*)(QKVU + (size_t)rowbase * 2048 + 1536), 0, len * 4096, 0x00020000);
    conv_chunk<0, 16>(acc, w, rsrc, 2 * ch, t0, len); conv_chunk<16, 16>(acc, w, rsrc, 2 * ch, t0, len); conv_chunk<32, 16>(acc, w, rsrc, 2 * ch, t0, len); conv_chunk<48, 14>(acc, w, rsrc, 2 * ch, t0, len);
#pragma unroll
    for (int t = 0; t < 32; ++t) cv[t * 512 + ch] = acc[t];
    __syncthreads();
    const f32x4 g0 = *(const f32x4*)(A.in[I_LNG] + 8 * lane), g1 = *(const f32x4*)(A.in[I_LNG] + 8 * lane + 4), b0 = *(const f32x4*)(A.in[I_LNB] + 8 * lane), b1 = *(const f32x4*)(A.in[I_LNB] + 8 * lane + 4);
#pragma unroll
    for (int q = 0; q < 4; ++q) { const int tt = 4 * wave + q;
        f32x4 x0 = *(const LAS f32x4*)(cv + tt * 512 + 8 * lane), x1 = *(const LAS f32x4*)(cv + tt * 512 + 8 * lane + 4);
        const float mean = wave_sum((x0.x + x0.y) + (x0.z + x0.w) + (x1.x + x1.y) + (x1.z + x1.w)) * (1.0f / 512.0f);
        x0 = x0 - mean; x1 = x1 - mean;
        const float var = wave_sum((x0.x * x0.x + x0.y * x0.y) + (x0.z * x0.z + x0.w * x0.w) + (x1.x * x1.x + x1.y * x1.y) + (x1.z * x1.z + x1.w * x1.w)) * (1.0f / 512.0f);
        const float rstd = rsqrtf(var + EPS);
        f32x4 y0 = x0 * rstd * g0 + b0, y1 = x1 * rstd * g1 + b1;
        y0 = (f32x4){y0.x * sigm(y0.x), y0.y * sigm(y0.y), y0.z * sigm(y0.z), y0.w * sigm(y0.w)}; y1 = (f32x4){y1.x * sigm(y1.x), y1.y * sigm(y1.y), y1.z * sigm(y1.z), y1.w * sigm(y1.w)};
        v4u o; o.x = cvtpk(y0.x, y0.y); o.y = cvtpk(y0.z, y0.w); o.z = cvtpk(y1.x, y1.y); o.w = cvtpk(y1.z, y1.w);
        *(v4u*)(MIX + (size_t)(rowbase + t0 + tt) * D + 512 + 8 * lane) = o; }
    __syncthreads();
}
__device__ __forceinline__ void s5_scan(const Args& A, int gt) {
    if (gt >= NB * 64 * 2 * 64) return;
    const int p = gt & 63, d = (gt >> 6) & 1, g = (gt >> 7) & 63, b = gt >> 13;
    const int ix = (d * 64 + g) * 64 + p;
    const float ar = A.in[I_ARE][ix], ai = A.in[I_AIM][ix], dt = __expf(A.in[I_LOGDT][d * 64 + g]);
    const float zr = ar * dt, zi = ai * dt, mag = __expf(zr); float lr = mag * cosf(zi), li = mag * sinf(zi);
#pragma unroll
    for (int k = 0; k < 5; ++k) { const float nr = lr * lr - li * li, ni = 2.f * lr * li; lr = nr; li = ni; }
    const float* E = (const float*)(A.ws + WS_E) + (size_t)g * 768 * 256 + d * 128 + p;
    bf16* UC = (bf16*)(A.ws + WS_UC) + (size_t)g * 768 * 768 + 512 + d * 128 + p;
    float sr = 0.f, si = 0.f;
    for (int s0 = 0; s0 < 72; s0 += 24) {
        float er[24], ei[24]; int bcs[24];
#pragma unroll
        for (int k = 0; k < 24; ++k) { const int step = s0 + k; int bc;
            if (step < 8) bc = 512 + 8 * b + (d == 0 ? step : 7 - step); else bc = 64 * b + (d == 0 ? step - 8 : 71 - step);
            bcs[k] = bc; er[k] = E[(size_t)bc * 256]; ei[k] = E[(size_t)bc * 256 + 64]; }
#pragma unroll
        for (int k = 0; k < 24; ++k) {
            if (s0 + k >= 8) { UC[(size_t)bcs[k] * 768] = (bf16)f2bf(sr); UC[(size_t)bcs[k] * 768 + 64] = (bf16)f2bf(si); }
            const float nr = lr * sr - li * si + er[k], ni = lr * si + li * sr + ei[k]; sr = nr; si = ni; }
    }
}
__device__ __forceinline__ void moe_route(const Args& A, const bf16* X, const float* mod, bf16* H, int chunk, LAS unsigned* lcnt, int tid, int wave, int lane) {
    unsigned char* tok = A.ws + WS_TOK;
    int* tokE = (int*)(tok + TOK_E); float* tokW = (float*)(tok + TOK_W); int* tokRank = (int*)(tok + TOK_RANK); int* wgbase = (int*)(tok + TOK_WGBASE);
    if (tid < 8) lcnt[tid] = 0u;
    __syncthreads();
    const float* gain = A.in[I_N2G] + D; const float* wr = A.in[I_ROUTER];
    for (int q2 = 0; q2 < 8; q2 += 2) {
        f32x4 vv[2][4];
#pragma unroll
        for (int u = 0; u < 2; ++u) { const bf16* xr = X + (size_t)(chunk * 64 + wave * 8 + q2 + u) * D;
#pragma unroll
            for (int j = 0; j < 4; ++j) { const v2u xw = *(const v2u*)(xr + 4 * lane + 256 * j); vv[u][j] = (f32x4){bflo(xw.x), bfhi(xw.x), bflo(xw.y), bfhi(xw.y)}; } }
#pragma unroll
        for (int u = 0; u < 2; ++u) {
        const int row = chunk * 64 + wave * 8 + q2 + u; const float* mp = mod + (size_t)(row >> 11) * 6144;
        float ss = 0.f;
#pragma unroll
        for (int j = 0; j < 4; ++j) ss += (vv[u][j].x * vv[u][j].x + vv[u][j].y * vv[u][j].y) + (vv[u][j].z * vv[u][j].z + vv[u][j].w * vv[u][j].w);
        const float rstd = rsqrtf(wave_sum(ss) * (1.0f / D) + EPS);
        float lg[8]; f32x4 hq[4];
#pragma unroll
        for (int e = 0; e < 8; ++e) lg[e] = 0.f;
#pragma unroll
        for (int j = 0; j < 4; ++j) { const int k = 4 * lane + 256 * j; const f32x4 gg = *(const f32x4*)(gain + k), sc = *(const f32x4*)(mp + 4 * 1024 + k), sh = *(const f32x4*)(mp + 3 * 1024 + k);
            const f32x4 h = vv[u][j] * rstd * gg * (sc + 1.0f) + sh; hq[j] = h;
#pragma unroll
            for (int i = 0; i < 4; ++i) { const f32x4 w0 = *(const f32x4*)(wr + (size_t)(k + i) * 8), w1 = *(const f32x4*)(wr + (size_t)(k + i) * 8 + 4); const float hv = h[i];
                lg[0] += hv * w0.x; lg[1] += hv * w0.y; lg[2] += hv * w0.z; lg[3] += hv * w0.w; lg[4] += hv * w1.x; lg[5] += hv * w1.y; lg[6] += hv * w1.z; lg[7] += hv * w1.w; } }
        {
            float am = 0.f;
#pragma unroll
            for (int j = 0; j < 4; ++j) am = fmaxf(am, fmaxf(fmaxf(fabsf(hq[j].x), fabsf(hq[j].y)), fmaxf(fabsf(hq[j].z), fabsf(hq[j].w))));
            am = wave_max(am); const float inv = am > 0.f ? 127.0f / am : 0.f;
#pragma unroll
            for (int j = 0; j < 4; ++j) *(unsigned*)((unsigned char*)H + (size_t)row * D + 4 * lane + 256 * j) = q8pack(hq[j].x * inv, hq[j].y * inv, hq[j].z * inv, hq[j].w * inv);
            if (lane == 0) ((float*)(A.ws + WS_ROWSC))[row] = am * (1.0f / 127.0f); }
#pragma unroll
        for (int e = 0; e < 8; ++e) lg[e] = wave_sum(lg[e]);
        int e0 = 0; float v0 = lg[0];
#pragma unroll
        for (int e = 1; e < 8; ++e) if (lg[e] > v0) { v0 = lg[e]; e0 = e; }
        int e1 = -1; float v1 = -3.0e38f;
#pragma unroll
        for (int e = 0; e < 8; ++e) if (e != e0 && lg[e] > v1) { v1 = lg[e]; e1 = e; }
        const float ex = __expf(v1 - v0), w0 = 1.0f / (1.0f + ex), w1 = ex * w0;
        if (lane == 0) { const unsigned r0 = __hip_atomic_fetch_add(&lcnt[e0], 1u, __ATOMIC_RELAXED, __HIP_MEMORY_SCOPE_WORKGROUP), r1 = __hip_atomic_fetch_add(&lcnt[e1], 1u, __ATOMIC_RELAXED, __HIP_MEMORY_SCOPE_WORKGROUP);
            tokE[2 * row] = e0; tokE[2 * row + 1] = e1; tokW[2 * row] = w0; tokW[2 * row + 1] = w1; tokRank[2 * row] = (int)r0; tokRank[2 * row + 1] = (int)r1; }
        }
    }
    __syncthreads();
    if (tid < 8) { const unsigned n = lcnt[tid]; const unsigned base = __hip_atomic_fetch_add((unsigned*)(A.ws + WS_CTL) + CW_GCNT + 64 * tid, n, RLX_AGENT); wgbase[chunk * 8 + tid] = (int)base; }
    __syncthreads();
}
constexpr int NPHASE = 17;
__device__ __forceinline__ void moe_offsets(const unsigned char* ws, int (&toff)[9]) {
    const unsigned* gc = (const unsigned*)(ws + WS_CTL) + CW_GCNT; int acc = 0;
#pragma unroll
    for (int e = 0; e < 8; ++e) { toff[e] = acc; const unsigned n = __hip_atomic_load(gc + 64 * e, RLX_AGENT); acc += (int)((n + 255u) >> 8); }
    toff[8] = acc;
}
#define TAIL_CONVERT(nunits, first, count) do { const int rounds_ = ((nunits) + G - 1) / G, nlast_ = (nunits) - (rounds_ - 1) * G; \
        if (bx >= nlast_) moe_convert(args, lds, (first), (count), (bx - nlast_) * NWAVES + wave, (G - nlast_) * NWAVES, wave, lane); } while (0)
constexpr int CVQ4 = 4000, CVQ6 = 8000, CVQ7 = 17500, CVQ9 = 8500, CVQS1 = 2000, CVQS2 = CV_NMOE - CVQ4 - CVQ6 - CVQ7 - CVQ9 - CVQS1;
__global__ void __launch_bounds__(NWAVES * 64, 2) fwd_kernel(Args args) {
    extern __shared__ __attribute__((aligned(16))) unsigned char lds_raw[];
    LAS unsigned char* lds = (LAS unsigned char*)lds_raw;
    volatile LAS unsigned* MISC = (volatile LAS unsigned*)(lds + MISC_OFF);
    const int tid = threadIdx.x, lane = tid & 63, wave = __builtin_amdgcn_readfirstlane(tid >> 6);
    const int G = gridDim.x, bx = blockIdx.x;
    const int gw = bx * NWAVES + wave, NGW = G * NWAVES;
    unsigned char* ws = args.ws;
    for (int u = tid; u < (LDS_BYTES - LDSCTL_OFF) / 4; u += NWAVES * 64) ((LAS unsigned*)(lds + LDSCTL_OFF))[u] = 0u;
    __syncthreads();
    const int lo = args.ph_lo, hi = args.ph_hi;
    XcdBarrier bar; bar.bar = (unsigned*)(ws + WS_CTL) + CW_BAR; bar.x = 0; bar.st = nullptr;
    if (hi - lo > 1) bar = xcd_barrier_post((unsigned*)(ws + WS_CTL) + CW_BAR, MISC + 8);
#define IN(k) (lo <= (k) && (k) < hi)
#define SEAM(k) do { if (IN((k) + 1)) xcd_barrier(bar); } while (0)
    float* mod = (float*)(ws + WS_MOD);
    bf16* XL = (bf16*)(ws + WS_XL); bf16* XC = (bf16*)(ws + WS_XC);
    bf16* H = (bf16*)(ws + WS_H);

    if (IN(0)) {
        for (int i = bx * (NWAVES * 64) + tid; i < NE * 2 * ED; i += G * NWAVES * 64) ((unsigned*)(ws + WS_COLMAX))[i] = 0u;
        for (int u = bx; u < 192; u += G) { if (args.sub & 1) p0_adaln(args, u, lds, tid, wave, lane); }
        if (args.sub & 4) p0_convert(args, lds, gw, NGW, wave, lane);
        SEAM(0);
    }
    if (IN(1)) {
        { const float* modp = (const float*)(ws + WS_MODP);
          for (int i = bx * (NWAVES * 64) + tid; i < MOD_N; i += G * NWAVES * 64) mod[i] = ((modp[i] + modp[MOD_N + i]) + modp[2 * MOD_N + i]) + modp[3 * MOD_N + i]; }
        { const float* modp = (const float*)(ws + WS_MODP); LAS float* ms = (LAS float*)lds;
          for (int i = tid; i < 9 * 2048; i += NWAVES * 64) { const int r = i >> 11, o = r * 6144 + (i & 2047); ms[i] = ((modp[o] + modp[MOD_N + o]) + modp[2 * MOD_N + o]) + modp[3 * MOD_N + o]; }
          __syncthreads(); norm_rows_lds(args.in[I_X], args.in[I_CTX], MT, args.in[I_N1G], ms, H, (float*)(ws + WS_ROWFAC1), gw, NGW, lane); }
        quant_rows_inplace_p((bf16*)(ws + WS_WIN), (const float*)(ws + WS_PMAX), (float*)(ws + WS_COLSCD), MIXIN, gw, NGW, lane);
        SEAM(1); }
    if (IN(2)) {
        pg8::Gemm g{H, (const bf16*)(ws + WS_WIN), MT, MIXIN, D / 2, D / 2, D}; pg8::StaticOrder S; S.init(MT, MIXIN, G, bx);
        pg8::EpiQKVUq E{(bf16*)(ws + WS_QKVU), args.in[I_QG], args.in[I_KG], EPS, (const float*)(ws + WS_ROWFAC1), (const float*)(ws + WS_COLSCD)};
        pg8::gemm_phase<pg8::EpiQKVUq, pg8::StaticOrder, true, true>(lds + RING_OFF, g, S, E);
        SEAM(2);
    }
    if (IN(3)) {
        const bf16* QKVU = (const bf16*)(ws + WS_QKVU); bf16* MIX = (bf16*)(ws + WS_MIX);
        LAS float* rpbl = (LAS float*)(lds + 40960); LAS float* cv = (LAS float*)(lds + 57344);
        float mq = 0.f, mk = 0.f, mb = 0.f;
        mq = fabsf(args.in[I_QG][lane]); mk = fabsf(args.in[I_KG][lane]);
        for (int i = lane; i < 8 * 465; i += 64) mb = fmaxf(mb, fabsf(args.in[I_RPB][i]));
        const float bnd = (8.2f * wave_max(mq) * wave_max(mk) + wave_max(mb)) * 1.44269504f;
        for (int i = tid; i < 8 * 465; i += NWAVES * 64) rpbl[i] = args.in[I_RPB][i] * 1.44269504f - bnd;
        __syncthreads();
        const int nbw = (G % 8 == 0) ? G / 8 : G, xb0 = (G % 8 == 0) ? (bx & 7) : 0, xbn = (G % 8 == 0) ? xb0 + 1 : 8, j0 = (G % 8 == 0) ? (bx >> 3) : bx;
        for (int x = xb0; x < xbn; ++x)
            for (int k = j0; k < 128; k += nbw) {
                if (k < 36) {
                    if (!(args.sub & (k < 32 ? 8 : 16))) continue;
                    const int wu = k < 32 ? (x * 32 + k) * 8 + wave : 2048 + (x * 4 + (k - 32)) * 8 + wave;
                    attn_unit(QKVU, MIX, wu, lds + wave * 5120, lds + 57344 + wave * 8192, rpbl, bnd, lane);
                } else {
                    if (!(args.sub & 32)) continue;
                    const int ci = k < 64 ? k - 36 : (k < 96 ? k - 36 : (k >= 100 && k < 112 ? k - 40 : -1)); if (ci < 0) continue;
                    conv_item(args, QKVU, MIX, ci < 64 ? x * 64 + ci : 512 + x * 8 + (ci - 64), cv, tid, wave, lane);
                }
            }
        SEAM(3);
    }
    if (IN(4)) {
        pg8::Gemm g{(const bf16*)(ws + WS_MIX), (const bf16*)(ws + WS_WOUT), MT, D, D, D, D}; pg8::StaticOrder S; S.init(MT, D, G, bx);
        pg8::EpiResidN<true> E{args.in[I_X], args.in[I_CTX], XL, XC, mod + 2 * 1024, H, (float*)(ws + WS_ROWSS), args.in[I_N2G], mod + 4 * 1024};
        pg8::gemm_phase<pg8::EpiResidN<true>, pg8::StaticOrder, true, true>(lds + RING_OFF, g, S, E);
        {
            const int nun = (MT / 256) * (D / 256), rounds = (nun + G - 1) / G, nlast = nun - (rounds - 1) * G, nidle = G - nlast, ii = bx - nlast;
            if (ii >= 0) {
                if (args.sub & 2) for (int u = ii; u < 128; u += nidle) p0_s5gen(args, u >> 1, u & 1, lds, tid);
                const bool cvw = (nidle > 128) ? (ii >= 128) : true;
                const int cw = (nidle > 128) ? (ii - 128) * NWAVES + wave : ii * NWAVES + wave, cn = (nidle > 128) ? (nidle - 128) * NWAVES : nidle * NWAVES;
                if (cvw) {
                    shw_rows((const bf16*)(ws + WS_W13), 2 * FFN, mod + 3 * 1024, (float*)(ws + WS_SHW13), cw, cn, lds, tid, lane);
                    shw_rows((const bf16*)(ws + WS_SIN), D, mod + 9 * 6144, (float*)(ws + WS_SHWS), cw, cn, lds, tid, lane);
                    moe_convert(args, lds, 0, CVQ4, cw, cn, wave, lane); }
            }
            if (nidle <= 0) { for (int u = bx; u < 128; u += G) p0_s5gen(args, u >> 1, u & 1, lds, tid);
                shw_rows((const bf16*)(ws + WS_W13), 2 * FFN, mod + 3 * 1024, (float*)(ws + WS_SHW13), gw, NGW, lds, tid, lane); shw_rows((const bf16*)(ws + WS_SIN), D, mod + 9 * 6144, (float*)(ws + WS_SHWS), gw, NGW, lds, tid, lane);
                moe_convert(args, lds, 0, CVQ4, gw, NGW, wave, lane); }
        }
        SEAM(4);
    }
    if (IN(5)) {
        pg8::Gemm g{H, (const bf16*)(ws + WS_W13), MT, 2 * FFN, D, D, D}; pg8::StaticOrder S; S.init(MT, 2 * FFN, G, bx);
        LAS float* rt = (LAS float*)(lds + RING_BYTES); pg8::rstd_prepass(S, (const float*)(ws + WS_ROWSS), rt, EPS, tid);
        pg8::EpiSwiGLUN E{(bf16*)(ws + WS_ACT), FFN, rt, (const float*)(ws + WS_SHW13), 2 * FFN};
        pg8::gemm_phase<pg8::EpiSwiGLUN, pg8::StaticOrder, true, true>(lds + RING_OFF, g, S, E);
        TAIL_CONVERT((MT / 256) * (2 * FFN / 256), CVQ4, CVQ6);
        SEAM(5);
    }
    if (IN(6)) {
        pg8::Gemm g{(const bf16*)(ws + WS_ACT), (const bf16*)(ws + WS_W2), MT, D, FFN, FFN, FFN}; pg8::StaticOrder S; S.init(MT, D, G, bx);
        pg8::EpiResidN<false> E{XL, XC, XL, XC, mod + 5 * 1024, H, (float*)(ws + WS_ROWSS), args.in[I_N1G] + D, mod + 9 * 6144 + 1 * 1024};
        pg8::gemm_phase<pg8::EpiResidN<false>, pg8::StaticOrder, true, true>(lds + RING_OFF, g, S, E);
        TAIL_CONVERT((MT / 256) * (D / 256), CVQ4 + CVQ6, CVQ7);
        SEAM(6);
    }
    float* mod1 = mod + 9 * 6144;
    if (IN(7)) {
        pg8::Gemm g{H, (const bf16*)(ws + WS_SIN), MT, D, D, D, D}; pg8::StaticOrder S; S.init(MT, D, G, bx);
        LAS float* rt = (LAS float*)(lds + RING_BYTES); pg8::rstd_prepass(S, (const float*)(ws + WS_ROWSS), rt, EPS, tid);
        pg8::EpiUC E{(bf16*)(ws + WS_UC), rt, (const float*)(ws + WS_SHWS)};
        pg8::gemm_phase<pg8::EpiUC, pg8::StaticOrder, true, true>(lds + RING_OFF, g, S, E);
        TAIL_CONVERT((MT / 256) * (D / 256), CVQ4 + CVQ6 + CVQ7, CVQ9);
        SEAM(7);
    }
    if (IN(8)) {
        pg8::Gemm g{(const bf16*)(ws + WS_UC), (const bf16*)(ws + WS_WEND), 64 * 768, 64 * 256, 512, 768, 512}; pg8::OrderS5E S{G, bx};
        pg8::EpiE E{(float*)(ws + WS_E)};
        pg8::gemm_phase<pg8::EpiE, pg8::OrderS5E, true, true>(lds + RING_OFF, g, S, E);
        if (G == 256) { if ((bx >> 3) >= 24) moe_convert(args, lds, CVQ4 + CVQ6 + CVQ7 + CVQ9, CVQS1, (((bx >> 3) - 24) * 8 + (bx & 7)) * NWAVES + wave, 64 * NWAVES, wave, lane); }
        else moe_convert(args, lds, CVQ4 + CVQ6 + CVQ7 + CVQ9, CVQS1, gw, NGW, wave, lane);
        SEAM(8);
    }
    if (IN(9)) { s5_scan(args, bx * (NWAVES * 64) + tid);
        if (G > 128) { if (bx >= 128) moe_convert(args, lds, CVQ4 + CVQ6 + CVQ7 + CVQ9 + CVQS1, CVQS2, (bx - 128) * NWAVES + wave, (G - 128) * NWAVES, wave, lane); }
        else moe_convert(args, lds, CVQ4 + CVQ6 + CVQ7 + CVQ9 + CVQS1, CVQS2, gw, NGW, wave, lane);
        SEAM(9); }
    if (IN(10)) {
        pg8::Gemm g{(const bf16*)(ws + WS_UC), (const bf16*)(ws + WS_BTOUT), 64 * 768, 64 * 512, 768, 768, 768}; pg8::OrderS5Y S{G, bx};
        pg8::EpiY E{(bf16*)(ws + WS_Y)};
        pg8::gemm_phase<pg8::EpiY, pg8::OrderS5Y, true, true>(lds + RING_OFF, g, S, E);
        SEAM(10);
    }
    if (IN(11)) {
        pg8::Gemm g{(const bf16*)(ws + WS_Y), (const bf16*)(ws + WS_SOUT), ML, 2 * D, D, D, D}; pg8::StaticOrder S; S.init(ML, 2 * D, G, bx);
        pg8::EpiGLURes E{XL, mod1 + 2 * 1024};
        pg8::gemm_phase<pg8::EpiGLURes, pg8::StaticOrder, true, true>(lds + RING_OFF, g, S, E);
        SEAM(11);
    }
    unsigned char* tok = ws + WS_TOK;
    if (IN(12)) {
        int* rowsrc = (int*)(tok + TOK_ROWSRC); int* rowinfo = (int*)(tok + TOK_ROWINFO); float* rowgate = (float*)(tok + TOK_ROWGATE);
        for (int i = bx * (NWAVES * 64) + tid; i < MOE_TILES * 256; i += G * NWAVES * 64) { rowsrc[i] = 0; rowinfo[i] = -1; rowgate[i] = 0.f; ((float*)(ws + WS_POSSC))[i] = 0.f; }
        for (int ch = bx; ch < ML / 64; ch += G) moe_route(args, XL, mod1, H, ch, (LAS unsigned*)lds, tid, wave, lane);
        SEAM(12);
    }
    if (IN(13)) {
        int toff[9]; moe_offsets(ws, toff);
        const int* tokE = (const int*)(tok + TOK_E); const float* tokW = (const float*)(tok + TOK_W); const int* tokRank = (const int*)(tok + TOK_RANK); const int* wgbase = (const int*)(tok + TOK_WGBASE);
        int* rowsrc = (int*)(tok + TOK_ROWSRC); int* rowinfo = (int*)(tok + TOK_ROWINFO); float* rowgate = (float*)(tok + TOK_ROWGATE); int* tokPos = (int*)(tok + TOK_POS);
        for (int i = bx * (NWAVES * 64) + tid; i < 2 * ML; i += G * NWAVES * 64) { const int t = i >> 1, e = tokE[i]; int to = 0;
#pragma unroll
            for (int q = 0; q < 8; ++q) to = (e == q) ? toff[q] : to;
            const int pos = to * 256 + wgbase[(t >> 6) * 8 + e] + tokRank[i];
            rowsrc[pos] = t; rowinfo[pos] = i; rowgate[pos] = tokW[i]; tokPos[i] = pos; ((float*)(ws + WS_POSSC))[pos] = ((const float*)(ws + WS_ROWSC))[t]; }
        quant_rows_inplace((bf16*)(ws + WS_MW13), (unsigned*)(ws + WS_COLMAX), NE * 2 * ED, gw, NGW, lane);
        SEAM(13);
    }
    if (IN(14)) {
        pg8::OrderMoE S; S.G = G; S.c = bx; S.nN = 2 * ED / 256; S.tmax = 1 << 30; S.fix = (args.sub >> 7) & 1; moe_offsets(ws, S.toff);
        pg8::Gemm g{H, (const bf16*)(ws + WS_MW13), MOE_TILES * 256, NE * 2 * ED, D / 2, D / 2, D, (const int*)(tok + TOK_ROWSRC)};
        pg8::EpiSwiGLUq E{(bf16*)(ws + WS_ACTM), ED, 2 * ED / 256, (const float*)(ws + WS_POSSC), (const float*)(ws + WS_COLSC)};
        pg8::gemm_phase<pg8::EpiSwiGLUq, pg8::OrderMoE, true, true, true>(lds + RING_OFF, g, S, E);
        SEAM(14);
    }
    if (IN(15)) {
        pg8::OrderMoE S; S.G = G; S.c = bx; S.nN = D / 256; S.tmax = 128; S.fix = 0; moe_offsets(ws, S.toff);
        pg8::Gemm g{(const bf16*)(ws + WS_ACTM), (const bf16*)(ws + WS_MW2), MOE_TILES * 256, NE * D, ED, ED, ED};
        pg8::EpiMoE2 E{(bf16*)args.out, (const float*)(tok + TOK_ROWGATE), (const int*)(tok + TOK_ROWINFO)};
        pg8::gemm_phase<pg8::EpiMoE2, pg8::OrderMoE, true, true>(lds + RING_OFF, g, S, E);
        pg8::OrderMoEx Sx; Sx.G = G; Sx.c = bx; moe_offsets(ws, Sx.toff);
        pg8::Gemm gx{(const bf16*)(ws + WS_ACTM), (const bf16*)(ws + WS_MW2), MOE_TILES * 256, NE * D, 896, ED, ED};
        pg8::EpiMoE2x Ex{(float*)(ws + WS_PX), (const float*)(tok + TOK_ROWGATE)};
        pg8::gemm_phase<pg8::EpiMoE2x, pg8::OrderMoEx, true, false>(lds + RING_OFF, gx, Sx, Ex);
        SEAM(15);
    }
    if (IN(16)) {
        const unsigned bad = __hip_atomic_load((unsigned*)(ws + WS_CTL) + CW_BAR + XB_TMO, RLX_AGENT);
        const int* tokPos = (const int*)(tok + TOK_POS); const float* PX = (const float*)(ws + WS_PX);
        for (int tb = gw; tb < ML; tb += 2 * NGW) {
            const int tt[2] = {tb, (tb + NGW < ML) ? tb + NGW : tb}; const int ntk = (tb + NGW < ML) ? 2 : 1;
            v2u a[2][4], b[2][4], xw[2][4]; f32x4 gv[2][4]; int p0[2], p1[2];
#pragma unroll
            for (int u = 0; u < 2; ++u) { const int t = tt[u]; const bf16* y0 = (const bf16*)(args.out + (size_t)t * D); const bf16* y1 = y0 + D; const float* gp = mod1 + (size_t)(t >> 11) * 6144 + 5 * 1024;
                p0[u] = tokPos[2 * t] - 128 * 256; p1[u] = tokPos[2 * t + 1] - 128 * 256;
#pragma unroll
                for (int j = 0; j < 4; ++j) { const int c = 4 * lane + 256 * j; a[u][j] = *(const v2u*)(y0 + c); b[u][j] = *(const v2u*)(y1 + c); xw[u][j] = *(const v2u*)(XL + (size_t)t * D + c); gv[u][j] = *(const f32x4*)(gp + c); } }
            asm volatile("s_waitcnt vmcnt(0)" ::: "memory");
#pragma unroll
            for (int u = 0; u < 2; ++u) { if (u < ntk) { const int t = tt[u];
#pragma unroll
                for (int j = 0; j < 4; ++j) { const int c = 4 * lane + 256 * j;
                    f32x4 ya = (f32x4){bflo(a[u][j].x), bfhi(a[u][j].x), bflo(a[u][j].y), bfhi(a[u][j].y)}, yb = (f32x4){bflo(b[u][j].x), bfhi(b[u][j].x), bflo(b[u][j].y), bfhi(b[u][j].y)};
                    if (p0[u] >= 0) { const float* q = PX + (size_t)p0[u] * D + c; ya = ((*(const f32x4*)q + *(const f32x4*)(q + (size_t)2048 * D)) + *(const f32x4*)(q + (size_t)4096 * D)) + *(const f32x4*)(q + (size_t)6144 * D); }
                    if (p1[u] >= 0) { const float* q = PX + (size_t)p1[u] * D + c; yb = ((*(const f32x4*)q + *(const f32x4*)(q + (size_t)2048 * D)) + *(const f32x4*)(q + (size_t)4096 * D)) + *(const f32x4*)(q + (size_t)6144 * D); }
                    const f32x4 xv = (f32x4){bflo(xw[u][j].x), bfhi(xw[u][j].x), bflo(xw[u][j].y), bfhi(xw[u][j].y)};
                    f32x4 o = xv + gv[u][j] * (ya + yb); if (bad) o = (f32x4){__builtin_nanf(""), __builtin_nanf(""), __builtin_nanf(""), __builtin_nanf("")};
                    *(f32x4*)(args.out + (size_t)t * D + c) = o; } } }
        }
    }
#undef IN
#undef SEAM
}

extern "C" void kernel_launch(void* const* d_in, const int* in_sizes, int n_in, void* d_out, int out_size, void* d_ws, size_t ws_size, hipStream_t stream) {
    static int grid = 0;
    if (grid == 0) {
        if (n_in != N_IN || out_size != ML * D || ws_size < WS_END) { fprintf(stderr, "kernel_launch: unexpected problem (n_in %d, out %d, ws %zu); nothing launched\n", n_in, out_size, ws_size); grid = -1; return; }
        int dev = 0, cus = 0, per_cu = 0;
        if (hipGetDevice(&dev) != hipSuccess || hipDeviceGetAttribute(&cus, hipDeviceAttributeMultiprocessorCount, dev) != hipSuccess) { grid = -1; return; }
        if (hipFuncSetAttribute((const void*)fwd_kernel, hipFuncAttributeMaxDynamicSharedMemorySize, LDS_BYTES) != hipSuccess) { fprintf(stderr, "kernel_launch: hipFuncSetAttribute failed\n"); grid = -1; return; }
        if (hipOccupancyMaxActiveBlocksPerMultiprocessor(&per_cu, (const void*)fwd_kernel, NWAVES * 64, LDS_BYTES) != hipSuccess || per_cu < 1) { fprintf(stderr, "kernel_launch: occupancy query says %d blocks per CU\n", per_cu); (void)hipGetLastError(); grid = -1; return; }
        grid = cus;
    }
    if (grid < 0) return;
    if (hipMemsetAsync((char*)d_ws + WS_CTL, 0, CTL_ZERO_BYTES, stream) != hipSuccess) return;
    Args a{};
    for (int i = 0; i < N_IN; ++i) a.in[i] = (const float*)d_in[i];
    a.out = (float*)d_out; a.ws = (unsigned char*)d_ws; a.sub = 63;
#if MK_N_LAUNCHES == 1
    a.ph_lo = 0; a.ph_hi = NPHASE;
    hipLaunchKernelGGL(fwd_kernel, dim3(grid), dim3(NWAVES * 64), LDS_BYTES, stream, a);
#else
    for (int p = 0; p < NPHASE; ++p) { const int nrep = ((MK_REPEAT_MASK >> p) & 1u) ? 2 : 1;
        for (int r = 0; r < nrep; ++r) { a.ph_lo = p; a.ph_hi = p + 1; a.sub = (r == 0) ? 63 : MK_REPEAT_SUB; hipLaunchKernelGGL(fwd_kernel, dim3(grid), dim3(NWAVES * 64), LDS_BYTES, stream, a); } }
#endif
}
```

```cpp
#include <hip/hip_runtime.h>
#include <cstdio>
#include <cstdint>
#ifndef MK_N_LAUNCHES
#define MK_N_LAUNCHES 1
#endif
#ifndef MK_REPEAT_SUB
#define MK_REPEAT_SUB 63
#endif
#ifndef MK_REPEAT_MASK
#define MK_REPEAT_MASK 0u
#endif
namespace pg8 {
#define PG8_LAS __attribute__((address_space(3)))
typedef unsigned short bf16_t;
typedef short bf16x8 __attribute__((ext_vector_type(8)));
typedef float f32x4 __attribute__((ext_vector_type(4)));
typedef unsigned u32x4 __attribute__((ext_vector_type(4)));
typedef unsigned u32x2 __attribute__((ext_vector_type(2)));
typedef int i32x4 __attribute__((ext_vector_type(4)));
__device__ __forceinline__ f32x4 mma16(bf16x8 a, bf16x8 b, f32x4 c) { return __builtin_amdgcn_mfma_f32_16x16x32_bf16(a, b, c, 0, 0, 0); }
__device__ __forceinline__ i32x4 mma16(bf16x8 a, bf16x8 b, i32x4 c) { return __builtin_amdgcn_mfma_i32_16x16x64_i8(__builtin_bit_cast(i32x4, a), __builtin_bit_cast(i32x4, b), c, 0, 0, 0); }
constexpr int BM = 256, BK = 64, HALF = 128, HTB = HALF * BK * 2  , STAGE_BYTES = 8 * HTB, NXCD = 8, WGM = 8;

__host__ __device__ __forceinline__ int lds_byte(int r, int c) { const int st = (r >> 4) * 2 + (c >> 5), rr = r & 15, cc = c & 31, ob = rr * 64 + cc * 2; return st * 1024 + (ob ^ (((ob >> 9) & 1) << 5)); }
__host__ __device__ __forceinline__ void stage_rc(int b, int& R, int& C) { const int st = b / 1024, sb = b % 1024, swz = sb ^ (((sb >> 9) & 1) << 5); R = (st >> 1) * 16 + swz / 64; C = (st & 1) * 32 + (swz % 64) / 2; }
__host__ __device__ __forceinline__ int perm32(int rho) { const int n = rho >> 4, i = rho & 15; return 8 * (i >> 2) + 4 * n + (i & 3); }

struct Unit { int pm, pn, k0, idx; };
struct Gemm { const bf16_t* A; const bf16_t* Bt; int M, N, K, lda, ldb; const int* rowsrc; };

struct StaticOrder {
    int nM, nN, nwg, G, c;
    __host__ __device__ void init(int M, int N, int G_, int c_) { nM = M / BM; nN = N / BM; nwg = nM * nN; G = G_; c = c_; }
    __host__ __device__ bool next(int i, Unit& u) const {
        const long L = (long)i * G + c; if (L >= nwg) return false;
        int wgid = (int)L; { const int q = nwg / NXCD, r = nwg % NXCD, xcd = wgid % NXCD, off = wgid / NXCD; wgid = (xcd < r ? xcd * (q + 1) : r * (q + 1) + (xcd - r) * q) + off; }
        const int nig = WGM * nN, gid = wgid / nig, fm = gid * WGM, gsz = (nM - fm) < WGM ? (nM - fm) : WGM;
        u.pm = fm + ((wgid % nig) % gsz); u.pn = (wgid % nig) / gsz; u.k0 = 0; u.idx = i; return true;
    }
    __device__ __forceinline__ void a_ready(const Unit&) const {}
    __device__ __forceinline__ void done(const Unit&) const {}
};

constexpr int ML_ = 16384, MC_ = 2048, MT_ = ML_ + MC_, DM_ = 1024;
__device__ __forceinline__ unsigned cvt_pk_bf16(float lo, float hi) { unsigned r; asm volatile("v_cvt_pk_bf16_f32 %0, %1, %2" : "=v"(r) : "v"(lo), "v"(hi)); return r; }
__device__ __forceinline__ float sigm(float x) { return __builtin_amdgcn_rcpf(1.0f + __expf(-x)); }
__device__ __forceinline__ float gelu_tanh(float x) { const float u = 1.5957691216f * (x + 0.044715f * x * x * x); return x * sigm(u); }
__device__ __forceinline__ u32x4 pack8(const f32x4 a, const f32x4 b) { u32x4 w; w.x = cvt_pk_bf16(a[0], a[1]); w.y = cvt_pk_bf16(a[2], a[3]); w.z = cvt_pk_bf16(b[0], b[1]); w.w = cvt_pk_bf16(b[2], b[3]); return w; }


struct EpiQKVU {
    typedef f32x4 acc_t; static constexpr bool PERM = true, AFTER_DRAIN = false;
    bf16_t* O; const float* gq; const float* gk; float eps;
    __device__ __forceinline__ void operator()(const f32x4 (&acc)[2][2][4][2], const Unit& u, int wr, int wc, int fr, int fq) const {
        const int row0 = u.pm * BM + wr * 64 + fr; const int pn = u.pn;
        if (pn < 6) {
            const bool nrm = pn < 4; const float* gp = (pn < 2) ? gq : gk;
            f32x4 gn[2][2];
#pragma unroll
            for (int bj = 0; bj < 2; ++bj)
#pragma unroll
                for (int n = 0; n < 2; ++n) gn[bj][n] = nrm ? *(const f32x4*)(gp + 32 * bj + 8 * fq + 4 * n) : (f32x4){1.f, 1.f, 1.f, 1.f};
#pragma unroll
            for (int ai = 0; ai < 2; ++ai)
#pragma unroll
                for (int m = 0; m < 4; ++m) {
                    float sc = 1.f;
                    if (nrm) { float ss = 0.f;
#pragma unroll
                        for (int bj = 0; bj < 2; ++bj)
#pragma unroll
                            for (int n = 0; n < 2; ++n) { const f32x4 x = acc[ai][bj][m][n]; ss += (x[0] * x[0] + x[1] * x[1]) + (x[2] * x[2] + x[3] * x[3]); }
                        ss += __shfl_xor(ss, 16); ss += __shfl_xor(ss, 32);
                        sc = rsqrtf(ss * (1.0f / 64.0f) + eps); }
                    bf16_t* rowp = O + (size_t)(row0 + ai * HALF + m * 16) * 2048 + 256 * pn + 64 * wc + 8 * fq;
#pragma unroll
                    for (int bj = 0; bj < 2; ++bj) { const f32x4 v0 = acc[ai][bj][m][0] * gn[bj][0] * sc, v1 = acc[ai][bj][m][1] * gn[bj][1] * sc; *(u32x4*)(rowp + 32 * bj) = pack8(v0, v1); }
                }
        } else {
            const int cb = 1536 + 128 * (pn - 6) + 32 * wc + 8 * fq;
#pragma unroll
            for (int ai = 0; ai < 2; ++ai)
#pragma unroll
                for (int m = 0; m < 4; ++m) {
                    f32x4 v[2];
#pragma unroll
                    for (int n = 0; n < 2; ++n) { const f32x4 a = acc[ai][0][m][n], g = acc[ai][1][m][n]; v[n] = (f32x4){a[0] * sigm(g[0]), a[1] * sigm(g[1]), a[2] * sigm(g[2]), a[3] * sigm(g[3])}; }
                    *(u32x4*)(O + (size_t)(row0 + ai * HALF + m * 16) * 2048 + cb) = pack8(v[0], v[1]);
                }
        }
    }
};
struct EpiQKVUq {
    typedef i32x4 acc_t; static constexpr bool PERM = true, AFTER_DRAIN = false;
    bf16_t* O; const float* gq; const float* gk; float eps; const float* rowfac; const float* colscale;
    __device__ __forceinline__ void operator()(const i32x4 (&acc)[2][2][4][2], const Unit& u, int wr, int wc, int fr, int fq) const {
        const int row0 = u.pm * BM + wr * 64 + fr; const int pn = u.pn;
        f32x4 cs[2][2];
#pragma unroll
        for (int bj = 0; bj < 2; ++bj)
#pragma unroll
            for (int n = 0; n < 2; ++n) cs[bj][n] = *(const f32x4*)(colscale + pn * BM + bj * HALF + wc * 32 + 8 * fq + 4 * n);
#define QF(ai_, bj_, m_, n_, rf_) ((f32x4){(float)acc[ai_][bj_][m_][n_][0], (float)acc[ai_][bj_][m_][n_][1], (float)acc[ai_][bj_][m_][n_][2], (float)acc[ai_][bj_][m_][n_][3]} * cs[bj_][n_] * (rf_))
        if (pn < 6) {
            const bool nrm = pn < 4; const float* gp = (pn < 2) ? gq : gk;
            f32x4 gn[2][2];
#pragma unroll
            for (int bj = 0; bj < 2; ++bj)
#pragma unroll
                for (int n = 0; n < 2; ++n) gn[bj][n] = nrm ? *(const f32x4*)(gp + 32 * bj + 8 * fq + 4 * n) : (f32x4){1.f, 1.f, 1.f, 1.f};
#pragma unroll
            for (int ai = 0; ai < 2; ++ai)
#pragma unroll
                for (int m = 0; m < 4; ++m) {
                    float sc = 1.f; const float rf = rowfac[row0 + ai * HALF + m * 16];
                    f32x4 xf[2][2];
#pragma unroll
                    for (int bj = 0; bj < 2; ++bj)
#pragma unroll
                        for (int n = 0; n < 2; ++n) xf[bj][n] = QF(ai, bj, m, n, rf);
                    if (nrm) { float ss = 0.f;
#pragma unroll
                        for (int bj = 0; bj < 2; ++bj)
#pragma unroll
                            for (int n = 0; n < 2; ++n) { const f32x4 x = xf[bj][n]; ss += (x[0] * x[0] + x[1] * x[1]) + (x[2] * x[2] + x[3] * x[3]); }
                        ss += __shfl_xor(ss, 16); ss += __shfl_xor(ss, 32);
                        sc = rsqrtf(ss * (1.0f / 64.0f) + eps); }
                    bf16_t* rowp = O + (size_t)(row0 + ai * HALF + m * 16) * 2048 + 256 * pn + 64 * wc + 8 * fq;
#pragma unroll
                    for (int bj = 0; bj < 2; ++bj) { const f32x4 v0 = xf[bj][0] * gn[bj][0] * sc, v1 = xf[bj][1] * gn[bj][1] * sc; *(u32x4*)(rowp + 32 * bj) = pack8(v0, v1); }
                }
        } else {
            const int cb = 1536 + 128 * (pn - 6) + 32 * wc + 8 * fq;
#pragma unroll
            for (int ai = 0; ai < 2; ++ai)
#pragma unroll
                for (int m = 0; m < 4; ++m) { const float rf = rowfac[row0 + ai * HALF + m * 16];
                    f32x4 v[2];
#pragma unroll
                    for (int n = 0; n < 2; ++n) { const f32x4 a = QF(ai, 0, m, n, rf), g = QF(ai, 1, m, n, rf); v[n] = (f32x4){a[0] * sigm(g[0]), a[1] * sigm(g[1]), a[2] * sigm(g[2]), a[3] * sigm(g[3])}; }
                    *(u32x4*)(O + (size_t)(row0 + ai * HALF + m * 16) * 2048 + cb) = pack8(v[0], v[1]);
                }
        }
    }
};
#undef QF
struct EpiResid {
    typedef f32x4 acc_t; static constexpr bool PERM = false, AFTER_DRAIN = false;
    const float* baseL; const float* baseC; float* XL; float* XC; const float* gate;
    __device__ __forceinline__ void operator()(const f32x4 (&acc)[2][2][4][2], const Unit& u, int wr, int wc, int fr, int fq) const {
        const int R0 = u.pm * BM, row0 = R0 + wr * 64 + fr, col0 = u.pn * BM + wc * 32 + 4 * fq;
        const int modrow = R0 < ML_ ? (R0 >> 11) : 8;
        const float* gp = gate + (size_t)modrow * 6144 + col0;
        const float* bp = R0 < ML_ ? baseL : baseC - (size_t)ML_ * DM_;
        float* xo = R0 < ML_ ? XL : XC - (size_t)ML_ * DM_;
        f32x4 gv[2][2];
#pragma unroll
        for (int bj = 0; bj < 2; ++bj)
#pragma unroll
            for (int n = 0; n < 2; ++n) gv[bj][n] = *(const f32x4*)(gp + bj * HALF + n * 16);
#pragma unroll
        for (int ai = 0; ai < 2; ++ai)
#pragma unroll
            for (int m = 0; m < 4; ++m) { const size_t ro = (size_t)(row0 + ai * HALF + m * 16) * DM_ + col0;
#pragma unroll
                for (int bj = 0; bj < 2; ++bj)
#pragma unroll
                    for (int n = 0; n < 2; ++n) { const f32x4 xv = *(const f32x4*)(bp + ro + bj * HALF + n * 16); *(f32x4*)(xo + ro + bj * HALF + n * 16) = xv + gv[bj][n] * acc[ai][bj][m][n]; } }
    }
};
__device__ __forceinline__ void unpack8(const u32x4 w, f32x4& a, f32x4& b) {
    a = (f32x4){__builtin_bit_cast(float, w.x << 16), __builtin_bit_cast(float, w.x & 0xffff0000u), __builtin_bit_cast(float, w.y << 16), __builtin_bit_cast(float, w.y & 0xffff0000u)};
    b = (f32x4){__builtin_bit_cast(float, w.z << 16), __builtin_bit_cast(float, w.z & 0xffff0000u), __builtin_bit_cast(float, w.w << 16), __builtin_bit_cast(float, w.w & 0xffff0000u)}; }
template <bool BASE_F32> struct EpiResidN {
    typedef f32x4 acc_t; static constexpr bool PERM = true, AFTER_DRAIN = false;
    const void* baseL; const void* baseC; bf16_t* XL; bf16_t* XC; const float* gate; bf16_t* Hn; float* rowss; const float* ngain; const float* nscale;
    __device__ __forceinline__ void operator()(const f32x4 (&acc)[2][2][4][2], const Unit& u, int wr, int wc, int fr, int fq) const {
        const int R0 = u.pm * BM, row0 = R0 + wr * 64 + fr, col0 = u.pn * BM + wc * 32 + 8 * fq;
        const int modrow = R0 < ML_ ? (R0 >> 11) : 8, rsub = R0 < ML_ ? 0 : ML_;
        const float* gp = gate + (size_t)modrow * 6144 + col0; const float* sp = nscale + (size_t)modrow * 6144 + col0;
        const void* bp = R0 < ML_ ? baseL : baseC; bf16_t* xo = R0 < ML_ ? XL : XC;
        f32x4 gv[2][2], gs[2][2];
#pragma unroll
        for (int bj = 0; bj < 2; ++bj)
#pragma unroll
            for (int n = 0; n < 2; ++n) { gv[bj][n] = *(const f32x4*)(gp + bj * HALF + n * 4); gs[bj][n] = *(const f32x4*)(ngain + col0 + bj * HALF + n * 4) * (*(const f32x4*)(sp + bj * HALF + n * 4) + 1.0f); }
#pragma unroll
        for (int ai = 0; ai < 2; ++ai)
#pragma unroll
            for (int m = 0; m < 4; ++m) { const int row = row0 + ai * HALF + m * 16; const size_t ro = (size_t)(row - rsub) * DM_ + col0; float ss = 0.f;
#pragma unroll
                for (int bj = 0; bj < 2; ++bj) { f32x4 x0, x1;
                    if constexpr (BASE_F32) { x0 = *(const f32x4*)((const float*)bp + ro + bj * HALF); x1 = *(const f32x4*)((const float*)bp + ro + bj * HALF + 4); }
                    else unpack8(*(const u32x4*)((const bf16_t*)bp + ro + bj * HALF), x0, x1);
                    const u32x4 xw = pack8(x0 + gv[bj][0] * acc[ai][bj][m][0], x1 + gv[bj][1] * acc[ai][bj][m][1]); *(u32x4*)(xo + ro + bj * HALF) = xw;
                    f32x4 r0, r1; unpack8(xw, r0, r1);
                    ss += ((r0[0] * r0[0] + r0[1] * r0[1]) + (r0[2] * r0[2] + r0[3] * r0[3])) + ((r1[0] * r1[0] + r1[1] * r1[1]) + (r1[2] * r1[2] + r1[3] * r1[3]));
                    *(u32x4*)(Hn + (size_t)row * DM_ + col0 + bj * HALF) = pack8(r0 * gs[bj][0], r1 * gs[bj][1]); }
                ss += __shfl_xor(ss, 16); ss += __shfl_xor(ss, 32);
                if (fq == 0) rowss[(size_t)row * 16 + u.pn * 4 + wc] = ss; }
    }
};
__device__ __forceinline__ float row_rstd(const float* rowss, int row, float eps) {
    const f32x4* p = (const f32x4*)(rowss + (size_t)row * 16); const f32x4 a = p[0], b = p[1], c = p[2], d = p[3];
    const float s = (((a[0] + a[1]) + (a[2] + a[3])) + ((b[0] + b[1]) + (b[2] + b[3]))) + (((c[0] + c[1]) + (c[2] + c[3])) + ((d[0] + d[1]) + (d[2] + d[3])));
    return rsqrtf(s * (1.0f / 1024.0f) + eps); }
template <class Sched> __device__ __forceinline__ void rstd_prepass(const Sched& S, const float* rowss, PG8_LAS float* rt, float eps, int tid) {
    Unit u; int n = 0; while (n < 8 && S.next(n, u)) ++n;
#pragma unroll
    for (int q = 0; q < 4; ++q) { const int r = tid + 512 * q, i = r >> 8;
        if (i < n) { S.next(i, u); rt[r] = row_rstd(rowss, u.pm * BM + (r & 255), eps); } }
    __syncthreads();
}
struct EpiSwiGLUN {
    typedef f32x4 acc_t; static constexpr bool PERM = true, AFTER_DRAIN = false;
    bf16_t* O; int ldo; const PG8_LAS float* rt; const float* shw; int nphys;
    __device__ __forceinline__ void operator()(const f32x4 (&acc)[2][2][4][2], const Unit& u, int wr, int wc, int fr, int fq) const {
        const int R0 = u.pm * BM, row0 = R0 + wr * 64 + fr, colp = u.pn * BM + wc * 32 + 8 * fq, col0 = u.pn * HALF + wc * 32 + 8 * fq;
        const float* sp = shw + (size_t)(R0 < ML_ ? (R0 >> 11) : 8) * nphys + colp;
        f32x4 s1[2], s3[2];
#pragma unroll
        for (int n = 0; n < 2; ++n) { s1[n] = *(const f32x4*)(sp + 4 * n); s3[n] = *(const f32x4*)(sp + HALF + 4 * n); }
#pragma unroll
        for (int ai = 0; ai < 2; ++ai)
#pragma unroll
            for (int m = 0; m < 4; ++m) { const int row = row0 + ai * HALF + m * 16; const float rs = rt[u.idx * BM + (row - R0)];
                f32x4 v[2];
#pragma unroll
                for (int n = 0; n < 2; ++n) { const f32x4 a = acc[ai][0][m][n] * rs + s1[n], b = acc[ai][1][m][n] * rs + s3[n]; v[n] = (f32x4){a[0] * sigm(a[0]) * b[0], a[1] * sigm(a[1]) * b[1], a[2] * sigm(a[2]) * b[2], a[3] * sigm(a[3]) * b[3]}; }
                *(u32x4*)(O + (size_t)row * ldo + col0) = pack8(v[0], v[1]);
            }
    }
};
struct EpiSwiGLU {
    typedef f32x4 acc_t; static constexpr bool PERM = true, AFTER_DRAIN = false;
    bf16_t* O; int ldo, nN, row_sub; int skip;
    __device__ __forceinline__ void operator()(const f32x4 (&acc)[2][2][4][2], const Unit& u, int wr, int wc, int fr, int fq) const {
        if (skip) {
#pragma unroll
            for (int ai = 0; ai < 2; ++ai)
#pragma unroll
                for (int bj = 0; bj < 2; ++bj)
#pragma unroll
                    for (int m = 0; m < 4; ++m)
#pragma unroll
                        for (int n = 0; n < 2; ++n) asm volatile("" :: "v"(acc[ai][bj][m][n]));
            return; }
        const int row0 = u.pm * BM + wr * 64 + fr - row_sub, col0 = (u.pn % nN) * HALF + wc * 32 + 8 * fq;
#pragma unroll
        for (int ai = 0; ai < 2; ++ai)
#pragma unroll
            for (int m = 0; m < 4; ++m) {
                f32x4 v[2];
#pragma unroll
                for (int n = 0; n < 2; ++n) { const f32x4 a = acc[ai][0][m][n], b = acc[ai][1][m][n]; v[n] = (f32x4){a[0] * sigm(a[0]) * b[0], a[1] * sigm(a[1]) * b[1], a[2] * sigm(a[2]) * b[2], a[3] * sigm(a[3]) * b[3]}; }
                *(u32x4*)(O + (size_t)(row0 + ai * HALF + m * 16) * ldo + col0) = pack8(v[0], v[1]);
            }
    }
};
template <class Sched> __device__ __forceinline__ void rowfac_prepass(const Sched& S, const float* rowfac, PG8_LAS float* rt, int tid) {
    Unit u; int n = 0; while (n < 8 && S.next(n, u)) ++n;
#pragma unroll
    for (int q = 0; q < 4; ++q) { const int r = tid + 512 * q, i = r >> 8; if (i < n) { S.next(i, u); rt[r] = rowfac[u.pm * BM + (r & 255)]; } }
    __syncthreads();
}
struct EpiSwiGLUNq {
    typedef i32x4 acc_t; static constexpr bool PERM = true, AFTER_DRAIN = false;
    bf16_t* O; int ldo; const PG8_LAS float* rt; const float* shw; int nphys; const float* colscale;
    __device__ __forceinline__ void operator()(const i32x4 (&acc)[2][2][4][2], const Unit& u, int wr, int wc, int fr, int fq) const {
        const int R0 = u.pm * BM, row0 = R0 + wr * 64 + fr, colp = u.pn * BM + wc * 32 + 8 * fq, col0 = u.pn * HALF + wc * 32 + 8 * fq;
        const float* sp = shw + (size_t)(R0 < ML_ ? (R0 >> 11) : 8) * nphys + colp; const float* cp = colscale + colp;
        f32x4 s1[2], s3[2], c1[2], c3[2];
#pragma unroll
        for (int n = 0; n < 2; ++n) { s1[n] = *(const f32x4*)(sp + 4 * n); s3[n] = *(const f32x4*)(sp + HALF + 4 * n); c1[n] = *(const f32x4*)(cp + 4 * n); c3[n] = *(const f32x4*)(cp + HALF + 4 * n); }
#pragma unroll
        for (int ai = 0; ai < 2; ++ai)
#pragma unroll
            for (int m = 0; m < 4; ++m) { const int row = row0 + ai * HALF + m * 16; const float rs = rt[u.idx * BM + (row - R0)];
                f32x4 v[2];
#pragma unroll
                for (int n = 0; n < 2; ++n) { const i32x4 ia = acc[ai][0][m][n], ib = acc[ai][1][m][n];
                    const f32x4 a = (f32x4){(float)ia[0], (float)ia[1], (float)ia[2], (float)ia[3]} * (c1[n] * rs) + s1[n], b = (f32x4){(float)ib[0], (float)ib[1], (float)ib[2], (float)ib[3]} * (c3[n] * rs) + s3[n];
                    v[n] = (f32x4){a[0] * sigm(a[0]) * b[0], a[1] * sigm(a[1]) * b[1], a[2] * sigm(a[2]) * b[2], a[3] * sigm(a[3]) * b[3]}; }
                *(u32x4*)(O + (size_t)row * ldo + col0) = pack8(v[0], v[1]);
            }
    }
};
struct EpiSwiGLUq {
    typedef i32x4 acc_t; static constexpr bool PERM = true, AFTER_DRAIN = false;
    bf16_t* O; int ldo, nN; const float* posscale; const float* colscale;
    __device__ __forceinline__ void operator()(const i32x4 (&acc)[2][2][4][2], const Unit& u, int wr, int wc, int fr, int fq) const {
        const int row0 = u.pm * BM + wr * 64 + fr, col0 = (u.pn % nN) * HALF + wc * 32 + 8 * fq; const float* cp = colscale + (size_t)u.pn * BM + wc * 32 + 8 * fq;
        f32x4 c1[2], c3[2];
#pragma unroll
        for (int n = 0; n < 2; ++n) { c1[n] = *(const f32x4*)(cp + 4 * n); c3[n] = *(const f32x4*)(cp + HALF + 4 * n); }
#pragma unroll
        for (int ai = 0; ai < 2; ++ai)
#pragma unroll
            for (int m = 0; m < 4; ++m) { const int row = row0 + ai * HALF + m * 16; const float rs = posscale[row];
                f32x4 v[2];
#pragma unroll
                for (int n = 0; n < 2; ++n) { const i32x4 ia = acc[ai][0][m][n], ib = acc[ai][1][m][n];
                    const f32x4 a = (f32x4){(float)ia[0], (float)ia[1], (float)ia[2], (float)ia[3]} * c1[n] * rs, b = (f32x4){(float)ib[0], (float)ib[1], (float)ib[2], (float)ib[3]} * c3[n] * rs;
                    v[n] = (f32x4){a[0] * sigm(a[0]) * b[0], a[1] * sigm(a[1]) * b[1], a[2] * sigm(a[2]) * b[2], a[3] * sigm(a[3]) * b[3]}; }
                *(u32x4*)(O + (size_t)row * ldo + col0) = pack8(v[0], v[1]);
            }
    }
};
struct EpiGLURes {
    typedef f32x4 acc_t; static constexpr bool PERM = true, AFTER_DRAIN = false;
    bf16_t* X; const float* gate;
    __device__ __forceinline__ void operator()(const f32x4 (&acc)[2][2][4][2], const Unit& u, int wr, int wc, int fr, int fq) const {
        const int R0 = u.pm * BM, row0 = R0 + wr * 64 + fr, col0 = u.pn * HALF + wc * 32 + 8 * fq;
        const float* gp = gate + (size_t)(R0 >> 11) * 6144 + col0;
        f32x4 gv[2];
#pragma unroll
        for (int n = 0; n < 2; ++n) gv[n] = *(const f32x4*)(gp + n * 4);
#pragma unroll
        for (int ai = 0; ai < 2; ++ai)
#pragma unroll
            for (int m = 0; m < 4; ++m) { bf16_t* xp = X + (size_t)(row0 + ai * HALF + m * 16) * DM_ + col0; f32x4 x0, x1, y[2];
                unpack8(*(const u32x4*)xp, x0, x1);
#pragma unroll
                for (int n = 0; n < 2; ++n) { const f32x4 z1 = acc[ai][0][m][n], z2 = acc[ai][1][m][n]; y[n] = (f32x4){z1[0] * sigm(z2[0]), z1[1] * sigm(z2[1]), z1[2] * sigm(z2[2]), z1[3] * sigm(z2[3])}; }
                *(u32x4*)xp = pack8(x0 + gv[0] * y[0], x1 + gv[1] * y[1]); }
    }
};
struct EpiUC {
    typedef f32x4 acc_t; static constexpr bool PERM = true, AFTER_DRAIN = false;
    bf16_t* UC; const PG8_LAS float* rt; const float* shw;
    __device__ __forceinline__ void operator()(const f32x4 (&acc)[2][2][4][2], const Unit& u, int wr, int wc, int fr, int fq) const {
        const int R0 = u.pm * BM, row0 = R0 + wr * 64 + fr, col0 = u.pn * BM + wc * 32 + 8 * fq;
        const float* sp = shw + (size_t)(R0 < ML_ ? (R0 >> 11) : 8) * DM_ + col0;
        f32x4 sv[2][2];
#pragma unroll
        for (int bj = 0; bj < 2; ++bj)
#pragma unroll
            for (int n = 0; n < 2; ++n) sv[bj][n] = *(const f32x4*)(sp + bj * HALF + 4 * n);
#pragma unroll
        for (int ai = 0; ai < 2; ++ai)
#pragma unroll
            for (int m = 0; m < 4; ++m) { const int row = row0 + ai * HALF + m * 16; int bc, j; const float rs = rt[u.idx * BM + (row - R0)];
                if (row < ML_) { bc = (row >> 11) * 64 + ((row & 2047) >> 5); j = row & 31; } else { const int r2 = row - ML_; bc = 512 + (r2 >> 8) * 8 + ((r2 & 255) >> 5); j = r2 & 31; }
#pragma unroll
                for (int bj = 0; bj < 2; ++bj) { const int col = col0 + bj * HALF, g = col >> 4, qi = col & 15;
                    *(u32x4*)(UC + ((size_t)(g * 768 + bc) * 768 + j * 16 + qi)) = pack8(acc[ai][bj][m][0] * rs + sv[bj][0], acc[ai][bj][m][1] * rs + sv[bj][1]); } }
    }
};
struct EpiE {
    typedef f32x4 acc_t; static constexpr bool PERM = false, AFTER_DRAIN = false;
    float* E;
    __device__ __forceinline__ void operator()(const f32x4 (&acc)[2][2][4][2], const Unit& u, int wr, int wc, int fr, int fq) const {
        const int row0 = u.pm * BM + wr * 64 + fr, col0 = wc * 32 + 4 * fq;
#pragma unroll
        for (int ai = 0; ai < 2; ++ai)
#pragma unroll
            for (int m = 0; m < 4; ++m) { float* rp = E + (size_t)(row0 + ai * HALF + m * 16) * 256 + col0;
#pragma unroll
                for (int bj = 0; bj < 2; ++bj)
#pragma unroll
                    for (int n = 0; n < 2; ++n) *(f32x4*)(rp + bj * HALF + n * 16) = acc[ai][bj][m][n]; }
    }
};
struct EpiY {
    typedef f32x4 acc_t; static constexpr bool PERM = true, AFTER_DRAIN = false;
    bf16_t* Y;
    __device__ __forceinline__ void operator()(const f32x4 (&acc)[2][2][4][2], const Unit& u, int wr, int wc, int fr, int fq) const {
        const int g = u.pm / 3, pml = u.pm - 3 * g, pnl = u.pn & 1;
        const int bc0 = pml * BM + wr * 64 + fr, n0 = pnl * BM + wc * 32 + 8 * fq;
#pragma unroll
        for (int ai = 0; ai < 2; ++ai)
#pragma unroll
            for (int m = 0; m < 4; ++m) { const int bc = bc0 + ai * HALF + m * 16, tok0 = (bc >> 6) * 2048 + (bc & 63) * 32;
#pragma unroll
                for (int bj = 0; bj < 2; ++bj) { const int n = n0 + bj * HALF, tin = n >> 4, qo = n & 15; const f32x4 a = acc[ai][bj][m][0], b = acc[ai][bj][m][1];
                    const f32x4 ya = (f32x4){gelu_tanh(a[0]), gelu_tanh(a[1]), gelu_tanh(a[2]), gelu_tanh(a[3])}, yb = (f32x4){gelu_tanh(b[0]), gelu_tanh(b[1]), gelu_tanh(b[2]), gelu_tanh(b[3])};
                    *(u32x4*)(Y + (size_t)(tok0 + tin) * DM_ + g * 16 + qo) = pack8(ya, yb); } }
    }
};
struct EpiMoE2 {
    typedef f32x4 acc_t; static constexpr bool PERM = true, AFTER_DRAIN = false;
    bf16_t* Y2; const float* rowgate; const int* rowinfo;
    __device__ __forceinline__ void operator()(const f32x4 (&acc)[2][2][4][2], const Unit& u, int wr, int wc, int fr, int fq) const {
        const int row0 = u.pm * BM + wr * 64 + fr, col0 = (u.pn & 3) * BM + wc * 32 + 8 * fq;
#pragma unroll
        for (int ai = 0; ai < 2; ++ai)
#pragma unroll
            for (int m = 0; m < 4; ++m) { const int row = row0 + ai * HALF + m * 16; const float gt = rowgate[row]; const int ri = rowinfo[row];
                if (ri >= 0) {
#pragma unroll
                    for (int bj = 0; bj < 2; ++bj) *(u32x4*)(Y2 + (size_t)ri * DM_ + col0 + bj * HALF) = pack8(acc[ai][bj][m][0] * gt, acc[ai][bj][m][1] * gt); } }
    }
};
struct OrderS5E { int G, c;
    __device__ __forceinline__ bool next(int i, Unit& u) const {
        if (G == 256) { if (i > 0) return false; const int x = c & 7, j = c >> 3; if (j >= 24) return false; const int g = 8 * (j / 3) + x; u.pm = 3 * g + (j % 3); u.pn = g; u.k0 = 0; u.idx = i; return true; }
        const int L = i * G + c; if (L >= 192) return false; u.pm = L; u.pn = L / 3; u.k0 = 0; u.idx = i; return true; }
    __device__ __forceinline__ void a_ready(const Unit&) const {}
    __device__ __forceinline__ void done(const Unit&) const {} };
struct OrderS5Y { int G, c;
    __device__ __forceinline__ bool next(int i, Unit& u) const {
        if (G == 256) { if (i > 0) return false; const int x = c & 7, j = c >> 3, g = 8 * (j >> 2) + x; u.pm = 3 * g + ((j >> 1) & 1); u.pn = 2 * g + (j & 1); u.k0 = 0; u.idx = i; return true; }
        const int L = i * G + c; if (L >= 256) return false; const int g = L >> 2; u.pm = 3 * g + ((L >> 1) & 1); u.pn = 2 * g + (L & 1); u.k0 = 0; u.idx = i; return true; }
    __device__ __forceinline__ void a_ready(const Unit&) const {}
    __device__ __forceinline__ void done(const Unit&) const {} };
struct OrderMoE { int G, c, nN, tmax, fix; int toff[9];
    __device__ __forceinline__ bool next(int i, Unit& u) const {
        int pm, pnl; const int nt = toff[8] < tmax ? toff[8] : tmax;
        if (G == 256) {
            const int x = c & 7, j = c >> 3, nCB = nN >> 2, b = i * 8 + x, nRB = (nt + 7) >> 3; if (b >= nRB * nCB) return false;
            const int rb = b / nCB, cbk = b - rb * nCB; pm = 8 * rb + (j & 7); pnl = 4 * cbk + (j >> 3);
        } else { const int L = i * G + c; pm = L / nN; pnl = L - pm * nN; }
        if (pm >= nt) return false;
        int e = 0;
#pragma unroll
        for (int k = 1; k < 8; ++k) e += (pm >= toff[k]) ? 1 : 0;
        u.pm = fix ? 0 : pm; u.pn = fix ? pnl & 3 : e * nN + pnl; u.k0 = 0; u.idx = i; return true; }
    __device__ __forceinline__ void a_ready(const Unit&) const {}
    __device__ __forceinline__ void done(const Unit&) const {} };
struct OrderMoEx { int G, c; int toff[9];
    __device__ __forceinline__ bool next(int i, Unit& u) const {
        const int s = i * G + c, tl = s >> 4, pm = 128 + tl; if (pm >= toff[8]) return false;
        int e = 0;
#pragma unroll
        for (int k = 1; k < 8; ++k) e += (pm >= toff[k]) ? 1 : 0;
        u.pm = pm; u.pn = e * 4 + ((s >> 2) & 3); u.k0 = (s & 3) * 896; u.idx = i; return true; }
    __device__ __forceinline__ void a_ready(const Unit&) const {}
    __device__ __forceinline__ void done(const Unit&) const {} };
struct EpiMoE2x {
    typedef f32x4 acc_t; static constexpr bool PERM = false, AFTER_DRAIN = false;
    float* P; const float* rowgate;
    __device__ __forceinline__ void operator()(const f32x4 (&acc)[2][2][4][2], const Unit& u, int wr, int wc, int fr, int fq) const {
        const int ks = u.k0 / 896, tl = u.pm - 128, r0 = wr * 64 + fr, col0 = (u.pn & 3) * BM + wc * 32 + 4 * fq;
        float* pb = P + ((size_t)(ks * 8 + tl) * 256) * DM_;
        const __amdgpu_buffer_rsrc_t grs = __builtin_amdgcn_make_buffer_rsrc((void*)rowgate, 0, 136 * 256 * 4, 0x00020000);
#pragma unroll
        for (int ai = 0; ai < 2; ++ai)
#pragma unroll
            for (int m = 0; m < 4; ++m) { const int r = r0 + ai * HALF + m * 16; const float gt = __builtin_bit_cast(float, __builtin_amdgcn_raw_buffer_load_b32(grs, (u.pm * BM + r) * 4, 0, 0));
#pragma unroll
                for (int bj = 0; bj < 2; ++bj)
#pragma unroll
                    for (int n = 0; n < 2; ++n) *(f32x4*)(pb + (size_t)r * DM_ + col0 + bj * HALF + n * 16) = acc[ai][bj][m][n] * gt; }
    }
};
template <class Epi, class Sched, bool ALIGN_EPI = false, bool SP2 = false, bool GATHER = false>
__device__ __forceinline__ void gemm_phase(PG8_LAS unsigned char* lds, const Gemm g, const Sched& S, const Epi& E) {
    const int tid = threadIdx.x, wid = __builtin_amdgcn_readfirstlane(tid >> 6), lane = tid & 63, wr = wid >> 2, wc = wid & 3, fr = lane & 15, fq = lane >> 4;
    const int K = g.K, nt = K / BK;
    unsigned voffA[2], voffB[2]; int RA[2]; unsigned CA[2];
    static_assert(!GATHER || SP2, "the gathered A operand is wired into the SP2 loop only");
#pragma unroll
    for (int i = 0; i < 2; ++i) { int R, C; stage_rc(tid * 16 + i * 8192, R, C); const int Rb = Epi::PERM ? ((R & ~31) + perm32(R & 31)) : R;
        voffA[i] = (unsigned)(R * g.lda + C) * 2u; voffB[i] = (unsigned)(Rb * g.ldb + C) * 2u; RA[i] = R; CA[i] = (unsigned)C * 2u; }
    const size_t kstep = (size_t)(BK * 2);
    const size_t hstepA = (size_t)HALF * g.lda * 2, hstepB = (size_t)HALF * g.ldb * 2;
    const size_t tstepA = 2 * hstepA, tstepB = 2 * hstepB;
    const unsigned ldsw = (unsigned)wid * 1024u;
    const int aoff = lds_byte(wr * 64 + fr, fq * 8), boff = lds_byte(wc * 32 + fr, fq * 8);
#define PG8_SA(b, h) (((b) * 2 + (h)) * HTB)
#define PG8_SB(b, h) ((4 + (b) * 2 + (h)) * HTB)
#define PG8_STAGE(bufoff, gbase, voff) do { _Pragma("unroll") for (int _i = 0; _i < 2; ++_i) \
        __builtin_amdgcn_global_load_lds((const unsigned*)((const char*)(gbase) + (voff)[_i]), (PG8_LAS unsigned*)(lds + (bufoff) + ldsw + _i * 8192), 16, 0, 0); } while (0)
#define PG8_LDA(dst, b, h) do { _Pragma("unroll") for (int m = 0; m < 4; ++m) _Pragma("unroll") for (int k = 0; k < 2; ++k) dst[m][k] = *(const PG8_LAS bf16x8*)(lds + PG8_SA(b, h) + aoff + m * 2048 + k * 1024); } while (0)
#define PG8_LDB(dst, b, h) do { _Pragma("unroll") for (int n = 0; n < 2; ++n) _Pragma("unroll") for (int k = 0; k < 2; ++k) dst[n][k] = *(const PG8_LAS bf16x8*)(lds + PG8_SB(b, h) + boff + n * 2048 + k * 1024); } while (0)
#define PG8_MMA(ai, bj, At, Bt) do { __builtin_amdgcn_s_setprio(1); _Pragma("unroll") for (int m = 0; m < 4; ++m) _Pragma("unroll") for (int n = 0; n < 2; ++n) _Pragma("unroll") for (int k = 0; k < 2; ++k) \
        acc[ai][bj][m][n] = mma16(Bt[n][k], At[m][k], acc[ai][bj][m][n]); __builtin_amdgcn_s_setprio(0); } while (0)
#define PG8_WAIT_V(n) asm volatile("s_waitcnt vmcnt(" #n ")" ::: "memory")
#define PG8_WAIT_L(n) asm volatile("s_waitcnt lgkmcnt(" #n ")" ::: "memory")
#define PG8_BAR __builtin_amdgcn_s_barrier()
#define PG8_SCHED __builtin_amdgcn_sched_barrier(0)
#define PG8_GIDX(d0, d1, un) do { _Pragma("unroll") for (int _i = 0; _i < 2; ++_i) { const int* _rp = g.rowsrc + (un).pm * BM + RA[_i]; d0[_i] = (unsigned)_rp[0] * (unsigned)(g.lda * 2) + CA[_i]; d1[_i] = (unsigned)_rp[HALF] * (unsigned)(g.lda * 2) + CA[_i]; } } while (0)
    Unit cur, nxt; int ui = 0;
    if (!S.next(0, cur)) return;
    typedef typename Epi::acc_t acc_t;
    acc_t acc[2][2][4][2];
#pragma unroll
    for (int a = 0; a < 2; ++a)
#pragma unroll
        for (int b = 0; b < 2; ++b)
#pragma unroll
            for (int m = 0; m < 4; ++m)
#pragma unroll
                for (int n = 0; n < 2; ++n) acc[a][b][m][n] = (acc_t){0, 0, 0, 0};
    bf16x8 At[4][2], B0[2][2], B1[2][2];
    const char* cA = (const char*)g.A + (size_t)cur.pm * tstepA + (size_t)cur.k0 * 2; const char* cB = (const char*)g.Bt + (size_t)cur.pn * tstepB + (size_t)cur.k0 * 2;
    S.a_ready(cur);
    unsigned cv0[2] = {0u, 0u}, cv1[2] = {0u, 0u}, nv0[2] = {0u, 0u}, nv1[2] = {0u, 0u}; const char* gA = (const char*)g.A;
    if constexpr (GATHER) { PG8_GIDX(cv0, cv1, cur); nv0[0] = cv0[0]; nv0[1] = cv0[1]; nv1[0] = cv1[0]; nv1[1] = cv1[1]; }
    if constexpr (SP2) {
        PG8_STAGE(PG8_SB(0, 0), cB, voffB); PG8_STAGE(PG8_SB(0, 1), cB + hstepB, voffB);
        if constexpr (GATHER) { PG8_STAGE(PG8_SA(0, 0), gA, cv0); PG8_STAGE(PG8_SA(0, 1), gA, cv1); } else { PG8_STAGE(PG8_SA(0, 0), cA, voffA); PG8_STAGE(PG8_SA(0, 1), cA + hstepA, voffA); }
        if (wr == 1) PG8_BAR;
        PG8_WAIT_V(2); PG8_BAR;
        PG8_STAGE(PG8_SB(1, 0), cB + kstep, voffB); if constexpr (GATHER) PG8_STAGE(PG8_SA(1, 0), gA + kstep, cv0); else PG8_STAGE(PG8_SA(1, 0), cA + kstep, voffA); PG8_STAGE(PG8_SB(1, 1), cB + hstepB + kstep, voffB);
        PG8_WAIT_V(6); PG8_BAR;
    } else {
        PG8_STAGE(PG8_SB(0, 0), cB, voffB); PG8_STAGE(PG8_SA(0, 0), cA, voffA); PG8_STAGE(PG8_SB(0, 1), cB + hstepB, voffB); PG8_STAGE(PG8_SA(0, 1), cA + hstepA, voffA);
        if (wr == 1) PG8_BAR;
        PG8_WAIT_V(4); PG8_BAR;
        PG8_STAGE(PG8_SB(1, 0), cB + kstep, voffB); PG8_STAGE(PG8_SA(1, 0), cA + kstep, voffA); PG8_STAGE(PG8_SB(1, 1), cB + hstepB + kstep, voffB);
        PG8_WAIT_V(6); PG8_BAR;
    }
    for (;;) {
        const bool has_next = S.next(ui + 1, nxt);
        const char* nA = has_next ? (const char*)g.A + (size_t)nxt.pm * tstepA + (size_t)nxt.k0 * 2 : cA; const char* nB = has_next ? (const char*)g.Bt + (size_t)nxt.pn * tstepB + (size_t)nxt.k0 * 2 : cB;
        for (int t = 0; t < nt; t += 2) {
            const bool last = (t == nt - 2);
            const char* a1 = cA + (size_t)(t + 1) * kstep;
            const char* a2 = last ? nA : cA + (size_t)(t + 2) * kstep; const char* b2 = last ? nB : cB + (size_t)(t + 2) * kstep;
            const char* a3 = a2 + kstep; const char* b3 = b2 + kstep;
            if (last && has_next) S.a_ready(nxt);
            if constexpr (GATHER) { if (t == nt - 4 && has_next) PG8_GIDX(nv0, nv1, nxt); }
            const char* g1 = gA + (size_t)(t + 1) * kstep; const char* g2 = last ? gA : gA + (size_t)(t + 2) * kstep; const char* g3 = g2 + kstep;
            unsigned x0[2], x1[2]; x0[0] = last ? nv0[0] : cv0[0]; x0[1] = last ? nv0[1] : cv0[1]; x1[0] = last ? nv1[0] : cv1[0]; x1[1] = last ? nv1[1] : cv1[1];
            if constexpr (SP2) {
            PG8_LDB(B0, 0, 0); PG8_LDB(B1, 0, 1); PG8_SCHED; PG8_LDA(At, 0, 0); if constexpr (GATHER) PG8_STAGE(PG8_SA(1, 1), g1, cv1); else PG8_STAGE(PG8_SA(1, 1), a1 + hstepA, voffA);
            PG8_WAIT_V(8); PG8_WAIT_L(0); PG8_BAR; PG8_MMA(0, 0, At, B0); PG8_MMA(0, 1, At, B1); PG8_BAR; PG8_SCHED;
            PG8_LDA(At, 0, 1); PG8_STAGE(PG8_SB(0, 0), b2, voffB); PG8_STAGE(PG8_SB(0, 1), b2 + hstepB, voffB); if constexpr (GATHER) PG8_STAGE(PG8_SA(0, 0), g2, x0); else PG8_STAGE(PG8_SA(0, 0), a2, voffA);
            PG8_WAIT_V(8); PG8_WAIT_L(0); PG8_BAR; PG8_MMA(1, 0, At, B0); PG8_MMA(1, 1, At, B1); PG8_BAR; PG8_SCHED;
            PG8_LDB(B0, 1, 0); PG8_LDB(B1, 1, 1); PG8_SCHED; PG8_LDA(At, 1, 0); if constexpr (GATHER) PG8_STAGE(PG8_SA(0, 1), g2, x1); else PG8_STAGE(PG8_SA(0, 1), a2 + hstepA, voffA);
            PG8_WAIT_V(8); PG8_WAIT_L(0); PG8_BAR; PG8_MMA(0, 0, At, B0); PG8_MMA(0, 1, At, B1); PG8_BAR; PG8_SCHED;
            PG8_LDA(At, 1, 1); PG8_STAGE(PG8_SB(1, 0), b3, voffB); PG8_STAGE(PG8_SB(1, 1), b3 + hstepB, voffB); if constexpr (GATHER) PG8_STAGE(PG8_SA(1, 0), g3, x0); else PG8_STAGE(PG8_SA(1, 0), a3, voffA);
            PG8_WAIT_V(8); PG8_WAIT_L(0); PG8_BAR; PG8_MMA(1, 0, At, B0); PG8_MMA(1, 1, At, B1); PG8_BAR; PG8_SCHED;
            } else {
            PG8_LDB(B0, 0, 0); PG8_SCHED; PG8_LDA(At, 0, 0); PG8_STAGE(PG8_SA(1, 1), a1 + hstepA, voffA);
            PG8_WAIT_L(8); PG8_BAR; PG8_WAIT_L(0); PG8_MMA(0, 0, At, B0); PG8_BAR; PG8_SCHED;
            PG8_LDB(B1, 0, 1); PG8_STAGE(PG8_SB(0, 0), b2, voffB);
            PG8_BAR; PG8_WAIT_L(0); PG8_MMA(0, 1, At, B1); PG8_BAR;
            PG8_LDA(At, 0, 1); PG8_STAGE(PG8_SA(0, 0), a2, voffA);
            PG8_BAR; PG8_WAIT_L(0); PG8_MMA(1, 0, At, B0); PG8_BAR; PG8_SCHED;
            PG8_STAGE(PG8_SB(0, 1), b2 + hstepB, voffB);
            PG8_WAIT_V(6); PG8_BAR; PG8_MMA(1, 1, At, B1); PG8_BAR;
            PG8_LDB(B0, 1, 0); PG8_SCHED; PG8_LDA(At, 1, 0); PG8_STAGE(PG8_SA(0, 1), a2 + hstepA, voffA);
            PG8_WAIT_L(8); PG8_BAR; PG8_WAIT_L(0); PG8_MMA(0, 0, At, B0); PG8_BAR; PG8_SCHED;
            PG8_LDB(B1, 1, 1); PG8_STAGE(PG8_SB(1, 0), b3, voffB);
            PG8_BAR; PG8_WAIT_L(0); PG8_MMA(0, 1, At, B1); PG8_BAR;
            PG8_LDA(At, 1, 1); PG8_STAGE(PG8_SA(1, 0), a3, voffA);
            PG8_BAR; PG8_WAIT_L(0); PG8_MMA(1, 0, At, B0); PG8_BAR; PG8_SCHED;
            PG8_STAGE(PG8_SB(1, 1), b3 + hstepB, voffB);
            PG8_WAIT_V(6); PG8_BAR; PG8_MMA(1, 1, At, B1); PG8_BAR;
            }
        }
        if constexpr (ALIGN_EPI) { if (wr == 0) PG8_BAR; }
        if constexpr (!Epi::AFTER_DRAIN) { E(acc, cur, wr, wc, fr, fq); S.done(cur); }
        if (!has_next) break;
#pragma unroll
        for (int a = 0; a < 2; ++a)
#pragma unroll
            for (int b = 0; b < 2; ++b)
#pragma unroll
                for (int m = 0; m < 4; ++m)
#pragma unroll
                    for (int n = 0; n < 2; ++n) acc[a][b][m][n] = (acc_t){0, 0, 0, 0};
        cur = nxt; cA = nA; cB = nB; ++ui;
        if constexpr (GATHER) { cv0[0] = nv0[0]; cv0[1] = nv0[1]; cv1[0] = nv1[0]; cv1[1] = nv1[1]; }
        if constexpr (ALIGN_EPI) { if (wr == 1) PG8_BAR; }
    }
    PG8_WAIT_V(0);
    if constexpr (!ALIGN_EPI) { if (wr == 0) PG8_BAR; }
    PG8_BAR;
    if constexpr (Epi::AFTER_DRAIN) { E.fused(acc, cur, wr, wc, fr, fq, lds, wid, lane); S.done(cur); }
#undef PG8_SA
#undef PG8_SB
#undef PG8_STAGE
#undef PG8_LDA
#undef PG8_LDB
#undef PG8_MMA
#undef PG8_WAIT_V
#undef PG8_WAIT_L
#undef PG8_BAR
#undef PG8_SCHED
#undef PG8_GIDX
}
}

constexpr int NB = 8, SEQ = 2048, NCTX = 256, D = 1024;
constexpr int ML = NB * SEQ, MC = NB * NCTX, MT = ML + MC;
constexpr int MIXIN = 2560, FFN = 2816, NE = 8, ED = 3584;
constexpr float EPS = 1e-6f;
constexpr int NWAVES = 8;
constexpr int MOE_TILES = 136;

constexpr size_t MiB = 1u << 20;
constexpr size_t WS_CTL = 0, CTL_ZERO_BYTES = 65536;
constexpr size_t WS_MOD = 65536, WS_MODP = 1 * MiB; constexpr int MOD_N = 2 * 9 * 6144;
constexpr size_t WS_ROWSS = 3 * MiB, WS_SHW13 = 4608 * 1024, WS_SHWS = WS_SHW13 + 9 * 5632 * 4;
constexpr size_t WS_ROWSC = 2800 * 1024, WS_POSSC = 2864 * 1024, WS_COLMAX = 4864 * 1024, WS_COLSC = WS_COLMAX;
constexpr size_t WS_COLSCD = WS_COLMAX + (size_t)NE * 2 * ED * 4, WS_PMAX = 376 * MiB, WS_ROWFAC1 = WS_POSSC;
constexpr size_t WS_TOK = 5 * MiB;
constexpr size_t TOK_E = 0, TOK_W = 128 * 1024, TOK_RANK = 256 * 1024, TOK_POS = 384 * 1024, TOK_WGBASE = 512 * 1024, TOK_ROWGATE = 576 * 1024, TOK_ROWSRC = 720 * 1024, TOK_ROWINFO = 864 * 1024;
constexpr size_t WS_MW13 = 6 * MiB, WS_MW2 = 118 * MiB;
constexpr size_t WS_XL = 174 * MiB, WS_H = 238 * MiB, WS_XC = 274 * MiB;
constexpr size_t WS_WIN = 282 * MiB, WS_WOUT = 287 * MiB, WS_W13 = 289 * MiB, WS_W2 = 300 * MiB, WS_SIN = 306 * MiB, WS_SOUT = 308 * MiB;
constexpr size_t WS_BTOUT = 312 * MiB, WS_WEND = 360 * MiB, WS_R = 376 * MiB, WS_END = 512 * MiB;
constexpr size_t WS_QKVU = WS_R, WS_MIX = WS_R + 72 * MiB, WS_ACT = WS_R;
constexpr size_t WS_UC = WS_R, WS_E = WS_R + 72 * MiB, WS_Y = WS_R + 72 * MiB;
constexpr size_t WS_PX = WS_H;
constexpr size_t WS_ACTM = 274 * MiB;
static_assert(WS_ACTM + (size_t)MOE_TILES * 256 * ED * 2 <= WS_END && WS_XC + (size_t)MC * D * 4 <= WS_WIN && WS_H + (size_t)MT * D * 2 <= WS_XC && WS_MW2 + (size_t)NE * D * ED * 2 <= WS_XL, "d_ws map");
constexpr int CW_TMO = 0, CW_CODE = 1, CW_BAR = 4096, CW_GCNT = 8192;

constexpr int RING_OFF = 0, RING_BYTES = 131072;
constexpr int LDSCTL_OFF = 155648, MISC_OFF = LDSCTL_OFF + 320;
constexpr int LDS_BYTES = 159744;
static_assert(MISC_OFF + 128 <= LDS_BYTES, "LDS map");

#define GAS __attribute__((address_space(1)))
#define LAS __attribute__((address_space(3)))
typedef unsigned short bf16;
typedef unsigned v4u __attribute__((ext_vector_type(4)));
typedef unsigned v2u __attribute__((ext_vector_type(2)));
typedef float f32x4 __attribute__((ext_vector_type(4)));
typedef float f32x2 __attribute__((ext_vector_type(2)));
typedef float f32x16 __attribute__((ext_vector_type(16)));
typedef short bf16x8 __attribute__((ext_vector_type(8)));
typedef GAS unsigned gu32;
#define RLX_AGENT __ATOMIC_RELAXED, __HIP_MEMORY_SCOPE_AGENT
#define LDS_WAIT() asm volatile("s_waitcnt lgkmcnt(0)" ::: "memory")
#define VM_WAIT() asm volatile("s_waitcnt vmcnt(0)" ::: "memory")
__device__ __forceinline__ unsigned f2bf(float f) { unsigned u = __builtin_bit_cast(unsigned, f); return (u + 0x7fffu + ((u >> 16) & 1u)) >> 16; }
__device__ __forceinline__ unsigned pk2(float lo, float hi) { return f2bf(lo) | (f2bf(hi) << 16); }
__device__ __forceinline__ float bf2f(unsigned short h) { return __builtin_bit_cast(float, (unsigned)h << 16); }
__device__ __forceinline__ float bflo(unsigned w) { return __builtin_bit_cast(float, w << 16); }
__device__ __forceinline__ float bfhi(unsigned w) { return __builtin_bit_cast(float, w & 0xffff0000u); }
__device__ __forceinline__ float sigm(float x) { return __builtin_amdgcn_rcpf(1.0f + __expf(-x)); }
__device__ __forceinline__ float wave_sum(float v) {
#pragma unroll
    for (int o = 1; o < 64; o <<= 1) v += __shfl_xor(v, o);
    return v;
}
__device__ __forceinline__ float wave_max(float v) {
#pragma unroll
    for (int o = 1; o < 64; o <<= 1) v = fmaxf(v, __shfl_xor(v, o));
    return v;
}
#define XB_TMO      128
#define XB_XCNT(j)  (256  + 64 * (j))
#define XB_XSUB(j)  (1280 + 64 * (j))
#define XB_XGEN(j)  (2304 + 64 * (j))
#define XB_TOP      3328
#define XB_TOPGEN   3392
#define XCD_BAR_WORDS 3456
#define XB_SPIN_CAP (1u << 18)

__device__ __forceinline__ unsigned xb_ld(unsigned* p)              { return __hip_atomic_load(p, __ATOMIC_RELAXED, __HIP_MEMORY_SCOPE_AGENT); }
__device__ __forceinline__ unsigned xb_add(unsigned* p, unsigned v) { return __hip_atomic_fetch_add(p, v, __ATOMIC_RELAXED, __HIP_MEMORY_SCOPE_AGENT); }
__device__ __forceinline__ unsigned xb_xcc_id() { return (unsigned)__builtin_amdgcn_s_getreg((3 << 11) | 20) & 0xFu; }
#define XB_SPIN(cond, bar) do { unsigned _sp = 0; while (cond) { __builtin_amdgcn_s_sleep(1); \
    if ((++_sp & 255u) == 0u) { if (xb_ld(&(bar)[XB_TMO])) break; if (_sp > XB_SPIN_CAP) { atomicAdd(&(bar)[XB_TMO], 1u); break; } } } } while (0)

struct XcdBarrier {
    unsigned* bar; unsigned x;
    volatile LAS unsigned* st;
};

__device__ __forceinline__ XcdBarrier xcd_barrier_post(unsigned* bar, volatile LAS unsigned* st) {
    XcdBarrier b; b.bar = bar; b.x = xb_xcc_id(); b.st = st;
    if (threadIdx.x == 0) (void)xb_add(&bar[XB_XCNT(b.x)], 1u);
    return b;
}
__device__ __forceinline__ void xcd_barrier_complete(unsigned* bar, unsigned x, unsigned& nloc, unsigned& nx) {
    const unsigned G = gridDim.x * gridDim.y * gridDim.z;
    unsigned sum, cnt, mine, sp = 0u;
    for (;;) {
        sum = 0u; cnt = 0u; mine = 0u;
#pragma unroll
        for (unsigned j = 0; j < 16; ++j) { const unsigned c = xb_ld(&bar[XB_XCNT(j)]); sum += c; cnt += (c > 0u) ? 1u : 0u; mine = (j == x) ? c : mine; }
        if (sum == G) break;
        __builtin_amdgcn_s_sleep(1);
        if ((++sp & 255u) == 0u) { if (xb_ld(&bar[XB_TMO])) break; if (sp > XB_SPIN_CAP) { atomicAdd(&bar[XB_TMO], 1u); break; } }
    }
    nloc = mine > 0u ? mine : 1u; nx = cnt > 0u ? cnt : 1u;
}

__device__ __forceinline__ void xcd_barrier(const XcdBarrier& b) {
    asm volatile("s_waitcnt vmcnt(0)" ::: "memory");
    __syncthreads();
    if (threadIdx.x == 0) {
        unsigned* bar = b.bar;
        __builtin_amdgcn_s_waitcnt(0);
        unsigned nloc = b.st[0], nx = b.st[1];
        if (nloc == 0u) { xcd_barrier_complete(bar, b.x, nloc, nx); b.st[0] = nloc; b.st[1] = nx; }
        const unsigned old = xb_add(&bar[XB_XSUB(b.x)], 1u);
        const unsigned gen = old / nloc;
        if (old + 1u == (gen + 1u) * nloc) {
            __builtin_amdgcn_fence(__ATOMIC_RELEASE, "agent");
            asm volatile("s_waitcnt vmcnt(0)" ::: "memory");
            const unsigned og = xb_add(&bar[XB_TOP], 1u);
            const unsigned tg = og / nx;
            if (og + 1u == (tg + 1u) * nx) xb_add(&bar[XB_TOPGEN], 1u);
            else XB_SPIN(xb_ld(&bar[XB_TOPGEN]) == tg, bar);
            __builtin_amdgcn_fence(__ATOMIC_ACQUIRE, "agent");
            xb_add(&bar[XB_XGEN(b.x)], 1u);
            asm volatile("s_waitcnt vmcnt(0)" ::: "memory");
        } else {
            XB_SPIN(xb_ld(&bar[XB_XGEN(b.x)]) == gen, bar);
            __builtin_amdgcn_fence(__ATOMIC_ACQUIRE, "agent");
            asm volatile("s_waitcnt vmcnt(0)" ::: "memory");
        }
    }
    __syncthreads();
}
enum { I_X = 0, I_C, I_CTX, I_CCTX, I_ADAW, I_ADAB, I_N1G, I_N2G, I_MIXWIN, I_QG, I_KG, I_RPB, I_DWW, I_DWB, I_LNG, I_LNB, I_MIXWOUT, I_FW1, I_FW3, I_FW2,
       I_SWIN, I_ARE, I_AIM, I_LOGDT, I_BRE, I_BIM, I_CRE, I_CIM, I_SD, I_SWOUT, I_ROUTER, I_MW1, I_MW3, I_MW2, N_IN };
struct Args { const float* in[N_IN]; float* out; unsigned char* ws; int ph_lo, ph_hi, sub, pad; };

typedef short s16x4 __attribute__((ext_vector_type(4)));
typedef float f32x2_t __attribute__((ext_vector_type(2)));
typedef __bf16 bf16x2_t __attribute__((ext_vector_type(2)));
__device__ __forceinline__ unsigned cvtpk(float lo, float hi) { const f32x2_t v = {lo, hi}; const bf16x2_t b = __builtin_convertvector(v, bf16x2_t); return __builtin_bit_cast(unsigned, b); }
__device__ __forceinline__ s16x4 vtr(const LAS unsigned char* p) { return __builtin_bit_cast(s16x4, __builtin_amdgcn_ds_read_tr16_b64_v4i16((LAS s16x4*)p)); }
__device__ __forceinline__ void p0_adaln(const Args& A, int unit, LAS unsigned char* lds, int tid, int wave, int lane) {
    const int l = unit / 96, rem = unit % 96, cb = rem >> 2, kq = rem & 3;
    LAS float* sc = (LAS float*)lds;
    LAS float* part = sc + 9 * 256;
    const float* c = A.in[I_C]; const float* cc = A.in[I_CCTX];
    for (int i = tid; i < 9 * 256; i += NWAVES * 64) { const int r = i >> 8, k = 256 * kq + (i & 255); const float v = r < 8 ? c[r * 1024 + k] : cc[k]; sc[i] = v * sigm(v); }
    __syncthreads();
    const float* wp = A.in[I_ADAW] + (size_t)l * 1024 * 6144 + (size_t)(256 * kq + 32 * wave) * 6144 + 256 * cb + 4 * lane;
    float acc[9][4];
#pragma unroll
    for (int r = 0; r < 9; ++r)
#pragma unroll
        for (int j = 0; j < 4; ++j) acc[r][j] = 0.f;
#pragma unroll 8
    for (int it = 0; it < 32; ++it) {
        const f32x4 wv = *(const f32x4*)(wp + (size_t)it * 6144); const int k = 32 * wave + it;
#pragma unroll
        for (int r = 0; r < 9; ++r) { const float s = sc[r * 256 + k];
#pragma unroll
            for (int j = 0; j < 4; ++j) acc[r][j] += s * wv[j]; }
    }
#pragma unroll
    for (int r = 0; r < 9; ++r) *(LAS f32x4*)(part + (wave * 9 + r) * 256 + 4 * lane) = (f32x4){acc[r][0], acc[r][1], acc[r][2], acc[r][3]};
    __syncthreads();
    float* modp = (float*)(A.ws + WS_MODP) + (size_t)kq * MOD_N;
    for (int i = tid; i < 9 * 256; i += NWAVES * 64) { const int r = i >> 8, col = i & 255; float s = 0.f;
#pragma unroll
        for (int w = 0; w < 8; ++w) s += part[(w * 9 + r) * 256 + col];
        if (kq == 0) s += A.in[I_ADAB][l * 6144 + 256 * cb + col];
        modp[((size_t)l * 9 + r) * 6144 + 256 * cb + col] = s; }
    __syncthreads();
}
constexpr int KTS = 260;
__device__ __forceinline__ void p0_s5gen(const Args& A, int g, int part, LAS unsigned char* lds, int tid) {
    LAS f32x2* POW = (LAS f32x2*)lds;
    LAS float* BBr = (LAS float*)(POW + 2 * 64 * 33 + 8);
    LAS float* BBi = BBr + 2 * 64 * 16;
    LAS f32x2* CC = (LAS f32x2*)(BBi + 2 * 64 * 16);
    LAS f32x2* CT = CC + 2 * 16 * 66 + 8;
    LAS float* KT = (LAS float*)(CT + 2 * 64 * 16);
    LAS f32x2* FF = (LAS f32x2*)(KT + 63 * KTS);
#define PWI(d_, p_, m_) (((d_) * 64 + (p_)) * 33 + (m_) + ((p_) >> 5) + (d_) * 4)
#define CCI(d_, q_, p_) (((d_) * 16 + (q_)) * 66 + (p_) + ((p_) >> 5) + (d_) * 4)
    if (tid < 128) { const int d = tid >> 6, p = tid & 63, ix = (d * 64 + g) * 64 + p;
        const float ar = A.in[I_ARE][ix], ai = A.in[I_AIM][ix], dt = __expf(A.in[I_LOGDT][d * 64 + g]);
        const float zr = ar * dt, zi = ai * dt, mag = __expf(zr); const float lr = mag * cosf(zi), li = mag * sinf(zi);
        float pr = 1.f, pi = 0.f;
        for (int m = 0; m <= 32; ++m) { POW[PWI(d, p, m)] = (f32x2){pr, pi}; const float nr = pr * lr - pi * li, ni = pr * li + pi * lr; pr = nr; pi = ni; }
        const float nr = lr - 1.f, ni = li, den = 1.f / (ar * ar + ai * ai);
        FF[d * 64 + p] = (f32x2){(nr * ar + ni * ai) * den, (ni * ar - nr * ai) * den}; }
    __syncthreads();
    for (int i = tid; i < 2048; i += NWAVES * 64) { const int d = i >> 10, p = (i >> 4) & 63, q = i & 15; const int ix = ((d * 64 + g) * 64 + p) * 16 + q;
        const float br = A.in[I_BRE][ix], bi = A.in[I_BIM][ix]; const f32x2 f = FF[d * 64 + p];
        BBr[(d * 64 + p) * 16 + q] = f.x * br - f.y * bi; BBi[(d * 64 + p) * 16 + q] = f.x * bi + f.y * br; }
    for (int i = tid; i < 2048; i += NWAVES * 64) { const int d = i >> 10, q = (i >> 6) & 15, p = i & 63; const int ix = ((d * 64 + g) * 16 + q) * 64 + p;
        const f32x2 cv2 = (f32x2){A.in[I_CRE][ix], A.in[I_CIM][ix]}; CC[CCI(d, q, p)] = cv2; CT[(d * 64 + p) * 16 + q] = cv2; }
    __syncthreads();
    bf16* BtOut = (bf16*)(A.ws + WS_BTOUT) + (size_t)g * 512 * 768;
    bf16* WEnd = (bf16*)(A.ws + WS_WEND) + (size_t)g * 256 * 512;
    if (part == 0) {
#pragma unroll 1
    for (int d = 0; d < 2; ++d) {
        const int dl = tid >> 4, qo = tid & 15; float acc[16];
#pragma unroll
        for (int i = 0; i < 16; ++i) acc[i] = 0.f;
#pragma unroll 2
        for (int p = 0; p < 64; ++p) { const f32x2 c = CT[(d * 64 + p) * 16 + qo], w = POW[PWI(d, p, dl)]; const float tr = c.x * w.x - c.y * w.y, ti = c.x * w.y + c.y * w.x;
            const LAS f32x4* br = (const LAS f32x4*)(BBr + (d * 64 + p) * 16); const LAS f32x4* bi = (const LAS f32x4*)(BBi + (d * 64 + p) * 16);
#pragma unroll
            for (int q4 = 0; q4 < 4; ++q4) { const f32x4 r4 = br[q4], i4 = bi[q4];
#pragma unroll
                for (int j = 0; j < 4; ++j) acc[4 * q4 + j] += tr * r4[j] - ti * i4[j]; } }
        if (d == 0) {
            { const float dsk = (dl == 0) ? A.in[I_SD][g * 16 + qo] : 0.f;
#pragma unroll
              for (int i = 0; i < 16; ++i) acc[i] += (i == qo) ? dsk : 0.f; }
#pragma unroll
            for (int i = 0; i < 4; ++i) *(LAS f32x4*)(KT + (31 + dl) * KTS + qo * 16 + 4 * i) = (f32x4){acc[4 * i], acc[4 * i + 1], acc[4 * i + 2], acc[4 * i + 3]};
        } else {
#pragma unroll
            for (int i = 0; i < 4; ++i) { LAS f32x4* kp = (LAS f32x4*)(KT + (31 - dl) * KTS + qo * 16 + 4 * i); f32x4 v = (f32x4){acc[4 * i], acc[4 * i + 1], acc[4 * i + 2], acc[4 * i + 3]}; if (dl == 0) v = v + *kp; *kp = v; }
        }
        __syncthreads();
    }
    for (int pc = tid; pc < 512 * 64; pc += NWAVES * 64) {
        const int n = pc >> 6, kp = pc & 63, t = n >> 4, qo = n & 15, j = kp >> 1, qi0 = (kp & 1) * 8; const LAS float* s = KT + (t - j + 31) * KTS + qo * 16 + qi0;
        const f32x4 s0 = *(const LAS f32x4*)s, s1 = *(const LAS f32x4*)(s + 4);
        v4u o; o.x = cvtpk(s0.x, s0.y); o.y = cvtpk(s0.z, s0.w); o.z = cvtpk(s1.x, s1.y); o.w = cvtpk(s1.z, s1.w);
        *(v4u*)(BtOut + (size_t)n * 768 + kp * 8) = o; }
    } else {
    for (int pc = tid; pc < 512 * 32; pc += NWAVES * 64) {
        const int n = pc >> 5, kp = pc & 31, t = n >> 4, qo = n & 15, d = kp >> 4, ri = (kp >> 3) & 1, p0 = (kp & 7) * 8, m = d == 0 ? t + 1 : 32 - t; float v[8];
#pragma unroll
        for (int i = 0; i < 8; ++i) { const f32x2 c = CC[CCI(d, qo, p0 + i)], w = POW[PWI(d, p0 + i, m)]; v[i] = ri == 0 ? (c.x * w.x - c.y * w.y) : -(c.x * w.y + c.y * w.x); }
        v4u o; o.x = cvtpk(v[0], v[1]); o.y = cvtpk(v[2], v[3]); o.z = cvtpk(v[4], v[5]); o.w = cvtpk(v[6], v[7]);
        *(v4u*)(BtOut + (size_t)n * 768 + 512 + kp * 8) = o; }
    for (int pc = tid; pc < 256 * 64; pc += NWAVES * 64) {
        const int n = pc >> 6, kp = pc & 63, d = n >> 7, ri = (n >> 6) & 1, p = n & 63, j = kp >> 1, qi0 = (kp & 1) * 8, m = d == 0 ? 31 - j : j; const f32x2 w = POW[PWI(d, p, m)]; float v[8];
#pragma unroll
        for (int i = 0; i < 8; ++i) { const float br = BBr[(d * 64 + p) * 16 + qi0 + i], bi = BBi[(d * 64 + p) * 16 + qi0 + i]; v[i] = ri == 0 ? (w.x * br - w.y * bi) : (w.x * bi + w.y * br); }
        v4u o; o.x = cvtpk(v[0], v[1]); o.y = cvtpk(v[2], v[3]); o.z = cvtpk(v[4], v[5]); o.w = cvtpk(v[6], v[7]);
        *(v4u*)(WEnd + (size_t)n * 512 + kp * 8) = o; }
    }
    __syncthreads();
#undef PWI
#undef CCI
}
__device__ __forceinline__ void cvt_item(const float* W, int K, int N, int ldw, bf16* WT, int mode, int item, LAS float* scr, int lane, unsigned* colmax = nullptr, float* pmax = nullptr) {
    const int nblk = N / 32, kb = item / nblk, nb = item - kb * nblk, k0 = 64 * kb, n0 = 32 * nb;
    int r0 = n0;
    if (mode == 1) r0 = 256 * (n0 >> 7) + (n0 & 127);
    else if (mode == 2) r0 = 256 * (n0 >> 7) + 128 + (n0 & 127);
    else if (mode == 3) { if (n0 < 1536) { const int pn = n0 >> 8, rem = n0 & 255; r0 = 256 * pn + 128 * ((rem & 63) >> 5) + 32 * (rem >> 6); }
                          else if (n0 < 2048) { const int n1 = n0 - 1536; r0 = 256 * (6 + (n1 >> 7)) + (n1 & 127); }
                          else { const int n1 = n0 - 2048; r0 = 256 * (6 + (n1 >> 7)) + 128 + (n1 & 127); } }
    { f32x4 v[8];
#pragma unroll
      for (int i = 0; i < 8; ++i) v[i] = *(const f32x4*)(W + (size_t)(k0 + 8 * i + (lane >> 3)) * ldw + n0 + 4 * (lane & 7));
#pragma unroll
      for (int i = 0; i < 8; ++i) { LAS float* d = scr + (8 * i + (lane >> 3)) * 33 + 4 * (lane & 7); d[0] = v[i].x; d[1] = v[i].y; d[2] = v[i].z; d[3] = v[i].w; } }
    LDS_WAIT(); asm volatile("" ::: "memory");
    const int c = lane & 7;
#pragma unroll
    for (int j = 0; j < 4; ++j) { const int n = (lane >> 3) + 8 * j; const LAS float* s = scr + (8 * c) * 33 + n;
        v4u o; o.x = cvtpk(s[0 * 33], s[1 * 33]); o.y = cvtpk(s[2 * 33], s[3 * 33]); o.z = cvtpk(s[4 * 33], s[5 * 33]); o.w = cvtpk(s[6 * 33], s[7 * 33]);
        *(GAS v4u*)(WT + (size_t)(r0 + n) * K + k0 + 8 * c) = o;
        if (colmax || pmax) { float mx = fmaxf(fmaxf(fmaxf(fabsf(s[0 * 33]), fabsf(s[1 * 33])), fmaxf(fabsf(s[2 * 33]), fabsf(s[3 * 33]))), fmaxf(fmaxf(fabsf(s[4 * 33]), fabsf(s[5 * 33])), fmaxf(fabsf(s[6 * 33]), fabsf(s[7 * 33]))));
            mx = fmaxf(mx, __shfl_xor(mx, 1)); mx = fmaxf(mx, __shfl_xor(mx, 2)); mx = fmaxf(mx, __shfl_xor(mx, 4));
            if (c == 0) { if (colmax) __hip_atomic_fetch_max(colmax + r0 + n, __builtin_bit_cast(unsigned, mx), RLX_AGENT); else pmax[(size_t)(r0 + n) * (K / 64) + kb] = mx; } } }
    LDS_WAIT(); asm volatile("" ::: "memory");
}
constexpr int CV_IM = 16 * 112, CV_IM2 = 56 * 32, CV_NMOE = NE * (2 * CV_IM + CV_IM2);
__device__ __forceinline__ void p0_convert(const Args& A, LAS unsigned char* lds, int gw, int NGW, int wave, int lane) {
    LAS float* scr = (LAS float*)(lds + wave * 16384);
    unsigned char* ws = A.ws;
    constexpr int I0 = 16 * 80, I1 = 16 * 32, I2 = 16 * 88, I3 = 44 * 32, I4 = 16 * 32, I5 = 16 * 32;
    constexpr int NSMALL = I0 + I1 + 2 * I2 + I3 + I4 + 2 * I5;
    for (int it = gw; it < NSMALL; it += NGW) {
        int r = it;
        if (r < I0) { cvt_item(A.in[I_MIXWIN], D, MIXIN, MIXIN, (bf16*)(ws + WS_WIN), 3, r, scr, lane, nullptr, (float*)(ws + WS_PMAX)); continue; } r -= I0;
        if (r < I1) { cvt_item(A.in[I_MIXWOUT], D, D, D, (bf16*)(ws + WS_WOUT), 0, r, scr, lane); continue; } r -= I1;
        if (r < I2) { cvt_item(A.in[I_FW1], D, FFN, FFN, (bf16*)(ws + WS_W13), 1, r, scr, lane, nullptr, (float*)(ws + WS_PMAX) + MIXIN * 16); continue; } r -= I2;
        if (r < I2) { cvt_item(A.in[I_FW3], D, FFN, FFN, (bf16*)(ws + WS_W13), 2, r, scr, lane, nullptr, (float*)(ws + WS_PMAX) + MIXIN * 16); continue; } r -= I2;
        if (r < I3) { cvt_item(A.in[I_FW2], FFN, D, D, (bf16*)(ws + WS_W2), 0, r, scr, lane); continue; } r -= I3;
        if (r < I4) { cvt_item(A.in[I_SWIN], D, D, D, (bf16*)(ws + WS_SIN), 0, r, scr, lane); continue; } r -= I4;
        if (r < I5) { cvt_item(A.in[I_SWOUT], D, D, 2 * D, (bf16*)(ws + WS_SOUT), 1, r, scr, lane); continue; } r -= I5;
        cvt_item(A.in[I_SWOUT] + D, D, D, 2 * D, (bf16*)(ws + WS_SOUT), 2, r, scr, lane);
    }
}
__device__ __forceinline__ void moe_convert(const Args& A, LAS unsigned char* lds, int first, int count, int widx, int nw, int wave, int lane) {
    LAS float* scr = (LAS float*)(lds + wave * 16384);
    unsigned char* ws = A.ws;
    const int last = (first + count) < CV_NMOE ? (first + count) : CV_NMOE;
    for (int it = first + widx; it < last; it += nw) {
        int r = it; const int e = r / (2 * CV_IM + CV_IM2); r -= e * (2 * CV_IM + CV_IM2);
        if (r < CV_IM) { cvt_item(A.in[I_MW1] + (size_t)e * D * ED, D, ED, ED, (bf16*)(ws + WS_MW13) + (size_t)e * 2 * ED * D, 1, r, scr, lane, (unsigned*)(ws + WS_COLMAX) + e * 2 * ED); continue; } r -= CV_IM;
        if (r < CV_IM) { cvt_item(A.in[I_MW3] + (size_t)e * D * ED, D, ED, ED, (bf16*)(ws + WS_MW13) + (size_t)e * 2 * ED * D, 2, r, scr, lane, (unsigned*)(ws + WS_COLMAX) + e * 2 * ED); continue; } r -= CV_IM;
        cvt_item(A.in[I_MW2] + (size_t)e * ED * D, ED, D, D, (bf16*)(ws + WS_MW2) + (size_t)e * D * ED, 0, r, scr, lane);
    }
}
__device__ __forceinline__ void shw_rows(const bf16* WT, int N, const float* sh, float* out, int widx, int nw, LAS unsigned char* lds, int tid, int lane, const float* colscale = nullptr) {
    LAS float* shl = (LAS float*)lds;
    __syncthreads();
    for (int i = tid; i < 9 * 1024; i += NWAVES * 64) shl[i] = sh[(size_t)(i >> 10) * 6144 + (i & 1023)];
    __syncthreads();
    for (int p = widx; p < N; p += nw) {
        float w[16];
        if (colscale) { const v4u q = *(const v4u*)((const unsigned char*)(WT + (size_t)p * D) + 16 * lane); const float cs = colscale[p]; const unsigned qq[4] = {q.x, q.y, q.z, q.w};
#pragma unroll
            for (int i = 0; i < 16; ++i) w[i] = (float)(int)(signed char)((qq[i >> 2] >> (8 * (i & 3))) & 255u) * cs; }
        else { const v4u w0 = *(const v4u*)(WT + (size_t)p * D + 16 * lane), w1 = *(const v4u*)(WT + (size_t)p * D + 16 * lane + 8);
            const float t[16] = {bflo(w0.x), bfhi(w0.x), bflo(w0.y), bfhi(w0.y), bflo(w0.z), bfhi(w0.z), bflo(w0.w), bfhi(w0.w), bflo(w1.x), bfhi(w1.x), bflo(w1.y), bfhi(w1.y), bflo(w1.z), bfhi(w1.z), bflo(w1.w), bfhi(w1.w)};
#pragma unroll
            for (int i = 0; i < 16; ++i) w[i] = t[i]; }
        float s[9];
#pragma unroll
        for (int b = 0; b < 9; ++b) { const LAS f32x4* sp = (const LAS f32x4*)(shl + b * 1024 + 16 * lane); float a = 0.f;
#pragma unroll
            for (int q = 0; q < 4; ++q) { const f32x4 v = sp[q]; a += (v.x * w[4 * q] + v.y * w[4 * q + 1]) + (v.z * w[4 * q + 2] + v.w * w[4 * q + 3]); }
            s[b] = a; }
#pragma unroll
        for (int b = 0; b < 9; ++b) s[b] = wave_sum(s[b]);
        if (lane < 9) { float v = s[0];
#pragma unroll
            for (int b = 1; b < 9; ++b) v = (lane == b) ? s[b] : v;
            out[(size_t)lane * N + p] = v; }
    }
    __syncthreads();
}
__device__ __forceinline__ unsigned q8pack(float a, float b, float c, float d) { const int ia = (int)rintf(a), ib = (int)rintf(b), ic = (int)rintf(c), id = (int)rintf(d);
    return (unsigned)(ia & 255) | ((unsigned)(ib & 255) << 8) | ((unsigned)(ic & 255) << 16) | ((unsigned)(id & 255) << 24); }
__device__ __forceinline__ void quant_rows_inplace(bf16* W, unsigned* colmax, int nrows, int gw, int NGW, int lane) {
    for (int r0 = gw; r0 < nrows; r0 += 2 * NGW) {
        const int r1 = (r0 + NGW < nrows) ? r0 + NGW : r0; const int nr = (r0 + NGW < nrows) ? 2 : 1;
        v4u a[2][2]; float mx[2];
#pragma unroll
        for (int u = 0; u < 2; ++u) { const int r = u ? r1 : r0; const bf16* rp = W + (size_t)r * 1024 + 16 * lane; a[u][0] = *(const v4u*)rp; a[u][1] = *(const v4u*)(rp + 8); mx[u] = __builtin_bit_cast(float, colmax[r]); }
        asm volatile("s_waitcnt vmcnt(0)" ::: "memory");
#pragma unroll
        for (int u = 0; u < 2; ++u) { if (u < nr) { const int r = u ? r1 : r0; const float inv = mx[u] > 0.f ? 127.0f / mx[u] : 0.f; v4u o;
            o.x = q8pack(bflo(a[u][0].x) * inv, bfhi(a[u][0].x) * inv, bflo(a[u][0].y) * inv, bfhi(a[u][0].y) * inv); o.y = q8pack(bflo(a[u][0].z) * inv, bfhi(a[u][0].z) * inv, bflo(a[u][0].w) * inv, bfhi(a[u][0].w) * inv);
            o.z = q8pack(bflo(a[u][1].x) * inv, bfhi(a[u][1].x) * inv, bflo(a[u][1].y) * inv, bfhi(a[u][1].y) * inv); o.w = q8pack(bflo(a[u][1].z) * inv, bfhi(a[u][1].z) * inv, bflo(a[u][1].w) * inv, bfhi(a[u][1].w) * inv);
            *(v4u*)((unsigned char*)(W + (size_t)r * 1024) + 16 * lane) = o;
            if (lane == 0) ((float*)colmax)[r] = mx[u] * (1.0f / 127.0f); } }
    }
}
__device__ __forceinline__ void quant_rows_inplace_p(bf16* W, const float* pmax, float* colscale, int nrows, int gw, int NGW, int lane) {
    for (int r = gw; r < nrows; r += NGW) {
        const bf16* rp = W + (size_t)r * 1024 + 16 * lane; const v4u a0 = *(const v4u*)rp, a1 = *(const v4u*)(rp + 8);
        const float mx = wave_max(pmax[(size_t)r * 16 + (lane & 15)]);
        asm volatile("s_waitcnt vmcnt(0)" ::: "memory");
        const float inv = mx > 0.f ? 127.0f / mx : 0.f; v4u o;
        o.x = q8pack(bflo(a0.x) * inv, bfhi(a0.x) * inv, bflo(a0.y) * inv, bfhi(a0.y) * inv); o.y = q8pack(bflo(a0.z) * inv, bfhi(a0.z) * inv, bflo(a0.w) * inv, bfhi(a0.w) * inv);
        o.z = q8pack(bflo(a1.x) * inv, bfhi(a1.x) * inv, bflo(a1.y) * inv, bfhi(a1.y) * inv); o.w = q8pack(bflo(a1.z) * inv, bfhi(a1.z) * inv, bflo(a1.w) * inv, bfhi(a1.w) * inv);
        *(v4u*)((unsigned char*)(W + (size_t)r * 1024) + 16 * lane) = o;
        if (lane == 0) colscale[r] = mx * (1.0f / 127.0f);
    }
}
__device__ __forceinline__ void quant_act_rows(bf16* Hb, const float* rowss, float* rowfac, int nrows, int gw, int NGW, int lane) {
    for (int r0 = gw; r0 < nrows; r0 += 2 * NGW) {
        const int r1 = (r0 + NGW < nrows) ? r0 + NGW : r0; const int nr = (r0 + NGW < nrows) ? 2 : 1;
        v4u a[2][2]; float ssq[2];
#pragma unroll
        for (int u = 0; u < 2; ++u) { const int r = u ? r1 : r0; const bf16* rp = Hb + (size_t)r * 1024 + 16 * lane; a[u][0] = *(const v4u*)rp; a[u][1] = *(const v4u*)(rp + 8); ssq[u] = rowss[(size_t)r * 16 + (lane & 15)]; }
        asm volatile("s_waitcnt vmcnt(0)" ::: "memory");
#pragma unroll
        for (int u = 0; u < 2; ++u) { if (u < nr) { const int r = u ? r1 : r0;
            const float v[16] = {bflo(a[u][0].x), bfhi(a[u][0].x), bflo(a[u][0].y), bfhi(a[u][0].y), bflo(a[u][0].z), bfhi(a[u][0].z), bflo(a[u][0].w), bfhi(a[u][0].w),
                                 bflo(a[u][1].x), bfhi(a[u][1].x), bflo(a[u][1].y), bfhi(a[u][1].y), bflo(a[u][1].z), bfhi(a[u][1].z), bflo(a[u][1].w), bfhi(a[u][1].w)};
            float am = 0.f;
#pragma unroll
            for (int i = 0; i < 16; ++i) am = fmaxf(am, fabsf(v[i]));
            am = wave_max(am); const float inv = am > 0.f ? 127.0f / am : 0.f;
            float sq = (lane < 16) ? ssq[u] : 0.f; sq = wave_sum(sq);
            v4u o; o.x = q8pack(v[0] * inv, v[1] * inv, v[2] * inv, v[3] * inv); o.y = q8pack(v[4] * inv, v[5] * inv, v[6] * inv, v[7] * inv);
            o.z = q8pack(v[8] * inv, v[9] * inv, v[10] * inv, v[11] * inv); o.w = q8pack(v[12] * inv, v[13] * inv, v[14] * inv, v[15] * inv);
            *(v4u*)((unsigned char*)(Hb + (size_t)r * 1024) + 16 * lane) = o;
            if (lane == 0) rowfac[r] = rsqrtf(sq * (1.0f / 1024.0f) + EPS) * am * (1.0f / 127.0f); } }
    }
}
template <int NPART> __device__ __forceinline__ void norm_row_finish(const f32x4 (&v)[4], int row, const float* gain, const float* mod, int shc, int scc, bf16* H, int lane) {
    const float* mp = mod + (size_t)(row < ML ? (row >> 11) : 8) * 6144; float ss = 0.f;
#pragma unroll
    for (int j = 0; j < 4; ++j) ss += (v[j].x * v[j].x + v[j].y * v[j].y) + (v[j].z * v[j].z + v[j].w * v[j].w);
    const float rstd = rsqrtf(wave_sum(ss) * (1.0f / D) + EPS);
#pragma unroll
    for (int j = 0; j < 4; ++j) { const int k = 4 * lane + 256 * j; const f32x4 gg = *(const f32x4*)(gain + k); f32x4 sc = *(const f32x4*)(mp + scc * 1024 + k), sh = *(const f32x4*)(mp + shc * 1024 + k);
#pragma unroll
        for (int q = 1; q < NPART; ++q) { sc = sc + *(const f32x4*)(mp + (size_t)q * MOD_N + scc * 1024 + k); sh = sh + *(const f32x4*)(mp + (size_t)q * MOD_N + shc * 1024 + k); }
        const f32x4 h = v[j] * rstd * gg * (sc + 1.0f) + sh;
        v2u o; o.x = cvtpk(h.x, h.y); o.y = cvtpk(h.z, h.w); *(v2u*)(H + (size_t)row * D + k) = o; }
}
__device__ __forceinline__ void norm_rows_lds(const float* xL, const float* xC, int nrows, const float* gain, const LAS float* ms, bf16* H, float* rowfac, int gw, int NGW, int lane) {
    for (int row = gw; row < nrows; row += 2 * NGW) {
        const int row1 = row + NGW; const bool two = row1 < nrows; const int r1 = two ? row1 : row;
        const float* xa = row < ML ? xL + (size_t)row * D : xC + (size_t)(row - ML) * D; const float* xb = r1 < ML ? xL + (size_t)r1 * D : xC + (size_t)(r1 - ML) * D;
        f32x4 vv[2][4];
#pragma unroll
        for (int j = 0; j < 4; ++j) { vv[0][j] = *(const f32x4*)(xa + 4 * lane + 256 * j); vv[1][j] = *(const f32x4*)(xb + 4 * lane + 256 * j); }
#pragma unroll
        for (int u = 0; u < 2; ++u) { if (u == 1 && !two) break; const int rw = u ? row1 : row; const LAS float* mp = ms + (rw < ML ? (rw >> 11) : 8) * 2048; float ss = 0.f;
#pragma unroll
            for (int j = 0; j < 4; ++j) ss += (vv[u][j].x * vv[u][j].x + vv[u][j].y * vv[u][j].y) + (vv[u][j].z * vv[u][j].z + vv[u][j].w * vv[u][j].w);
            const float rstd = rsqrtf(wave_sum(ss) * (1.0f / D) + EPS);
            f32x4 hq[4]; float am = 0.f;
#pragma unroll
            for (int j = 0; j < 4; ++j) { const int k = 4 * lane + 256 * j; const f32x4 gg = *(const f32x4*)(gain + k), sh = *(const LAS f32x4*)(mp + k), sc = *(const LAS f32x4*)(mp + 1024 + k);
                const f32x4 h = vv[u][j] * rstd * gg * (sc + 1.0f) + sh; hq[j] = h; am = fmaxf(am, fmaxf(fmaxf(fabsf(h.x), fabsf(h.y)), fmaxf(fabsf(h.z), fabsf(h.w)))); }
            am = wave_max(am); const float inv = am > 0.f ? 127.0f / am : 0.f;
#pragma unroll
            for (int j = 0; j < 4; ++j) *(unsigned*)((unsigned char*)H + (size_t)rw * D + 4 * lane + 256 * j) = q8pack(hq[j].x * inv, hq[j].y * inv, hq[j].z * inv, hq[j].w * inv);
            if (lane == 0) rowfac[rw] = am * (1.0f / 127.0f); }
    }
}
template <int NPART> __device__ __forceinline__ void norm_rows(const float* xL, const float* xC, int nrows, const float* gain, const float* mod, int shc, int scc, bf16* H, int gw, int NGW, int lane) {
    for (int row = gw; row < nrows; row += 2 * NGW) {
        const int row1 = row + NGW; const bool two = row1 < nrows; const int r1 = two ? row1 : row;
        const float* xa = row < ML ? xL + (size_t)row * D : xC + (size_t)(row - ML) * D; const float* xb = r1 < ML ? xL + (size_t)r1 * D : xC + (size_t)(r1 - ML) * D;
        f32x4 va[4], vb[4];
#pragma unroll
        for (int j = 0; j < 4; ++j) { va[j] = *(const f32x4*)(xa + 4 * lane + 256 * j); vb[j] = *(const f32x4*)(xb + 4 * lane + 256 * j); }
        norm_row_finish<NPART>(va, row, gain, mod, shc, scc, H, lane);
        if (two) norm_row_finish<NPART>(vb, row1, gain, mod, shc, scc, H, lane);
    }
}
constexpr int VSTR = 144;
__device__ __forceinline__ void attn_unit(const bf16* QKVU, bf16* MIX, int wu, LAS unsigned char* vl, LAS unsigned char* ql, const LAS float* rpbl, float bnd, int lane) {
    const bool isctx = wu >= 2048;
    int b, h, r = 0, qrow0;
    if (!isctx) { h = wu & 7; r = (wu >> 3) & 31; b = wu >> 8; qrow0 = b * SEQ + r * 64; }
    else { const int w = wu - 2048; h = w & 7; b = w >> 5; qrow0 = ML + b * NCTX + 64 * ((w >> 3) & 3); }
    const int c = lane & 31, hh = lane >> 5;
    const int rs = r < 4 ? 0 : (r > 28 ? 24 : r - 4);
    const int csA = c < 8 ? 0 : c - 8;
    const int csB = c > 24 ? 48 : c + 24;
    const LAS unsigned char* vtb = vl + (4 * hh + ((lane & 15) >> 2)) * VSTR + 32 * ((lane >> 4) & 1) + 8 * (lane & 3);
    LAS unsigned char* qs = ql + c * 128 + 16 * hh;
    { const bf16* qp = QKVU + (size_t)(qrow0 + c) * 2048 + h * 64 + 8 * hh;
#pragma unroll
      for (int s = 0; s < 4; ++s) { *(LAS bf16x8*)(qs + 32 * s) = *(const bf16x8*)(qp + 16 * s); *(LAS bf16x8*)(qs + 4096 + 32 * s) = *(const bf16x8*)(qp + (size_t)32 * 2048 + 16 * s); } }
    f32x16 oA0, oA1, oB0, oB1;
#pragma unroll
    for (int i = 0; i < 16; ++i) { oA0[i] = 0.f; oA1[i] = 0.f; oB0[i] = 0.f; oB1[i] = 0.f; }
    float lsA = 0.f, lsB = 0.f;
    const int nblk = isctx ? 8 : 24;
    const bf16* kbase = QKVU + 512 + h * 64 + 8 * hh + (size_t)c * 2048;
    const bf16* vbase = QKVU + 1024 + h * 64 + 8 * (lane & 7) + (size_t)(lane >> 3) * 2048;
#define ATT_KROW0(kb_) (((!isctx) && (kb_) < 16) ? (b * SEQ + (rs + ((kb_) >> 1)) * 64 + 32 * ((kb_) & 1)) : (ML + b * NCTX + 32 * (isctx ? (kb_) : (kb_) - 16)))
#define ATT_LOADK(KF, kb_) do { const int kq_ = (kb_) < nblk ? (kb_) : nblk - 1; const size_t ro_ = (size_t)ATT_KROW0(kq_) * 2048; \
        _Pragma("unroll") for (int s_ = 0; s_ < 4; ++s_) KF[s_] = *(const bf16x8*)(kbase + ro_ + 16 * s_); } while (0)
#define ATT_LOADV(VF, kb_) do { const int kq_ = (kb_) < nblk ? (kb_) : nblk - 1; const size_t ro_ = (size_t)ATT_KROW0(kq_) * 2048; \
        _Pragma("unroll") for (int i_ = 0; i_ < 4; ++i_) VF[i_] = *(const v4u*)(vbase + ro_ + (size_t)i_ * 8 * 2048); } while (0)
#define ATT_PACK(PF, P) do { _Pragma("unroll") for (int s = 0; s < 2; ++s) { v4u w; w.x = cvtpk(P[8 * s], P[8 * s + 1]); w.y = cvtpk(P[8 * s + 2], P[8 * s + 3]); w.z = cvtpk(P[8 * s + 4], P[8 * s + 5]); w.w = cvtpk(P[8 * s + 6], P[8 * s + 7]); PF[s] = __builtin_bit_cast(bf16x8, w); } } while (0)
#define ATT_BLOCK(KF, VF, kb_) do { const int kb = (kb_); const bool live = kb < nblk; const bool band = (!isctx) && kb < 16; const int kr = rs + (kb >> 1); \
        _Pragma("unroll") for (int i = 0; i < 4; ++i) { const int id = lane + 64 * i; *(LAS v4u*)(vl + (id >> 3) * VSTR + (id & 7) * 16) = VF[i]; } \
        ATT_LOADV(VF, kb + 1);              \
        f32x16 sA, sB; \
        _Pragma("unroll") for (int i = 0; i < 16; ++i) { sA[i] = 0.f; sB[i] = 0.f; } \
        _Pragma("unroll") for (int s = 0; s < 4; ++s) { sA = __builtin_amdgcn_mfma_f32_32x32x16_bf16(KF[s], *(const LAS bf16x8*)(qs + 32 * s), sA, 0, 0, 0); \
                                                        sB = __builtin_amdgcn_mfma_f32_32x32x16_bf16(KF[s], *(const LAS bf16x8*)(qs + 4096 + 32 * s), sB, 0, 0, 0); } \
        ATT_LOADK(KF, kb + 1);              \
        float pA[16], pB[16]; \
        if (band) { const int kc0 = 32 * (kb & 1) + 4 * hh; const LAS float* rb = rpbl + h * 465 + (kr - r + 7) * 31 + (kc0 - c); \
              \
            float bA[16], bB[16]; \
            _Pragma("unroll") for (int i = 0; i < 16; ++i) { bA[i] = rb[15 + (i & 3) + 8 * (i >> 2)]; bB[i] = rb[(i & 3) + 8 * (i >> 2) - 17]; } \
            const int tA = kc0 - csA, tB = kc0 - csB; \
            _Pragma("unroll") for (int i = 0; i < 16; ++i) { const int o = (i & 3) + 8 * (i >> 2); \
                { const bool ok = (unsigned)(tA + o) < 16u; const float e = __builtin_amdgcn_exp2f(sA[i] * 0.18033688f + bA[i]); pA[i] = ok ? e : 0.f; } \
                { const bool ok = (unsigned)(tB + o) < 16u; const float e = __builtin_amdgcn_exp2f(sB[i] * 0.18033688f + bB[i]); pB[i] = ok ? e : 0.f; } } \
        } else { \
            _Pragma("unroll") for (int i = 0; i < 16; ++i) { const float ea = __builtin_amdgcn_exp2f(sA[i] * 0.18033688f - bnd), eb = __builtin_amdgcn_exp2f(sB[i] * 0.18033688f - bnd); pA[i] = live ? ea : 0.f; pB[i] = live ? eb : 0.f; } } \
        _Pragma("unroll") for (int i = 0; i < 16; ++i) { lsA += pA[i]; lsB += pB[i]; } \
        bf16x8 fA[2], fB[2]; ATT_PACK(fA, pA); ATT_PACK(fB, pB); \
        LDS_WAIT(); \
        _Pragma("unroll") for (int dt = 0; dt < 2; ++dt) \
            _Pragma("unroll") for (int s = 0; s < 2; ++s) { \
                const s16x4 lo = vtr(vtb + (16 * s) * VSTR + 64 * dt), hi = vtr(vtb + (16 * s + 8) * VSTR + 64 * dt); \
                const bf16x8 af = (bf16x8){lo[0], lo[1], lo[2], lo[3], hi[0], hi[1], hi[2], hi[3]}; \
                if (dt == 0) { oA0 = __builtin_amdgcn_mfma_f32_32x32x16_bf16(af, fA[s], oA0, 0, 0, 0); oB0 = __builtin_amdgcn_mfma_f32_32x32x16_bf16(af, fB[s], oB0, 0, 0, 0); } \
                else { oA1 = __builtin_amdgcn_mfma_f32_32x32x16_bf16(af, fA[s], oA1, 0, 0, 0); oB1 = __builtin_amdgcn_mfma_f32_32x32x16_bf16(af, fB[s], oB1, 0, 0, 0); } } \
        } while (0)
    bf16x8 kA[4]; v4u vA[4];
    ATT_LOADK(kA, 0); ATT_LOADV(vA, 0);
    for (int kb1 = 0; kb1 < nblk; ++kb1) ATT_BLOCK(kA, vA, kb1);
#undef ATT_KROW0
#undef ATT_LOADK
#undef ATT_LOADV
#undef ATT_PACK
#undef ATT_BLOCK
    lsA += __shfl_xor(lsA, 32); lsB += __shfl_xor(lsB, 32);
    const float iA = 1.0f / lsA, iB = 1.0f / lsB;
    bf16* op = MIX + (size_t)(qrow0 + c) * D + h * 64 + 4 * hh; bf16* oq = op + (size_t)32 * D;
#pragma unroll
    for (int i4 = 0; i4 < 4; ++i4) {
        v2u w0; w0.x = cvtpk(oA0[4 * i4] * iA, oA0[4 * i4 + 1] * iA); w0.y = cvtpk(oA0[4 * i4 + 2] * iA, oA0[4 * i4 + 3] * iA); *(v2u*)(op + 8 * i4) = w0;
        v2u w1; w1.x = cvtpk(oA1[4 * i4] * iA, oA1[4 * i4 + 1] * iA); w1.y = cvtpk(oA1[4 * i4 + 2] * iA, oA1[4 * i4 + 3] * iA); *(v2u*)(op + 32 + 8 * i4) = w1;
        v2u w2; w2.x = cvtpk(oB0[4 * i4] * iB, oB0[4 * i4 + 1] * iB); w2.y = cvtpk(oB0[4 * i4 + 2] * iB, oB0[4 * i4 + 3] * iB); *(v2u*)(oq + 8 * i4) = w2;
        v2u w3; w3.x = cvtpk(oB1[4 * i4] * iB, oB1[4 * i4 + 1] * iB); w3.y = cvtpk(oB1[4 * i4 + 2] * iB, oB1[4 * i4 + 3] * iB); *(v2u*)(oq + 32 + 8 * i4) = w3; }
}
template <int P0, int NP> __device__ __forceinline__ void conv_chunk(float (&acc)[32], const float (&w)[31], const __amdgpu_buffer_rsrc_t rsrc, int voff, int t0, int len) {
    float v[NP];
#pragma unroll
    for (int i = 0; i < NP; ++i) { const int t = t0 - 15 + P0 + i, tc = t < 0 ? 0 : (t >= len ? len - 1 : t); const int so = __builtin_amdgcn_readfirstlane(tc * 4096);
        const float x = bf2f(__builtin_amdgcn_raw_buffer_load_b16(rsrc, voff, so, 0)); v[i] = (t == tc) ? x : 0.f; }
#pragma unroll
    for (int i = 0; i < NP; ++i)
#pragma unroll
        for (int tt = 0; tt < 32; ++tt) { if (P0 + i - tt >= 0 && P0 + i - tt <= 30) acc[tt] += v[i] * w[(P0 + i - tt >= 0 && P0 + i - tt <= 30) ? P0 + i - tt : 0]; }
}
__device__ __forceinline__ void conv_item(const Args& A, const bf16* QKVU, bf16* MIX, int item, LAS float* cv, int tid, int wave, int lane) {
    __syncthreads();
    int rowbase, len, t0;
    if (item < 512) { rowbase = (item >> 6) * SEQ; len = SEQ; t0 = 32 * (item & 63); } else { const int i2 = item - 512; rowbase = ML + (i2 >> 3) * NCTX; len = NCTX; t0 = 32 * (i2 & 7); }
    const int ch = tid;
    float w[31], acc[32];
    { const __amdgpu_buffer_rsrc_t wrs = __builtin_amdgcn_make_buffer_rsrc((void*)A.in[I_DWW], 0, 31 * 512 * 4, 0x00020000);
#pragma unroll
      for (int k = 0; k < 31; ++k) w[k] = __builtin_bit_cast(float, __builtin_amdgcn_raw_buffer_load_b32(wrs, 4 * ch, k * 2048, 0)); }
    const float bias = A.in[I_DWB][ch];
#pragma unroll
    for (int t = 0; t < 32; ++t) acc[t] = bias;
    const __amdgpu_buffer_rsrc_t rsrc = __builtin_amdgcn_make_buffer_rsrc((void*)(QKVU + (size_t)rowbase * 2048 + 1536), 0, len * 4096, 0x00020000);
    conv_chunk<0, 16>(acc, w, rsrc, 2 * ch, t0, len); conv_chunk<16, 16>(acc, w, rsrc, 2 * ch, t0, len); conv_chunk<32, 16>(acc, w, rsrc, 2 * ch, t0, len); conv_chunk<48, 14>(acc, w, rsrc, 2 * ch, t0, len);
#pragma unroll
    for (int t = 0; t < 32; ++t) cv[t * 512 + ch] = acc[t];
    __syncthreads();
    const f32x4 g0 = *(const f32x4*)(A.in[I_LNG] + 8 * lane), g1 = *(const f32x4*)(A.in[I_LNG] + 8 * lane + 4), b0 = *(const f32x4*)(A.in[I_LNB] + 8 * lane), b1 = *(const f32x4*)(A.in[I_LNB] + 8 * lane + 4);
#pragma unroll
    for (int q = 0; q < 4; ++q) { const int tt = 4 * wave + q;
        f32x4 x0 = *(const LAS f32x4*)(cv + tt * 512 + 8 * lane), x1 = *(const LAS f32x4*)(cv + tt * 512 + 8 * lane + 4);
        const float mean = wave_sum((x0.x + x0.y) + (x0.z + x0.w) + (x1.x + x1.y) + (x1.z + x1.w)) * (1.0f / 512.0f);
        x0 = x0 - mean; x1 = x1 - mean;
        const float var = wave_sum((x0.x * x0.x + x0.y * x0.y) + (x0.z * x0.z + x0.w * x0.w) + (x1.x * x1.x + x1.y * x1.y) + (x1.z * x1.z + x1.w * x1.w)) * (1.0f / 512.0f);
        const float rstd = rsqrtf(var + EPS);
        f32x4 y0 = x0 * rstd * g0 + b0, y1 = x1 * rstd * g1 + b1;
        y0 = (f32x4){y0.x * sigm(y0.x), y0.y * sigm(y0.y), y0.z * sigm(y0.z), y0.w * sigm(y0.w)}; y1 = (f32x4){y1.x * sigm(y1.x), y1.y * sigm(y1.y), y1.z * sigm(y1.z), y1.w * sigm(y1.w)};
        v4u o; o.x = cvtpk(y0.x, y0.y); o.y = cvtpk(y0.z, y0.w); o.z = cvtpk(y1.x, y1.y); o.w = cvtpk(y1.z, y1.w);
        *(v4u*)(MIX + (size_t)(rowbase + t0 + tt) * D + 512 + 8 * lane) = o; }
    __syncthreads();
}
__device__ __forceinline__ void s5_scan(const Args& A, int gt) {
    if (gt >= NB * 64 * 2 * 64) return;
    const int p = gt & 63, d = (gt >> 6) & 1, g = (gt >> 7) & 63, b = gt >> 13;
    const int ix = (d * 64 + g) * 64 + p;
    const float ar = A.in[I_ARE][ix], ai = A.in[I_AIM][ix], dt = __expf(A.in[I_LOGDT][d * 64 + g]);
    const float zr = ar * dt, zi = ai * dt, mag = __expf(zr); float lr = mag * cosf(zi), li = mag * sinf(zi);
#pragma unroll
    for (int k = 0; k < 5; ++k) { const float nr = lr * lr - li * li, ni = 2.f * lr * li; lr = nr; li = ni; }
    const float* E = (const float*)(A.ws + WS_E) + (size_t)g * 768 * 256 + d * 128 + p;
    bf16* UC = (bf16*)(A.ws + WS_UC) + (size_t)g * 768 * 768 + 512 + d * 128 + p;
    float sr = 0.f, si = 0.f;
    for (int s0 = 0; s0 < 72; s0 += 24) {
        float er[24], ei[24]; int bcs[24];
#pragma unroll
        for (int k = 0; k < 24; ++k) { const int step = s0 + k; int bc;
            if (step < 8) bc = 512 + 8 * b + (d == 0 ? step : 7 - step); else bc = 64 * b + (d == 0 ? step - 8 : 71 - step);
            bcs[k] = bc; er[k] = E[(size_t)bc * 256]; ei[k] = E[(size_t)bc * 256 + 64]; }
#pragma unroll
        for (int k = 0; k < 24; ++k) {
            if (s0 + k >= 8) { UC[(size_t)bcs[k] * 768] = (bf16)f2bf(sr); UC[(size_t)bcs[k] * 768 + 64] = (bf16)f2bf(si); }
            const float nr = lr * sr - li * si + er[k], ni = lr * si + li * sr + ei[k]; sr = nr; si = ni; }
    }
}
__device__ __forceinline__ void moe_route(const Args& A, const bf16* X, const float* mod, bf16* H, int chunk, LAS unsigned* lcnt, int tid, int wave, int lane) {
    unsigned char* tok = A.ws + WS_TOK;
    int* tokE = (int*)(tok + TOK_E); float* tokW = (float*)(tok + TOK_W); int* tokRank = (int*)(tok + TOK_RANK); int* wgbase = (int*)(tok + TOK_WGBASE);
    if (tid < 8) lcnt[tid] = 0u;
    __syncthreads();
    const float* gain = A.in[I_N2G] + D; const float* wr = A.in[I_ROUTER];
    for (int q2 = 0; q2 < 8; q2 += 2) {
        f32x4 vv[2][4];
#pragma unroll
        for (int u = 0; u < 2; ++u) { const bf16* xr = X + (size_t)(chunk * 64 + wave * 8 + q2 + u) * D;
#pragma unroll
            for (int j = 0; j < 4; ++j) { const v2u xw = *(const v2u*)(xr + 4 * lane + 256 * j); vv[u][j] = (f32x4){bflo(xw.x), bfhi(xw.x), bflo(xw.y), bfhi(xw.y)}; } }
#pragma unroll
        for (int u = 0; u < 2; ++u) {
        const int row = chunk * 64 + wave * 8 + q2 + u; const float* mp = mod + (size_t)(row >> 11) * 6144;
        float ss = 0.f;
#pragma unroll
        for (int j = 0; j < 4; ++j) ss += (vv[u][j].x * vv[u][j].x + vv[u][j].y * vv[u][j].y) + (vv[u][j].z * vv[u][j].z + vv[u][j].w * vv[u][j].w);
        const float rstd = rsqrtf(wave_sum(ss) * (1.0f / D) + EPS);
        float lg[8]; f32x4 hq[4];
#pragma unroll
        for (int e = 0; e < 8; ++e) lg[e] = 0.f;
#pragma unroll
        for (int j = 0; j < 4; ++j) { const int k = 4 * lane + 256 * j; const f32x4 gg = *(const f32x4*)(gain + k), sc = *(const f32x4*)(mp + 4 * 1024 + k), sh = *(const f32x4*)(mp + 3 * 1024 + k);
            const f32x4 h = vv[u][j] * rstd * gg * (sc + 1.0f) + sh; hq[j] = h;
#pragma unroll
            for (int i = 0; i < 4; ++i) { const f32x4 w0 = *(const f32x4*)(wr + (size_t)(k + i) * 8), w1 = *(const f32x4*)(wr + (size_t)(k + i) * 8 + 4); const float hv = h[i];
                lg[0] += hv * w0.x; lg[1] += hv * w0.y; lg[2] += hv * w0.z; lg[3] += hv * w0.w; lg[4] += hv * w1.x; lg[5] += hv * w1.y; lg[6] += hv * w1.z; lg[7] += hv * w1.w; } }
        {
            float am = 0.f;
#pragma unroll
            for (int j = 0; j < 4; ++j) am = fmaxf(am, fmaxf(fmaxf(fabsf(hq[j].x), fabsf(hq[j].y)), fmaxf(fabsf(hq[j].z), fabsf(hq[j].w))));
            am = wave_max(am); const float inv = am > 0.f ? 127.0f / am : 0.f;
#pragma unroll
            for (int j = 0; j < 4; ++j) *(unsigned*)((unsigned char*)H + (size_t)row * D + 4 * lane + 256 * j) = q8pack(hq[j].x * inv, hq[j].y * inv, hq[j].z * inv, hq[j].w * inv);
            if (lane == 0) ((float*)(A.ws + WS_ROWSC))[row] = am * (1.0f / 127.0f); }
#pragma unroll
        for (int e = 0; e < 8; ++e) lg[e] = wave_sum(lg[e]);
        int e0 = 0; float v0 = lg[0];
#pragma unroll
        for (int e = 1; e < 8; ++e) if (lg[e] > v0) { v0 = lg[e]; e0 = e; }
        int e1 = -1; float v1 = -3.0e38f;
#pragma unroll
        for (int e = 0; e < 8; ++e) if (e != e0 && lg[e] > v1) { v1 = lg[e]; e1 = e; }
        const float ex = __expf(v1 - v0), w0 = 1.0f / (1.0f + ex), w1 = ex * w0;
        if (lane == 0) { const unsigned r0 = __hip_atomic_fetch_add(&lcnt[e0], 1u, __ATOMIC_RELAXED, __HIP_MEMORY_SCOPE_WORKGROUP), r1 = __hip_atomic_fetch_add(&lcnt[e1], 1u, __ATOMIC_RELAXED, __HIP_MEMORY_SCOPE_WORKGROUP);
            tokE[2 * row] = e0; tokE[2 * row + 1] = e1; tokW[2 * row] = w0; tokW[2 * row + 1] = w1; tokRank[2 * row] = (int)r0; tokRank[2 * row + 1] = (int)r1; }
        }
    }
    __syncthreads();
    if (tid < 8) { const unsigned n = lcnt[tid]; const unsigned base = __hip_atomic_fetch_add((unsigned*)(A.ws + WS_CTL) + CW_GCNT + 64 * tid, n, RLX_AGENT); wgbase[chunk * 8 + tid] = (int)base; }
    __syncthreads();
}
constexpr int NPHASE = 18;
__device__ __forceinline__ void moe_offsets(const unsigned char* ws, int (&toff)[9]) {
    const unsigned* gc = (const unsigned*)(ws + WS_CTL) + CW_GCNT; int acc = 0;
#pragma unroll
    for (int e = 0; e < 8; ++e) { toff[e] = acc; const unsigned n = __hip_atomic_load(gc + 64 * e, RLX_AGENT); acc += (int)((n + 255u) >> 8); }
    toff[8] = acc;
}
#define TAIL_CONVERT(nunits, first, count) do { const int rounds_ = ((nunits) + G - 1) / G, nlast_ = (nunits) - (rounds_ - 1) * G; \
        if (bx >= nlast_) moe_convert(args, lds, (first), (count), (bx - nlast_) * NWAVES + wave, (G - nlast_) * NWAVES, wave, lane); } while (0)
constexpr int CVQ4 = 4000, CVQ6 = 5500, CVQ7 = 20000, CVQ9 = 8500, CVQS1 = 2000, CVQS2 = CV_NMOE - CVQ4 - CVQ6 - CVQ7 - CVQ9 - CVQS1;
__global__ void __launch_bounds__(NWAVES * 64, 2) fwd_kernel(Args args) {
    extern __shared__ __attribute__((aligned(16))) unsigned char lds_raw[];
    LAS unsigned char* lds = (LAS unsigned char*)lds_raw;
    volatile LAS unsigned* MISC = (volatile LAS unsigned*)(lds + MISC_OFF);
    const int tid = threadIdx.x, lane = tid & 63, wave = __builtin_amdgcn_readfirstlane(tid >> 6);
    const int G = gridDim.x, bx = blockIdx.x;
    const int gw = bx * NWAVES + wave, NGW = G * NWAVES;
    unsigned char* ws = args.ws;
    for (int u = tid; u < (LDS_BYTES - LDSCTL_OFF) / 4; u += NWAVES * 64) ((LAS unsigned*)(lds + LDSCTL_OFF))[u] = 0u;
    __syncthreads();
    const int lo = args.ph_lo, hi = args.ph_hi;
    XcdBarrier bar; bar.bar = (unsigned*)(ws + WS_CTL) + CW_BAR; bar.x = 0; bar.st = nullptr;
    if (hi - lo > 1) bar = xcd_barrier_post((unsigned*)(ws + WS_CTL) + CW_BAR, MISC + 8);
#define IN(k) (lo <= (k) && (k) < hi)
#define SEAM(k) do { if (IN((k) + 1)) xcd_barrier(bar); } while (0)
    float* mod = (float*)(ws + WS_MOD);
    bf16* XL = (bf16*)(ws + WS_XL); bf16* XC = (bf16*)(ws + WS_XC);
    bf16* H = (bf16*)(ws + WS_H);

    if (IN(0)) {
        for (int i = bx * (NWAVES * 64) + tid; i < NE * 2 * ED; i += G * NWAVES * 64) ((unsigned*)(ws + WS_COLMAX))[i] = 0u;
        for (int u = bx; u < 192; u += G) { if (args.sub & 1) p0_adaln(args, u, lds, tid, wave, lane); }
        if (args.sub & 4) p0_convert(args, lds, gw, NGW, wave, lane);
        SEAM(0);
    }
    if (IN(1)) {
        { const float* modp = (const float*)(ws + WS_MODP);
          for (int i = bx * (NWAVES * 64) + tid; i < MOD_N; i += G * NWAVES * 64) mod[i] = ((modp[i] + modp[MOD_N + i]) + modp[2 * MOD_N + i]) + modp[3 * MOD_N + i]; }
        { const float* modp = (const float*)(ws + WS_MODP); LAS float* ms = (LAS float*)lds;
          for (int i = tid; i < 9 * 2048; i += NWAVES * 64) { const int r = i >> 11, o = r * 6144 + (i & 2047); ms[i] = ((modp[o] + modp[MOD_N + o]) + modp[2 * MOD_N + o]) + modp[3 * MOD_N + o]; }
          __syncthreads(); norm_rows_lds(args.in[I_X], args.in[I_CTX], MT, args.in[I_N1G], ms, H, (float*)(ws + WS_ROWFAC1), gw, NGW, lane); }
        quant_rows_inplace_p((bf16*)(ws + WS_WIN), (const float*)(ws + WS_PMAX), (float*)(ws + WS_COLSCD), MIXIN, gw, NGW, lane);
        quant_rows_inplace_p((bf16*)(ws + WS_W13), (const float*)(ws + WS_PMAX) + MIXIN * 16, (float*)(ws + WS_COLSCD) + MIXIN, 2 * FFN, gw, NGW, lane);
        SEAM(1); }
    if (IN(2)) {
        pg8::Gemm g{H, (const bf16*)(ws + WS_WIN), MT, MIXIN, D / 2, D / 2, D}; pg8::StaticOrder S; S.init(MT, MIXIN, G, bx);
        pg8::EpiQKVUq E{(bf16*)(ws + WS_QKVU), args.in[I_QG], args.in[I_KG], EPS, (const float*)(ws + WS_ROWFAC1), (const float*)(ws + WS_COLSCD)};
        pg8::gemm_phase<pg8::EpiQKVUq, pg8::StaticOrder, true, true>(lds + RING_OFF, g, S, E);
        SEAM(2);
    }
    if (IN(3)) {
        const bf16* QKVU = (const bf16*)(ws + WS_QKVU); bf16* MIX = (bf16*)(ws + WS_MIX);
        LAS float* rpbl = (LAS float*)(lds + 40960); LAS float* cv = (LAS float*)(lds + 57344);
        float mq = 0.f, mk = 0.f, mb = 0.f;
        mq = fabsf(args.in[I_QG][lane]); mk = fabsf(args.in[I_KG][lane]);
        for (int i = lane; i < 8 * 465; i += 64) mb = fmaxf(mb, fabsf(args.in[I_RPB][i]));
        const float bnd = (8.2f * wave_max(mq) * wave_max(mk) + wave_max(mb)) * 1.44269504f;
        for (int i = tid; i < 8 * 465; i += NWAVES * 64) rpbl[i] = args.in[I_RPB][i] * 1.44269504f - bnd;
        __syncthreads();
        const int nbw = (G % 8 == 0) ? G / 8 : G, xb0 = (G % 8 == 0) ? (bx & 7) : 0, xbn = (G % 8 == 0) ? xb0 + 1 : 8, j0 = (G % 8 == 0) ? (bx >> 3) : bx;
        for (int x = xb0; x < xbn; ++x)
            for (int k = j0; k < 128; k += nbw) {
                if (k < 36) {
                    if (!(args.sub & (k < 32 ? 8 : 16))) continue;
                    const int wu = k < 32 ? (x * 32 + k) * 8 + wave : 2048 + (x * 4 + (k - 32)) * 8 + wave;
                    attn_unit(QKVU, MIX, wu, lds + wave * 5120, lds + 57344 + wave * 8192, rpbl, bnd, lane);
                } else {
                    if (!(args.sub & 32)) continue;
                    const int ci = k < 64 ? k - 36 : (k < 96 ? k - 36 : (k >= 100 && k < 112 ? k - 40 : -1)); if (ci < 0) continue;
                    conv_item(args, QKVU, MIX, ci < 64 ? x * 64 + ci : 512 + x * 8 + (ci - 64), cv, tid, wave, lane);
                }
            }
        SEAM(3);
    }
    if (IN(4)) {
        pg8::Gemm g{(const bf16*)(ws + WS_MIX), (const bf16*)(ws + WS_WOUT), MT, D, D, D, D}; pg8::StaticOrder S; S.init(MT, D, G, bx);
        pg8::EpiResidN<true> E{args.in[I_X], args.in[I_CTX], XL, XC, mod + 2 * 1024, H, (float*)(ws + WS_ROWSS), args.in[I_N2G], mod + 4 * 1024};
        pg8::gemm_phase<pg8::EpiResidN<true>, pg8::StaticOrder, true, true>(lds + RING_OFF, g, S, E);
        {
            const int nun = (MT / 256) * (D / 256), rounds = (nun + G - 1) / G, nlast = nun - (rounds - 1) * G, nidle = G - nlast, ii = bx - nlast;
            if (ii >= 0) {
                if (args.sub & 2) for (int u = ii; u < 128; u += nidle) p0_s5gen(args, u >> 1, u & 1, lds, tid);
                const bool cvw = (nidle > 128) ? (ii >= 128) : true;
                const int cw = (nidle > 128) ? (ii - 128) * NWAVES + wave : ii * NWAVES + wave, cn = (nidle > 128) ? (nidle - 128) * NWAVES : nidle * NWAVES;
                if (cvw) {
                    shw_rows((const bf16*)(ws + WS_W13), 2 * FFN, mod + 3 * 1024, (float*)(ws + WS_SHW13), cw, cn, lds, tid, lane, (const float*)(ws + WS_COLSCD) + MIXIN);
                    shw_rows((const bf16*)(ws + WS_SIN), D, mod + 9 * 6144, (float*)(ws + WS_SHWS), cw, cn, lds, tid, lane);
                    moe_convert(args, lds, 0, CVQ4, cw, cn, wave, lane); }
            }
            if (nidle <= 0) { for (int u = bx; u < 128; u += G) p0_s5gen(args, u >> 1, u & 1, lds, tid);
                shw_rows((const bf16*)(ws + WS_W13), 2 * FFN, mod + 3 * 1024, (float*)(ws + WS_SHW13), gw, NGW, lds, tid, lane, (const float*)(ws + WS_COLSCD) + MIXIN); shw_rows((const bf16*)(ws + WS_SIN), D, mod + 9 * 6144, (float*)(ws + WS_SHWS), gw, NGW, lds, tid, lane);
                moe_convert(args, lds, 0, CVQ4, gw, NGW, wave, lane); }
        }
        SEAM(4);
    }
    if (IN(5)) { quant_act_rows(H, (const float*)(ws + WS_ROWSS), (float*)(ws + WS_ROWFAC1), MT, gw, NGW, lane); SEAM(5); }
    if (IN(6)) {
        pg8::Gemm g{H, (const bf16*)(ws + WS_W13), MT, 2 * FFN, D / 2, D, D}; pg8::StaticOrder S; S.init(MT, 2 * FFN, G, bx);
        LAS float* rt = (LAS float*)(lds + RING_BYTES); pg8::rowfac_prepass(S, (const float*)(ws + WS_ROWFAC1), rt, tid);
        pg8::EpiSwiGLUNq E{(bf16*)(ws + WS_ACT), FFN, rt, (const float*)(ws + WS_SHW13), 2 * FFN, (const float*)(ws + WS_COLSCD) + MIXIN};
        pg8::gemm_phase<pg8::EpiSwiGLUNq, pg8::StaticOrder, true, true>(lds + RING_OFF, g, S, E);
        TAIL_CONVERT((MT / 256) * (2 * FFN / 256), CVQ4, CVQ6);
        SEAM(6);
    }
    if (IN(7)) {
        pg8::Gemm g{(const bf16*)(ws + WS_ACT), (const bf16*)(ws + WS_W2), MT, D, FFN, FFN, FFN}; pg8::StaticOrder S; S.init(MT, D, G, bx);
        pg8::EpiResidN<false> E{XL, XC, XL, XC, mod + 5 * 1024, H, (float*)(ws + WS_ROWSS), args.in[I_N1G] + D, mod + 9 * 6144 + 1 * 1024};
        pg8::gemm_phase<pg8::EpiResidN<false>, pg8::StaticOrder, true, true>(lds + RING_OFF, g, S, E);
        TAIL_CONVERT((MT / 256) * (D / 256), CVQ4 + CVQ6, CVQ7);
        SEAM(7);
    }
    float* mod1 = mod + 9 * 6144;
    if (IN(8)) {
        pg8::Gemm g{H, (const bf16*)(ws + WS_SIN), MT, D, D, D, D}; pg8::StaticOrder S; S.init(MT, D, G, bx);
        LAS float* rt = (LAS float*)(lds + RING_BYTES); pg8::rstd_prepass(S, (const float*)(ws + WS_ROWSS), rt, EPS, tid);
        pg8::EpiUC E{(bf16*)(ws + WS_UC), rt, (const float*)(ws + WS_SHWS)};
        pg8::gemm_phase<pg8::EpiUC, pg8::StaticOrder, true, true>(lds + RING_OFF, g, S, E);
        TAIL_CONVERT((MT / 256) * (D / 256), CVQ4 + CVQ6 + CVQ7, CVQ9);
        SEAM(8);
    }
    if (IN(9)) {
        pg8::Gemm g{(const bf16*)(ws + WS_UC), (const bf16*)(ws + WS_WEND), 64 * 768, 64 * 256, 512, 768, 512}; pg8::OrderS5E S{G, bx};
        pg8::EpiE E{(float*)(ws + WS_E)};
        pg8::gemm_phase<pg8::EpiE, pg8::OrderS5E, true, true>(lds + RING_OFF, g, S, E);
        if (G == 256) { if ((bx >> 3) >= 24) moe_convert(args, lds, CVQ4 + CVQ6 + CVQ7 + CVQ9, CVQS1, (((bx >> 3) - 24) * 8 + (bx & 7)) * NWAVES + wave, 64 * NWAVES, wave, lane); }
        else moe_convert(args, lds, CVQ4 + CVQ6 + CVQ7 + CVQ9, CVQS1, gw, NGW, wave, lane);
        SEAM(9);
    }
    if (IN(10)) { s5_scan(args, bx * (NWAVES * 64) + tid);
        if (G > 128) { if (bx >= 128) moe_convert(args, lds, CVQ4 + CVQ6 + CVQ7 + CVQ9 + CVQS1, CVQS2, (bx - 128) * NWAVES + wave, (G - 128) * NWAVES, wave, lane); }
        else moe_convert(args, lds, CVQ4 + CVQ6 + CVQ7 + CVQ9 + CVQS1, CVQS2, gw, NGW, wave, lane);
        SEAM(10); }
    if (IN(11)) {
        pg8::Gemm g{(const bf16*)(ws + WS_UC), (const bf16*)(ws + WS_BTOUT), 64 * 768, 64 * 512, 768, 768, 768}; pg8::OrderS5Y S{G, bx};
        pg8::EpiY E{(bf16*)(ws + WS_Y)};
        pg8::gemm_phase<pg8::EpiY, pg8::OrderS5Y, true, true>(lds + RING_OFF, g, S, E);
        SEAM(11);
    }
    if (IN(12)) {
        pg8::Gemm g{(const bf16*)(ws + WS_Y), (const bf16*)(ws + WS_SOUT), ML, 2 * D, D, D, D}; pg8::StaticOrder S; S.init(ML, 2 * D, G, bx);
        pg8::EpiGLURes E{XL, mod1 + 2 * 1024};
        pg8::gemm_phase<pg8::EpiGLURes, pg8::StaticOrder, true, true>(lds + RING_OFF, g, S, E);
        SEAM(12);
    }
    unsigned char* tok = ws + WS_TOK;
    if (IN(13)) {
        int* rowsrc = (int*)(tok + TOK_ROWSRC); int* rowinfo = (int*)(tok + TOK_ROWINFO); float* rowgate = (float*)(tok + TOK_ROWGATE);
        for (int i = bx * (NWAVES * 64) + tid; i < MOE_TILES * 256; i += G * NWAVES * 64) { rowsrc[i] = 0; rowinfo[i] = -1; rowgate[i] = 0.f; ((float*)(ws + WS_POSSC))[i] = 0.f; }
        for (int ch = bx; ch < ML / 64; ch += G) moe_route(args, XL, mod1, H, ch, (LAS unsigned*)lds, tid, wave, lane);
        SEAM(13);
    }
    if (IN(14)) {
        int toff[9]; moe_offsets(ws, toff);
        const int* tokE = (const int*)(tok + TOK_E); const float* tokW = (const float*)(tok + TOK_W); const int* tokRank = (const int*)(tok + TOK_RANK); const int* wgbase = (const int*)(tok + TOK_WGBASE);
        int* rowsrc = (int*)(tok + TOK_ROWSRC); int* rowinfo = (int*)(tok + TOK_ROWINFO); float* rowgate = (float*)(tok + TOK_ROWGATE); int* tokPos = (int*)(tok + TOK_POS);
        for (int i = bx * (NWAVES * 64) + tid; i < 2 * ML; i += G * NWAVES * 64) { const int t = i >> 1, e = tokE[i]; int to = 0;
#pragma unroll
            for (int q = 0; q < 8; ++q) to = (e == q) ? toff[q] : to;
            const int pos = to * 256 + wgbase[(t >> 6) * 8 + e] + tokRank[i];
            rowsrc[pos] = t; rowinfo[pos] = i; rowgate[pos] = tokW[i]; tokPos[i] = pos; ((float*)(ws + WS_POSSC))[pos] = ((const float*)(ws + WS_ROWSC))[t]; }
        quant_rows_inplace((bf16*)(ws + WS_MW13), (unsigned*)(ws + WS_COLMAX), NE * 2 * ED, gw, NGW, lane);
        SEAM(14);
    }
    if (IN(15)) {
        pg8::OrderMoE S; S.G = G; S.c = bx; S.nN = 2 * ED / 256; S.tmax = 1 << 30; S.fix = (args.sub >> 7) & 1; moe_offsets(ws, S.toff);
        pg8::Gemm g{H, (const bf16*)(ws + WS_MW13), MOE_TILES * 256, NE * 2 * ED, D / 2, D / 2, D, (const int*)(tok + TOK_ROWSRC)};
        pg8::EpiSwiGLUq E{(bf16*)(ws + WS_ACTM), ED, 2 * ED / 256, (const float*)(ws + WS_POSSC), (const float*)(ws + WS_COLSC)};
        pg8::gemm_phase<pg8::EpiSwiGLUq, pg8::OrderMoE, true, true, true>(lds + RING_OFF, g, S, E);
        SEAM(15);
    }
    if (IN(16)) {
        pg8::OrderMoE S; S.G = G; S.c = bx; S.nN = D / 256; S.tmax = 128; S.fix = 0; moe_offsets(ws, S.toff);
        pg8::Gemm g{(const bf16*)(ws + WS_ACTM), (const bf16*)(ws + WS_MW2), MOE_TILES * 256, NE * D, ED, ED, ED};
        pg8::EpiMoE2 E{(bf16*)args.out, (const float*)(tok + TOK_ROWGATE), (const int*)(tok + TOK_ROWINFO)};
        pg8::gemm_phase<pg8::EpiMoE2, pg8::OrderMoE, true, true>(lds + RING_OFF, g, S, E);
        pg8::OrderMoEx Sx; Sx.G = G; Sx.c = bx; moe_offsets(ws, Sx.toff);
        pg8::Gemm gx{(const bf16*)(ws + WS_ACTM), (const bf16*)(ws + WS_MW2), MOE_TILES * 256, NE * D, 896, ED, ED};
        pg8::EpiMoE2x Ex{(float*)(ws + WS_PX), (const float*)(tok + TOK_ROWGATE)};
        pg8::gemm_phase<pg8::EpiMoE2x, pg8::OrderMoEx, true, false>(lds + RING_OFF, gx, Sx, Ex);
        SEAM(16);
    }
    if (IN(17)) {
        const unsigned bad = __hip_atomic_load((unsigned*)(ws + WS_CTL) + CW_BAR + XB_TMO, RLX_AGENT);
        const int* tokPos = (const int*)(tok + TOK_POS); const float* PX = (const float*)(ws + WS_PX);
        for (int tb = gw; tb < ML; tb += 2 * NGW) {
            const int tt[2] = {tb, (tb + NGW < ML) ? tb + NGW : tb}; const int ntk = (tb + NGW < ML) ? 2 : 1;
            v2u a[2][4], b[2][4], xw[2][4]; f32x4 gv[2][4]; int p0[2], p1[2];
#pragma unroll
            for (int u = 0; u < 2; ++u) { const int t = tt[u]; const bf16* y0 = (const bf16*)(args.out + (size_t)t * D); const bf16* y1 = y0 + D; const float* gp = mod1 + (size_t)(t >> 11) * 6144 + 5 * 1024;
                p0[u] = tokPos[2 * t] - 128 * 256; p1[u] = tokPos[2 * t + 1] - 128 * 256;
#pragma unroll
                for (int j = 0; j < 4; ++j) { const int c = 4 * lane + 256 * j; a[u][j] = *(const v2u*)(y0 + c); b[u][j] = *(const v2u*)(y1 + c); xw[u][j] = *(const v2u*)(XL + (size_t)t * D + c); gv[u][j] = *(const f32x4*)(gp + c); } }
            asm volatile("s_waitcnt vmcnt(0)" ::: "memory");
#pragma unroll
            for (int u = 0; u < 2; ++u) { if (u < ntk) { const int t = tt[u];
#pragma unroll
                for (int j = 0; j < 4; ++j) { const int c = 4 * lane + 256 * j;
                    f32x4 ya = (f32x4){bflo(a[u][j].x), bfhi(a[u][j].x), bflo(a[u][j].y), bfhi(a[u][j].y)}, yb = (f32x4){bflo(b[u][j].x), bfhi(b[u][j].x), bflo(b[u][j].y), bfhi(b[u][j].y)};
                    if (p0[u] >= 0) { const float* q = PX + (size_t)p0[u] * D + c; ya = ((*(const f32x4*)q + *(const f32x4*)(q + (size_t)2048 * D)) + *(const f32x4*)(q + (size_t)4096 * D)) + *(const f32x4*)(q + (size_t)6144 * D); }
                    if (p1[u] >= 0) { const float* q = PX + (size_t)p1[u] * D + c; yb = ((*(const f32x4*)q + *(const f32x4*)(q + (size_t)2048 * D)) + *(const f32x4*)(q + (size_t)4096 * D)) + *(const f32x4*)(q + (size_t)6144 * D); }
                    const f32x4 xv = (f32x4){bflo(xw[u][j].x), bfhi(xw[u][j].x), bflo(xw[u][j].y), bfhi(xw[u][j].y)};
                    f32x4 o = xv + gv[u][j] * (ya + yb); if (bad) o = (f32x4){__builtin_nanf(""), __builtin_nanf(""), __builtin_nanf(""), __builtin_nanf("")};
                    *(f32x4*)(args.out + (size_t)t * D + c) = o; } } }
        }
    }
#undef IN
#undef SEAM
}

extern "C" void kernel_launch(void* const* d_in, const int* in_sizes, int n_in, void* d_out, int out_size, void* d_ws, size_t ws_size, hipStream_t stream) {
    static int grid = 0;
    if (grid == 0) {
        if (n_in != N_IN || out_size != ML * D || ws_size < WS_END) { fprintf(stderr, "kernel_launch: unexpected problem (n_in %d, out %d, ws %zu); nothing launched\n", n_in, out_size, ws_size); grid = -1; return; }
        int dev = 0, cus = 0, per_cu = 0;
        if (hipGetDevice(&dev) != hipSuccess || hipDeviceGetAttribute(&cus, hipDeviceAttributeMultiprocessorCount, dev) != hipSuccess) { grid = -1; return; }
        if (hipFuncSetAttribute((const void*)fwd_kernel, hipFuncAttributeMaxDynamicSharedMemorySize, LDS_BYTES) != hipSuccess) { fprintf(stderr, "kernel_launch: hipFuncSetAttribute failed\n"); grid = -1; return; }
        if (hipOccupancyMaxActiveBlocksPerMultiprocessor(&per_cu, (const void*)fwd_kernel, NWAVES * 64, LDS_BYTES) != hipSuccess || per_cu < 1) { fprintf(stderr, "kernel_launch: occupancy query says %d blocks per CU\n", per_cu); (void)hipGetLastError(); grid = -1; return; }
        grid = cus;
    }
    if (grid < 0) return;
    if (hipMemsetAsync((char*)d_ws + WS_CTL, 0, CTL_ZERO_BYTES, stream) != hipSuccess) return;
    Args a{};
    for (int i = 0; i < N_IN; ++i) a.in[i] = (const float*)d_in[i];
    a.out = (float*)d_out; a.ws = (unsigned char*)d_ws; a.sub = 63;
#if MK_N_LAUNCHES == 1
    a.ph_lo = 0; a.ph_hi = NPHASE;
    hipLaunchKernelGGL(fwd_kernel, dim3(grid), dim3(NWAVES * 64), LDS_BYTES, stream, a);
#else
    for (int p = 0; p < NPHASE; ++p) { const int nrep = ((MK_REPEAT_MASK >> p) & 1u) ? 2 : 1;
        for (int r = 0; r < nrep; ++r) { a.ph_lo = p; a.ph_hi = p + 1; a.sub = (r == 0) ? 63 : MK_REPEAT_SUB; hipLaunchKernelGGL(fwd_kernel, dim3(grid), dim3(NWAVES * 64), LDS_BYTES, stream, a); } }
#endif
}
```

```cpp
#include <hip/hip_runtime.h>
#include <cstdio>
#include <cstdint>
#ifndef MK_N_LAUNCHES
#define MK_N_LAUNCHES 1
#endif
#ifndef MK_REPEAT_SUB
#define MK_REPEAT_SUB 63
#endif
#ifndef MK_REPEAT_MASK
#define MK_REPEAT_MASK 0u
#endif
namespace pg8 {
#define PG8_LAS __attribute__((address_space(3)))
typedef unsigned short bf16_t;
typedef short bf16x8 __attribute__((ext_vector_type(8)));
typedef float f32x4 __attribute__((ext_vector_type(4)));
typedef unsigned u32x4 __attribute__((ext_vector_type(4)));
typedef unsigned u32x2 __attribute__((ext_vector_type(2)));
typedef int i32x4 __attribute__((ext_vector_type(4)));
__device__ __forceinline__ f32x4 mma16(bf16x8 a, bf16x8 b, f32x4 c) { return __builtin_amdgcn_mfma_f32_16x16x32_bf16(a, b, c, 0, 0, 0); }
__device__ __forceinline__ i32x4 mma16(bf16x8 a, bf16x8 b, i32x4 c) { return __builtin_amdgcn_mfma_i32_16x16x64_i8(__builtin_bit_cast(i32x4, a), __builtin_bit_cast(i32x4, b), c, 0, 0, 0); }
typedef int i32x8 __attribute__((ext_vector_type(8)));
template <class T, class = void> struct is_fp8 { static constexpr bool v = false; };
template <class T> struct is_fp8<T, decltype((void)T::FP8)> { static constexpr bool v = T::FP8; };
template <bool FP8> struct Frag { bf16x8 k0, k1;
    __device__ __forceinline__ void set(int k, bf16x8 x) { if (k == 0) k0 = x; else k1 = x; } };
template <> struct Frag<true> { i32x8 v;
    __device__ __forceinline__ void set(int k, bf16x8 x) { if (k == 0) v.lo = __builtin_bit_cast(i32x4, x); else v.hi = __builtin_bit_cast(i32x4, x); } };
template <class ACC> __device__ __forceinline__ ACC mma_frag(const Frag<false>& a, const Frag<false>& b, ACC c) { c = mma16(a.k0, b.k0, c); return mma16(a.k1, b.k1, c); }
__device__ __forceinline__ f32x4 mma_frag(const Frag<true>& a, const Frag<true>& b, f32x4 c) { asm volatile("v_mfma_f32_16x16x128_f8f6f4 %0, %1, %2, %0" : "+v"(c) : "v"(a.v), "v"(b.v)); return c; }
template <bool FP8> __device__ __forceinline__ void mma_drain() { if constexpr (FP8) asm volatile("s_nop 15\n\ts_nop 15" ::: "memory"); }
constexpr int BM = 256, BK = 64, HALF = 128, HTB = HALF * BK * 2  , STAGE_BYTES = 8 * HTB, NXCD = 8, WGM = 8;

__host__ __device__ __forceinline__ int lds_byte(int r, int c) { const int st = (r >> 4) * 2 + (c >> 5), rr = r & 15, cc = c & 31, ob = rr * 64 + cc * 2; return st * 1024 + (ob ^ (((ob >> 9) & 1) << 5)); }
__host__ __device__ __forceinline__ void stage_rc(int b, int& R, int& C) { const int st = b / 1024, sb = b % 1024, swz = sb ^ (((sb >> 9) & 1) << 5); R = (st >> 1) * 16 + swz / 64; C = (st & 1) * 32 + (swz % 64) / 2; }
__host__ __device__ __forceinline__ int perm32(int rho) { const int n = rho >> 4, i = rho & 15; return 8 * (i >> 2) + 4 * n + (i & 3); }

struct Unit { int pm, pn, k0, idx; };
struct Gemm { const bf16_t* A; const bf16_t* Bt; int M, N, K, lda, ldb; const int* rowsrc; };

struct StaticOrder {
    static constexpr bool VARK = false;
    int nM, nN, nwg, G, c;
    __host__ __device__ void init(int M, int N, int G_, int c_) { nM = M / BM; nN = N / BM; nwg = nM * nN; G = G_; c = c_; }
    __host__ __device__ bool next(int i, Unit& u) const {
        const long L = (long)i * G + c; if (L >= nwg) return false;
        int wgid = (int)L; { const int q = nwg / NXCD, r = nwg % NXCD, xcd = wgid % NXCD, off = wgid / NXCD; wgid = (xcd < r ? xcd * (q + 1) : r * (q + 1) + (xcd - r) * q) + off; }
        const int nig = WGM * nN, gid = wgid / nig, fm = gid * WGM, gsz = (nM - fm) < WGM ? (nM - fm) : WGM;
        u.pm = fm + ((wgid % nig) % gsz); u.pn = (wgid % nig) / gsz; u.k0 = 0; u.idx = i; return true;
    }
    __device__ __forceinline__ void a_ready(const Unit&) const {}
    __device__ __forceinline__ void done(const Unit&) const {}
};

constexpr int ML_ = 16384, MC_ = 2048, MT_ = ML_ + MC_, DM_ = 1024;
__device__ __forceinline__ unsigned cvt_pk_bf16(float lo, float hi) { unsigned r; asm volatile("v_cvt_pk_bf16_f32 %0, %1, %2" : "=v"(r) : "v"(lo), "v"(hi)); return r; }
__device__ __forceinline__ float sigm(float x) { return __builtin_amdgcn_rcpf(1.0f + __expf(-x)); }
__device__ __forceinline__ float gelu_tanh(float x) { const float u = 1.5957691216f * (x + 0.044715f * x * x * x); return x * sigm(u); }
__device__ __forceinline__ unsigned f8pack4(const f32x4 v) { int w = 0;
    w = __builtin_amdgcn_cvt_pk_fp8_f32(__builtin_amdgcn_fmed3f(v[0], -448.f, 448.f), __builtin_amdgcn_fmed3f(v[1], -448.f, 448.f), w, false);
    w = __builtin_amdgcn_cvt_pk_fp8_f32(__builtin_amdgcn_fmed3f(v[2], -448.f, 448.f), __builtin_amdgcn_fmed3f(v[3], -448.f, 448.f), w, true); return (unsigned)w; }
__device__ __forceinline__ u32x4 pack8(const f32x4 a, const f32x4 b) { u32x4 w; w.x = cvt_pk_bf16(a[0], a[1]); w.y = cvt_pk_bf16(a[2], a[3]); w.z = cvt_pk_bf16(b[0], b[1]); w.w = cvt_pk_bf16(b[2], b[3]); return w; }


struct EpiQKVU {
    typedef f32x4 acc_t; static constexpr bool PERM = true, AFTER_DRAIN = false;
    bf16_t* O; const float* gq; const float* gk; float eps;
    __device__ __forceinline__ void operator()(const f32x4 (&acc)[2][2][4][2], const Unit& u, int wr, int wc, int fr, int fq) const {
        const int row0 = u.pm * BM + wr * 64 + fr; const int pn = u.pn;
        if (pn < 6) {
            const bool nrm = pn < 4; const float* gp = (pn < 2) ? gq : gk;
            f32x4 gn[2][2];
#pragma unroll
            for (int bj = 0; bj < 2; ++bj)
#pragma unroll
                for (int n = 0; n < 2; ++n) gn[bj][n] = nrm ? *(const f32x4*)(gp + 32 * bj + 8 * fq + 4 * n) : (f32x4){1.f, 1.f, 1.f, 1.f};
#pragma unroll
            for (int ai = 0; ai < 2; ++ai)
#pragma unroll
                for (int m = 0; m < 4; ++m) {
                    float sc = 1.f;
                    if (nrm) { float ss = 0.f;
#pragma unroll
                        for (int bj = 0; bj < 2; ++bj)
#pragma unroll
                            for (int n = 0; n < 2; ++n) { const f32x4 x = acc[ai][bj][m][n]; ss += (x[0] * x[0] + x[1] * x[1]) + (x[2] * x[2] + x[3] * x[3]); }
                        ss += __shfl_xor(ss, 16); ss += __shfl_xor(ss, 32);
                        sc = rsqrtf(ss * (1.0f / 64.0f) + eps); }
                    bf16_t* rowp = O + (size_t)(row0 + ai * HALF + m * 16) * 2048 + 256 * pn + 64 * wc + 8 * fq;
#pragma unroll
                    for (int bj = 0; bj < 2; ++bj) { const f32x4 v0 = acc[ai][bj][m][0] * gn[bj][0] * sc, v1 = acc[ai][bj][m][1] * gn[bj][1] * sc; *(u32x4*)(rowp + 32 * bj) = pack8(v0, v1); }
                }
        } else {
            const int cb = 1536 + 128 * (pn - 6) + 32 * wc + 8 * fq;
#pragma unroll
            for (int ai = 0; ai < 2; ++ai)
#pragma unroll
                for (int m = 0; m < 4; ++m) {
                    f32x4 v[2];
#pragma unroll
                    for (int n = 0; n < 2; ++n) { const f32x4 a = acc[ai][0][m][n], g = acc[ai][1][m][n]; v[n] = (f32x4){a[0] * sigm(g[0]), a[1] * sigm(g[1]), a[2] * sigm(g[2]), a[3] * sigm(g[3])}; }
                    *(u32x4*)(O + (size_t)(row0 + ai * HALF + m * 16) * 2048 + cb) = pack8(v[0], v[1]);
                }
        }
    }
};
struct EpiQKVUq {
    typedef i32x4 acc_t; static constexpr bool PERM = true, AFTER_DRAIN = false;
    bf16_t* O; const float* gq; const float* gk; float eps; const float* rowfac; const float* colscale;
    __device__ __forceinline__ void operator()(const i32x4 (&acc)[2][2][4][2], const Unit& u, int wr, int wc, int fr, int fq) const {
        const int row0 = u.pm * BM + wr * 64 + fr; const int pn = u.pn;
        f32x4 cs[2][2];
#pragma unroll
        for (int bj = 0; bj < 2; ++bj)
#pragma unroll
            for (int n = 0; n < 2; ++n) cs[bj][n] = *(const f32x4*)(colscale + pn * BM + bj * HALF + wc * 32 + 8 * fq + 4 * n);
#define QF(ai_, bj_, m_, n_, rf_) ((f32x4){(float)acc[ai_][bj_][m_][n_][0], (float)acc[ai_][bj_][m_][n_][1], (float)acc[ai_][bj_][m_][n_][2], (float)acc[ai_][bj_][m_][n_][3]} * cs[bj_][n_] * (rf_))
        if (pn < 6) {
            const bool nrm = pn < 4; const float* gp = (pn < 2) ? gq : gk;
            f32x4 gn[2][2];
#pragma unroll
            for (int bj = 0; bj < 2; ++bj)
#pragma unroll
                for (int n = 0; n < 2; ++n) gn[bj][n] = nrm ? *(const f32x4*)(gp + 32 * bj + 8 * fq + 4 * n) : (f32x4){1.f, 1.f, 1.f, 1.f};
#pragma unroll
            for (int ai = 0; ai < 2; ++ai)
#pragma unroll
                for (int m = 0; m < 4; ++m) {
                    float sc = 1.f; const float rf = rowfac[row0 + ai * HALF + m * 16];
                    f32x4 xf[2][2];
#pragma unroll
                    for (int bj = 0; bj < 2; ++bj)
#pragma unroll
                        for (int n = 0; n < 2; ++n) xf[bj][n] = QF(ai, bj, m, n, rf);
                    if (nrm) { float ss = 0.f;
#pragma unroll
                        for (int bj = 0; bj < 2; ++bj)
#pragma unroll
                            for (int n = 0; n < 2; ++n) { const f32x4 x = xf[bj][n]; ss += (x[0] * x[0] + x[1] * x[1]) + (x[2] * x[2] + x[3] * x[3]); }
                        ss += __shfl_xor(ss, 16); ss += __shfl_xor(ss, 32);
                        sc = rsqrtf(ss * (1.0f / 64.0f) + eps); }
                    bf16_t* rowp = O + (size_t)(row0 + ai * HALF + m * 16) * 2048 + 256 * pn + 64 * wc + 8 * fq;
#pragma unroll
                    for (int bj = 0; bj < 2; ++bj) { const f32x4 v0 = xf[bj][0] * gn[bj][0] * sc, v1 = xf[bj][1] * gn[bj][1] * sc; *(u32x4*)(rowp + 32 * bj) = pack8(v0, v1); }
                }
        } else {
            const int cb = 1536 + 128 * (pn - 6) + 32 * wc + 8 * fq;
#pragma unroll
            for (int ai = 0; ai < 2; ++ai)
#pragma unroll
                for (int m = 0; m < 4; ++m) { const float rf = rowfac[row0 + ai * HALF + m * 16];
                    f32x4 v[2];
#pragma unroll
                    for (int n = 0; n < 2; ++n) { const f32x4 a = QF(ai, 0, m, n, rf), g = QF(ai, 1, m, n, rf); v[n] = (f32x4){a[0] * sigm(g[0]), a[1] * sigm(g[1]), a[2] * sigm(g[2]), a[3] * sigm(g[3])}; }
                    *(u32x4*)(O + (size_t)(row0 + ai * HALF + m * 16) * 2048 + cb) = pack8(v[0], v[1]);
                }
        }
    }
};
#undef QF
struct EpiResid {
    typedef f32x4 acc_t; static constexpr bool PERM = false, AFTER_DRAIN = false;
    const float* baseL; const float* baseC; float* XL; float* XC; const float* gate;
    __device__ __forceinline__ void operator()(const f32x4 (&acc)[2][2][4][2], const Unit& u, int wr, int wc, int fr, int fq) const {
        const int R0 = u.pm * BM, row0 = R0 + wr * 64 + fr, col0 = u.pn * BM + wc * 32 + 4 * fq;
        const int modrow = R0 < ML_ ? (R0 >> 11) : 8;
        const float* gp = gate + (size_t)modrow * 6144 + col0;
        const float* bp = R0 < ML_ ? baseL : baseC - (size_t)ML_ * DM_;
        float* xo = R0 < ML_ ? XL : XC - (size_t)ML_ * DM_;
        f32x4 gv[2][2];
#pragma unroll
        for (int bj = 0; bj < 2; ++bj)
#pragma unroll
            for (int n = 0; n < 2; ++n) gv[bj][n] = *(const f32x4*)(gp + bj * HALF + n * 16);
#pragma unroll
        for (int ai = 0; ai < 2; ++ai)
#pragma unroll
            for (int m = 0; m < 4; ++m) { const size_t ro = (size_t)(row0 + ai * HALF + m * 16) * DM_ + col0;
#pragma unroll
                for (int bj = 0; bj < 2; ++bj)
#pragma unroll
                    for (int n = 0; n < 2; ++n) { const f32x4 xv = *(const f32x4*)(bp + ro + bj * HALF + n * 16); *(f32x4*)(xo + ro + bj * HALF + n * 16) = xv + gv[bj][n] * acc[ai][bj][m][n]; } }
    }
};
__device__ __forceinline__ void unpack8(const u32x4 w, f32x4& a, f32x4& b) {
    a = (f32x4){__builtin_bit_cast(float, w.x << 16), __builtin_bit_cast(float, w.x & 0xffff0000u), __builtin_bit_cast(float, w.y << 16), __builtin_bit_cast(float, w.y & 0xffff0000u)};
    b = (f32x4){__builtin_bit_cast(float, w.z << 16), __builtin_bit_cast(float, w.z & 0xffff0000u), __builtin_bit_cast(float, w.w << 16), __builtin_bit_cast(float, w.w & 0xffff0000u)}; }
template <bool BASE_F32> struct EpiResidN {
    typedef f32x4 acc_t; static constexpr bool PERM = true, AFTER_DRAIN = false;
    const void* baseL; const void* baseC; bf16_t* XL; bf16_t* XC; const float* gate; bf16_t* Hn; float* rowss; const float* ngain; const float* nscale;
    __device__ __forceinline__ void operator()(const f32x4 (&acc)[2][2][4][2], const Unit& u, int wr, int wc, int fr, int fq) const {
        const int R0 = u.pm * BM, row0 = R0 + wr * 64 + fr, col0 = u.pn * BM + wc * 32 + 8 * fq;
        const int modrow = R0 < ML_ ? (R0 >> 11) : 8, rsub = R0 < ML_ ? 0 : ML_;
        const float* gp = gate + (size_t)modrow * 6144 + col0; const float* sp = nscale + (size_t)modrow * 6144 + col0;
        const void* bp = R0 < ML_ ? baseL : baseC; bf16_t* xo = R0 < ML_ ? XL : XC;
        f32x4 gv[2][2], gs[2][2];
#pragma unroll
        for (int bj = 0; bj < 2; ++bj)
#pragma unroll
            for (int n = 0; n < 2; ++n) { gv[bj][n] = *(const f32x4*)(gp + bj * HALF + n * 4); gs[bj][n] = *(const f32x4*)(ngain + col0 + bj * HALF + n * 4) * (*(const f32x4*)(sp + bj * HALF + n * 4) + 1.0f); }
#pragma unroll
        for (int ai = 0; ai < 2; ++ai)
#pragma unroll
            for (int m = 0; m < 4; ++m) { const int row = row0 + ai * HALF + m * 16; const size_t ro = (size_t)(row - rsub) * DM_ + col0; float ss = 0.f;
#pragma unroll
                for (int bj = 0; bj < 2; ++bj) { f32x4 x0, x1;
                    if constexpr (BASE_F32) { x0 = *(const f32x4*)((const float*)bp + ro + bj * HALF); x1 = *(const f32x4*)((const float*)bp + ro + bj * HALF + 4); }
                    else unpack8(*(const u32x4*)((const bf16_t*)bp + ro + bj * HALF), x0, x1);
                    const u32x4 xw = pack8(x0 + gv[bj][0] * acc[ai][bj][m][0], x1 + gv[bj][1] * acc[ai][bj][m][1]); *(u32x4*)(xo + ro + bj * HALF) = xw;
                    f32x4 r0, r1; unpack8(xw, r0, r1);
                    ss += ((r0[0] * r0[0] + r0[1] * r0[1]) + (r0[2] * r0[2] + r0[3] * r0[3])) + ((r1[0] * r1[0] + r1[1] * r1[1]) + (r1[2] * r1[2] + r1[3] * r1[3]));
                    *(u32x4*)(Hn + (size_t)row * DM_ + col0 + bj * HALF) = pack8(r0 * gs[bj][0], r1 * gs[bj][1]); }
                ss += __shfl_xor(ss, 16); ss += __shfl_xor(ss, 32);
                if (fq == 0) rowss[(size_t)row * 16 + u.pn * 4 + wc] = ss; }
    }
};
__device__ __forceinline__ float row_rstd(const float* rowss, int row, float eps) {
    const f32x4* p = (const f32x4*)(rowss + (size_t)row * 16); const f32x4 a = p[0], b = p[1], c = p[2], d = p[3];
    const float s = (((a[0] + a[1]) + (a[2] + a[3])) + ((b[0] + b[1]) + (b[2] + b[3]))) + (((c[0] + c[1]) + (c[2] + c[3])) + ((d[0] + d[1]) + (d[2] + d[3])));
    return rsqrtf(s * (1.0f / 1024.0f) + eps); }
template <class Sched> __device__ __forceinline__ void rstd_prepass(const Sched& S, const float* rowss, PG8_LAS float* rt, float eps, int tid) {
    Unit u; int n = 0; while (n < 8 && S.next(n, u)) ++n;
#pragma unroll
    for (int q = 0; q < 4; ++q) { const int r = tid + 512 * q, i = r >> 8;
        if (i < n) { S.next(i, u); rt[r] = row_rstd(rowss, u.pm * BM + (r & 255), eps); } }
    __syncthreads();
}
struct EpiSwiGLUN {
    typedef f32x4 acc_t; static constexpr bool PERM = true, AFTER_DRAIN = false;
    bf16_t* O; int ldo; const PG8_LAS float* rt; const float* shw; int nphys;
    __device__ __forceinline__ void operator()(const f32x4 (&acc)[2][2][4][2], const Unit& u, int wr, int wc, int fr, int fq) const {
        const int R0 = u.pm * BM, row0 = R0 + wr * 64 + fr, colp = u.pn * BM + wc * 32 + 8 * fq, col0 = u.pn * HALF + wc * 32 + 8 * fq;
        const float* sp = shw + (size_t)(R0 < ML_ ? (R0 >> 11) : 8) * nphys + colp;
        f32x4 s1[2], s3[2];
#pragma unroll
        for (int n = 0; n < 2; ++n) { s1[n] = *(const f32x4*)(sp + 4 * n); s3[n] = *(const f32x4*)(sp + HALF + 4 * n); }
#pragma unroll
        for (int ai = 0; ai < 2; ++ai)
#pragma unroll
            for (int m = 0; m < 4; ++m) { const int row = row0 + ai * HALF + m * 16; const float rs = rt[u.idx * BM + (row - R0)];
                f32x4 v[2];
#pragma unroll
                for (int n = 0; n < 2; ++n) { const f32x4 a = acc[ai][0][m][n] * rs + s1[n], b = acc[ai][1][m][n] * rs + s3[n]; v[n] = (f32x4){a[0] * sigm(a[0]) * b[0], a[1] * sigm(a[1]) * b[1], a[2] * sigm(a[2]) * b[2], a[3] * sigm(a[3]) * b[3]}; }
                *(u32x4*)(O + (size_t)row * ldo + col0) = pack8(v[0], v[1]);
            }
    }
};
struct EpiSwiGLU {
    typedef f32x4 acc_t; static constexpr bool PERM = true, AFTER_DRAIN = false;
    bf16_t* O; int ldo, nN, row_sub; int skip;
    __device__ __forceinline__ void operator()(const f32x4 (&acc)[2][2][4][2], const Unit& u, int wr, int wc, int fr, int fq) const {
        if (skip) {
#pragma unroll
            for (int ai = 0; ai < 2; ++ai)
#pragma unroll
                for (int bj = 0; bj < 2; ++bj)
#pragma unroll
                    for (int m = 0; m < 4; ++m)
#pragma unroll
                        for (int n = 0; n < 2; ++n) asm volatile("" :: "v"(acc[ai][bj][m][n]));
            return; }
        const int row0 = u.pm * BM + wr * 64 + fr - row_sub, col0 = (u.pn % nN) * HALF + wc * 32 + 8 * fq;
#pragma unroll
        for (int ai = 0; ai < 2; ++ai)
#pragma unroll
            for (int m = 0; m < 4; ++m) {
                f32x4 v[2];
#pragma unroll
                for (int n = 0; n < 2; ++n) { const f32x4 a = acc[ai][0][m][n], b = acc[ai][1][m][n]; v[n] = (f32x4){a[0] * sigm(a[0]) * b[0], a[1] * sigm(a[1]) * b[1], a[2] * sigm(a[2]) * b[2], a[3] * sigm(a[3]) * b[3]}; }
                *(u32x4*)(O + (size_t)(row0 + ai * HALF + m * 16) * ldo + col0) = pack8(v[0], v[1]);
            }
    }
};
template <class Sched> __device__ __forceinline__ void rowfac_prepass(const Sched& S, const float* rowfac, PG8_LAS float* rt, int tid) {
    Unit u; int n = 0; while (n < 8 && S.next(n, u)) ++n;
#pragma unroll
    for (int q = 0; q < 4; ++q) { const int r = tid + 512 * q, i = r >> 8; if (i < n) { S.next(i, u); rt[r] = rowfac[u.pm * BM + (r & 255)]; } }
    __syncthreads();
}
struct EpiSwiGLUNq {
    typedef i32x4 acc_t; static constexpr bool PERM = true, AFTER_DRAIN = false;
    bf16_t* O; int ldo; const PG8_LAS float* rt; const float* shw; int nphys; const float* colscale;
    __device__ __forceinline__ void operator()(const i32x4 (&acc)[2][2][4][2], const Unit& u, int wr, int wc, int fr, int fq) const {
        const int R0 = u.pm * BM, row0 = R0 + wr * 64 + fr, colp = u.pn * BM + wc * 32 + 8 * fq, col0 = u.pn * HALF + wc * 32 + 8 * fq;
        const float* sp = shw + (size_t)(R0 < ML_ ? (R0 >> 11) : 8) * nphys + colp; const float* cp = colscale + colp;
        f32x4 s1[2], s3[2], c1[2], c3[2];
#pragma unroll
        for (int n = 0; n < 2; ++n) { s1[n] = *(const f32x4*)(sp + 4 * n); s3[n] = *(const f32x4*)(sp + HALF + 4 * n); c1[n] = *(const f32x4*)(cp + 4 * n); c3[n] = *(const f32x4*)(cp + HALF + 4 * n); }
#pragma unroll
        for (int ai = 0; ai < 2; ++ai)
#pragma unroll
            for (int m = 0; m < 4; ++m) { const int row = row0 + ai * HALF + m * 16; const float rs = rt[u.idx * BM + (row - R0)];
                f32x4 v[2];
#pragma unroll
                for (int n = 0; n < 2; ++n) { const i32x4 ia = acc[ai][0][m][n], ib = acc[ai][1][m][n];
                    const f32x4 a = (f32x4){(float)ia[0], (float)ia[1], (float)ia[2], (float)ia[3]} * (c1[n] * rs) + s1[n], b = (f32x4){(float)ib[0], (float)ib[1], (float)ib[2], (float)ib[3]} * (c3[n] * rs) + s3[n];
                    v[n] = (f32x4){a[0] * sigm(a[0]) * b[0], a[1] * sigm(a[1]) * b[1], a[2] * sigm(a[2]) * b[2], a[3] * sigm(a[3]) * b[3]}; }
                *(u32x4*)(O + (size_t)row * ldo + col0) = pack8(v[0], v[1]);
            }
    }
};
struct EpiSwiGLUq {
    typedef i32x4 acc_t; static constexpr bool PERM = true, AFTER_DRAIN = false;
    unsigned char* O; int ldo, nN; const float* posscale; const float* colscale;
    __device__ __forceinline__ void operator()(const i32x4 (&acc)[2][2][4][2], const Unit& u, int wr, int wc, int fr, int fq) const {
        const int row0 = u.pm * BM + wr * 64 + fr, col0 = (u.pn % nN) * HALF + wc * 32 + 8 * fq; const float* cp = colscale + (size_t)u.pn * BM + wc * 32 + 8 * fq;
        f32x4 c1[2], c3[2];
#pragma unroll
        for (int n = 0; n < 2; ++n) { c1[n] = *(const f32x4*)(cp + 4 * n); c3[n] = *(const f32x4*)(cp + HALF + 4 * n); }
#pragma unroll
        for (int ai = 0; ai < 2; ++ai)
#pragma unroll
            for (int m = 0; m < 4; ++m) { const int row = row0 + ai * HALF + m * 16; const float rs = posscale[row];
                f32x4 v[2];
#pragma unroll
                for (int n = 0; n < 2; ++n) { const i32x4 ia = acc[ai][0][m][n], ib = acc[ai][1][m][n];
                    const f32x4 a = (f32x4){(float)ia[0], (float)ia[1], (float)ia[2], (float)ia[3]} * c1[n] * rs, b = (f32x4){(float)ib[0], (float)ib[1], (float)ib[2], (float)ib[3]} * c3[n] * rs;
                    v[n] = (f32x4){a[0] * sigm(a[0]) * b[0], a[1] * sigm(a[1]) * b[1], a[2] * sigm(a[2]) * b[2], a[3] * sigm(a[3]) * b[3]}; }
                u32x2 o; o.x = f8pack4(v[0]); o.y = f8pack4(v[1]); *(u32x2*)(O + (size_t)row * ldo + col0) = o;
            }
    }
};
struct EpiGLURes {
    typedef f32x4 acc_t; static constexpr bool PERM = true, AFTER_DRAIN = false;
    bf16_t* X; const float* gate;
    __device__ __forceinline__ void operator()(const f32x4 (&acc)[2][2][4][2], const Unit& u, int wr, int wc, int fr, int fq) const {
        const int R0 = u.pm * BM, row0 = R0 + wr * 64 + fr, col0 = u.pn * HALF + wc * 32 + 8 * fq;
        const float* gp = gate + (size_t)(R0 >> 11) * 6144 + col0;
        f32x4 gv[2];
#pragma unroll
        for (int n = 0; n < 2; ++n) gv[n] = *(const f32x4*)(gp + n * 4);
#pragma unroll
        for (int ai = 0; ai < 2; ++ai)
#pragma unroll
            for (int m = 0; m < 4; ++m) { bf16_t* xp = X + (size_t)(row0 + ai * HALF + m * 16) * DM_ + col0; f32x4 x0, x1, y[2];
                unpack8(*(const u32x4*)xp, x0, x1);
#pragma unroll
                for (int n = 0; n < 2; ++n) { const f32x4 z1 = acc[ai][0][m][n], z2 = acc[ai][1][m][n]; y[n] = (f32x4){z1[0] * sigm(z2[0]), z1[1] * sigm(z2[1]), z1[2] * sigm(z2[2]), z1[3] * sigm(z2[3])}; }
                *(u32x4*)xp = pack8(x0 + gv[0] * y[0], x1 + gv[1] * y[1]); }
    }
};
struct EpiUC {
    typedef f32x4 acc_t; static constexpr bool PERM = true, AFTER_DRAIN = false;
    bf16_t* UC; const PG8_LAS float* rt; const float* shw;
    __device__ __forceinline__ void operator()(const f32x4 (&acc)[2][2][4][2], const Unit& u, int wr, int wc, int fr, int fq) const {
        const int R0 = u.pm * BM, row0 = R0 + wr * 64 + fr, col0 = u.pn * BM + wc * 32 + 8 * fq;
        const float* sp = shw + (size_t)(R0 < ML_ ? (R0 >> 11) : 8) * DM_ + col0;
        f32x4 sv[2][2];
#pragma unroll
        for (int bj = 0; bj < 2; ++bj)
#pragma unroll
            for (int n = 0; n < 2; ++n) sv[bj][n] = *(const f32x4*)(sp + bj * HALF + 4 * n);
#pragma unroll
        for (int ai = 0; ai < 2; ++ai)
#pragma unroll
            for (int m = 0; m < 4; ++m) { const int row = row0 + ai * HALF + m * 16; int bc, j; const float rs = rt[u.idx * BM + (row - R0)];
                if (row < ML_) { bc = (row >> 11) * 64 + ((row & 2047) >> 5); j = row & 31; } else { const int r2 = row - ML_; bc = 512 + (r2 >> 8) * 8 + ((r2 & 255) >> 5); j = r2 & 31; }
#pragma unroll
                for (int bj = 0; bj < 2; ++bj) { const int col = col0 + bj * HALF, g = col >> 4, qi = col & 15;
                    *(u32x4*)(UC + ((size_t)(g * 768 + bc) * 768 + j * 16 + qi)) = pack8(acc[ai][bj][m][0] * rs + sv[bj][0], acc[ai][bj][m][1] * rs + sv[bj][1]); } }
    }
};
struct EpiE {
    typedef f32x4 acc_t; static constexpr bool PERM = false, AFTER_DRAIN = false;
    float* E;
    __device__ __forceinline__ void operator()(const f32x4 (&acc)[2][2][4][2], const Unit& u, int wr, int wc, int fr, int fq) const {
        const int row0 = u.pm * BM + wr * 64 + fr, col0 = wc * 32 + 4 * fq;
#pragma unroll
        for (int ai = 0; ai < 2; ++ai)
#pragma unroll
            for (int m = 0; m < 4; ++m) { float* rp = E + (size_t)(row0 + ai * HALF + m * 16) * 256 + col0;
#pragma unroll
                for (int bj = 0; bj < 2; ++bj)
#pragma unroll
                    for (int n = 0; n < 2; ++n) *(f32x4*)(rp + bj * HALF + n * 16) = acc[ai][bj][m][n]; }
    }
};
struct EpiY {
    typedef f32x4 acc_t; static constexpr bool PERM = true, AFTER_DRAIN = false;
    bf16_t* Y;
    __device__ __forceinline__ void operator()(const f32x4 (&acc)[2][2][4][2], const Unit& u, int wr, int wc, int fr, int fq) const {
        const int g = u.pm / 3, pml = u.pm - 3 * g, pnl = u.pn & 1;
        const int bc0 = pml * BM + wr * 64 + fr, n0 = pnl * BM + wc * 32 + 8 * fq;
#pragma unroll
        for (int ai = 0; ai < 2; ++ai)
#pragma unroll
            for (int m = 0; m < 4; ++m) { const int bc = bc0 + ai * HALF + m * 16, tok0 = (bc >> 6) * 2048 + (bc & 63) * 32;
#pragma unroll
                for (int bj = 0; bj < 2; ++bj) { const int n = n0 + bj * HALF, tin = n >> 4, qo = n & 15; const f32x4 a = acc[ai][bj][m][0], b = acc[ai][bj][m][1];
                    const f32x4 ya = (f32x4){gelu_tanh(a[0]), gelu_tanh(a[1]), gelu_tanh(a[2]), gelu_tanh(a[3])}, yb = (f32x4){gelu_tanh(b[0]), gelu_tanh(b[1]), gelu_tanh(b[2]), gelu_tanh(b[3])};
                    *(u32x4*)(Y + (size_t)(tok0 + tin) * DM_ + g * 16 + qo) = pack8(ya, yb); } }
    }
};
struct EpiMoE2 {
    typedef f32x4 acc_t; static constexpr bool PERM = true, AFTER_DRAIN = false, FP8 = true;
    bf16_t* Y2; const float* rowgate; const int* rowinfo; const float* colscale;
    __device__ __forceinline__ void operator()(const f32x4 (&acc)[2][2][4][2], const Unit& u, int wr, int wc, int fr, int fq) const {
        const int row0 = u.pm * BM + wr * 64 + fr, col0 = (u.pn & 3) * BM + wc * 32 + 8 * fq; const float* cp = colscale + (size_t)u.pn * BM + wc * 32 + 8 * fq;
        f32x4 cs[2][2];
#pragma unroll
        for (int bj = 0; bj < 2; ++bj)
#pragma unroll
            for (int n = 0; n < 2; ++n) cs[bj][n] = *(const f32x4*)(cp + bj * HALF + 4 * n);
#pragma unroll
        for (int ai = 0; ai < 2; ++ai)
#pragma unroll
            for (int m = 0; m < 4; ++m) { const int row = row0 + ai * HALF + m * 16; const float gt = rowgate[row]; const int ri = rowinfo[row];
                if (ri >= 0) {
#pragma unroll
                    for (int bj = 0; bj < 2; ++bj) *(u32x4*)(Y2 + (size_t)ri * DM_ + col0 + bj * HALF) = pack8(acc[ai][bj][m][0] * (cs[bj][0] * gt), acc[ai][bj][m][1] * (cs[bj][1] * gt)); } }
    }
};
struct OrderS5E { static constexpr bool VARK = false; int G, c;
    __device__ __forceinline__ bool next(int i, Unit& u) const {
        if (G == 256) { if (i > 0) return false; const int x = c & 7, j = c >> 3; if (j >= 24) return false; const int g = 8 * (j / 3) + x; u.pm = 3 * g + (j % 3); u.pn = g; u.k0 = 0; u.idx = i; return true; }
        const int L = i * G + c; if (L >= 192) return false; u.pm = L; u.pn = L / 3; u.k0 = 0; u.idx = i; return true; }
    __device__ __forceinline__ void a_ready(const Unit&) const {}
    __device__ __forceinline__ void done(const Unit&) const {} };
struct OrderS5Y { static constexpr bool VARK = false; int G, c;
    __device__ __forceinline__ bool next(int i, Unit& u) const {
        if (G == 256) { if (i > 0) return false; const int x = c & 7, j = c >> 3, g = 8 * (j >> 2) + x; u.pm = 3 * g + ((j >> 1) & 1); u.pn = 2 * g + (j & 1); u.k0 = 0; u.idx = i; return true; }
        const int L = i * G + c; if (L >= 256) return false; const int g = L >> 2; u.pm = 3 * g + ((L >> 1) & 1); u.pn = 2 * g + (L & 1); u.k0 = 0; u.idx = i; return true; }
    __device__ __forceinline__ void a_ready(const Unit&) const {}
    __device__ __forceinline__ void done(const Unit&) const {} };
struct OrderMoE { static constexpr bool VARK = false; int G, c, nN, tmax, fix; int toff[9];
    __device__ __forceinline__ bool next(int i, Unit& u) const {
        int pm, pnl; const int nt = toff[8] < tmax ? toff[8] : tmax;
        if (G == 256) {
            const int x = c & 7, j = c >> 3, nCB = nN >> 2, b = i * 8 + x, nRB = (nt + 7) >> 3; if (b >= nRB * nCB) return false;
            const int rb = b / nCB, cbk = b - rb * nCB; pm = 8 * rb + (j & 7); pnl = 4 * cbk + (j >> 3);
        } else { const int L = i * G + c; pm = L / nN; pnl = L - pm * nN; }
        if (pm >= nt) return false;
        int e = 0;
#pragma unroll
        for (int k = 1; k < 8; ++k) e += (pm >= toff[k]) ? 1 : 0;
        u.pm = fix ? 0 : pm; u.pn = fix ? pnl & 3 : e * nN + pnl; u.k0 = 0; u.idx = i; return true; }
    __device__ __forceinline__ void a_ready(const Unit&) const {}
    __device__ __forceinline__ void done(const Unit&) const {} };
struct OrderMoEx { static constexpr bool VARK = true; int G, c; int toff[9];
    __device__ __forceinline__ bool next(int i, Unit& u) const {
        const int s = i * G + c, tl = s >> 4, pm = 128 + tl; if (pm >= toff[8]) return false;
        int e = 0;
#pragma unroll
        for (int k = 1; k < 8; ++k) e += (pm >= toff[k]) ? 1 : 0;
        const int ks = s & 3; u.pm = pm; u.pn = e * 4 + ((s >> 2) & 3); u.k0 = (ks * 8 - (ks == 3 ? 2 : 0)) * BK; u.idx = ks; return true; }
    __device__ __forceinline__ int ktiles(const Unit& u) const { return u.idx < 2 ? 8 : 6; }
    __device__ __forceinline__ void a_ready(const Unit&) const {}
    __device__ __forceinline__ void done(const Unit&) const {} };
struct EpiMoE2x {
    typedef f32x4 acc_t; static constexpr bool PERM = false, AFTER_DRAIN = false, FP8 = true;
    float* P; const float* rowgate; const float* colscale;
    __device__ __forceinline__ void operator()(const f32x4 (&acc)[2][2][4][2], const Unit& u, int wr, int wc, int fr, int fq) const {
        const int ks = u.idx, tl = u.pm - 128, r0 = wr * 64 + fr, col0 = (u.pn & 3) * BM + wc * 32 + 4 * fq;
        const __amdgpu_buffer_rsrc_t crs = __builtin_amdgcn_make_buffer_rsrc((void*)colscale, 0, 8 * 1024 * 4, 0x00020000);
        f32x4 cs[2][2];
#pragma unroll
        for (int bj = 0; bj < 2; ++bj)
#pragma unroll
            for (int n = 0; n < 2; ++n) cs[bj][n] = __builtin_bit_cast(f32x4, __builtin_amdgcn_raw_buffer_load_b128(crs, (u.pn * BM + wc * 32 + 4 * fq + bj * HALF + n * 16) * 4, 0, 0));
        float* pb = P + ((size_t)(ks * 8 + tl) * 256) * DM_;
        const __amdgpu_buffer_rsrc_t grs = __builtin_amdgcn_make_buffer_rsrc((void*)rowgate, 0, 136 * 256 * 4, 0x00020000);
#pragma unroll
        for (int ai = 0; ai < 2; ++ai)
#pragma unroll
            for (int m = 0; m < 4; ++m) { const int r = r0 + ai * HALF + m * 16; const float gt = __builtin_bit_cast(float, __builtin_amdgcn_raw_buffer_load_b32(grs, (u.pm * BM + r) * 4, 0, 0));
#pragma unroll
                for (int bj = 0; bj < 2; ++bj)
#pragma unroll
                    for (int n = 0; n < 2; ++n) *(f32x4*)(pb + (size_t)r * DM_ + col0 + bj * HALF + n * 16) = acc[ai][bj][m][n] * (cs[bj][n] * gt); }
    }
};
template <class Epi, class Sched, bool ALIGN_EPI = false, bool SP2 = false, bool GATHER = false>
__device__ __forceinline__ void gemm_phase(PG8_LAS unsigned char* lds, const Gemm g, const Sched& S, const Epi& E) {
    const int tid = threadIdx.x, wid = __builtin_amdgcn_readfirstlane(tid >> 6), lane = tid & 63, wr = wid >> 2, wc = wid & 3, fr = lane & 15, fq = lane >> 4;
    const int K = g.K; int nt = K / BK;
    unsigned voffA[2], voffB[2]; int RA[2]; unsigned CA[2];
    static_assert(!GATHER || SP2, "the gathered A operand is wired into the SP2 loop only");
#pragma unroll
    for (int i = 0; i < 2; ++i) { int R, C; stage_rc(tid * 16 + i * 8192, R, C); const int Rb = Epi::PERM ? ((R & ~31) + perm32(R & 31)) : R;
        voffA[i] = (unsigned)(R * g.lda + C) * 2u; voffB[i] = (unsigned)(Rb * g.ldb + C) * 2u; RA[i] = R; CA[i] = (unsigned)C * 2u; }
    const size_t kstep = (size_t)(BK * 2);
    const size_t hstepA = (size_t)HALF * g.lda * 2, hstepB = (size_t)HALF * g.ldb * 2;
    const size_t tstepA = 2 * hstepA, tstepB = 2 * hstepB;
    const unsigned ldsw = (unsigned)wid * 1024u;
    const int aoff = lds_byte(wr * 64 + fr, fq * 8), boff = lds_byte(wc * 32 + fr, fq * 8);
#define PG8_SA(b, h) (((b) * 2 + (h)) * HTB)
#define PG8_SB(b, h) ((4 + (b) * 2 + (h)) * HTB)
#define PG8_STAGE(bufoff, gbase, voff) do { _Pragma("unroll") for (int _i = 0; _i < 2; ++_i) \
        __builtin_amdgcn_global_load_lds((const unsigned*)((const char*)(gbase) + (voff)[_i]), (PG8_LAS unsigned*)(lds + (bufoff) + ldsw + _i * 8192), 16, 0, 0); } while (0)
#define PG8_LDA(dst, b, h) do { _Pragma("unroll") for (int m = 0; m < 4; ++m) _Pragma("unroll") for (int k = 0; k < 2; ++k) dst[m].set(k, *(const PG8_LAS bf16x8*)(lds + PG8_SA(b, h) + aoff + m * 2048 + k * 1024)); } while (0)
#define PG8_LDB(dst, b, h) do { _Pragma("unroll") for (int n = 0; n < 2; ++n) _Pragma("unroll") for (int k = 0; k < 2; ++k) dst[n].set(k, *(const PG8_LAS bf16x8*)(lds + PG8_SB(b, h) + boff + n * 2048 + k * 1024)); } while (0)
#define PG8_MMA(ai, bj, At, Bt) do { __builtin_amdgcn_s_setprio(1); _Pragma("unroll") for (int m = 0; m < 4; ++m) _Pragma("unroll") for (int n = 0; n < 2; ++n) \
        acc[ai][bj][m][n] = mma_frag(Bt[n], At[m], acc[ai][bj][m][n]); __builtin_amdgcn_s_setprio(0); } while (0)
#define PG8_WAIT_V(n) asm volatile("s_waitcnt vmcnt(" #n ")" ::: "memory")
#define PG8_WAIT_L(n) asm volatile("s_waitcnt lgkmcnt(" #n ")" ::: "memory")
#define PG8_BAR __builtin_amdgcn_s_barrier()
#define PG8_SCHED __builtin_amdgcn_sched_barrier(0)
#define PG8_GIDX(d0, d1, un) do { _Pragma("unroll") for (int _i = 0; _i < 2; ++_i) { const int* _rp = g.rowsrc + (un).pm * BM + RA[_i]; d0[_i] = (unsigned)_rp[0] * (unsigned)(g.lda * 2) + CA[_i]; d1[_i] = (unsigned)_rp[HALF] * (unsigned)(g.lda * 2) + CA[_i]; } } while (0)
    Unit cur, nxt; int ui = 0;
    if (!S.next(0, cur)) return;
    if constexpr (Sched::VARK) nt = S.ktiles(cur);
    typedef typename Epi::acc_t acc_t;
    acc_t acc[2][2][4][2];
#pragma unroll
    for (int a = 0; a < 2; ++a)
#pragma unroll
        for (int b = 0; b < 2; ++b)
#pragma unroll
            for (int m = 0; m < 4; ++m)
#pragma unroll
                for (int n = 0; n < 2; ++n) acc[a][b][m][n] = (acc_t){0, 0, 0, 0};
    Frag<is_fp8<Epi>::v> At[4], B0[2], B1[2];
    const char* cA = (const char*)g.A + (size_t)cur.pm * tstepA + (size_t)cur.k0 * 2; const char* cB = (const char*)g.Bt + (size_t)cur.pn * tstepB + (size_t)cur.k0 * 2;
    S.a_ready(cur);
    unsigned cv0[2] = {0u, 0u}, cv1[2] = {0u, 0u}, nv0[2] = {0u, 0u}, nv1[2] = {0u, 0u}; const char* gA = (const char*)g.A;
    if constexpr (GATHER) { PG8_GIDX(cv0, cv1, cur); nv0[0] = cv0[0]; nv0[1] = cv0[1]; nv1[0] = cv1[0]; nv1[1] = cv1[1]; }
    if constexpr (SP2) {
        PG8_STAGE(PG8_SB(0, 0), cB, voffB); PG8_STAGE(PG8_SB(0, 1), cB + hstepB, voffB);
        if constexpr (GATHER) { PG8_STAGE(PG8_SA(0, 0), gA, cv0); PG8_STAGE(PG8_SA(0, 1), gA, cv1); } else { PG8_STAGE(PG8_SA(0, 0), cA, voffA); PG8_STAGE(PG8_SA(0, 1), cA + hstepA, voffA); }
        if (wr == 1) PG8_BAR;
        PG8_WAIT_V(2); PG8_BAR;
        PG8_STAGE(PG8_SB(1, 0), cB + kstep, voffB); if constexpr (GATHER) PG8_STAGE(PG8_SA(1, 0), gA + kstep, cv0); else PG8_STAGE(PG8_SA(1, 0), cA + kstep, voffA); PG8_STAGE(PG8_SB(1, 1), cB + hstepB + kstep, voffB);
        PG8_WAIT_V(6); PG8_BAR;
    } else {
        PG8_STAGE(PG8_SB(0, 0), cB, voffB); PG8_STAGE(PG8_SA(0, 0), cA, voffA); PG8_STAGE(PG8_SB(0, 1), cB + hstepB, voffB); PG8_STAGE(PG8_SA(0, 1), cA + hstepA, voffA);
        if (wr == 1) PG8_BAR;
        PG8_WAIT_V(4); PG8_BAR;
        PG8_STAGE(PG8_SB(1, 0), cB + kstep, voffB); PG8_STAGE(PG8_SA(1, 0), cA + kstep, voffA); PG8_STAGE(PG8_SB(1, 1), cB + hstepB + kstep, voffB);
        PG8_WAIT_V(6); PG8_BAR;
    }
    for (;;) {
        const bool has_next = S.next(ui + 1, nxt);
        const char* nA = has_next ? (const char*)g.A + (size_t)nxt.pm * tstepA + (size_t)nxt.k0 * 2 : cA; const char* nB = has_next ? (const char*)g.Bt + (size_t)nxt.pn * tstepB + (size_t)nxt.k0 * 2 : cB;
        for (int t = 0; t < nt; t += 2) {
            const bool last = (t == nt - 2);
            const char* a1 = cA + (size_t)(t + 1) * kstep;
            const char* a2 = last ? nA : cA + (size_t)(t + 2) * kstep; const char* b2 = last ? nB : cB + (size_t)(t + 2) * kstep;
            const char* a3 = a2 + kstep; const char* b3 = b2 + kstep;
            if (last && has_next) S.a_ready(nxt);
            if constexpr (GATHER) { if (t == nt - 4 && has_next) PG8_GIDX(nv0, nv1, nxt); }
            const char* g1 = gA + (size_t)(t + 1) * kstep; const char* g2 = last ? gA : gA + (size_t)(t + 2) * kstep; const char* g3 = g2 + kstep;
            unsigned x0[2], x1[2]; x0[0] = last ? nv0[0] : cv0[0]; x0[1] = last ? nv0[1] : cv0[1]; x1[0] = last ? nv1[0] : cv1[0]; x1[1] = last ? nv1[1] : cv1[1];
            if constexpr (SP2) {
            PG8_LDB(B0, 0, 0); PG8_LDB(B1, 0, 1); PG8_SCHED; PG8_LDA(At, 0, 0); if constexpr (GATHER) PG8_STAGE(PG8_SA(1, 1), g1, cv1); else PG8_STAGE(PG8_SA(1, 1), a1 + hstepA, voffA);
            PG8_WAIT_V(8); PG8_WAIT_L(0); PG8_BAR; PG8_MMA(0, 0, At, B0); PG8_MMA(0, 1, At, B1); PG8_BAR; PG8_SCHED;
            PG8_LDA(At, 0, 1); PG8_STAGE(PG8_SB(0, 0), b2, voffB); PG8_STAGE(PG8_SB(0, 1), b2 + hstepB, voffB); if constexpr (GATHER) PG8_STAGE(PG8_SA(0, 0), g2, x0); else PG8_STAGE(PG8_SA(0, 0), a2, voffA);
            PG8_WAIT_V(8); PG8_WAIT_L(0); PG8_BAR; PG8_MMA(1, 0, At, B0); PG8_MMA(1, 1, At, B1); PG8_BAR; PG8_SCHED;
            PG8_LDB(B0, 1, 0); PG8_LDB(B1, 1, 1); PG8_SCHED; PG8_LDA(At, 1, 0); if constexpr (GATHER) PG8_STAGE(PG8_SA(0, 1), g2, x1); else PG8_STAGE(PG8_SA(0, 1), a2 + hstepA, voffA);
            PG8_WAIT_V(8); PG8_WAIT_L(0); PG8_BAR; PG8_MMA(0, 0, At, B0); PG8_MMA(0, 1, At, B1); PG8_BAR; PG8_SCHED;
            PG8_LDA(At, 1, 1); PG8_STAGE(PG8_SB(1, 0), b3, voffB); PG8_STAGE(PG8_SB(1, 1), b3 + hstepB, voffB); if constexpr (GATHER) PG8_STAGE(PG8_SA(1, 0), g3, x0); else PG8_STAGE(PG8_SA(1, 0), a3, voffA);
            PG8_WAIT_V(8); PG8_WAIT_L(0); PG8_BAR; PG8_MMA(1, 0, At, B0); PG8_MMA(1, 1, At, B1); PG8_BAR; PG8_SCHED;
            } else {
            PG8_LDB(B0, 0, 0); PG8_SCHED; PG8_LDA(At, 0, 0); PG8_STAGE(PG8_SA(1, 1), a1 + hstepA, voffA);
            PG8_WAIT_L(8); PG8_BAR; PG8_WAIT_L(0); PG8_MMA(0, 0, At, B0); PG8_BAR; PG8_SCHED;
            PG8_LDB(B1, 0, 1); PG8_STAGE(PG8_SB(0, 0), b2, voffB);
            PG8_BAR; PG8_WAIT_L(0); PG8_MMA(0, 1, At, B1); PG8_BAR;
            PG8_LDA(At, 0, 1); PG8_STAGE(PG8_SA(0, 0), a2, voffA);
            PG8_BAR; PG8_WAIT_L(0); PG8_MMA(1, 0, At, B0); PG8_BAR; PG8_SCHED;
            PG8_STAGE(PG8_SB(0, 1), b2 + hstepB, voffB);
            PG8_WAIT_V(6); PG8_BAR; PG8_MMA(1, 1, At, B1); PG8_BAR;
            PG8_LDB(B0, 1, 0); PG8_SCHED; PG8_LDA(At, 1, 0); PG8_STAGE(PG8_SA(0, 1), a2 + hstepA, voffA);
            PG8_WAIT_L(8); PG8_BAR; PG8_WAIT_L(0); PG8_MMA(0, 0, At, B0); PG8_BAR; PG8_SCHED;
            PG8_LDB(B1, 1, 1); PG8_STAGE(PG8_SB(1, 0), b3, voffB);
            PG8_BAR; PG8_WAIT_L(0); PG8_MMA(0, 1, At, B1); PG8_BAR;
            PG8_LDA(At, 1, 1); PG8_STAGE(PG8_SA(1, 0), a3, voffA);
            PG8_BAR; PG8_WAIT_L(0); PG8_MMA(1, 0, At, B0); PG8_BAR; PG8_SCHED;
            PG8_STAGE(PG8_SB(1, 1), b3 + hstepB, voffB);
            PG8_WAIT_V(6); PG8_BAR; PG8_MMA(1, 1, At, B1); PG8_BAR;
            }
        }
        if constexpr (ALIGN_EPI) { if (wr == 0) PG8_BAR; }
        mma_drain<is_fp8<Epi>::v>();
        if constexpr (!Epi::AFTER_DRAIN) { E(acc, cur, wr, wc, fr, fq); S.done(cur); }
        if (!has_next) break;
#pragma unroll
        for (int a = 0; a < 2; ++a)
#pragma unroll
            for (int b = 0; b < 2; ++b)
#pragma unroll
                for (int m = 0; m < 4; ++m)
#pragma unroll
                    for (int n = 0; n < 2; ++n) acc[a][b][m][n] = (acc_t){0, 0, 0, 0};
        cur = nxt; cA = nA; cB = nB; ++ui; if constexpr (Sched::VARK) nt = S.ktiles(cur);
        if constexpr (GATHER) { cv0[0] = nv0[0]; cv0[1] = nv0[1]; cv1[0] = nv1[0]; cv1[1] = nv1[1]; }
        if constexpr (ALIGN_EPI) { if (wr == 1) PG8_BAR; }
    }
    PG8_WAIT_V(0);
    if constexpr (!ALIGN_EPI) { if (wr == 0) PG8_BAR; }
    PG8_BAR;
    if constexpr (Epi::AFTER_DRAIN) { E.fused(acc, cur, wr, wc, fr, fq, lds, wid, lane); S.done(cur); }
#undef PG8_SA
#undef PG8_SB
#undef PG8_STAGE
#undef PG8_LDA
#undef PG8_LDB
#undef PG8_MMA
#undef PG8_WAIT_V
#undef PG8_WAIT_L
#undef PG8_BAR
#undef PG8_SCHED
#undef PG8_GIDX
}
}

constexpr int NB = 8, SEQ = 2048, NCTX = 256, D = 1024;
constexpr int ML = NB * SEQ, MC = NB * NCTX, MT = ML + MC;
constexpr int MIXIN = 2560, FFN = 2816, NE = 8, ED = 3584;
constexpr float EPS = 1e-6f;
constexpr int NWAVES = 8;
constexpr int MOE_TILES = 136;

constexpr size_t MiB = 1u << 20;
constexpr size_t WS_CTL = 0, CTL_ZERO_BYTES = 65536;
constexpr size_t WS_MOD = 65536, WS_MODP = 1 * MiB; constexpr int MOD_N = 2 * 9 * 6144;
constexpr size_t WS_ROWSS = 3 * MiB, WS_SHW13 = 4608 * 1024, WS_SHWS = WS_SHW13 + 9 * 5632 * 4;
constexpr size_t WS_ROWSC = 2800 * 1024, WS_POSSC = 2864 * 1024, WS_COLMAX = 4864 * 1024, WS_COLSC = WS_COLMAX;
constexpr size_t WS_COLSCD = WS_COLMAX + (size_t)NE * 2 * ED * 4, WS_PMAX = 376 * MiB, WS_ROWFAC1 = WS_POSSC;
constexpr size_t WS_COLSC2 = 4352 * 1024;
constexpr size_t WS_TOK = 5 * MiB;
constexpr size_t TOK_E = 0, TOK_W = 128 * 1024, TOK_RANK = 256 * 1024, TOK_POS = 384 * 1024, TOK_WGBASE = 512 * 1024, TOK_ROWGATE = 576 * 1024, TOK_ROWSRC = 720 * 1024, TOK_ROWINFO = 864 * 1024;
constexpr size_t WS_MW13 = 6 * MiB, WS_MW2 = 118 * MiB;
constexpr size_t WS_XL = 174 * MiB, WS_H = 238 * MiB, WS_XC = 274 * MiB;
constexpr size_t WS_WIN = 282 * MiB, WS_WOUT = 287 * MiB, WS_W13 = 289 * MiB, WS_W2 = 300 * MiB, WS_SIN = 306 * MiB, WS_SOUT = 308 * MiB;
constexpr size_t WS_BTOUT = 312 * MiB, WS_WEND = 360 * MiB, WS_R = 376 * MiB, WS_END = 512 * MiB;
constexpr size_t WS_QKVU = WS_R, WS_MIX = WS_R + 72 * MiB, WS_ACT = WS_R;
constexpr size_t WS_UC = WS_R, WS_E = WS_R + 72 * MiB, WS_Y = WS_R + 72 * MiB;
constexpr size_t WS_PX = WS_H;
constexpr size_t WS_ACTM = 274 * MiB;
static_assert(WS_ACTM + (size_t)MOE_TILES * 256 * ED * 2 <= WS_END && WS_XC + (size_t)MC * D * 4 <= WS_WIN && WS_H + (size_t)MT * D * 2 <= WS_XC && WS_MW2 + (size_t)NE * D * ED * 2 <= WS_XL, "d_ws map");
constexpr int CW_TMO = 0, CW_CODE = 1, CW_BAR = 4096, CW_GCNT = 8192;

constexpr int RING_OFF = 0, RING_BYTES = 131072;
constexpr int LDSCTL_OFF = 155648, MISC_OFF = LDSCTL_OFF + 320;
constexpr int LDS_BYTES = 159744;
static_assert(MISC_OFF + 128 <= LDS_BYTES, "LDS map");

#define GAS __attribute__((address_space(1)))
#define LAS __attribute__((address_space(3)))
typedef unsigned short bf16;
typedef unsigned v4u __attribute__((ext_vector_type(4)));
typedef unsigned v2u __attribute__((ext_vector_type(2)));
typedef float f32x4 __attribute__((ext_vector_type(4)));
typedef float f32x2 __attribute__((ext_vector_type(2)));
typedef float f32x16 __attribute__((ext_vector_type(16)));
typedef short bf16x8 __attribute__((ext_vector_type(8)));
typedef GAS unsigned gu32;
#define RLX_AGENT __ATOMIC_RELAXED, __HIP_MEMORY_SCOPE_AGENT
#define LDS_WAIT() asm volatile("s_waitcnt lgkmcnt(0)" ::: "memory")
#define VM_WAIT() asm volatile("s_waitcnt vmcnt(0)" ::: "memory")
__device__ __forceinline__ unsigned f2bf(float f) { unsigned u = __builtin_bit_cast(unsigned, f); return (u + 0x7fffu + ((u >> 16) & 1u)) >> 16; }
__device__ __forceinline__ unsigned pk2(float lo, float hi) { return f2bf(lo) | (f2bf(hi) << 16); }
__device__ __forceinline__ float bf2f(unsigned short h) { return __builtin_bit_cast(float, (unsigned)h << 16); }
__device__ __forceinline__ float bflo(unsigned w) { return __builtin_bit_cast(float, w << 16); }
__device__ __forceinline__ float bfhi(unsigned w) { return __builtin_bit_cast(float, w & 0xffff0000u); }
__device__ __forceinline__ float sigm(float x) { return __builtin_amdgcn_rcpf(1.0f + __expf(-x)); }
__device__ __forceinline__ float wave_sum(float v) {
#pragma unroll
    for (int o = 1; o < 64; o <<= 1) v += __shfl_xor(v, o);
    return v;
}
__device__ __forceinline__ float wave_max(float v) {
#pragma unroll
    for (int o = 1; o < 64; o <<= 1) v = fmaxf(v, __shfl_xor(v, o));
    return v;
}
#define XB_TMO      128
#define XB_XCNT(j)  (256  + 64 * (j))
#define XB_XSUB(j)  (1280 + 64 * (j))
#define XB_XGEN(j)  (2304 + 64 * (j))
#define XB_TOP      3328
#define XB_TOPGEN   3392
#define XCD_BAR_WORDS 3456
#define XB_SPIN_CAP (1u << 18)

__device__ __forceinline__ unsigned xb_ld(unsigned* p)              { return __hip_atomic_load(p, __ATOMIC_RELAXED, __HIP_MEMORY_SCOPE_AGENT); }
__device__ __forceinline__ unsigned xb_add(unsigned* p, unsigned v) { return __hip_atomic_fetch_add(p, v, __ATOMIC_RELAXED, __HIP_MEMORY_SCOPE_AGENT); }
__device__ __forceinline__ unsigned xb_xcc_id() { return (unsigned)__builtin_amdgcn_s_getreg((3 << 11) | 20) & 0xFu; }
#define XB_SPIN(cond, bar) do { unsigned _sp = 0; while (cond) { __builtin_amdgcn_s_sleep(1); \
    if ((++_sp & 255u) == 0u) { if (xb_ld(&(bar)[XB_TMO])) break; if (_sp > XB_SPIN_CAP) { atomicAdd(&(bar)[XB_TMO], 1u); break; } } } } while (0)

struct XcdBarrier {
    unsigned* bar; unsigned x;
    volatile LAS unsigned* st;
};

__device__ __forceinline__ XcdBarrier xcd_barrier_post(unsigned* bar, volatile LAS unsigned* st) {
    XcdBarrier b; b.bar = bar; b.x = xb_xcc_id(); b.st = st;
    if (threadIdx.x == 0) (void)xb_add(&bar[XB_XCNT(b.x)], 1u);
    return b;
}
__device__ __forceinline__ void xcd_barrier_complete(unsigned* bar, unsigned x, unsigned& nloc, unsigned& nx) {
    const unsigned G = gridDim.x * gridDim.y * gridDim.z;
    unsigned sum, cnt, mine, sp = 0u;
    for (;;) {
        sum = 0u; cnt = 0u; mine = 0u;
#pragma unroll
        for (unsigned j = 0; j < 16; ++j) { const unsigned c = xb_ld(&bar[XB_XCNT(j)]); sum += c; cnt += (c > 0u) ? 1u : 0u; mine = (j == x) ? c : mine; }
        if (sum == G) break;
        __builtin_amdgcn_s_sleep(1);
        if ((++sp & 255u) == 0u) { if (xb_ld(&bar[XB_TMO])) break; if (sp > XB_SPIN_CAP) { atomicAdd(&bar[XB_TMO], 1u); break; } }
    }
    nloc = mine > 0u ? mine : 1u; nx = cnt > 0u ? cnt : 1u;
}

__device__ __forceinline__ void xcd_barrier(const XcdBarrier& b) {
    asm volatile("s_waitcnt vmcnt(0)" ::: "memory");
    __syncthreads();
    if (threadIdx.x == 0) {
        unsigned* bar = b.bar;
        __builtin_amdgcn_s_waitcnt(0);
        unsigned nloc = b.st[0], nx = b.st[1];
        if (nloc == 0u) { xcd_barrier_complete(bar, b.x, nloc, nx); b.st[0] = nloc; b.st[1] = nx; }
        const unsigned old = xb_add(&bar[XB_XSUB(b.x)], 1u);
        const unsigned gen = old / nloc;
        if (old + 1u == (gen + 1u) * nloc) {
            __builtin_amdgcn_fence(__ATOMIC_RELEASE, "agent");
            asm volatile("s_waitcnt vmcnt(0)" ::: "memory");
            const unsigned og = xb_add(&bar[XB_TOP], 1u);
            const unsigned tg = og / nx;
            if (og + 1u == (tg + 1u) * nx) xb_add(&bar[XB_TOPGEN], 1u);
            else XB_SPIN(xb_ld(&bar[XB_TOPGEN]) == tg, bar);
            __builtin_amdgcn_fence(__ATOMIC_ACQUIRE, "agent");
            xb_add(&bar[XB_XGEN(b.x)], 1u);
            asm volatile("s_waitcnt vmcnt(0)" ::: "memory");
        } else {
            XB_SPIN(xb_ld(&bar[XB_XGEN(b.x)]) == gen, bar);
            __builtin_amdgcn_fence(__ATOMIC_ACQUIRE, "agent");
            asm volatile("s_waitcnt vmcnt(0)" ::: "memory");
        }
    }
    __syncthreads();
}
enum { I_X = 0, I_C, I_CTX, I_CCTX, I_ADAW, I_ADAB, I_N1G, I_N2G, I_MIXWIN, I_QG, I_KG, I_RPB, I_DWW, I_DWB, I_LNG, I_LNB, I_MIXWOUT, I_FW1, I_FW3, I_FW2,
       I_SWIN, I_ARE, I_AIM, I_LOGDT, I_BRE, I_BIM, I_CRE, I_CIM, I_SD, I_SWOUT, I_ROUTER, I_MW1, I_MW3, I_MW2, N_IN };
struct Args { const float* in[N_IN]; float* out; unsigned char* ws; int ph_lo, ph_hi, sub, pad; };

typedef short s16x4 __attribute__((ext_vector_type(4)));
typedef float f32x2_t __attribute__((ext_vector_type(2)));
typedef __bf16 bf16x2_t __attribute__((ext_vector_type(2)));
__device__ __forceinline__ unsigned cvtpk(float lo, float hi) { const f32x2_t v = {lo, hi}; const bf16x2_t b = __builtin_convertvector(v, bf16x2_t); return __builtin_bit_cast(unsigned, b); }
__device__ __forceinline__ s16x4 vtr(const LAS unsigned char* p) { return __builtin_bit_cast(s16x4, __builtin_amdgcn_ds_read_tr16_b64_v4i16((LAS s16x4*)p)); }
__device__ __forceinline__ void p0_adaln(const Args& A, int unit, LAS unsigned char* lds, int tid, int wave, int lane) {
    const int l = unit / 96, rem = unit % 96, cb = rem >> 2, kq = rem & 3;
    LAS float* sc = (LAS float*)lds;
    LAS float* part = sc + 9 * 256;
    const float* c = A.in[I_C]; const float* cc = A.in[I_CCTX];
    for (int i = tid; i < 9 * 256; i += NWAVES * 64) { const int r = i >> 8, k = 256 * kq + (i & 255); const float v = r < 8 ? c[r * 1024 + k] : cc[k]; sc[i] = v * sigm(v); }
    __syncthreads();
    const float* wp = A.in[I_ADAW] + (size_t)l * 1024 * 6144 + (size_t)(256 * kq + 32 * wave) * 6144 + 256 * cb + 4 * lane;
    float acc[9][4];
#pragma unroll
    for (int r = 0; r < 9; ++r)
#pragma unroll
        for (int j = 0; j < 4; ++j) acc[r][j] = 0.f;
#pragma unroll 8
    for (int it = 0; it < 32; ++it) {
        const f32x4 wv = *(const f32x4*)(wp + (size_t)it * 6144); const int k = 32 * wave + it;
#pragma unroll
        for (int r = 0; r < 9; ++r) { const float s = sc[r * 256 + k];
#pragma unroll
            for (int j = 0; j < 4; ++j) acc[r][j] += s * wv[j]; }
    }
#pragma unroll
    for (int r = 0; r < 9; ++r) *(LAS f32x4*)(part + (wave * 9 + r) * 256 + 4 * lane) = (f32x4){acc[r][0], acc[r][1], acc[r][2], acc[r][3]};
    __syncthreads();
    float* modp = (float*)(A.ws + WS_MODP) + (size_t)kq * MOD_N;
    for (int i = tid; i < 9 * 256; i += NWAVES * 64) { const int r = i >> 8, col = i & 255; float s = 0.f;
#pragma unroll
        for (int w = 0; w < 8; ++w) s += part[(w * 9 + r) * 256 + col];
        if (kq == 0) s += A.in[I_ADAB][l * 6144 + 256 * cb + col];
        modp[((size_t)l * 9 + r) * 6144 + 256 * cb + col] = s; }
    __syncthreads();
}
constexpr int KTS = 260;
__device__ __forceinline__ void p0_s5gen(const Args& A, int g, int part, LAS unsigned char* lds, int tid) {
    LAS f32x2* POW = (LAS f32x2*)lds;
    LAS float* BBr = (LAS float*)(POW + 2 * 64 * 33 + 8);
    LAS float* BBi = BBr + 2 * 64 * 16;
    LAS f32x2* CC = (LAS f32x2*)(BBi + 2 * 64 * 16);
    LAS f32x2* CT = CC + 2 * 16 * 66 + 8;
    LAS float* KT = (LAS float*)(CT + 2 * 64 * 16);
    LAS f32x2* FF = (LAS f32x2*)(KT + 63 * KTS);
#define PWI(d_, p_, m_) (((d_) * 64 + (p_)) * 33 + (m_) + ((p_) >> 5) + (d_) * 4)
#define CCI(d_, q_, p_) (((d_) * 16 + (q_)) * 66 + (p_) + ((p_) >> 5) + (d_) * 4)
    if (tid < 128) { const int d = tid >> 6, p = tid & 63, ix = (d * 64 + g) * 64 + p;
        const float ar = A.in[I_ARE][ix], ai = A.in[I_AIM][ix], dt = __expf(A.in[I_LOGDT][d * 64 + g]);
        const float zr = ar * dt, zi = ai * dt, mag = __expf(zr); const float lr = mag * cosf(zi), li = mag * sinf(zi);
        float pr = 1.f, pi = 0.f;
        for (int m = 0; m <= 32; ++m) { POW[PWI(d, p, m)] = (f32x2){pr, pi}; const float nr = pr * lr - pi * li, ni = pr * li + pi * lr; pr = nr; pi = ni; }
        const float nr = lr - 1.f, ni = li, den = 1.f / (ar * ar + ai * ai);
        FF[d * 64 + p] = (f32x2){(nr * ar + ni * ai) * den, (ni * ar - nr * ai) * den}; }
    __syncthreads();
    for (int i = tid; i < 2048; i += NWAVES * 64) { const int d = i >> 10, p = (i >> 4) & 63, q = i & 15; const int ix = ((d * 64 + g) * 64 + p) * 16 + q;
        const float br = A.in[I_BRE][ix], bi = A.in[I_BIM][ix]; const f32x2 f = FF[d * 64 + p];
        BBr[(d * 64 + p) * 16 + q] = f.x * br - f.y * bi; BBi[(d * 64 + p) * 16 + q] = f.x * bi + f.y * br; }
    for (int i = tid; i < 2048; i += NWAVES * 64) { const int d = i >> 10, q = (i >> 6) & 15, p = i & 63; const int ix = ((d * 64 + g) * 16 + q) * 64 + p;
        const f32x2 cv2 = (f32x2){A.in[I_CRE][ix], A.in[I_CIM][ix]}; CC[CCI(d, q, p)] = cv2; CT[(d * 64 + p) * 16 + q] = cv2; }
    __syncthreads();
    bf16* BtOut = (bf16*)(A.ws + WS_BTOUT) + (size_t)g * 512 * 768;
    bf16* WEnd = (bf16*)(A.ws + WS_WEND) + (size_t)g * 256 * 512;
    if (part == 0) {
#pragma unroll 1
    for (int d = 0; d < 2; ++d) {
        const int dl = tid >> 4, qo = tid & 15; float acc[16];
#pragma unroll
        for (int i = 0; i < 16; ++i) acc[i] = 0.f;
#pragma unroll 2
        for (int p = 0; p < 64; ++p) { const f32x2 c = CT[(d * 64 + p) * 16 + qo], w = POW[PWI(d, p, dl)]; const float tr = c.x * w.x - c.y * w.y, ti = c.x * w.y + c.y * w.x;
            const LAS f32x4* br = (const LAS f32x4*)(BBr + (d * 64 + p) * 16); const LAS f32x4* bi = (const LAS f32x4*)(BBi + (d * 64 + p) * 16);
#pragma unroll
            for (int q4 = 0; q4 < 4; ++q4) { const f32x4 r4 = br[q4], i4 = bi[q4];
#pragma unroll
                for (int j = 0; j < 4; ++j) acc[4 * q4 + j] += tr * r4[j] - ti * i4[j]; } }
        if (d == 0) {
            { const float dsk = (dl == 0) ? A.in[I_SD][g * 16 + qo] : 0.f;
#pragma unroll
              for (int i = 0; i < 16; ++i) acc[i] += (i == qo) ? dsk : 0.f; }
#pragma unroll
            for (int i = 0; i < 4; ++i) *(LAS f32x4*)(KT + (31 + dl) * KTS + qo * 16 + 4 * i) = (f32x4){acc[4 * i], acc[4 * i + 1], acc[4 * i + 2], acc[4 * i + 3]};
        } else {
#pragma unroll
            for (int i = 0; i < 4; ++i) { LAS f32x4* kp = (LAS f32x4*)(KT + (31 - dl) * KTS + qo * 16 + 4 * i); f32x4 v = (f32x4){acc[4 * i], acc[4 * i + 1], acc[4 * i + 2], acc[4 * i + 3]}; if (dl == 0) v = v + *kp; *kp = v; }
        }
        __syncthreads();
    }
    for (int pc = tid; pc < 512 * 64; pc += NWAVES * 64) {
        const int n = pc >> 6, kp = pc & 63, t = n >> 4, qo = n & 15, j = kp >> 1, qi0 = (kp & 1) * 8; const LAS float* s = KT + (t - j + 31) * KTS + qo * 16 + qi0;
        const f32x4 s0 = *(const LAS f32x4*)s, s1 = *(const LAS f32x4*)(s + 4);
        v4u o; o.x = cvtpk(s0.x, s0.y); o.y = cvtpk(s0.z, s0.w); o.z = cvtpk(s1.x, s1.y); o.w = cvtpk(s1.z, s1.w);
        *(v4u*)(BtOut + (size_t)n * 768 + kp * 8) = o; }
    } else {
    for (int pc = tid; pc < 512 * 32; pc += NWAVES * 64) {
        const int n = pc >> 5, kp = pc & 31, t = n >> 4, qo = n & 15, d = kp >> 4, ri = (kp >> 3) & 1, p0 = (kp & 7) * 8, m = d == 0 ? t + 1 : 32 - t; float v[8];
#pragma unroll
        for (int i = 0; i < 8; ++i) { const f32x2 c = CC[CCI(d, qo, p0 + i)], w = POW[PWI(d, p0 + i, m)]; v[i] = ri == 0 ? (c.x * w.x - c.y * w.y) : -(c.x * w.y + c.y * w.x); }
        v4u o; o.x = cvtpk(v[0], v[1]); o.y = cvtpk(v[2], v[3]); o.z = cvtpk(v[4], v[5]); o.w = cvtpk(v[6], v[7]);
        *(v4u*)(BtOut + (size_t)n * 768 + 512 + kp * 8) = o; }
    for (int pc = tid; pc < 256 * 64; pc += NWAVES * 64) {
        const int n = pc >> 6, kp = pc & 63, d = n >> 7, ri = (n >> 6) & 1, p = n & 63, j = kp >> 1, qi0 = (kp & 1) * 8, m = d == 0 ? 31 - j : j; const f32x2 w = POW[PWI(d, p, m)]; float v[8];
#pragma unroll
        for (int i = 0; i < 8; ++i) { const float br = BBr[(d * 64 + p) * 16 + qi0 + i], bi = BBi[(d * 64 + p) * 16 + qi0 + i]; v[i] = ri == 0 ? (w.x * br - w.y * bi) : (w.x * bi + w.y * br); }
        v4u o; o.x = cvtpk(v[0], v[1]); o.y = cvtpk(v[2], v[3]); o.z = cvtpk(v[4], v[5]); o.w = cvtpk(v[6], v[7]);
        *(v4u*)(WEnd + (size_t)n * 512 + kp * 8) = o; }
    }
    __syncthreads();
#undef PWI
#undef CCI
}
__device__ __forceinline__ void cvt_item(const float* W, int K, int N, int ldw, bf16* WT, int mode, int item, LAS float* scr, int lane, unsigned* colmax = nullptr, float* pmax = nullptr) {
    const int nblk = N / 32, kb = item / nblk, nb = item - kb * nblk, k0 = 64 * kb, n0 = 32 * nb;
    int r0 = n0;
    if (mode == 1) r0 = 256 * (n0 >> 7) + (n0 & 127);
    else if (mode == 2) r0 = 256 * (n0 >> 7) + 128 + (n0 & 127);
    else if (mode == 3) { if (n0 < 1536) { const int pn = n0 >> 8, rem = n0 & 255; r0 = 256 * pn + 128 * ((rem & 63) >> 5) + 32 * (rem >> 6); }
                          else if (n0 < 2048) { const int n1 = n0 - 1536; r0 = 256 * (6 + (n1 >> 7)) + (n1 & 127); }
                          else { const int n1 = n0 - 2048; r0 = 256 * (6 + (n1 >> 7)) + 128 + (n1 & 127); } }
    { f32x4 v[8];
#pragma unroll
      for (int i = 0; i < 8; ++i) v[i] = *(const f32x4*)(W + (size_t)(k0 + 8 * i + (lane >> 3)) * ldw + n0 + 4 * (lane & 7));
#pragma unroll
      for (int i = 0; i < 8; ++i) { LAS float* d = scr + (8 * i + (lane >> 3)) * 33 + 4 * (lane & 7); d[0] = v[i].x; d[1] = v[i].y; d[2] = v[i].z; d[3] = v[i].w; } }
    LDS_WAIT(); asm volatile("" ::: "memory");
    const int c = lane & 7;
#pragma unroll
    for (int j = 0; j < 4; ++j) { const int n = (lane >> 3) + 8 * j; const LAS float* s = scr + (8 * c) * 33 + n;
        v4u o; o.x = cvtpk(s[0 * 33], s[1 * 33]); o.y = cvtpk(s[2 * 33], s[3 * 33]); o.z = cvtpk(s[4 * 33], s[5 * 33]); o.w = cvtpk(s[6 * 33], s[7 * 33]);
        *(GAS v4u*)(WT + (size_t)(r0 + n) * K + k0 + 8 * c) = o;
        if (colmax || pmax) { float mx = fmaxf(fmaxf(fmaxf(fabsf(s[0 * 33]), fabsf(s[1 * 33])), fmaxf(fabsf(s[2 * 33]), fabsf(s[3 * 33]))), fmaxf(fmaxf(fabsf(s[4 * 33]), fabsf(s[5 * 33])), fmaxf(fabsf(s[6 * 33]), fabsf(s[7 * 33]))));
            mx = fmaxf(mx, __shfl_xor(mx, 1)); mx = fmaxf(mx, __shfl_xor(mx, 2)); mx = fmaxf(mx, __shfl_xor(mx, 4));
            if (c == 0) { if (colmax) __hip_atomic_fetch_max(colmax + r0 + n, __builtin_bit_cast(unsigned, mx), RLX_AGENT); else pmax[(size_t)(r0 + n) * (K / 64) + kb] = mx; } } }
    LDS_WAIT(); asm volatile("" ::: "memory");
}
constexpr int CV_IM = 16 * 112, CV_IM2 = 56 * 32, CV_NMOE = NE * (2 * CV_IM + CV_IM2);
__device__ __forceinline__ void p0_convert(const Args& A, LAS unsigned char* lds, int gw, int NGW, int wave, int lane) {
    LAS float* scr = (LAS float*)(lds + wave * 16384);
    unsigned char* ws = A.ws;
    constexpr int I0 = 16 * 80, I1 = 16 * 32, I2 = 16 * 88, I3 = 44 * 32, I4 = 16 * 32, I5 = 16 * 32;
    constexpr int NSMALL = I0 + I1 + 2 * I2 + I3 + I4 + 2 * I5;
    for (int it = gw; it < NSMALL; it += NGW) {
        int r = it;
        if (r < I0) { cvt_item(A.in[I_MIXWIN], D, MIXIN, MIXIN, (bf16*)(ws + WS_WIN), 3, r, scr, lane, nullptr, (float*)(ws + WS_PMAX)); continue; } r -= I0;
        if (r < I1) { cvt_item(A.in[I_MIXWOUT], D, D, D, (bf16*)(ws + WS_WOUT), 0, r, scr, lane); continue; } r -= I1;
        if (r < I2) { cvt_item(A.in[I_FW1], D, FFN, FFN, (bf16*)(ws + WS_W13), 1, r, scr, lane, nullptr, (float*)(ws + WS_PMAX) + MIXIN * 16); continue; } r -= I2;
        if (r < I2) { cvt_item(A.in[I_FW3], D, FFN, FFN, (bf16*)(ws + WS_W13), 2, r, scr, lane, nullptr, (float*)(ws + WS_PMAX) + MIXIN * 16); continue; } r -= I2;
        if (r < I3) { cvt_item(A.in[I_FW2], FFN, D, D, (bf16*)(ws + WS_W2), 0, r, scr, lane); continue; } r -= I3;
        if (r < I4) { cvt_item(A.in[I_SWIN], D, D, D, (bf16*)(ws + WS_SIN), 0, r, scr, lane); continue; } r -= I4;
        if (r < I5) { cvt_item(A.in[I_SWOUT], D, D, 2 * D, (bf16*)(ws + WS_SOUT), 1, r, scr, lane); continue; } r -= I5;
        cvt_item(A.in[I_SWOUT] + D, D, D, 2 * D, (bf16*)(ws + WS_SOUT), 2, r, scr, lane);
    }
}
__device__ __forceinline__ void moe_convert(const Args& A, LAS unsigned char* lds, int first, int count, int widx, int nw, int wave, int lane) {
    LAS float* scr = (LAS float*)(lds + wave * 16384);
    unsigned char* ws = A.ws;
    const int last = (first + count) < CV_NMOE ? (first + count) : CV_NMOE;
    for (int it = first + widx; it < last; it += nw) {
        int r = it; const int e = r / (2 * CV_IM + CV_IM2); r -= e * (2 * CV_IM + CV_IM2);
        if (r < CV_IM) { cvt_item(A.in[I_MW1] + (size_t)e * D * ED, D, ED, ED, (bf16*)(ws + WS_MW13) + (size_t)e * 2 * ED * D, 1, r, scr, lane, (unsigned*)(ws + WS_COLMAX) + e * 2 * ED); continue; } r -= CV_IM;
        if (r < CV_IM) { cvt_item(A.in[I_MW3] + (size_t)e * D * ED, D, ED, ED, (bf16*)(ws + WS_MW13) + (size_t)e * 2 * ED * D, 2, r, scr, lane, (unsigned*)(ws + WS_COLMAX) + e * 2 * ED); continue; } r -= CV_IM;
        cvt_item(A.in[I_MW2] + (size_t)e * ED * D, ED, D, D, (bf16*)(ws + WS_MW2) + (size_t)e * D * ED, 0, r, scr, lane);
    }
}
__device__ __forceinline__ void shw_rows(const bf16* WT, int N, const float* sh, float* out, int widx, int nw, LAS unsigned char* lds, int tid, int lane, const float* colscale = nullptr) {
    LAS float* shl = (LAS float*)lds;
    __syncthreads();
    for (int i = tid; i < 9 * 1024; i += NWAVES * 64) shl[i] = sh[(size_t)(i >> 10) * 6144 + (i & 1023)];
    __syncthreads();
    for (int p = widx; p < N; p += nw) {
        float w[16];
        if (colscale) { const v4u q = *(const v4u*)((const unsigned char*)(WT + (size_t)p * D) + 16 * lane); const float cs = colscale[p]; const unsigned qq[4] = {q.x, q.y, q.z, q.w};
#pragma unroll
            for (int i = 0; i < 16; ++i) w[i] = (float)(int)(signed char)((qq[i >> 2] >> (8 * (i & 3))) & 255u) * cs; }
        else { const v4u w0 = *(const v4u*)(WT + (size_t)p * D + 16 * lane), w1 = *(const v4u*)(WT + (size_t)p * D + 16 * lane + 8);
            const float t[16] = {bflo(w0.x), bfhi(w0.x), bflo(w0.y), bfhi(w0.y), bflo(w0.z), bfhi(w0.z), bflo(w0.w), bfhi(w0.w), bflo(w1.x), bfhi(w1.x), bflo(w1.y), bfhi(w1.y), bflo(w1.z), bfhi(w1.z), bflo(w1.w), bfhi(w1.w)};
#pragma unroll
            for (int i = 0; i < 16; ++i) w[i] = t[i]; }
        float s[9];
#pragma unroll
        for (int b = 0; b < 9; ++b) { const LAS f32x4* sp = (const LAS f32x4*)(shl + b * 1024 + 16 * lane); float a = 0.f;
#pragma unroll
            for (int q = 0; q < 4; ++q) { const f32x4 v = sp[q]; a += (v.x * w[4 * q] + v.y * w[4 * q + 1]) + (v.z * w[4 * q + 2] + v.w * w[4 * q + 3]); }
            s[b] = a; }
#pragma unroll
        for (int b = 0; b < 9; ++b) s[b] = wave_sum(s[b]);
        if (lane < 9) { float v = s[0];
#pragma unroll
            for (int b = 1; b < 9; ++b) v = (lane == b) ? s[b] : v;
            out[(size_t)lane * N + p] = v; }
    }
    __syncthreads();
}
__device__ __forceinline__ unsigned q8pack(float a, float b, float c, float d) { const int ia = (int)rintf(a), ib = (int)rintf(b), ic = (int)rintf(c), id = (int)rintf(d);
    return (unsigned)(ia & 255) | ((unsigned)(ib & 255) << 8) | ((unsigned)(ic & 255) << 16) | ((unsigned)(id & 255) << 24); }
__device__ __forceinline__ void quant_rows_inplace(bf16* W, unsigned* colmax, int nrows, int gw, int NGW, int lane) {
    for (int r0 = gw; r0 < nrows; r0 += 2 * NGW) {
        const int r1 = (r0 + NGW < nrows) ? r0 + NGW : r0; const int nr = (r0 + NGW < nrows) ? 2 : 1;
        v4u a[2][2]; float mx[2];
#pragma unroll
        for (int u = 0; u < 2; ++u) { const int r = u ? r1 : r0; const bf16* rp = W + (size_t)r * 1024 + 16 * lane; a[u][0] = *(const v4u*)rp; a[u][1] = *(const v4u*)(rp + 8); mx[u] = __builtin_bit_cast(float, colmax[r]); }
        asm volatile("s_waitcnt vmcnt(0)" ::: "memory");
#pragma unroll
        for (int u = 0; u < 2; ++u) { if (u < nr) { const int r = u ? r1 : r0; const float inv = mx[u] > 0.f ? 127.0f / mx[u] : 0.f; v4u o;
            o.x = q8pack(bflo(a[u][0].x) * inv, bfhi(a[u][0].x) * inv, bflo(a[u][0].y) * inv, bfhi(a[u][0].y) * inv); o.y = q8pack(bflo(a[u][0].z) * inv, bfhi(a[u][0].z) * inv, bflo(a[u][0].w) * inv, bfhi(a[u][0].w) * inv);
            o.z = q8pack(bflo(a[u][1].x) * inv, bfhi(a[u][1].x) * inv, bflo(a[u][1].y) * inv, bfhi(a[u][1].y) * inv); o.w = q8pack(bflo(a[u][1].z) * inv, bfhi(a[u][1].z) * inv, bflo(a[u][1].w) * inv, bfhi(a[u][1].w) * inv);
            *(v4u*)((unsigned char*)(W + (size_t)r * 1024) + 16 * lane) = o;
            if (lane == 0) ((float*)colmax)[r] = mx[u] * (1.0f / 127.0f); } }
    }
}
__device__ __forceinline__ void quant_rows_f8_inplace(bf16* W, float* scale, int nrows, int gw, int NGW, int lane) {
    for (int r0 = gw; r0 < nrows; r0 += 2 * NGW) {
        const int r1 = (r0 + NGW < nrows) ? r0 + NGW : r0; const int nr = (r0 + NGW < nrows) ? 2 : 1;
        v4u a[2][7];
#pragma unroll
        for (int u = 0; u < 2; ++u) { const bf16* rp = W + (size_t)(u ? r1 : r0) * 3584 + 8 * lane;
#pragma unroll
            for (int c = 0; c < 7; ++c) a[u][c] = *(const v4u*)(rp + 512 * c); }
        asm volatile("s_waitcnt vmcnt(0)" ::: "memory");
#pragma unroll
        for (int u = 0; u < 2; ++u) { if (u < nr) { const int r = u ? r1 : r0; float am = 0.f;
#pragma unroll
            for (int c = 0; c < 7; ++c) { am = fmaxf(am, fmaxf(fmaxf(fabsf(bflo(a[u][c].x)), fabsf(bfhi(a[u][c].x))), fmaxf(fabsf(bflo(a[u][c].y)), fabsf(bfhi(a[u][c].y)))));
                am = fmaxf(am, fmaxf(fmaxf(fabsf(bflo(a[u][c].z)), fabsf(bfhi(a[u][c].z))), fmaxf(fabsf(bflo(a[u][c].w)), fabsf(bfhi(a[u][c].w))))); }
            am = wave_max(am); const float inv = am > 0.f ? 448.0f / am : 0.f;
#pragma unroll
            for (int c = 0; c < 7; ++c) { v2u o;
                o.x = pg8::f8pack4((f32x4){bflo(a[u][c].x), bfhi(a[u][c].x), bflo(a[u][c].y), bfhi(a[u][c].y)} * inv); o.y = pg8::f8pack4((f32x4){bflo(a[u][c].z), bfhi(a[u][c].z), bflo(a[u][c].w), bfhi(a[u][c].w)} * inv);
                *(v2u*)((unsigned char*)(W + (size_t)r * 3584) + 8 * lane + 512 * c) = o; }
            if (lane == 0) scale[r] = am * (1.0f / 448.0f); } }
    }
}
__device__ __forceinline__ void quant_rows_inplace_p(bf16* W, const float* pmax, float* colscale, int nrows, int gw, int NGW, int lane) {
    for (int r = gw; r < nrows; r += NGW) {
        const bf16* rp = W + (size_t)r * 1024 + 16 * lane; const v4u a0 = *(const v4u*)rp, a1 = *(const v4u*)(rp + 8);
        const float mx = wave_max(pmax[(size_t)r * 16 + (lane & 15)]);
        asm volatile("s_waitcnt vmcnt(0)" ::: "memory");
        const float inv = mx > 0.f ? 127.0f / mx : 0.f; v4u o;
        o.x = q8pack(bflo(a0.x) * inv, bfhi(a0.x) * inv, bflo(a0.y) * inv, bfhi(a0.y) * inv); o.y = q8pack(bflo(a0.z) * inv, bfhi(a0.z) * inv, bflo(a0.w) * inv, bfhi(a0.w) * inv);
        o.z = q8pack(bflo(a1.x) * inv, bfhi(a1.x) * inv, bflo(a1.y) * inv, bfhi(a1.y) * inv); o.w = q8pack(bflo(a1.z) * inv, bfhi(a1.z) * inv, bflo(a1.w) * inv, bfhi(a1.w) * inv);
        *(v4u*)((unsigned char*)(W + (size_t)r * 1024) + 16 * lane) = o;
        if (lane == 0) colscale[r] = mx * (1.0f / 127.0f);
    }
}
__device__ __forceinline__ void quant_act_rows(bf16* Hb, const float* rowss, float* rowfac, int nrows, int gw, int NGW, int lane) {
    for (int r0 = gw; r0 < nrows; r0 += 2 * NGW) {
        const int r1 = (r0 + NGW < nrows) ? r0 + NGW : r0; const int nr = (r0 + NGW < nrows) ? 2 : 1;
        v4u a[2][2]; float ssq[2];
#pragma unroll
        for (int u = 0; u < 2; ++u) { const int r = u ? r1 : r0; const bf16* rp = Hb + (size_t)r * 1024 + 16 * lane; a[u][0] = *(const v4u*)rp; a[u][1] = *(const v4u*)(rp + 8); ssq[u] = rowss[(size_t)r * 16 + (lane & 15)]; }
        asm volatile("s_waitcnt vmcnt(0)" ::: "memory");
#pragma unroll
        for (int u = 0; u < 2; ++u) { if (u < nr) { const int r = u ? r1 : r0;
            const float v[16] = {bflo(a[u][0].x), bfhi(a[u][0].x), bflo(a[u][0].y), bfhi(a[u][0].y), bflo(a[u][0].z), bfhi(a[u][0].z), bflo(a[u][0].w), bfhi(a[u][0].w),
                                 bflo(a[u][1].x), bfhi(a[u][1].x), bflo(a[u][1].y), bfhi(a[u][1].y), bflo(a[u][1].z), bfhi(a[u][1].z), bflo(a[u][1].w), bfhi(a[u][1].w)};
            float am = 0.f;
#pragma unroll
            for (int i = 0; i < 16; ++i) am = fmaxf(am, fabsf(v[i]));
            am = wave_max(am); const float inv = am > 0.f ? 127.0f / am : 0.f;
            float sq = (lane < 16) ? ssq[u] : 0.f; sq = wave_sum(sq);
            v4u o; o.x = q8pack(v[0] * inv, v[1] * inv, v[2] * inv, v[3] * inv); o.y = q8pack(v[4] * inv, v[5] * inv, v[6] * inv, v[7] * inv);
            o.z = q8pack(v[8] * inv, v[9] * inv, v[10] * inv, v[11] * inv); o.w = q8pack(v[12] * inv, v[13] * inv, v[14] * inv, v[15] * inv);
            *(v4u*)((unsigned char*)(Hb + (size_t)r * 1024) + 16 * lane) = o;
            if (lane == 0) rowfac[r] = rsqrtf(sq * (1.0f / 1024.0f) + EPS) * am * (1.0f / 127.0f); } }
    }
}
template <int NPART> __device__ __forceinline__ void norm_row_finish(const f32x4 (&v)[4], int row, const float* gain, const float* mod, int shc, int scc, bf16* H, int lane) {
    const float* mp = mod + (size_t)(row < ML ? (row >> 11) : 8) * 6144; float ss = 0.f;
#pragma unroll
    for (int j = 0; j < 4; ++j) ss += (v[j].x * v[j].x + v[j].y * v[j].y) + (v[j].z * v[j].z + v[j].w * v[j].w);
    const float rstd = rsqrtf(wave_sum(ss) * (1.0f / D) + EPS);
#pragma unroll
    for (int j = 0; j < 4; ++j) { const int k = 4 * lane + 256 * j; const f32x4 gg = *(const f32x4*)(gain + k); f32x4 sc = *(const f32x4*)(mp + scc * 1024 + k), sh = *(const f32x4*)(mp + shc * 1024 + k);
#pragma unroll
        for (int q = 1; q < NPART; ++q) { sc = sc + *(const f32x4*)(mp + (size_t)q * MOD_N + scc * 1024 + k); sh = sh + *(const f32x4*)(mp + (size_t)q * MOD_N + shc * 1024 + k); }
        const f32x4 h = v[j] * rstd * gg * (sc + 1.0f) + sh;
        v2u o; o.x = cvtpk(h.x, h.y); o.y = cvtpk(h.z, h.w); *(v2u*)(H + (size_t)row * D + k) = o; }
}
__device__ __forceinline__ void norm_rows_lds(const float* xL, const float* xC, int nrows, const float* gain, const LAS float* ms, bf16* H, float* rowfac, int gw, int NGW, int lane) {
    for (int row = gw; row < nrows; row += 2 * NGW) {
        const int row1 = row + NGW; const bool two = row1 < nrows; const int r1 = two ? row1 : row;
        const float* xa = row < ML ? xL + (size_t)row * D : xC + (size_t)(row - ML) * D; const float* xb = r1 < ML ? xL + (size_t)r1 * D : xC + (size_t)(r1 - ML) * D;
        f32x4 vv[2][4];
#pragma unroll
        for (int j = 0; j < 4; ++j) { vv[0][j] = *(const f32x4*)(xa + 4 * lane + 256 * j); vv[1][j] = *(const f32x4*)(xb + 4 * lane + 256 * j); }
#pragma unroll
        for (int u = 0; u < 2; ++u) { if (u == 1 && !two) break; const int rw = u ? row1 : row; const LAS float* mp = ms + (rw < ML ? (rw >> 11) : 8) * 2048; float ss = 0.f;
#pragma unroll
            for (int j = 0; j < 4; ++j) ss += (vv[u][j].x * vv[u][j].x + vv[u][j].y * vv[u][j].y) + (vv[u][j].z * vv[u][j].z + vv[u][j].w * vv[u][j].w);
            const float rstd = rsqrtf(wave_sum(ss) * (1.0f / D) + EPS);
            f32x4 hq[4]; float am = 0.f;
#pragma unroll
            for (int j = 0; j < 4; ++j) { const int k = 4 * lane + 256 * j; const f32x4 gg = *(const f32x4*)(gain + k), sh = *(const LAS f32x4*)(mp + k), sc = *(const LAS f32x4*)(mp + 1024 + k);
                const f32x4 h = vv[u][j] * rstd * gg * (sc + 1.0f) + sh; hq[j] = h; am = fmaxf(am, fmaxf(fmaxf(fabsf(h.x), fabsf(h.y)), fmaxf(fabsf(h.z), fabsf(h.w)))); }
            am = wave_max(am); const float inv = am > 0.f ? 127.0f / am : 0.f;
#pragma unroll
            for (int j = 0; j < 4; ++j) *(unsigned*)((unsigned char*)H + (size_t)rw * D + 4 * lane + 256 * j) = q8pack(hq[j].x * inv, hq[j].y * inv, hq[j].z * inv, hq[j].w * inv);
            if (lane == 0) rowfac[rw] = am * (1.0f / 127.0f); }
    }
}
template <int NPART> __device__ __forceinline__ void norm_rows(const float* xL, const float* xC, int nrows, const float* gain, const float* mod, int shc, int scc, bf16* H, int gw, int NGW, int lane) {
    for (int row = gw; row < nrows; row += 2 * NGW) {
        const int row1 = row + NGW; const bool two = row1 < nrows; const int r1 = two ? row1 : row;
        const float* xa = row < ML ? xL + (size_t)row * D : xC + (size_t)(row - ML) * D; const float* xb = r1 < ML ? xL + (size_t)r1 * D : xC + (size_t)(r1 - ML) * D;
        f32x4 va[4], vb[4];
#pragma unroll
        for (int j = 0; j < 4; ++j) { va[j] = *(const f32x4*)(xa + 4 * lane + 256 * j); vb[j] = *(const f32x4*)(xb + 4 * lane + 256 * j); }
        norm_row_finish<NPART>(va, row, gain, mod, shc, scc, H, lane);
        if (two) norm_row_finish<NPART>(vb, row1, gain, mod, shc, scc, H, lane);
    }
}
constexpr int VSTR = 144;
__device__ __forceinline__ void attn_unit(const bf16* QKVU, bf16* MIX, int wu, LAS unsigned char* vl, LAS unsigned char* ql, const LAS float* rpbl, float bnd, int lane) {
    const bool isctx = wu >= 2048;
    int b, h, r = 0, qrow0;
    if (!isctx) { h = wu & 7; r = (wu >> 3) & 31; b = wu >> 8; qrow0 = b * SEQ + r * 64; }
    else { const int w = wu - 2048; h = w & 7; b = w >> 5; qrow0 = ML + b * NCTX + 64 * ((w >> 3) & 3); }
    const int c = lane & 31, hh = lane >> 5;
    const int rs = r < 4 ? 0 : (r > 28 ? 24 : r - 4);
    const int csA = c < 8 ? 0 : c - 8;
    const int csB = c > 24 ? 48 : c + 24;
    const LAS unsigned char* vtb = vl + (4 * hh + ((lane & 15) >> 2)) * VSTR + 32 * ((lane >> 4) & 1) + 8 * (lane & 3);
    LAS unsigned char* qs = ql + c * 128 + 16 * hh;
    { const bf16* qp = QKVU + (size_t)(qrow0 + c) * 2048 + h * 64 + 8 * hh;
#pragma unroll
      for (int s = 0; s < 4; ++s) { *(LAS bf16x8*)(qs + 32 * s) = *(const bf16x8*)(qp + 16 * s); *(LAS bf16x8*)(qs + 4096 + 32 * s) = *(const bf16x8*)(qp + (size_t)32 * 2048 + 16 * s); } }
    f32x16 oA0, oA1, oB0, oB1;
#pragma unroll
    for (int i = 0; i < 16; ++i) { oA0[i] = 0.f; oA1[i] = 0.f; oB0[i] = 0.f; oB1[i] = 0.f; }
    float lsA = 0.f, lsB = 0.f;
    const int nblk = isctx ? 8 : 24;
    const bf16* kbase = QKVU + 512 + h * 64 + 8 * hh + (size_t)c * 2048;
    const bf16* vbase = QKVU + 1024 + h * 64 + 8 * (lane & 7) + (size_t)(lane >> 3) * 2048;
#define ATT_KROW0(kb_) (((!isctx) && (kb_) < 16) ? (b * SEQ + (rs + ((kb_) >> 1)) * 64 + 32 * ((kb_) & 1)) : (ML + b * NCTX + 32 * (isctx ? (kb_) : (kb_) - 16)))
#define ATT_LOADK(KF, kb_) do { const int kq_ = (kb_) < nblk ? (kb_) : nblk - 1; const size_t ro_ = (size_t)ATT_KROW0(kq_) * 2048; \
        _Pragma("unroll") for (int s_ = 0; s_ < 4; ++s_) KF[s_] = *(const bf16x8*)(kbase + ro_ + 16 * s_); } while (0)
#define ATT_LOADV(VF, kb_) do { const int kq_ = (kb_) < nblk ? (kb_) : nblk - 1; const size_t ro_ = (size_t)ATT_KROW0(kq_) * 2048; \
        _Pragma("unroll") for (int i_ = 0; i_ < 4; ++i_) VF[i_] = *(const v4u*)(vbase + ro_ + (size_t)i_ * 8 * 2048); } while (0)
#define ATT_PACK(PF, P) do { _Pragma("unroll") for (int s = 0; s < 2; ++s) { v4u w; w.x = cvtpk(P[8 * s], P[8 * s + 1]); w.y = cvtpk(P[8 * s + 2], P[8 * s + 3]); w.z = cvtpk(P[8 * s + 4], P[8 * s + 5]); w.w = cvtpk(P[8 * s + 6], P[8 * s + 7]); PF[s] = __builtin_bit_cast(bf16x8, w); } } while (0)
#define ATT_BLOCK(KF, VF, kb_) do { const int kb = (kb_); const bool live = kb < nblk; const bool band = (!isctx) && kb < 16; const int kr = rs + (kb >> 1); \
        _Pragma("unroll") for (int i = 0; i < 4; ++i) { const int id = lane + 64 * i; *(LAS v4u*)(vl + (id >> 3) * VSTR + (id & 7) * 16) = VF[i]; } \
        ATT_LOADV(VF, kb + 1);              \
        f32x16 sA, sB; \
        _Pragma("unroll") for (int i = 0; i < 16; ++i) { sA[i] = 0.f; sB[i] = 0.f; } \
        _Pragma("unroll") for (int s = 0; s < 4; ++s) { sA = __builtin_amdgcn_mfma_f32_32x32x16_bf16(KF[s], *(const LAS bf16x8*)(qs + 32 * s), sA, 0, 0, 0); \
                                                        sB = __builtin_amdgcn_mfma_f32_32x32x16_bf16(KF[s], *(const LAS bf16x8*)(qs + 4096 + 32 * s), sB, 0, 0, 0); } \
        ATT_LOADK(KF, kb + 1);              \
        float pA[16], pB[16]; \
        if (band) { const int kc0 = 32 * (kb & 1) + 4 * hh; const LAS float* rb = rpbl + h * 465 + (kr - r + 7) * 31 + (kc0 - c); \
              \
            float bA[16], bB[16]; \
            _Pragma("unroll") for (int i = 0; i < 16; ++i) { bA[i] = rb[15 + (i & 3) + 8 * (i >> 2)]; bB[i] = rb[(i & 3) + 8 * (i >> 2) - 17]; } \
            const int tA = kc0 - csA, tB = kc0 - csB; \
            _Pragma("unroll") for (int i = 0; i < 16; ++i) { const int o = (i & 3) + 8 * (i >> 2); \
                { const bool ok = (unsigned)(tA + o) < 16u; const float e = __builtin_amdgcn_exp2f(sA[i] * 0.18033688f + bA[i]); pA[i] = ok ? e : 0.f; } \
                { const bool ok = (unsigned)(tB + o) < 16u; const float e = __builtin_amdgcn_exp2f(sB[i] * 0.18033688f + bB[i]); pB[i] = ok ? e : 0.f; } } \
        } else { \
            _Pragma("unroll") for (int i = 0; i < 16; ++i) { const float ea = __builtin_amdgcn_exp2f(sA[i] * 0.18033688f - bnd), eb = __builtin_amdgcn_exp2f(sB[i] * 0.18033688f - bnd); pA[i] = live ? ea : 0.f; pB[i] = live ? eb : 0.f; } } \
        _Pragma("unroll") for (int i = 0; i < 16; ++i) { lsA += pA[i]; lsB += pB[i]; } \
        bf16x8 fA[2], fB[2]; ATT_PACK(fA, pA); ATT_PACK(fB, pB); \
        LDS_WAIT(); \
        _Pragma("unroll") for (int dt = 0; dt < 2; ++dt) \
            _Pragma("unroll") for (int s = 0; s < 2; ++s) { \
                const s16x4 lo = vtr(vtb + (16 * s) * VSTR + 64 * dt), hi = vtr(vtb + (16 * s + 8) * VSTR + 64 * dt); \
                const bf16x8 af = (bf16x8){lo[0], lo[1], lo[2], lo[3], hi[0], hi[1], hi[2], hi[3]}; \
                if (dt == 0) { oA0 = __builtin_amdgcn_mfma_f32_32x32x16_bf16(af, fA[s], oA0, 0, 0, 0); oB0 = __builtin_amdgcn_mfma_f32_32x32x16_bf16(af, fB[s], oB0, 0, 0, 0); } \
                else { oA1 = __builtin_amdgcn_mfma_f32_32x32x16_bf16(af, fA[s], oA1, 0, 0, 0); oB1 = __builtin_amdgcn_mfma_f32_32x32x16_bf16(af, fB[s], oB1, 0, 0, 0); } } \
        } while (0)
    bf16x8 kA[4]; v4u vA[4];
    ATT_LOADK(kA, 0); ATT_LOADV(vA, 0);
    for (int kb1 = 0; kb1 < nblk; ++kb1) ATT_BLOCK(kA, vA, kb1);
#undef ATT_KROW0
#undef ATT_LOADK
#undef ATT_LOADV
#undef ATT_PACK
#undef ATT_BLOCK
    lsA += __shfl_xor(lsA, 32); lsB += __shfl_xor(lsB, 32);
    const float iA = 1.0f / lsA, iB = 1.0f / lsB;
    bf16* op = MIX + (size_t)(qrow0 + c) * D + h * 64 + 4 * hh; bf16* oq = op + (size_t)32 * D;
#pragma unroll
    for (int i4 = 0; i4 < 4; ++i4) {
        v2u w0; w0.x = cvtpk(oA0[4 * i4] * iA, oA0[4 * i4 + 1] * iA); w0.y = cvtpk(oA0[4 * i4 + 2] * iA, oA0[4 * i4 + 3] * iA); *(v2u*)(op + 8 * i4) = w0;
        v2u w1; w1.x = cvtpk(oA1[4 * i4] * iA, oA1[4 * i4 + 1] * iA); w1.y = cvtpk(oA1[4 * i4 + 2] * iA, oA1[4 * i4 + 3] * iA); *(v2u*)(op + 32 + 8 * i4) = w1;
        v2u w2; w2.x = cvtpk(oB0[4 * i4] * iB, oB0[4 * i4 + 1] * iB); w2.y = cvtpk(oB0[4 * i4 + 2] * iB, oB0[4 * i4 + 3] * iB); *(v2u*)(oq + 8 * i4) = w2;
        v2u w3; w3.x = cvtpk(oB1[4 * i4] * iB, oB1[4 * i4 + 1] * iB); w3.y = cvtpk(oB1[4 * i4 + 2] * iB, oB1[4 * i4 + 3] * iB); *(v2u*)(oq + 32 + 8 * i4) = w3; }
}
template <int P0, int NP> __device__ __forceinline__ void conv_chunk(float (&acc)[32], const float (&w)[31], const __amdgpu_buffer_rsrc_t rsrc, int voff, int t0, int len) {
    float v[NP];
#pragma unroll
    for (int i = 0; i < NP; ++i) { const int t = t0 - 15 + P0 + i, tc = t < 0 ? 0 : (t >= len ? len - 1 : t); const int so = __builtin_amdgcn_readfirstlane(tc * 4096);
        const float x = bf2f(__builtin_amdgcn_raw_buffer_load_b16(rsrc, voff, so, 0)); v[i] = (t == tc) ? x : 0.f; }
#pragma unroll
    for (int i = 0; i < NP; ++i)
#pragma unroll
        for (int tt = 0; tt < 32; ++tt) { if (P0 + i - tt >= 0 && P0 + i - tt <= 30) acc[tt] += v[i] * w[(P0 + i - tt >= 0 && P0 + i - tt <= 30) ? P0 + i - tt : 0]; }
}
__device__ __forceinline__ void conv_item(const Args& A, const bf16* QKVU, bf16* MIX, int item, LAS float* cv, int tid, int wave, int lane) {
    __syncthreads();
    int rowbase, len, t0;
    if (item < 512) { rowbase = (item >> 6) * SEQ; len = SEQ; t0 = 32 * (item & 63); } else { const int i2 = item - 512; rowbase = ML + (i2 >> 3) * NCTX; len = NCTX; t0 = 32 * (i2 & 7); }
    const int ch = tid;
    float w[31], acc[32];
    { const __amdgpu_buffer_rsrc_t wrs = __builtin_amdgcn_make_buffer_rsrc((void*)A.in[I_DWW], 0, 31 * 512 * 4, 0x00020000);
#pragma unroll
      for (int k = 0; k < 31; ++k) w[k] = __builtin_bit_cast(float, __builtin_amdgcn_raw_buffer_load_b32(wrs, 4 * ch, k * 2048, 0)); }
    const float bias = A.in[I_DWB][ch];
#pragma unroll
    for (int t = 0; t < 32; ++t) acc[t] = bias;
    const __amdgpu_buffer_rsrc_t rsrc = __builtin_amdgcn_make_buffer_rsrc((void*)(QKVU + (size_t)rowbase * 2048 + 1536), 0, len * 4096, 0x00020000);
    conv_chunk<0, 16>(acc, w, rsrc, 2 * ch, t0, len); conv_chunk<16, 16>(acc, w, rsrc, 2 * ch, t0, len); conv_chunk<32, 16>(acc, w, rsrc, 2 * ch, t0, len); conv_chunk<48, 14>(acc, w, rsrc, 2 * ch, t0, len);
#pragma unroll
    for (int t = 0; t < 32; ++t) cv[t * 512 + ch] = acc[t];
    __syncthreads();
    const f32x4 g0 = *(const f32x4*)(A.in[I_LNG] + 8 * lane), g1 = *(const f32x4*)(A.in[I_LNG] + 8 * lane + 4), b0 = *(const f32x4*)(A.in[I_LNB] + 8 * lane), b1 = *(const f32x4*)(A.in[I_LNB] + 8 * lane + 4);
#pragma unroll
    for (int q = 0; q < 4; ++q) { const int tt = 4 * wave + q;
        f32x4 x0 = *(const LAS f32x4*)(cv + tt * 512 + 8 * lane), x1 = *(const LAS f32x4*)(cv + tt * 512 + 8 * lane + 4);
        const float mean = wave_sum((x0.x + x0.y) + (x0.z + x0.w) + (x1.x + x1.y) + (x1.z + x1.w)) * (1.0f / 512.0f);
        x0 = x0 - mean; x1 = x1 - mean;
        const float var = wave_sum((x0.x * x0.x + x0.y * x0.y) + (x0.z * x0.z + x0.w * x0.w) + (x1.x * x1.x + x1.y * x1.y) + (x1.z * x1.z + x1.w * x1.w)) * (1.0f / 512.0f);
        const float rstd = rsqrtf(var + EPS);
        f32x4 y0 = x0 * rstd * g0 + b0, y1 = x1 * rstd * g1 + b1;
        y0 = (f32x4){y0.x * sigm(y0.x), y0.y * sigm(y0.y), y0.z * sigm(y0.z), y0.w * sigm(y0.w)}; y1 = (f32x4){y1.x * sigm(y1.x), y1.y * sigm(y1.y), y1.z * sigm(y1.z), y1.w * sigm(y1.w)};
        v4u o; o.x = cvtpk(y0.x, y0.y); o.y = cvtpk(y0.z, y0.w); o.z = cvtpk(y1.x, y1.y); o.w = cvtpk(y1.z, y1.w);
        *(v4u*)(MIX + (size_t)(rowbase + t0 + tt) * D + 512 + 8 * lane) = o; }
    __syncthreads();
}
__device__ __forceinline__ void s5_scan(const Args& A, int gt) {
    if (gt >= NB * 64 * 2 * 64) return;
    const int p = gt & 63, d = (gt >> 6) & 1, g = (gt >> 7) & 63, b = gt >> 13;
    const int ix = (d * 64 + g) * 64 + p;
    const float ar = A.in[I_ARE][ix], ai = A.in[I_AIM][ix], dt = __expf(A.in[I_LOGDT][d * 64 + g]);
    const float zr = ar * dt, zi = ai * dt, mag = __expf(zr); float lr = mag * cosf(zi), li = mag * sinf(zi);
#pragma unroll
    for (int k = 0; k < 5; ++k) { const float nr = lr * lr - li * li, ni = 2.f * lr * li; lr = nr; li = ni; }
    const float* E = (const float*)(A.ws + WS_E) + (size_t)g * 768 * 256 + d * 128 + p;
    bf16* UC = (bf16*)(A.ws + WS_UC) + (size_t)g * 768 * 768 + 512 + d * 128 + p;
    float sr = 0.f, si = 0.f;
    for (int s0 = 0; s0 < 72; s0 += 24) {
        float er[24], ei[24]; int bcs[24];
#pragma unroll
        for (int k = 0; k < 24; ++k) { const int step = s0 + k; int bc;
            if (step < 8) bc = 512 + 8 * b + (d == 0 ? step : 7 - step); else bc = 64 * b + (d == 0 ? step - 8 : 71 - step);
            bcs[k] = bc; er[k] = E[(size_t)bc * 256]; ei[k] = E[(size_t)bc * 256 + 64]; }
#pragma unroll
        for (int k = 0; k < 24; ++k) {
            if (s0 + k >= 8) { UC[(size_t)bcs[k] * 768] = (bf16)f2bf(sr); UC[(size_t)bcs[k] * 768 + 64] = (bf16)f2bf(si); }
            const float nr = lr * sr - li * si + er[k], ni = lr * si + li * sr + ei[k]; sr = nr; si = ni; }
    }
}
__device__ __forceinline__ void moe_route(const Args& A, const bf16* X, const float* mod, bf16* H, int chunk, LAS unsigned* lcnt, int tid, int wave, int lane) {
    unsigned char* tok = A.ws + WS_TOK;
    int* tokE = (int*)(tok + TOK_E); float* tokW = (float*)(tok + TOK_W); int* tokRank = (int*)(tok + TOK_RANK); int* wgbase = (int*)(tok + TOK_WGBASE);
    if (tid < 8) lcnt[tid] = 0u;
    __syncthreads();
    const float* gain = A.in[I_N2G] + D; const float* wr = A.in[I_ROUTER];
    for (int q2 = 0; q2 < 8; q2 += 2) {
        f32x4 vv[2][4];
#pragma unroll
        for (int u = 0; u < 2; ++u) { const bf16* xr = X + (size_t)(chunk * 64 + wave * 8 + q2 + u) * D;
#pragma unroll
            for (int j = 0; j < 4; ++j) { const v2u xw = *(const v2u*)(xr + 4 * lane + 256 * j); vv[u][j] = (f32x4){bflo(xw.x), bfhi(xw.x), bflo(xw.y), bfhi(xw.y)}; } }
#pragma unroll
        for (int u = 0; u < 2; ++u) {
        const int row = chunk * 64 + wave * 8 + q2 + u; const float* mp = mod + (size_t)(row >> 11) * 6144;
        float ss = 0.f;
#pragma unroll
        for (int j = 0; j < 4; ++j) ss += (vv[u][j].x * vv[u][j].x + vv[u][j].y * vv[u][j].y) + (vv[u][j].z * vv[u][j].z + vv[u][j].w * vv[u][j].w);
        const float rstd = rsqrtf(wave_sum(ss) * (1.0f / D) + EPS);
        float lg[8]; f32x4 hq[4];
#pragma unroll
        for (int e = 0; e < 8; ++e) lg[e] = 0.f;
#pragma unroll
        for (int j = 0; j < 4; ++j) { const int k = 4 * lane + 256 * j; const f32x4 gg = *(const f32x4*)(gain + k), sc = *(const f32x4*)(mp + 4 * 1024 + k), sh = *(const f32x4*)(mp + 3 * 1024 + k);
            const f32x4 h = vv[u][j] * rstd * gg * (sc + 1.0f) + sh; hq[j] = h;
#pragma unroll
            for (int i = 0; i < 4; ++i) { const f32x4 w0 = *(const f32x4*)(wr + (size_t)(k + i) * 8), w1 = *(const f32x4*)(wr + (size_t)(k + i) * 8 + 4); const float hv = h[i];
                lg[0] += hv * w0.x; lg[1] += hv * w0.y; lg[2] += hv * w0.z; lg[3] += hv * w0.w; lg[4] += hv * w1.x; lg[5] += hv * w1.y; lg[6] += hv * w1.z; lg[7] += hv * w1.w; } }
        {
            float am = 0.f;
#pragma unroll
            for (int j = 0; j < 4; ++j) am = fmaxf(am, fmaxf(fmaxf(fabsf(hq[j].x), fabsf(hq[j].y)), fmaxf(fabsf(hq[j].z), fabsf(hq[j].w))));
            am = wave_max(am); const float inv = am > 0.f ? 127.0f / am : 0.f;
#pragma unroll
            for (int j = 0; j < 4; ++j) *(unsigned*)((unsigned char*)H + (size_t)row * D + 4 * lane + 256 * j) = q8pack(hq[j].x * inv, hq[j].y * inv, hq[j].z * inv, hq[j].w * inv);
            if (lane == 0) ((float*)(A.ws + WS_ROWSC))[row] = am * (1.0f / 127.0f); }
#pragma unroll
        for (int e = 0; e < 8; ++e) lg[e] = wave_sum(lg[e]);
        int e0 = 0; float v0 = lg[0];
#pragma unroll
        for (int e = 1; e < 8; ++e) if (lg[e] > v0) { v0 = lg[e]; e0 = e; }
        int e1 = -1; float v1 = -3.0e38f;
#pragma unroll
        for (int e = 0; e < 8; ++e) if (e != e0 && lg[e] > v1) { v1 = lg[e]; e1 = e; }
        const float ex = __expf(v1 - v0), w0 = 1.0f / (1.0f + ex), w1 = ex * w0;
        if (lane == 0) { const unsigned r0 = __hip_atomic_fetch_add(&lcnt[e0], 1u, __ATOMIC_RELAXED, __HIP_MEMORY_SCOPE_WORKGROUP), r1 = __hip_atomic_fetch_add(&lcnt[e1], 1u, __ATOMIC_RELAXED, __HIP_MEMORY_SCOPE_WORKGROUP);
            tokE[2 * row] = e0; tokE[2 * row + 1] = e1; tokW[2 * row] = w0; tokW[2 * row + 1] = w1; tokRank[2 * row] = (int)r0; tokRank[2 * row + 1] = (int)r1; }
        }
    }
    __syncthreads();
    if (tid < 8) { const unsigned n = lcnt[tid]; const unsigned base = __hip_atomic_fetch_add((unsigned*)(A.ws + WS_CTL) + CW_GCNT + 64 * tid, n, RLX_AGENT); wgbase[chunk * 8 + tid] = (int)base; }
    __syncthreads();
}
constexpr int NPHASE = 18;
__device__ __forceinline__ void moe_offsets(const unsigned char* ws, int (&toff)[9]) {
    const unsigned* gc = (const unsigned*)(ws + WS_CTL) + CW_GCNT; int acc = 0;
#pragma unroll
    for (int e = 0; e < 8; ++e) { toff[e] = acc; const unsigned n = (unsigned)__builtin_amdgcn_readfirstlane((int)__hip_atomic_load(gc + 64 * e, RLX_AGENT)); acc += (int)((n + 255u) >> 8); }
    toff[8] = acc;
}
#define TAIL_CONVERT(nunits, first, count) do { const int rounds_ = ((nunits) + G - 1) / G, nlast_ = (nunits) - (rounds_ - 1) * G; \
        if (bx >= nlast_) moe_convert(args, lds, (first), (count), (bx - nlast_) * NWAVES + wave, (G - nlast_) * NWAVES, wave, lane); } while (0)
constexpr int CVQ4 = 4000, CVQ6 = 5500, CVQ7 = 20000, CVQ9 = 8500, CVQS1 = 2000, CVQS2 = CV_NMOE - CVQ4 - CVQ6 - CVQ7 - CVQ9 - CVQS1;
__global__ void __launch_bounds__(NWAVES * 64, 2) fwd_kernel(Args args) {
    extern __shared__ __attribute__((aligned(16))) unsigned char lds_raw[];
    LAS unsigned char* lds = (LAS unsigned char*)lds_raw;
    volatile LAS unsigned* MISC = (volatile LAS unsigned*)(lds + MISC_OFF);
    const int tid = threadIdx.x, lane = tid & 63, wave = __builtin_amdgcn_readfirstlane(tid >> 6);
    const int G = gridDim.x, bx = blockIdx.x;
    const int gw = bx * NWAVES + wave, NGW = G * NWAVES;
    unsigned char* ws = args.ws;
    for (int u = tid; u < (LDS_BYTES - LDSCTL_OFF) / 4; u += NWAVES * 64) ((LAS unsigned*)(lds + LDSCTL_OFF))[u] = 0u;
    __syncthreads();
    const int lo = args.ph_lo, hi = args.ph_hi;
    XcdBarrier bar; bar.bar = (unsigned*)(ws + WS_CTL) + CW_BAR; bar.x = 0; bar.st = nullptr;
    if (hi - lo > 1) bar = xcd_barrier_post((unsigned*)(ws + WS_CTL) + CW_BAR, MISC + 8);
#define IN(k) (lo <= (k) && (k) < hi)
#define SEAM(k) do { if (IN((k) + 1)) xcd_barrier(bar); } while (0)
    float* mod = (float*)(ws + WS_MOD);
    bf16* XL = (bf16*)(ws + WS_XL); bf16* XC = (bf16*)(ws + WS_XC);
    bf16* H = (bf16*)(ws + WS_H);

    if (IN(0)) {
        for (int i = bx * (NWAVES * 64) + tid; i < NE * 2 * ED; i += G * NWAVES * 64) ((unsigned*)(ws + WS_COLMAX))[i] = 0u;
        for (int u = bx; u < 192; u += G) { if (args.sub & 1) p0_adaln(args, u, lds, tid, wave, lane); }
        if (args.sub & 4) p0_convert(args, lds, gw, NGW, wave, lane);
        SEAM(0);
    }
    if (IN(1)) {
        { const float* modp = (const float*)(ws + WS_MODP);
          for (int i = bx * (NWAVES * 64) + tid; i < MOD_N; i += G * NWAVES * 64) mod[i] = ((modp[i] + modp[MOD_N + i]) + modp[2 * MOD_N + i]) + modp[3 * MOD_N + i]; }
        { const float* modp = (const float*)(ws + WS_MODP); LAS float* ms = (LAS float*)lds;
          for (int i = tid; i < 9 * 2048; i += NWAVES * 64) { const int r = i >> 11, o = r * 6144 + (i & 2047); ms[i] = ((modp[o] + modp[MOD_N + o]) + modp[2 * MOD_N + o]) + modp[3 * MOD_N + o]; }
          __syncthreads(); norm_rows_lds(args.in[I_X], args.in[I_CTX], MT, args.in[I_N1G], ms, H, (float*)(ws + WS_ROWFAC1), gw, NGW, lane); }
        quant_rows_inplace_p((bf16*)(ws + WS_WIN), (const float*)(ws + WS_PMAX), (float*)(ws + WS_COLSCD), MIXIN, gw, NGW, lane);
        quant_rows_inplace_p((bf16*)(ws + WS_W13), (const float*)(ws + WS_PMAX) + MIXIN * 16, (float*)(ws + WS_COLSCD) + MIXIN, 2 * FFN, gw, NGW, lane);
        SEAM(1); }
    if (IN(2)) {
        pg8::Gemm g{H, (const bf16*)(ws + WS_WIN), MT, MIXIN, D / 2, D / 2, D}; pg8::StaticOrder S; S.init(MT, MIXIN, G, bx);
        pg8::EpiQKVUq E{(bf16*)(ws + WS_QKVU), args.in[I_QG], args.in[I_KG], EPS, (const float*)(ws + WS_ROWFAC1), (const float*)(ws + WS_COLSCD)};
        pg8::gemm_phase<pg8::EpiQKVUq, pg8::StaticOrder, true, true>(lds + RING_OFF, g, S, E);
        SEAM(2);
    }
    if (IN(3)) {
        const bf16* QKVU = (const bf16*)(ws + WS_QKVU); bf16* MIX = (bf16*)(ws + WS_MIX);
        LAS float* rpbl = (LAS float*)(lds + 40960); LAS float* cv = (LAS float*)(lds + 57344);
        float mq = 0.f, mk = 0.f, mb = 0.f;
        mq = fabsf(args.in[I_QG][lane]); mk = fabsf(args.in[I_KG][lane]);
        for (int i = lane; i < 8 * 465; i += 64) mb = fmaxf(mb, fabsf(args.in[I_RPB][i]));
        const float bnd = (8.2f * wave_max(mq) * wave_max(mk) + wave_max(mb)) * 1.44269504f;
        for (int i = tid; i < 8 * 465; i += NWAVES * 64) rpbl[i] = args.in[I_RPB][i] * 1.44269504f - bnd;
        __syncthreads();
        const int nbw = (G % 8 == 0) ? G / 8 : G, xb0 = (G % 8 == 0) ? (bx & 7) : 0, xbn = (G % 8 == 0) ? xb0 + 1 : 8, j0 = (G % 8 == 0) ? (bx >> 3) : bx;
        for (int x = xb0; x < xbn; ++x)
            for (int k = j0; k < 128; k += nbw) {
                if (k < 36) {
                    if (!(args.sub & (k < 32 ? 8 : 16))) continue;
                    const int wu = k < 32 ? (x * 32 + k) * 8 + wave : 2048 + (x * 4 + (k - 32)) * 8 + wave;
                    attn_unit(QKVU, MIX, wu, lds + wave * 5120, lds + 57344 + wave * 8192, rpbl, bnd, lane);
                } else {
                    if (!(args.sub & 32)) continue;
                    const int ci = k < 64 ? k - 36 : (k < 96 ? k - 36 : (k >= 100 && k < 112 ? k - 40 : -1)); if (ci < 0) continue;
                    conv_item(args, QKVU, MIX, ci < 64 ? x * 64 + ci : 512 + x * 8 + (ci - 64), cv, tid, wave, lane);
                }
            }
        SEAM(3);
    }
    if (IN(4)) {
        pg8::Gemm g{(const bf16*)(ws + WS_MIX), (const bf16*)(ws + WS_WOUT), MT, D, D, D, D}; pg8::StaticOrder S; S.init(MT, D, G, bx);
        pg8::EpiResidN<true> E{args.in[I_X], args.in[I_CTX], XL, XC, mod + 2 * 1024, H, (float*)(ws + WS_ROWSS), args.in[I_N2G], mod + 4 * 1024};
        pg8::gemm_phase<pg8::EpiResidN<true>, pg8::StaticOrder, true, true>(lds + RING_OFF, g, S, E);
        {
            const int nun = (MT / 256) * (D / 256), rounds = (nun + G - 1) / G, nlast = nun - (rounds - 1) * G, nidle = G - nlast, ii = bx - nlast;
            if (ii >= 0) {
                if (args.sub & 2) for (int u = ii; u < 128; u += nidle) p0_s5gen(args, u >> 1, u & 1, lds, tid);
                const bool cvw = (nidle > 128) ? (ii >= 128) : true;
                const int cw = (nidle > 128) ? (ii - 128) * NWAVES + wave : ii * NWAVES + wave, cn = (nidle > 128) ? (nidle - 128) * NWAVES : nidle * NWAVES;
                if (cvw) {
                    shw_rows((const bf16*)(ws + WS_W13), 2 * FFN, mod + 3 * 1024, (float*)(ws + WS_SHW13), cw, cn, lds, tid, lane, (const float*)(ws + WS_COLSCD) + MIXIN);
                    shw_rows((const bf16*)(ws + WS_SIN), D, mod + 9 * 6144, (float*)(ws + WS_SHWS), cw, cn, lds, tid, lane);
                    moe_convert(args, lds, 0, CVQ4, cw, cn, wave, lane); }
            }
            if (nidle <= 0) { for (int u = bx; u < 128; u += G) p0_s5gen(args, u >> 1, u & 1, lds, tid);
                shw_rows((const bf16*)(ws + WS_W13), 2 * FFN, mod + 3 * 1024, (float*)(ws + WS_SHW13), gw, NGW, lds, tid, lane, (const float*)(ws + WS_COLSCD) + MIXIN); shw_rows((const bf16*)(ws + WS_SIN), D, mod + 9 * 6144, (float*)(ws + WS_SHWS), gw, NGW, lds, tid, lane);
                moe_convert(args, lds, 0, CVQ4, gw, NGW, wave, lane); }
        }
        SEAM(4);
    }
    if (IN(5)) { quant_act_rows(H, (const float*)(ws + WS_ROWSS), (float*)(ws + WS_ROWFAC1), MT, gw, NGW, lane); SEAM(5); }
    if (IN(6)) {
        pg8::Gemm g{H, (const bf16*)(ws + WS_W13), MT, 2 * FFN, D / 2, D, D}; pg8::StaticOrder S; S.init(MT, 2 * FFN, G, bx);
        LAS float* rt = (LAS float*)(lds + RING_BYTES); pg8::rowfac_prepass(S, (const float*)(ws + WS_ROWFAC1), rt, tid);
        pg8::EpiSwiGLUNq E{(bf16*)(ws + WS_ACT), FFN, rt, (const float*)(ws + WS_SHW13), 2 * FFN, (const float*)(ws + WS_COLSCD) + MIXIN};
        pg8::gemm_phase<pg8::EpiSwiGLUNq, pg8::StaticOrder, true, true>(lds + RING_OFF, g, S, E);
        TAIL_CONVERT((MT / 256) * (2 * FFN / 256), CVQ4, CVQ6);
        SEAM(6);
    }
    if (IN(7)) {
        pg8::Gemm g{(const bf16*)(ws + WS_ACT), (const bf16*)(ws + WS_W2), MT, D, FFN, FFN, FFN}; pg8::StaticOrder S; S.init(MT, D, G, bx);
        pg8::EpiResidN<false> E{XL, XC, XL, XC, mod + 5 * 1024, H, (float*)(ws + WS_ROWSS), args.in[I_N1G] + D, mod + 9 * 6144 + 1 * 1024};
        pg8::gemm_phase<pg8::EpiResidN<false>, pg8::StaticOrder, true, true>(lds + RING_OFF, g, S, E);
        TAIL_CONVERT((MT / 256) * (D / 256), CVQ4 + CVQ6, CVQ7);
        SEAM(7);
    }
    float* mod1 = mod + 9 * 6144;
    if (IN(8)) {
        pg8::Gemm g{H, (const bf16*)(ws + WS_SIN), MT, D, D, D, D}; pg8::StaticOrder S; S.init(MT, D, G, bx);
        LAS float* rt = (LAS float*)(lds + RING_BYTES); pg8::rstd_prepass(S, (const float*)(ws + WS_ROWSS), rt, EPS, tid);
        pg8::EpiUC E{(bf16*)(ws + WS_UC), rt, (const float*)(ws + WS_SHWS)};
        pg8::gemm_phase<pg8::EpiUC, pg8::StaticOrder, true, true>(lds + RING_OFF, g, S, E);
        TAIL_CONVERT((MT / 256) * (D / 256), CVQ4 + CVQ6 + CVQ7, CVQ9);
        SEAM(8);
    }
    if (IN(9)) {
        pg8::Gemm g{(const bf16*)(ws + WS_UC), (const bf16*)(ws + WS_WEND), 64 * 768, 64 * 256, 512, 768, 512}; pg8::OrderS5E S{G, bx};
        pg8::EpiE E{(float*)(ws + WS_E)};
        pg8::gemm_phase<pg8::EpiE, pg8::OrderS5E, true, true>(lds + RING_OFF, g, S, E);
        if (G == 256) { if ((bx >> 3) >= 24) moe_convert(args, lds, CVQ4 + CVQ6 + CVQ7 + CVQ9, CVQS1, (((bx >> 3) - 24) * 8 + (bx & 7)) * NWAVES + wave, 64 * NWAVES, wave, lane); }
        else moe_convert(args, lds, CVQ4 + CVQ6 + CVQ7 + CVQ9, CVQS1, gw, NGW, wave, lane);
        SEAM(9);
    }
    if (IN(10)) { s5_scan(args, bx * (NWAVES * 64) + tid);
        if (G > 128) { if (bx >= 128) moe_convert(args, lds, CVQ4 + CVQ6 + CVQ7 + CVQ9 + CVQS1, CVQS2, (bx - 128) * NWAVES + wave, (G - 128) * NWAVES, wave, lane); }
        else moe_convert(args, lds, CVQ4 + CVQ6 + CVQ7 + CVQ9 + CVQS1, CVQS2, gw, NGW, wave, lane);
        SEAM(10); }
    if (IN(11)) {
        pg8::Gemm g{(const bf16*)(ws + WS_UC), (const bf16*)(ws + WS_BTOUT), 64 * 768, 64 * 512, 768, 768, 768}; pg8::OrderS5Y S{G, bx};
        pg8::EpiY E{(bf16*)(ws + WS_Y)};
        pg8::gemm_phase<pg8::EpiY, pg8::OrderS5Y, true, true>(lds + RING_OFF, g, S, E);
        SEAM(11);
    }
    if (IN(12)) {
        pg8::Gemm g{(const bf16*)(ws + WS_Y), (const bf16*)(ws + WS_SOUT), ML, 2 * D, D, D, D}; pg8::StaticOrder S; S.init(ML, 2 * D, G, bx);
        pg8::EpiGLURes E{XL, mod1 + 2 * 1024};
        pg8::gemm_phase<pg8::EpiGLURes, pg8::StaticOrder, true, true>(lds + RING_OFF, g, S, E);
        SEAM(12);
    }
    unsigned char* tok = ws + WS_TOK;
    if (IN(13)) {
        int* rowsrc = (int*)(tok + TOK_ROWSRC); int* rowinfo = (int*)(tok + TOK_ROWINFO); float* rowgate = (float*)(tok + TOK_ROWGATE);
        for (int i = bx * (NWAVES * 64) + tid; i < MOE_TILES * 256; i += G * NWAVES * 64) { rowsrc[i] = 0; rowinfo[i] = -1; rowgate[i] = 0.f; ((float*)(ws + WS_POSSC))[i] = 0.f; }
        for (int ch = bx; ch < ML / 64; ch += G) moe_route(args, XL, mod1, H, ch, (LAS unsigned*)lds, tid, wave, lane);
        SEAM(13);
    }
    if (IN(14)) {
        int toff[9]; moe_offsets(ws, toff);
        const int* tokE = (const int*)(tok + TOK_E); const float* tokW = (const float*)(tok + TOK_W); const int* tokRank = (const int*)(tok + TOK_RANK); const int* wgbase = (const int*)(tok + TOK_WGBASE);
        int* rowsrc = (int*)(tok + TOK_ROWSRC); int* rowinfo = (int*)(tok + TOK_ROWINFO); float* rowgate = (float*)(tok + TOK_ROWGATE); int* tokPos = (int*)(tok + TOK_POS);
        for (int i = bx * (NWAVES * 64) + tid; i < 2 * ML; i += G * NWAVES * 64) { const int t = i >> 1, e = tokE[i]; int to = 0;
#pragma unroll
            for (int q = 0; q < 8; ++q) to = (e == q) ? toff[q] : to;
            const int pos = to * 256 + wgbase[(t >> 6) * 8 + e] + tokRank[i];
            rowsrc[pos] = t; rowinfo[pos] = i; rowgate[pos] = tokW[i]; tokPos[i] = pos; ((float*)(ws + WS_POSSC))[pos] = ((const float*)(ws + WS_ROWSC))[t]; }
        quant_rows_f8_inplace((bf16*)(ws + WS_MW2), (float*)(ws + WS_COLSC2), NE * D, gw, NGW, lane);
        quant_rows_inplace((bf16*)(ws + WS_MW13), (unsigned*)(ws + WS_COLMAX), NE * 2 * ED, gw, NGW, lane);
        SEAM(14);
    }
    if (IN(15)) {
        pg8::OrderMoE S; S.G = G; S.c = bx; S.nN = 2 * ED / 256; S.tmax = 1 << 30; S.fix = (args.sub >> 7) & 1; moe_offsets(ws, S.toff);
        pg8::Gemm g{H, (const bf16*)(ws + WS_MW13), MOE_TILES * 256, NE * 2 * ED, D / 2, D / 2, D, (const int*)(tok + TOK_ROWSRC)};
        pg8::EpiSwiGLUq E{ws + WS_ACTM, ED, 2 * ED / 256, (const float*)(ws + WS_POSSC), (const float*)(ws + WS_COLSC)};
        pg8::gemm_phase<pg8::EpiSwiGLUq, pg8::OrderMoE, true, true, true>(lds + RING_OFF, g, S, E);
        SEAM(15);
    }
    if (IN(16)) {
        pg8::OrderMoE S; S.G = G; S.c = bx; S.nN = D / 256; S.tmax = 128; S.fix = 0; moe_offsets(ws, S.toff);
        pg8::Gemm g{(const bf16*)(ws + WS_ACTM), (const bf16*)(ws + WS_MW2), MOE_TILES * 256, NE * D, ED / 2, ED / 2, ED};
        pg8::EpiMoE2 E{(bf16*)args.out, (const float*)(tok + TOK_ROWGATE), (const int*)(tok + TOK_ROWINFO), (const float*)(ws + WS_COLSC2)};
        pg8::gemm_phase<pg8::EpiMoE2, pg8::OrderMoE, true, true>(lds + RING_OFF, g, S, E);
        pg8::OrderMoEx Sx; Sx.G = G; Sx.c = bx; moe_offsets(ws, Sx.toff);
        pg8::Gemm gx{(const bf16*)(ws + WS_ACTM), (const bf16*)(ws + WS_MW2), MOE_TILES * 256, NE * D, 512, ED / 2, ED};
        pg8::EpiMoE2x Ex{(float*)(ws + WS_PX), (const float*)(tok + TOK_ROWGATE), (const float*)(ws + WS_COLSC2)};
        pg8::gemm_phase<pg8::EpiMoE2x, pg8::OrderMoEx, true, false>(lds + RING_OFF, gx, Sx, Ex);
        SEAM(16);
    }
    if (IN(17)) {
        const unsigned bad = __hip_atomic_load((unsigned*)(ws + WS_CTL) + CW_BAR + XB_TMO, RLX_AGENT);
        const int* tokPos = (const int*)(tok + TOK_POS); const float* PX = (const float*)(ws + WS_PX);
        for (int tb = gw; tb < ML; tb += 2 * NGW) {
            const int tt[2] = {tb, (tb + NGW < ML) ? tb + NGW : tb}; const int ntk = (tb + NGW < ML) ? 2 : 1;
            v2u a[2][4], b[2][4], xw[2][4]; f32x4 gv[2][4]; int p0[2], p1[2];
#pragma unroll
            for (int u = 0; u < 2; ++u) { const int t = tt[u]; const bf16* y0 = (const bf16*)(args.out + (size_t)t * D); const bf16* y1 = y0 + D; const float* gp = mod1 + (size_t)(t >> 11) * 6144 + 5 * 1024;
                p0[u] = tokPos[2 * t] - 128 * 256; p1[u] = tokPos[2 * t + 1] - 128 * 256;
#pragma unroll
                for (int j = 0; j < 4; ++j) { const int c = 4 * lane + 256 * j; a[u][j] = *(const v2u*)(y0 + c); b[u][j] = *(const v2u*)(y1 + c); xw[u][j] = *(const v2u*)(XL + (size_t)t * D + c); gv[u][j] = *(const f32x4*)(gp + c); } }
            asm volatile("s_waitcnt vmcnt(0)" ::: "memory");
#pragma unroll
            for (int u = 0; u < 2; ++u) { if (u < ntk) { const int t = tt[u];
#pragma unroll
                for (int j = 0; j < 4; ++j) { const int c = 4 * lane + 256 * j;
                    f32x4 ya = (f32x4){bflo(a[u][j].x), bfhi(a[u][j].x), bflo(a[u][j].y), bfhi(a[u][j].y)}, yb = (f32x4){bflo(b[u][j].x), bfhi(b[u][j].x), bflo(b[u][j].y), bfhi(b[u][j].y)};
                    if (p0[u] >= 0) { const float* q = PX + (size_t)p0[u] * D + c; ya = ((*(const f32x4*)q + *(const f32x4*)(q + (size_t)2048 * D)) + *(const f32x4*)(q + (size_t)4096 * D)) + *(const f32x4*)(q + (size_t)6144 * D); }
                    if (p1[u] >= 0) { const float* q = PX + (size_t)p1[u] * D + c; yb = ((*(const f32x4*)q + *(const f32x4*)(q + (size_t)2048 * D)) + *(const f32x4*)(q + (size_t)4096 * D)) + *(const f32x4*)(q + (size_t)6144 * D); }
                    const f32x4 xv = (f32x4){bflo(xw[u][j].x), bfhi(xw[u][j].x), bflo(xw[u][j].y), bfhi(xw[u][j].y)};
                    f32x4 o = xv + gv[u][j] * (ya + yb); if (bad) o = (f32x4){__builtin_nanf(""), __builtin_nanf(""), __builtin_nanf(""), __builtin_nanf("")};
                    *(f32x4*)(args.out + (size_t)t * D + c) = o; } } }
        }
    }
#undef IN
#undef SEAM
}

extern "C" void kernel_launch(void* const* d_in, const int* in_sizes, int n_in, void* d_out, int out_size, void* d_ws, size_t ws_size, hipStream_t stream) {
    static int grid = 0;
    if (grid == 0) {
        if (n_in != N_IN || out_size != ML * D || ws_size < WS_END) { fprintf(stderr, "kernel_launch: unexpected problem (n_in %d, out %d, ws %zu); nothing launched\n", n_in, out_size, ws_size); grid = -1; return; }
        int dev = 0, cus = 0, per_cu = 0;
        if (hipGetDevice(&dev) != hipSuccess || hipDeviceGetAttribute(&cus, hipDeviceAttributeMultiprocessorCount, dev) != hipSuccess) { grid = -1; return; }
        if (hipFuncSetAttribute((const void*)fwd_kernel, hipFuncAttributeMaxDynamicSharedMemorySize, LDS_BYTES) != hipSuccess) { fprintf(stderr, "kernel_launch: hipFuncSetAttribute failed\n"); grid = -1; return; }
        if (hipOccupancyMaxActiveBlocksPerMultiprocessor(&per_cu, (const void*)fwd_kernel, NWAVES * 64, LDS_BYTES) != hipSuccess || per_cu < 1) { fprintf(stderr, "kernel_launch: occupancy query says %d blocks per CU\n", per_cu); (void)hipGetLastError(); grid = -1; return; }
        grid = cus;
    }
    if (grid < 0) return;
    if (hipMemsetAsync((char*)d_ws + WS_CTL, 0, CTL_ZERO_BYTES, stream) != hipSuccess) return;
    Args a{};
    for (int i = 0; i < N_IN; ++i) a.in[i] = (const float*)d_in[i];
    a.out = (float*)d_out; a.ws = (unsigned char*)d_ws; a.sub = 63;
#if MK_N_LAUNCHES == 1
    a.ph_lo = 0; a.ph_hi = NPHASE;
    hipLaunchKernelGGL(fwd_kernel, dim3(grid), dim3(NWAVES * 64), LDS_BYTES, stream, a);
#else
    for (int p = 0; p < NPHASE; ++p) { const int nrep = ((MK_REPEAT_MASK >> p) & 1u) ? 2 : 1;
        for (int r = 0; r < nrep; ++r) { a.ph_lo = p; a.ph_hi = p + 1; a.sub = (r == 0) ? 63 : MK_REPEAT_SUB; hipLaunchKernelGGL(fwd_kernel, dim3(grid), dim3(NWAVES * 64), LDS_BYTES, stream, a); } }
#endif
}
```

```cpp
#include <hip/hip_runtime.h>
#include <cstdio>
#include <cstdint>
#ifndef MK_N_LAUNCHES
#define MK_N_LAUNCHES 1
#endif
#ifndef MK_REPEAT_SUB
#define MK_REPEAT_SUB 63
#endif
#ifndef MK_REPEAT_MASK
#define MK_REPEAT_MASK 0u
#endif
namespace pg8 {
#define PG8_LAS __attribute__((address_space(3)))
typedef unsigned short bf16_t;
typedef short bf16x8 __attribute__((ext_vector_type(8)));
typedef float f32x4 __attribute__((ext_vector_type(4)));
typedef unsigned u32x4 __attribute__((ext_vector_type(4)));
typedef unsigned u32x2 __attribute__((ext_vector_type(2)));
typedef int i32x4 __attribute__((ext_vector_type(4)));
__device__ __forceinline__ f32x4 mma16(bf16x8 a, bf16x8 b, f32x4 c) { return __builtin_amdgcn_mfma_f32_16x16x32_bf16(a, b, c, 0, 0, 0); }
__device__ __forceinline__ i32x4 mma16(bf16x8 a, bf16x8 b, i32x4 c) { return __builtin_amdgcn_mfma_i32_16x16x64_i8(__builtin_bit_cast(i32x4, a), __builtin_bit_cast(i32x4, b), c, 0, 0, 0); }
typedef int i32x8 __attribute__((ext_vector_type(8)));
template <class T, class = void> struct is_fp8 { static constexpr bool v = false; };
template <class T> struct is_fp8<T, decltype((void)T::FP8)> { static constexpr bool v = T::FP8; };
template <bool FP8> struct Frag { bf16x8 k0, k1;
    __device__ __forceinline__ void set(int k, bf16x8 x) { if (k == 0) k0 = x; else k1 = x; } };
template <> struct Frag<true> { i32x8 v;
    __device__ __forceinline__ void set(int k, bf16x8 x) { if (k == 0) v.lo = __builtin_bit_cast(i32x4, x); else v.hi = __builtin_bit_cast(i32x4, x); } };
template <class ACC> __device__ __forceinline__ ACC mma_frag(const Frag<false>& a, const Frag<false>& b, ACC c) { c = mma16(a.k0, b.k0, c); return mma16(a.k1, b.k1, c); }
__device__ __forceinline__ f32x4 mma_frag(const Frag<true>& a, const Frag<true>& b, f32x4 c) { asm volatile("v_mfma_f32_16x16x128_f8f6f4 %0, %1, %2, %0" : "+v"(c) : "v"(a.v), "v"(b.v)); return c; }
template <bool FP8> __device__ __forceinline__ void mma_drain() { if constexpr (FP8) asm volatile("s_nop 15\n\ts_nop 15" ::: "memory"); }
constexpr int BM = 256, BK = 64, HALF = 128, HTB = HALF * BK * 2  , STAGE_BYTES = 8 * HTB, NXCD = 8, WGM = 8;

__host__ __device__ __forceinline__ int lds_byte(int r, int c) { const int st = (r >> 4) * 2 + (c >> 5), rr = r & 15, cc = c & 31, ob = rr * 64 + cc * 2; return st * 1024 + (ob ^ (((ob >> 9) & 1) << 5)); }
__host__ __device__ __forceinline__ void stage_rc(int b, int& R, int& C) { const int st = b / 1024, sb = b % 1024, swz = sb ^ (((sb >> 9) & 1) << 5); R = (st >> 1) * 16 + swz / 64; C = (st & 1) * 32 + (swz % 64) / 2; }
__host__ __device__ __forceinline__ int perm32(int rho) { const int n = rho >> 4, i = rho & 15; return 8 * (i >> 2) + 4 * n + (i & 3); }

struct Unit { int pm, pn, k0, idx; };
struct Gemm { const bf16_t* A; const bf16_t* Bt; int M, N, K, lda, ldb; const int* rowsrc; };

struct StaticOrder {
    static constexpr bool VARK = false;
    int nM, nN, nwg, G, c;
    __host__ __device__ void init(int M, int N, int G_, int c_) { nM = M / BM; nN = N / BM; nwg = nM * nN; G = G_; c = c_; }
    __host__ __device__ bool next(int i, Unit& u) const {
        const long L = (long)i * G + c; if (L >= nwg) return false;
        int wgid = (int)L; { const int q = nwg / NXCD, r = nwg % NXCD, xcd = wgid % NXCD, off = wgid / NXCD; wgid = (xcd < r ? xcd * (q + 1) : r * (q + 1) + (xcd - r) * q) + off; }
        const int nig = WGM * nN, gid = wgid / nig, fm = gid * WGM, gsz = (nM - fm) < WGM ? (nM - fm) : WGM;
        u.pm = fm + ((wgid % nig) % gsz); u.pn = (wgid % nig) / gsz; u.k0 = 0; u.idx = i; return true;
    }
    __device__ __forceinline__ void a_ready(const Unit&) const {}
    __device__ __forceinline__ void done(const Unit&) const {}
};

constexpr int ML_ = 16384, MC_ = 2048, MT_ = ML_ + MC_, DM_ = 1024;
__device__ __forceinline__ unsigned cvt_pk_bf16(float lo, float hi) { unsigned r; asm volatile("v_cvt_pk_bf16_f32 %0, %1, %2" : "=v"(r) : "v"(lo), "v"(hi)); return r; }
__device__ __forceinline__ float sigm(float x) { return __builtin_amdgcn_rcpf(1.0f + __expf(-x)); }
__device__ __forceinline__ float gelu_tanh(float x) { const float u = 1.5957691216f * (x + 0.044715f * x * x * x); return x * sigm(u); }
__device__ __forceinline__ unsigned f8pack4(const f32x4 v) { int w = 0;
    w = __builtin_amdgcn_cvt_pk_fp8_f32(__builtin_amdgcn_fmed3f(v[0], -448.f, 448.f), __builtin_amdgcn_fmed3f(v[1], -448.f, 448.f), w, false);
    w = __builtin_amdgcn_cvt_pk_fp8_f32(__builtin_amdgcn_fmed3f(v[2], -448.f, 448.f), __builtin_amdgcn_fmed3f(v[3], -448.f, 448.f), w, true); return (unsigned)w; }
__device__ __forceinline__ u32x4 pack8(const f32x4 a, const f32x4 b) { u32x4 w; w.x = cvt_pk_bf16(a[0], a[1]); w.y = cvt_pk_bf16(a[2], a[3]); w.z = cvt_pk_bf16(b[0], b[1]); w.w = cvt_pk_bf16(b[2], b[3]); return w; }


struct EpiQKVU {
    typedef f32x4 acc_t; static constexpr bool PERM = true, AFTER_DRAIN = false;
    bf16_t* O; const float* gq; const float* gk; float eps;
    __device__ __forceinline__ void operator()(const f32x4 (&acc)[2][2][4][2], const Unit& u, int wr, int wc, int fr, int fq) const {
        const int row0 = u.pm * BM + wr * 64 + fr; const int pn = u.pn;
        if (pn < 6) {
            const bool nrm = pn < 4; const float* gp = (pn < 2) ? gq : gk;
            f32x4 gn[2][2];
#pragma unroll
            for (int bj = 0; bj < 2; ++bj)
#pragma unroll
                for (int n = 0; n < 2; ++n) gn[bj][n] = nrm ? *(const f32x4*)(gp + 32 * bj + 8 * fq + 4 * n) : (f32x4){1.f, 1.f, 1.f, 1.f};
#pragma unroll
            for (int ai = 0; ai < 2; ++ai)
#pragma unroll
                for (int m = 0; m < 4; ++m) {
                    float sc = 1.f;
                    if (nrm) { float ss = 0.f;
#pragma unroll
                        for (int bj = 0; bj < 2; ++bj)
#pragma unroll
                            for (int n = 0; n < 2; ++n) { const f32x4 x = acc[ai][bj][m][n]; ss += (x[0] * x[0] + x[1] * x[1]) + (x[2] * x[2] + x[3] * x[3]); }
                        ss += __shfl_xor(ss, 16); ss += __shfl_xor(ss, 32);
                        sc = rsqrtf(ss * (1.0f / 64.0f) + eps); }
                    bf16_t* rowp = O + (size_t)(row0 + ai * HALF + m * 16) * 2048 + 256 * pn + 64 * wc + 8 * fq;
#pragma unroll
                    for (int bj = 0; bj < 2; ++bj) { const f32x4 v0 = acc[ai][bj][m][0] * gn[bj][0] * sc, v1 = acc[ai][bj][m][1] * gn[bj][1] * sc; *(u32x4*)(rowp + 32 * bj) = pack8(v0, v1); }
                }
        } else {
            const int cb = 1536 + 128 * (pn - 6) + 32 * wc + 8 * fq;
#pragma unroll
            for (int ai = 0; ai < 2; ++ai)
#pragma unroll
                for (int m = 0; m < 4; ++m) {
                    f32x4 v[2];
#pragma unroll
                    for (int n = 0; n < 2; ++n) { const f32x4 a = acc[ai][0][m][n], g = acc[ai][1][m][n]; v[n] = (f32x4){a[0] * sigm(g[0]), a[1] * sigm(g[1]), a[2] * sigm(g[2]), a[3] * sigm(g[3])}; }
                    *(u32x4*)(O + (size_t)(row0 + ai * HALF + m * 16) * 2048 + cb) = pack8(v[0], v[1]);
                }
        }
    }
};
struct EpiQKVUq {
    typedef i32x4 acc_t; static constexpr bool PERM = true, AFTER_DRAIN = false;
    bf16_t* O; const float* gq; const float* gk; float eps; const float* rowfac; const float* colscale;
    __device__ __forceinline__ void operator()(const i32x4 (&acc)[2][2][4][2], const Unit& u, int wr, int wc, int fr, int fq) const {
        const int row0 = u.pm * BM + wr * 64 + fr; const int pn = u.pn;
        f32x4 cs[2][2];
#pragma unroll
        for (int bj = 0; bj < 2; ++bj)
#pragma unroll
            for (int n = 0; n < 2; ++n) cs[bj][n] = *(const f32x4*)(colscale + pn * BM + bj * HALF + wc * 32 + 8 * fq + 4 * n);
#define QF(ai_, bj_, m_, n_, rf_) ((f32x4){(float)acc[ai_][bj_][m_][n_][0], (float)acc[ai_][bj_][m_][n_][1], (float)acc[ai_][bj_][m_][n_][2], (float)acc[ai_][bj_][m_][n_][3]} * cs[bj_][n_] * (rf_))
        if (pn < 6) {
            const bool nrm = pn < 4; const float* gp = (pn < 2) ? gq : gk;
            f32x4 gn[2][2];
#pragma unroll
            for (int bj = 0; bj < 2; ++bj)
#pragma unroll
                for (int n = 0; n < 2; ++n) gn[bj][n] = nrm ? *(const f32x4*)(gp + 32 * bj + 8 * fq + 4 * n) : (f32x4){1.f, 1.f, 1.f, 1.f};
#pragma unroll
            for (int ai = 0; ai < 2; ++ai)
#pragma unroll
                for (int m = 0; m < 4; ++m) {
                    float sc = 1.f; const float rf = rowfac[row0 + ai * HALF + m * 16];
                    f32x4 xf[2][2];
#pragma unroll
                    for (int bj = 0; bj < 2; ++bj)
#pragma unroll
                        for (int n = 0; n < 2; ++n) xf[bj][n] = QF(ai, bj, m, n, rf);
                    if (nrm) { float ss = 0.f;
#pragma unroll
                        for (int bj = 0; bj < 2; ++bj)
#pragma unroll
                            for (int n = 0; n < 2; ++n) { const f32x4 x = xf[bj][n]; ss += (x[0] * x[0] + x[1] * x[1]) + (x[2] * x[2] + x[3] * x[3]); }
                        ss += __shfl_xor(ss, 16); ss += __shfl_xor(ss, 32);
                        sc = rsqrtf(ss * (1.0f / 64.0f) + eps); }
                    bf16_t* rowp = O + (size_t)(row0 + ai * HALF + m * 16) * 2048 + 256 * pn + 64 * wc + 8 * fq;
#pragma unroll
                    for (int bj = 0; bj < 2; ++bj) { const f32x4 v0 = xf[bj][0] * gn[bj][0] * sc, v1 = xf[bj][1] * gn[bj][1] * sc; *(u32x4*)(rowp + 32 * bj) = pack8(v0, v1); }
                }
        } else {
            const int cb = 1536 + 128 * (pn - 6) + 32 * wc + 8 * fq;
#pragma unroll
            for (int ai = 0; ai < 2; ++ai)
#pragma unroll
                for (int m = 0; m < 4; ++m) { const float rf = rowfac[row0 + ai * HALF + m * 16];
                    f32x4 v[2];
#pragma unroll
                    for (int n = 0; n < 2; ++n) { const f32x4 a = QF(ai, 0, m, n, rf), g = QF(ai, 1, m, n, rf); v[n] = (f32x4){a[0] * sigm(g[0]), a[1] * sigm(g[1]), a[2] * sigm(g[2]), a[3] * sigm(g[3])}; }
                    *(u32x4*)(O + (size_t)(row0 + ai * HALF + m * 16) * 2048 + cb) = pack8(v[0], v[1]);
                }
        }
    }
};
#undef QF
struct EpiResid {
    typedef f32x4 acc_t; static constexpr bool PERM = false, AFTER_DRAIN = false;
    const float* baseL; const float* baseC; float* XL; float* XC; const float* gate;
    __device__ __forceinline__ void operator()(const f32x4 (&acc)[2][2][4][2], const Unit& u, int wr, int wc, int fr, int fq) const {
        const int R0 = u.pm * BM, row0 = R0 + wr * 64 + fr, col0 = u.pn * BM + wc * 32 + 4 * fq;
        const int modrow = R0 < ML_ ? (R0 >> 11) : 8;
        const float* gp = gate + (size_t)modrow * 6144 + col0;
        const float* bp = R0 < ML_ ? baseL : baseC - (size_t)ML_ * DM_;
        float* xo = R0 < ML_ ? XL : XC - (size_t)ML_ * DM_;
        f32x4 gv[2][2];
#pragma unroll
        for (int bj = 0; bj < 2; ++bj)
#pragma unroll
            for (int n = 0; n < 2; ++n) gv[bj][n] = *(const f32x4*)(gp + bj * HALF + n * 16);
#pragma unroll
        for (int ai = 0; ai < 2; ++ai)
#pragma unroll
            for (int m = 0; m < 4; ++m) { const size_t ro = (size_t)(row0 + ai * HALF + m * 16) * DM_ + col0;
#pragma unroll
                for (int bj = 0; bj < 2; ++bj)
#pragma unroll
                    for (int n = 0; n < 2; ++n) { const f32x4 xv = *(const f32x4*)(bp + ro + bj * HALF + n * 16); *(f32x4*)(xo + ro + bj * HALF + n * 16) = xv + gv[bj][n] * acc[ai][bj][m][n]; } }
    }
};
__device__ __forceinline__ void unpack8(const u32x4 w, f32x4& a, f32x4& b) {
    a = (f32x4){__builtin_bit_cast(float, w.x << 16), __builtin_bit_cast(float, w.x & 0xffff0000u), __builtin_bit_cast(float, w.y << 16), __builtin_bit_cast(float, w.y & 0xffff0000u)};
    b = (f32x4){__builtin_bit_cast(float, w.z << 16), __builtin_bit_cast(float, w.z & 0xffff0000u), __builtin_bit_cast(float, w.w << 16), __builtin_bit_cast(float, w.w & 0xffff0000u)}; }
template <bool BASE_F32> struct EpiResidN {
    typedef f32x4 acc_t; static constexpr bool PERM = true, AFTER_DRAIN = false;
    const void* baseL; const void* baseC; bf16_t* XL; bf16_t* XC; const float* gate; bf16_t* Hn; float* rowss; const float* ngain; const float* nscale;
    __device__ __forceinline__ void operator()(const f32x4 (&acc)[2][2][4][2], const Unit& u, int wr, int wc, int fr, int fq) const {
        const int R0 = u.pm * BM, row0 = R0 + wr * 64 + fr, col0 = u.pn * BM + wc * 32 + 8 * fq;
        const int modrow = R0 < ML_ ? (R0 >> 11) : 8, rsub = R0 < ML_ ? 0 : ML_;
        const float* gp = gate + (size_t)modrow * 6144 + col0; const float* sp = nscale + (size_t)modrow * 6144 + col0;
        const void* bp = R0 < ML_ ? baseL : baseC; bf16_t* xo = R0 < ML_ ? XL : XC;
        f32x4 gv[2][2], gs[2][2];
#pragma unroll
        for (int bj = 0; bj < 2; ++bj)
#pragma unroll
            for (int n = 0; n < 2; ++n) { gv[bj][n] = *(const f32x4*)(gp + bj * HALF + n * 4); gs[bj][n] = *(const f32x4*)(ngain + col0 + bj * HALF + n * 4) * (*(const f32x4*)(sp + bj * HALF + n * 4) + 1.0f); }
#pragma unroll
        for (int ai = 0; ai < 2; ++ai)
#pragma unroll
            for (int m = 0; m < 4; ++m) { const int row = row0 + ai * HALF + m * 16; const size_t ro = (size_t)(row - rsub) * DM_ + col0; float ss = 0.f;
#pragma unroll
                for (int bj = 0; bj < 2; ++bj) { f32x4 x0, x1;
                    if constexpr (BASE_F32) { x0 = *(const f32x4*)((const float*)bp + ro + bj * HALF); x1 = *(const f32x4*)((const float*)bp + ro + bj * HALF + 4); }
                    else unpack8(*(const u32x4*)((const bf16_t*)bp + ro + bj * HALF), x0, x1);
                    const u32x4 xw = pack8(x0 + gv[bj][0] * acc[ai][bj][m][0], x1 + gv[bj][1] * acc[ai][bj][m][1]); *(u32x4*)(xo + ro + bj * HALF) = xw;
                    f32x4 r0, r1; unpack8(xw, r0, r1);
                    ss += ((r0[0] * r0[0] + r0[1] * r0[1]) + (r0[2] * r0[2] + r0[3] * r0[3])) + ((r1[0] * r1[0] + r1[1] * r1[1]) + (r1[2] * r1[2] + r1[3] * r1[3]));
                    *(u32x4*)(Hn + (size_t)row * DM_ + col0 + bj * HALF) = pack8(r0 * gs[bj][0], r1 * gs[bj][1]); }
                ss += __shfl_xor(ss, 16); ss += __shfl_xor(ss, 32);
                if (fq == 0) rowss[(size_t)row * 16 + u.pn * 4 + wc] = ss; }
    }
};
__device__ __forceinline__ float row_rstd(const float* rowss, int row, float eps) {
    const f32x4* p = (const f32x4*)(rowss + (size_t)row * 16); const f32x4 a = p[0], b = p[1], c = p[2], d = p[3];
    const float s = (((a[0] + a[1]) + (a[2] + a[3])) + ((b[0] + b[1]) + (b[2] + b[3]))) + (((c[0] + c[1]) + (c[2] + c[3])) + ((d[0] + d[1]) + (d[2] + d[3])));
    return rsqrtf(s * (1.0f / 1024.0f) + eps); }
template <class Sched> __device__ __forceinline__ void rstd_prepass(const Sched& S, const float* rowss, PG8_LAS float* rt, float eps, int tid) {
    Unit u; int n = 0; while (n < 8 && S.next(n, u)) ++n;
#pragma unroll
    for (int q = 0; q < 4; ++q) { const int r = tid + 512 * q, i = r >> 8;
        if (i < n) { S.next(i, u); rt[r] = row_rstd(rowss, u.pm * BM + (r & 255), eps); } }
    __syncthreads();
}
struct EpiSwiGLUN {
    typedef f32x4 acc_t; static constexpr bool PERM = true, AFTER_DRAIN = false;
    bf16_t* O; int ldo; const PG8_LAS float* rt; const float* shw; int nphys;
    __device__ __forceinline__ void operator()(const f32x4 (&acc)[2][2][4][2], const Unit& u, int wr, int wc, int fr, int fq) const {
        const int R0 = u.pm * BM, row0 = R0 + wr * 64 + fr, colp = u.pn * BM + wc * 32 + 8 * fq, col0 = u.pn * HALF + wc * 32 + 8 * fq;
        const float* sp = shw + (size_t)(R0 < ML_ ? (R0 >> 11) : 8) * nphys + colp;
        f32x4 s1[2], s3[2];
#pragma unroll
        for (int n = 0; n < 2; ++n) { s1[n] = *(const f32x4*)(sp + 4 * n); s3[n] = *(const f32x4*)(sp + HALF + 4 * n); }
#pragma unroll
        for (int ai = 0; ai < 2; ++ai)
#pragma unroll
            for (int m = 0; m < 4; ++m) { const int row = row0 + ai * HALF + m * 16; const float rs = rt[u.idx * BM + (row - R0)];
                f32x4 v[2];
#pragma unroll
                for (int n = 0; n < 2; ++n) { const f32x4 a = acc[ai][0][m][n] * rs + s1[n], b = acc[ai][1][m][n] * rs + s3[n]; v[n] = (f32x4){a[0] * sigm(a[0]) * b[0], a[1] * sigm(a[1]) * b[1], a[2] * sigm(a[2]) * b[2], a[3] * sigm(a[3]) * b[3]}; }
                *(u32x4*)(O + (size_t)row * ldo + col0) = pack8(v[0], v[1]);
            }
    }
};
struct EpiSwiGLU {
    typedef f32x4 acc_t; static constexpr bool PERM = true, AFTER_DRAIN = false;
    bf16_t* O; int ldo, nN, row_sub; int skip;
    __device__ __forceinline__ void operator()(const f32x4 (&acc)[2][2][4][2], const Unit& u, int wr, int wc, int fr, int fq) const {
        if (skip) {
#pragma unroll
            for (int ai = 0; ai < 2; ++ai)
#pragma unroll
                for (int bj = 0; bj < 2; ++bj)
#pragma unroll
                    for (int m = 0; m < 4; ++m)
#pragma unroll
                        for (int n = 0; n < 2; ++n) asm volatile("" :: "v"(acc[ai][bj][m][n]));
            return; }
        const int row0 = u.pm * BM + wr * 64 + fr - row_sub, col0 = (u.pn % nN) * HALF + wc * 32 + 8 * fq;
#pragma unroll
        for (int ai = 0; ai < 2; ++ai)
#pragma unroll
            for (int m = 0; m < 4; ++m) {
                f32x4 v[2];
#pragma unroll
                for (int n = 0; n < 2; ++n) { const f32x4 a = acc[ai][0][m][n], b = acc[ai][1][m][n]; v[n] = (f32x4){a[0] * sigm(a[0]) * b[0], a[1] * sigm(a[1]) * b[1], a[2] * sigm(a[2]) * b[2], a[3] * sigm(a[3]) * b[3]}; }
                *(u32x4*)(O + (size_t)(row0 + ai * HALF + m * 16) * ldo + col0) = pack8(v[0], v[1]);
            }
    }
};
template <class Sched> __device__ __forceinline__ void rowfac_prepass(const Sched& S, const float* rowfac, PG8_LAS float* rt, int tid) {
    Unit u; int n = 0; while (n < 8 && S.next(n, u)) ++n;
#pragma unroll
    for (int q = 0; q < 4; ++q) { const int r = tid + 512 * q, i = r >> 8; if (i < n) { S.next(i, u); rt[r] = rowfac[u.pm * BM + (r & 255)]; } }
    __syncthreads();
}
struct EpiSwiGLUNq {
    typedef i32x4 acc_t; static constexpr bool PERM = true, AFTER_DRAIN = false;
    bf16_t* O; int ldo; const PG8_LAS float* rt; const float* shw; int nphys; const float* colscale;
    __device__ __forceinline__ void operator()(const i32x4 (&acc)[2][2][4][2], const Unit& u, int wr, int wc, int fr, int fq) const {
        const int R0 = u.pm * BM, row0 = R0 + wr * 64 + fr, colp = u.pn * BM + wc * 32 + 8 * fq, col0 = u.pn * HALF + wc * 32 + 8 * fq;
        const float* sp = shw + (size_t)(R0 < ML_ ? (R0 >> 11) : 8) * nphys + colp; const float* cp = colscale + colp;
        f32x4 s1[2], s3[2], c1[2], c3[2];
#pragma unroll
        for (int n = 0; n < 2; ++n) { s1[n] = *(const f32x4*)(sp + 4 * n); s3[n] = *(const f32x4*)(sp + HALF + 4 * n); c1[n] = *(const f32x4*)(cp + 4 * n); c3[n] = *(const f32x4*)(cp + HALF + 4 * n); }
#pragma unroll
        for (int ai = 0; ai < 2; ++ai)
#pragma unroll
            for (int m = 0; m < 4; ++m) { const int row = row0 + ai * HALF + m * 16; const float rs = rt[u.idx * BM + (row - R0)];
                f32x4 v[2];
#pragma unroll
                for (int n = 0; n < 2; ++n) { const i32x4 ia = acc[ai][0][m][n], ib = acc[ai][1][m][n];
                    const f32x4 a = (f32x4){(float)ia[0], (float)ia[1], (float)ia[2], (float)ia[3]} * (c1[n] * rs) + s1[n], b = (f32x4){(float)ib[0], (float)ib[1], (float)ib[2], (float)ib[3]} * (c3[n] * rs) + s3[n];
                    v[n] = (f32x4){a[0] * sigm(a[0]) * b[0], a[1] * sigm(a[1]) * b[1], a[2] * sigm(a[2]) * b[2], a[3] * sigm(a[3]) * b[3]}; }
                *(u32x4*)(O + (size_t)row * ldo + col0) = pack8(v[0], v[1]);
            }
    }
};
struct EpiSwiGLUq {
    typedef i32x4 acc_t; static constexpr bool PERM = true, AFTER_DRAIN = false;
    unsigned char* O; int ldo, nN; const float* posscale; const float* colscale;
    __device__ __forceinline__ void operator()(const i32x4 (&acc)[2][2][4][2], const Unit& u, int wr, int wc, int fr, int fq) const {
        const int row0 = u.pm * BM + wr * 64 + fr, col0 = (u.pn % nN) * HALF + wc * 32 + 8 * fq; const float* cp = colscale + (size_t)u.pn * BM + wc * 32 + 8 * fq;
        f32x4 c1[2], c3[2];
#pragma unroll
        for (int n = 0; n < 2; ++n) { c1[n] = *(const f32x4*)(cp + 4 * n); c3[n] = *(const f32x4*)(cp + HALF + 4 * n); }
#pragma unroll
        for (int ai = 0; ai < 2; ++ai)
#pragma unroll
            for (int m = 0; m < 4; ++m) { const int row = row0 + ai * HALF + m * 16; const float rs = posscale[row];
                f32x4 v[2];
#pragma unroll
                for (int n = 0; n < 2; ++n) { const i32x4 ia = acc[ai][0][m][n], ib = acc[ai][1][m][n];
                    const f32x4 a = (f32x4){(float)ia[0], (float)ia[1], (float)ia[2], (float)ia[3]} * c1[n] * rs, b = (f32x4){(float)ib[0], (float)ib[1], (float)ib[2], (float)ib[3]} * c3[n] * rs;
                    v[n] = (f32x4){a[0] * sigm(a[0]) * b[0], a[1] * sigm(a[1]) * b[1], a[2] * sigm(a[2]) * b[2], a[3] * sigm(a[3]) * b[3]}; }
                u32x2 o; o.x = f8pack4(v[0]); o.y = f8pack4(v[1]); *(u32x2*)(O + (size_t)row * ldo + col0) = o;
            }
    }
};
struct EpiGLURes {
    typedef f32x4 acc_t; static constexpr bool PERM = true, AFTER_DRAIN = false, FP8 = true;
    bf16_t* X; const float* gate; const float* colscale;
    __device__ __forceinline__ void operator()(const f32x4 (&acc)[2][2][4][2], const Unit& u, int wr, int wc, int fr, int fq) const {
        const int R0 = u.pm * BM, row0 = R0 + wr * 64 + fr, col0 = u.pn * HALF + wc * 32 + 8 * fq;
        const float* gp = gate + (size_t)(R0 >> 11) * 6144 + col0; const float* cp = colscale + (size_t)u.pn * BM + wc * 32 + 8 * fq;
        f32x4 gv[2], c1[2], c2[2];
#pragma unroll
        for (int n = 0; n < 2; ++n) { gv[n] = *(const f32x4*)(gp + n * 4); c1[n] = *(const f32x4*)(cp + n * 4); c2[n] = *(const f32x4*)(cp + HALF + n * 4); }
#pragma unroll
        for (int ai = 0; ai < 2; ++ai)
#pragma unroll
            for (int m = 0; m < 4; ++m) { bf16_t* xp = X + (size_t)(row0 + ai * HALF + m * 16) * DM_ + col0; f32x4 x0, x1, y[2];
                unpack8(*(const u32x4*)xp, x0, x1);
#pragma unroll
                for (int n = 0; n < 2; ++n) { const f32x4 z1 = acc[ai][0][m][n] * c1[n], z2 = acc[ai][1][m][n] * c2[n]; y[n] = (f32x4){z1[0] * sigm(z2[0]), z1[1] * sigm(z2[1]), z1[2] * sigm(z2[2]), z1[3] * sigm(z2[3])}; }
                *(u32x4*)xp = pack8(x0 + gv[0] * y[0], x1 + gv[1] * y[1]); }
    }
};
struct EpiUC {
    typedef f32x4 acc_t; static constexpr bool PERM = true, AFTER_DRAIN = false;
    bf16_t* UC; const PG8_LAS float* rt; const float* shw;
    __device__ __forceinline__ void operator()(const f32x4 (&acc)[2][2][4][2], const Unit& u, int wr, int wc, int fr, int fq) const {
        const int R0 = u.pm * BM, row0 = R0 + wr * 64 + fr, col0 = u.pn * BM + wc * 32 + 8 * fq;
        const float* sp = shw + (size_t)(R0 < ML_ ? (R0 >> 11) : 8) * DM_ + col0;
        f32x4 sv[2][2];
#pragma unroll
        for (int bj = 0; bj < 2; ++bj)
#pragma unroll
            for (int n = 0; n < 2; ++n) sv[bj][n] = *(const f32x4*)(sp + bj * HALF + 4 * n);
#pragma unroll
        for (int ai = 0; ai < 2; ++ai)
#pragma unroll
            for (int m = 0; m < 4; ++m) { const int row = row0 + ai * HALF + m * 16; int bc, j; const float rs = rt[u.idx * BM + (row - R0)];
                if (row < ML_) { bc = (row >> 11) * 64 + ((row & 2047) >> 5); j = row & 31; } else { const int r2 = row - ML_; bc = 512 + (r2 >> 8) * 8 + ((r2 & 255) >> 5); j = r2 & 31; }
#pragma unroll
                for (int bj = 0; bj < 2; ++bj) { const int col = col0 + bj * HALF, g = col >> 4, qi = col & 15;
                    *(u32x4*)(UC + ((size_t)(g * 768 + bc) * 768 + j * 16 + qi)) = pack8(acc[ai][bj][m][0] * rs + sv[bj][0], acc[ai][bj][m][1] * rs + sv[bj][1]); } }
    }
};
struct EpiE {
    typedef f32x4 acc_t; static constexpr bool PERM = false, AFTER_DRAIN = false;
    float* E;
    __device__ __forceinline__ void operator()(const f32x4 (&acc)[2][2][4][2], const Unit& u, int wr, int wc, int fr, int fq) const {
        const int row0 = u.pm * BM + wr * 64 + fr, col0 = wc * 32 + 4 * fq;
#pragma unroll
        for (int ai = 0; ai < 2; ++ai)
#pragma unroll
            for (int m = 0; m < 4; ++m) { float* rp = E + (size_t)(row0 + ai * HALF + m * 16) * 256 + col0;
#pragma unroll
                for (int bj = 0; bj < 2; ++bj)
#pragma unroll
                    for (int n = 0; n < 2; ++n) *(f32x4*)(rp + bj * HALF + n * 16) = acc[ai][bj][m][n]; }
    }
};
struct EpiY {
    typedef f32x4 acc_t; static constexpr bool PERM = true, AFTER_DRAIN = false;
    unsigned char* Y;
    __device__ __forceinline__ void operator()(const f32x4 (&acc)[2][2][4][2], const Unit& u, int wr, int wc, int fr, int fq) const {
        const int g = u.pm / 3, pml = u.pm - 3 * g, pnl = u.pn & 1;
        const int bc0 = pml * BM + wr * 64 + fr, n0 = pnl * BM + wc * 32 + 8 * fq;
#pragma unroll
        for (int ai = 0; ai < 2; ++ai)
#pragma unroll
            for (int m = 0; m < 4; ++m) { const int bc = bc0 + ai * HALF + m * 16, tok0 = (bc >> 6) * 2048 + (bc & 63) * 32;
#pragma unroll
                for (int bj = 0; bj < 2; ++bj) { const int n = n0 + bj * HALF, tin = n >> 4, qo = n & 15; const f32x4 a = acc[ai][bj][m][0], b = acc[ai][bj][m][1];
                    const f32x4 ya = (f32x4){gelu_tanh(a[0]), gelu_tanh(a[1]), gelu_tanh(a[2]), gelu_tanh(a[3])}, yb = (f32x4){gelu_tanh(b[0]), gelu_tanh(b[1]), gelu_tanh(b[2]), gelu_tanh(b[3])};
                    u32x2 o; o.x = f8pack4(ya); o.y = f8pack4(yb); *(u32x2*)(Y + (size_t)(tok0 + tin) * DM_ + g * 16 + qo) = o; } }
    }
};
struct EpiMoE2 {
    typedef f32x4 acc_t; static constexpr bool PERM = true, AFTER_DRAIN = false, FP8 = true;
    bf16_t* Y2; const float* rowgate; const int* rowinfo; const float* colscale;
    __device__ __forceinline__ void operator()(const f32x4 (&acc)[2][2][4][2], const Unit& u, int wr, int wc, int fr, int fq) const {
        const int row0 = u.pm * BM + wr * 64 + fr, col0 = (u.pn & 3) * BM + wc * 32 + 8 * fq; const float* cp = colscale + (size_t)u.pn * BM + wc * 32 + 8 * fq;
        f32x4 cs[2][2];
#pragma unroll
        for (int bj = 0; bj < 2; ++bj)
#pragma unroll
            for (int n = 0; n < 2; ++n) cs[bj][n] = *(const f32x4*)(cp + bj * HALF + 4 * n);
#pragma unroll
        for (int ai = 0; ai < 2; ++ai)
#pragma unroll
            for (int m = 0; m < 4; ++m) { const int row = row0 + ai * HALF + m * 16; const float gt = rowgate[row]; const int ri = rowinfo[row];
                if (ri >= 0) {
#pragma unroll
                    for (int bj = 0; bj < 2; ++bj) *(u32x4*)(Y2 + (size_t)ri * DM_ + col0 + bj * HALF) = pack8(acc[ai][bj][m][0] * (cs[bj][0] * gt), acc[ai][bj][m][1] * (cs[bj][1] * gt)); } }
    }
};
struct OrderS5E { static constexpr bool VARK = false; int G, c;
    __device__ __forceinline__ bool next(int i, Unit& u) const {
        if (G == 256) { if (i > 0) return false; const int x = c & 7, j = c >> 3; if (j >= 24) return false; const int g = 8 * (j / 3) + x; u.pm = 3 * g + (j % 3); u.pn = g; u.k0 = 0; u.idx = i; return true; }
        const int L = i * G + c; if (L >= 192) return false; u.pm = L; u.pn = L / 3; u.k0 = 0; u.idx = i; return true; }
    __device__ __forceinline__ void a_ready(const Unit&) const {}
    __device__ __forceinline__ void done(const Unit&) const {} };
struct OrderS5Y { static constexpr bool VARK = false; int G, c;
    __device__ __forceinline__ bool next(int i, Unit& u) const {
        if (G == 256) { if (i > 0) return false; const int x = c & 7, j = c >> 3, g = 8 * (j >> 2) + x; u.pm = 3 * g + ((j >> 1) & 1); u.pn = 2 * g + (j & 1); u.k0 = 0; u.idx = i; return true; }
        const int L = i * G + c; if (L >= 256) return false; const int g = L >> 2; u.pm = 3 * g + ((L >> 1) & 1); u.pn = 2 * g + (L & 1); u.k0 = 0; u.idx = i; return true; }
    __device__ __forceinline__ void a_ready(const Unit&) const {}
    __device__ __forceinline__ void done(const Unit&) const {} };
struct OrderMoE { static constexpr bool VARK = false; int G, c, nN, tmax, fix; int toff[9];
    __device__ __forceinline__ bool next(int i, Unit& u) const {
        int pm, pnl; const int nt = toff[8] < tmax ? toff[8] : tmax;
        if (G == 256) {
            const int x = c & 7, j = c >> 3, nCB = nN >> 2, b = i * 8 + x, nRB = (nt + 7) >> 3; if (b >= nRB * nCB) return false;
            const int rb = b / nCB, cbk = b - rb * nCB; pm = 8 * rb + (j & 7); pnl = 4 * cbk + (j >> 3);
        } else { const int L = i * G + c; pm = L / nN; pnl = L - pm * nN; }
        if (pm >= nt) return false;
        int e = 0;
#pragma unroll
        for (int k = 1; k < 8; ++k) e += (pm >= toff[k]) ? 1 : 0;
        u.pm = fix ? 0 : pm; u.pn = fix ? pnl & 3 : e * nN + pnl; u.k0 = 0; u.idx = i; return true; }
    __device__ __forceinline__ void a_ready(const Unit&) const {}
    __device__ __forceinline__ void done(const Unit&) const {} };
struct OrderMoEx { static constexpr bool VARK = true; int G, c; int toff[9];
    __device__ __forceinline__ bool next(int i, Unit& u) const {
        const int s = i * G + c, tl = s >> 4, pm = 128 + tl; if (pm >= toff[8]) return false;
        int e = 0;
#pragma unroll
        for (int k = 1; k < 8; ++k) e += (pm >= toff[k]) ? 1 : 0;
        const int ks = s & 3; u.pm = pm; u.pn = e * 4 + ((s >> 2) & 3); u.k0 = (ks * 8 - (ks == 3 ? 2 : 0)) * BK; u.idx = ks; return true; }
    __device__ __forceinline__ int ktiles(const Unit& u) const { return u.idx < 2 ? 8 : 6; }
    __device__ __forceinline__ void a_ready(const Unit&) const {}
    __device__ __forceinline__ void done(const Unit&) const {} };
struct EpiMoE2x {
    typedef f32x4 acc_t; static constexpr bool PERM = false, AFTER_DRAIN = false, FP8 = true;
    float* P; const float* rowgate; const float* colscale;
    __device__ __forceinline__ void operator()(const f32x4 (&acc)[2][2][4][2], const Unit& u, int wr, int wc, int fr, int fq) const {
        const int ks = u.idx, tl = u.pm - 128, r0 = wr * 64 + fr, col0 = (u.pn & 3) * BM + wc * 32 + 4 * fq;
        const __amdgpu_buffer_rsrc_t crs = __builtin_amdgcn_make_buffer_rsrc((void*)colscale, 0, 8 * 1024 * 4, 0x00020000);
        f32x4 cs[2][2];
#pragma unroll
        for (int bj = 0; bj < 2; ++bj)
#pragma unroll
            for (int n = 0; n < 2; ++n) cs[bj][n] = __builtin_bit_cast(f32x4, __builtin_amdgcn_raw_buffer_load_b128(crs, (u.pn * BM + wc * 32 + 4 * fq + bj * HALF + n * 16) * 4, 0, 0));
        float* pb = P + ((size_t)(ks * 8 + tl) * 256) * DM_;
        const __amdgpu_buffer_rsrc_t grs = __builtin_amdgcn_make_buffer_rsrc((void*)rowgate, 0, 136 * 256 * 4, 0x00020000);
#pragma unroll
        for (int ai = 0; ai < 2; ++ai)
#pragma unroll
            for (int m = 0; m < 4; ++m) { const int r = r0 + ai * HALF + m * 16; const float gt = __builtin_bit_cast(float, __builtin_amdgcn_raw_buffer_load_b32(grs, (u.pm * BM + r) * 4, 0, 0));
#pragma unroll
                for (int bj = 0; bj < 2; ++bj)
#pragma unroll
                    for (int n = 0; n < 2; ++n) *(f32x4*)(pb + (size_t)r * DM_ + col0 + bj * HALF + n * 16) = acc[ai][bj][m][n] * (cs[bj][n] * gt); }
    }
};
template <class Epi, class Sched, bool ALIGN_EPI = false, bool SP2 = false, bool GATHER = false>
__device__ __forceinline__ void gemm_phase(PG8_LAS unsigned char* lds, const Gemm g, const Sched& S, const Epi& E) {
    const int tid = threadIdx.x, wid = __builtin_amdgcn_readfirstlane(tid >> 6), lane = tid & 63, wr = wid >> 2, wc = wid & 3, fr = lane & 15, fq = lane >> 4;
    const int K = g.K; int nt = K / BK;
    unsigned voffA[2], voffB[2]; int RA[2]; unsigned CA[2];
    static_assert(!GATHER || SP2, "the gathered A operand is wired into the SP2 loop only");
#pragma unroll
    for (int i = 0; i < 2; ++i) { int R, C; stage_rc(tid * 16 + i * 8192, R, C); const int Rb = Epi::PERM ? ((R & ~31) + perm32(R & 31)) : R;
        voffA[i] = (unsigned)(R * g.lda + C) * 2u; voffB[i] = (unsigned)(Rb * g.ldb + C) * 2u; RA[i] = R; CA[i] = (unsigned)C * 2u; }
    const size_t kstep = (size_t)(BK * 2);
    const size_t hstepA = (size_t)HALF * g.lda * 2, hstepB = (size_t)HALF * g.ldb * 2;
    const size_t tstepA = 2 * hstepA, tstepB = 2 * hstepB;
    const unsigned ldsw = (unsigned)wid * 1024u;
    const int aoff = lds_byte(wr * 64 + fr, fq * 8), boff = lds_byte(wc * 32 + fr, fq * 8);
#define PG8_SA(b, h) (((b) * 2 + (h)) * HTB)
#define PG8_SB(b, h) ((4 + (b) * 2 + (h)) * HTB)
#define PG8_STAGE(bufoff, gbase, voff) do { _Pragma("unroll") for (int _i = 0; _i < 2; ++_i) \
        __builtin_amdgcn_global_load_lds((const unsigned*)((const char*)(gbase) + (voff)[_i]), (PG8_LAS unsigned*)(lds + (bufoff) + ldsw + _i * 8192), 16, 0, 0); } while (0)
#define PG8_LDA(dst, b, h) do { _Pragma("unroll") for (int m = 0; m < 4; ++m) _Pragma("unroll") for (int k = 0; k < 2; ++k) dst[m].set(k, *(const PG8_LAS bf16x8*)(lds + PG8_SA(b, h) + aoff + m * 2048 + k * 1024)); } while (0)
#define PG8_LDB(dst, b, h) do { _Pragma("unroll") for (int n = 0; n < 2; ++n) _Pragma("unroll") for (int k = 0; k < 2; ++k) dst[n].set(k, *(const PG8_LAS bf16x8*)(lds + PG8_SB(b, h) + boff + n * 2048 + k * 1024)); } while (0)
#define PG8_MMA(ai, bj, At, Bt) do { __builtin_amdgcn_s_setprio(1); _Pragma("unroll") for (int m = 0; m < 4; ++m) _Pragma("unroll") for (int n = 0; n < 2; ++n) \
        acc[ai][bj][m][n] = mma_frag(Bt[n], At[m], acc[ai][bj][m][n]); __builtin_amdgcn_s_setprio(0); } while (0)
#define PG8_WAIT_V(n) asm volatile("s_waitcnt vmcnt(" #n ")" ::: "memory")
#define PG8_WAIT_L(n) asm volatile("s_waitcnt lgkmcnt(" #n ")" ::: "memory")
#define PG8_BAR __builtin_amdgcn_s_barrier()
#define PG8_SCHED __builtin_amdgcn_sched_barrier(0)
#define PG8_GIDX(d0, d1, un) do { _Pragma("unroll") for (int _i = 0; _i < 2; ++_i) { const int* _rp = g.rowsrc + (un).pm * BM + RA[_i]; d0[_i] = (unsigned)_rp[0] * (unsigned)(g.lda * 2) + CA[_i]; d1[_i] = (unsigned)_rp[HALF] * (unsigned)(g.lda * 2) + CA[_i]; } } while (0)
    Unit cur, nxt; int ui = 0;
    if (!S.next(0, cur)) return;
    if constexpr (Sched::VARK) nt = S.ktiles(cur);
    typedef typename Epi::acc_t acc_t;
    acc_t acc[2][2][4][2];
#pragma unroll
    for (int a = 0; a < 2; ++a)
#pragma unroll
        for (int b = 0; b < 2; ++b)
#pragma unroll
            for (int m = 0; m < 4; ++m)
#pragma unroll
                for (int n = 0; n < 2; ++n) acc[a][b][m][n] = (acc_t){0, 0, 0, 0};
    Frag<is_fp8<Epi>::v> At[4], B0[2], B1[2];
    const char* cA = (const char*)g.A + (size_t)cur.pm * tstepA + (size_t)cur.k0 * 2; const char* cB = (const char*)g.Bt + (size_t)cur.pn * tstepB + (size_t)cur.k0 * 2;
    S.a_ready(cur);
    unsigned cv0[2] = {0u, 0u}, cv1[2] = {0u, 0u}, nv0[2] = {0u, 0u}, nv1[2] = {0u, 0u}; const char* gA = (const char*)g.A;
    if constexpr (GATHER) { PG8_GIDX(cv0, cv1, cur); nv0[0] = cv0[0]; nv0[1] = cv0[1]; nv1[0] = cv1[0]; nv1[1] = cv1[1]; }
    if constexpr (SP2) {
        PG8_STAGE(PG8_SB(0, 0), cB, voffB); PG8_STAGE(PG8_SB(0, 1), cB + hstepB, voffB);
        if constexpr (GATHER) { PG8_STAGE(PG8_SA(0, 0), gA, cv0); PG8_STAGE(PG8_SA(0, 1), gA, cv1); } else { PG8_STAGE(PG8_SA(0, 0), cA, voffA); PG8_STAGE(PG8_SA(0, 1), cA + hstepA, voffA); }
        if (wr == 1) PG8_BAR;
        PG8_WAIT_V(2); PG8_BAR;
        PG8_STAGE(PG8_SB(1, 0), cB + kstep, voffB); if constexpr (GATHER) PG8_STAGE(PG8_SA(1, 0), gA + kstep, cv0); else PG8_STAGE(PG8_SA(1, 0), cA + kstep, voffA); PG8_STAGE(PG8_SB(1, 1), cB + hstepB + kstep, voffB);
        PG8_WAIT_V(6); PG8_BAR;
    } else {
        PG8_STAGE(PG8_SB(0, 0), cB, voffB); PG8_STAGE(PG8_SA(0, 0), cA, voffA); PG8_STAGE(PG8_SB(0, 1), cB + hstepB, voffB); PG8_STAGE(PG8_SA(0, 1), cA + hstepA, voffA);
        if (wr == 1) PG8_BAR;
        PG8_WAIT_V(4); PG8_BAR;
        PG8_STAGE(PG8_SB(1, 0), cB + kstep, voffB); PG8_STAGE(PG8_SA(1, 0), cA + kstep, voffA); PG8_STAGE(PG8_SB(1, 1), cB + hstepB + kstep, voffB);
        PG8_WAIT_V(6); PG8_BAR;
    }
    for (;;) {
        const bool has_next = S.next(ui + 1, nxt);
        const char* nA = has_next ? (const char*)g.A + (size_t)nxt.pm * tstepA + (size_t)nxt.k0 * 2 : cA; const char* nB = has_next ? (const char*)g.Bt + (size_t)nxt.pn * tstepB + (size_t)nxt.k0 * 2 : cB;
        for (int t = 0; t < nt; t += 2) {
            const bool last = (t == nt - 2);
            const char* a1 = cA + (size_t)(t + 1) * kstep;
            const char* a2 = last ? nA : cA + (size_t)(t + 2) * kstep; const char* b2 = last ? nB : cB + (size_t)(t + 2) * kstep;
            const char* a3 = a2 + kstep; const char* b3 = b2 + kstep;
            if (last && has_next) S.a_ready(nxt);
            if constexpr (GATHER) { if (t == nt - 4 && has_next) PG8_GIDX(nv0, nv1, nxt); }
            const char* g1 = gA + (size_t)(t + 1) * kstep; const char* g2 = last ? gA : gA + (size_t)(t + 2) * kstep; const char* g3 = g2 + kstep;
            unsigned x0[2], x1[2]; x0[0] = last ? nv0[0] : cv0[0]; x0[1] = last ? nv0[1] : cv0[1]; x1[0] = last ? nv1[0] : cv1[0]; x1[1] = last ? nv1[1] : cv1[1];
            if constexpr (SP2) {
            PG8_LDB(B0, 0, 0); PG8_LDB(B1, 0, 1); PG8_SCHED; PG8_LDA(At, 0, 0); if constexpr (GATHER) PG8_STAGE(PG8_SA(1, 1), g1, cv1); else PG8_STAGE(PG8_SA(1, 1), a1 + hstepA, voffA);
            PG8_WAIT_V(8); PG8_WAIT_L(0); PG8_BAR; PG8_MMA(0, 0, At, B0); PG8_MMA(0, 1, At, B1); PG8_BAR; PG8_SCHED;
            PG8_LDA(At, 0, 1); PG8_STAGE(PG8_SB(0, 0), b2, voffB); PG8_STAGE(PG8_SB(0, 1), b2 + hstepB, voffB); if constexpr (GATHER) PG8_STAGE(PG8_SA(0, 0), g2, x0); else PG8_STAGE(PG8_SA(0, 0), a2, voffA);
            PG8_WAIT_V(8); PG8_WAIT_L(0); PG8_BAR; PG8_MMA(1, 0, At, B0); PG8_MMA(1, 1, At, B1); PG8_BAR; PG8_SCHED;
            PG8_LDB(B0, 1, 0); PG8_LDB(B1, 1, 1); PG8_SCHED; PG8_LDA(At, 1, 0); if constexpr (GATHER) PG8_STAGE(PG8_SA(0, 1), g2, x1); else PG8_STAGE(PG8_SA(0, 1), a2 + hstepA, voffA);
            PG8_WAIT_V(8); PG8_WAIT_L(0); PG8_BAR; PG8_MMA(0, 0, At, B0); PG8_MMA(0, 1, At, B1); PG8_BAR; PG8_SCHED;
            PG8_LDA(At, 1, 1); PG8_STAGE(PG8_SB(1, 0), b3, voffB); PG8_STAGE(PG8_SB(1, 1), b3 + hstepB, voffB); if constexpr (GATHER) PG8_STAGE(PG8_SA(1, 0), g3, x0); else PG8_STAGE(PG8_SA(1, 0), a3, voffA);
            PG8_WAIT_V(8); PG8_WAIT_L(0); PG8_BAR; PG8_MMA(1, 0, At, B0); PG8_MMA(1, 1, At, B1); PG8_BAR; PG8_SCHED;
            } else {
            PG8_LDB(B0, 0, 0); PG8_SCHED; PG8_LDA(At, 0, 0); PG8_STAGE(PG8_SA(1, 1), a1 + hstepA, voffA);
            PG8_WAIT_L(8); PG8_BAR; PG8_WAIT_L(0); PG8_MMA(0, 0, At, B0); PG8_BAR; PG8_SCHED;
            PG8_LDB(B1, 0, 1); PG8_STAGE(PG8_SB(0, 0), b2, voffB);
            PG8_BAR; PG8_WAIT_L(0); PG8_MMA(0, 1, At, B1); PG8_BAR;
            PG8_LDA(At, 0, 1); PG8_STAGE(PG8_SA(0, 0), a2, voffA);
            PG8_BAR; PG8_WAIT_L(0); PG8_MMA(1, 0, At, B0); PG8_BAR; PG8_SCHED;
            PG8_STAGE(PG8_SB(0, 1), b2 + hstepB, voffB);
            PG8_WAIT_V(6); PG8_BAR; PG8_MMA(1, 1, At, B1); PG8_BAR;
            PG8_LDB(B0, 1, 0); PG8_SCHED; PG8_LDA(At, 1, 0); PG8_STAGE(PG8_SA(0, 1), a2 + hstepA, voffA);
            PG8_WAIT_L(8); PG8_BAR; PG8_WAIT_L(0); PG8_MMA(0, 0, At, B0); PG8_BAR; PG8_SCHED;
            PG8_LDB(B1, 1, 1); PG8_STAGE(PG8_SB(1, 0), b3, voffB);
            PG8_BAR; PG8_WAIT_L(0); PG8_MMA(0, 1, At, B1); PG8_BAR;
            PG8_LDA(At, 1, 1); PG8_STAGE(PG8_SA(1, 0), a3, voffA);
            PG8_BAR; PG8_WAIT_L(0); PG8_MMA(1, 0, At, B0); PG8_BAR; PG8_SCHED;
            PG8_STAGE(PG8_SB(1, 1), b3 + hstepB, voffB);
            PG8_WAIT_V(6); PG8_BAR; PG8_MMA(1, 1, At, B1); PG8_BAR;
            }
        }
        if constexpr (ALIGN_EPI) { if (wr == 0) PG8_BAR; }
        mma_drain<is_fp8<Epi>::v>();
        if constexpr (!Epi::AFTER_DRAIN) { E(acc, cur, wr, wc, fr, fq); S.done(cur); }
        if (!has_next) break;
#pragma unroll
        for (int a = 0; a < 2; ++a)
#pragma unroll
            for (int b = 0; b < 2; ++b)
#pragma unroll
                for (int m = 0; m < 4; ++m)
#pragma unroll
                    for (int n = 0; n < 2; ++n) acc[a][b][m][n] = (acc_t){0, 0, 0, 0};
        cur = nxt; cA = nA; cB = nB; ++ui; if constexpr (Sched::VARK) nt = S.ktiles(cur);
        if constexpr (GATHER) { cv0[0] = nv0[0]; cv0[1] = nv0[1]; cv1[0] = nv1[0]; cv1[1] = nv1[1]; }
        if constexpr (ALIGN_EPI) { if (wr == 1) PG8_BAR; }
    }
    PG8_WAIT_V(0);
    if constexpr (!ALIGN_EPI) { if (wr == 0) PG8_BAR; }
    PG8_BAR;
    if constexpr (Epi::AFTER_DRAIN) { E.fused(acc, cur, wr, wc, fr, fq, lds, wid, lane); S.done(cur); }
#undef PG8_SA
#undef PG8_SB
#undef PG8_STAGE
#undef PG8_LDA
#undef PG8_LDB
#undef PG8_MMA
#undef PG8_WAIT_V
#undef PG8_WAIT_L
#undef PG8_BAR
#undef PG8_SCHED
#undef PG8_GIDX
}
}

constexpr int NB = 8, SEQ = 2048, NCTX = 256, D = 1024;
constexpr int ML = NB * SEQ, MC = NB * NCTX, MT = ML + MC;
constexpr int MIXIN = 2560, FFN = 2816, NE = 8, ED = 3584;
constexpr float EPS = 1e-6f;
constexpr int NWAVES = 8;
constexpr int MOE_TILES = 136;

constexpr size_t MiB = 1u << 20;
constexpr size_t WS_CTL = 0, CTL_ZERO_BYTES = 65536;
constexpr size_t WS_MOD = 65536, WS_MODP = 1 * MiB; constexpr int MOD_N = 2 * 9 * 6144;
constexpr size_t WS_ROWSS = 3 * MiB, WS_SHW13 = 4608 * 1024, WS_SHWS = WS_SHW13 + 9 * 5632 * 4;
constexpr size_t WS_ROWSC = 2800 * 1024, WS_POSSC = 2864 * 1024, WS_COLMAX = 4864 * 1024, WS_COLSC = WS_COLMAX;
constexpr size_t WS_COLSCD = WS_COLMAX + (size_t)NE * 2 * ED * 4, WS_PMAX = 376 * MiB, WS_ROWFAC1 = WS_POSSC;
constexpr size_t WS_COLSC2 = 4352 * 1024;
constexpr size_t WS_COLSCS = WS_COLSC2 + 32768;
constexpr size_t WS_TOK = 5 * MiB;
constexpr size_t TOK_E = 0, TOK_W = 128 * 1024, TOK_RANK = 256 * 1024, TOK_POS = 384 * 1024, TOK_WGBASE = 512 * 1024, TOK_ROWGATE = 576 * 1024, TOK_ROWSRC = 720 * 1024, TOK_ROWINFO = 864 * 1024;
constexpr size_t WS_MW13 = 6 * MiB, WS_MW2 = 118 * MiB;
constexpr size_t WS_XL = 174 * MiB, WS_H = 238 * MiB, WS_XC = 274 * MiB;
constexpr size_t WS_WIN = 282 * MiB, WS_WOUT = 287 * MiB, WS_W13 = 289 * MiB, WS_W2 = 300 * MiB, WS_SIN = 306 * MiB, WS_SOUT = 308 * MiB;
constexpr size_t WS_BTOUT = 312 * MiB, WS_WEND = 360 * MiB, WS_R = 376 * MiB, WS_END = 512 * MiB;
constexpr size_t WS_QKVU = WS_R, WS_MIX = WS_R + 72 * MiB, WS_ACT = WS_R;
constexpr size_t WS_UC = WS_R, WS_E = WS_R + 72 * MiB, WS_Y = WS_R + 72 * MiB;
constexpr size_t WS_PX = WS_H;
constexpr size_t WS_ACTM = 274 * MiB;
static_assert(WS_ACTM + (size_t)MOE_TILES * 256 * ED * 2 <= WS_END && WS_XC + (size_t)MC * D * 4 <= WS_WIN && WS_H + (size_t)MT * D * 2 <= WS_XC && WS_MW2 + (size_t)NE * D * ED * 2 <= WS_XL, "d_ws map");
constexpr int CW_TMO = 0, CW_CODE = 1, CW_BAR = 4096, CW_GCNT = 8192;

constexpr int RING_OFF = 0, RING_BYTES = 131072;
constexpr int LDSCTL_OFF = 155648, MISC_OFF = LDSCTL_OFF + 320;
constexpr int LDS_BYTES = 159744;
static_assert(MISC_OFF + 128 <= LDS_BYTES, "LDS map");

#define GAS __attribute__((address_space(1)))
#define LAS __attribute__((address_space(3)))
typedef unsigned short bf16;
typedef unsigned v4u __attribute__((ext_vector_type(4)));
typedef unsigned v2u __attribute__((ext_vector_type(2)));
typedef float f32x4 __attribute__((ext_vector_type(4)));
typedef float f32x2 __attribute__((ext_vector_type(2)));
typedef float f32x16 __attribute__((ext_vector_type(16)));
typedef short bf16x8 __attribute__((ext_vector_type(8)));
typedef GAS unsigned gu32;
#define RLX_AGENT __ATOMIC_RELAXED, __HIP_MEMORY_SCOPE_AGENT
#define LDS_WAIT() asm volatile("s_waitcnt lgkmcnt(0)" ::: "memory")
#define VM_WAIT() asm volatile("s_waitcnt vmcnt(0)" ::: "memory")
__device__ __forceinline__ unsigned f2bf(float f) { unsigned u = __builtin_bit_cast(unsigned, f); return (u + 0x7fffu + ((u >> 16) & 1u)) >> 16; }
__device__ __forceinline__ unsigned pk2(float lo, float hi) { return f2bf(lo) | (f2bf(hi) << 16); }
__device__ __forceinline__ float bf2f(unsigned short h) { return __builtin_bit_cast(float, (unsigned)h << 16); }
__device__ __forceinline__ float bflo(unsigned w) { return __builtin_bit_cast(float, w << 16); }
__device__ __forceinline__ float bfhi(unsigned w) { return __builtin_bit_cast(float, w & 0xffff0000u); }
__device__ __forceinline__ float sigm(float x) { return __builtin_amdgcn_rcpf(1.0f + __expf(-x)); }
__device__ __forceinline__ float wave_sum(float v) {
#pragma unroll
    for (int o = 1; o < 64; o <<= 1) v += __shfl_xor(v, o);
    return v;
}
__device__ __forceinline__ float wave_max(float v) {
#pragma unroll
    for (int o = 1; o < 64; o <<= 1) v = fmaxf(v, __shfl_xor(v, o));
    return v;
}
#define XB_TMO      128
#define XB_XCNT(j)  (256  + 64 * (j))
#define XB_XSUB(j)  (1280 + 64 * (j))
#define XB_XGEN(j)  (2304 + 64 * (j))
#define XB_TOP      3328
#define XB_TOPGEN   3392
#define XCD_BAR_WORDS 3456
#define XB_SPIN_CAP (1u << 18)

__device__ __forceinline__ unsigned xb_ld(unsigned* p)              { return __hip_atomic_load(p, __ATOMIC_RELAXED, __HIP_MEMORY_SCOPE_AGENT); }
__device__ __forceinline__ unsigned xb_add(unsigned* p, unsigned v) { return __hip_atomic_fetch_add(p, v, __ATOMIC_RELAXED, __HIP_MEMORY_SCOPE_AGENT); }
__device__ __forceinline__ unsigned xb_xcc_id() { return (unsigned)__builtin_amdgcn_s_getreg((3 << 11) | 20) & 0xFu; }
#define XB_SPIN(cond, bar) do { unsigned _sp = 0; while (cond) { __builtin_amdgcn_s_sleep(1); \
    if ((++_sp & 255u) == 0u) { if (xb_ld(&(bar)[XB_TMO])) break; if (_sp > XB_SPIN_CAP) { atomicAdd(&(bar)[XB_TMO], 1u); break; } } } } while (0)

struct XcdBarrier {
    unsigned* bar; unsigned x;
    volatile LAS unsigned* st;
};

__device__ __forceinline__ XcdBarrier xcd_barrier_post(unsigned* bar, volatile LAS unsigned* st) {
    XcdBarrier b; b.bar = bar; b.x = xb_xcc_id(); b.st = st;
    if (threadIdx.x == 0) (void)xb_add(&bar[XB_XCNT(b.x)], 1u);
    return b;
}
__device__ __forceinline__ void xcd_barrier_complete(unsigned* bar, unsigned x, unsigned& nloc, unsigned& nx) {
    const unsigned G = gridDim.x * gridDim.y * gridDim.z;
    unsigned sum, cnt, mine, sp = 0u;
    for (;;) {
        sum = 0u; cnt = 0u; mine = 0u;
#pragma unroll
        for (unsigned j = 0; j < 16; ++j) { const unsigned c = xb_ld(&bar[XB_XCNT(j)]); sum += c; cnt += (c > 0u) ? 1u : 0u; mine = (j == x) ? c : mine; }
        if (sum == G) break;
        __builtin_amdgcn_s_sleep(1);
        if ((++sp & 255u) == 0u) { if (xb_ld(&bar[XB_TMO])) break; if (sp > XB_SPIN_CAP) { atomicAdd(&bar[XB_TMO], 1u); break; } }
    }
    nloc = mine > 0u ? mine : 1u; nx = cnt > 0u ? cnt : 1u;
}

__device__ __forceinline__ void xcd_barrier(const XcdBarrier& b) {
    asm volatile("s_waitcnt vmcnt(0)" ::: "memory");
    __syncthreads();
    if (threadIdx.x == 0) {
        unsigned* bar = b.bar;
        __builtin_amdgcn_s_waitcnt(0);
        unsigned nloc = b.st[0], nx = b.st[1];
        if (nloc == 0u) { xcd_barrier_complete(bar, b.x, nloc, nx); b.st[0] = nloc; b.st[1] = nx; }
        const unsigned old = xb_add(&bar[XB_XSUB(b.x)], 1u);
        const unsigned gen = old / nloc;
        if (old + 1u == (gen + 1u) * nloc) {
            __builtin_amdgcn_fence(__ATOMIC_RELEASE, "agent");
            asm volatile("s_waitcnt vmcnt(0)" ::: "memory");
            const unsigned og = xb_add(&bar[XB_TOP], 1u);
            const unsigned tg = og / nx;
            if (og + 1u == (tg + 1u) * nx) xb_add(&bar[XB_TOPGEN], 1u);
            else XB_SPIN(xb_ld(&bar[XB_TOPGEN]) == tg, bar);
            __builtin_amdgcn_fence(__ATOMIC_ACQUIRE, "agent");
            xb_add(&bar[XB_XGEN(b.x)], 1u);
            asm volatile("s_waitcnt vmcnt(0)" ::: "memory");
        } else {
            XB_SPIN(xb_ld(&bar[XB_XGEN(b.x)]) == gen, bar);
            __builtin_amdgcn_fence(__ATOMIC_ACQUIRE, "agent");
            asm volatile("s_waitcnt vmcnt(0)" ::: "memory");
        }
    }
    __syncthreads();
}
enum { I_X = 0, I_C, I_CTX, I_CCTX, I_ADAW, I_ADAB, I_N1G, I_N2G, I_MIXWIN, I_QG, I_KG, I_RPB, I_DWW, I_DWB, I_LNG, I_LNB, I_MIXWOUT, I_FW1, I_FW3, I_FW2,
       I_SWIN, I_ARE, I_AIM, I_LOGDT, I_BRE, I_BIM, I_CRE, I_CIM, I_SD, I_SWOUT, I_ROUTER, I_MW1, I_MW3, I_MW2, N_IN };
struct Args { const float* in[N_IN]; float* out; unsigned char* ws; int ph_lo, ph_hi, sub, pad; };

typedef short s16x4 __attribute__((ext_vector_type(4)));
typedef float f32x2_t __attribute__((ext_vector_type(2)));
typedef __bf16 bf16x2_t __attribute__((ext_vector_type(2)));
__device__ __forceinline__ unsigned cvtpk(float lo, float hi) { const f32x2_t v = {lo, hi}; const bf16x2_t b = __builtin_convertvector(v, bf16x2_t); return __builtin_bit_cast(unsigned, b); }
__device__ __forceinline__ s16x4 vtr(const LAS unsigned char* p) { return __builtin_bit_cast(s16x4, __builtin_amdgcn_ds_read_tr16_b64_v4i16((LAS s16x4*)p)); }
__device__ __forceinline__ void p0_adaln(const Args& A, int unit, LAS unsigned char* lds, int tid, int wave, int lane) {
    const int l = unit / 96, rem = unit % 96, cb = rem >> 2, kq = rem & 3;
    LAS float* sc = (LAS float*)lds;
    LAS float* part = sc + 9 * 256;
    const float* c = A.in[I_C]; const float* cc = A.in[I_CCTX];
    for (int i = tid; i < 9 * 256; i += NWAVES * 64) { const int r = i >> 8, k = 256 * kq + (i & 255); const float v = r < 8 ? c[r * 1024 + k] : cc[k]; sc[i] = v * sigm(v); }
    __syncthreads();
    const float* wp = A.in[I_ADAW] + (size_t)l * 1024 * 6144 + (size_t)(256 * kq + 32 * wave) * 6144 + 256 * cb + 4 * lane;
    float acc[9][4];
#pragma unroll
    for (int r = 0; r < 9; ++r)
#pragma unroll
        for (int j = 0; j < 4; ++j) acc[r][j] = 0.f;
#pragma unroll 8
    for (int it = 0; it < 32; ++it) {
        const f32x4 wv = *(const f32x4*)(wp + (size_t)it * 6144); const int k = 32 * wave + it;
#pragma unroll
        for (int r = 0; r < 9; ++r) { const float s = sc[r * 256 + k];
#pragma unroll
            for (int j = 0; j < 4; ++j) acc[r][j] += s * wv[j]; }
    }
#pragma unroll
    for (int r = 0; r < 9; ++r) *(LAS f32x4*)(part + (wave * 9 + r) * 256 + 4 * lane) = (f32x4){acc[r][0], acc[r][1], acc[r][2], acc[r][3]};
    __syncthreads();
    float* modp = (float*)(A.ws + WS_MODP) + (size_t)kq * MOD_N;
    for (int i = tid; i < 9 * 256; i += NWAVES * 64) { const int r = i >> 8, col = i & 255; float s = 0.f;
#pragma unroll
        for (int w = 0; w < 8; ++w) s += part[(w * 9 + r) * 256 + col];
        if (kq == 0) s += A.in[I_ADAB][l * 6144 + 256 * cb + col];
        modp[((size_t)l * 9 + r) * 6144 + 256 * cb + col] = s; }
    __syncthreads();
}
constexpr int KTS = 260;
__device__ __forceinline__ void p0_s5gen(const Args& A, int g, int part, LAS unsigned char* lds, int tid) {
    LAS f32x2* POW = (LAS f32x2*)lds;
    LAS float* BBr = (LAS float*)(POW + 2 * 64 * 33 + 8);
    LAS float* BBi = BBr + 2 * 64 * 16;
    LAS f32x2* CC = (LAS f32x2*)(BBi + 2 * 64 * 16);
    LAS f32x2* CT = CC + 2 * 16 * 66 + 8;
    LAS float* KT = (LAS float*)(CT + 2 * 64 * 16);
    LAS f32x2* FF = (LAS f32x2*)(KT + 63 * KTS);
#define PWI(d_, p_, m_) (((d_) * 64 + (p_)) * 33 + (m_) + ((p_) >> 5) + (d_) * 4)
#define CCI(d_, q_, p_) (((d_) * 16 + (q_)) * 66 + (p_) + ((p_) >> 5) + (d_) * 4)
    if (tid < 128) { const int d = tid >> 6, p = tid & 63, ix = (d * 64 + g) * 64 + p;
        const float ar = A.in[I_ARE][ix], ai = A.in[I_AIM][ix], dt = __expf(A.in[I_LOGDT][d * 64 + g]);
        const float zr = ar * dt, zi = ai * dt, mag = __expf(zr); const float lr = mag * cosf(zi), li = mag * sinf(zi);
        float pr = 1.f, pi = 0.f;
        for (int m = 0; m <= 32; ++m) { POW[PWI(d, p, m)] = (f32x2){pr, pi}; const float nr = pr * lr - pi * li, ni = pr * li + pi * lr; pr = nr; pi = ni; }
        const float nr = lr - 1.f, ni = li, den = 1.f / (ar * ar + ai * ai);
        FF[d * 64 + p] = (f32x2){(nr * ar + ni * ai) * den, (ni * ar - nr * ai) * den}; }
    __syncthreads();
    for (int i = tid; i < 2048; i += NWAVES * 64) { const int d = i >> 10, p = (i >> 4) & 63, q = i & 15; const int ix = ((d * 64 + g) * 64 + p) * 16 + q;
        const float br = A.in[I_BRE][ix], bi = A.in[I_BIM][ix]; const f32x2 f = FF[d * 64 + p];
        BBr[(d * 64 + p) * 16 + q] = f.x * br - f.y * bi; BBi[(d * 64 + p) * 16 + q] = f.x * bi + f.y * br; }
    for (int i = tid; i < 2048; i += NWAVES * 64) { const int d = i >> 10, q = (i >> 6) & 15, p = i & 63; const int ix = ((d * 64 + g) * 16 + q) * 64 + p;
        const f32x2 cv2 = (f32x2){A.in[I_CRE][ix], A.in[I_CIM][ix]}; CC[CCI(d, q, p)] = cv2; CT[(d * 64 + p) * 16 + q] = cv2; }
    __syncthreads();
    bf16* BtOut = (bf16*)(A.ws + WS_BTOUT) + (size_t)g * 512 * 768;
    bf16* WEnd = (bf16*)(A.ws + WS_WEND) + (size_t)g * 256 * 512;
    if (part == 0) {
#pragma unroll 1
    for (int d = 0; d < 2; ++d) {
        const int dl = tid >> 4, qo = tid & 15; float acc[16];
#pragma unroll
        for (int i = 0; i < 16; ++i) acc[i] = 0.f;
#pragma unroll 2
        for (int p = 0; p < 64; ++p) { const f32x2 c = CT[(d * 64 + p) * 16 + qo], w = POW[PWI(d, p, dl)]; const float tr = c.x * w.x - c.y * w.y, ti = c.x * w.y + c.y * w.x;
            const LAS f32x4* br = (const LAS f32x4*)(BBr + (d * 64 + p) * 16); const LAS f32x4* bi = (const LAS f32x4*)(BBi + (d * 64 + p) * 16);
#pragma unroll
            for (int q4 = 0; q4 < 4; ++q4) { const f32x4 r4 = br[q4], i4 = bi[q4];
#pragma unroll
                for (int j = 0; j < 4; ++j) acc[4 * q4 + j] += tr * r4[j] - ti * i4[j]; } }
        if (d == 0) {
            { const float dsk = (dl == 0) ? A.in[I_SD][g * 16 + qo] : 0.f;
#pragma unroll
              for (int i = 0; i < 16; ++i) acc[i] += (i == qo) ? dsk : 0.f; }
#pragma unroll
            for (int i = 0; i < 4; ++i) *(LAS f32x4*)(KT + (31 + dl) * KTS + qo * 16 + 4 * i) = (f32x4){acc[4 * i], acc[4 * i + 1], acc[4 * i + 2], acc[4 * i + 3]};
        } else {
#pragma unroll
            for (int i = 0; i < 4; ++i) { LAS f32x4* kp = (LAS f32x4*)(KT + (31 - dl) * KTS + qo * 16 + 4 * i); f32x4 v = (f32x4){acc[4 * i], acc[4 * i + 1], acc[4 * i + 2], acc[4 * i + 3]}; if (dl == 0) v = v + *kp; *kp = v; }
        }
        __syncthreads();
    }
    for (int pc = tid; pc < 512 * 64; pc += NWAVES * 64) {
        const int n = pc >> 6, kp = pc & 63, t = n >> 4, qo = n & 15, j = kp >> 1, qi0 = (kp & 1) * 8; const LAS float* s = KT + (t - j + 31) * KTS + qo * 16 + qi0;
        const f32x4 s0 = *(const LAS f32x4*)s, s1 = *(const LAS f32x4*)(s + 4);
        v4u o; o.x = cvtpk(s0.x, s0.y); o.y = cvtpk(s0.z, s0.w); o.z = cvtpk(s1.x, s1.y); o.w = cvtpk(s1.z, s1.w);
        *(v4u*)(BtOut + (size_t)n * 768 + kp * 8) = o; }
    } else {
    for (int pc = tid; pc < 512 * 32; pc += NWAVES * 64) {
        const int n = pc >> 5, kp = pc & 31, t = n >> 4, qo = n & 15, d = kp >> 4, ri = (kp >> 3) & 1, p0 = (kp & 7) * 8, m = d == 0 ? t + 1 : 32 - t; float v[8];
#pragma unroll
        for (int i = 0; i < 8; ++i) { const f32x2 c = CC[CCI(d, qo, p0 + i)], w = POW[PWI(d, p0 + i, m)]; v[i] = ri == 0 ? (c.x * w.x - c.y * w.y) : -(c.x * w.y + c.y * w.x); }
        v4u o; o.x = cvtpk(v[0], v[1]); o.y = cvtpk(v[2], v[3]); o.z = cvtpk(v[4], v[5]); o.w = cvtpk(v[6], v[7]);
        *(v4u*)(BtOut + (size_t)n * 768 + 512 + kp * 8) = o; }
    for (int pc = tid; pc < 256 * 64; pc += NWAVES * 64) {
        const int n = pc >> 6, kp = pc & 63, d = n >> 7, ri = (n >> 6) & 1, p = n & 63, j = kp >> 1, qi0 = (kp & 1) * 8, m = d == 0 ? 31 - j : j; const f32x2 w = POW[PWI(d, p, m)]; float v[8];
#pragma unroll
        for (int i = 0; i < 8; ++i) { const float br = BBr[(d * 64 + p) * 16 + qi0 + i], bi = BBi[(d * 64 + p) * 16 + qi0 + i]; v[i] = ri == 0 ? (w.x * br - w.y * bi) : (w.x * bi + w.y * br); }
        v4u o; o.x = cvtpk(v[0], v[1]); o.y = cvtpk(v[2], v[3]); o.z = cvtpk(v[4], v[5]); o.w = cvtpk(v[6], v[7]);
        *(v4u*)(WEnd + (size_t)n * 512 + kp * 8) = o; }
    }
    __syncthreads();
#undef PWI
#undef CCI
}
__device__ __forceinline__ void cvt_item(const float* W, int K, int N, int ldw, bf16* WT, int mode, int item, LAS float* scr, int lane, unsigned* colmax = nullptr, float* pmax = nullptr) {
    const int nblk = N / 32, kb = item / nblk, nb = item - kb * nblk, k0 = 64 * kb, n0 = 32 * nb;
    int r0 = n0;
    if (mode == 1) r0 = 256 * (n0 >> 7) + (n0 & 127);
    else if (mode == 2) r0 = 256 * (n0 >> 7) + 128 + (n0 & 127);
    else if (mode == 3) { if (n0 < 1536) { const int pn = n0 >> 8, rem = n0 & 255; r0 = 256 * pn + 128 * ((rem & 63) >> 5) + 32 * (rem >> 6); }
                          else if (n0 < 2048) { const int n1 = n0 - 1536; r0 = 256 * (6 + (n1 >> 7)) + (n1 & 127); }
                          else { const int n1 = n0 - 2048; r0 = 256 * (6 + (n1 >> 7)) + 128 + (n1 & 127); } }
    { f32x4 v[8];
#pragma unroll
      for (int i = 0; i < 8; ++i) v[i] = *(const f32x4*)(W + (size_t)(k0 + 8 * i + (lane >> 3)) * ldw + n0 + 4 * (lane & 7));
#pragma unroll
      for (int i = 0; i < 8; ++i) { LAS float* d = scr + (8 * i + (lane >> 3)) * 33 + 4 * (lane & 7); d[0] = v[i].x; d[1] = v[i].y; d[2] = v[i].z; d[3] = v[i].w; } }
    LDS_WAIT(); asm volatile("" ::: "memory");
    const int c = lane & 7;
#pragma unroll
    for (int j = 0; j < 4; ++j) { const int n = (lane >> 3) + 8 * j; const LAS float* s = scr + (8 * c) * 33 + n;
        v4u o; o.x = cvtpk(s[0 * 33], s[1 * 33]); o.y = cvtpk(s[2 * 33], s[3 * 33]); o.z = cvtpk(s[4 * 33], s[5 * 33]); o.w = cvtpk(s[6 * 33], s[7 * 33]);
        *(GAS v4u*)(WT + (size_t)(r0 + n) * K + k0 + 8 * c) = o;
        if (colmax || pmax) { float mx = fmaxf(fmaxf(fmaxf(fabsf(s[0 * 33]), fabsf(s[1 * 33])), fmaxf(fabsf(s[2 * 33]), fabsf(s[3 * 33]))), fmaxf(fmaxf(fabsf(s[4 * 33]), fabsf(s[5 * 33])), fmaxf(fabsf(s[6 * 33]), fabsf(s[7 * 33]))));
            mx = fmaxf(mx, __shfl_xor(mx, 1)); mx = fmaxf(mx, __shfl_xor(mx, 2)); mx = fmaxf(mx, __shfl_xor(mx, 4));
            if (c == 0) { if (colmax) __hip_atomic_fetch_max(colmax + r0 + n, __builtin_bit_cast(unsigned, mx), RLX_AGENT); else pmax[(size_t)(r0 + n) * (K / 64) + kb] = mx; } } }
    LDS_WAIT(); asm volatile("" ::: "memory");
}
constexpr int CV_IM = 16 * 112, CV_IM2 = 56 * 32, CV_NMOE = NE * (2 * CV_IM + CV_IM2);
__device__ __forceinline__ void p0_convert(const Args& A, LAS unsigned char* lds, int gw, int NGW, int wave, int lane) {
    LAS float* scr = (LAS float*)(lds + wave * 16384);
    unsigned char* ws = A.ws;
    constexpr int I0 = 16 * 80, I1 = 16 * 32, I2 = 16 * 88, I3 = 44 * 32, I4 = 16 * 32, I5 = 16 * 32;
    constexpr int NSMALL = I0 + I1 + 2 * I2 + I3 + I4 + 2 * I5;
    for (int it = gw; it < NSMALL; it += NGW) {
        int r = it;
        if (r < I0) { cvt_item(A.in[I_MIXWIN], D, MIXIN, MIXIN, (bf16*)(ws + WS_WIN), 3, r, scr, lane, nullptr, (float*)(ws + WS_PMAX)); continue; } r -= I0;
        if (r < I1) { cvt_item(A.in[I_MIXWOUT], D, D, D, (bf16*)(ws + WS_WOUT), 0, r, scr, lane); continue; } r -= I1;
        if (r < I2) { cvt_item(A.in[I_FW1], D, FFN, FFN, (bf16*)(ws + WS_W13), 1, r, scr, lane, nullptr, (float*)(ws + WS_PMAX) + MIXIN * 16); continue; } r -= I2;
        if (r < I2) { cvt_item(A.in[I_FW3], D, FFN, FFN, (bf16*)(ws + WS_W13), 2, r, scr, lane, nullptr, (float*)(ws + WS_PMAX) + MIXIN * 16); continue; } r -= I2;
        if (r < I3) { cvt_item(A.in[I_FW2], FFN, D, D, (bf16*)(ws + WS_W2), 0, r, scr, lane); continue; } r -= I3;
        if (r < I4) { cvt_item(A.in[I_SWIN], D, D, D, (bf16*)(ws + WS_SIN), 0, r, scr, lane); continue; } r -= I4;
        if (r < I5) { cvt_item(A.in[I_SWOUT], D, D, 2 * D, (bf16*)(ws + WS_SOUT), 1, r, scr, lane); continue; } r -= I5;
        cvt_item(A.in[I_SWOUT] + D, D, D, 2 * D, (bf16*)(ws + WS_SOUT), 2, r, scr, lane);
    }
}
__device__ __forceinline__ void moe_convert(const Args& A, LAS unsigned char* lds, int first, int count, int widx, int nw, int wave, int lane) {
    LAS float* scr = (LAS float*)(lds + wave * 16384);
    unsigned char* ws = A.ws;
    const int last = (first + count) < CV_NMOE ? (first + count) : CV_NMOE;
    for (int it = first + widx; it < last; it += nw) {
        int r = it; const int e = r / (2 * CV_IM + CV_IM2); r -= e * (2 * CV_IM + CV_IM2);
        if (r < CV_IM) { cvt_item(A.in[I_MW1] + (size_t)e * D * ED, D, ED, ED, (bf16*)(ws + WS_MW13) + (size_t)e * 2 * ED * D, 1, r, scr, lane, (unsigned*)(ws + WS_COLMAX) + e * 2 * ED); continue; } r -= CV_IM;
        if (r < CV_IM) { cvt_item(A.in[I_MW3] + (size_t)e * D * ED, D, ED, ED, (bf16*)(ws + WS_MW13) + (size_t)e * 2 * ED * D, 2, r, scr, lane, (unsigned*)(ws + WS_COLMAX) + e * 2 * ED); continue; } r -= CV_IM;
        cvt_item(A.in[I_MW2] + (size_t)e * ED * D, ED, D, D, (bf16*)(ws + WS_MW2) + (size_t)e * D * ED, 0, r, scr, lane);
    }
}
__device__ __forceinline__ void shw_rows(const bf16* WT, int N, const float* sh, float* out, int widx, int nw, LAS unsigned char* lds, int tid, int lane, const float* colscale = nullptr) {
    LAS float* shl = (LAS float*)lds;
    __syncthreads();
    for (int i = tid; i < 9 * 1024; i += NWAVES * 64) shl[i] = sh[(size_t)(i >> 10) * 6144 + (i & 1023)];
    __syncthreads();
    for (int p = widx; p < N; p += nw) {
        float w[16];
        if (colscale) { const v4u q = *(const v4u*)((const unsigned char*)(WT + (size_t)p * D) + 16 * lane); const float cs = colscale[p]; const unsigned qq[4] = {q.x, q.y, q.z, q.w};
#pragma unroll
            for (int i = 0; i < 16; ++i) w[i] = (float)(int)(signed char)((qq[i >> 2] >> (8 * (i & 3))) & 255u) * cs; }
        else { const v4u w0 = *(const v4u*)(WT + (size_t)p * D + 16 * lane), w1 = *(const v4u*)(WT + (size_t)p * D + 16 * lane + 8);
            const float t[16] = {bflo(w0.x), bfhi(w0.x), bflo(w0.y), bfhi(w0.y), bflo(w0.z), bfhi(w0.z), bflo(w0.w), bfhi(w0.w), bflo(w1.x), bfhi(w1.x), bflo(w1.y), bfhi(w1.y), bflo(w1.z), bfhi(w1.z), bflo(w1.w), bfhi(w1.w)};
#pragma unroll
            for (int i = 0; i < 16; ++i) w[i] = t[i]; }
        float s[9];
#pragma unroll
        for (int b = 0; b < 9; ++b) { const LAS f32x4* sp = (const LAS f32x4*)(shl + b * 1024 + 16 * lane); float a = 0.f;
#pragma unroll
            for (int q = 0; q < 4; ++q) { const f32x4 v = sp[q]; a += (v.x * w[4 * q] + v.y * w[4 * q + 1]) + (v.z * w[4 * q + 2] + v.w * w[4 * q + 3]); }
            s[b] = a; }
#pragma unroll
        for (int b = 0; b < 9; ++b) s[b] = wave_sum(s[b]);
        if (lane < 9) { float v = s[0];
#pragma unroll
            for (int b = 1; b < 9; ++b) v = (lane == b) ? s[b] : v;
            out[(size_t)lane * N + p] = v; }
    }
    __syncthreads();
}
__device__ __forceinline__ unsigned q8pack(float a, float b, float c, float d) { const int ia = (int)rintf(a), ib = (int)rintf(b), ic = (int)rintf(c), id = (int)rintf(d);
    return (unsigned)(ia & 255) | ((unsigned)(ib & 255) << 8) | ((unsigned)(ic & 255) << 16) | ((unsigned)(id & 255) << 24); }
__device__ __forceinline__ void quant_rows_inplace(bf16* W, unsigned* colmax, int nrows, int gw, int NGW, int lane) {
    for (int r0 = gw; r0 < nrows; r0 += 2 * NGW) {
        const int r1 = (r0 + NGW < nrows) ? r0 + NGW : r0; const int nr = (r0 + NGW < nrows) ? 2 : 1;
        v4u a[2][2]; float mx[2];
#pragma unroll
        for (int u = 0; u < 2; ++u) { const int r = u ? r1 : r0; const bf16* rp = W + (size_t)r * 1024 + 16 * lane; a[u][0] = *(const v4u*)rp; a[u][1] = *(const v4u*)(rp + 8); mx[u] = __builtin_bit_cast(float, colmax[r]); }
        asm volatile("s_waitcnt vmcnt(0)" ::: "memory");
#pragma unroll
        for (int u = 0; u < 2; ++u) { if (u < nr) { const int r = u ? r1 : r0; const float inv = mx[u] > 0.f ? 127.0f / mx[u] : 0.f; v4u o;
            o.x = q8pack(bflo(a[u][0].x) * inv, bfhi(a[u][0].x) * inv, bflo(a[u][0].y) * inv, bfhi(a[u][0].y) * inv); o.y = q8pack(bflo(a[u][0].z) * inv, bfhi(a[u][0].z) * inv, bflo(a[u][0].w) * inv, bfhi(a[u][0].w) * inv);
            o.z = q8pack(bflo(a[u][1].x) * inv, bfhi(a[u][1].x) * inv, bflo(a[u][1].y) * inv, bfhi(a[u][1].y) * inv); o.w = q8pack(bflo(a[u][1].z) * inv, bfhi(a[u][1].z) * inv, bflo(a[u][1].w) * inv, bfhi(a[u][1].w) * inv);
            *(v4u*)((unsigned char*)(W + (size_t)r * 1024) + 16 * lane) = o;
            if (lane == 0) ((float*)colmax)[r] = mx[u] * (1.0f / 127.0f); } }
    }
}
__device__ __forceinline__ void quant_rows_f8_inplace(bf16* W, float* scale, int nrows, int gw, int NGW, int lane) {
    for (int r0 = gw; r0 < nrows; r0 += 2 * NGW) {
        const int r1 = (r0 + NGW < nrows) ? r0 + NGW : r0; const int nr = (r0 + NGW < nrows) ? 2 : 1;
        v4u a[2][7];
#pragma unroll
        for (int u = 0; u < 2; ++u) { const bf16* rp = W + (size_t)(u ? r1 : r0) * 3584 + 8 * lane;
#pragma unroll
            for (int c = 0; c < 7; ++c) a[u][c] = *(const v4u*)(rp + 512 * c); }
        asm volatile("s_waitcnt vmcnt(0)" ::: "memory");
#pragma unroll
        for (int u = 0; u < 2; ++u) { if (u < nr) { const int r = u ? r1 : r0; float am = 0.f;
#pragma unroll
            for (int c = 0; c < 7; ++c) { am = fmaxf(am, fmaxf(fmaxf(fabsf(bflo(a[u][c].x)), fabsf(bfhi(a[u][c].x))), fmaxf(fabsf(bflo(a[u][c].y)), fabsf(bfhi(a[u][c].y)))));
                am = fmaxf(am, fmaxf(fmaxf(fabsf(bflo(a[u][c].z)), fabsf(bfhi(a[u][c].z))), fmaxf(fabsf(bflo(a[u][c].w)), fabsf(bfhi(a[u][c].w))))); }
            am = wave_max(am); const float inv = am > 0.f ? 448.0f / am : 0.f;
#pragma unroll
            for (int c = 0; c < 7; ++c) { v2u o;
                o.x = pg8::f8pack4((f32x4){bflo(a[u][c].x), bfhi(a[u][c].x), bflo(a[u][c].y), bfhi(a[u][c].y)} * inv); o.y = pg8::f8pack4((f32x4){bflo(a[u][c].z), bfhi(a[u][c].z), bflo(a[u][c].w), bfhi(a[u][c].w)} * inv);
                *(v2u*)((unsigned char*)(W + (size_t)r * 3584) + 8 * lane + 512 * c) = o; }
            if (lane == 0) scale[r] = am * (1.0f / 448.0f); } }
    }
}
__device__ __forceinline__ void quant_rows_f8_1k(bf16* W, float* scale, int nrows, int gw, int NGW, int lane) {
    for (int r = gw; r < nrows; r += NGW) {
        const bf16* rp = W + (size_t)r * 1024 + 16 * lane; const v4u a0 = *(const v4u*)rp, a1 = *(const v4u*)(rp + 8);
        asm volatile("s_waitcnt vmcnt(0)" ::: "memory");
        const f32x4 v0 = (f32x4){bflo(a0.x), bfhi(a0.x), bflo(a0.y), bfhi(a0.y)}, v1 = (f32x4){bflo(a0.z), bfhi(a0.z), bflo(a0.w), bfhi(a0.w)}, v2 = (f32x4){bflo(a1.x), bfhi(a1.x), bflo(a1.y), bfhi(a1.y)}, v3 = (f32x4){bflo(a1.z), bfhi(a1.z), bflo(a1.w), bfhi(a1.w)};
        float am = 0.f;
#pragma unroll
        for (int i = 0; i < 4; ++i) am = fmaxf(am, fmaxf(fmaxf(fabsf(v0[i]), fabsf(v1[i])), fmaxf(fabsf(v2[i]), fabsf(v3[i]))));
        am = wave_max(am); const float inv = am > 0.f ? 448.0f / am : 0.f;
        v4u o; o.x = pg8::f8pack4(v0 * inv); o.y = pg8::f8pack4(v1 * inv); o.z = pg8::f8pack4(v2 * inv); o.w = pg8::f8pack4(v3 * inv);
        *(v4u*)((unsigned char*)(W + (size_t)r * 1024) + 16 * lane) = o;
        if (lane == 0) scale[r] = am * (1.0f / 448.0f);
    }
}
__device__ __forceinline__ void quant_rows_inplace_p(bf16* W, const float* pmax, float* colscale, int nrows, int gw, int NGW, int lane) {
    for (int r = gw; r < nrows; r += NGW) {
        const bf16* rp = W + (size_t)r * 1024 + 16 * lane; const v4u a0 = *(const v4u*)rp, a1 = *(const v4u*)(rp + 8);
        const float mx = wave_max(pmax[(size_t)r * 16 + (lane & 15)]);
        asm volatile("s_waitcnt vmcnt(0)" ::: "memory");
        const float inv = mx > 0.f ? 127.0f / mx : 0.f; v4u o;
        o.x = q8pack(bflo(a0.x) * inv, bfhi(a0.x) * inv, bflo(a0.y) * inv, bfhi(a0.y) * inv); o.y = q8pack(bflo(a0.z) * inv, bfhi(a0.z) * inv, bflo(a0.w) * inv, bfhi(a0.w) * inv);
        o.z = q8pack(bflo(a1.x) * inv, bfhi(a1.x) * inv, bflo(a1.y) * inv, bfhi(a1.y) * inv); o.w = q8pack(bflo(a1.z) * inv, bfhi(a1.z) * inv, bflo(a1.w) * inv, bfhi(a1.w) * inv);
        *(v4u*)((unsigned char*)(W + (size_t)r * 1024) + 16 * lane) = o;
        if (lane == 0) colscale[r] = mx * (1.0f / 127.0f);
    }
}
__device__ __forceinline__ void quant_act_rows(bf16* Hb, const float* rowss, float* rowfac, int nrows, int gw, int NGW, int lane) {
    for (int r0 = gw; r0 < nrows; r0 += 2 * NGW) {
        const int r1 = (r0 + NGW < nrows) ? r0 + NGW : r0; const int nr = (r0 + NGW < nrows) ? 2 : 1;
        v4u a[2][2]; float ssq[2];
#pragma unroll
        for (int u = 0; u < 2; ++u) { const int r = u ? r1 : r0; const bf16* rp = Hb + (size_t)r * 1024 + 16 * lane; a[u][0] = *(const v4u*)rp; a[u][1] = *(const v4u*)(rp + 8); ssq[u] = rowss[(size_t)r * 16 + (lane & 15)]; }
        asm volatile("s_waitcnt vmcnt(0)" ::: "memory");
#pragma unroll
        for (int u = 0; u < 2; ++u) { if (u < nr) { const int r = u ? r1 : r0;
            const float v[16] = {bflo(a[u][0].x), bfhi(a[u][0].x), bflo(a[u][0].y), bfhi(a[u][0].y), bflo(a[u][0].z), bfhi(a[u][0].z), bflo(a[u][0].w), bfhi(a[u][0].w),
                                 bflo(a[u][1].x), bfhi(a[u][1].x), bflo(a[u][1].y), bfhi(a[u][1].y), bflo(a[u][1].z), bfhi(a[u][1].z), bflo(a[u][1].w), bfhi(a[u][1].w)};
            float am = 0.f;
#pragma unroll
            for (int i = 0; i < 16; ++i) am = fmaxf(am, fabsf(v[i]));
            am = wave_max(am); const float inv = am > 0.f ? 127.0f / am : 0.f;
            float sq = (lane < 16) ? ssq[u] : 0.f; sq = wave_sum(sq);
            v4u o; o.x = q8pack(v[0] * inv, v[1] * inv, v[2] * inv, v[3] * inv); o.y = q8pack(v[4] * inv, v[5] * inv, v[6] * inv, v[7] * inv);
            o.z = q8pack(v[8] * inv, v[9] * inv, v[10] * inv, v[11] * inv); o.w = q8pack(v[12] * inv, v[13] * inv, v[14] * inv, v[15] * inv);
            *(v4u*)((unsigned char*)(Hb + (size_t)r * 1024) + 16 * lane) = o;
            if (lane == 0) rowfac[r] = rsqrtf(sq * (1.0f / 1024.0f) + EPS) * am * (1.0f / 127.0f); } }
    }
}
template <int NPART> __device__ __forceinline__ void norm_row_finish(const f32x4 (&v)[4], int row, const float* gain, const float* mod, int shc, int scc, bf16* H, int lane) {
    const float* mp = mod + (size_t)(row < ML ? (row >> 11) : 8) * 6144; float ss = 0.f;
#pragma unroll
    for (int j = 0; j < 4; ++j) ss += (v[j].x * v[j].x + v[j].y * v[j].y) + (v[j].z * v[j].z + v[j].w * v[j].w);
    const float rstd = rsqrtf(wave_sum(ss) * (1.0f / D) + EPS);
#pragma unroll
    for (int j = 0; j < 4; ++j) { const int k = 4 * lane + 256 * j; const f32x4 gg = *(const f32x4*)(gain + k); f32x4 sc = *(const f32x4*)(mp + scc * 1024 + k), sh = *(const f32x4*)(mp + shc * 1024 + k);
#pragma unroll
        for (int q = 1; q < NPART; ++q) { sc = sc + *(const f32x4*)(mp + (size_t)q * MOD_N + scc * 1024 + k); sh = sh + *(const f32x4*)(mp + (size_t)q * MOD_N + shc * 1024 + k); }
        const f32x4 h = v[j] * rstd * gg * (sc + 1.0f) + sh;
        v2u o; o.x = cvtpk(h.x, h.y); o.y = cvtpk(h.z, h.w); *(v2u*)(H + (size_t)row * D + k) = o; }
}
__device__ __forceinline__ void norm_rows_lds(const float* xL, const float* xC, int nrows, const float* gain, const LAS float* ms, bf16* H, float* rowfac, int gw, int NGW, int lane) {
    for (int row = gw; row < nrows; row += 2 * NGW) {
        const int row1 = row + NGW; const bool two = row1 < nrows; const int r1 = two ? row1 : row;
        const float* xa = row < ML ? xL + (size_t)row * D : xC + (size_t)(row - ML) * D; const float* xb = r1 < ML ? xL + (size_t)r1 * D : xC + (size_t)(r1 - ML) * D;
        f32x4 vv[2][4];
#pragma unroll
        for (int j = 0; j < 4; ++j) { vv[0][j] = *(const f32x4*)(xa + 4 * lane + 256 * j); vv[1][j] = *(const f32x4*)(xb + 4 * lane + 256 * j); }
#pragma unroll
        for (int u = 0; u < 2; ++u) { if (u == 1 && !two) break; const int rw = u ? row1 : row; const LAS float* mp = ms + (rw < ML ? (rw >> 11) : 8) * 2048; float ss = 0.f;
#pragma unroll
            for (int j = 0; j < 4; ++j) ss += (vv[u][j].x * vv[u][j].x + vv[u][j].y * vv[u][j].y) + (vv[u][j].z * vv[u][j].z + vv[u][j].w * vv[u][j].w);
            const float rstd = rsqrtf(wave_sum(ss) * (1.0f / D) + EPS);
            f32x4 hq[4]; float am = 0.f;
#pragma unroll
            for (int j = 0; j < 4; ++j) { const int k = 4 * lane + 256 * j; const f32x4 gg = *(const f32x4*)(gain + k), sh = *(const LAS f32x4*)(mp + k), sc = *(const LAS f32x4*)(mp + 1024 + k);
                const f32x4 h = vv[u][j] * rstd * gg * (sc + 1.0f) + sh; hq[j] = h; am = fmaxf(am, fmaxf(fmaxf(fabsf(h.x), fabsf(h.y)), fmaxf(fabsf(h.z), fabsf(h.w)))); }
            am = wave_max(am); const float inv = am > 0.f ? 127.0f / am : 0.f;
#pragma unroll
            for (int j = 0; j < 4; ++j) *(unsigned*)((unsigned char*)H + (size_t)rw * D + 4 * lane + 256 * j) = q8pack(hq[j].x * inv, hq[j].y * inv, hq[j].z * inv, hq[j].w * inv);
            if (lane == 0) rowfac[rw] = am * (1.0f / 127.0f); }
    }
}
template <int NPART> __device__ __forceinline__ void norm_rows(const float* xL, const float* xC, int nrows, const float* gain, const float* mod, int shc, int scc, bf16* H, int gw, int NGW, int lane) {
    for (int row = gw; row < nrows; row += 2 * NGW) {
        const int row1 = row + NGW; const bool two = row1 < nrows; const int r1 = two ? row1 : row;
        const float* xa = row < ML ? xL + (size_t)row * D : xC + (size_t)(row - ML) * D; const float* xb = r1 < ML ? xL + (size_t)r1 * D : xC + (size_t)(r1 - ML) * D;
        f32x4 va[4], vb[4];
#pragma unroll
        for (int j = 0; j < 4; ++j) { va[j] = *(const f32x4*)(xa + 4 * lane + 256 * j); vb[j] = *(const f32x4*)(xb + 4 * lane + 256 * j); }
        norm_row_finish<NPART>(va, row, gain, mod, shc, scc, H, lane);
        if (two) norm_row_finish<NPART>(vb, row1, gain, mod, shc, scc, H, lane);
    }
}
constexpr int VSTR = 144;
__device__ __forceinline__ void attn_unit(const bf16* QKVU, bf16* MIX, int wu, LAS unsigned char* vl, LAS unsigned char* ql, const LAS float* rpbl, float bnd, int lane) {
    const bool isctx = wu >= 2048;
    int b, h, r = 0, qrow0;
    if (!isctx) { h = wu & 7; r = (wu >> 3) & 31; b = wu >> 8; qrow0 = b * SEQ + r * 64; }
    else { const int w = wu - 2048; h = w & 7; b = w >> 5; qrow0 = ML + b * NCTX + 64 * ((w >> 3) & 3); }
    const int c = lane & 31, hh = lane >> 5;
    const int rs = r < 4 ? 0 : (r > 28 ? 24 : r - 4);
    const int csA = c < 8 ? 0 : c - 8;
    const int csB = c > 24 ? 48 : c + 24;
    const LAS unsigned char* vtb = vl + (4 * hh + ((lane & 15) >> 2)) * VSTR + 32 * ((lane >> 4) & 1) + 8 * (lane & 3);
    LAS unsigned char* qs = ql + c * 128 + 16 * hh;
    { const bf16* qp = QKVU + (size_t)(qrow0 + c) * 2048 + h * 64 + 8 * hh;
#pragma unroll
      for (int s = 0; s < 4; ++s) { *(LAS bf16x8*)(qs + 32 * s) = *(const bf16x8*)(qp + 16 * s); *(LAS bf16x8*)(qs + 4096 + 32 * s) = *(const bf16x8*)(qp + (size_t)32 * 2048 + 16 * s); } }
    f32x16 oA0, oA1, oB0, oB1;
#pragma unroll
    for (int i = 0; i < 16; ++i) { oA0[i] = 0.f; oA1[i] = 0.f; oB0[i] = 0.f; oB1[i] = 0.f; }
    float lsA = 0.f, lsB = 0.f;
    const int nblk = isctx ? 8 : 24;
    const bf16* kbase = QKVU + 512 + h * 64 + 8 * hh + (size_t)c * 2048;
    const bf16* vbase = QKVU + 1024 + h * 64 + 8 * (lane & 7) + (size_t)(lane >> 3) * 2048;
#define ATT_KROW0(kb_) (((!isctx) && (kb_) < 16) ? (b * SEQ + (rs + ((kb_) >> 1)) * 64 + 32 * ((kb_) & 1)) : (ML + b * NCTX + 32 * (isctx ? (kb_) : (kb_) - 16)))
#define ATT_LOADK(KF, kb_) do { const int kq_ = (kb_) < nblk ? (kb_) : nblk - 1; const size_t ro_ = (size_t)ATT_KROW0(kq_) * 2048; \
        _Pragma("unroll") for (int s_ = 0; s_ < 4; ++s_) KF[s_] = *(const bf16x8*)(kbase + ro_ + 16 * s_); } while (0)
#define ATT_LOADV(VF, kb_) do { const int kq_ = (kb_) < nblk ? (kb_) : nblk - 1; const size_t ro_ = (size_t)ATT_KROW0(kq_) * 2048; \
        _Pragma("unroll") for (int i_ = 0; i_ < 4; ++i_) VF[i_] = *(const v4u*)(vbase + ro_ + (size_t)i_ * 8 * 2048); } while (0)
#define ATT_PACK(PF, P) do { _Pragma("unroll") for (int s = 0; s < 2; ++s) { v4u w; w.x = cvtpk(P[8 * s], P[8 * s + 1]); w.y = cvtpk(P[8 * s + 2], P[8 * s + 3]); w.z = cvtpk(P[8 * s + 4], P[8 * s + 5]); w.w = cvtpk(P[8 * s + 6], P[8 * s + 7]); PF[s] = __builtin_bit_cast(bf16x8, w); } } while (0)
#define ATT_BLOCK(KF, VF, kb_) do { const int kb = (kb_); const bool live = kb < nblk; const bool band = (!isctx) && kb < 16; const int kr = rs + (kb >> 1); \
        _Pragma("unroll") for (int i = 0; i < 4; ++i) { const int id = lane + 64 * i; *(LAS v4u*)(vl + (id >> 3) * VSTR + (id & 7) * 16) = VF[i]; } \
        ATT_LOADV(VF, kb + 1);              \
        f32x16 sA, sB; \
        _Pragma("unroll") for (int i = 0; i < 16; ++i) { sA[i] = 0.f; sB[i] = 0.f; } \
        _Pragma("unroll") for (int s = 0; s < 4; ++s) { sA = __builtin_amdgcn_mfma_f32_32x32x16_bf16(KF[s], *(const LAS bf16x8*)(qs + 32 * s), sA, 0, 0, 0); \
                                                        sB = __builtin_amdgcn_mfma_f32_32x32x16_bf16(KF[s], *(const LAS bf16x8*)(qs + 4096 + 32 * s), sB, 0, 0, 0); } \
        ATT_LOADK(KF, kb + 1);              \
        float pA[16], pB[16]; \
        if (band) { const int kc0 = 32 * (kb & 1) + 4 * hh; const LAS float* rb = rpbl + h * 465 + (kr - r + 7) * 31 + (kc0 - c); \
              \
            float bA[16], bB[16]; \
            _Pragma("unroll") for (int i = 0; i < 16; ++i) { bA[i] = rb[15 + (i & 3) + 8 * (i >> 2)]; bB[i] = rb[(i & 3) + 8 * (i >> 2) - 17]; } \
            const int tA = kc0 - csA, tB = kc0 - csB; \
            _Pragma("unroll") for (int i = 0; i < 16; ++i) { const int o = (i & 3) + 8 * (i >> 2); \
                { const bool ok = (unsigned)(tA + o) < 16u; const float e = __builtin_amdgcn_exp2f(sA[i] * 0.18033688f + bA[i]); pA[i] = ok ? e : 0.f; } \
                { const bool ok = (unsigned)(tB + o) < 16u; const float e = __builtin_amdgcn_exp2f(sB[i] * 0.18033688f + bB[i]); pB[i] = ok ? e : 0.f; } } \
        } else { \
            _Pragma("unroll") for (int i = 0; i < 16; ++i) { const float ea = __builtin_amdgcn_exp2f(sA[i] * 0.18033688f - bnd), eb = __builtin_amdgcn_exp2f(sB[i] * 0.18033688f - bnd); pA[i] = live ? ea : 0.f; pB[i] = live ? eb : 0.f; } } \
        _Pragma("unroll") for (int i = 0; i < 16; ++i) { lsA += pA[i]; lsB += pB[i]; } \
        bf16x8 fA[2], fB[2]; ATT_PACK(fA, pA); ATT_PACK(fB, pB); \
        LDS_WAIT(); \
        _Pragma("unroll") for (int dt = 0; dt < 2; ++dt) \
            _Pragma("unroll") for (int s = 0; s < 2; ++s) { \
                const s16x4 lo = vtr(vtb + (16 * s) * VSTR + 64 * dt), hi = vtr(vtb + (16 * s + 8) * VSTR + 64 * dt); \
                const bf16x8 af = (bf16x8){lo[0], lo[1], lo[2], lo[3], hi[0], hi[1], hi[2], hi[3]}; \
                if (dt == 0) { oA0 = __builtin_amdgcn_mfma_f32_32x32x16_bf16(af, fA[s], oA0, 0, 0, 0); oB0 = __builtin_amdgcn_mfma_f32_32x32x16_bf16(af, fB[s], oB0, 0, 0, 0); } \
                else { oA1 = __builtin_amdgcn_mfma_f32_32x32x16_bf16(af, fA[s], oA1, 0, 0, 0); oB1 = __builtin_amdgcn_mfma_f32_32x32x16_bf16(af, fB[s], oB1, 0, 0, 0); } } \
        } while (0)
    bf16x8 kA[4]; v4u vA[4];
    ATT_LOADK(kA, 0); ATT_LOADV(vA, 0);
    for (int kb1 = 0; kb1 < nblk; ++kb1) ATT_BLOCK(kA, vA, kb1);
#undef ATT_KROW0
#undef ATT_LOADK
#undef ATT_LOADV
#undef ATT_PACK
#undef ATT_BLOCK
    lsA += __shfl_xor(lsA, 32); lsB += __shfl_xor(lsB, 32);
    const float iA = 1.0f / lsA, iB = 1.0f / lsB;
    bf16* op = MIX + (size_t)(qrow0 + c) * D + h * 64 + 4 * hh; bf16* oq = op + (size_t)32 * D;
#pragma unroll
    for (int i4 = 0; i4 < 4; ++i4) {
        v2u w0; w0.x = cvtpk(oA0[4 * i4] * iA, oA0[4 * i4 + 1] * iA); w0.y = cvtpk(oA0[4 * i4 + 2] * iA, oA0[4 * i4 + 3] * iA); *(v2u*)(op + 8 * i4) = w0;
        v2u w1; w1.x = cvtpk(oA1[4 * i4] * iA, oA1[4 * i4 + 1] * iA); w1.y = cvtpk(oA1[4 * i4 + 2] * iA, oA1[4 * i4 + 3] * iA); *(v2u*)(op + 32 + 8 * i4) = w1;
        v2u w2; w2.x = cvtpk(oB0[4 * i4] * iB, oB0[4 * i4 + 1] * iB); w2.y = cvtpk(oB0[4 * i4 + 2] * iB, oB0[4 * i4 + 3] * iB); *(v2u*)(oq + 8 * i4) = w2;
        v2u w3; w3.x = cvtpk(oB1[4 * i4] * iB, oB1[4 * i4 + 1] * iB); w3.y = cvtpk(oB1[4 * i4 + 2] * iB, oB1[4 * i4 + 3] * iB); *(v2u*)(oq + 32 + 8 * i4) = w3; }
}
template <int P0, int NP> __device__ __forceinline__ void conv_chunk(float (&acc)[32], const float (&w)[31], const __amdgpu_buffer_rsrc_t rsrc, int voff, int t0, int len) {
    float v[NP];
#pragma unroll
    for (int i = 0; i < NP; ++i) { const int t = t0 - 15 + P0 + i, tc = t < 0 ? 0 : (t >= len ? len - 1 : t); const int so = __builtin_amdgcn_readfirstlane(tc * 4096);
        const float x = bf2f(__builtin_amdgcn_raw_buffer_load_b16(rsrc, voff, so, 0)); v[i] = (t == tc) ? x : 0.f; }
#pragma unroll
    for (int i = 0; i < NP; ++i)
#pragma unroll
        for (int tt = 0; tt < 32; ++tt) { if (P0 + i - tt >= 0 && P0 + i - tt <= 30) acc[tt] += v[i] * w[(P0 + i - tt >= 0 && P0 + i - tt <= 30) ? P0 + i - tt : 0]; }
}
__device__ __forceinline__ void conv_item(const Args& A, const bf16* QKVU, bf16* MIX, int item, LAS float* cv, int tid, int wave, int lane) {
    __syncthreads();
    int rowbase, len, t0;
    if (item < 512) { rowbase = (item >> 6) * SEQ; len = SEQ; t0 = 32 * (item & 63); } else { const int i2 = item - 512; rowbase = ML + (i2 >> 3) * NCTX; len = NCTX; t0 = 32 * (i2 & 7); }
    const int ch = tid;
    float w[31], acc[32];
    { const __amdgpu_buffer_rsrc_t wrs = __builtin_amdgcn_make_buffer_rsrc((void*)A.in[I_DWW], 0, 31 * 512 * 4, 0x00020000);
#pragma unroll
      for (int k = 0; k < 31; ++k) w[k] = __builtin_bit_cast(float, __builtin_amdgcn_raw_buffer_load_b32(wrs, 4 * ch, k * 2048, 0)); }
    const float bias = A.in[I_DWB][ch];
#pragma unroll
    for (int t = 0; t < 32; ++t) acc[t] = bias;
    const __amdgpu_buffer_rsrc_t rsrc = __builtin_amdgcn_make_buffer_rsrc((void*)(QKVU + (size_t)rowbase * 2048 + 1536), 0, len * 4096, 0x00020000);
    conv_chunk<0, 16>(acc, w, rsrc, 2 * ch, t0, len); conv_chunk<16, 16>(acc, w, rsrc, 2 * ch, t0, len); conv_chunk<32, 16>(acc, w, rsrc, 2 * ch, t0, len); conv_chunk<48, 14>(acc, w, rsrc, 2 * ch, t0, len);
#pragma unroll
    for (int t = 0; t < 32; ++t) cv[t * 512 + ch] = acc[t];
    __syncthreads();
    const f32x4 g0 = *(const f32x4*)(A.in[I_LNG] + 8 * lane), g1 = *(const f32x4*)(A.in[I_LNG] + 8 * lane + 4), b0 = *(const f32x4*)(A.in[I_LNB] + 8 * lane), b1 = *(const f32x4*)(A.in[I_LNB] + 8 * lane + 4);
#pragma unroll
    for (int q = 0; q < 4; ++q) { const int tt = 4 * wave + q;
        f32x4 x0 = *(const LAS f32x4*)(cv + tt * 512 + 8 * lane), x1 = *(const LAS f32x4*)(cv + tt * 512 + 8 * lane + 4);
        const float mean = wave_sum((x0.x + x0.y) + (x0.z + x0.w) + (x1.x + x1.y) + (x1.z + x1.w)) * (1.0f / 512.0f);
        x0 = x0 - mean; x1 = x1 - mean;
        const float var = wave_sum((x0.x * x0.x + x0.y * x0.y) + (x0.z * x0.z + x0.w * x0.w) + (x1.x * x1.x + x1.y * x1.y) + (x1.z * x1.z + x1.w * x1.w)) * (1.0f / 512.0f);
        const float rstd = rsqrtf(var + EPS);
        f32x4 y0 = x0 * rstd * g0 + b0, y1 = x1 * rstd * g1 + b1;
        y0 = (f32x4){y0.x * sigm(y0.x), y0.y * sigm(y0.y), y0.z * sigm(y0.z), y0.w * sigm(y0.w)}; y1 = (f32x4){y1.x * sigm(y1.x), y1.y * sigm(y1.y), y1.z * sigm(y1.z), y1.w * sigm(y1.w)};
        v4u o; o.x = cvtpk(y0.x, y0.y); o.y = cvtpk(y0.z, y0.w); o.z = cvtpk(y1.x, y1.y); o.w = cvtpk(y1.z, y1.w);
        *(v4u*)(MIX + (size_t)(rowbase + t0 + tt) * D + 512 + 8 * lane) = o; }
    __syncthreads();
}
__device__ __forceinline__ void s5_scan(const Args& A, int gt) {
    if (gt >= NB * 64 * 2 * 64) return;
    const int p = gt & 63, d = (gt >> 6) & 1, g = (gt >> 7) & 63, b = gt >> 13;
    const int ix = (d * 64 + g) * 64 + p;
    const float ar = A.in[I_ARE][ix], ai = A.in[I_AIM][ix], dt = __expf(A.in[I_LOGDT][d * 64 + g]);
    const float zr = ar * dt, zi = ai * dt, mag = __expf(zr); float lr = mag * cosf(zi), li = mag * sinf(zi);
#pragma unroll
    for (int k = 0; k < 5; ++k) { const float nr = lr * lr - li * li, ni = 2.f * lr * li; lr = nr; li = ni; }
    const float* E = (const float*)(A.ws + WS_E) + (size_t)g * 768 * 256 + d * 128 + p;
    bf16* UC = (bf16*)(A.ws + WS_UC) + (size_t)g * 768 * 768 + 512 + d * 128 + p;
    float sr = 0.f, si = 0.f;
    for (int s0 = 0; s0 < 72; s0 += 24) {
        float er[24], ei[24]; int bcs[24];
#pragma unroll
        for (int k = 0; k < 24; ++k) { const int step = s0 + k; int bc;
            if (step < 8) bc = 512 + 8 * b + (d == 0 ? step : 7 - step); else bc = 64 * b + (d == 0 ? step - 8 : 71 - step);
            bcs[k] = bc; er[k] = E[(size_t)bc * 256]; ei[k] = E[(size_t)bc * 256 + 64]; }
#pragma unroll
        for (int k = 0; k < 24; ++k) {
            if (s0 + k >= 8) { UC[(size_t)bcs[k] * 768] = (bf16)f2bf(sr); UC[(size_t)bcs[k] * 768 + 64] = (bf16)f2bf(si); }
            const float nr = lr * sr - li * si + er[k], ni = lr * si + li * sr + ei[k]; sr = nr; si = ni; }
    }
}
__device__ __forceinline__ void moe_route(const Args& A, const bf16* X, const float* mod, bf16* H, int chunk, LAS unsigned* lcnt, int tid, int wave, int lane) {
    unsigned char* tok = A.ws + WS_TOK;
    int* tokE = (int*)(tok + TOK_E); float* tokW = (float*)(tok + TOK_W); int* tokRank = (int*)(tok + TOK_RANK); int* wgbase = (int*)(tok + TOK_WGBASE);
    if (tid < 8) lcnt[tid] = 0u;
    __syncthreads();
    const float* gain = A.in[I_N2G] + D; const float* wr = A.in[I_ROUTER];
    for (int q2 = 0; q2 < 8; q2 += 2) {
        f32x4 vv[2][4];
#pragma unroll
        for (int u = 0; u < 2; ++u) { const bf16* xr = X + (size_t)(chunk * 64 + wave * 8 + q2 + u) * D;
#pragma unroll
            for (int j = 0; j < 4; ++j) { const v2u xw = *(const v2u*)(xr + 4 * lane + 256 * j); vv[u][j] = (f32x4){bflo(xw.x), bfhi(xw.x), bflo(xw.y), bfhi(xw.y)}; } }
#pragma unroll
        for (int u = 0; u < 2; ++u) {
        const int row = chunk * 64 + wave * 8 + q2 + u; const float* mp = mod + (size_t)(row >> 11) * 6144;
        float ss = 0.f;
#pragma unroll
        for (int j = 0; j < 4; ++j) ss += (vv[u][j].x * vv[u][j].x + vv[u][j].y * vv[u][j].y) + (vv[u][j].z * vv[u][j].z + vv[u][j].w * vv[u][j].w);
        const float rstd = rsqrtf(wave_sum(ss) * (1.0f / D) + EPS);
        float lg[8]; f32x4 hq[4];
#pragma unroll
        for (int e = 0; e < 8; ++e) lg[e] = 0.f;
#pragma unroll
        for (int j = 0; j < 4; ++j) { const int k = 4 * lane + 256 * j; const f32x4 gg = *(const f32x4*)(gain + k), sc = *(const f32x4*)(mp + 4 * 1024 + k), sh = *(const f32x4*)(mp + 3 * 1024 + k);
            const f32x4 h = vv[u][j] * rstd * gg * (sc + 1.0f) + sh; hq[j] = h;
#pragma unroll
            for (int i = 0; i < 4; ++i) { const f32x4 w0 = *(const f32x4*)(wr + (size_t)(k + i) * 8), w1 = *(const f32x4*)(wr + (size_t)(k + i) * 8 + 4); const float hv = h[i];
                lg[0] += hv * w0.x; lg[1] += hv * w0.y; lg[2] += hv * w0.z; lg[3] += hv * w0.w; lg[4] += hv * w1.x; lg[5] += hv * w1.y; lg[6] += hv * w1.z; lg[7] += hv * w1.w; } }
        {
            float am = 0.f;
#pragma unroll
            for (int j = 0; j < 4; ++j) am = fmaxf(am, fmaxf(fmaxf(fabsf(hq[j].x), fabsf(hq[j].y)), fmaxf(fabsf(hq[j].z), fabsf(hq[j].w))));
            am = wave_max(am); const float inv = am > 0.f ? 127.0f / am : 0.f;
#pragma unroll
            for (int j = 0; j < 4; ++j) *(unsigned*)((unsigned char*)H + (size_t)row * D + 4 * lane + 256 * j) = q8pack(hq[j].x * inv, hq[j].y * inv, hq[j].z * inv, hq[j].w * inv);
            if (lane == 0) ((float*)(A.ws + WS_ROWSC))[row] = am * (1.0f / 127.0f); }
#pragma unroll
        for (int e = 0; e < 8; ++e) lg[e] = wave_sum(lg[e]);
        int e0 = 0; float v0 = lg[0];
#pragma unroll
        for (int e = 1; e < 8; ++e) if (lg[e] > v0) { v0 = lg[e]; e0 = e; }
        int e1 = -1; float v1 = -3.0e38f;
#pragma unroll
        for (int e = 0; e < 8; ++e) if (e != e0 && lg[e] > v1) { v1 = lg[e]; e1 = e; }
        const float ex = __expf(v1 - v0), w0 = 1.0f / (1.0f + ex), w1 = ex * w0;
        if (lane == 0) { const unsigned r0 = __hip_atomic_fetch_add(&lcnt[e0], 1u, __ATOMIC_RELAXED, __HIP_MEMORY_SCOPE_WORKGROUP), r1 = __hip_atomic_fetch_add(&lcnt[e1], 1u, __ATOMIC_RELAXED, __HIP_MEMORY_SCOPE_WORKGROUP);
            tokE[2 * row] = e0; tokE[2 * row + 1] = e1; tokW[2 * row] = w0; tokW[2 * row + 1] = w1; tokRank[2 * row] = (int)r0; tokRank[2 * row + 1] = (int)r1; }
        }
    }
    __syncthreads();
    if (tid < 8) { const unsigned n = lcnt[tid]; const unsigned base = __hip_atomic_fetch_add((unsigned*)(A.ws + WS_CTL) + CW_GCNT + 64 * tid, n, RLX_AGENT); wgbase[chunk * 8 + tid] = (int)base; }
    __syncthreads();
}
constexpr int NPHASE = 18;
__device__ __forceinline__ void moe_offsets(const unsigned char* ws, int (&toff)[9]) {
    const unsigned* gc = (const unsigned*)(ws + WS_CTL) + CW_GCNT; int acc = 0;
#pragma unroll
    for (int e = 0; e < 8; ++e) { toff[e] = acc; const unsigned n = (unsigned)__builtin_amdgcn_readfirstlane((int)__hip_atomic_load(gc + 64 * e, RLX_AGENT)); acc += (int)((n + 255u) >> 8); }
    toff[8] = acc;
}
#define TAIL_CONVERT(nunits, first, count) do { const int rounds_ = ((nunits) + G - 1) / G, nlast_ = (nunits) - (rounds_ - 1) * G; \
        if (bx >= nlast_) moe_convert(args, lds, (first), (count), (bx - nlast_) * NWAVES + wave, (G - nlast_) * NWAVES, wave, lane); } while (0)
constexpr int CVQ4 = 4000, CVQ6 = 5500, CVQ7 = 20000, CVQ9 = 8500, CVQS1 = 2000, CVQS2 = CV_NMOE - CVQ4 - CVQ6 - CVQ7 - CVQ9 - CVQS1;
__global__ void __launch_bounds__(NWAVES * 64, 2) fwd_kernel(Args args) {
    extern __shared__ __attribute__((aligned(16))) unsigned char lds_raw[];
    LAS unsigned char* lds = (LAS unsigned char*)lds_raw;
    volatile LAS unsigned* MISC = (volatile LAS unsigned*)(lds + MISC_OFF);
    const int tid = threadIdx.x, lane = tid & 63, wave = __builtin_amdgcn_readfirstlane(tid >> 6);
    const int G = gridDim.x, bx = blockIdx.x;
    const int gw = bx * NWAVES + wave, NGW = G * NWAVES;
    unsigned char* ws = args.ws;
    for (int u = tid; u < (LDS_BYTES - LDSCTL_OFF) / 4; u += NWAVES * 64) ((LAS unsigned*)(lds + LDSCTL_OFF))[u] = 0u;
    __syncthreads();
    const int lo = args.ph_lo, hi = args.ph_hi;
    XcdBarrier bar; bar.bar = (unsigned*)(ws + WS_CTL) + CW_BAR; bar.x = 0; bar.st = nullptr;
    if (hi - lo > 1) bar = xcd_barrier_post((unsigned*)(ws + WS_CTL) + CW_BAR, MISC + 8);
#define IN(k) (lo <= (k) && (k) < hi)
#define SEAM(k) do { if (IN((k) + 1)) xcd_barrier(bar); } while (0)
    float* mod = (float*)(ws + WS_MOD);
    bf16* XL = (bf16*)(ws + WS_XL); bf16* XC = (bf16*)(ws + WS_XC);
    bf16* H = (bf16*)(ws + WS_H);

    if (IN(0)) {
        for (int i = bx * (NWAVES * 64) + tid; i < NE * 2 * ED; i += G * NWAVES * 64) ((unsigned*)(ws + WS_COLMAX))[i] = 0u;
        for (int u = bx; u < 192; u += G) { if (args.sub & 1) p0_adaln(args, u, lds, tid, wave, lane); }
        if (args.sub & 4) p0_convert(args, lds, gw, NGW, wave, lane);
        SEAM(0);
    }
    if (IN(1)) {
        { const float* modp = (const float*)(ws + WS_MODP);
          for (int i = bx * (NWAVES * 64) + tid; i < MOD_N; i += G * NWAVES * 64) mod[i] = ((modp[i] + modp[MOD_N + i]) + modp[2 * MOD_N + i]) + modp[3 * MOD_N + i]; }
        { const float* modp = (const float*)(ws + WS_MODP); LAS float* ms = (LAS float*)lds;
          for (int i = tid; i < 9 * 2048; i += NWAVES * 64) { const int r = i >> 11, o = r * 6144 + (i & 2047); ms[i] = ((modp[o] + modp[MOD_N + o]) + modp[2 * MOD_N + o]) + modp[3 * MOD_N + o]; }
          __syncthreads(); norm_rows_lds(args.in[I_X], args.in[I_CTX], MT, args.in[I_N1G], ms, H, (float*)(ws + WS_ROWFAC1), gw, NGW, lane); }
        quant_rows_inplace_p((bf16*)(ws + WS_WIN), (const float*)(ws + WS_PMAX), (float*)(ws + WS_COLSCD), MIXIN, gw, NGW, lane);
        quant_rows_inplace_p((bf16*)(ws + WS_W13), (const float*)(ws + WS_PMAX) + MIXIN * 16, (float*)(ws + WS_COLSCD) + MIXIN, 2 * FFN, gw, NGW, lane);
        quant_rows_f8_1k((bf16*)(ws + WS_SOUT), (float*)(ws + WS_COLSCS), 2 * D, gw, NGW, lane);
        SEAM(1); }
    if (IN(2)) {
        pg8::Gemm g{H, (const bf16*)(ws + WS_WIN), MT, MIXIN, D / 2, D / 2, D}; pg8::StaticOrder S; S.init(MT, MIXIN, G, bx);
        pg8::EpiQKVUq E{(bf16*)(ws + WS_QKVU), args.in[I_QG], args.in[I_KG], EPS, (const float*)(ws + WS_ROWFAC1), (const float*)(ws + WS_COLSCD)};
        pg8::gemm_phase<pg8::EpiQKVUq, pg8::StaticOrder, true, true>(lds + RING_OFF, g, S, E);
        SEAM(2);
    }
    if (IN(3)) {
        const bf16* QKVU = (const bf16*)(ws + WS_QKVU); bf16* MIX = (bf16*)(ws + WS_MIX);
        LAS float* rpbl = (LAS float*)(lds + 40960); LAS float* cv = (LAS float*)(lds + 57344);
        float mq = 0.f, mk = 0.f, mb = 0.f;
        mq = fabsf(args.in[I_QG][lane]); mk = fabsf(args.in[I_KG][lane]);
        for (int i = lane; i < 8 * 465; i += 64) mb = fmaxf(mb, fabsf(args.in[I_RPB][i]));
        const float bnd = (8.2f * wave_max(mq) * wave_max(mk) + wave_max(mb)) * 1.44269504f;
        for (int i = tid; i < 8 * 465; i += NWAVES * 64) rpbl[i] = args.in[I_RPB][i] * 1.44269504f - bnd;
        __syncthreads();
        const int nbw = (G % 8 == 0) ? G / 8 : G, xb0 = (G % 8 == 0) ? (bx & 7) : 0, xbn = (G % 8 == 0) ? xb0 + 1 : 8, j0 = (G % 8 == 0) ? (bx >> 3) : bx;
        for (int x = xb0; x < xbn; ++x)
            for (int k = j0; k < 128; k += nbw) {
                if (k < 36) {
                    if (!(args.sub & (k < 32 ? 8 : 16))) continue;
                    const int wu = k < 32 ? (x * 32 + k) * 8 + wave : 2048 + (x * 4 + (k - 32)) * 8 + wave;
                    attn_unit(QKVU, MIX, wu, lds + wave * 5120, lds + 57344 + wave * 8192, rpbl, bnd, lane);
                } else {
                    if (!(args.sub & 32)) continue;
                    const int ci = k < 64 ? k - 36 : (k < 96 ? k - 36 : (k >= 100 && k < 112 ? k - 40 : -1)); if (ci < 0) continue;
                    conv_item(args, QKVU, MIX, ci < 64 ? x * 64 + ci : 512 + x * 8 + (ci - 64), cv, tid, wave, lane);
                }
            }
        SEAM(3);
    }
    if (IN(4)) {
        pg8::Gemm g{(const bf16*)(ws + WS_MIX), (const bf16*)(ws + WS_WOUT), MT, D, D, D, D}; pg8::StaticOrder S; S.init(MT, D, G, bx);
        pg8::EpiResidN<true> E{args.in[I_X], args.in[I_CTX], XL, XC, mod + 2 * 1024, H, (float*)(ws + WS_ROWSS), args.in[I_N2G], mod + 4 * 1024};
        pg8::gemm_phase<pg8::EpiResidN<true>, pg8::StaticOrder, true, true>(lds + RING_OFF, g, S, E);
        {
            const int nun = (MT / 256) * (D / 256), rounds = (nun + G - 1) / G, nlast = nun - (rounds - 1) * G, nidle = G - nlast, ii = bx - nlast;
            if (ii >= 0) {
                if (args.sub & 2) for (int u = ii; u < 128; u += nidle) p0_s5gen(args, u >> 1, u & 1, lds, tid);
                const bool cvw = (nidle > 128) ? (ii >= 128) : true;
                const int cw = (nidle > 128) ? (ii - 128) * NWAVES + wave : ii * NWAVES + wave, cn = (nidle > 128) ? (nidle - 128) * NWAVES : nidle * NWAVES;
                if (cvw) {
                    shw_rows((const bf16*)(ws + WS_W13), 2 * FFN, mod + 3 * 1024, (float*)(ws + WS_SHW13), cw, cn, lds, tid, lane, (const float*)(ws + WS_COLSCD) + MIXIN);
                    shw_rows((const bf16*)(ws + WS_SIN), D, mod + 9 * 6144, (float*)(ws + WS_SHWS), cw, cn, lds, tid, lane);
                    moe_convert(args, lds, 0, CVQ4, cw, cn, wave, lane); }
            }
            if (nidle <= 0) { for (int u = bx; u < 128; u += G) p0_s5gen(args, u >> 1, u & 1, lds, tid);
                shw_rows((const bf16*)(ws + WS_W13), 2 * FFN, mod + 3 * 1024, (float*)(ws + WS_SHW13), gw, NGW, lds, tid, lane, (const float*)(ws + WS_COLSCD) + MIXIN); shw_rows((const bf16*)(ws + WS_SIN), D, mod + 9 * 6144, (float*)(ws + WS_SHWS), gw, NGW, lds, tid, lane);
                moe_convert(args, lds, 0, CVQ4, gw, NGW, wave, lane); }
        }
        SEAM(4);
    }
    if (IN(5)) { quant_act_rows(H, (const float*)(ws + WS_ROWSS), (float*)(ws + WS_ROWFAC1), MT, gw, NGW, lane); SEAM(5); }
    if (IN(6)) {
        pg8::Gemm g{H, (const bf16*)(ws + WS_W13), MT, 2 * FFN, D / 2, D, D}; pg8::StaticOrder S; S.init(MT, 2 * FFN, G, bx);
        LAS float* rt = (LAS float*)(lds + RING_BYTES); pg8::rowfac_prepass(S, (const float*)(ws + WS_ROWFAC1), rt, tid);
        pg8::EpiSwiGLUNq E{(bf16*)(ws + WS_ACT), FFN, rt, (const float*)(ws + WS_SHW13), 2 * FFN, (const float*)(ws + WS_COLSCD) + MIXIN};
        pg8::gemm_phase<pg8::EpiSwiGLUNq, pg8::StaticOrder, true, true>(lds + RING_OFF, g, S, E);
        TAIL_CONVERT((MT / 256) * (2 * FFN / 256), CVQ4, CVQ6);
        SEAM(6);
    }
    if (IN(7)) {
        pg8::Gemm g{(const bf16*)(ws + WS_ACT), (const bf16*)(ws + WS_W2), MT, D, FFN, FFN, FFN}; pg8::StaticOrder S; S.init(MT, D, G, bx);
        pg8::EpiResidN<false> E{XL, XC, XL, XC, mod + 5 * 1024, H, (float*)(ws + WS_ROWSS), args.in[I_N1G] + D, mod + 9 * 6144 + 1 * 1024};
        pg8::gemm_phase<pg8::EpiResidN<false>, pg8::StaticOrder, true, true>(lds + RING_OFF, g, S, E);
        TAIL_CONVERT((MT / 256) * (D / 256), CVQ4 + CVQ6, CVQ7);
        SEAM(7);
    }
    float* mod1 = mod + 9 * 6144;
    if (IN(8)) {
        pg8::Gemm g{H, (const bf16*)(ws + WS_SIN), MT, D, D, D, D}; pg8::StaticOrder S; S.init(MT, D, G, bx);
        LAS float* rt = (LAS float*)(lds + RING_BYTES); pg8::rstd_prepass(S, (const float*)(ws + WS_ROWSS), rt, EPS, tid);
        pg8::EpiUC E{(bf16*)(ws + WS_UC), rt, (const float*)(ws + WS_SHWS)};
        pg8::gemm_phase<pg8::EpiUC, pg8::StaticOrder, true, true>(lds + RING_OFF, g, S, E);
        TAIL_CONVERT((MT / 256) * (D / 256), CVQ4 + CVQ6 + CVQ7, CVQ9);
        SEAM(8);
    }
    if (IN(9)) {
        pg8::Gemm g{(const bf16*)(ws + WS_UC), (const bf16*)(ws + WS_WEND), 64 * 768, 64 * 256, 512, 768, 512}; pg8::OrderS5E S{G, bx};
        pg8::EpiE E{(float*)(ws + WS_E)};
        pg8::gemm_phase<pg8::EpiE, pg8::OrderS5E, true, true>(lds + RING_OFF, g, S, E);
        if (G == 256) { if ((bx >> 3) >= 24) moe_convert(args, lds, CVQ4 + CVQ6 + CVQ7 + CVQ9, CVQS1, (((bx >> 3) - 24) * 8 + (bx & 7)) * NWAVES + wave, 64 * NWAVES, wave, lane); }
        else moe_convert(args, lds, CVQ4 + CVQ6 + CVQ7 + CVQ9, CVQS1, gw, NGW, wave, lane);
        SEAM(9);
    }
    if (IN(10)) { s5_scan(args, bx * (NWAVES * 64) + tid);
        if (G > 128) { if (bx >= 128) moe_convert(args, lds, CVQ4 + CVQ6 + CVQ7 + CVQ9 + CVQS1, CVQS2, (bx - 128) * NWAVES + wave, (G - 128) * NWAVES, wave, lane); }
        else moe_convert(args, lds, CVQ4 + CVQ6 + CVQ7 + CVQ9 + CVQS1, CVQS2, gw, NGW, wave, lane);
        SEAM(10); }
    if (IN(11)) {
        pg8::Gemm g{(const bf16*)(ws + WS_UC), (const bf16*)(ws + WS_BTOUT), 64 * 768, 64 * 512, 768, 768, 768}; pg8::OrderS5Y S{G, bx};
        pg8::EpiY E{ws + WS_Y};
        pg8::gemm_phase<pg8::EpiY, pg8::OrderS5Y, true, true>(lds + RING_OFF, g, S, E);
        SEAM(11);
    }
    if (IN(12)) {
        pg8::Gemm g{(const bf16*)(ws + WS_Y), (const bf16*)(ws + WS_SOUT), ML, 2 * D, D / 2, D / 2, D}; pg8::StaticOrder S; S.init(ML, 2 * D, G, bx);
        pg8::EpiGLURes E{XL, mod1 + 2 * 1024, (const float*)(ws + WS_COLSCS)};
        pg8::gemm_phase<pg8::EpiGLURes, pg8::StaticOrder, true, true>(lds + RING_OFF, g, S, E);
        SEAM(12);
    }
    unsigned char* tok = ws + WS_TOK;
    if (IN(13)) {
        int* rowsrc = (int*)(tok + TOK_ROWSRC); int* rowinfo = (int*)(tok + TOK_ROWINFO); float* rowgate = (float*)(tok + TOK_ROWGATE);
        for (int i = bx * (NWAVES * 64) + tid; i < MOE_TILES * 256; i += G * NWAVES * 64) { rowsrc[i] = 0; rowinfo[i] = -1; rowgate[i] = 0.f; ((float*)(ws + WS_POSSC))[i] = 0.f; }
        for (int ch = bx; ch < ML / 64; ch += G) moe_route(args, XL, mod1, H, ch, (LAS unsigned*)lds, tid, wave, lane);
        SEAM(13);
    }
    if (IN(14)) {
        int toff[9]; moe_offsets(ws, toff);
        const int* tokE = (const int*)(tok + TOK_E); const float* tokW = (const float*)(tok + TOK_W); const int* tokRank = (const int*)(tok + TOK_RANK); const int* wgbase = (const int*)(tok + TOK_WGBASE);
        int* rowsrc = (int*)(tok + TOK_ROWSRC); int* rowinfo = (int*)(tok + TOK_ROWINFO); float* rowgate = (float*)(tok + TOK_ROWGATE); int* tokPos = (int*)(tok + TOK_POS);
        for (int i = bx * (NWAVES * 64) + tid; i < 2 * ML; i += G * NWAVES * 64) { const int t = i >> 1, e = tokE[i]; int to = 0;
#pragma unroll
            for (int q = 0; q < 8; ++q) to = (e == q) ? toff[q] : to;
            const int pos = to * 256 + wgbase[(t >> 6) * 8 + e] + tokRank[i];
            rowsrc[pos] = t; rowinfo[pos] = i; rowgate[pos] = tokW[i]; tokPos[i] = pos; ((float*)(ws + WS_POSSC))[pos] = ((const float*)(ws + WS_ROWSC))[t]; }
        quant_rows_f8_inplace((bf16*)(ws + WS_MW2), (float*)(ws + WS_COLSC2), NE * D, gw, NGW, lane);
        quant_rows_inplace((bf16*)(ws + WS_MW13), (unsigned*)(ws + WS_COLMAX), NE * 2 * ED, gw, NGW, lane);
        SEAM(14);
    }
    if (IN(15)) {
        pg8::OrderMoE S; S.G = G; S.c = bx; S.nN = 2 * ED / 256; S.tmax = 1 << 30; S.fix = (args.sub >> 7) & 1; moe_offsets(ws, S.toff);
        pg8::Gemm g{H, (const bf16*)(ws + WS_MW13), MOE_TILES * 256, NE * 2 * ED, D / 2, D / 2, D, (const int*)(tok + TOK_ROWSRC)};
        pg8::EpiSwiGLUq E{ws + WS_ACTM, ED, 2 * ED / 256, (const float*)(ws + WS_POSSC), (const float*)(ws + WS_COLSC)};
        pg8::gemm_phase<pg8::EpiSwiGLUq, pg8::OrderMoE, true, true, true>(lds + RING_OFF, g, S, E);
        SEAM(15);
    }
    if (IN(16)) {
        pg8::OrderMoE S; S.G = G; S.c = bx; S.nN = D / 256; S.tmax = 128; S.fix = 0; moe_offsets(ws, S.toff);
        pg8::Gemm g{(const bf16*)(ws + WS_ACTM), (const bf16*)(ws + WS_MW2), MOE_TILES * 256, NE * D, ED / 2, ED / 2, ED};
        pg8::EpiMoE2 E{(bf16*)args.out, (const float*)(tok + TOK_ROWGATE), (const int*)(tok + TOK_ROWINFO), (const float*)(ws + WS_COLSC2)};
        pg8::gemm_phase<pg8::EpiMoE2, pg8::OrderMoE, true, true>(lds + RING_OFF, g, S, E);
        pg8::OrderMoEx Sx; Sx.G = G; Sx.c = bx; moe_offsets(ws, Sx.toff);
        pg8::Gemm gx{(const bf16*)(ws + WS_ACTM), (const bf16*)(ws + WS_MW2), MOE_TILES * 256, NE * D, 512, ED / 2, ED};
        pg8::EpiMoE2x Ex{(float*)(ws + WS_PX), (const float*)(tok + TOK_ROWGATE), (const float*)(ws + WS_COLSC2)};
        pg8::gemm_phase<pg8::EpiMoE2x, pg8::OrderMoEx, true, false>(lds + RING_OFF, gx, Sx, Ex);
        SEAM(16);
    }
    if (IN(17)) {
        const unsigned bad = __hip_atomic_load((unsigned*)(ws + WS_CTL) + CW_BAR + XB_TMO, RLX_AGENT);
        const int* tokPos = (const int*)(tok + TOK_POS); const float* PX = (const float*)(ws + WS_PX);
        for (int tb = gw; tb < ML; tb += 2 * NGW) {
            const int tt[2] = {tb, (tb + NGW < ML) ? tb + NGW : tb}; const int ntk = (tb + NGW < ML) ? 2 : 1;
            v2u a[2][4], b[2][4], xw[2][4]; f32x4 gv[2][4]; int p0[2], p1[2];
#pragma unroll
            for (int u = 0; u < 2; ++u) { const int t = tt[u]; const bf16* y0 = (const bf16*)(args.out + (size_t)t * D); const bf16* y1 = y0 + D; const float* gp = mod1 + (size_t)(t >> 11) * 6144 + 5 * 1024;
                p0[u] = tokPos[2 * t] - 128 * 256; p1[u] = tokPos[2 * t + 1] - 128 * 256;
#pragma unroll
                for (int j = 0; j < 4; ++j) { const int c = 4 * lane + 256 * j; a[u][j] = *(const v2u*)(y0 + c); b[u][j] = *(const v2u*)(y1 + c); xw[u][j] = *(const v2u*)(XL + (size_t)t * D + c); gv[u][j] = *(const f32x4*)(gp + c); } }
            asm volatile("s_waitcnt vmcnt(0)" ::: "memory");
#pragma unroll
            for (int u = 0; u < 2; ++u) { if (u < ntk) { const int t = tt[u];
#pragma unroll
                for (int j = 0; j < 4; ++j) { const int c = 4 * lane + 256 * j;
                    f32x4 ya = (f32x4){bflo(a[u][j].x), bfhi(a[u][j].x), bflo(a[u][j].y), bfhi(a[u][j].y)}, yb = (f32x4){bflo(b[u][j].x), bfhi(b[u][j].x), bflo(b[u][j].y), bfhi(b[u][j].y)};
                    if (p0[u] >= 0) { const float* q = PX + (size_t)p0[u] * D + c; ya = ((*(const f32x4*)q + *(const f32x4*)(q + (size_t)2048 * D)) + *(const f32x4*)(q + (size_t)4096 * D)) + *(const f32x4*)(q + (size_t)6144 * D); }
                    if (p1[u] >= 0) { const float* q = PX + (size_t)p1[u] * D + c; yb = ((*(const f32x4*)q + *(const f32x4*)(q + (size_t)2048 * D)) + *(const f32x4*)(q + (size_t)4096 * D)) + *(const f32x4*)(q + (size_t)6144 * D); }
                    const f32x4 xv = (f32x4){bflo(xw[u][j].x), bfhi(xw[u][j].x), bflo(xw[u][j].y), bfhi(xw[u][j].y)};
                    f32x4 o = xv + gv[u][j] * (ya + yb); if (bad) o = (f32x4){__builtin_nanf(""), __builtin_nanf(""), __builtin_nanf(""), __builtin_nanf("")};
                    *(f32x4*)(args.out + (size_t)t * D + c) = o; } } }
        }
    }
#undef IN
#undef SEAM
}

extern "C" void kernel_launch(void* const* d_in, const int* in_sizes, int n_in, void* d_out, int out_size, void* d_ws, size_t ws_size, hipStream_t stream) {
    static int grid = 0;
    if (grid == 0) {
        if (n_in != N_IN || out_size != ML * D || ws_size < WS_END) { fprintf(stderr, "kernel_launch: unexpected problem (n_in %d, out %d, ws %zu); nothing launched\n", n_in, out_size, ws_size); grid = -1; return; }
        int dev = 0, cus = 0, per_cu = 0;
        if (hipGetDevice(&dev) != hipSuccess || hipDeviceGetAttribute(&cus, hipDeviceAttributeMultiprocessorCount, dev) != hipSuccess) { grid = -1; return; }
        if (hipFuncSetAttribute((const void*)fwd_kernel, hipFuncAttributeMaxDynamicSharedMemorySize, LDS_BYTES) != hipSuccess) { fprintf(stderr, "kernel_launch: hipFuncSetAttribute failed\n"); grid = -1; return; }
        if (hipOccupancyMaxActiveBlocksPerMultiprocessor(&per_cu, (const void*)fwd_kernel, NWAVES * 64, LDS_BYTES) != hipSuccess || per_cu < 1) { fprintf(stderr, "kernel_launch: occupancy query says %d blocks per CU\n", per_cu); (void)hipGetLastError(); grid = -1; return; }
        grid = cus;
    }
    if (grid < 0) return;
    if (hipMemsetAsync((char*)d_ws + WS_CTL, 0, CTL_ZERO_BYTES, stream) != hipSuccess) return;
    Args a{};
    for (int i = 0; i < N_IN; ++i) a.in[i] = (const float*)d_in[i];
    a.out = (float*)d_out; a.ws = (unsigned char*)d_ws; a.sub = 63;
#if MK_N_LAUNCHES == 1
    a.ph_lo = 0; a.ph_hi = NPHASE;
    hipLaunchKernelGGL(fwd_kernel, dim3(grid), dim3(NWAVES * 64), LDS_BYTES, stream, a);
#else
    for (int p = 0; p < NPHASE; ++p) { const int nrep = ((MK_REPEAT_MASK >> p) & 1u) ? 2 : 1;
        for (int r = 0; r < nrep; ++r) { a.ph_lo = p; a.ph_hi = p + 1; a.sub = (r == 0) ? 63 : MK_REPEAT_SUB; hipLaunchKernelGGL(fwd_kernel, dim3(grid), dim3(NWAVES * 64), LDS_BYTES, stream, a); } }
#endif
}
```

```cpp
#include <hip/hip_runtime.h>
#include <cstdio>
#include <cstdint>
#ifndef MK_N_LAUNCHES
#define MK_N_LAUNCHES 1
#endif
#ifndef MK_REPEAT_SUB
#define MK_REPEAT_SUB 63
#endif
#ifndef MK_REPEAT_MASK
#define MK_REPEAT_MASK 0u
#endif
namespace pg8 {
#define PG8_LAS __attribute__((address_space(3)))
typedef unsigned short bf16_t;
typedef short bf16x8 __attribute__((ext_vector_type(8)));
typedef float f32x4 __attribute__((ext_vector_type(4)));
typedef unsigned u32x4 __attribute__((ext_vector_type(4)));
typedef unsigned u32x2 __attribute__((ext_vector_type(2)));
typedef int i32x4 __attribute__((ext_vector_type(4)));
__device__ __forceinline__ f32x4 mma16(bf16x8 a, bf16x8 b, f32x4 c) { return __builtin_amdgcn_mfma_f32_16x16x32_bf16(a, b, c, 0, 0, 0); }
__device__ __forceinline__ i32x4 mma16(bf16x8 a, bf16x8 b, i32x4 c) { return __builtin_amdgcn_mfma_i32_16x16x64_i8(__builtin_bit_cast(i32x4, a), __builtin_bit_cast(i32x4, b), c, 0, 0, 0); }
typedef int i32x8 __attribute__((ext_vector_type(8)));
template <class T, class = void> struct is_fp8 { static constexpr bool v = false; };
template <class T> struct is_fp8<T, decltype((void)T::FP8)> { static constexpr bool v = T::FP8; };
template <bool FP8> struct Frag { bf16x8 k0, k1;
    __device__ __forceinline__ void set(int k, bf16x8 x) { if (k == 0) k0 = x; else k1 = x; } };
template <> struct Frag<true> { i32x8 v;
    __device__ __forceinline__ void set(int k, bf16x8 x) { if (k == 0) v.lo = __builtin_bit_cast(i32x4, x); else v.hi = __builtin_bit_cast(i32x4, x); } };
template <class ACC> __device__ __forceinline__ ACC mma_frag(const Frag<false>& a, const Frag<false>& b, ACC c) { c = mma16(a.k0, b.k0, c); return mma16(a.k1, b.k1, c); }
__device__ __forceinline__ f32x4 mma_frag(const Frag<true>& a, const Frag<true>& b, f32x4 c) { asm volatile("v_mfma_f32_16x16x128_f8f6f4 %0, %1, %2, %0" : "+v"(c) : "v"(a.v), "v"(b.v)); return c; }
template <bool FP8> __device__ __forceinline__ void mma_drain() { if constexpr (FP8) asm volatile("s_nop 15\n\ts_nop 15" ::: "memory"); }
constexpr int BM = 256, BK = 64, HALF = 128, HTB = HALF * BK * 2  , STAGE_BYTES = 8 * HTB, NXCD = 8, WGM = 8;

__host__ __device__ __forceinline__ int lds_byte(int r, int c) { const int st = (r >> 4) * 2 + (c >> 5), rr = r & 15, cc = c & 31, ob = rr * 64 + cc * 2; return st * 1024 + (ob ^ (((ob >> 9) & 1) << 5)); }
__host__ __device__ __forceinline__ void stage_rc(int b, int& R, int& C) { const int st = b / 1024, sb = b % 1024, swz = sb ^ (((sb >> 9) & 1) << 5); R = (st >> 1) * 16 + swz / 64; C = (st & 1) * 32 + (swz % 64) / 2; }
__host__ __device__ __forceinline__ int perm32(int rho) { const int n = rho >> 4, i = rho & 15; return 8 * (i >> 2) + 4 * n + (i & 3); }

struct Unit { int pm, pn, k0, idx; };
struct Gemm { const bf16_t* A; const bf16_t* Bt; int M, N, K, lda, ldb; const int* rowsrc; };

struct StaticOrder {
    static constexpr bool VARK = false;
    int nM, nN, nwg, G, c;
    __host__ __device__ void init(int M, int N, int G_, int c_) { nM = M / BM; nN = N / BM; nwg = nM * nN; G = G_; c = c_; }
    __host__ __device__ bool next(int i, Unit& u) const {
        const long L = (long)i * G + c; if (L >= nwg) return false;
        int wgid = (int)L; { const int q = nwg / NXCD, r = nwg % NXCD, xcd = wgid % NXCD, off = wgid / NXCD; wgid = (xcd < r ? xcd * (q + 1) : r * (q + 1) + (xcd - r) * q) + off; }
        const int nig = WGM * nN, gid = wgid / nig, fm = gid * WGM, gsz = (nM - fm) < WGM ? (nM - fm) : WGM;
        u.pm = fm + ((wgid % nig) % gsz); u.pn = (wgid % nig) / gsz; u.k0 = 0; u.idx = i; return true;
    }
    __device__ __forceinline__ void a_ready(const Unit&) const {}
    __device__ __forceinline__ void done(const Unit&) const {}
};

constexpr int ML_ = 16384, MC_ = 2048, MT_ = ML_ + MC_, DM_ = 1024;
__device__ __forceinline__ unsigned cvt_pk_bf16(float lo, float hi) { unsigned r; asm volatile("v_cvt_pk_bf16_f32 %0, %1, %2" : "=v"(r) : "v"(lo), "v"(hi)); return r; }
__device__ __forceinline__ float sigm(float x) { return __builtin_amdgcn_rcpf(1.0f + __expf(-x)); }
__device__ __forceinline__ float gelu_tanh(float x) { const float u = 1.5957691216f * (x + 0.044715f * x * x * x); return x * sigm(u); }
__device__ __forceinline__ unsigned f8pack4(const f32x4 v) { int w = 0;
    w = __builtin_amdgcn_cvt_pk_fp8_f32(__builtin_amdgcn_fmed3f(v[0], -448.f, 448.f), __builtin_amdgcn_fmed3f(v[1], -448.f, 448.f), w, false);
    w = __builtin_amdgcn_cvt_pk_fp8_f32(__builtin_amdgcn_fmed3f(v[2], -448.f, 448.f), __builtin_amdgcn_fmed3f(v[3], -448.f, 448.f), w, true); return (unsigned)w; }
__device__ __forceinline__ u32x4 pack8(const f32x4 a, const f32x4 b) { u32x4 w; w.x = cvt_pk_bf16(a[0], a[1]); w.y = cvt_pk_bf16(a[2], a[3]); w.z = cvt_pk_bf16(b[0], b[1]); w.w = cvt_pk_bf16(b[2], b[3]); return w; }


struct EpiQKVU {
    typedef f32x4 acc_t; static constexpr bool PERM = true, AFTER_DRAIN = false;
    bf16_t* O; const float* gq; const float* gk; float eps;
    __device__ __forceinline__ void operator()(const f32x4 (&acc)[2][2][4][2], const Unit& u, int wr, int wc, int fr, int fq) const {
        const int row0 = u.pm * BM + wr * 64 + fr; const int pn = u.pn;
        if (pn < 6) {
            const bool nrm = pn < 4; const float* gp = (pn < 2) ? gq : gk;
            f32x4 gn[2][2];
#pragma unroll
            for (int bj = 0; bj < 2; ++bj)
#pragma unroll
                for (int n = 0; n < 2; ++n) gn[bj][n] = nrm ? *(const f32x4*)(gp + 32 * bj + 8 * fq + 4 * n) : (f32x4){1.f, 1.f, 1.f, 1.f};
#pragma unroll
            for (int ai = 0; ai < 2; ++ai)
#pragma unroll
                for (int m = 0; m < 4; ++m) {
                    float sc = 1.f;
                    if (nrm) { float ss = 0.f;
#pragma unroll
                        for (int bj = 0; bj < 2; ++bj)
#pragma unroll
                            for (int n = 0; n < 2; ++n) { const f32x4 x = acc[ai][bj][m][n]; ss += (x[0] * x[0] + x[1] * x[1]) + (x[2] * x[2] + x[3] * x[3]); }
                        ss += __shfl_xor(ss, 16); ss += __shfl_xor(ss, 32);
                        sc = rsqrtf(ss * (1.0f / 64.0f) + eps); }
                    bf16_t* rowp = O + (size_t)(row0 + ai * HALF + m * 16) * 2048 + 256 * pn + 64 * wc + 8 * fq;
#pragma unroll
                    for (int bj = 0; bj < 2; ++bj) { const f32x4 v0 = acc[ai][bj][m][0] * gn[bj][0] * sc, v1 = acc[ai][bj][m][1] * gn[bj][1] * sc; *(u32x4*)(rowp + 32 * bj) = pack8(v0, v1); }
                }
        } else {
            const int cb = 1536 + 128 * (pn - 6) + 32 * wc + 8 * fq;
#pragma unroll
            for (int ai = 0; ai < 2; ++ai)
#pragma unroll
                for (int m = 0; m < 4; ++m) {
                    f32x4 v[2];
#pragma unroll
                    for (int n = 0; n < 2; ++n) { const f32x4 a = acc[ai][0][m][n], g = acc[ai][1][m][n]; v[n] = (f32x4){a[0] * sigm(g[0]), a[1] * sigm(g[1]), a[2] * sigm(g[2]), a[3] * sigm(g[3])}; }
                    *(u32x4*)(O + (size_t)(row0 + ai * HALF + m * 16) * 2048 + cb) = pack8(v[0], v[1]);
                }
        }
    }
};
struct EpiQKVUq {
    typedef i32x4 acc_t; static constexpr bool PERM = true, AFTER_DRAIN = false;
    bf16_t* O; const float* gq; const float* gk; float eps; const float* rowfac; const float* colscale;
    __device__ __forceinline__ void operator()(const i32x4 (&acc)[2][2][4][2], const Unit& u, int wr, int wc, int fr, int fq) const {
        const int row0 = u.pm * BM + wr * 64 + fr; const int pn = u.pn;
        f32x4 cs[2][2];
#pragma unroll
        for (int bj = 0; bj < 2; ++bj)
#pragma unroll
            for (int n = 0; n < 2; ++n) cs[bj][n] = *(const f32x4*)(colscale + pn * BM + bj * HALF + wc * 32 + 8 * fq + 4 * n);
#define QF(ai_, bj_, m_, n_, rf_) ((f32x4){(float)acc[ai_][bj_][m_][n_][0], (float)acc[ai_][bj_][m_][n_][1], (float)acc[ai_][bj_][m_][n_][2], (float)acc[ai_][bj_][m_][n_][3]} * cs[bj_][n_] * (rf_))
        if (pn < 6) {
            const bool nrm = pn < 4; const float* gp = (pn < 2) ? gq : gk;
            f32x4 gn[2][2];
#pragma unroll
            for (int bj = 0; bj < 2; ++bj)
#pragma unroll
                for (int n = 0; n < 2; ++n) gn[bj][n] = nrm ? *(const f32x4*)(gp + 32 * bj + 8 * fq + 4 * n) : (f32x4){1.f, 1.f, 1.f, 1.f};
#pragma unroll
            for (int ai = 0; ai < 2; ++ai)
#pragma unroll
                for (int m = 0; m < 4; ++m) {
                    float sc = 1.f; const float rf = rowfac[row0 + ai * HALF + m * 16];
                    f32x4 xf[2][2];
#pragma unroll
                    for (int bj = 0; bj < 2; ++bj)
#pragma unroll
                        for (int n = 0; n < 2; ++n) xf[bj][n] = QF(ai, bj, m, n, rf);
                    if (nrm) { float ss = 0.f;
#pragma unroll
                        for (int bj = 0; bj < 2; ++bj)
#pragma unroll
                            for (int n = 0; n < 2; ++n) { const f32x4 x = xf[bj][n]; ss += (x[0] * x[0] + x[1] * x[1]) + (x[2] * x[2] + x[3] * x[3]); }
                        ss += __shfl_xor(ss, 16); ss += __shfl_xor(ss, 32);
                        sc = rsqrtf(ss * (1.0f / 64.0f) + eps); }
                    bf16_t* rowp = O + (size_t)(row0 + ai * HALF + m * 16) * 2048 + 256 * pn + 64 * wc + 8 * fq;
#pragma unroll
                    for (int bj = 0; bj < 2; ++bj) { const f32x4 v0 = xf[bj][0] * gn[bj][0] * sc, v1 = xf[bj][1] * gn[bj][1] * sc; *(u32x4*)(rowp + 32 * bj) = pack8(v0, v1); }
                }
        } else {
            const int cb = 1536 + 128 * (pn - 6) + 32 * wc + 8 * fq;
#pragma unroll
            for (int ai = 0; ai < 2; ++ai)
#pragma unroll
                for (int m = 0; m < 4; ++m) { const float rf = rowfac[row0 + ai * HALF + m * 16];
                    f32x4 v[2];
#pragma unroll
                    for (int n = 0; n < 2; ++n) { const f32x4 a = QF(ai, 0, m, n, rf), g = QF(ai, 1, m, n, rf); v[n] = (f32x4){a[0] * sigm(g[0]), a[1] * sigm(g[1]), a[2] * sigm(g[2]), a[3] * sigm(g[3])}; }
                    *(u32x4*)(O + (size_t)(row0 + ai * HALF + m * 16) * 2048 + cb) = pack8(v[0], v[1]);
                }
        }
    }
};
#undef QF
struct EpiResid {
    typedef f32x4 acc_t; static constexpr bool PERM = false, AFTER_DRAIN = false;
    const float* baseL; const float* baseC; float* XL; float* XC; const float* gate;
    __device__ __forceinline__ void operator()(const f32x4 (&acc)[2][2][4][2], const Unit& u, int wr, int wc, int fr, int fq) const {
        const int R0 = u.pm * BM, row0 = R0 + wr * 64 + fr, col0 = u.pn * BM + wc * 32 + 4 * fq;
        const int modrow = R0 < ML_ ? (R0 >> 11) : 8;
        const float* gp = gate + (size_t)modrow * 6144 + col0;
        const float* bp = R0 < ML_ ? baseL : baseC - (size_t)ML_ * DM_;
        float* xo = R0 < ML_ ? XL : XC - (size_t)ML_ * DM_;
        f32x4 gv[2][2];
#pragma unroll
        for (int bj = 0; bj < 2; ++bj)
#pragma unroll
            for (int n = 0; n < 2; ++n) gv[bj][n] = *(const f32x4*)(gp + bj * HALF + n * 16);
#pragma unroll
        for (int ai = 0; ai < 2; ++ai)
#pragma unroll
            for (int m = 0; m < 4; ++m) { const size_t ro = (size_t)(row0 + ai * HALF + m * 16) * DM_ + col0;
#pragma unroll
                for (int bj = 0; bj < 2; ++bj)
#pragma unroll
                    for (int n = 0; n < 2; ++n) { const f32x4 xv = *(const f32x4*)(bp + ro + bj * HALF + n * 16); *(f32x4*)(xo + ro + bj * HALF + n * 16) = xv + gv[bj][n] * acc[ai][bj][m][n]; } }
    }
};
__device__ __forceinline__ void unpack8(const u32x4 w, f32x4& a, f32x4& b) {
    a = (f32x4){__builtin_bit_cast(float, w.x << 16), __builtin_bit_cast(float, w.x & 0xffff0000u), __builtin_bit_cast(float, w.y << 16), __builtin_bit_cast(float, w.y & 0xffff0000u)};
    b = (f32x4){__builtin_bit_cast(float, w.z << 16), __builtin_bit_cast(float, w.z & 0xffff0000u), __builtin_bit_cast(float, w.w << 16), __builtin_bit_cast(float, w.w & 0xffff0000u)}; }
template <bool BASE_F32> struct EpiResidN {
    typedef f32x4 acc_t; static constexpr bool PERM = true, AFTER_DRAIN = false;
    const void* baseL; const void* baseC; bf16_t* XL; bf16_t* XC; const float* gate; bf16_t* Hn; float* rowss; const float* ngain; const float* nscale;
    __device__ __forceinline__ void operator()(const f32x4 (&acc)[2][2][4][2], const Unit& u, int wr, int wc, int fr, int fq) const {
        const int R0 = u.pm * BM, row0 = R0 + wr * 64 + fr, col0 = u.pn * BM + wc * 32 + 8 * fq;
        const int modrow = R0 < ML_ ? (R0 >> 11) : 8, rsub = R0 < ML_ ? 0 : ML_;
        const float* gp = gate + (size_t)modrow * 6144 + col0; const float* sp = nscale + (size_t)modrow * 6144 + col0;
        const void* bp = R0 < ML_ ? baseL : baseC; bf16_t* xo = R0 < ML_ ? XL : XC;
        f32x4 gv[2][2], gs[2][2];
#pragma unroll
        for (int bj = 0; bj < 2; ++bj)
#pragma unroll
            for (int n = 0; n < 2; ++n) { gv[bj][n] = *(const f32x4*)(gp + bj * HALF + n * 4); gs[bj][n] = *(const f32x4*)(ngain + col0 + bj * HALF + n * 4) * (*(const f32x4*)(sp + bj * HALF + n * 4) + 1.0f); }
#pragma unroll
        for (int ai = 0; ai < 2; ++ai)
#pragma unroll
            for (int m = 0; m < 4; ++m) { const int row = row0 + ai * HALF + m * 16; const size_t ro = (size_t)(row - rsub) * DM_ + col0; float ss = 0.f;
#pragma unroll
                for (int bj = 0; bj < 2; ++bj) { f32x4 x0, x1;
                    if constexpr (BASE_F32) { x0 = *(const f32x4*)((const float*)bp + ro + bj * HALF); x1 = *(const f32x4*)((const float*)bp + ro + bj * HALF + 4); }
                    else unpack8(*(const u32x4*)((const bf16_t*)bp + ro + bj * HALF), x0, x1);
                    const u32x4 xw = pack8(x0 + gv[bj][0] * acc[ai][bj][m][0], x1 + gv[bj][1] * acc[ai][bj][m][1]); *(u32x4*)(xo + ro + bj * HALF) = xw;
                    f32x4 r0, r1; unpack8(xw, r0, r1);
                    ss += ((r0[0] * r0[0] + r0[1] * r0[1]) + (r0[2] * r0[2] + r0[3] * r0[3])) + ((r1[0] * r1[0] + r1[1] * r1[1]) + (r1[2] * r1[2] + r1[3] * r1[3]));
                    *(u32x4*)(Hn + (size_t)row * DM_ + col0 + bj * HALF) = pack8(r0 * gs[bj][0], r1 * gs[bj][1]); }
                ss += __shfl_xor(ss, 16); ss += __shfl_xor(ss, 32);
                if (fq == 0) rowss[(size_t)row * 16 + u.pn * 4 + wc] = ss; }
    }
};
__device__ __forceinline__ float row_rstd(const float* rowss, int row, float eps) {
    const f32x4* p = (const f32x4*)(rowss + (size_t)row * 16); const f32x4 a = p[0], b = p[1], c = p[2], d = p[3];
    const float s = (((a[0] + a[1]) + (a[2] + a[3])) + ((b[0] + b[1]) + (b[2] + b[3]))) + (((c[0] + c[1]) + (c[2] + c[3])) + ((d[0] + d[1]) + (d[2] + d[3])));
    return rsqrtf(s * (1.0f / 1024.0f) + eps); }
template <class Sched> __device__ __forceinline__ void rstd_prepass(const Sched& S, const float* rowss, PG8_LAS float* rt, float eps, int tid) {
    Unit u; int n = 0; while (n < 8 && S.next(n, u)) ++n;
#pragma unroll
    for (int q = 0; q < 4; ++q) { const int r = tid + 512 * q, i = r >> 8;
        if (i < n) { S.next(i, u); rt[r] = row_rstd(rowss, u.pm * BM + (r & 255), eps); } }
    __syncthreads();
}
struct EpiSwiGLUN {
    typedef f32x4 acc_t; static constexpr bool PERM = true, AFTER_DRAIN = false;
    bf16_t* O; int ldo; const PG8_LAS float* rt; const float* shw; int nphys;
    __device__ __forceinline__ void operator()(const f32x4 (&acc)[2][2][4][2], const Unit& u, int wr, int wc, int fr, int fq) const {
        const int R0 = u.pm * BM, row0 = R0 + wr * 64 + fr, colp = u.pn * BM + wc * 32 + 8 * fq, col0 = u.pn * HALF + wc * 32 + 8 * fq;
        const float* sp = shw + (size_t)(R0 < ML_ ? (R0 >> 11) : 8) * nphys + colp;
        f32x4 s1[2], s3[2];
#pragma unroll
        for (int n = 0; n < 2; ++n) { s1[n] = *(const f32x4*)(sp + 4 * n); s3[n] = *(const f32x4*)(sp + HALF + 4 * n); }
#pragma unroll
        for (int ai = 0; ai < 2; ++ai)
#pragma unroll
            for (int m = 0; m < 4; ++m) { const int row = row0 + ai * HALF + m * 16; const float rs = rt[u.idx * BM + (row - R0)];
                f32x4 v[2];
#pragma unroll
                for (int n = 0; n < 2; ++n) { const f32x4 a = acc[ai][0][m][n] * rs + s1[n], b = acc[ai][1][m][n] * rs + s3[n]; v[n] = (f32x4){a[0] * sigm(a[0]) * b[0], a[1] * sigm(a[1]) * b[1], a[2] * sigm(a[2]) * b[2], a[3] * sigm(a[3]) * b[3]}; }
                *(u32x4*)(O + (size_t)row * ldo + col0) = pack8(v[0], v[1]);
            }
    }
};
struct EpiSwiGLU {
    typedef f32x4 acc_t; static constexpr bool PERM = true, AFTER_DRAIN = false;
    bf16_t* O; int ldo, nN, row_sub; int skip;
    __device__ __forceinline__ void operator()(const f32x4 (&acc)[2][2][4][2], const Unit& u, int wr, int wc, int fr, int fq) const {
        if (skip) {
#pragma unroll
            for (int ai = 0; ai < 2; ++ai)
#pragma unroll
                for (int bj = 0; bj < 2; ++bj)
#pragma unroll
                    for (int m = 0; m < 4; ++m)
#pragma unroll
                        for (int n = 0; n < 2; ++n) asm volatile("" :: "v"(acc[ai][bj][m][n]));
            return; }
        const int row0 = u.pm * BM + wr * 64 + fr - row_sub, col0 = (u.pn % nN) * HALF + wc * 32 + 8 * fq;
#pragma unroll
        for (int ai = 0; ai < 2; ++ai)
#pragma unroll
            for (int m = 0; m < 4; ++m) {
                f32x4 v[2];
#pragma unroll
                for (int n = 0; n < 2; ++n) { const f32x4 a = acc[ai][0][m][n], b = acc[ai][1][m][n]; v[n] = (f32x4){a[0] * sigm(a[0]) * b[0], a[1] * sigm(a[1]) * b[1], a[2] * sigm(a[2]) * b[2], a[3] * sigm(a[3]) * b[3]}; }
                *(u32x4*)(O + (size_t)(row0 + ai * HALF + m * 16) * ldo + col0) = pack8(v[0], v[1]);
            }
    }
};
template <class Sched> __device__ __forceinline__ void rowfac_prepass(const Sched& S, const float* rowfac, PG8_LAS float* rt, int tid) {
    Unit u; int n = 0; while (n < 8 && S.next(n, u)) ++n;
#pragma unroll
    for (int q = 0; q < 4; ++q) { const int r = tid + 512 * q, i = r >> 8; if (i < n) { S.next(i, u); rt[r] = rowfac[u.pm * BM + (r & 255)]; } }
    __syncthreads();
}
struct EpiSwiGLUNq {
    typedef i32x4 acc_t; static constexpr bool PERM = true, AFTER_DRAIN = false;
    bf16_t* O; int ldo; const PG8_LAS float* rt; const float* shw; int nphys; const float* colscale;
    __device__ __forceinline__ void operator()(const i32x4 (&acc)[2][2][4][2], const Unit& u, int wr, int wc, int fr, int fq) const {
        const int R0 = u.pm * BM, row0 = R0 + wr * 64 + fr, colp = u.pn * BM + wc * 32 + 8 * fq, col0 = u.pn * HALF + wc * 32 + 8 * fq;
        const float* sp = shw + (size_t)(R0 < ML_ ? (R0 >> 11) : 8) * nphys + colp; const float* cp = colscale + colp;
        f32x4 s1[2], s3[2], c1[2], c3[2];
#pragma unroll
        for (int n = 0; n < 2; ++n) { s1[n] = *(const f32x4*)(sp + 4 * n); s3[n] = *(const f32x4*)(sp + HALF + 4 * n); c1[n] = *(const f32x4*)(cp + 4 * n); c3[n] = *(const f32x4*)(cp + HALF + 4 * n); }
#pragma unroll
        for (int ai = 0; ai < 2; ++ai)
#pragma unroll
            for (int m = 0; m < 4; ++m) { const int row = row0 + ai * HALF + m * 16; const float rs = rt[u.idx * BM + (row - R0)];
                f32x4 v[2];
#pragma unroll
                for (int n = 0; n < 2; ++n) { const i32x4 ia = acc[ai][0][m][n], ib = acc[ai][1][m][n];
                    const f32x4 a = (f32x4){(float)ia[0], (float)ia[1], (float)ia[2], (float)ia[3]} * (c1[n] * rs) + s1[n], b = (f32x4){(float)ib[0], (float)ib[1], (float)ib[2], (float)ib[3]} * (c3[n] * rs) + s3[n];
                    v[n] = (f32x4){a[0] * sigm(a[0]) * b[0], a[1] * sigm(a[1]) * b[1], a[2] * sigm(a[2]) * b[2], a[3] * sigm(a[3]) * b[3]}; }
                *(u32x4*)(O + (size_t)row * ldo + col0) = pack8(v[0], v[1]);
            }
    }
};
struct EpiSwiGLUq {
    typedef i32x4 acc_t; static constexpr bool PERM = true, AFTER_DRAIN = false;
    unsigned char* O; int ldo, nN; const float* posscale; const float* colscale;
    __device__ __forceinline__ void operator()(const i32x4 (&acc)[2][2][4][2], const Unit& u, int wr, int wc, int fr, int fq) const {
        const int row0 = u.pm * BM + wr * 64 + fr, col0 = (u.pn % nN) * HALF + wc * 32 + 8 * fq; const float* cp = colscale + (size_t)u.pn * BM + wc * 32 + 8 * fq;
        f32x4 c1[2], c3[2];
#pragma unroll
        for (int n = 0; n < 2; ++n) { c1[n] = *(const f32x4*)(cp + 4 * n); c3[n] = *(const f32x4*)(cp + HALF + 4 * n); }
#pragma unroll
        for (int ai = 0; ai < 2; ++ai)
#pragma unroll
            for (int m = 0; m < 4; ++m) { const int row = row0 + ai * HALF + m * 16; const float rs = posscale[row];
                f32x4 v[2];
#pragma unroll
                for (int n = 0; n < 2; ++n) { const i32x4 ia = acc[ai][0][m][n], ib = acc[ai][1][m][n];
                    const f32x4 a = (f32x4){(float)ia[0], (float)ia[1], (float)ia[2], (float)ia[3]} * c1[n] * rs, b = (f32x4){(float)ib[0], (float)ib[1], (float)ib[2], (float)ib[3]} * c3[n] * rs;
                    v[n] = (f32x4){a[0] * sigm(a[0]) * b[0], a[1] * sigm(a[1]) * b[1], a[2] * sigm(a[2]) * b[2], a[3] * sigm(a[3]) * b[3]}; }
                u32x2 o; o.x = f8pack4(v[0]); o.y = f8pack4(v[1]); *(u32x2*)(O + (size_t)row * ldo + col0) = o;
            }
    }
};
struct EpiGLURes {
    typedef f32x4 acc_t; static constexpr bool PERM = true, AFTER_DRAIN = false, FP8 = true;
    bf16_t* X; const float* gate; const float* colscale;
    __device__ __forceinline__ void operator()(const f32x4 (&acc)[2][2][4][2], const Unit& u, int wr, int wc, int fr, int fq) const {
        const int R0 = u.pm * BM, row0 = R0 + wr * 64 + fr, col0 = u.pn * HALF + wc * 32 + 8 * fq;
        const float* gp = gate + (size_t)(R0 >> 11) * 6144 + col0; const float* cp = colscale + (size_t)u.pn * BM + wc * 32 + 8 * fq;
        f32x4 gv[2], c1[2], c2[2];
#pragma unroll
        for (int n = 0; n < 2; ++n) { gv[n] = *(const f32x4*)(gp + n * 4); c1[n] = *(const f32x4*)(cp + n * 4); c2[n] = *(const f32x4*)(cp + HALF + n * 4); }
#pragma unroll
        for (int ai = 0; ai < 2; ++ai)
#pragma unroll
            for (int m = 0; m < 4; ++m) { bf16_t* xp = X + (size_t)(row0 + ai * HALF + m * 16) * DM_ + col0; f32x4 x0, x1, y[2];
                unpack8(*(const u32x4*)xp, x0, x1);
#pragma unroll
                for (int n = 0; n < 2; ++n) { const f32x4 z1 = acc[ai][0][m][n] * c1[n], z2 = acc[ai][1][m][n] * c2[n]; y[n] = (f32x4){z1[0] * sigm(z2[0]), z1[1] * sigm(z2[1]), z1[2] * sigm(z2[2]), z1[3] * sigm(z2[3])}; }
                *(u32x4*)xp = pack8(x0 + gv[0] * y[0], x1 + gv[1] * y[1]); }
    }
};
struct EpiUC {
    typedef f32x4 acc_t; static constexpr bool PERM = true, AFTER_DRAIN = false;
    bf16_t* UC; const PG8_LAS float* rt; const float* shw;
    __device__ __forceinline__ void operator()(const f32x4 (&acc)[2][2][4][2], const Unit& u, int wr, int wc, int fr, int fq) const {
        const int R0 = u.pm * BM, row0 = R0 + wr * 64 + fr, col0 = u.pn * BM + wc * 32 + 8 * fq;
        const float* sp = shw + (size_t)(R0 < ML_ ? (R0 >> 11) : 8) * DM_ + col0;
        f32x4 sv[2][2];
#pragma unroll
        for (int bj = 0; bj < 2; ++bj)
#pragma unroll
            for (int n = 0; n < 2; ++n) sv[bj][n] = *(const f32x4*)(sp + bj * HALF + 4 * n);
#pragma unroll
        for (int ai = 0; ai < 2; ++ai)
#pragma unroll
            for (int m = 0; m < 4; ++m) { const int row = row0 + ai * HALF + m * 16; int bc, j; const float rs = rt[u.idx * BM + (row - R0)];
                if (row < ML_) { bc = (row >> 11) * 64 + ((row & 2047) >> 5); j = row & 31; } else { const int r2 = row - ML_; bc = 512 + (r2 >> 8) * 8 + ((r2 & 255) >> 5); j = r2 & 31; }
#pragma unroll
                for (int bj = 0; bj < 2; ++bj) { const int col = col0 + bj * HALF, g = col >> 4, qi = col & 15;
                    *(u32x4*)(UC + ((size_t)(g * 768 + bc) * 768 + j * 16 + qi)) = pack8(acc[ai][bj][m][0] * rs + sv[bj][0], acc[ai][bj][m][1] * rs + sv[bj][1]); } }
    }
};
struct EpiE {
    typedef f32x4 acc_t; static constexpr bool PERM = false, AFTER_DRAIN = false;
    float* E;
    __device__ __forceinline__ void operator()(const f32x4 (&acc)[2][2][4][2], const Unit& u, int wr, int wc, int fr, int fq) const {
        const int row0 = u.pm * BM + wr * 64 + fr, col0 = wc * 32 + 4 * fq;
#pragma unroll
        for (int ai = 0; ai < 2; ++ai)
#pragma unroll
            for (int m = 0; m < 4; ++m) { float* rp = E + (size_t)(row0 + ai * HALF + m * 16) * 256 + col0;
#pragma unroll
                for (int bj = 0; bj < 2; ++bj)
#pragma unroll
                    for (int n = 0; n < 2; ++n) *(f32x4*)(rp + bj * HALF + n * 16) = acc[ai][bj][m][n]; }
    }
};
struct EpiY {
    typedef f32x4 acc_t; static constexpr bool PERM = true, AFTER_DRAIN = false;
    unsigned char* Y;
    __device__ __forceinline__ void operator()(const f32x4 (&acc)[2][2][4][2], const Unit& u, int wr, int wc, int fr, int fq) const {
        const int g = u.pm / 3, pml = u.pm - 3 * g, pnl = u.pn & 1;
        const int bc0 = pml * BM + wr * 64 + fr, n0 = pnl * BM + wc * 32 + 8 * fq;
#pragma unroll
        for (int ai = 0; ai < 2; ++ai)
#pragma unroll
            for (int m = 0; m < 4; ++m) { const int bc = bc0 + ai * HALF + m * 16, tok0 = (bc >> 6) * 2048 + (bc & 63) * 32;
#pragma unroll
                for (int bj = 0; bj < 2; ++bj) { const int n = n0 + bj * HALF, tin = n >> 4, qo = n & 15; const f32x4 a = acc[ai][bj][m][0], b = acc[ai][bj][m][1];
                    const f32x4 ya = (f32x4){gelu_tanh(a[0]), gelu_tanh(a[1]), gelu_tanh(a[2]), gelu_tanh(a[3])}, yb = (f32x4){gelu_tanh(b[0]), gelu_tanh(b[1]), gelu_tanh(b[2]), gelu_tanh(b[3])};
                    u32x2 o; o.x = f8pack4(ya); o.y = f8pack4(yb); *(u32x2*)(Y + (size_t)(tok0 + tin) * DM_ + g * 16 + qo) = o; } }
    }
};
struct EpiMoE2 {
    typedef f32x4 acc_t; static constexpr bool PERM = true, AFTER_DRAIN = false, FP8 = true;
    bf16_t* Y2; const float* rowgate; const int* rowinfo; const float* colscale;
    __device__ __forceinline__ void operator()(const f32x4 (&acc)[2][2][4][2], const Unit& u, int wr, int wc, int fr, int fq) const {
        const int row0 = u.pm * BM + wr * 64 + fr, col0 = (u.pn & 3) * BM + wc * 32 + 8 * fq; const float* cp = colscale + (size_t)u.pn * BM + wc * 32 + 8 * fq;
        f32x4 cs[2][2];
#pragma unroll
        for (int bj = 0; bj < 2; ++bj)
#pragma unroll
            for (int n = 0; n < 2; ++n) cs[bj][n] = *(const f32x4*)(cp + bj * HALF + 4 * n);
#pragma unroll
        for (int ai = 0; ai < 2; ++ai)
#pragma unroll
            for (int m = 0; m < 4; ++m) { const int row = row0 + ai * HALF + m * 16; const float gt = rowgate[row]; const int ri = rowinfo[row];
                if (ri >= 0) {
#pragma unroll
                    for (int bj = 0; bj < 2; ++bj) *(u32x4*)(Y2 + (size_t)ri * DM_ + col0 + bj * HALF) = pack8(acc[ai][bj][m][0] * (cs[bj][0] * gt), acc[ai][bj][m][1] * (cs[bj][1] * gt)); } }
    }
};
struct OrderS5E { static constexpr bool VARK = false; int G, c;
    __device__ __forceinline__ bool next(int i, Unit& u) const {
        if (G == 256) { if (i > 0) return false; const int x = c & 7, j = c >> 3; if (j >= 24) return false; const int g = 8 * (j / 3) + x; u.pm = 3 * g + (j % 3); u.pn = g; u.k0 = 0; u.idx = i; return true; }
        const int L = i * G + c; if (L >= 192) return false; u.pm = L; u.pn = L / 3; u.k0 = 0; u.idx = i; return true; }
    __device__ __forceinline__ void a_ready(const Unit&) const {}
    __device__ __forceinline__ void done(const Unit&) const {} };
struct OrderS5Y { static constexpr bool VARK = false; int G, c;
    __device__ __forceinline__ bool next(int i, Unit& u) const {
        if (G == 256) { if (i > 0) return false; const int x = c & 7, j = c >> 3, g = 8 * (j >> 2) + x; u.pm = 3 * g + ((j >> 1) & 1); u.pn = 2 * g + (j & 1); u.k0 = 0; u.idx = i; return true; }
        const int L = i * G + c; if (L >= 256) return false; const int g = L >> 2; u.pm = 3 * g + ((L >> 1) & 1); u.pn = 2 * g + (L & 1); u.k0 = 0; u.idx = i; return true; }
    __device__ __forceinline__ void a_ready(const Unit&) const {}
    __device__ __forceinline__ void done(const Unit&) const {} };
struct OrderMoE { static constexpr bool VARK = false; int G, c, nN, tmax, fix; int toff[9];
    __device__ __forceinline__ bool next(int i, Unit& u) const {
        int pm, pnl; const int nt = toff[8] < tmax ? toff[8] : tmax;
        if (G == 256) {
            const int x = c & 7, j = c >> 3, nCB = nN >> 2, b = i * 8 + x, nRB = (nt + 7) >> 3; if (b >= nRB * nCB) return false;
            const int rb = b / nCB, cbk = b - rb * nCB; pm = 8 * rb + (j & 7); pnl = 4 * cbk + (j >> 3);
        } else { const int L = i * G + c; pm = L / nN; pnl = L - pm * nN; }
        if (pm >= nt) return false;
        int e = 0;
#pragma unroll
        for (int k = 1; k < 8; ++k) e += (pm >= toff[k]) ? 1 : 0;
        u.pm = fix ? 0 : pm; u.pn = fix ? pnl & 3 : e * nN + pnl; u.k0 = 0; u.idx = i; return true; }
    __device__ __forceinline__ void a_ready(const Unit&) const {}
    __device__ __forceinline__ void done(const Unit&) const {} };
struct OrderMoEx { static constexpr bool VARK = true; int G, c; int toff[9];
    __device__ __forceinline__ bool next(int i, Unit& u) const {
        const int s = i * G + c, tl = s >> 4, pm = 128 + tl; if (pm >= toff[8]) return false;
        int e = 0;
#pragma unroll
        for (int k = 1; k < 8; ++k) e += (pm >= toff[k]) ? 1 : 0;
        const int ks = s & 3; u.pm = pm; u.pn = e * 4 + ((s >> 2) & 3); u.k0 = (ks * 8 - (ks == 3 ? 2 : 0)) * BK; u.idx = ks; return true; }
    __device__ __forceinline__ int ktiles(const Unit& u) const { return u.idx < 2 ? 8 : 6; }
    __device__ __forceinline__ void a_ready(const Unit&) const {}
    __device__ __forceinline__ void done(const Unit&) const {} };
struct EpiMoE2x {
    typedef f32x4 acc_t; static constexpr bool PERM = false, AFTER_DRAIN = false, FP8 = true;
    float* P; const float* rowgate; const float* colscale;
    __device__ __forceinline__ void operator()(const f32x4 (&acc)[2][2][4][2], const Unit& u, int wr, int wc, int fr, int fq) const {
        const int ks = u.idx, tl = u.pm - 128, r0 = wr * 64 + fr, col0 = (u.pn & 3) * BM + wc * 32 + 4 * fq;
        const __amdgpu_buffer_rsrc_t crs = __builtin_amdgcn_make_buffer_rsrc((void*)colscale, 0, 8 * 1024 * 4, 0x00020000);
        f32x4 cs[2][2];
#pragma unroll
        for (int bj = 0; bj < 2; ++bj)
#pragma unroll
            for (int n = 0; n < 2; ++n) cs[bj][n] = __builtin_bit_cast(f32x4, __builtin_amdgcn_raw_buffer_load_b128(crs, (u.pn * BM + wc * 32 + 4 * fq + bj * HALF + n * 16) * 4, 0, 0));
        float* pb = P + ((size_t)(ks * 8 + tl) * 256) * DM_;
        const __amdgpu_buffer_rsrc_t grs = __builtin_amdgcn_make_buffer_rsrc((void*)rowgate, 0, 136 * 256 * 4, 0x00020000);
#pragma unroll
        for (int ai = 0; ai < 2; ++ai)
#pragma unroll
            for (int m = 0; m < 4; ++m) { const int r = r0 + ai * HALF + m * 16; const float gt = __builtin_bit_cast(float, __builtin_amdgcn_raw_buffer_load_b32(grs, (u.pm * BM + r) * 4, 0, 0));
#pragma unroll
                for (int bj = 0; bj < 2; ++bj)
#pragma unroll
                    for (int n = 0; n < 2; ++n) *(f32x4*)(pb + (size_t)r * DM_ + col0 + bj * HALF + n * 16) = acc[ai][bj][m][n] * (cs[bj][n] * gt); }
    }
};
template <class Epi, class Sched, bool ALIGN_EPI = false, bool SP2 = false, bool GATHER = false>
__device__ __forceinline__ void gemm_phase(PG8_LAS unsigned char* lds, const Gemm g, const Sched& S, const Epi& E) {
    const int tid = threadIdx.x, wid = __builtin_amdgcn_readfirstlane(tid >> 6), lane = tid & 63, wr = wid >> 2, wc = wid & 3, fr = lane & 15, fq = lane >> 4;
    const int K = g.K; int nt = K / BK;
    unsigned voffA[2], voffB[2]; int RA[2]; unsigned CA[2];
    static_assert(!GATHER || SP2, "the gathered A operand is wired into the SP2 loop only");
#pragma unroll
    for (int i = 0; i < 2; ++i) { int R, C; stage_rc(tid * 16 + i * 8192, R, C); const int Rb = Epi::PERM ? ((R & ~31) + perm32(R & 31)) : R;
        voffA[i] = (unsigned)(R * g.lda + C) * 2u; voffB[i] = (unsigned)(Rb * g.ldb + C) * 2u; RA[i] = R; CA[i] = (unsigned)C * 2u; }
    const size_t kstep = (size_t)(BK * 2);
    const size_t hstepA = (size_t)HALF * g.lda * 2, hstepB = (size_t)HALF * g.ldb * 2;
    const size_t tstepA = 2 * hstepA, tstepB = 2 * hstepB;
    const unsigned ldsw = (unsigned)wid * 1024u;
    const int aoff = lds_byte(wr * 64 + fr, fq * 8), boff = lds_byte(wc * 32 + fr, fq * 8);
#define PG8_SA(b, h) (((b) * 2 + (h)) * HTB)
#define PG8_SB(b, h) ((4 + (b) * 2 + (h)) * HTB)
#define PG8_STAGE(bufoff, gbase, voff) do { _Pragma("unroll") for (int _i = 0; _i < 2; ++_i) \
        __builtin_amdgcn_global_load_lds((const unsigned*)((const char*)(gbase) + (voff)[_i]), (PG8_LAS unsigned*)(lds + (bufoff) + ldsw + _i * 8192), 16, 0, 0); } while (0)
#define PG8_LDA(dst, b, h) do { _Pragma("unroll") for (int m = 0; m < 4; ++m) _Pragma("unroll") for (int k = 0; k < 2; ++k) dst[m].set(k, *(const PG8_LAS bf16x8*)(lds + PG8_SA(b, h) + aoff + m * 2048 + k * 1024)); } while (0)
#define PG8_LDB(dst, b, h) do { _Pragma("unroll") for (int n = 0; n < 2; ++n) _Pragma("unroll") for (int k = 0; k < 2; ++k) dst[n].set(k, *(const PG8_LAS bf16x8*)(lds + PG8_SB(b, h) + boff + n * 2048 + k * 1024)); } while (0)
#define PG8_MMA(ai, bj, At, Bt) do { __builtin_amdgcn_s_setprio(1); _Pragma("unroll") for (int m = 0; m < 4; ++m) _Pragma("unroll") for (int n = 0; n < 2; ++n) \
        acc[ai][bj][m][n] = mma_frag(Bt[n], At[m], acc[ai][bj][m][n]); __builtin_amdgcn_s_setprio(0); } while (0)
#define PG8_WAIT_V(n) asm volatile("s_waitcnt vmcnt(" #n ")" ::: "memory")
#define PG8_WAIT_L(n) asm volatile("s_waitcnt lgkmcnt(" #n ")" ::: "memory")
#define PG8_BAR __builtin_amdgcn_s_barrier()
#define PG8_SCHED __builtin_amdgcn_sched_barrier(0)
#define PG8_GIDX(d0, d1, un) do { _Pragma("unroll") for (int _i = 0; _i < 2; ++_i) { const int* _rp = g.rowsrc + (un).pm * BM + RA[_i]; d0[_i] = (unsigned)_rp[0] * (unsigned)(g.lda * 2) + CA[_i]; d1[_i] = (unsigned)_rp[HALF] * (unsigned)(g.lda * 2) + CA[_i]; } } while (0)
    Unit cur, nxt; int ui = 0;
    if (!S.next(0, cur)) return;
    if constexpr (Sched::VARK) nt = S.ktiles(cur);
    typedef typename Epi::acc_t acc_t;
    acc_t acc[2][2][4][2];
#pragma unroll
    for (int a = 0; a < 2; ++a)
#pragma unroll
        for (int b = 0; b < 2; ++b)
#pragma unroll
            for (int m = 0; m < 4; ++m)
#pragma unroll
                for (int n = 0; n < 2; ++n) acc[a][b][m][n] = (acc_t){0, 0, 0, 0};
    Frag<is_fp8<Epi>::v> At[4], B0[2], B1[2];
    const char* cA = (const char*)g.A + (size_t)cur.pm * tstepA + (size_t)cur.k0 * 2; const char* cB = (const char*)g.Bt + (size_t)cur.pn * tstepB + (size_t)cur.k0 * 2;
    S.a_ready(cur);
    unsigned cv0[2] = {0u, 0u}, cv1[2] = {0u, 0u}, nv0[2] = {0u, 0u}, nv1[2] = {0u, 0u}; const char* gA = (const char*)g.A;
    if constexpr (GATHER) { PG8_GIDX(cv0, cv1, cur); nv0[0] = cv0[0]; nv0[1] = cv0[1]; nv1[0] = cv1[0]; nv1[1] = cv1[1]; }
    if constexpr (SP2) {
        PG8_STAGE(PG8_SB(0, 0), cB, voffB); PG8_STAGE(PG8_SB(0, 1), cB + hstepB, voffB);
        if constexpr (GATHER) { PG8_STAGE(PG8_SA(0, 0), gA, cv0); PG8_STAGE(PG8_SA(0, 1), gA, cv1); } else { PG8_STAGE(PG8_SA(0, 0), cA, voffA); PG8_STAGE(PG8_SA(0, 1), cA + hstepA, voffA); }
        if (wr == 1) PG8_BAR;
        PG8_WAIT_V(2); PG8_BAR;
        PG8_STAGE(PG8_SB(1, 0), cB + kstep, voffB); if constexpr (GATHER) PG8_STAGE(PG8_SA(1, 0), gA + kstep, cv0); else PG8_STAGE(PG8_SA(1, 0), cA + kstep, voffA); PG8_STAGE(PG8_SB(1, 1), cB + hstepB + kstep, voffB);
        PG8_WAIT_V(6); PG8_BAR;
    } else {
        PG8_STAGE(PG8_SB(0, 0), cB, voffB); PG8_STAGE(PG8_SA(0, 0), cA, voffA); PG8_STAGE(PG8_SB(0, 1), cB + hstepB, voffB); PG8_STAGE(PG8_SA(0, 1), cA + hstepA, voffA);
        if (wr == 1) PG8_BAR;
        PG8_WAIT_V(4); PG8_BAR;
        PG8_STAGE(PG8_SB(1, 0), cB + kstep, voffB); PG8_STAGE(PG8_SA(1, 0), cA + kstep, voffA); PG8_STAGE(PG8_SB(1, 1), cB + hstepB + kstep, voffB);
        PG8_WAIT_V(6); PG8_BAR;
    }
    for (;;) {
        const bool has_next = S.next(ui + 1, nxt);
        const char* nA = has_next ? (const char*)g.A + (size_t)nxt.pm * tstepA + (size_t)nxt.k0 * 2 : cA; const char* nB = has_next ? (const char*)g.Bt + (size_t)nxt.pn * tstepB + (size_t)nxt.k0 * 2 : cB;
        for (int t = 0; t < nt; t += 2) {
            const bool last = (t == nt - 2);
            const char* a1 = cA + (size_t)(t + 1) * kstep;
            const char* a2 = last ? nA : cA + (size_t)(t + 2) * kstep; const char* b2 = last ? nB : cB + (size_t)(t + 2) * kstep;
            const char* a3 = a2 + kstep; const char* b3 = b2 + kstep;
            if (last && has_next) S.a_ready(nxt);
            if constexpr (GATHER) { if (t == nt - 4 && has_next) PG8_GIDX(nv0, nv1, nxt); }
            const char* g1 = gA + (size_t)(t + 1) * kstep; const char* g2 = last ? gA : gA + (size_t)(t + 2) * kstep; const char* g3 = g2 + kstep;
            unsigned x0[2], x1[2]; x0[0] = last ? nv0[0] : cv0[0]; x0[1] = last ? nv0[1] : cv0[1]; x1[0] = last ? nv1[0] : cv1[0]; x1[1] = last ? nv1[1] : cv1[1];
            if constexpr (SP2) {
            PG8_LDB(B0, 0, 0); PG8_LDB(B1, 0, 1); PG8_SCHED; PG8_LDA(At, 0, 0); if constexpr (GATHER) PG8_STAGE(PG8_SA(1, 1), g1, cv1); else PG8_STAGE(PG8_SA(1, 1), a1 + hstepA, voffA);
            PG8_WAIT_V(8); PG8_WAIT_L(0); PG8_BAR; PG8_MMA(0, 0, At, B0); PG8_MMA(0, 1, At, B1); PG8_BAR; PG8_SCHED;
            PG8_LDA(At, 0, 1); PG8_STAGE(PG8_SB(0, 0), b2, voffB); PG8_STAGE(PG8_SB(0, 1), b2 + hstepB, voffB); if constexpr (GATHER) PG8_STAGE(PG8_SA(0, 0), g2, x0); else PG8_STAGE(PG8_SA(0, 0), a2, voffA);
            PG8_WAIT_V(8); PG8_WAIT_L(0); PG8_BAR; PG8_MMA(1, 0, At, B0); PG8_MMA(1, 1, At, B1); PG8_BAR; PG8_SCHED;
            PG8_LDB(B0, 1, 0); PG8_LDB(B1, 1, 1); PG8_SCHED; PG8_LDA(At, 1, 0); if constexpr (GATHER) PG8_STAGE(PG8_SA(0, 1), g2, x1); else PG8_STAGE(PG8_SA(0, 1), a2 + hstepA, voffA);
            PG8_WAIT_V(8); PG8_WAIT_L(0); PG8_BAR; PG8_MMA(0, 0, At, B0); PG8_MMA(0, 1, At, B1); PG8_BAR; PG8_SCHED;
            PG8_LDA(At, 1, 1); PG8_STAGE(PG8_SB(1, 0), b3, voffB); PG8_STAGE(PG8_SB(1, 1), b3 + hstepB, voffB); if constexpr (GATHER) PG8_STAGE(PG8_SA(1, 0), g3, x0); else PG8_STAGE(PG8_SA(1, 0), a3, voffA);
            PG8_WAIT_V(8); PG8_WAIT_L(0); PG8_BAR; PG8_MMA(1, 0, At, B0); PG8_MMA(1, 1, At, B1); PG8_BAR; PG8_SCHED;
            } else {
            PG8_LDB(B0, 0, 0); PG8_SCHED; PG8_LDA(At, 0, 0); PG8_STAGE(PG8_SA(1, 1), a1 + hstepA, voffA);
            PG8_WAIT_L(8); PG8_BAR; PG8_WAIT_L(0); PG8_MMA(0, 0, At, B0); PG8_BAR; PG8_SCHED;
            PG8_LDB(B1, 0, 1); PG8_STAGE(PG8_SB(0, 0), b2, voffB);
            PG8_BAR; PG8_WAIT_L(0); PG8_MMA(0, 1, At, B1); PG8_BAR;
            PG8_LDA(At, 0, 1); PG8_STAGE(PG8_SA(0, 0), a2, voffA);
            PG8_BAR; PG8_WAIT_L(0); PG8_MMA(1, 0, At, B0); PG8_BAR; PG8_SCHED;
            PG8_STAGE(PG8_SB(0, 1), b2 + hstepB, voffB);
            PG8_WAIT_V(6); PG8_BAR; PG8_MMA(1, 1, At, B1); PG8_BAR;
            PG8_LDB(B0, 1, 0); PG8_SCHED; PG8_LDA(At, 1, 0); PG8_STAGE(PG8_SA(0, 1), a2 + hstepA, voffA);
            PG8_WAIT_L(8); PG8_BAR; PG8_WAIT_L(0); PG8_MMA(0, 0, At, B0); PG8_BAR; PG8_SCHED;
            PG8_LDB(B1, 1, 1); PG8_STAGE(PG8_SB(1, 0), b3, voffB);
            PG8_BAR; PG8_WAIT_L(0); PG8_MMA(0, 1, At, B1); PG8_BAR;
            PG8_LDA(At, 1, 1); PG8_STAGE(PG8_SA(1, 0), a3, voffA);
            PG8_BAR; PG8_WAIT_L(0); PG8_MMA(1, 0, At, B0); PG8_BAR; PG8_SCHED;
            PG8_STAGE(PG8_SB(1, 1), b3 + hstepB, voffB);
            PG8_WAIT_V(6); PG8_BAR; PG8_MMA(1, 1, At, B1); PG8_BAR;
            }
        }
        if constexpr (ALIGN_EPI) { if (wr == 0) PG8_BAR; }
        mma_drain<is_fp8<Epi>::v>();
        if constexpr (!Epi::AFTER_DRAIN) { E(acc, cur, wr, wc, fr, fq); S.done(cur); }
        if (!has_next) break;
#pragma unroll
        for (int a = 0; a < 2; ++a)
#pragma unroll
            for (int b = 0; b < 2; ++b)
#pragma unroll
                for (int m = 0; m < 4; ++m)
#pragma unroll
                    for (int n = 0; n < 2; ++n) acc[a][b][m][n] = (acc_t){0, 0, 0, 0};
        cur = nxt; cA = nA; cB = nB; ++ui; if constexpr (Sched::VARK) nt = S.ktiles(cur);
        if constexpr (GATHER) { cv0[0] = nv0[0]; cv0[1] = nv0[1]; cv1[0] = nv1[0]; cv1[1] = nv1[1]; }
        if constexpr (ALIGN_EPI) { if (wr == 1) PG8_BAR; }
    }
    PG8_WAIT_V(0);
    if constexpr (!ALIGN_EPI) { if (wr == 0) PG8_BAR; }
    PG8_BAR;
    if constexpr (Epi::AFTER_DRAIN) { E.fused(acc, cur, wr, wc, fr, fq, lds, wid, lane); S.done(cur); }
#undef PG8_SA
#undef PG8_SB
#undef PG8_STAGE
#undef PG8_LDA
#undef PG8_LDB
#undef PG8_MMA
#undef PG8_WAIT_V
#undef PG8_WAIT_L
#undef PG8_BAR
#undef PG8_SCHED
#undef PG8_GIDX
}
}

constexpr int NB = 8, SEQ = 2048, NCTX = 256, D = 1024;
constexpr int ML = NB * SEQ, MC = NB * NCTX, MT = ML + MC;
constexpr int MIXIN = 2560, FFN = 2816, NE = 8, ED = 3584;
constexpr float EPS = 1e-6f;
constexpr int NWAVES = 8;
constexpr int MOE_TILES = 136;

constexpr size_t MiB = 1u << 20;
constexpr size_t WS_CTL = 0, CTL_ZERO_BYTES = 65536;
constexpr size_t WS_MOD = 65536, WS_MODP = 1 * MiB; constexpr int MOD_N = 2 * 9 * 6144;
constexpr size_t WS_ROWSS = 3 * MiB, WS_SHW13 = 4608 * 1024, WS_SHWS = WS_SHW13 + 9 * 5632 * 4;
constexpr size_t WS_ROWSC = 2800 * 1024, WS_POSSC = 2864 * 1024, WS_COLMAX = 4864 * 1024, WS_COLSC = WS_COLMAX;
constexpr size_t WS_COLSCD = WS_COLMAX + (size_t)NE * 2 * ED * 4, WS_PMAX = 376 * MiB, WS_ROWFAC1 = WS_POSSC;
constexpr size_t WS_COLSC2 = 4352 * 1024;
constexpr size_t WS_COLSCS = WS_COLSC2 + 32768;
constexpr size_t WS_TOK = 5 * MiB;
constexpr size_t TOK_E = 0, TOK_W = 128 * 1024, TOK_RANK = 256 * 1024, TOK_POS = 384 * 1024, TOK_WGBASE = 512 * 1024, TOK_ROWGATE = 576 * 1024, TOK_ROWSRC = 720 * 1024, TOK_ROWINFO = 864 * 1024;
constexpr size_t WS_MW13 = 6 * MiB, WS_MW2 = 118 * MiB;
constexpr size_t WS_XL = 174 * MiB, WS_H = 238 * MiB, WS_XC = 274 * MiB;
constexpr size_t WS_WIN = 282 * MiB, WS_WOUT = 287 * MiB, WS_W13 = 289 * MiB, WS_W2 = 300 * MiB, WS_SIN = 306 * MiB, WS_SOUT = 308 * MiB;
constexpr size_t WS_BTOUT = 312 * MiB, WS_WEND = 360 * MiB, WS_R = 376 * MiB, WS_END = 512 * MiB;
constexpr size_t WS_QKVU = WS_R, WS_MIX = WS_R + 72 * MiB, WS_ACT = WS_R;
constexpr size_t WS_UC = WS_R, WS_E = WS_R + 72 * MiB, WS_Y = WS_R + 72 * MiB;
constexpr size_t WS_PX = WS_H;
constexpr size_t WS_ACTM = 274 * MiB;
static_assert(WS_ACTM + (size_t)MOE_TILES * 256 * ED * 2 <= WS_END && WS_XC + (size_t)MC * D * 4 <= WS_WIN && WS_H + (size_t)MT * D * 2 <= WS_XC && WS_MW2 + (size_t)NE * D * ED * 2 <= WS_XL, "d_ws map");
constexpr int CW_TMO = 0, CW_CODE = 1, CW_BAR = 4096, CW_GCNT = 8192;

constexpr int RING_OFF = 0, RING_BYTES = 131072;
constexpr int LDSCTL_OFF = 155648, MISC_OFF = LDSCTL_OFF + 320;
constexpr int LDS_BYTES = 159744;
static_assert(MISC_OFF + 128 <= LDS_BYTES, "LDS map");

#define GAS __attribute__((address_space(1)))
#define LAS __attribute__((address_space(3)))
typedef unsigned short bf16;
typedef unsigned v4u __attribute__((ext_vector_type(4)));
typedef unsigned v2u __attribute__((ext_vector_type(2)));
typedef float f32x4 __attribute__((ext_vector_type(4)));
typedef float f32x2 __attribute__((ext_vector_type(2)));
typedef float f32x16 __attribute__((ext_vector_type(16)));
typedef short bf16x8 __attribute__((ext_vector_type(8)));
typedef GAS unsigned gu32;
#define RLX_AGENT __ATOMIC_RELAXED, __HIP_MEMORY_SCOPE_AGENT
#define LDS_WAIT() asm volatile("s_waitcnt lgkmcnt(0)" ::: "memory")
#define VM_WAIT() asm volatile("s_waitcnt vmcnt(0)" ::: "memory")
__device__ __forceinline__ unsigned f2bf(float f) { unsigned u = __builtin_bit_cast(unsigned, f); return (u + 0x7fffu + ((u >> 16) & 1u)) >> 16; }
__device__ __forceinline__ unsigned pk2(float lo, float hi) { return f2bf(lo) | (f2bf(hi) << 16); }
__device__ __forceinline__ float bf2f(unsigned short h) { return __builtin_bit_cast(float, (unsigned)h << 16); }
__device__ __forceinline__ float bflo(unsigned w) { return __builtin_bit_cast(float, w << 16); }
__device__ __forceinline__ float bfhi(unsigned w) { return __builtin_bit_cast(float, w & 0xffff0000u); }
__device__ __forceinline__ float sigm(float x) { return __builtin_amdgcn_rcpf(1.0f + __expf(-x)); }
__device__ __forceinline__ float wave_sum(float v) {
#pragma unroll
    for (int o = 1; o < 64; o <<= 1) v += __shfl_xor(v, o);
    return v;
}
__device__ __forceinline__ float wave_max(float v) {
#pragma unroll
    for (int o = 1; o < 64; o <<= 1) v = fmaxf(v, __shfl_xor(v, o));
    return v;
}
#define XB_TMO      128
#define XB_XCNT(j)  (256  + 64 * (j))
#define XB_XSUB(j)  (1280 + 64 * (j))
#define XB_XGEN(j)  (2304 + 64 * (j))
#define XB_TOP      3328
#define XB_TOPGEN   3392
#define XCD_BAR_WORDS 3456
#define XB_SPIN_CAP (1u << 18)

__device__ __forceinline__ unsigned xb_ld(unsigned* p)              { return __hip_atomic_load(p, __ATOMIC_RELAXED, __HIP_MEMORY_SCOPE_AGENT); }
__device__ __forceinline__ unsigned xb_add(unsigned* p, unsigned v) { return __hip_atomic_fetch_add(p, v, __ATOMIC_RELAXED, __HIP_MEMORY_SCOPE_AGENT); }
__device__ __forceinline__ unsigned xb_xcc_id() { return (unsigned)__builtin_amdgcn_s_getreg((3 << 11) | 20) & 0xFu; }
#define XB_SPIN(cond, bar) do { unsigned _sp = 0; while (cond) { __builtin_amdgcn_s_sleep(1); \
    if ((++_sp & 255u) == 0u) { if (xb_ld(&(bar)[XB_TMO])) break; if (_sp > XB_SPIN_CAP) { atomicAdd(&(bar)[XB_TMO], 1u); break; } } } } while (0)

struct XcdBarrier {
    unsigned* bar; unsigned x;
    volatile LAS unsigned* st;
};

__device__ __forceinline__ XcdBarrier xcd_barrier_post(unsigned* bar, volatile LAS unsigned* st) {
    XcdBarrier b; b.bar = bar; b.x = xb_xcc_id(); b.st = st;
    if (threadIdx.x == 0) (void)xb_add(&bar[XB_XCNT(b.x)], 1u);
    return b;
}
__device__ __forceinline__ void xcd_barrier_complete(unsigned* bar, unsigned x, unsigned& nloc, unsigned& nx) {
    const unsigned G = gridDim.x * gridDim.y * gridDim.z;
    unsigned sum, cnt, mine, sp = 0u;
    for (;;) {
        sum = 0u; cnt = 0u; mine = 0u;
#pragma unroll
        for (unsigned j = 0; j < 16; ++j) { const unsigned c = xb_ld(&bar[XB_XCNT(j)]); sum += c; cnt += (c > 0u) ? 1u : 0u; mine = (j == x) ? c : mine; }
        if (sum == G) break;
        __builtin_amdgcn_s_sleep(1);
        if ((++sp & 255u) == 0u) { if (xb_ld(&bar[XB_TMO])) break; if (sp > XB_SPIN_CAP) { atomicAdd(&bar[XB_TMO], 1u); break; } }
    }
    nloc = mine > 0u ? mine : 1u; nx = cnt > 0u ? cnt : 1u;
}

__device__ __forceinline__ void xcd_barrier(const XcdBarrier& b) {
    asm volatile("s_waitcnt vmcnt(0)" ::: "memory");
    __syncthreads();
    if (threadIdx.x == 0) {
        unsigned* bar = b.bar;
        __builtin_amdgcn_s_waitcnt(0);
        unsigned nloc = b.st[0], nx = b.st[1];
        if (nloc == 0u) { xcd_barrier_complete(bar, b.x, nloc, nx); b.st[0] = nloc; b.st[1] = nx; }
        const unsigned old = xb_add(&bar[XB_XSUB(b.x)], 1u);
        const unsigned gen = old / nloc;
        if (old + 1u == (gen + 1u) * nloc) {
            __builtin_amdgcn_fence(__ATOMIC_RELEASE, "agent");
            asm volatile("s_waitcnt vmcnt(0)" ::: "memory");
            const unsigned og = xb_add(&bar[XB_TOP], 1u);
            const unsigned tg = og / nx;
            if (og + 1u == (tg + 1u) * nx) xb_add(&bar[XB_TOPGEN], 1u);
            else XB_SPIN(xb_ld(&bar[XB_TOPGEN]) == tg, bar);
            __builtin_amdgcn_fence(__ATOMIC_ACQUIRE, "agent");
            xb_add(&bar[XB_XGEN(b.x)], 1u);
            asm volatile("s_waitcnt vmcnt(0)" ::: "memory");
        } else {
            XB_SPIN(xb_ld(&bar[XB_XGEN(b.x)]) == gen, bar);
            __builtin_amdgcn_fence(__ATOMIC_ACQUIRE, "agent");
            asm volatile("s_waitcnt vmcnt(0)" ::: "memory");
        }
    }
    __syncthreads();
}
enum { I_X = 0, I_C, I_CTX, I_CCTX, I_ADAW, I_ADAB, I_N1G, I_N2G, I_MIXWIN, I_QG, I_KG, I_RPB, I_DWW, I_DWB, I_LNG, I_LNB, I_MIXWOUT, I_FW1, I_FW3, I_FW2,
       I_SWIN, I_ARE, I_AIM, I_LOGDT, I_BRE, I_BIM, I_CRE, I_CIM, I_SD, I_SWOUT, I_ROUTER, I_MW1, I_MW3, I_MW2, N_IN };
struct Args { const float* in[N_IN]; float* out; unsigned char* ws; int ph_lo, ph_hi, sub, pad; };

typedef short s16x4 __attribute__((ext_vector_type(4)));
typedef float f32x2_t __attribute__((ext_vector_type(2)));
typedef __bf16 bf16x2_t __attribute__((ext_vector_type(2)));
__device__ __forceinline__ unsigned cvtpk(float lo, float hi) { const f32x2_t v = {lo, hi}; const bf16x2_t b = __builtin_convertvector(v, bf16x2_t); return __builtin_bit_cast(unsigned, b); }
__device__ __forceinline__ s16x4 vtr(const LAS unsigned char* p) { return __builtin_bit_cast(s16x4, __builtin_amdgcn_ds_read_tr16_b64_v4i16((LAS s16x4*)p)); }
__device__ __forceinline__ void p0_adaln(const Args& A, int unit, LAS unsigned char* lds, int tid, int wave, int lane) {
    const int l = unit / 96, rem = unit % 96, cb = rem >> 2, kq = rem & 3;
    LAS float* sc = (LAS float*)lds;
    LAS float* part = sc + 9 * 256;
    const float* c = A.in[I_C]; const float* cc = A.in[I_CCTX];
    for (int i = tid; i < 9 * 256; i += NWAVES * 64) { const int r = i >> 8, k = 256 * kq + (i & 255); const float v = r < 8 ? c[r * 1024 + k] : cc[k]; sc[i] = v * sigm(v); }
    __syncthreads();
    const float* wp = A.in[I_ADAW] + (size_t)l * 1024 * 6144 + (size_t)(256 * kq + 32 * wave) * 6144 + 256 * cb + 4 * lane;
    float acc[9][4];
#pragma unroll
    for (int r = 0; r < 9; ++r)
#pragma unroll
        for (int j = 0; j < 4; ++j) acc[r][j] = 0.f;
#pragma unroll 8
    for (int it = 0; it < 32; ++it) {
        const f32x4 wv = *(const f32x4*)(wp + (size_t)it * 6144); const int k = 32 * wave + it;
#pragma unroll
        for (int r = 0; r < 9; ++r) { const float s = sc[r * 256 + k];
#pragma unroll
            for (int j = 0; j < 4; ++j) acc[r][j] += s * wv[j]; }
    }
#pragma unroll
    for (int r = 0; r < 9; ++r) *(LAS f32x4*)(part + (wave * 9 + r) * 256 + 4 * lane) = (f32x4){acc[r][0], acc[r][1], acc[r][2], acc[r][3]};
    __syncthreads();
    float* modp = (float*)(A.ws + WS_MODP) + (size_t)kq * MOD_N;
    for (int i = tid; i < 9 * 256; i += NWAVES * 64) { const int r = i >> 8, col = i & 255; float s = 0.f;
#pragma unroll
        for (int w = 0; w < 8; ++w) s += part[(w * 9 + r) * 256 + col];
        if (kq == 0) s += A.in[I_ADAB][l * 6144 + 256 * cb + col];
        modp[((size_t)l * 9 + r) * 6144 + 256 * cb + col] = s; }
    __syncthreads();
}
constexpr int KTS = 260;
__device__ __forceinline__ void p0_s5gen(const Args& A, int g, int part, LAS unsigned char* lds, int tid) {
    LAS f32x2* POW = (LAS f32x2*)lds;
    LAS float* BBr = (LAS float*)(POW + 2 * 64 * 33 + 8);
    LAS float* BBi = BBr + 2 * 64 * 16;
    LAS f32x2* CC = (LAS f32x2*)(BBi + 2 * 64 * 16);
    LAS f32x2* CT = CC + 2 * 16 * 66 + 8;
    LAS float* KT = (LAS float*)(CT + 2 * 64 * 16);
    LAS f32x2* FF = (LAS f32x2*)(KT + 63 * KTS);
#define PWI(d_, p_, m_) (((d_) * 64 + (p_)) * 33 + (m_) + ((p_) >> 5) + (d_) * 4)
#define CCI(d_, q_, p_) (((d_) * 16 + (q_)) * 66 + (p_) + ((p_) >> 5) + (d_) * 4)
    if (tid < 128) { const int d = tid >> 6, p = tid & 63, ix = (d * 64 + g) * 64 + p;
        const float ar = A.in[I_ARE][ix], ai = A.in[I_AIM][ix], dt = __expf(A.in[I_LOGDT][d * 64 + g]);
        const float zr = ar * dt, zi = ai * dt, mag = __expf(zr); const float lr = mag * cosf(zi), li = mag * sinf(zi);
        float pr = 1.f, pi = 0.f;
        for (int m = 0; m <= 32; ++m) { POW[PWI(d, p, m)] = (f32x2){pr, pi}; const float nr = pr * lr - pi * li, ni = pr * li + pi * lr; pr = nr; pi = ni; }
        const float nr = lr - 1.f, ni = li, den = 1.f / (ar * ar + ai * ai);
        FF[d * 64 + p] = (f32x2){(nr * ar + ni * ai) * den, (ni * ar - nr * ai) * den}; }
    __syncthreads();
    for (int i = tid; i < 2048; i += NWAVES * 64) { const int d = i >> 10, p = (i >> 4) & 63, q = i & 15; const int ix = ((d * 64 + g) * 64 + p) * 16 + q;
        const float br = A.in[I_BRE][ix], bi = A.in[I_BIM][ix]; const f32x2 f = FF[d * 64 + p];
        BBr[(d * 64 + p) * 16 + q] = f.x * br - f.y * bi; BBi[(d * 64 + p) * 16 + q] = f.x * bi + f.y * br; }
    for (int i = tid; i < 2048; i += NWAVES * 64) { const int d = i >> 10, q = (i >> 6) & 15, p = i & 63; const int ix = ((d * 64 + g) * 16 + q) * 64 + p;
        const f32x2 cv2 = (f32x2){A.in[I_CRE][ix], A.in[I_CIM][ix]}; CC[CCI(d, q, p)] = cv2; CT[(d * 64 + p) * 16 + q] = cv2; }
    __syncthreads();
    bf16* BtOut = (bf16*)(A.ws + WS_BTOUT) + (size_t)g * 512 * 768;
    bf16* WEnd = (bf16*)(A.ws + WS_WEND) + (size_t)g * 256 * 512;
    if (part == 0) {
#pragma unroll 1
    for (int d = 0; d < 2; ++d) {
        const int dl = tid >> 4, qo = tid & 15; float acc[16];
#pragma unroll
        for (int i = 0; i < 16; ++i) acc[i] = 0.f;
#pragma unroll 2
        for (int p = 0; p < 64; ++p) { const f32x2 c = CT[(d * 64 + p) * 16 + qo], w = POW[PWI(d, p, dl)]; const float tr = c.x * w.x - c.y * w.y, ti = c.x * w.y + c.y * w.x;
            const LAS f32x4* br = (const LAS f32x4*)(BBr + (d * 64 + p) * 16); const LAS f32x4* bi = (const LAS f32x4*)(BBi + (d * 64 + p) * 16);
#pragma unroll
            for (int q4 = 0; q4 < 4; ++q4) { const f32x4 r4 = br[q4], i4 = bi[q4];
#pragma unroll
                for (int j = 0; j < 4; ++j) acc[4 * q4 + j] += tr * r4[j] - ti * i4[j]; } }
        if (d == 0) {
            { const float dsk = (dl == 0) ? A.in[I_SD][g * 16 + qo] : 0.f;
#pragma unroll
              for (int i = 0; i < 16; ++i) acc[i] += (i == qo) ? dsk : 0.f; }
#pragma unroll
            for (int i = 0; i < 4; ++i) *(LAS f32x4*)(KT + (31 + dl) * KTS + qo * 16 + 4 * i) = (f32x4){acc[4 * i], acc[4 * i + 1], acc[4 * i + 2], acc[4 * i + 3]};
        } else {
#pragma unroll
            for (int i = 0; i < 4; ++i) { LAS f32x4* kp = (LAS f32x4*)(KT + (31 - dl) * KTS + qo * 16 + 4 * i); f32x4 v = (f32x4){acc[4 * i], acc[4 * i + 1], acc[4 * i + 2], acc[4 * i + 3]}; if (dl == 0) v = v + *kp; *kp = v; }
        }
        __syncthreads();
    }
    for (int pc = tid; pc < 512 * 64; pc += NWAVES * 64) {
        const int n = pc >> 6, kp = pc & 63, t = n >> 4, qo = n & 15, j = kp >> 1, qi0 = (kp & 1) * 8; const LAS float* s = KT + (t - j + 31) * KTS + qo * 16 + qi0;
        const f32x4 s0 = *(const LAS f32x4*)s, s1 = *(const LAS f32x4*)(s + 4);
        v4u o; o.x = cvtpk(s0.x, s0.y); o.y = cvtpk(s0.z, s0.w); o.z = cvtpk(s1.x, s1.y); o.w = cvtpk(s1.z, s1.w);
        *(v4u*)(BtOut + (size_t)n * 768 + kp * 8) = o; }
    } else {
    for (int pc = tid; pc < 512 * 32; pc += NWAVES * 64) {
        const int n = pc >> 5, kp = pc & 31, t = n >> 4, qo = n & 15, d = kp >> 4, ri = (kp >> 3) & 1, p0 = (kp & 7) * 8, m = d == 0 ? t + 1 : 32 - t; float v[8];
#pragma unroll
        for (int i = 0; i < 8; ++i) { const f32x2 c = CC[CCI(d, qo, p0 + i)], w = POW[PWI(d, p0 + i, m)]; v[i] = ri == 0 ? (c.x * w.x - c.y * w.y) : -(c.x * w.y + c.y * w.x); }
        v4u o; o.x = cvtpk(v[0], v[1]); o.y = cvtpk(v[2], v[3]); o.z = cvtpk(v[4], v[5]); o.w = cvtpk(v[6], v[7]);
        *(v4u*)(BtOut + (size_t)n * 768 + 512 + kp * 8) = o; }
    for (int pc = tid; pc < 256 * 64; pc += NWAVES * 64) {
        const int n = pc >> 6, kp = pc & 63, d = n >> 7, ri = (n >> 6) & 1, p = n & 63, j = kp >> 1, qi0 = (kp & 1) * 8, m = d == 0 ? 31 - j : j; const f32x2 w = POW[PWI(d, p, m)]; float v[8];
#pragma unroll
        for (int i = 0; i < 8; ++i) { const float br = BBr[(d * 64 + p) * 16 + qi0 + i], bi = BBi[(d * 64 + p) * 16 + qi0 + i]; v[i] = ri == 0 ? (w.x * br - w.y * bi) : (w.x * bi + w.y * br); }
        v4u o; o.x = cvtpk(v[0], v[1]); o.y = cvtpk(v[2], v[3]); o.z = cvtpk(v[4], v[5]); o.w = cvtpk(v[6], v[7]);
        *(v4u*)(WEnd + (size_t)n * 512 + kp * 8) = o; }
    }
    __syncthreads();
#undef PWI
#undef CCI
}
__device__ __forceinline__ unsigned q8pack(float a, float b, float c, float d) { const int ia = (int)rintf(a), ib = (int)rintf(b), ic = (int)rintf(c), id = (int)rintf(d);
    return (unsigned)(ia & 255) | ((unsigned)(ib & 255) << 8) | ((unsigned)(ic & 255) << 16) | ((unsigned)(id & 255) << 24); }
__device__ __forceinline__ void cvt_item(const float* W, int K, int N, int ldw, bf16* WT, int mode, int item, LAS float* scr, int lane, unsigned* colmax = nullptr, float* pmax = nullptr) {
    const int nblk = N / 32, kb = item / nblk, nb = item - kb * nblk, k0 = 64 * kb, n0 = 32 * nb;
    int r0 = n0;
    if (mode == 1) r0 = 256 * (n0 >> 7) + (n0 & 127);
    else if (mode == 2) r0 = 256 * (n0 >> 7) + 128 + (n0 & 127);
    else if (mode == 3) { if (n0 < 1536) { const int pn = n0 >> 8, rem = n0 & 255; r0 = 256 * pn + 128 * ((rem & 63) >> 5) + 32 * (rem >> 6); }
                          else if (n0 < 2048) { const int n1 = n0 - 1536; r0 = 256 * (6 + (n1 >> 7)) + (n1 & 127); }
                          else { const int n1 = n0 - 2048; r0 = 256 * (6 + (n1 >> 7)) + 128 + (n1 & 127); } }
    { f32x4 v[8];
#pragma unroll
      for (int i = 0; i < 8; ++i) v[i] = *(const f32x4*)(W + (size_t)(k0 + 8 * i + (lane >> 3)) * ldw + n0 + 4 * (lane & 7));
#pragma unroll
      for (int i = 0; i < 8; ++i) { LAS float* d = scr + (8 * i + (lane >> 3)) * 33 + 4 * (lane & 7); d[0] = v[i].x; d[1] = v[i].y; d[2] = v[i].z; d[3] = v[i].w; } }
    LDS_WAIT(); asm volatile("" ::: "memory");
    const int c = lane & 7;
#pragma unroll
    for (int j = 0; j < 4; ++j) { const int n = (lane >> 3) + 8 * j; const LAS float* s = scr + (8 * c) * 33 + n;
        v4u o; o.x = cvtpk(s[0 * 33], s[1 * 33]); o.y = cvtpk(s[2 * 33], s[3 * 33]); o.z = cvtpk(s[4 * 33], s[5 * 33]); o.w = cvtpk(s[6 * 33], s[7 * 33]);
        *(GAS v4u*)(WT + (size_t)(r0 + n) * K + k0 + 8 * c) = o;
        if (colmax || pmax) { float mx = fmaxf(fmaxf(fmaxf(fabsf(s[0 * 33]), fabsf(s[1 * 33])), fmaxf(fabsf(s[2 * 33]), fabsf(s[3 * 33]))), fmaxf(fmaxf(fabsf(s[4 * 33]), fabsf(s[5 * 33])), fmaxf(fabsf(s[6 * 33]), fabsf(s[7 * 33]))));
            mx = fmaxf(mx, __shfl_xor(mx, 1)); mx = fmaxf(mx, __shfl_xor(mx, 2)); mx = fmaxf(mx, __shfl_xor(mx, 4));
            if (c == 0) { if (colmax) __hip_atomic_fetch_max(colmax + r0 + n, __builtin_bit_cast(unsigned, mx), RLX_AGENT); else pmax[(size_t)(r0 + n) * (K / 64) + kb] = mx; } } }
    LDS_WAIT(); asm volatile("" ::: "memory");
}
constexpr int CV_IM = 16 * 112, CV_IM2 = 56 * 32, CV_NMOE = NE * (2 * CV_IM + CV_IM2);
__device__ __forceinline__ void p0_convert(const Args& A, LAS unsigned char* lds, int gw, int NGW, int wave, int lane) {
    LAS float* scr = (LAS float*)(lds + wave * 16384);
    unsigned char* ws = A.ws;
    constexpr int I0 = 16 * 80, I1 = 16 * 32, I2 = 16 * 88, I3 = 44 * 32, I4 = 16 * 32, I5 = 16 * 32;
    constexpr int NSMALL = I0 + I1 + 2 * I2 + I3 + I4 + 2 * I5;
    for (int it = gw; it < NSMALL; it += NGW) {
        int r = it;
        if (r < I0) { cvt_item(A.in[I_MIXWIN], D, MIXIN, MIXIN, (bf16*)(ws + WS_WIN), 3, r, scr, lane, nullptr, (float*)(ws + WS_PMAX)); continue; } r -= I0;
        if (r < I1) { cvt_item(A.in[I_MIXWOUT], D, D, D, (bf16*)(ws + WS_WOUT), 0, r, scr, lane); continue; } r -= I1;
        if (r < I2) { cvt_item(A.in[I_FW1], D, FFN, FFN, (bf16*)(ws + WS_W13), 1, r, scr, lane, nullptr, (float*)(ws + WS_PMAX) + MIXIN * 16); continue; } r -= I2;
        if (r < I2) { cvt_item(A.in[I_FW3], D, FFN, FFN, (bf16*)(ws + WS_W13), 2, r, scr, lane, nullptr, (float*)(ws + WS_PMAX) + MIXIN * 16); continue; } r -= I2;
        if (r < I3) { cvt_item(A.in[I_FW2], FFN, D, D, (bf16*)(ws + WS_W2), 0, r, scr, lane); continue; } r -= I3;
        if (r < I4) { cvt_item(A.in[I_SWIN], D, D, D, (bf16*)(ws + WS_SIN), 0, r, scr, lane); continue; } r -= I4;
        if (r < I5) { cvt_item(A.in[I_SWOUT], D, D, 2 * D, (bf16*)(ws + WS_SOUT), 1, r, scr, lane); continue; } r -= I5;
        cvt_item(A.in[I_SWOUT] + D, D, D, 2 * D, (bf16*)(ws + WS_SOUT), 2, r, scr, lane);
    }
}
constexpr int CV_NQ = NE * 2 * (ED / 32), CV_NW2 = NE * (CV_IM2 / 16), CV_NUNITS = CV_NQ + CV_NW2, CQ_P = 514;
__device__ __forceinline__ void moe_convert(const Args& A, LAS unsigned char* lds, int first, int count, int wgi, int nwg, int tid, int wave, int lane) {
    LAS unsigned* T = (LAS unsigned*)lds; LAS float* scr = (LAS float*)(lds + wave * 16384);
    unsigned char* ws = A.ws;
    const int last = (first + count) < CV_NUNITS ? (first + count) : CV_NUNITS;
    const int c = tid & 7, rr = tid >> 3;
    f32x4 v[16];
#define CQ_LOAD(u_) do { const int e_ = (u_) / 224, r_ = (u_) - e_ * 224, wh_ = r_ / 112, nb_ = r_ - wh_ * 112; const float* W_ = (wh_ ? A.in[I_MW3] : A.in[I_MW1]) + (size_t)e_ * D * ED + 32 * nb_ + 4 * c; \
        _Pragma("unroll") for (int i = 0; i < 16; ++i) v[i] = *(const f32x4*)(W_ + (size_t)(2 * rr + (i & 1) + 128 * (i >> 1)) * ED); } while (0)
    int u = first + wgi;
    if (u < last && u < CV_NQ) CQ_LOAD(u);
    for (; u < last; u += nwg) {
        __syncthreads();
        if (u < CV_NQ) {
#pragma unroll
            for (int j = 0; j < 8; ++j)
#pragma unroll
                for (int q = 0; q < 4; ++q) T[(4 * c + q) * CQ_P + rr + 64 * j] = cvtpk(v[2 * j][q], v[2 * j + 1][q]);
            __syncthreads();
            const int un = u + nwg; if (un < last && un < CV_NQ) CQ_LOAD(un);
            const int e = u / 224, r = u - e * 224, wh = r / 112, n0 = 32 * (r - wh * 112), r0 = e * 2 * ED + 256 * (n0 >> 7) + 128 * wh + (n0 & 127) + 4 * wave;
#pragma unroll
            for (int q = 0; q < 4; ++q) { const LAS unsigned* col = T + (4 * wave + q) * CQ_P + 8 * lane;
                const v2u d0 = *(const LAS v2u*)col, d1 = *(const LAS v2u*)(col + 2), d2 = *(const LAS v2u*)(col + 4), d3 = *(const LAS v2u*)(col + 6);
                const float x[16] = {bflo(d0.x), bfhi(d0.x), bflo(d0.y), bfhi(d0.y), bflo(d1.x), bfhi(d1.x), bflo(d1.y), bfhi(d1.y), bflo(d2.x), bfhi(d2.x), bflo(d2.y), bfhi(d2.y), bflo(d3.x), bfhi(d3.x), bflo(d3.y), bfhi(d3.y)};
                float am = 0.f;
#pragma unroll
                for (int i = 0; i < 16; ++i) am = fmaxf(am, fabsf(x[i]));
                am = wave_max(am); const float inv = am > 0.f ? 127.0f / am : 0.f;
                v4u o; o.x = q8pack(x[0] * inv, x[1] * inv, x[2] * inv, x[3] * inv); o.y = q8pack(x[4] * inv, x[5] * inv, x[6] * inv, x[7] * inv);
                o.z = q8pack(x[8] * inv, x[9] * inv, x[10] * inv, x[11] * inv); o.w = q8pack(x[12] * inv, x[13] * inv, x[14] * inv, x[15] * inv);
                *(v4u*)(ws + WS_MW13 + (size_t)(r0 + q) * 1024 + 16 * lane) = o;
                if (lane == 0) ((float*)(ws + WS_COLSC))[r0 + q] = am * (1.0f / 127.0f); }
        } else {
            const int g = u - CV_NQ, e = g / (CV_IM2 / 16), gi = g - e * (CV_IM2 / 16);
#pragma unroll 1
            for (int i = 0; i < 2; ++i) cvt_item(A.in[I_MW2] + (size_t)e * ED * D, ED, D, D, (bf16*)(ws + WS_MW2) + (size_t)e * D * ED, 0, 16 * gi + 2 * wave + i, scr, lane);
        }
    }
#undef CQ_LOAD
}
__device__ __forceinline__ void shw_rows(const bf16* WT, int N, const float* sh, float* out, int widx, int nw, LAS unsigned char* lds, int tid, int lane, const float* colscale = nullptr) {
    LAS float* shl = (LAS float*)lds;
    __syncthreads();
    for (int i = tid; i < 9 * 1024; i += NWAVES * 64) shl[i] = sh[(size_t)(i >> 10) * 6144 + (i & 1023)];
    __syncthreads();
    for (int p = widx; p < N; p += nw) {
        float w[16];
        if (colscale) { const v4u q = *(const v4u*)((const unsigned char*)(WT + (size_t)p * D) + 16 * lane); const float cs = colscale[p]; const unsigned qq[4] = {q.x, q.y, q.z, q.w};
#pragma unroll
            for (int i = 0; i < 16; ++i) w[i] = (float)(int)(signed char)((qq[i >> 2] >> (8 * (i & 3))) & 255u) * cs; }
        else { const v4u w0 = *(const v4u*)(WT + (size_t)p * D + 16 * lane), w1 = *(const v4u*)(WT + (size_t)p * D + 16 * lane + 8);
            const float t[16] = {bflo(w0.x), bfhi(w0.x), bflo(w0.y), bfhi(w0.y), bflo(w0.z), bfhi(w0.z), bflo(w0.w), bfhi(w0.w), bflo(w1.x), bfhi(w1.x), bflo(w1.y), bfhi(w1.y), bflo(w1.z), bfhi(w1.z), bflo(w1.w), bfhi(w1.w)};
#pragma unroll
            for (int i = 0; i < 16; ++i) w[i] = t[i]; }
        float s[9];
#pragma unroll
        for (int b = 0; b < 9; ++b) { const LAS f32x4* sp = (const LAS f32x4*)(shl + b * 1024 + 16 * lane); float a = 0.f;
#pragma unroll
            for (int q = 0; q < 4; ++q) { const f32x4 v = sp[q]; a += (v.x * w[4 * q] + v.y * w[4 * q + 1]) + (v.z * w[4 * q + 2] + v.w * w[4 * q + 3]); }
            s[b] = a; }
#pragma unroll
        for (int b = 0; b < 9; ++b) s[b] = wave_sum(s[b]);
        if (lane < 9) { float v = s[0];
#pragma unroll
            for (int b = 1; b < 9; ++b) v = (lane == b) ? s[b] : v;
            out[(size_t)lane * N + p] = v; }
    }
    __syncthreads();
}
__device__ __forceinline__ void quant_rows_inplace(bf16* W, unsigned* colmax, int nrows, int gw, int NGW, int lane) {
    for (int r0 = gw; r0 < nrows; r0 += 2 * NGW) {
        const int r1 = (r0 + NGW < nrows) ? r0 + NGW : r0; const int nr = (r0 + NGW < nrows) ? 2 : 1;
        v4u a[2][2]; float mx[2];
#pragma unroll
        for (int u = 0; u < 2; ++u) { const int r = u ? r1 : r0; const bf16* rp = W + (size_t)r * 1024 + 16 * lane; a[u][0] = *(const v4u*)rp; a[u][1] = *(const v4u*)(rp + 8); mx[u] = __builtin_bit_cast(float, colmax[r]); }
        asm volatile("s_waitcnt vmcnt(0)" ::: "memory");
#pragma unroll
        for (int u = 0; u < 2; ++u) { if (u < nr) { const int r = u ? r1 : r0; const float inv = mx[u] > 0.f ? 127.0f / mx[u] : 0.f; v4u o;
            o.x = q8pack(bflo(a[u][0].x) * inv, bfhi(a[u][0].x) * inv, bflo(a[u][0].y) * inv, bfhi(a[u][0].y) * inv); o.y = q8pack(bflo(a[u][0].z) * inv, bfhi(a[u][0].z) * inv, bflo(a[u][0].w) * inv, bfhi(a[u][0].w) * inv);
            o.z = q8pack(bflo(a[u][1].x) * inv, bfhi(a[u][1].x) * inv, bflo(a[u][1].y) * inv, bfhi(a[u][1].y) * inv); o.w = q8pack(bflo(a[u][1].z) * inv, bfhi(a[u][1].z) * inv, bflo(a[u][1].w) * inv, bfhi(a[u][1].w) * inv);
            *(v4u*)((unsigned char*)(W + (size_t)r * 1024) + 16 * lane) = o;
            if (lane == 0) ((float*)colmax)[r] = mx[u] * (1.0f / 127.0f); } }
    }
}
__device__ __forceinline__ void quant_rows_f8_inplace(bf16* W, float* scale, int nrows, int gw, int NGW, int lane) {
    for (int r0 = gw; r0 < nrows; r0 += 2 * NGW) {
        const int r1 = (r0 + NGW < nrows) ? r0 + NGW : r0; const int nr = (r0 + NGW < nrows) ? 2 : 1;
        v4u a[2][7];
#pragma unroll
        for (int u = 0; u < 2; ++u) { const bf16* rp = W + (size_t)(u ? r1 : r0) * 3584 + 8 * lane;
#pragma unroll
            for (int c = 0; c < 7; ++c) a[u][c] = *(const v4u*)(rp + 512 * c); }
        asm volatile("s_waitcnt vmcnt(0)" ::: "memory");
#pragma unroll
        for (int u = 0; u < 2; ++u) { if (u < nr) { const int r = u ? r1 : r0; float am = 0.f;
#pragma unroll
            for (int c = 0; c < 7; ++c) { am = fmaxf(am, fmaxf(fmaxf(fabsf(bflo(a[u][c].x)), fabsf(bfhi(a[u][c].x))), fmaxf(fabsf(bflo(a[u][c].y)), fabsf(bfhi(a[u][c].y)))));
                am = fmaxf(am, fmaxf(fmaxf(fabsf(bflo(a[u][c].z)), fabsf(bfhi(a[u][c].z))), fmaxf(fabsf(bflo(a[u][c].w)), fabsf(bfhi(a[u][c].w))))); }
            am = wave_max(am); const float inv = am > 0.f ? 448.0f / am : 0.f;
#pragma unroll
            for (int c = 0; c < 7; ++c) { v2u o;
                o.x = pg8::f8pack4((f32x4){bflo(a[u][c].x), bfhi(a[u][c].x), bflo(a[u][c].y), bfhi(a[u][c].y)} * inv); o.y = pg8::f8pack4((f32x4){bflo(a[u][c].z), bfhi(a[u][c].z), bflo(a[u][c].w), bfhi(a[u][c].w)} * inv);
                *(v2u*)((unsigned char*)(W + (size_t)r * 3584) + 8 * lane + 512 * c) = o; }
            if (lane == 0) scale[r] = am * (1.0f / 448.0f); } }
    }
}
__device__ __forceinline__ void quant_rows_f8_1k(bf16* W, float* scale, int nrows, int gw, int NGW, int lane) {
    for (int r = gw; r < nrows; r += NGW) {
        const bf16* rp = W + (size_t)r * 1024 + 16 * lane; const v4u a0 = *(const v4u*)rp, a1 = *(const v4u*)(rp + 8);
        asm volatile("s_waitcnt vmcnt(0)" ::: "memory");
        const f32x4 v0 = (f32x4){bflo(a0.x), bfhi(a0.x), bflo(a0.y), bfhi(a0.y)}, v1 = (f32x4){bflo(a0.z), bfhi(a0.z), bflo(a0.w), bfhi(a0.w)}, v2 = (f32x4){bflo(a1.x), bfhi(a1.x), bflo(a1.y), bfhi(a1.y)}, v3 = (f32x4){bflo(a1.z), bfhi(a1.z), bflo(a1.w), bfhi(a1.w)};
        float am = 0.f;
#pragma unroll
        for (int i = 0; i < 4; ++i) am = fmaxf(am, fmaxf(fmaxf(fabsf(v0[i]), fabsf(v1[i])), fmaxf(fabsf(v2[i]), fabsf(v3[i]))));
        am = wave_max(am); const float inv = am > 0.f ? 448.0f / am : 0.f;
        v4u o; o.x = pg8::f8pack4(v0 * inv); o.y = pg8::f8pack4(v1 * inv); o.z = pg8::f8pack4(v2 * inv); o.w = pg8::f8pack4(v3 * inv);
        *(v4u*)((unsigned char*)(W + (size_t)r * 1024) + 16 * lane) = o;
        if (lane == 0) scale[r] = am * (1.0f / 448.0f);
    }
}
__device__ __forceinline__ void quant_rows_inplace_p(bf16* W, const float* pmax, float* colscale, int nrows, int gw, int NGW, int lane) {
    for (int r = gw; r < nrows; r += NGW) {
        const bf16* rp = W + (size_t)r * 1024 + 16 * lane; const v4u a0 = *(const v4u*)rp, a1 = *(const v4u*)(rp + 8);
        const float mx = wave_max(pmax[(size_t)r * 16 + (lane & 15)]);
        asm volatile("s_waitcnt vmcnt(0)" ::: "memory");
        const float inv = mx > 0.f ? 127.0f / mx : 0.f; v4u o;
        o.x = q8pack(bflo(a0.x) * inv, bfhi(a0.x) * inv, bflo(a0.y) * inv, bfhi(a0.y) * inv); o.y = q8pack(bflo(a0.z) * inv, bfhi(a0.z) * inv, bflo(a0.w) * inv, bfhi(a0.w) * inv);
        o.z = q8pack(bflo(a1.x) * inv, bfhi(a1.x) * inv, bflo(a1.y) * inv, bfhi(a1.y) * inv); o.w = q8pack(bflo(a1.z) * inv, bfhi(a1.z) * inv, bflo(a1.w) * inv, bfhi(a1.w) * inv);
        *(v4u*)((unsigned char*)(W + (size_t)r * 1024) + 16 * lane) = o;
        if (lane == 0) colscale[r] = mx * (1.0f / 127.0f);
    }
}
__device__ __forceinline__ void quant_act_rows(bf16* Hb, const float* rowss, float* rowfac, int nrows, int gw, int NGW, int lane) {
    for (int r0 = gw; r0 < nrows; r0 += 2 * NGW) {
        const int r1 = (r0 + NGW < nrows) ? r0 + NGW : r0; const int nr = (r0 + NGW < nrows) ? 2 : 1;
        v4u a[2][2]; float ssq[2];
#pragma unroll
        for (int u = 0; u < 2; ++u) { const int r = u ? r1 : r0; const bf16* rp = Hb + (size_t)r * 1024 + 16 * lane; a[u][0] = *(const v4u*)rp; a[u][1] = *(const v4u*)(rp + 8); ssq[u] = rowss[(size_t)r * 16 + (lane & 15)]; }
        asm volatile("s_waitcnt vmcnt(0)" ::: "memory");
#pragma unroll
        for (int u = 0; u < 2; ++u) { if (u < nr) { const int r = u ? r1 : r0;
            const float v[16] = {bflo(a[u][0].x), bfhi(a[u][0].x), bflo(a[u][0].y), bfhi(a[u][0].y), bflo(a[u][0].z), bfhi(a[u][0].z), bflo(a[u][0].w), bfhi(a[u][0].w),
                                 bflo(a[u][1].x), bfhi(a[u][1].x), bflo(a[u][1].y), bfhi(a[u][1].y), bflo(a[u][1].z), bfhi(a[u][1].z), bflo(a[u][1].w), bfhi(a[u][1].w)};
            float am = 0.f;
#pragma unroll
            for (int i = 0; i < 16; ++i) am = fmaxf(am, fabsf(v[i]));
            am = wave_max(am); const float inv = am > 0.f ? 127.0f / am : 0.f;
            float sq = (lane < 16) ? ssq[u] : 0.f; sq = wave_sum(sq);
            v4u o; o.x = q8pack(v[0] * inv, v[1] * inv, v[2] * inv, v[3] * inv); o.y = q8pack(v[4] * inv, v[5] * inv, v[6] * inv, v[7] * inv);
            o.z = q8pack(v[8] * inv, v[9] * inv, v[10] * inv, v[11] * inv); o.w = q8pack(v[12] * inv, v[13] * inv, v[14] * inv, v[15] * inv);
            *(v4u*)((unsigned char*)(Hb + (size_t)r * 1024) + 16 * lane) = o;
            if (lane == 0) rowfac[r] = rsqrtf(sq * (1.0f / 1024.0f) + EPS) * am * (1.0f / 127.0f); } }
    }
}
template <int NPART> __device__ __forceinline__ void norm_row_finish(const f32x4 (&v)[4], int row, const float* gain, const float* mod, int shc, int scc, bf16* H, int lane) {
    const float* mp = mod + (size_t)(row < ML ? (row >> 11) : 8) * 6144; float ss = 0.f;
#pragma unroll
    for (int j = 0; j < 4; ++j) ss += (v[j].x * v[j].x + v[j].y * v[j].y) + (v[j].z * v[j].z + v[j].w * v[j].w);
    const float rstd = rsqrtf(wave_sum(ss) * (1.0f / D) + EPS);
#pragma unroll
    for (int j = 0; j < 4; ++j) { const int k = 4 * lane + 256 * j; const f32x4 gg = *(const f32x4*)(gain + k); f32x4 sc = *(const f32x4*)(mp + scc * 1024 + k), sh = *(const f32x4*)(mp + shc * 1024 + k);
#pragma unroll
        for (int q = 1; q < NPART; ++q) { sc = sc + *(const f32x4*)(mp + (size_t)q * MOD_N + scc * 1024 + k); sh = sh + *(const f32x4*)(mp + (size_t)q * MOD_N + shc * 1024 + k); }
        const f32x4 h = v[j] * rstd * gg * (sc + 1.0f) + sh;
        v2u o; o.x = cvtpk(h.x, h.y); o.y = cvtpk(h.z, h.w); *(v2u*)(H + (size_t)row * D + k) = o; }
}
__device__ __forceinline__ void norm_rows_lds(const float* xL, const float* xC, int nrows, const float* gain, const LAS float* ms, bf16* H, float* rowfac, int gw, int NGW, int lane) {
    for (int row = gw; row < nrows; row += 2 * NGW) {
        const int row1 = row + NGW; const bool two = row1 < nrows; const int r1 = two ? row1 : row;
        const float* xa = row < ML ? xL + (size_t)row * D : xC + (size_t)(row - ML) * D; const float* xb = r1 < ML ? xL + (size_t)r1 * D : xC + (size_t)(r1 - ML) * D;
        f32x4 vv[2][4];
#pragma unroll
        for (int j = 0; j < 4; ++j) { vv[0][j] = *(const f32x4*)(xa + 4 * lane + 256 * j); vv[1][j] = *(const f32x4*)(xb + 4 * lane + 256 * j); }
#pragma unroll
        for (int u = 0; u < 2; ++u) { if (u == 1 && !two) break; const int rw = u ? row1 : row; const LAS float* mp = ms + (rw < ML ? (rw >> 11) : 8) * 2048; float ss = 0.f;
#pragma unroll
            for (int j = 0; j < 4; ++j) ss += (vv[u][j].x * vv[u][j].x + vv[u][j].y * vv[u][j].y) + (vv[u][j].z * vv[u][j].z + vv[u][j].w * vv[u][j].w);
            const float rstd = rsqrtf(wave_sum(ss) * (1.0f / D) + EPS);
            f32x4 hq[4]; float am = 0.f;
#pragma unroll
            for (int j = 0; j < 4; ++j) { const int k = 4 * lane + 256 * j; const f32x4 gg = *(const f32x4*)(gain + k), sh = *(const LAS f32x4*)(mp + k), sc = *(const LAS f32x4*)(mp + 1024 + k);
                const f32x4 h = vv[u][j] * rstd * gg * (sc + 1.0f) + sh; hq[j] = h; am = fmaxf(am, fmaxf(fmaxf(fabsf(h.x), fabsf(h.y)), fmaxf(fabsf(h.z), fabsf(h.w)))); }
            am = wave_max(am); const float inv = am > 0.f ? 127.0f / am : 0.f;
#pragma unroll
            for (int j = 0; j < 4; ++j) *(unsigned*)((unsigned char*)H + (size_t)rw * D + 4 * lane + 256 * j) = q8pack(hq[j].x * inv, hq[j].y * inv, hq[j].z * inv, hq[j].w * inv);
            if (lane == 0) rowfac[rw] = am * (1.0f / 127.0f); }
    }
}
template <int NPART> __device__ __forceinline__ void norm_rows(const float* xL, const float* xC, int nrows, const float* gain, const float* mod, int shc, int scc, bf16* H, int gw, int NGW, int lane) {
    for (int row = gw; row < nrows; row += 2 * NGW) {
        const int row1 = row + NGW; const bool two = row1 < nrows; const int r1 = two ? row1 : row;
        const float* xa = row < ML ? xL + (size_t)row * D : xC + (size_t)(row - ML) * D; const float* xb = r1 < ML ? xL + (size_t)r1 * D : xC + (size_t)(r1 - ML) * D;
        f32x4 va[4], vb[4];
#pragma unroll
        for (int j = 0; j < 4; ++j) { va[j] = *(const f32x4*)(xa + 4 * lane + 256 * j); vb[j] = *(const f32x4*)(xb + 4 * lane + 256 * j); }
        norm_row_finish<NPART>(va, row, gain, mod, shc, scc, H, lane);
        if (two) norm_row_finish<NPART>(vb, row1, gain, mod, shc, scc, H, lane);
    }
}
constexpr int VSTR = 144;
__device__ __forceinline__ void attn_unit(const bf16* QKVU, bf16* MIX, int wu, LAS unsigned char* vl, LAS unsigned char* ql, const LAS float* rpbl, float bnd, int lane) {
    const bool isctx = wu >= 2048;
    int b, h, r = 0, qrow0;
    if (!isctx) { h = wu & 7; r = (wu >> 3) & 31; b = wu >> 8; qrow0 = b * SEQ + r * 64; }
    else { const int w = wu - 2048; h = w & 7; b = w >> 5; qrow0 = ML + b * NCTX + 64 * ((w >> 3) & 3); }
    const int c = lane & 31, hh = lane >> 5;
    const int rs = r < 4 ? 0 : (r > 28 ? 24 : r - 4);
    const int csA = c < 8 ? 0 : c - 8;
    const int csB = c > 24 ? 48 : c + 24;
    const LAS unsigned char* vtb = vl + (4 * hh + ((lane & 15) >> 2)) * VSTR + 32 * ((lane >> 4) & 1) + 8 * (lane & 3);
    LAS unsigned char* qs = ql + c * 128 + 16 * hh;
    { const bf16* qp = QKVU + (size_t)(qrow0 + c) * 2048 + h * 64 + 8 * hh;
#pragma unroll
      for (int s = 0; s < 4; ++s) { *(LAS bf16x8*)(qs + 32 * s) = *(const bf16x8*)(qp + 16 * s); *(LAS bf16x8*)(qs + 4096 + 32 * s) = *(const bf16x8*)(qp + (size_t)32 * 2048 + 16 * s); } }
    f32x16 oA0, oA1, oB0, oB1;
#pragma unroll
    for (int i = 0; i < 16; ++i) { oA0[i] = 0.f; oA1[i] = 0.f; oB0[i] = 0.f; oB1[i] = 0.f; }
    float lsA = 0.f, lsB = 0.f;
    const int nblk = isctx ? 8 : 24;
    const bf16* kbase = QKVU + 512 + h * 64 + 8 * hh + (size_t)c * 2048;
    const bf16* vbase = QKVU + 1024 + h * 64 + 8 * (lane & 7) + (size_t)(lane >> 3) * 2048;
#define ATT_KROW0(kb_) (((!isctx) && (kb_) < 16) ? (b * SEQ + (rs + ((kb_) >> 1)) * 64 + 32 * ((kb_) & 1)) : (ML + b * NCTX + 32 * (isctx ? (kb_) : (kb_) - 16)))
#define ATT_LOADK(KF, kb_) do { const int kq_ = (kb_) < nblk ? (kb_) : nblk - 1; const size_t ro_ = (size_t)ATT_KROW0(kq_) * 2048; \
        _Pragma("unroll") for (int s_ = 0; s_ < 4; ++s_) KF[s_] = *(const bf16x8*)(kbase + ro_ + 16 * s_); } while (0)
#define ATT_LOADV(VF, kb_) do { const int kq_ = (kb_) < nblk ? (kb_) : nblk - 1; const size_t ro_ = (size_t)ATT_KROW0(kq_) * 2048; \
        _Pragma("unroll") for (int i_ = 0; i_ < 4; ++i_) VF[i_] = *(const v4u*)(vbase + ro_ + (size_t)i_ * 8 * 2048); } while (0)
#define ATT_PACK(PF, P) do { _Pragma("unroll") for (int s = 0; s < 2; ++s) { v4u w; w.x = cvtpk(P[8 * s], P[8 * s + 1]); w.y = cvtpk(P[8 * s + 2], P[8 * s + 3]); w.z = cvtpk(P[8 * s + 4], P[8 * s + 5]); w.w = cvtpk(P[8 * s + 6], P[8 * s + 7]); PF[s] = __builtin_bit_cast(bf16x8, w); } } while (0)
#define ATT_BLOCK(KF, VF, kb_) do { const int kb = (kb_); const bool live = kb < nblk; const bool band = (!isctx) && kb < 16; const int kr = rs + (kb >> 1); \
        _Pragma("unroll") for (int i = 0; i < 4; ++i) { const int id = lane + 64 * i; *(LAS v4u*)(vl + (id >> 3) * VSTR + (id & 7) * 16) = VF[i]; } \
        ATT_LOADV(VF, kb + 1);              \
        f32x16 sA, sB; \
        _Pragma("unroll") for (int i = 0; i < 16; ++i) { sA[i] = 0.f; sB[i] = 0.f; } \
        _Pragma("unroll") for (int s = 0; s < 4; ++s) { sA = __builtin_amdgcn_mfma_f32_32x32x16_bf16(KF[s], *(const LAS bf16x8*)(qs + 32 * s), sA, 0, 0, 0); \
                                                        sB = __builtin_amdgcn_mfma_f32_32x32x16_bf16(KF[s], *(const LAS bf16x8*)(qs + 4096 + 32 * s), sB, 0, 0, 0); } \
        ATT_LOADK(KF, kb + 1);              \
        float pA[16], pB[16]; \
        if (band) { const int kc0 = 32 * (kb & 1) + 4 * hh; const LAS float* rb = rpbl + h * 465 + (kr - r + 7) * 31 + (kc0 - c); \
              \
            float bA[16], bB[16]; \
            _Pragma("unroll") for (int i = 0; i < 16; ++i) { bA[i] = rb[15 + (i & 3) + 8 * (i >> 2)]; bB[i] = rb[(i & 3) + 8 * (i >> 2) - 17]; } \
            const int tA = kc0 - csA, tB = kc0 - csB; \
            _Pragma("unroll") for (int i = 0; i < 16; ++i) { const int o = (i & 3) + 8 * (i >> 2); \
                { const bool ok = (unsigned)(tA + o) < 16u; const float e = __builtin_amdgcn_exp2f(sA[i] * 0.18033688f + bA[i]); pA[i] = ok ? e : 0.f; } \
                { const bool ok = (unsigned)(tB + o) < 16u; const float e = __builtin_amdgcn_exp2f(sB[i] * 0.18033688f + bB[i]); pB[i] = ok ? e : 0.f; } } \
        } else { \
            _Pragma("unroll") for (int i = 0; i < 16; ++i) { const float ea = __builtin_amdgcn_exp2f(sA[i] * 0.18033688f - bnd), eb = __builtin_amdgcn_exp2f(sB[i] * 0.18033688f - bnd); pA[i] = live ? ea : 0.f; pB[i] = live ? eb : 0.f; } } \
        _Pragma("unroll") for (int i = 0; i < 16; ++i) { lsA += pA[i]; lsB += pB[i]; } \
        bf16x8 fA[2], fB[2]; ATT_PACK(fA, pA); ATT_PACK(fB, pB); \
        LDS_WAIT(); \
        _Pragma("unroll") for (int dt = 0; dt < 2; ++dt) \
            _Pragma("unroll") for (int s = 0; s < 2; ++s) { \
                const s16x4 lo = vtr(vtb + (16 * s) * VSTR + 64 * dt), hi = vtr(vtb + (16 * s + 8) * VSTR + 64 * dt); \
                const bf16x8 af = (bf16x8){lo[0], lo[1], lo[2], lo[3], hi[0], hi[1], hi[2], hi[3]}; \
                if (dt == 0) { oA0 = __builtin_amdgcn_mfma_f32_32x32x16_bf16(af, fA[s], oA0, 0, 0, 0); oB0 = __builtin_amdgcn_mfma_f32_32x32x16_bf16(af, fB[s], oB0, 0, 0, 0); } \
                else { oA1 = __builtin_amdgcn_mfma_f32_32x32x16_bf16(af, fA[s], oA1, 0, 0, 0); oB1 = __builtin_amdgcn_mfma_f32_32x32x16_bf16(af, fB[s], oB1, 0, 0, 0); } } \
        } while (0)
    bf16x8 kA[4]; v4u vA[4];
    ATT_LOADK(kA, 0); ATT_LOADV(vA, 0);
    for (int kb1 = 0; kb1 < nblk; ++kb1) ATT_BLOCK(kA, vA, kb1);
#undef ATT_KROW0
#undef ATT_LOADK
#undef ATT_LOADV
#undef ATT_PACK
#undef ATT_BLOCK
    lsA += __shfl_xor(lsA, 32); lsB += __shfl_xor(lsB, 32);
    const float iA = 1.0f / lsA, iB = 1.0f / lsB;
    bf16* op = MIX + (size_t)(qrow0 + c) * D + h * 64 + 4 * hh; bf16* oq = op + (size_t)32 * D;
#pragma unroll
    for (int i4 = 0; i4 < 4; ++i4) {
        v2u w0; w0.x = cvtpk(oA0[4 * i4] * iA, oA0[4 * i4 + 1] * iA); w0.y = cvtpk(oA0[4 * i4 + 2] * iA, oA0[4 * i4 + 3] * iA); *(v2u*)(op + 8 * i4) = w0;
        v2u w1; w1.x = cvtpk(oA1[4 * i4] * iA, oA1[4 * i4 + 1] * iA); w1.y = cvtpk(oA1[4 * i4 + 2] * iA, oA1[4 * i4 + 3] * iA); *(v2u*)(op + 32 + 8 * i4) = w1;
        v2u w2; w2.x = cvtpk(oB0[4 * i4] * iB, oB0[4 * i4 + 1] * iB); w2.y = cvtpk(oB0[4 * i4 + 2] * iB, oB0[4 * i4 + 3] * iB); *(v2u*)(oq + 8 * i4) = w2;
        v2u w3; w3.x = cvtpk(oB1[4 * i4] * iB, oB1[4 * i4 + 1] * iB); w3.y = cvtpk(oB1[4 * i4 + 2] * iB, oB1[4 * i4 + 3] * iB); *(v2u*)(oq + 32 + 8 * i4) = w3; }
}
template <int P0, int NP> __device__ __forceinline__ void conv_chunk(float (&acc)[32], const float (&w)[31], const __amdgpu_buffer_rsrc_t rsrc, int voff, int t0, int len) {
    float v[NP];
#pragma unroll
    for (int i = 0; i < NP; ++i) { const int t = t0 - 15 + P0 + i, tc = t < 0 ? 0 : (t >= len ? len - 1 : t); const int so = __builtin_amdgcn_readfirstlane(tc * 4096);
        const float x = bf2f(__builtin_amdgcn_raw_buffer_load_b16(rsrc, voff, so, 0)); v[i] = (t == tc) ? x : 0.f; }
#pragma unroll
    for (int i = 0; i < NP; ++i)
#pragma unroll
        for (int tt = 0; tt < 32; ++tt) { if (P0 + i - tt >= 0 && P0 + i - tt <= 30) acc[tt] += v[i] * w[(P0 + i - tt >= 0 && P0 + i - tt <= 30) ? P0 + i - tt : 0]; }
}
__device__ __forceinline__ void conv_item(const Args& A, const bf16* QKVU, bf16* MIX, int item, LAS float* cv, int tid, int wave, int lane) {
    __syncthreads();
    int rowbase, len, t0;
    if (item < 512) { rowbase = (item >> 6) * SEQ; len = SEQ; t0 = 32 * (item & 63); } else { const int i2 = item - 512; rowbase = ML + (i2 >> 3) * NCTX; len = NCTX; t0 = 32 * (i2 & 7); }
    const int ch = tid;
    float w[31], acc[32];
    { const __amdgpu_buffer_rsrc_t wrs = __builtin_amdgcn_make_buffer_rsrc((void*)A.in[I_DWW], 0, 31 * 512 * 4, 0x00020000);
#pragma unroll
      for (int k = 0; k < 31; ++k) w[k] = __builtin_bit_cast(float, __builtin_amdgcn_raw_buffer_load_b32(wrs, 4 * ch, k * 2048, 0)); }
    const float bias = A.in[I_DWB][ch];
#pragma unroll
    for (int t = 0; t < 32; ++t) acc[t] = bias;
    const __amdgpu_buffer_rsrc_t rsrc = __builtin_amdgcn_make_buffer_rsrc((void*)(QKVU + (size_t)rowbase * 2048 + 1536), 0, len * 4096, 0x00020000);
    conv_chunk<0, 16>(acc, w, rsrc, 2 * ch, t0, len); conv_chunk<16, 16>(acc, w, rsrc, 2 * ch, t0, len); conv_chunk<32, 16>(acc, w, rsrc, 2 * ch, t0, len); conv_chunk<48, 14>(acc, w, rsrc, 2 * ch, t0, len);
#pragma unroll
    for (int t = 0; t < 32; ++t) cv[t * 512 + ch] = acc[t];
    __syncthreads();
    const f32x4 g0 = *(const f32x4*)(A.in[I_LNG] + 8 * lane), g1 = *(const f32x4*)(A.in[I_LNG] + 8 * lane + 4), b0 = *(const f32x4*)(A.in[I_LNB] + 8 * lane), b1 = *(const f32x4*)(A.in[I_LNB] + 8 * lane + 4);
#pragma unroll
    for (int q = 0; q < 4; ++q) { const int tt = 4 * wave + q;
        f32x4 x0 = *(const LAS f32x4*)(cv + tt * 512 + 8 * lane), x1 = *(const LAS f32x4*)(cv + tt * 512 + 8 * lane + 4);
        const float mean = wave_sum((x0.x + x0.y) + (x0.z + x0.w) + (x1.x + x1.y) + (x1.z + x1.w)) * (1.0f / 512.0f);
        x0 = x0 - mean; x1 = x1 - mean;
        const float var = wave_sum((x0.x * x0.x + x0.y * x0.y) + (x0.z * x0.z + x0.w * x0.w) + (x1.x * x1.x + x1.y * x1.y) + (x1.z * x1.z + x1.w * x1.w)) * (1.0f / 512.0f);
        const float rstd = rsqrtf(var + EPS);
        f32x4 y0 = x0 * rstd * g0 + b0, y1 = x1 * rstd * g1 + b1;
        y0 = (f32x4){y0.x * sigm(y0.x), y0.y * sigm(y0.y), y0.z * sigm(y0.z), y0.w * sigm(y0.w)}; y1 = (f32x4){y1.x * sigm(y1.x), y1.y * sigm(y1.y), y1.z * sigm(y1.z), y1.w * sigm(y1.w)};
        v4u o; o.x = cvtpk(y0.x, y0.y); o.y = cvtpk(y0.z, y0.w); o.z = cvtpk(y1.x, y1.y); o.w = cvtpk(y1.z, y1.w);
        *(v4u*)(MIX + (size_t)(rowbase + t0 + tt) * D + 512 + 8 * lane) = o; }
    __syncthreads();
}
__device__ __forceinline__ void s5_scan(const Args& A, int gt) {
    if (gt >= NB * 64 * 2 * 64) return;
    const int p = gt & 63, d = (gt >> 6) & 1, g = (gt >> 7) & 63, b = gt >> 13;
    const int ix = (d * 64 + g) * 64 + p;
    const float ar = A.in[I_ARE][ix], ai = A.in[I_AIM][ix], dt = __expf(A.in[I_LOGDT][d * 64 + g]);
    const float zr = ar * dt, zi = ai * dt, mag = __expf(zr); float lr = mag * cosf(zi), li = mag * sinf(zi);
#pragma unroll
    for (int k = 0; k < 5; ++k) { const float nr = lr * lr - li * li, ni = 2.f * lr * li; lr = nr; li = ni; }
    const float* E = (const float*)(A.ws + WS_E) + (size_t)g * 768 * 256 + d * 128 + p;
    bf16* UC = (bf16*)(A.ws + WS_UC) + (size_t)g * 768 * 768 + 512 + d * 128 + p;
    float sr = 0.f, si = 0.f;
    for (int s0 = 0; s0 < 72; s0 += 24) {
        float er[24], ei[24]; int bcs[24];
#pragma unroll
        for (int k = 0; k < 24; ++k) { const int step = s0 + k; int bc;
            if (step < 8) bc = 512 + 8 * b + (d == 0 ? step : 7 - step); else bc = 64 * b + (d == 0 ? step - 8 : 71 - step);
            bcs[k] = bc; er[k] = E[(size_t)bc * 256]; ei[k] = E[(size_t)bc * 256 + 64]; }
#pragma unroll
        for (int k = 0; k < 24; ++k) {
            if (s0 + k >= 8) { UC[(size_t)bcs[k] * 768] = (bf16)f2bf(sr); UC[(size_t)bcs[k] * 768 + 64] = (bf16)f2bf(si); }
            const float nr = lr * sr - li * si + er[k], ni = lr * si + li * sr + ei[k]; sr = nr; si = ni; }
    }
}
__device__ __forceinline__ void moe_route(const Args& A, const bf16* X, const float* mod, bf16* H, int chunk, LAS unsigned* lcnt, int tid, int wave, int lane) {
    unsigned char* tok = A.ws + WS_TOK;
    int* tokE = (int*)(tok + TOK_E); float* tokW = (float*)(tok + TOK_W); int* tokRank = (int*)(tok + TOK_RANK); int* wgbase = (int*)(tok + TOK_WGBASE);
    if (tid < 8) lcnt[tid] = 0u;
    __syncthreads();
    const float* gain = A.in[I_N2G] + D; const float* wr = A.in[I_ROUTER];
    for (int q2 = 0; q2 < 8; q2 += 2) {
        f32x4 vv[2][4];
#pragma unroll
        for (int u = 0; u < 2; ++u) { const bf16* xr = X + (size_t)(chunk * 64 + wave * 8 + q2 + u) * D;
#pragma unroll
            for (int j = 0; j < 4; ++j) { const v2u xw = *(const v2u*)(xr + 4 * lane + 256 * j); vv[u][j] = (f32x4){bflo(xw.x), bfhi(xw.x), bflo(xw.y), bfhi(xw.y)}; } }
#pragma unroll
        for (int u = 0; u < 2; ++u) {
        const int row = chunk * 64 + wave * 8 + q2 + u; const float* mp = mod + (size_t)(row >> 11) * 6144;
        float ss = 0.f;
#pragma unroll
        for (int j = 0; j < 4; ++j) ss += (vv[u][j].x * vv[u][j].x + vv[u][j].y * vv[u][j].y) + (vv[u][j].z * vv[u][j].z + vv[u][j].w * vv[u][j].w);
        const float rstd = rsqrtf(wave_sum(ss) * (1.0f / D) + EPS);
        float lg[8]; f32x4 hq[4];
#pragma unroll
        for (int e = 0; e < 8; ++e) lg[e] = 0.f;
#pragma unroll
        for (int j = 0; j < 4; ++j) { const int k = 4 * lane + 256 * j; const f32x4 gg = *(const f32x4*)(gain + k), sc = *(const f32x4*)(mp + 4 * 1024 + k), sh = *(const f32x4*)(mp + 3 * 1024 + k);
            const f32x4 h = vv[u][j] * rstd * gg * (sc + 1.0f) + sh; hq[j] = h;
#pragma unroll
            for (int i = 0; i < 4; ++i) { const f32x4 w0 = *(const f32x4*)(wr + (size_t)(k + i) * 8), w1 = *(const f32x4*)(wr + (size_t)(k + i) * 8 + 4); const float hv = h[i];
                lg[0] += hv * w0.x; lg[1] += hv * w0.y; lg[2] += hv * w0.z; lg[3] += hv * w0.w; lg[4] += hv * w1.x; lg[5] += hv * w1.y; lg[6] += hv * w1.z; lg[7] += hv * w1.w; } }
        {
            float am = 0.f;
#pragma unroll
            for (int j = 0; j < 4; ++j) am = fmaxf(am, fmaxf(fmaxf(fabsf(hq[j].x), fabsf(hq[j].y)), fmaxf(fabsf(hq[j].z), fabsf(hq[j].w))));
            am = wave_max(am); const float inv = am > 0.f ? 127.0f / am : 0.f;
#pragma unroll
            for (int j = 0; j < 4; ++j) *(unsigned*)((unsigned char*)H + (size_t)row * D + 4 * lane + 256 * j) = q8pack(hq[j].x * inv, hq[j].y * inv, hq[j].z * inv, hq[j].w * inv);
            if (lane == 0) ((float*)(A.ws + WS_ROWSC))[row] = am * (1.0f / 127.0f); }
#pragma unroll
        for (int e = 0; e < 8; ++e) lg[e] = wave_sum(lg[e]);
        int e0 = 0; float v0 = lg[0];
#pragma unroll
        for (int e = 1; e < 8; ++e) if (lg[e] > v0) { v0 = lg[e]; e0 = e; }
        int e1 = -1; float v1 = -3.0e38f;
#pragma unroll
        for (int e = 0; e < 8; ++e) if (e != e0 && lg[e] > v1) { v1 = lg[e]; e1 = e; }
        const float ex = __expf(v1 - v0), w0 = 1.0f / (1.0f + ex), w1 = ex * w0;
        if (lane == 0) { const unsigned r0 = __hip_atomic_fetch_add(&lcnt[e0], 1u, __ATOMIC_RELAXED, __HIP_MEMORY_SCOPE_WORKGROUP), r1 = __hip_atomic_fetch_add(&lcnt[e1], 1u, __ATOMIC_RELAXED, __HIP_MEMORY_SCOPE_WORKGROUP);
            tokE[2 * row] = e0; tokE[2 * row + 1] = e1; tokW[2 * row] = w0; tokW[2 * row + 1] = w1; tokRank[2 * row] = (int)r0; tokRank[2 * row + 1] = (int)r1; }
        }
    }
    __syncthreads();
    if (tid < 8) { const unsigned n = lcnt[tid]; const unsigned base = __hip_atomic_fetch_add((unsigned*)(A.ws + WS_CTL) + CW_GCNT + 64 * tid, n, RLX_AGENT); wgbase[chunk * 8 + tid] = (int)base; }
    __syncthreads();
}
constexpr int NPHASE = 18;
__device__ __forceinline__ void moe_offsets(const unsigned char* ws, int (&toff)[9]) {
    const unsigned* gc = (const unsigned*)(ws + WS_CTL) + CW_GCNT; int acc = 0;
#pragma unroll
    for (int e = 0; e < 8; ++e) { toff[e] = acc; const unsigned n = (unsigned)__builtin_amdgcn_readfirstlane((int)__hip_atomic_load(gc + 64 * e, RLX_AGENT)); acc += (int)((n + 255u) >> 8); }
    toff[8] = acc;
}
#define TAIL_CONVERT(nunits, first, count) do { const int rounds_ = ((nunits) + G - 1) / G, nlast_ = (nunits) - (rounds_ - 1) * G; \
        if (bx >= nlast_) moe_convert(args, lds, (first), (count), bx - nlast_, G - nlast_, tid, wave, lane); } while (0)
constexpr int CVQ4 = 288, CVQ6 = 416, CVQ7 = 1344, CVQ9 = 448, CVQS1 = 128, CVQS2 = CV_NUNITS - CVQ4 - CVQ6 - CVQ7 - CVQ9 - CVQS1;
__global__ void __launch_bounds__(NWAVES * 64, 2) fwd_kernel(Args args) {
    extern __shared__ __attribute__((aligned(16))) unsigned char lds_raw[];
    LAS unsigned char* lds = (LAS unsigned char*)lds_raw;
    volatile LAS unsigned* MISC = (volatile LAS unsigned*)(lds + MISC_OFF);
    const int tid = threadIdx.x, lane = tid & 63, wave = __builtin_amdgcn_readfirstlane(tid >> 6);
    const int G = gridDim.x, bx = blockIdx.x;
    const int gw = bx * NWAVES + wave, NGW = G * NWAVES;
    unsigned char* ws = args.ws;
    for (int u = tid; u < (LDS_BYTES - LDSCTL_OFF) / 4; u += NWAVES * 64) ((LAS unsigned*)(lds + LDSCTL_OFF))[u] = 0u;
    __syncthreads();
    const int lo = args.ph_lo, hi = args.ph_hi;
    XcdBarrier bar; bar.bar = (unsigned*)(ws + WS_CTL) + CW_BAR; bar.x = 0; bar.st = nullptr;
    if (hi - lo > 1) bar = xcd_barrier_post((unsigned*)(ws + WS_CTL) + CW_BAR, MISC + 8);
#define IN(k) (lo <= (k) && (k) < hi)
#define SEAM(k) do { if (IN((k) + 1)) xcd_barrier(bar); } while (0)
    float* mod = (float*)(ws + WS_MOD);
    bf16* XL = (bf16*)(ws + WS_XL); bf16* XC = (bf16*)(ws + WS_XC);
    bf16* H = (bf16*)(ws + WS_H);

    if (IN(0)) {
        for (int u = bx; u < 192; u += G) { if (args.sub & 1) p0_adaln(args, u, lds, tid, wave, lane); }
        if (args.sub & 4) p0_convert(args, lds, gw, NGW, wave, lane);
        SEAM(0);
    }
    if (IN(1)) {
        { const float* modp = (const float*)(ws + WS_MODP);
          for (int i = bx * (NWAVES * 64) + tid; i < MOD_N; i += G * NWAVES * 64) mod[i] = ((modp[i] + modp[MOD_N + i]) + modp[2 * MOD_N + i]) + modp[3 * MOD_N + i]; }
        { const float* modp = (const float*)(ws + WS_MODP); LAS float* ms = (LAS float*)lds;
          for (int i = tid; i < 9 * 2048; i += NWAVES * 64) { const int r = i >> 11, o = r * 6144 + (i & 2047); ms[i] = ((modp[o] + modp[MOD_N + o]) + modp[2 * MOD_N + o]) + modp[3 * MOD_N + o]; }
          __syncthreads(); norm_rows_lds(args.in[I_X], args.in[I_CTX], MT, args.in[I_N1G], ms, H, (float*)(ws + WS_ROWFAC1), gw, NGW, lane); }
        quant_rows_inplace_p((bf16*)(ws + WS_WIN), (const float*)(ws + WS_PMAX), (float*)(ws + WS_COLSCD), MIXIN, gw, NGW, lane);
        quant_rows_inplace_p((bf16*)(ws + WS_W13), (const float*)(ws + WS_PMAX) + MIXIN * 16, (float*)(ws + WS_COLSCD) + MIXIN, 2 * FFN, gw, NGW, lane);
        quant_rows_f8_1k((bf16*)(ws + WS_SOUT), (float*)(ws + WS_COLSCS), 2 * D, gw, NGW, lane);
        SEAM(1); }
    if (IN(2)) {
        pg8::Gemm g{H, (const bf16*)(ws + WS_WIN), MT, MIXIN, D / 2, D / 2, D}; pg8::StaticOrder S; S.init(MT, MIXIN, G, bx);
        pg8::EpiQKVUq E{(bf16*)(ws + WS_QKVU), args.in[I_QG], args.in[I_KG], EPS, (const float*)(ws + WS_ROWFAC1), (const float*)(ws + WS_COLSCD)};
        pg8::gemm_phase<pg8::EpiQKVUq, pg8::StaticOrder, true, true>(lds + RING_OFF, g, S, E);
        SEAM(2);
    }
    if (IN(3)) {
        const bf16* QKVU = (const bf16*)(ws + WS_QKVU); bf16* MIX = (bf16*)(ws + WS_MIX);
        LAS float* rpbl = (LAS float*)(lds + 40960); LAS float* cv = (LAS float*)(lds + 57344);
        float mq = 0.f, mk = 0.f, mb = 0.f;
        mq = fabsf(args.in[I_QG][lane]); mk = fabsf(args.in[I_KG][lane]);
        for (int i = lane; i < 8 * 465; i += 64) mb = fmaxf(mb, fabsf(args.in[I_RPB][i]));
        const float bnd = (8.2f * wave_max(mq) * wave_max(mk) + wave_max(mb)) * 1.44269504f;
        for (int i = tid; i < 8 * 465; i += NWAVES * 64) rpbl[i] = args.in[I_RPB][i] * 1.44269504f - bnd;
        __syncthreads();
        const int nbw = (G % 8 == 0) ? G / 8 : G, xb0 = (G % 8 == 0) ? (bx & 7) : 0, xbn = (G % 8 == 0) ? xb0 + 1 : 8, j0 = (G % 8 == 0) ? (bx >> 3) : bx;
        for (int x = xb0; x < xbn; ++x)
            for (int k = j0; k < 128; k += nbw) {
                if (k < 36) {
                    if (!(args.sub & (k < 32 ? 8 : 16))) continue;
                    const int wu = k < 32 ? (x * 32 + k) * 8 + wave : 2048 + (x * 4 + (k - 32)) * 8 + wave;
                    attn_unit(QKVU, MIX, wu, lds + wave * 5120, lds + 57344 + wave * 8192, rpbl, bnd, lane);
                } else {
                    if (!(args.sub & 32)) continue;
                    const int ci = k < 64 ? k - 36 : (k < 96 ? k - 36 : (k >= 100 && k < 112 ? k - 40 : -1)); if (ci < 0) continue;
                    conv_item(args, QKVU, MIX, ci < 64 ? x * 64 + ci : 512 + x * 8 + (ci - 64), cv, tid, wave, lane);
                }
            }
        SEAM(3);
    }
    if (IN(4)) {
        pg8::Gemm g{(const bf16*)(ws + WS_MIX), (const bf16*)(ws + WS_WOUT), MT, D, D, D, D}; pg8::StaticOrder S; S.init(MT, D, G, bx);
        pg8::EpiResidN<true> E{args.in[I_X], args.in[I_CTX], XL, XC, mod + 2 * 1024, H, (float*)(ws + WS_ROWSS), args.in[I_N2G], mod + 4 * 1024};
        pg8::gemm_phase<pg8::EpiResidN<true>, pg8::StaticOrder, true, true>(lds + RING_OFF, g, S, E);
        {
            const int nun = (MT / 256) * (D / 256), rounds = (nun + G - 1) / G, nlast = nun - (rounds - 1) * G, nidle = G - nlast, ii = bx - nlast;
            if (ii >= 0) {
                if (args.sub & 2) for (int u = ii; u < 128; u += nidle) p0_s5gen(args, u >> 1, u & 1, lds, tid);
                const bool cvw = (nidle > 128) ? (ii >= 128) : true;
                const int cw = (nidle > 128) ? (ii - 128) * NWAVES + wave : ii * NWAVES + wave, cn = (nidle > 128) ? (nidle - 128) * NWAVES : nidle * NWAVES;
                if (cvw) {
                    shw_rows((const bf16*)(ws + WS_W13), 2 * FFN, mod + 3 * 1024, (float*)(ws + WS_SHW13), cw, cn, lds, tid, lane, (const float*)(ws + WS_COLSCD) + MIXIN);
                    shw_rows((const bf16*)(ws + WS_SIN), D, mod + 9 * 6144, (float*)(ws + WS_SHWS), cw, cn, lds, tid, lane);
                    moe_convert(args, lds, 0, CVQ4, (nidle > 128) ? ii - 128 : ii, (nidle > 128) ? nidle - 128 : nidle, tid, wave, lane); }
            }
            if (nidle <= 0) { for (int u = bx; u < 128; u += G) p0_s5gen(args, u >> 1, u & 1, lds, tid);
                shw_rows((const bf16*)(ws + WS_W13), 2 * FFN, mod + 3 * 1024, (float*)(ws + WS_SHW13), gw, NGW, lds, tid, lane, (const float*)(ws + WS_COLSCD) + MIXIN); shw_rows((const bf16*)(ws + WS_SIN), D, mod + 9 * 6144, (float*)(ws + WS_SHWS), gw, NGW, lds, tid, lane);
                moe_convert(args, lds, 0, CVQ4, bx, G, tid, wave, lane); }
        }
        SEAM(4);
    }
    if (IN(5)) { quant_act_rows(H, (const float*)(ws + WS_ROWSS), (float*)(ws + WS_ROWFAC1), MT, gw, NGW, lane); SEAM(5); }
    if (IN(6)) {
        pg8::Gemm g{H, (const bf16*)(ws + WS_W13), MT, 2 * FFN, D / 2, D, D}; pg8::StaticOrder S; S.init(MT, 2 * FFN, G, bx);
        LAS float* rt = (LAS float*)(lds + RING_BYTES); pg8::rowfac_prepass(S, (const float*)(ws + WS_ROWFAC1), rt, tid);
        pg8::EpiSwiGLUNq E{(bf16*)(ws + WS_ACT), FFN, rt, (const float*)(ws + WS_SHW13), 2 * FFN, (const float*)(ws + WS_COLSCD) + MIXIN};
        pg8::gemm_phase<pg8::EpiSwiGLUNq, pg8::StaticOrder, true, true>(lds + RING_OFF, g, S, E);
        TAIL_CONVERT((MT / 256) * (2 * FFN / 256), CVQ4, CVQ6);
        SEAM(6);
    }
    if (IN(7)) {
        pg8::Gemm g{(const bf16*)(ws + WS_ACT), (const bf16*)(ws + WS_W2), MT, D, FFN, FFN, FFN}; pg8::StaticOrder S; S.init(MT, D, G, bx);
        pg8::EpiResidN<false> E{XL, XC, XL, XC, mod + 5 * 1024, H, (float*)(ws + WS_ROWSS), args.in[I_N1G] + D, mod + 9 * 6144 + 1 * 1024};
        pg8::gemm_phase<pg8::EpiResidN<false>, pg8::StaticOrder, true, true>(lds + RING_OFF, g, S, E);
        TAIL_CONVERT((MT / 256) * (D / 256), CVQ4 + CVQ6, CVQ7);
        SEAM(7);
    }
    float* mod1 = mod + 9 * 6144;
    if (IN(8)) {
        pg8::Gemm g{H, (const bf16*)(ws + WS_SIN), MT, D, D, D, D}; pg8::StaticOrder S; S.init(MT, D, G, bx);
        LAS float* rt = (LAS float*)(lds + RING_BYTES); pg8::rstd_prepass(S, (const float*)(ws + WS_ROWSS), rt, EPS, tid);
        pg8::EpiUC E{(bf16*)(ws + WS_UC), rt, (const float*)(ws + WS_SHWS)};
        pg8::gemm_phase<pg8::EpiUC, pg8::StaticOrder, true, true>(lds + RING_OFF, g, S, E);
        TAIL_CONVERT((MT / 256) * (D / 256), CVQ4 + CVQ6 + CVQ7, CVQ9);
        SEAM(8);
    }
    if (IN(9)) {
        pg8::Gemm g{(const bf16*)(ws + WS_UC), (const bf16*)(ws + WS_WEND), 64 * 768, 64 * 256, 512, 768, 512}; pg8::OrderS5E S{G, bx};
        pg8::EpiE E{(float*)(ws + WS_E)};
        pg8::gemm_phase<pg8::EpiE, pg8::OrderS5E, true, true>(lds + RING_OFF, g, S, E);
        if (G == 256) { if ((bx >> 3) >= 24) moe_convert(args, lds, CVQ4 + CVQ6 + CVQ7 + CVQ9, CVQS1, ((bx >> 3) - 24) * 8 + (bx & 7), 64, tid, wave, lane); }
        else moe_convert(args, lds, CVQ4 + CVQ6 + CVQ7 + CVQ9, CVQS1, bx, G, tid, wave, lane);
        SEAM(9);
    }
    if (IN(10)) { s5_scan(args, bx * (NWAVES * 64) + tid);
        if (G > 128) { if (bx >= 128) moe_convert(args, lds, CVQ4 + CVQ6 + CVQ7 + CVQ9 + CVQS1, CVQS2, bx - 128, G - 128, tid, wave, lane); }
        else moe_convert(args, lds, CVQ4 + CVQ6 + CVQ7 + CVQ9 + CVQS1, CVQS2, bx, G, tid, wave, lane);
        SEAM(10); }
    if (IN(11)) {
        pg8::Gemm g{(const bf16*)(ws + WS_UC), (const bf16*)(ws + WS_BTOUT), 64 * 768, 64 * 512, 768, 768, 768}; pg8::OrderS5Y S{G, bx};
        pg8::EpiY E{ws + WS_Y};
        pg8::gemm_phase<pg8::EpiY, pg8::OrderS5Y, true, true>(lds + RING_OFF, g, S, E);
        SEAM(11);
    }
    if (IN(12)) {
        pg8::Gemm g{(const bf16*)(ws + WS_Y), (const bf16*)(ws + WS_SOUT), ML, 2 * D, D / 2, D / 2, D}; pg8::StaticOrder S; S.init(ML, 2 * D, G, bx);
        pg8::EpiGLURes E{XL, mod1 + 2 * 1024, (const float*)(ws + WS_COLSCS)};
        pg8::gemm_phase<pg8::EpiGLURes, pg8::StaticOrder, true, true>(lds + RING_OFF, g, S, E);
        SEAM(12);
    }
    unsigned char* tok = ws + WS_TOK;
    if (IN(13)) {
        int* rowsrc = (int*)(tok + TOK_ROWSRC); int* rowinfo = (int*)(tok + TOK_ROWINFO); float* rowgate = (float*)(tok + TOK_ROWGATE);
        for (int i = bx * (NWAVES * 64) + tid; i < MOE_TILES * 256; i += G * NWAVES * 64) { rowsrc[i] = 0; rowinfo[i] = -1; rowgate[i] = 0.f; ((float*)(ws + WS_POSSC))[i] = 0.f; }
        for (int ch = bx; ch < ML / 64; ch += G) moe_route(args, XL, mod1, H, ch, (LAS unsigned*)lds, tid, wave, lane);
        SEAM(13);
    }
    if (IN(14)) {
        int toff[9]; moe_offsets(ws, toff);
        const int* tokE = (const int*)(tok + TOK_E); const float* tokW = (const float*)(tok + TOK_W); const int* tokRank = (const int*)(tok + TOK_RANK); const int* wgbase = (const int*)(tok + TOK_WGBASE);
        int* rowsrc = (int*)(tok + TOK_ROWSRC); int* rowinfo = (int*)(tok + TOK_ROWINFO); float* rowgate = (float*)(tok + TOK_ROWGATE); int* tokPos = (int*)(tok + TOK_POS);
        for (int i = bx * (NWAVES * 64) + tid; i < 2 * ML; i += G * NWAVES * 64) { const int t = i >> 1, e = tokE[i]; int to = 0;
#pragma unroll
            for (int q = 0; q < 8; ++q) to = (e == q) ? toff[q] : to;
            const int pos = to * 256 + wgbase[(t >> 6) * 8 + e] + tokRank[i];
            rowsrc[pos] = t; rowinfo[pos] = i; rowgate[pos] = tokW[i]; tokPos[i] = pos; ((float*)(ws + WS_POSSC))[pos] = ((const float*)(ws + WS_ROWSC))[t]; }
        quant_rows_f8_inplace((bf16*)(ws + WS_MW2), (float*)(ws + WS_COLSC2), NE * D, gw, NGW, lane);
        SEAM(14);
    }
    if (IN(15)) {
        pg8::OrderMoE S; S.G = G; S.c = bx; S.nN = 2 * ED / 256; S.tmax = 1 << 30; S.fix = (args.sub >> 7) & 1; moe_offsets(ws, S.toff);
        pg8::Gemm g{H, (const bf16*)(ws + WS_MW13), MOE_TILES * 256, NE * 2 * ED, D / 2, D / 2, D / 2, (const int*)(tok + TOK_ROWSRC)};
        pg8::EpiSwiGLUq E{ws + WS_ACTM, ED, 2 * ED / 256, (const float*)(ws + WS_POSSC), (const float*)(ws + WS_COLSC)};
        pg8::gemm_phase<pg8::EpiSwiGLUq, pg8::OrderMoE, true, true, true>(lds + RING_OFF, g, S, E);
        SEAM(15);
    }
    if (IN(16)) {
        pg8::OrderMoE S; S.G = G; S.c = bx; S.nN = D / 256; S.tmax = 128; S.fix = 0; moe_offsets(ws, S.toff);
        pg8::Gemm g{(const bf16*)(ws + WS_ACTM), (const bf16*)(ws + WS_MW2), MOE_TILES * 256, NE * D, ED / 2, ED / 2, ED};
        pg8::EpiMoE2 E{(bf16*)args.out, (const float*)(tok + TOK_ROWGATE), (const int*)(tok + TOK_ROWINFO), (const float*)(ws + WS_COLSC2)};
        pg8::gemm_phase<pg8::EpiMoE2, pg8::OrderMoE, true, true>(lds + RING_OFF, g, S, E);
        pg8::OrderMoEx Sx; Sx.G = G; Sx.c = bx; moe_offsets(ws, Sx.toff);
        pg8::Gemm gx{(const bf16*)(ws + WS_ACTM), (const bf16*)(ws + WS_MW2), MOE_TILES * 256, NE * D, 512, ED / 2, ED};
        pg8::EpiMoE2x Ex{(float*)(ws + WS_PX), (const float*)(tok + TOK_ROWGATE), (const float*)(ws + WS_COLSC2)};
        pg8::gemm_phase<pg8::EpiMoE2x, pg8::OrderMoEx, true, false>(lds + RING_OFF, gx, Sx, Ex);
        SEAM(16);
    }
    if (IN(17)) {
        const unsigned bad = __hip_atomic_load((unsigned*)(ws + WS_CTL) + CW_BAR + XB_TMO, RLX_AGENT);
        const int* tokPos = (const int*)(tok + TOK_POS); const float* PX = (const float*)(ws + WS_PX);
        for (int tb = gw; tb < ML; tb += 2 * NGW) {
            const int tt[2] = {tb, (tb + NGW < ML) ? tb + NGW : tb}; const int ntk = (tb + NGW < ML) ? 2 : 1;
            v2u a[2][4], b[2][4], xw[2][4]; f32x4 gv[2][4]; int p0[2], p1[2];
#pragma unroll
            for (int u = 0; u < 2; ++u) { const int t = tt[u]; const bf16* y0 = (const bf16*)(args.out + (size_t)t * D); const bf16* y1 = y0 + D; const float* gp = mod1 + (size_t)(t >> 11) * 6144 + 5 * 1024;
                p0[u] = tokPos[2 * t] - 128 * 256; p1[u] = tokPos[2 * t + 1] - 128 * 256;
#pragma unroll
                for (int j = 0; j < 4; ++j) { const int c = 4 * lane + 256 * j; a[u][j] = *(const v2u*)(y0 + c); b[u][j] = *(const v2u*)(y1 + c); xw[u][j] = *(const v2u*)(XL + (size_t)t * D + c); gv[u][j] = *(const f32x4*)(gp + c); } }
            asm volatile("s_waitcnt vmcnt(0)" ::: "memory");
#pragma unroll
            for (int u = 0; u < 2; ++u) { if (u < ntk) { const int t = tt[u];
#pragma unroll
                for (int j = 0; j < 4; ++j) { const int c = 4 * lane + 256 * j;
                    f32x4 ya = (f32x4){bflo(a[u][j].x), bfhi(a[u][j].x), bflo(a[u][j].y), bfhi(a[u][j].y)}, yb = (f32x4){bflo(b[u][j].x), bfhi(b[u][j].x), bflo(b[u][j].y), bfhi(b[u][j].y)};
                    if (p0[u] >= 0) { const float* q = PX + (size_t)p0[u] * D + c; ya = ((*(const f32x4*)q + *(const f32x4*)(q + (size_t)2048 * D)) + *(const f32x4*)(q + (size_t)4096 * D)) + *(const f32x4*)(q + (size_t)6144 * D); }
                    if (p1[u] >= 0) { const float* q = PX + (size_t)p1[u] * D + c; yb = ((*(const f32x4*)q + *(const f32x4*)(q + (size_t)2048 * D)) + *(const f32x4*)(q + (size_t)4096 * D)) + *(const f32x4*)(q + (size_t)6144 * D); }
                    const f32x4 xv = (f32x4){bflo(xw[u][j].x), bfhi(xw[u][j].x), bflo(xw[u][j].y), bfhi(xw[u][j].y)};
                    f32x4 o = xv + gv[u][j] * (ya + yb); if (bad) o = (f32x4){__builtin_nanf(""), __builtin_nanf(""), __builtin_nanf(""), __builtin_nanf("")};
                    *(f32x4*)(args.out + (size_t)t * D + c) = o; } } }
        }
    }
#undef IN
#undef SEAM
}

extern "C" void kernel_launch(void* const* d_in, const int* in_sizes, int n_in, void* d_out, int out_size, void* d_ws, size_t ws_size, hipStream_t stream) {
    static int grid = 0;
    if (grid == 0) {
        if (n_in != N_IN || out_size != ML * D || ws_size < WS_END) { fprintf(stderr, "kernel_launch: unexpected problem (n_in %d, out %d, ws %zu); nothing launched\n", n_in, out_size, ws_size); grid = -1; return; }
        int dev = 0, cus = 0, per_cu = 0;
        if (hipGetDevice(&dev) != hipSuccess || hipDeviceGetAttribute(&cus, hipDeviceAttributeMultiprocessorCount, dev) != hipSuccess) { grid = -1; return; }
        if (hipFuncSetAttribute((const void*)fwd_kernel, hipFuncAttributeMaxDynamicSharedMemorySize, LDS_BYTES) != hipSuccess) { fprintf(stderr, "kernel_launch: hipFuncSetAttribute failed\n"); grid = -1; return; }
        if (hipOccupancyMaxActiveBlocksPerMultiprocessor(&per_cu, (const void*)fwd_kernel, NWAVES * 64, LDS_BYTES) != hipSuccess || per_cu < 1) { fprintf(stderr, "kernel_launch: occupancy query says %d blocks per CU\n", per_cu); (void)hipGetLastError(); grid = -1; return; }
        grid = cus;
    }
    if (grid < 0) return;
    if (hipMemsetAsync((char*)d_ws + WS_CTL, 0, CTL_ZERO_BYTES, stream) != hipSuccess) return;
    Args a{};
    for (int i = 0; i < N_IN; ++i) a.in[i] = (const float*)d_in[i];
    a.out = (float*)d_out; a.ws = (unsigned char*)d_ws; a.sub = 63;
#if MK_N_LAUNCHES == 1
    a.ph_lo = 0; a.ph_hi = NPHASE;
    hipLaunchKernelGGL(fwd_kernel, dim3(grid), dim3(NWAVES * 64), LDS_BYTES, stream, a);
#else
    for (int p = 0; p < NPHASE; ++p) { const int nrep = ((MK_REPEAT_MASK >> p) & 1u) ? 2 : 1;
        for (int r = 0; r < nrep; ++r) { a.ph_lo = p; a.ph_hi = p + 1; a.sub = (r == 0) ? 63 : MK_REPEAT_SUB; hipLaunchKernelGGL(fwd_kernel, dim3(grid), dim3(NWAVES * 64), LDS_BYTES, stream, a); } }
#endif
}
```

```cpp
#include <hip/hip_runtime.h>
#include <cstdio>
#include <cstdint>
#ifndef MK_N_LAUNCHES
#define MK_N_LAUNCHES 1
#endif
#ifndef MK_REPEAT_SUB
#define MK_REPEAT_SUB 63
#endif
#ifndef MK_REPEAT_MASK
#define MK_REPEAT_MASK 0u
#endif
namespace pg8 {
#define PG8_LAS __attribute__((address_space(3)))
typedef unsigned short bf16_t;
typedef short bf16x8 __attribute__((ext_vector_type(8)));
typedef float f32x4 __attribute__((ext_vector_type(4)));
typedef unsigned u32x4 __attribute__((ext_vector_type(4)));
typedef unsigned u32x2 __attribute__((ext_vector_type(2)));
typedef int i32x4 __attribute__((ext_vector_type(4)));
__device__ __forceinline__ f32x4 mma16(bf16x8 a, bf16x8 b, f32x4 c) { return __builtin_amdgcn_mfma_f32_16x16x32_bf16(a, b, c, 0, 0, 0); }
__device__ __forceinline__ i32x4 mma16(bf16x8 a, bf16x8 b, i32x4 c) { return __builtin_amdgcn_mfma_i32_16x16x64_i8(__builtin_bit_cast(i32x4, a), __builtin_bit_cast(i32x4, b), c, 0, 0, 0); }
typedef int i32x8 __attribute__((ext_vector_type(8)));
template <class T, class = void> struct is_fp8 { static constexpr bool v = false; };
template <class T> struct is_fp8<T, decltype((void)T::FP8)> { static constexpr bool v = T::FP8; };
template <bool FP8> struct Frag { bf16x8 k0, k1;
    __device__ __forceinline__ void set(int k, bf16x8 x) { if (k == 0) k0 = x; else k1 = x; } };
template <> struct Frag<true> { i32x8 v;
    __device__ __forceinline__ void set(int k, bf16x8 x) { if (k == 0) v.lo = __builtin_bit_cast(i32x4, x); else v.hi = __builtin_bit_cast(i32x4, x); } };
template <class ACC> __device__ __forceinline__ ACC mma_frag(const Frag<false>& a, const Frag<false>& b, ACC c) { c = mma16(a.k0, b.k0, c); return mma16(a.k1, b.k1, c); }
__device__ __forceinline__ f32x4 mma_frag(const Frag<true>& a, const Frag<true>& b, f32x4 c) { asm volatile("v_mfma_f32_16x16x128_f8f6f4 %0, %1, %2, %0" : "+v"(c) : "v"(a.v), "v"(b.v)); return c; }
template <bool FP8> __device__ __forceinline__ void mma_drain() { if constexpr (FP8) asm volatile("s_nop 15\n\ts_nop 15" ::: "memory"); }
constexpr int BM = 256, BK = 64, HALF = 128, HTB = HALF * BK * 2  , STAGE_BYTES = 8 * HTB, NXCD = 8, WGM = 8;

__host__ __device__ __forceinline__ int lds_byte(int r, int c) { const int st = (r >> 4) * 2 + (c >> 5), rr = r & 15, cc = c & 31, ob = rr * 64 + cc * 2; return st * 1024 + (ob ^ (((ob >> 9) & 1) << 5)); }
__host__ __device__ __forceinline__ void stage_rc(int b, int& R, int& C) { const int st = b / 1024, sb = b % 1024, swz = sb ^ (((sb >> 9) & 1) << 5); R = (st >> 1) * 16 + swz / 64; C = (st & 1) * 32 + (swz % 64) / 2; }
__host__ __device__ __forceinline__ int perm32(int rho) { const int n = rho >> 4, i = rho & 15; return 8 * (i >> 2) + 4 * n + (i & 3); }

struct Unit { int pm, pn, k0, idx; };
struct Gemm { const bf16_t* A; const bf16_t* Bt; int M, N, K, lda, ldb; const int* rowsrc; };

struct StaticOrder {
    static constexpr bool VARK = false;
    int nM, nN, nwg, G, c;
    __host__ __device__ void init(int M, int N, int G_, int c_) { nM = M / BM; nN = N / BM; nwg = nM * nN; G = G_; c = c_; }
    __host__ __device__ bool next(int i, Unit& u) const {
        const long L = (long)i * G + c; if (L >= nwg) return false;
        int wgid = (int)L; { const int q = nwg / NXCD, r = nwg % NXCD, xcd = wgid % NXCD, off = wgid / NXCD; wgid = (xcd < r ? xcd * (q + 1) : r * (q + 1) + (xcd - r) * q) + off; }
        const int nig = WGM * nN, gid = wgid / nig, fm = gid * WGM, gsz = (nM - fm) < WGM ? (nM - fm) : WGM;
        u.pm = fm + ((wgid % nig) % gsz); u.pn = (wgid % nig) / gsz; u.k0 = 0; u.idx = i; return true;
    }
    __device__ __forceinline__ void a_ready(const Unit&) const {}
    __device__ __forceinline__ void done(const Unit&) const {}
};

constexpr int ML_ = 16384, MC_ = 2048, MT_ = ML_ + MC_, DM_ = 1024;
__device__ __forceinline__ unsigned cvt_pk_bf16(float lo, float hi) { unsigned r; asm volatile("v_cvt_pk_bf16_f32 %0, %1, %2" : "=v"(r) : "v"(lo), "v"(hi)); return r; }
__device__ __forceinline__ float sigm(float x) { return __builtin_amdgcn_rcpf(1.0f + __expf(-x)); }
__device__ __forceinline__ float sigm2(float xl) { return __builtin_amdgcn_rcpf(1.0f + __builtin_amdgcn_exp2f(-xl)); }
__device__ __forceinline__ float gelu_tanh(float x) { const float u = 1.5957691216f * (x + 0.044715f * x * x * x); return x * sigm(u); }
__device__ __forceinline__ unsigned f8pack4(const f32x4 v) { int w = 0;
    w = __builtin_amdgcn_cvt_pk_fp8_f32(__builtin_amdgcn_fmed3f(v[0], -448.f, 448.f), __builtin_amdgcn_fmed3f(v[1], -448.f, 448.f), w, false);
    w = __builtin_amdgcn_cvt_pk_fp8_f32(__builtin_amdgcn_fmed3f(v[2], -448.f, 448.f), __builtin_amdgcn_fmed3f(v[3], -448.f, 448.f), w, true); return (unsigned)w; }
__device__ __forceinline__ u32x4 pack8(const f32x4 a, const f32x4 b) { u32x4 w; w.x = cvt_pk_bf16(a[0], a[1]); w.y = cvt_pk_bf16(a[2], a[3]); w.z = cvt_pk_bf16(b[0], b[1]); w.w = cvt_pk_bf16(b[2], b[3]); return w; }


struct EpiQKVU {
    typedef f32x4 acc_t; static constexpr bool PERM = true, AFTER_DRAIN = false;
    bf16_t* O; const float* gq; const float* gk; float eps;
    __device__ __forceinline__ void operator()(const f32x4 (&acc)[2][2][4][2], const Unit& u, int wr, int wc, int fr, int fq) const {
        const int row0 = u.pm * BM + wr * 64 + fr; const int pn = u.pn;
        if (pn < 6) {
            const bool nrm = pn < 4; const float* gp = (pn < 2) ? gq : gk;
            f32x4 gn[2][2];
#pragma unroll
            for (int bj = 0; bj < 2; ++bj)
#pragma unroll
                for (int n = 0; n < 2; ++n) gn[bj][n] = nrm ? *(const f32x4*)(gp + 32 * bj + 8 * fq + 4 * n) : (f32x4){1.f, 1.f, 1.f, 1.f};
#pragma unroll
            for (int ai = 0; ai < 2; ++ai)
#pragma unroll
                for (int m = 0; m < 4; ++m) {
                    float sc = 1.f;
                    if (nrm) { float ss = 0.f;
#pragma unroll
                        for (int bj = 0; bj < 2; ++bj)
#pragma unroll
                            for (int n = 0; n < 2; ++n) { const f32x4 x = acc[ai][bj][m][n]; ss += (x[0] * x[0] + x[1] * x[1]) + (x[2] * x[2] + x[3] * x[3]); }
                        ss += __shfl_xor(ss, 16); ss += __shfl_xor(ss, 32);
                        sc = rsqrtf(ss * (1.0f / 64.0f) + eps); }
                    bf16_t* rowp = O + (size_t)(row0 + ai * HALF + m * 16) * 2048 + 256 * pn + 64 * wc + 8 * fq;
#pragma unroll
                    for (int bj = 0; bj < 2; ++bj) { const f32x4 v0 = acc[ai][bj][m][0] * gn[bj][0] * sc, v1 = acc[ai][bj][m][1] * gn[bj][1] * sc; *(u32x4*)(rowp + 32 * bj) = pack8(v0, v1); }
                }
        } else {
            const int cb = 1536 + 128 * (pn - 6) + 32 * wc + 8 * fq;
#pragma unroll
            for (int ai = 0; ai < 2; ++ai)
#pragma unroll
                for (int m = 0; m < 4; ++m) {
                    f32x4 v[2];
#pragma unroll
                    for (int n = 0; n < 2; ++n) { const f32x4 a = acc[ai][0][m][n], g = acc[ai][1][m][n]; v[n] = (f32x4){a[0] * sigm(g[0]), a[1] * sigm(g[1]), a[2] * sigm(g[2]), a[3] * sigm(g[3])}; }
                    *(u32x4*)(O + (size_t)(row0 + ai * HALF + m * 16) * 2048 + cb) = pack8(v[0], v[1]);
                }
        }
    }
};
struct EpiQKVUq {
    typedef i32x4 acc_t; static constexpr bool PERM = true, AFTER_DRAIN = false;
    bf16_t* O; const float* gq; const float* gk; float eps; const float* rowfac; const float* colscale;
    __device__ __forceinline__ void operator()(const i32x4 (&acc)[2][2][4][2], const Unit& u, int wr, int wc, int fr, int fq) const {
        const int row0 = u.pm * BM + wr * 64 + fr; const int pn = u.pn;
        f32x4 cs[2][2];
#pragma unroll
        for (int bj = 0; bj < 2; ++bj)
#pragma unroll
            for (int n = 0; n < 2; ++n) cs[bj][n] = *(const f32x4*)(colscale + pn * BM + bj * HALF + wc * 32 + 8 * fq + 4 * n);
        float rfv[8];
#pragma unroll
        for (int q = 0; q < 8; ++q) rfv[q] = rowfac[row0 + (q >> 2) * HALF + (q & 3) * 16];
#define QF(ai_, bj_, m_, n_, rf_) ((f32x4){(float)acc[ai_][bj_][m_][n_][0], (float)acc[ai_][bj_][m_][n_][1], (float)acc[ai_][bj_][m_][n_][2], (float)acc[ai_][bj_][m_][n_][3]} * cs[bj_][n_] * (rf_))
        if (pn < 6) {
            const bool nrm = pn < 4; const float* gp = (pn < 2) ? gq : gk;
            f32x4 gn[2][2];
#pragma unroll
            for (int bj = 0; bj < 2; ++bj)
#pragma unroll
                for (int n = 0; n < 2; ++n) gn[bj][n] = nrm ? *(const f32x4*)(gp + 32 * bj + 8 * fq + 4 * n) : (f32x4){1.f, 1.f, 1.f, 1.f};
#pragma unroll
            for (int ai = 0; ai < 2; ++ai)
#pragma unroll
                for (int m = 0; m < 4; ++m) {
                    float sc = 1.f; const float rf = rfv[ai * 4 + m];
                    f32x4 xf[2][2];
#pragma unroll
                    for (int bj = 0; bj < 2; ++bj)
#pragma unroll
                        for (int n = 0; n < 2; ++n) xf[bj][n] = QF(ai, bj, m, n, rf);
                    if (nrm) { float ss = 0.f;
#pragma unroll
                        for (int bj = 0; bj < 2; ++bj)
#pragma unroll
                            for (int n = 0; n < 2; ++n) { const f32x4 x = xf[bj][n]; ss += (x[0] * x[0] + x[1] * x[1]) + (x[2] * x[2] + x[3] * x[3]); }
                        ss += __shfl_xor(ss, 16); ss += __shfl_xor(ss, 32);
                        sc = rsqrtf(ss * (1.0f / 64.0f) + eps); }
                    bf16_t* rowp = O + (size_t)(row0 + ai * HALF + m * 16) * 2048 + 256 * pn + 64 * wc + 8 * fq;
#pragma unroll
                    for (int bj = 0; bj < 2; ++bj) { const f32x4 v0 = xf[bj][0] * gn[bj][0] * sc, v1 = xf[bj][1] * gn[bj][1] * sc; *(u32x4*)(rowp + 32 * bj) = pack8(v0, v1); }
                }
        } else {
            const int cb = 1536 + 128 * (pn - 6) + 32 * wc + 8 * fq;
#pragma unroll
            for (int ai = 0; ai < 2; ++ai)
#pragma unroll
                for (int m = 0; m < 4; ++m) { const float rf = rfv[ai * 4 + m];
                    f32x4 v[2];
#pragma unroll
                    for (int n = 0; n < 2; ++n) { const f32x4 a = QF(ai, 0, m, n, rf), g = QF(ai, 1, m, n, rf); v[n] = (f32x4){a[0] * sigm(g[0]), a[1] * sigm(g[1]), a[2] * sigm(g[2]), a[3] * sigm(g[3])}; }
                    *(u32x4*)(O + (size_t)(row0 + ai * HALF + m * 16) * 2048 + cb) = pack8(v[0], v[1]);
                }
        }
    }
};
#undef QF
struct EpiResid {
    typedef f32x4 acc_t; static constexpr bool PERM = false, AFTER_DRAIN = false;
    const float* baseL; const float* baseC; float* XL; float* XC; const float* gate;
    __device__ __forceinline__ void operator()(const f32x4 (&acc)[2][2][4][2], const Unit& u, int wr, int wc, int fr, int fq) const {
        const int R0 = u.pm * BM, row0 = R0 + wr * 64 + fr, col0 = u.pn * BM + wc * 32 + 4 * fq;
        const int modrow = R0 < ML_ ? (R0 >> 11) : 8;
        const float* gp = gate + (size_t)modrow * 6144 + col0;
        const float* bp = R0 < ML_ ? baseL : baseC - (size_t)ML_ * DM_;
        float* xo = R0 < ML_ ? XL : XC - (size_t)ML_ * DM_;
        f32x4 gv[2][2];
#pragma unroll
        for (int bj = 0; bj < 2; ++bj)
#pragma unroll
            for (int n = 0; n < 2; ++n) gv[bj][n] = *(const f32x4*)(gp + bj * HALF + n * 16);
#pragma unroll
        for (int ai = 0; ai < 2; ++ai)
#pragma unroll
            for (int m = 0; m < 4; ++m) { const size_t ro = (size_t)(row0 + ai * HALF + m * 16) * DM_ + col0;
#pragma unroll
                for (int bj = 0; bj < 2; ++bj)
#pragma unroll
                    for (int n = 0; n < 2; ++n) { const f32x4 xv = *(const f32x4*)(bp + ro + bj * HALF + n * 16); *(f32x4*)(xo + ro + bj * HALF + n * 16) = xv + gv[bj][n] * acc[ai][bj][m][n]; } }
    }
};
__device__ __forceinline__ void unpack8(const u32x4 w, f32x4& a, f32x4& b) {
    a = (f32x4){__builtin_bit_cast(float, w.x << 16), __builtin_bit_cast(float, w.x & 0xffff0000u), __builtin_bit_cast(float, w.y << 16), __builtin_bit_cast(float, w.y & 0xffff0000u)};
    b = (f32x4){__builtin_bit_cast(float, w.z << 16), __builtin_bit_cast(float, w.z & 0xffff0000u), __builtin_bit_cast(float, w.w << 16), __builtin_bit_cast(float, w.w & 0xffff0000u)}; }
template <bool BASE_F32, bool WRITE_H = true> struct EpiResidN {
    typedef f32x4 acc_t; static constexpr bool PERM = true, AFTER_DRAIN = false;
    const void* baseL; const void* baseC; bf16_t* XL; bf16_t* XC; const float* gate; bf16_t* Hn; float* rowss; const float* ngain; const float* nscale;
    __device__ __forceinline__ void operator()(const f32x4 (&acc)[2][2][4][2], const Unit& u, int wr, int wc, int fr, int fq) const {
        const int R0 = u.pm * BM, row0 = R0 + wr * 64 + fr, col0 = u.pn * BM + wc * 32 + 8 * fq;
        const int modrow = R0 < ML_ ? (R0 >> 11) : 8, rsub = R0 < ML_ ? 0 : ML_;
        const float* gp = gate + (size_t)modrow * 6144 + col0; const float* sp = nscale + (size_t)modrow * 6144 + col0;
        const void* bp = R0 < ML_ ? baseL : baseC; bf16_t* xo = R0 < ML_ ? XL : XC;
        f32x4 gv[2][2], gs[2][2];
#pragma unroll
        for (int bj = 0; bj < 2; ++bj)
#pragma unroll
            for (int n = 0; n < 2; ++n) { gv[bj][n] = *(const f32x4*)(gp + bj * HALF + n * 4); gs[bj][n] = *(const f32x4*)(ngain + col0 + bj * HALF + n * 4) * (*(const f32x4*)(sp + bj * HALF + n * 4) + 1.0f); }
#pragma unroll
        for (int ai = 0; ai < 2; ++ai) {
            f32x4 xb0[4][2], xb1[4][2];
#pragma unroll
            for (int m = 0; m < 4; ++m) { const size_t ro = (size_t)(row0 + ai * HALF + m * 16 - rsub) * DM_ + col0;
#pragma unroll
                for (int bj = 0; bj < 2; ++bj) {
                    if constexpr (BASE_F32) { xb0[m][bj] = *(const f32x4*)((const float*)bp + ro + bj * HALF); xb1[m][bj] = *(const f32x4*)((const float*)bp + ro + bj * HALF + 4); }
                    else unpack8(*(const u32x4*)((const bf16_t*)bp + ro + bj * HALF), xb0[m][bj], xb1[m][bj]); } }
#pragma unroll
            for (int m = 0; m < 4; ++m) { const int row = row0 + ai * HALF + m * 16; const size_t ro = (size_t)(row - rsub) * DM_ + col0; float ss = 0.f;
#pragma unroll
                for (int bj = 0; bj < 2; ++bj) { const f32x4 x0 = xb0[m][bj], x1 = xb1[m][bj];
                    const u32x4 xw = pack8(x0 + gv[bj][0] * acc[ai][bj][m][0], x1 + gv[bj][1] * acc[ai][bj][m][1]); *(u32x4*)(xo + ro + bj * HALF) = xw;
                    f32x4 r0, r1; unpack8(xw, r0, r1);
                    ss += ((r0[0] * r0[0] + r0[1] * r0[1]) + (r0[2] * r0[2] + r0[3] * r0[3])) + ((r1[0] * r1[0] + r1[1] * r1[1]) + (r1[2] * r1[2] + r1[3] * r1[3]));
                    if constexpr (WRITE_H) *(u32x4*)(Hn + (size_t)row * DM_ + col0 + bj * HALF) = pack8(r0 * gs[bj][0], r1 * gs[bj][1]); }
                ss += __shfl_xor(ss, 16); ss += __shfl_xor(ss, 32);
                if (fq == 0) rowss[(size_t)row * 16 + u.pn * 4 + wc] = ss; }
        }
    }
};
__device__ __forceinline__ float row_rstd(const float* rowss, int row, float eps) {
    const f32x4* p = (const f32x4*)(rowss + (size_t)row * 16); const f32x4 a = p[0], b = p[1], c = p[2], d = p[3];
    const float s = (((a[0] + a[1]) + (a[2] + a[3])) + ((b[0] + b[1]) + (b[2] + b[3]))) + (((c[0] + c[1]) + (c[2] + c[3])) + ((d[0] + d[1]) + (d[2] + d[3])));
    return rsqrtf(s * (1.0f / 1024.0f) + eps); }
template <class Sched> __device__ __forceinline__ void rstd_prepass(const Sched& S, const float* rowss, PG8_LAS float* rt, float eps, int tid) {
    Unit u; int n = 0; while (n < 8 && S.next(n, u)) ++n;
#pragma unroll
    for (int q = 0; q < 4; ++q) { const int r = tid + 512 * q, i = r >> 8;
        if (i < n) { S.next(i, u); rt[r] = row_rstd(rowss, u.pm * BM + (r & 255), eps); } }
    __syncthreads();
}
struct EpiSwiGLUN {
    typedef f32x4 acc_t; static constexpr bool PERM = true, AFTER_DRAIN = false;
    bf16_t* O; int ldo; const PG8_LAS float* rt; const float* shw; int nphys;
    __device__ __forceinline__ void operator()(const f32x4 (&acc)[2][2][4][2], const Unit& u, int wr, int wc, int fr, int fq) const {
        const int R0 = u.pm * BM, row0 = R0 + wr * 64 + fr, colp = u.pn * BM + wc * 32 + 8 * fq, col0 = u.pn * HALF + wc * 32 + 8 * fq;
        const float* sp = shw + (size_t)(R0 < ML_ ? (R0 >> 11) : 8) * nphys + colp;
        f32x4 s1[2], s3[2];
#pragma unroll
        for (int n = 0; n < 2; ++n) { s1[n] = *(const f32x4*)(sp + 4 * n); s3[n] = *(const f32x4*)(sp + HALF + 4 * n); }
#pragma unroll
        for (int ai = 0; ai < 2; ++ai)
#pragma unroll
            for (int m = 0; m < 4; ++m) { const int row = row0 + ai * HALF + m * 16; const float rs = rt[u.idx * BM + (row - R0)];
                f32x4 v[2];
#pragma unroll
                for (int n = 0; n < 2; ++n) { const f32x4 a = acc[ai][0][m][n] * rs + s1[n], b = acc[ai][1][m][n] * rs + s3[n]; v[n] = (f32x4){a[0] * sigm(a[0]) * b[0], a[1] * sigm(a[1]) * b[1], a[2] * sigm(a[2]) * b[2], a[3] * sigm(a[3]) * b[3]}; }
                *(u32x4*)(O + (size_t)row * ldo + col0) = pack8(v[0], v[1]);
            }
    }
};
struct EpiSwiGLU {
    typedef f32x4 acc_t; static constexpr bool PERM = true, AFTER_DRAIN = false;
    bf16_t* O; int ldo, nN, row_sub; int skip;
    __device__ __forceinline__ void operator()(const f32x4 (&acc)[2][2][4][2], const Unit& u, int wr, int wc, int fr, int fq) const {
        if (skip) {
#pragma unroll
            for (int ai = 0; ai < 2; ++ai)
#pragma unroll
                for (int bj = 0; bj < 2; ++bj)
#pragma unroll
                    for (int m = 0; m < 4; ++m)
#pragma unroll
                        for (int n = 0; n < 2; ++n) asm volatile("" :: "v"(acc[ai][bj][m][n]));
            return; }
        const int row0 = u.pm * BM + wr * 64 + fr - row_sub, col0 = (u.pn % nN) * HALF + wc * 32 + 8 * fq;
#pragma unroll
        for (int ai = 0; ai < 2; ++ai)
#pragma unroll
            for (int m = 0; m < 4; ++m) {
                f32x4 v[2];
#pragma unroll
                for (int n = 0; n < 2; ++n) { const f32x4 a = acc[ai][0][m][n], b = acc[ai][1][m][n]; v[n] = (f32x4){a[0] * sigm(a[0]) * b[0], a[1] * sigm(a[1]) * b[1], a[2] * sigm(a[2]) * b[2], a[3] * sigm(a[3]) * b[3]}; }
                *(u32x4*)(O + (size_t)(row0 + ai * HALF + m * 16) * ldo + col0) = pack8(v[0], v[1]);
            }
    }
};
template <class Sched> __device__ __forceinline__ void rowfac_prepass(const Sched& S, const float* rowfac, PG8_LAS float* rt, int tid) {
    Unit u; int n = 0; while (n < 8 && S.next(n, u)) ++n;
#pragma unroll
    for (int q = 0; q < 4; ++q) { const int r = tid + 512 * q, i = r >> 8; if (i < n) { S.next(i, u); rt[r] = rowfac[u.pm * BM + (r & 255)]; } }
    __syncthreads();
}
struct EpiSwiGLUNq {
    typedef i32x4 acc_t; static constexpr bool PERM = true, AFTER_DRAIN = false;
    bf16_t* O; int ldo; const PG8_LAS float* rt; const float* shw; int nphys; const float* colscale;
    __device__ __forceinline__ void operator()(const i32x4 (&acc)[2][2][4][2], const Unit& u, int wr, int wc, int fr, int fq) const {
        const int R0 = u.pm * BM, row0 = R0 + wr * 64 + fr, colp = u.pn * BM + wc * 32 + 8 * fq, col0 = u.pn * HALF + wc * 32 + 8 * fq;
        const float* sp = shw + (size_t)(R0 < ML_ ? (R0 >> 11) : 8) * nphys + colp; const float* cp = colscale + colp;
        f32x4 s1[2], s3[2], c1[2], c3[2];
#pragma unroll
        for (int n = 0; n < 2; ++n) { s1[n] = *(const f32x4*)(sp + 4 * n) * 1.44269504f; s3[n] = *(const f32x4*)(sp + HALF + 4 * n) * 0.693147181f; c1[n] = *(const f32x4*)(cp + 4 * n) * 1.44269504f; c3[n] = *(const f32x4*)(cp + HALF + 4 * n) * 0.693147181f; }
#pragma unroll
        for (int ai = 0; ai < 2; ++ai)
#pragma unroll
            for (int m = 0; m < 4; ++m) { const int row = row0 + ai * HALF + m * 16; const float rs = rt[u.idx * BM + (row - R0)];
                f32x4 v[2];
#pragma unroll
                for (int n = 0; n < 2; ++n) { const i32x4 ia = acc[ai][0][m][n], ib = acc[ai][1][m][n];
                    const f32x4 a = (f32x4){(float)ia[0], (float)ia[1], (float)ia[2], (float)ia[3]} * (c1[n] * rs) + s1[n], b = (f32x4){(float)ib[0], (float)ib[1], (float)ib[2], (float)ib[3]} * (c3[n] * rs) + s3[n];
                    v[n] = (f32x4){a[0] * sigm2(a[0]) * b[0], a[1] * sigm2(a[1]) * b[1], a[2] * sigm2(a[2]) * b[2], a[3] * sigm2(a[3]) * b[3]}; }
                *(u32x4*)(O + (size_t)row * ldo + col0) = pack8(v[0], v[1]);
            }
    }
};
struct EpiSwiGLUq {
    typedef i32x4 acc_t; static constexpr bool PERM = true, AFTER_DRAIN = false;
    unsigned char* O; int ldo, nN; const float* posscale; const float* colscale;
    __device__ __forceinline__ void operator()(const i32x4 (&acc)[2][2][4][2], const Unit& u, int wr, int wc, int fr, int fq) const {
        const int row0 = u.pm * BM + wr * 64 + fr, col0 = (u.pn % nN) * HALF + wc * 32 + 8 * fq; const float* cp = colscale + (size_t)u.pn * BM + wc * 32 + 8 * fq;
        f32x4 c1[2], c3[2];
#pragma unroll
        for (int n = 0; n < 2; ++n) { c1[n] = *(const f32x4*)(cp + 4 * n); c3[n] = *(const f32x4*)(cp + HALF + 4 * n); }
        float rsv[8];
#pragma unroll
        for (int q = 0; q < 8; ++q) rsv[q] = posscale[row0 + (q >> 2) * HALF + (q & 3) * 16];
#pragma unroll
        for (int ai = 0; ai < 2; ++ai)
#pragma unroll
            for (int m = 0; m < 4; ++m) { const int row = row0 + ai * HALF + m * 16; const float rs = rsv[ai * 4 + m], rsa = rs * 1.44269504f, rsb = rs * 0.693147181f;
                f32x4 v[2];
#pragma unroll
                for (int n = 0; n < 2; ++n) { const i32x4 ia = acc[ai][0][m][n], ib = acc[ai][1][m][n];
                    const f32x4 a = (f32x4){(float)ia[0], (float)ia[1], (float)ia[2], (float)ia[3]} * (c1[n] * rsa), b = (f32x4){(float)ib[0], (float)ib[1], (float)ib[2], (float)ib[3]} * (c3[n] * rsb);
                    v[n] = (f32x4){a[0] * sigm2(a[0]) * b[0], a[1] * sigm2(a[1]) * b[1], a[2] * sigm2(a[2]) * b[2], a[3] * sigm2(a[3]) * b[3]}; }
                u32x2 o; o.x = f8pack4(v[0]); o.y = f8pack4(v[1]); *(u32x2*)(O + (size_t)row * ldo + col0) = o;
            }
    }
};
struct EpiGLURes {
    typedef f32x4 acc_t; static constexpr bool PERM = true, AFTER_DRAIN = false, FP8 = true;
    bf16_t* X; const float* gate; const float* colscale;
    __device__ __forceinline__ void operator()(const f32x4 (&acc)[2][2][4][2], const Unit& u, int wr, int wc, int fr, int fq) const {
        const int R0 = u.pm * BM, row0 = R0 + wr * 64 + fr, col0 = u.pn * HALF + wc * 32 + 8 * fq;
        const float* gp = gate + (size_t)(R0 >> 11) * 6144 + col0; const float* cp = colscale + (size_t)u.pn * BM + wc * 32 + 8 * fq;
        f32x4 gv[2], c1[2], c2[2];
#pragma unroll
        for (int n = 0; n < 2; ++n) { gv[n] = *(const f32x4*)(gp + n * 4); c1[n] = *(const f32x4*)(cp + n * 4); c2[n] = *(const f32x4*)(cp + HALF + n * 4); }
        u32x4 xr[8];
#pragma unroll
        for (int q = 0; q < 8; ++q) xr[q] = *(const u32x4*)(X + (size_t)(row0 + (q >> 2) * HALF + (q & 3) * 16) * DM_ + col0);
#pragma unroll
        for (int ai = 0; ai < 2; ++ai)
#pragma unroll
            for (int m = 0; m < 4; ++m) { bf16_t* xp = X + (size_t)(row0 + ai * HALF + m * 16) * DM_ + col0; f32x4 x0, x1, y[2];
                unpack8(xr[ai * 4 + m], x0, x1);
#pragma unroll
                for (int n = 0; n < 2; ++n) { const f32x4 z1 = acc[ai][0][m][n] * c1[n], z2 = acc[ai][1][m][n] * c2[n]; y[n] = (f32x4){z1[0] * sigm(z2[0]), z1[1] * sigm(z2[1]), z1[2] * sigm(z2[2]), z1[3] * sigm(z2[3])}; }
                *(u32x4*)xp = pack8(x0 + gv[0] * y[0], x1 + gv[1] * y[1]); }
    }
};
struct EpiUC {
    typedef f32x4 acc_t; static constexpr bool PERM = true, AFTER_DRAIN = false;
    bf16_t* UC; const PG8_LAS float* rt; const float* shw;
    __device__ __forceinline__ void operator()(const f32x4 (&acc)[2][2][4][2], const Unit& u, int wr, int wc, int fr, int fq) const {
        const int R0 = u.pm * BM, row0 = R0 + wr * 64 + fr, col0 = u.pn * BM + wc * 32 + 8 * fq;
        const float* sp = shw + (size_t)(R0 < ML_ ? (R0 >> 11) : 8) * DM_ + col0;
        f32x4 sv[2][2];
#pragma unroll
        for (int bj = 0; bj < 2; ++bj)
#pragma unroll
            for (int n = 0; n < 2; ++n) sv[bj][n] = *(const f32x4*)(sp + bj * HALF + 4 * n);
#pragma unroll
        for (int ai = 0; ai < 2; ++ai)
#pragma unroll
            for (int m = 0; m < 4; ++m) { const int row = row0 + ai * HALF + m * 16; int bc, j; const float rs = rt[u.idx * BM + (row - R0)];
                if (row < ML_) { bc = (row >> 11) * 64 + ((row & 2047) >> 5); j = row & 31; } else { const int r2 = row - ML_; bc = 512 + (r2 >> 8) * 8 + ((r2 & 255) >> 5); j = r2 & 31; }
#pragma unroll
                for (int bj = 0; bj < 2; ++bj) { const int col = col0 + bj * HALF, g = col >> 4, qi = col & 15;
                    *(u32x4*)(UC + ((size_t)(g * 768 + bc) * 768 + j * 16 + qi)) = pack8(acc[ai][bj][m][0] * rs + sv[bj][0], acc[ai][bj][m][1] * rs + sv[bj][1]); } }
    }
};
struct EpiE {
    typedef f32x4 acc_t; static constexpr bool PERM = false, AFTER_DRAIN = false;
    float* E;
    __device__ __forceinline__ void operator()(const f32x4 (&acc)[2][2][4][2], const Unit& u, int wr, int wc, int fr, int fq) const {
        const int row0 = u.pm * BM + wr * 64 + fr, col0 = wc * 32 + 4 * fq;
#pragma unroll
        for (int ai = 0; ai < 2; ++ai)
#pragma unroll
            for (int m = 0; m < 4; ++m) { float* rp = E + (size_t)(row0 + ai * HALF + m * 16) * 256 + col0;
#pragma unroll
                for (int bj = 0; bj < 2; ++bj)
#pragma unroll
                    for (int n = 0; n < 2; ++n) *(f32x4*)(rp + bj * HALF + n * 16) = acc[ai][bj][m][n]; }
    }
};
struct EpiY {
    typedef f32x4 acc_t; static constexpr bool PERM = true, AFTER_DRAIN = false;
    unsigned char* Y;
    __device__ __forceinline__ void operator()(const f32x4 (&acc)[2][2][4][2], const Unit& u, int wr, int wc, int fr, int fq) const {
        const int g = u.pm / 3, pml = u.pm - 3 * g, pnl = u.pn & 1;
        const int bc0 = pml * BM + wr * 64 + fr, n0 = pnl * BM + wc * 32 + 8 * fq;
#pragma unroll
        for (int ai = 0; ai < 2; ++ai)
#pragma unroll
            for (int m = 0; m < 4; ++m) { const int bc = bc0 + ai * HALF + m * 16, tok0 = (bc >> 6) * 2048 + (bc & 63) * 32;
#pragma unroll
                for (int bj = 0; bj < 2; ++bj) { const int n = n0 + bj * HALF, tin = n >> 4, qo = n & 15; const f32x4 a = acc[ai][bj][m][0], b = acc[ai][bj][m][1];
                    const f32x4 ya = (f32x4){gelu_tanh(a[0]), gelu_tanh(a[1]), gelu_tanh(a[2]), gelu_tanh(a[3])}, yb = (f32x4){gelu_tanh(b[0]), gelu_tanh(b[1]), gelu_tanh(b[2]), gelu_tanh(b[3])};
                    u32x2 o; o.x = f8pack4(ya); o.y = f8pack4(yb); *(u32x2*)(Y + (size_t)(tok0 + tin) * DM_ + g * 16 + qo) = o; } }
    }
};
struct EpiMoE2 {
    typedef f32x4 acc_t; static constexpr bool PERM = true, AFTER_DRAIN = false, FP8 = true;
    bf16_t* Y2; const float* rowgate; const int* rowinfo; const float* colscale;
    __device__ __forceinline__ void operator()(const f32x4 (&acc)[2][2][4][2], const Unit& u, int wr, int wc, int fr, int fq) const {
        const int row0 = u.pm * BM + wr * 64 + fr, col0 = (u.pn & 3) * BM + wc * 32 + 8 * fq; const float* cp = colscale + (size_t)u.pn * BM + wc * 32 + 8 * fq;
        f32x4 cs[2][2];
#pragma unroll
        for (int bj = 0; bj < 2; ++bj)
#pragma unroll
            for (int n = 0; n < 2; ++n) cs[bj][n] = *(const f32x4*)(cp + bj * HALF + 4 * n);
        float gtv[8]; int riv[8];
#pragma unroll
        for (int q = 0; q < 8; ++q) { const int row = row0 + (q >> 2) * HALF + (q & 3) * 16; gtv[q] = rowgate[row]; riv[q] = rowinfo[row]; }
#pragma unroll
        for (int ai = 0; ai < 2; ++ai)
#pragma unroll
            for (int m = 0; m < 4; ++m) { const float gt = gtv[ai * 4 + m]; const int ri = riv[ai * 4 + m];
                if (ri >= 0) {
#pragma unroll
                    for (int bj = 0; bj < 2; ++bj) *(u32x4*)(Y2 + (size_t)ri * DM_ + col0 + bj * HALF) = pack8(acc[ai][bj][m][0] * (cs[bj][0] * gt), acc[ai][bj][m][1] * (cs[bj][1] * gt)); } }
    }
};
struct OrderS5E { static constexpr bool VARK = false; int G, c;
    __device__ __forceinline__ bool next(int i, Unit& u) const {
        if (G == 256) { if (i > 0) return false; const int x = c & 7, j = c >> 3; if (j >= 24) return false; const int g = 8 * (j / 3) + x; u.pm = 3 * g + (j % 3); u.pn = g; u.k0 = 0; u.idx = i; return true; }
        const int L = i * G + c; if (L >= 192) return false; u.pm = L; u.pn = L / 3; u.k0 = 0; u.idx = i; return true; }
    __device__ __forceinline__ void a_ready(const Unit&) const {}
    __device__ __forceinline__ void done(const Unit&) const {} };
struct OrderS5Y { static constexpr bool VARK = false; int G, c;
    __device__ __forceinline__ bool next(int i, Unit& u) const {
        if (G == 256) { if (i > 0) return false; const int x = c & 7, j = c >> 3, g = 8 * (j >> 2) + x; u.pm = 3 * g + ((j >> 1) & 1); u.pn = 2 * g + (j & 1); u.k0 = 0; u.idx = i; return true; }
        const int L = i * G + c; if (L >= 256) return false; const int g = L >> 2; u.pm = 3 * g + ((L >> 1) & 1); u.pn = 2 * g + (L & 1); u.k0 = 0; u.idx = i; return true; }
    __device__ __forceinline__ void a_ready(const Unit&) const {}
    __device__ __forceinline__ void done(const Unit&) const {} };
struct OrderMoE { static constexpr bool VARK = false; int G, c, nN, tmax, fix; int toff[9];
    __device__ __forceinline__ bool next(int i, Unit& u) const {
        int pm, pnl; const int nt = toff[8] < tmax ? toff[8] : tmax;
        if (G == 256) {
            const int x = c & 7, j = c >> 3, nCB = nN >> 2, b = i * 8 + x, nRB = (nt + 7) >> 3; if (b >= nRB * nCB) return false;
            const int rb = b / nCB, cbk = b - rb * nCB; pm = 8 * rb + (j & 7); pnl = 4 * cbk + (j >> 3);
        } else { const int L = i * G + c; pm = L / nN; pnl = L - pm * nN; }
        if (pm >= nt) return false;
        int e = 0;
#pragma unroll
        for (int k = 1; k < 8; ++k) e += (pm >= toff[k]) ? 1 : 0;
        u.pm = fix ? 0 : pm; u.pn = fix ? pnl & 3 : e * nN + pnl; u.k0 = 0; u.idx = i; return true; }
    __device__ __forceinline__ void a_ready(const Unit&) const {}
    __device__ __forceinline__ void done(const Unit&) const {} };
struct OrderMoEx { static constexpr bool VARK = true; int G, c; int toff[9];
    __device__ __forceinline__ bool next(int i, Unit& u) const {
        const int s = i * G + c, tl = s >> 4, pm = 128 + tl; if (pm >= toff[8]) return false;
        int e = 0;
#pragma unroll
        for (int k = 1; k < 8; ++k) e += (pm >= toff[k]) ? 1 : 0;
        const int ks = s & 3; u.pm = pm; u.pn = e * 4 + ((s >> 2) & 3); u.k0 = (ks * 8 - (ks == 3 ? 2 : 0)) * BK; u.idx = ks; return true; }
    __device__ __forceinline__ int ktiles(const Unit& u) const { return u.idx < 2 ? 8 : 6; }
    __device__ __forceinline__ void a_ready(const Unit&) const {}
    __device__ __forceinline__ void done(const Unit&) const {} };
struct EpiMoE2x {
    typedef f32x4 acc_t; static constexpr bool PERM = false, AFTER_DRAIN = false, FP8 = true;
    float* P; const float* rowgate; const float* colscale;
    __device__ __forceinline__ void operator()(const f32x4 (&acc)[2][2][4][2], const Unit& u, int wr, int wc, int fr, int fq) const {
        const int ks = u.idx, tl = u.pm - 128, r0 = wr * 64 + fr, col0 = (u.pn & 3) * BM + wc * 32 + 4 * fq;
        const __amdgpu_buffer_rsrc_t crs = __builtin_amdgcn_make_buffer_rsrc((void*)colscale, 0, 8 * 1024 * 4, 0x00020000);
        f32x4 cs[2][2];
#pragma unroll
        for (int bj = 0; bj < 2; ++bj)
#pragma unroll
            for (int n = 0; n < 2; ++n) cs[bj][n] = __builtin_bit_cast(f32x4, __builtin_amdgcn_raw_buffer_load_b128(crs, (u.pn * BM + wc * 32 + 4 * fq + bj * HALF + n * 16) * 4, 0, 0));
        float* pb = P + ((size_t)(ks * 8 + tl) * 256) * DM_;
        const __amdgpu_buffer_rsrc_t grs = __builtin_amdgcn_make_buffer_rsrc((void*)rowgate, 0, 136 * 256 * 4, 0x00020000);
        float gtv[8];
#pragma unroll
        for (int q = 0; q < 8; ++q) gtv[q] = __builtin_bit_cast(float, __builtin_amdgcn_raw_buffer_load_b32(grs, (u.pm * BM + r0 + (q >> 2) * HALF + (q & 3) * 16) * 4, 0, 0));
#pragma unroll
        for (int ai = 0; ai < 2; ++ai)
#pragma unroll
            for (int m = 0; m < 4; ++m) { const int r = r0 + ai * HALF + m * 16; const float gt = gtv[ai * 4 + m];
#pragma unroll
                for (int bj = 0; bj < 2; ++bj)
#pragma unroll
                    for (int n = 0; n < 2; ++n) *(f32x4*)(pb + (size_t)r * DM_ + col0 + bj * HALF + n * 16) = acc[ai][bj][m][n] * (cs[bj][n] * gt); }
    }
};
template <class Epi, class Sched, bool ALIGN_EPI = false, bool SP2 = false, bool GATHER = false>
__device__ __forceinline__ void gemm_phase(PG8_LAS unsigned char* lds, const Gemm g, const Sched& S, const Epi& E) {
    const int tid = threadIdx.x, wid = __builtin_amdgcn_readfirstlane(tid >> 6), lane = tid & 63, wr = wid >> 2, wc = wid & 3, fr = lane & 15, fq = lane >> 4;
    const int K = g.K; int nt = K / BK;
    unsigned voffA[2], voffB[2]; int RA[2]; unsigned CA[2];
    static_assert(!GATHER || SP2, "the gathered A operand is wired into the SP2 loop only");
#pragma unroll
    for (int i = 0; i < 2; ++i) { int R, C; stage_rc(tid * 16 + i * 8192, R, C); const int Rb = Epi::PERM ? ((R & ~31) + perm32(R & 31)) : R;
        voffA[i] = (unsigned)(R * g.lda + C) * 2u; voffB[i] = (unsigned)(Rb * g.ldb + C) * 2u; RA[i] = R; CA[i] = (unsigned)C * 2u; }
    const size_t kstep = (size_t)(BK * 2);
    const size_t hstepA = (size_t)HALF * g.lda * 2, hstepB = (size_t)HALF * g.ldb * 2;
    const size_t tstepA = 2 * hstepA, tstepB = 2 * hstepB;
    const unsigned ldsw = (unsigned)wid * 1024u;
    const int aoff = lds_byte(wr * 64 + fr, fq * 8), boff = lds_byte(wc * 32 + fr, fq * 8);
#define PG8_SA(b, h) (((b) * 2 + (h)) * HTB)
#define PG8_SB(b, h) ((4 + (b) * 2 + (h)) * HTB)
#define PG8_STAGE(bufoff, gbase, voff) do { _Pragma("unroll") for (int _i = 0; _i < 2; ++_i) \
        __builtin_amdgcn_global_load_lds((const unsigned*)((const char*)(gbase) + (voff)[_i]), (PG8_LAS unsigned*)(lds + (bufoff) + ldsw + _i * 8192), 16, 0, 0); } while (0)
#define PG8_LDA(dst, b, h) do { _Pragma("unroll") for (int m = 0; m < 4; ++m) _Pragma("unroll") for (int k = 0; k < 2; ++k) dst[m].set(k, *(const PG8_LAS bf16x8*)(lds + PG8_SA(b, h) + aoff + m * 2048 + k * 1024)); } while (0)
#define PG8_LDB(dst, b, h) do { _Pragma("unroll") for (int n = 0; n < 2; ++n) _Pragma("unroll") for (int k = 0; k < 2; ++k) dst[n].set(k, *(const PG8_LAS bf16x8*)(lds + PG8_SB(b, h) + boff + n * 2048 + k * 1024)); } while (0)
#define PG8_MMA(ai, bj, At, Bt) do { __builtin_amdgcn_s_setprio(1); _Pragma("unroll") for (int m = 0; m < 4; ++m) _Pragma("unroll") for (int n = 0; n < 2; ++n) \
        acc[ai][bj][m][n] = mma_frag(Bt[n], At[m], acc[ai][bj][m][n]); __builtin_amdgcn_s_setprio(0); } while (0)
#define PG8_WAIT_V(n) asm volatile("s_waitcnt vmcnt(" #n ")" ::: "memory")
#define PG8_WAIT_L(n) asm volatile("s_waitcnt lgkmcnt(" #n ")" ::: "memory")
#define PG8_BAR __builtin_amdgcn_s_barrier()
#define PG8_SCHED __builtin_amdgcn_sched_barrier(0)
#define PG8_GIDX(d0, d1, un) do { _Pragma("unroll") for (int _i = 0; _i < 2; ++_i) { const int* _rp = g.rowsrc + (un).pm * BM + RA[_i]; d0[_i] = (unsigned)_rp[0] * (unsigned)(g.lda * 2) + CA[_i]; d1[_i] = (unsigned)_rp[HALF] * (unsigned)(g.lda * 2) + CA[_i]; } } while (0)
    Unit cur, nxt; int ui = 0;
    if (!S.next(0, cur)) return;
    if constexpr (Sched::VARK) nt = S.ktiles(cur);
    typedef typename Epi::acc_t acc_t;
    acc_t acc[2][2][4][2];
#pragma unroll
    for (int a = 0; a < 2; ++a)
#pragma unroll
        for (int b = 0; b < 2; ++b)
#pragma unroll
            for (int m = 0; m < 4; ++m)
#pragma unroll
                for (int n = 0; n < 2; ++n) acc[a][b][m][n] = (acc_t){0, 0, 0, 0};
    Frag<is_fp8<Epi>::v> At[4], B0[2], B1[2];
    const char* cA = (const char*)g.A + (size_t)cur.pm * tstepA + (size_t)cur.k0 * 2; const char* cB = (const char*)g.Bt + (size_t)cur.pn * tstepB + (size_t)cur.k0 * 2;
    S.a_ready(cur);
    unsigned cv0[2] = {0u, 0u}, cv1[2] = {0u, 0u}, nv0[2] = {0u, 0u}, nv1[2] = {0u, 0u}; const char* gA = (const char*)g.A;
    if constexpr (GATHER) { PG8_GIDX(cv0, cv1, cur); nv0[0] = cv0[0]; nv0[1] = cv0[1]; nv1[0] = cv1[0]; nv1[1] = cv1[1]; }
    if constexpr (SP2) {
        PG8_STAGE(PG8_SB(0, 0), cB, voffB); PG8_STAGE(PG8_SB(0, 1), cB + hstepB, voffB);
        if constexpr (GATHER) { PG8_STAGE(PG8_SA(0, 0), gA, cv0); PG8_STAGE(PG8_SA(0, 1), gA, cv1); } else { PG8_STAGE(PG8_SA(0, 0), cA, voffA); PG8_STAGE(PG8_SA(0, 1), cA + hstepA, voffA); }
        if (wr == 1) PG8_BAR;
        PG8_WAIT_V(2); PG8_BAR;
        PG8_STAGE(PG8_SB(1, 0), cB + kstep, voffB); if constexpr (GATHER) PG8_STAGE(PG8_SA(1, 0), gA + kstep, cv0); else PG8_STAGE(PG8_SA(1, 0), cA + kstep, voffA); PG8_STAGE(PG8_SB(1, 1), cB + hstepB + kstep, voffB);
        PG8_WAIT_V(6); PG8_BAR;
    } else {
        PG8_STAGE(PG8_SB(0, 0), cB, voffB); PG8_STAGE(PG8_SA(0, 0), cA, voffA); PG8_STAGE(PG8_SB(0, 1), cB + hstepB, voffB); PG8_STAGE(PG8_SA(0, 1), cA + hstepA, voffA);
        if (wr == 1) PG8_BAR;
        PG8_WAIT_V(4); PG8_BAR;
        PG8_STAGE(PG8_SB(1, 0), cB + kstep, voffB); PG8_STAGE(PG8_SA(1, 0), cA + kstep, voffA); PG8_STAGE(PG8_SB(1, 1), cB + hstepB + kstep, voffB);
        PG8_WAIT_V(6); PG8_BAR;
    }
    for (;;) {
        const bool has_next = S.next(ui + 1, nxt);
        const char* nA = has_next ? (const char*)g.A + (size_t)nxt.pm * tstepA + (size_t)nxt.k0 * 2 : cA; const char* nB = has_next ? (const char*)g.Bt + (size_t)nxt.pn * tstepB + (size_t)nxt.k0 * 2 : cB;
        for (int t = 0; t < nt; t += 2) {
            const bool last = (t == nt - 2);
            const char* a1 = cA + (size_t)(t + 1) * kstep;
            const char* a2 = last ? nA : cA + (size_t)(t + 2) * kstep; const char* b2 = last ? nB : cB + (size_t)(t + 2) * kstep;
            const char* a3 = a2 + kstep; const char* b3 = b2 + kstep;
            if (last && has_next) S.a_ready(nxt);
            if constexpr (GATHER) { if (t == nt - 4 && has_next) PG8_GIDX(nv0, nv1, nxt); }
            const char* g1 = gA + (size_t)(t + 1) * kstep; const char* g2 = last ? gA : gA + (size_t)(t + 2) * kstep; const char* g3 = g2 + kstep;
            unsigned x0[2], x1[2]; x0[0] = last ? nv0[0] : cv0[0]; x0[1] = last ? nv0[1] : cv0[1]; x1[0] = last ? nv1[0] : cv1[0]; x1[1] = last ? nv1[1] : cv1[1];
            if constexpr (SP2) {
            PG8_LDB(B0, 0, 0); PG8_LDB(B1, 0, 1); PG8_SCHED; PG8_LDA(At, 0, 0); if constexpr (GATHER) PG8_STAGE(PG8_SA(1, 1), g1, cv1); else PG8_STAGE(PG8_SA(1, 1), a1 + hstepA, voffA);
            PG8_WAIT_V(8); PG8_WAIT_L(0); PG8_BAR; PG8_MMA(0, 0, At, B0); PG8_MMA(0, 1, At, B1); PG8_BAR; PG8_SCHED;
            PG8_LDA(At, 0, 1); PG8_STAGE(PG8_SB(0, 0), b2, voffB); PG8_STAGE(PG8_SB(0, 1), b2 + hstepB, voffB); if constexpr (GATHER) PG8_STAGE(PG8_SA(0, 0), g2, x0); else PG8_STAGE(PG8_SA(0, 0), a2, voffA);
            PG8_WAIT_V(8); PG8_WAIT_L(0); PG8_BAR; PG8_MMA(1, 0, At, B0); PG8_MMA(1, 1, At, B1); PG8_BAR; PG8_SCHED;
            PG8_LDB(B0, 1, 0); PG8_LDB(B1, 1, 1); PG8_SCHED; PG8_LDA(At, 1, 0); if constexpr (GATHER) PG8_STAGE(PG8_SA(0, 1), g2, x1); else PG8_STAGE(PG8_SA(0, 1), a2 + hstepA, voffA);
            PG8_WAIT_V(8); PG8_WAIT_L(0); PG8_BAR; PG8_MMA(0, 0, At, B0); PG8_MMA(0, 1, At, B1); PG8_BAR; PG8_SCHED;
            PG8_LDA(At, 1, 1); PG8_STAGE(PG8_SB(1, 0), b3, voffB); PG8_STAGE(PG8_SB(1, 1), b3 + hstepB, voffB); if constexpr (GATHER) PG8_STAGE(PG8_SA(1, 0), g3, x0); else PG8_STAGE(PG8_SA(1, 0), a3, voffA);
            PG8_WAIT_V(8); PG8_WAIT_L(0); PG8_BAR; PG8_MMA(1, 0, At, B0); PG8_MMA(1, 1, At, B1); PG8_BAR; PG8_SCHED;
            } else {
            PG8_LDB(B0, 0, 0); PG8_SCHED; PG8_LDA(At, 0, 0); PG8_STAGE(PG8_SA(1, 1), a1 + hstepA, voffA);
            PG8_WAIT_L(8); PG8_BAR; PG8_WAIT_L(0); PG8_MMA(0, 0, At, B0); PG8_BAR; PG8_SCHED;
            PG8_LDB(B1, 0, 1); PG8_STAGE(PG8_SB(0, 0), b2, voffB);
            PG8_BAR; PG8_WAIT_L(0); PG8_MMA(0, 1, At, B1); PG8_BAR;
            PG8_LDA(At, 0, 1); PG8_STAGE(PG8_SA(0, 0), a2, voffA);
            PG8_BAR; PG8_WAIT_L(0); PG8_MMA(1, 0, At, B0); PG8_BAR; PG8_SCHED;
            PG8_STAGE(PG8_SB(0, 1), b2 + hstepB, voffB);
            PG8_WAIT_V(6); PG8_BAR; PG8_MMA(1, 1, At, B1); PG8_BAR;
            PG8_LDB(B0, 1, 0); PG8_SCHED; PG8_LDA(At, 1, 0); PG8_STAGE(PG8_SA(0, 1), a2 + hstepA, voffA);
            PG8_WAIT_L(8); PG8_BAR; PG8_WAIT_L(0); PG8_MMA(0, 0, At, B0); PG8_BAR; PG8_SCHED;
            PG8_LDB(B1, 1, 1); PG8_STAGE(PG8_SB(1, 0), b3, voffB);
            PG8_BAR; PG8_WAIT_L(0); PG8_MMA(0, 1, At, B1); PG8_BAR;
            PG8_LDA(At, 1, 1); PG8_STAGE(PG8_SA(1, 0), a3, voffA);
            PG8_BAR; PG8_WAIT_L(0); PG8_MMA(1, 0, At, B0); PG8_BAR; PG8_SCHED;
            PG8_STAGE(PG8_SB(1, 1), b3 + hstepB, voffB);
            PG8_WAIT_V(6); PG8_BAR; PG8_MMA(1, 1, At, B1); PG8_BAR;
            }
        }
        if constexpr (ALIGN_EPI) { if (wr == 0) PG8_BAR; }
        mma_drain<is_fp8<Epi>::v>();
        if constexpr (!Epi::AFTER_DRAIN) { E(acc, cur, wr, wc, fr, fq); S.done(cur); }
        if (!has_next) break;
#pragma unroll
        for (int a = 0; a < 2; ++a)
#pragma unroll
            for (int b = 0; b < 2; ++b)
#pragma unroll
                for (int m = 0; m < 4; ++m)
#pragma unroll
                    for (int n = 0; n < 2; ++n) acc[a][b][m][n] = (acc_t){0, 0, 0, 0};
        cur = nxt; cA = nA; cB = nB; ++ui; if constexpr (Sched::VARK) nt = S.ktiles(cur);
        if constexpr (GATHER) { cv0[0] = nv0[0]; cv0[1] = nv0[1]; cv1[0] = nv1[0]; cv1[1] = nv1[1]; }
        if constexpr (ALIGN_EPI) { if (wr == 1) PG8_BAR; }
    }
    PG8_WAIT_V(0);
    if constexpr (!ALIGN_EPI) { if (wr == 0) PG8_BAR; }
    PG8_BAR;
    if constexpr (Epi::AFTER_DRAIN) { E.fused(acc, cur, wr, wc, fr, fq, lds, wid, lane); S.done(cur); }
#undef PG8_SA
#undef PG8_SB
#undef PG8_STAGE
#undef PG8_LDA
#undef PG8_LDB
#undef PG8_MMA
#undef PG8_WAIT_V
#undef PG8_WAIT_L
#undef PG8_BAR
#undef PG8_SCHED
#undef PG8_GIDX
}
}

constexpr int NB = 8, SEQ = 2048, NCTX = 256, D = 1024;
constexpr int ML = NB * SEQ, MC = NB * NCTX, MT = ML + MC;
constexpr int MIXIN = 2560, FFN = 2816, NE = 8, ED = 3584;
constexpr float EPS = 1e-6f;
constexpr int NWAVES = 8;
constexpr int MOE_TILES = 136;

constexpr size_t MiB = 1u << 20;
constexpr size_t WS_CTL = 0, CTL_ZERO_BYTES = 65536;
constexpr size_t WS_MOD = 65536, WS_MODP = 1 * MiB; constexpr int MOD_N = 2 * 9 * 6144;
constexpr size_t WS_ROWSS = 3 * MiB, WS_SHW13 = 4608 * 1024, WS_SHWS = WS_SHW13 + 9 * 5632 * 4;
constexpr size_t WS_ROWSC = 2800 * 1024, WS_POSSC = 2864 * 1024, WS_COLMAX = 4864 * 1024, WS_COLSC = WS_COLMAX;
constexpr size_t WS_COLSCD = WS_COLMAX + (size_t)NE * 2 * ED * 4, WS_PMAX = 376 * MiB, WS_ROWFAC1 = WS_POSSC;
constexpr size_t WS_COLSC2 = 4352 * 1024;
constexpr size_t WS_COLSCS = WS_COLSC2 + 32768;
constexpr size_t WS_TOK = 5 * MiB;
constexpr size_t TOK_E = 0, TOK_W = 128 * 1024, TOK_RANK = 256 * 1024, TOK_POS = 384 * 1024, TOK_WGBASE = 512 * 1024, TOK_ROWGATE = 576 * 1024, TOK_ROWSRC = 720 * 1024, TOK_ROWINFO = 864 * 1024;
constexpr size_t WS_MW13 = 6 * MiB, WS_MW2 = 118 * MiB;
constexpr size_t WS_XL = 174 * MiB, WS_H = 238 * MiB, WS_XC = 274 * MiB;
constexpr size_t WS_WIN = 282 * MiB, WS_WOUT = 287 * MiB, WS_W13 = 289 * MiB, WS_W2 = 300 * MiB, WS_SIN = 306 * MiB, WS_SOUT = 308 * MiB;
constexpr size_t WS_BTOUT = 312 * MiB, WS_WEND = 360 * MiB, WS_R = 376 * MiB, WS_END = 512 * MiB;
constexpr size_t WS_QKVU = WS_R, WS_MIX = WS_R + 72 * MiB, WS_ACT = WS_R;
constexpr size_t WS_UC = WS_R, WS_E = WS_R + 72 * MiB, WS_Y = WS_R + 72 * MiB;
constexpr size_t WS_PX = WS_H;
constexpr size_t WS_ACTM = 274 * MiB;
static_assert(WS_ACTM + (size_t)MOE_TILES * 256 * ED * 2 <= WS_END && WS_XC + (size_t)MC * D * 4 <= WS_WIN && WS_H + (size_t)MT * D * 2 <= WS_XC && WS_MW2 + (size_t)NE * D * ED * 2 <= WS_XL, "d_ws map");
constexpr int CW_TMO = 0, CW_CODE = 1, CW_BAR = 4096, CW_GCNT = 8192;

constexpr int RING_OFF = 0, RING_BYTES = 131072;
constexpr int LDSCTL_OFF = 155648, MISC_OFF = LDSCTL_OFF + 320;
constexpr int LDS_BYTES = 159744;
static_assert(MISC_OFF + 128 <= LDS_BYTES, "LDS map");

#define GAS __attribute__((address_space(1)))
#define LAS __attribute__((address_space(3)))
typedef unsigned short bf16;
typedef unsigned v4u __attribute__((ext_vector_type(4)));
typedef unsigned v2u __attribute__((ext_vector_type(2)));
typedef float f32x4 __attribute__((ext_vector_type(4)));
typedef float f32x2 __attribute__((ext_vector_type(2)));
typedef float f32x16 __attribute__((ext_vector_type(16)));
typedef short bf16x8 __attribute__((ext_vector_type(8)));
typedef GAS unsigned gu32;
#define RLX_AGENT __ATOMIC_RELAXED, __HIP_MEMORY_SCOPE_AGENT
#define LDS_WAIT() asm volatile("s_waitcnt lgkmcnt(0)" ::: "memory")
#define VM_WAIT() asm volatile("s_waitcnt vmcnt(0)" ::: "memory")
__device__ __forceinline__ unsigned f2bf(float f) { unsigned u = __builtin_bit_cast(unsigned, f); return (u + 0x7fffu + ((u >> 16) & 1u)) >> 16; }
__device__ __forceinline__ unsigned pk2(float lo, float hi) { return f2bf(lo) | (f2bf(hi) << 16); }
__device__ __forceinline__ float bf2f(unsigned short h) { return __builtin_bit_cast(float, (unsigned)h << 16); }
__device__ __forceinline__ float bflo(unsigned w) { return __builtin_bit_cast(float, w << 16); }
__device__ __forceinline__ float bfhi(unsigned w) { return __builtin_bit_cast(float, w & 0xffff0000u); }
__device__ __forceinline__ float sigm(float x) { return __builtin_amdgcn_rcpf(1.0f + __expf(-x)); }
__device__ __forceinline__ float sigm2(float xl) { return __builtin_amdgcn_rcpf(1.0f + __builtin_amdgcn_exp2f(-xl)); }
__device__ __forceinline__ float wave_sum(float v) {
#pragma unroll
    for (int o = 1; o < 64; o <<= 1) v += __shfl_xor(v, o);
    return v;
}
__device__ __forceinline__ float wave_max(float v) {
#pragma unroll
    for (int o = 1; o < 64; o <<= 1) v = fmaxf(v, __shfl_xor(v, o));
    return v;
}
#define XB_TMO      128
#define XB_XCNT(j)  (256  + 64 * (j))
#define XB_XSUB(j)  (1280 + 64 * (j))
#define XB_XGEN(j)  (2304 + 64 * (j))
#define XB_TOP      3328
#define XB_TOPGEN   3392
#define XCD_BAR_WORDS 3456
#define XB_SPIN_CAP (1u << 18)

__device__ __forceinline__ unsigned xb_ld(unsigned* p)              { return __hip_atomic_load(p, __ATOMIC_RELAXED, __HIP_MEMORY_SCOPE_AGENT); }
__device__ __forceinline__ unsigned xb_add(unsigned* p, unsigned v) { return __hip_atomic_fetch_add(p, v, __ATOMIC_RELAXED, __HIP_MEMORY_SCOPE_AGENT); }
__device__ __forceinline__ unsigned xb_xcc_id() { return (unsigned)__builtin_amdgcn_s_getreg((3 << 11) | 20) & 0xFu; }
#define XB_SPIN(cond, bar) do { unsigned _sp = 0; while (cond) { __builtin_amdgcn_s_sleep(1); \
    if ((++_sp & 255u) == 0u) { if (xb_ld(&(bar)[XB_TMO])) break; if (_sp > XB_SPIN_CAP) { atomicAdd(&(bar)[XB_TMO], 1u); break; } } } } while (0)

struct XcdBarrier {
    unsigned* bar; unsigned x;
    volatile LAS unsigned* st;
};

__device__ __forceinline__ XcdBarrier xcd_barrier_post(unsigned* bar, volatile LAS unsigned* st) {
    XcdBarrier b; b.bar = bar; b.x = xb_xcc_id(); b.st = st;
    if (threadIdx.x == 0) (void)xb_add(&bar[XB_XCNT(b.x)], 1u);
    return b;
}
__device__ __forceinline__ void xcd_barrier_complete(unsigned* bar, unsigned x, unsigned& nloc, unsigned& nx) {
    const unsigned G = gridDim.x * gridDim.y * gridDim.z;
    unsigned sum, cnt, mine, sp = 0u;
    for (;;) {
        sum = 0u; cnt = 0u; mine = 0u;
#pragma unroll
        for (unsigned j = 0; j < 16; ++j) { const unsigned c = xb_ld(&bar[XB_XCNT(j)]); sum += c; cnt += (c > 0u) ? 1u : 0u; mine = (j == x) ? c : mine; }
        if (sum == G) break;
        __builtin_amdgcn_s_sleep(1);
        if ((++sp & 255u) == 0u) { if (xb_ld(&bar[XB_TMO])) break; if (sp > XB_SPIN_CAP) { atomicAdd(&bar[XB_TMO], 1u); break; } }
    }
    nloc = mine > 0u ? mine : 1u; nx = cnt > 0u ? cnt : 1u;
}

__device__ __forceinline__ void xcd_barrier(const XcdBarrier& b) {
    asm volatile("s_waitcnt vmcnt(0)" ::: "memory");
    __syncthreads();
    if (threadIdx.x == 0) {
        unsigned* bar = b.bar;
        __builtin_amdgcn_s_waitcnt(0);
        unsigned nloc = b.st[0], nx = b.st[1];
        if (nloc == 0u) { xcd_barrier_complete(bar, b.x, nloc, nx); b.st[0] = nloc; b.st[1] = nx; }
        const unsigned old = xb_add(&bar[XB_XSUB(b.x)], 1u);
        const unsigned gen = old / nloc;
        if (old + 1u == (gen + 1u) * nloc) {
            __builtin_amdgcn_fence(__ATOMIC_RELEASE, "agent");
            asm volatile("s_waitcnt vmcnt(0)" ::: "memory");
            const unsigned og = xb_add(&bar[XB_TOP], 1u);
            const unsigned tg = og / nx;
            if (og + 1u == (tg + 1u) * nx) {
#pragma unroll
                for (unsigned j = 0; j < 16; ++j) (void)xb_add(&bar[XB_XGEN(j)], 1u);
            }
        }
        XB_SPIN(xb_ld(&bar[XB_XGEN(b.x)]) == gen, bar);
        __builtin_amdgcn_fence(__ATOMIC_ACQUIRE, "agent");
        asm volatile("s_waitcnt vmcnt(0)" ::: "memory");
    }
    __syncthreads();
}
enum { I_X = 0, I_C, I_CTX, I_CCTX, I_ADAW, I_ADAB, I_N1G, I_N2G, I_MIXWIN, I_QG, I_KG, I_RPB, I_DWW, I_DWB, I_LNG, I_LNB, I_MIXWOUT, I_FW1, I_FW3, I_FW2,
       I_SWIN, I_ARE, I_AIM, I_LOGDT, I_BRE, I_BIM, I_CRE, I_CIM, I_SD, I_SWOUT, I_ROUTER, I_MW1, I_MW3, I_MW2, N_IN };
struct Args { const float* in[N_IN]; float* out; unsigned char* ws; int ph_lo, ph_hi, sub, pad; };

typedef short s16x4 __attribute__((ext_vector_type(4)));
typedef float f32x2_t __attribute__((ext_vector_type(2)));
typedef __bf16 bf16x2_t __attribute__((ext_vector_type(2)));
__device__ __forceinline__ unsigned cvtpk(float lo, float hi) { const f32x2_t v = {lo, hi}; const bf16x2_t b = __builtin_convertvector(v, bf16x2_t); return __builtin_bit_cast(unsigned, b); }
__device__ __forceinline__ s16x4 vtr(const LAS unsigned char* p) { return __builtin_bit_cast(s16x4, __builtin_amdgcn_ds_read_tr16_b64_v4i16((LAS s16x4*)p)); }
__device__ __forceinline__ void p0_adaln(const Args& A, int unit, LAS unsigned char* lds, int tid, int wave, int lane) {
    const int l = unit / 96, rem = unit % 96, cb = rem >> 2, kq = rem & 3;
    LAS float* sc = (LAS float*)lds;
    LAS float* part = sc + 9 * 256;
    const float* c = A.in[I_C]; const float* cc = A.in[I_CCTX];
    for (int i = tid; i < 9 * 256; i += NWAVES * 64) { const int r = i >> 8, k = 256 * kq + (i & 255); const float v = r < 8 ? c[r * 1024 + k] : cc[k]; sc[i] = v * sigm(v); }
    __syncthreads();
    const float* wp = A.in[I_ADAW] + (size_t)l * 1024 * 6144 + (size_t)(256 * kq + 32 * wave) * 6144 + 256 * cb + 4 * lane;
    float acc[9][4];
#pragma unroll
    for (int r = 0; r < 9; ++r)
#pragma unroll
        for (int j = 0; j < 4; ++j) acc[r][j] = 0.f;
#pragma unroll 8
    for (int it = 0; it < 32; ++it) {
        const f32x4 wv = *(const f32x4*)(wp + (size_t)it * 6144); const int k = 32 * wave + it;
#pragma unroll
        for (int r = 0; r < 9; ++r) { const float s = sc[r * 256 + k];
#pragma unroll
            for (int j = 0; j < 4; ++j) acc[r][j] += s * wv[j]; }
    }
#pragma unroll
    for (int r = 0; r < 9; ++r) *(LAS f32x4*)(part + (wave * 9 + r) * 256 + 4 * lane) = (f32x4){acc[r][0], acc[r][1], acc[r][2], acc[r][3]};
    __syncthreads();
    float* modp = (float*)(A.ws + WS_MODP) + (size_t)kq * MOD_N;
    for (int i = tid; i < 9 * 256; i += NWAVES * 64) { const int r = i >> 8, col = i & 255; float s = 0.f;
#pragma unroll
        for (int w = 0; w < 8; ++w) s += part[(w * 9 + r) * 256 + col];
        if (kq == 0) s += A.in[I_ADAB][l * 6144 + 256 * cb + col];
        modp[((size_t)l * 9 + r) * 6144 + 256 * cb + col] = s; }
    __syncthreads();
}
constexpr int KTS = 260;
__device__ __forceinline__ void p0_s5gen(const Args& A, int g, int part, LAS unsigned char* lds, int tid) {
    LAS f32x2* POW = (LAS f32x2*)lds;
    LAS float* BBr = (LAS float*)(POW + 2 * 64 * 33 + 8);
    LAS float* BBi = BBr + 2 * 64 * 16;
    LAS f32x2* CC = (LAS f32x2*)(BBi + 2 * 64 * 16);
    LAS f32x2* CT = CC + 2 * 16 * 66 + 8;
    LAS float* KT = (LAS float*)(CT + 2 * 64 * 16);
    LAS f32x2* FF = (LAS f32x2*)(KT + 63 * KTS);
#define PWI(d_, p_, m_) (((d_) * 64 + (p_)) * 33 + (m_) + ((p_) >> 5) + (d_) * 4)
#define CCI(d_, q_, p_) (((d_) * 16 + (q_)) * 66 + (p_) + ((p_) >> 5) + (d_) * 4)
    if (tid < 128) { const int d = tid >> 6, p = tid & 63, ix = (d * 64 + g) * 64 + p;
        const float ar = A.in[I_ARE][ix], ai = A.in[I_AIM][ix], dt = __expf(A.in[I_LOGDT][d * 64 + g]);
        const float zr = ar * dt, zi = ai * dt, mag = __expf(zr); const float lr = mag * cosf(zi), li = mag * sinf(zi);
        float pr = 1.f, pi = 0.f;
        for (int m = 0; m <= 32; ++m) { POW[PWI(d, p, m)] = (f32x2){pr, pi}; const float nr = pr * lr - pi * li, ni = pr * li + pi * lr; pr = nr; pi = ni; }
        const float nr = lr - 1.f, ni = li, den = 1.f / (ar * ar + ai * ai);
        FF[d * 64 + p] = (f32x2){(nr * ar + ni * ai) * den, (ni * ar - nr * ai) * den}; }
    __syncthreads();
    for (int i = tid; i < 2048; i += NWAVES * 64) { const int d = i >> 10, p = (i >> 4) & 63, q = i & 15; const int ix = ((d * 64 + g) * 64 + p) * 16 + q;
        const float br = A.in[I_BRE][ix], bi = A.in[I_BIM][ix]; const f32x2 f = FF[d * 64 + p];
        BBr[(d * 64 + p) * 16 + q] = f.x * br - f.y * bi; BBi[(d * 64 + p) * 16 + q] = f.x * bi + f.y * br; }
    for (int i = tid; i < 2048; i += NWAVES * 64) { const int d = i >> 10, q = (i >> 6) & 15, p = i & 63; const int ix = ((d * 64 + g) * 16 + q) * 64 + p;
        const f32x2 cv2 = (f32x2){A.in[I_CRE][ix], A.in[I_CIM][ix]}; CC[CCI(d, q, p)] = cv2; CT[(d * 64 + p) * 16 + q] = cv2; }
    __syncthreads();
    bf16* BtOut = (bf16*)(A.ws + WS_BTOUT) + (size_t)g * 512 * 768;
    bf16* WEnd = (bf16*)(A.ws + WS_WEND) + (size_t)g * 256 * 512;
    if (part == 0) {
    {
        const int d = tid >> 8, dl = (tid >> 4) & 15, qo = tid & 15; float acc[2][16];
#pragma unroll
        for (int i = 0; i < 16; ++i) { acc[0][i] = 0.f; acc[1][i] = 0.f; }
#pragma unroll 2
        for (int p = 0; p < 64; ++p) { const f32x2 c = CT[(d * 64 + p) * 16 + qo], w0 = POW[PWI(d, p, dl)], w1 = POW[PWI(d, p, dl + 16)];
            const float tr0 = c.x * w0.x - c.y * w0.y, ti0 = c.x * w0.y + c.y * w0.x, tr1 = c.x * w1.x - c.y * w1.y, ti1 = c.x * w1.y + c.y * w1.x;
            const LAS f32x4* br = (const LAS f32x4*)(BBr + (d * 64 + p) * 16); const LAS f32x4* bi = (const LAS f32x4*)(BBi + (d * 64 + p) * 16);
#pragma unroll
            for (int q4 = 0; q4 < 4; ++q4) { const f32x4 r4 = br[q4], i4 = bi[q4];
#pragma unroll
                for (int j = 0; j < 4; ++j) { acc[0][4 * q4 + j] += tr0 * r4[j] - ti0 * i4[j]; acc[1][4 * q4 + j] += tr1 * r4[j] - ti1 * i4[j]; } } }
        if (d == 0) {
            const float dsk = (dl == 0) ? A.in[I_SD][g * 16 + qo] : 0.f;
#pragma unroll
            for (int i = 0; i < 16; ++i) acc[0][i] += (i == qo) ? dsk : 0.f;
#pragma unroll
            for (int h = 0; h < 2; ++h)
#pragma unroll
                for (int i = 0; i < 4; ++i) *(LAS f32x4*)(KT + (31 + dl + 16 * h) * KTS + qo * 16 + 4 * i) = (f32x4){acc[h][4 * i], acc[h][4 * i + 1], acc[h][4 * i + 2], acc[h][4 * i + 3]};
        }
        __syncthreads();
        if (d == 1) {
#pragma unroll
            for (int h = 0; h < 2; ++h)
#pragma unroll
                for (int i = 0; i < 4; ++i) { LAS f32x4* kp = (LAS f32x4*)(KT + (31 - dl - 16 * h) * KTS + qo * 16 + 4 * i); f32x4 v = (f32x4){acc[h][4 * i], acc[h][4 * i + 1], acc[h][4 * i + 2], acc[h][4 * i + 3]}; if (dl + 16 * h == 0) v = v + *kp; *kp = v; }
        }
        __syncthreads();
    }
    for (int pc = tid; pc < 512 * 64; pc += NWAVES * 64) {
        const int n = pc >> 6, kp = pc & 63, t = n >> 4, qo = n & 15, j = kp >> 1, qi0 = (kp & 1) * 8; const LAS float* s = KT + (t - j + 31) * KTS + qo * 16 + qi0;
        const f32x4 s0 = *(const LAS f32x4*)s, s1 = *(const LAS f32x4*)(s + 4);
        v4u o; o.x = cvtpk(s0.x, s0.y); o.y = cvtpk(s0.z, s0.w); o.z = cvtpk(s1.x, s1.y); o.w = cvtpk(s1.z, s1.w);
        *(v4u*)(BtOut + (size_t)n * 768 + kp * 8) = o; }
    } else {
    {
        const int pb = tid & 7, d = (tid >> 3) & 1, qo = (tid >> 4) & 15, th = tid >> 8, p0 = pb * 8;
        f32x2 w[8], lam[8], c[8];
#pragma unroll
        for (int i = 0; i < 8; ++i) { w[i] = POW[PWI(d, p0 + i, 1 + 16 * th)]; lam[i] = POW[PWI(d, p0 + i, 1)]; c[i] = CC[CCI(d, qo, p0 + i)]; }
#pragma unroll 2
        for (int st = 0; st < 16; ++st) { const int m = 1 + 16 * th + st, t = d == 0 ? m - 1 : 32 - m; float re[8], im[8];
#pragma unroll
            for (int i = 0; i < 8; ++i) { re[i] = c[i].x * w[i].x - c[i].y * w[i].y; im[i] = -(c[i].x * w[i].y + c[i].y * w[i].x);
                const float nr = w[i].x * lam[i].x - w[i].y * lam[i].y, ni = w[i].x * lam[i].y + w[i].y * lam[i].x; w[i] = (f32x2){nr, ni}; }
            bf16* dst = BtOut + (size_t)(t * 16 + qo) * 768 + 512 + d * 128 + p0;
            v4u o; o.x = cvtpk(re[0], re[1]); o.y = cvtpk(re[2], re[3]); o.z = cvtpk(re[4], re[5]); o.w = cvtpk(re[6], re[7]); *(v4u*)dst = o;
            o.x = cvtpk(im[0], im[1]); o.y = cvtpk(im[2], im[3]); o.z = cvtpk(im[4], im[5]); o.w = cvtpk(im[6], im[7]); *(v4u*)(dst + 64) = o; }
    }
    for (int pc = tid; pc < 256 * 64; pc += NWAVES * 64) {
        const int n = pc >> 6, kp = pc & 63, d = n >> 7, ri = (n >> 6) & 1, p = n & 63, j = kp >> 1, qi0 = (kp & 1) * 8, m = d == 0 ? 31 - j : j; const f32x2 w = POW[PWI(d, p, m)];
        const LAS f32x4* brp = (const LAS f32x4*)(BBr + (d * 64 + p) * 16 + qi0); const LAS f32x4* bip = (const LAS f32x4*)(BBi + (d * 64 + p) * 16 + qi0);
        const f32x4 br0 = brp[0], br1 = brp[1], bi0 = bip[0], bi1 = bip[1];
        const f32x4 v0 = ri == 0 ? (br0 * w.x - bi0 * w.y) : (bi0 * w.x + br0 * w.y), v1 = ri == 0 ? (br1 * w.x - bi1 * w.y) : (bi1 * w.x + br1 * w.y);
        v4u o; o.x = cvtpk(v0[0], v0[1]); o.y = cvtpk(v0[2], v0[3]); o.z = cvtpk(v1[0], v1[1]); o.w = cvtpk(v1[2], v1[3]);
        *(v4u*)(WEnd + (size_t)n * 512 + kp * 8) = o; }
    }
    __syncthreads();
#undef PWI
#undef CCI
}
__device__ __forceinline__ unsigned q8pack(float a, float b, float c, float d) { const int ia = (int)rintf(a), ib = (int)rintf(b), ic = (int)rintf(c), id = (int)rintf(d);
    return (unsigned)(ia & 255) | ((unsigned)(ib & 255) << 8) | ((unsigned)(ic & 255) << 16) | ((unsigned)(id & 255) << 24); }
__device__ __forceinline__ void cvt_item(const float* W, int K, int N, int ldw, bf16* WT, int mode, int item, LAS float* scr, int lane, unsigned* colmax = nullptr, float* pmax = nullptr) {
    const int nblk = N / 32, kb = item / nblk, nb = item - kb * nblk, k0 = 64 * kb, n0 = 32 * nb;
    int r0 = n0;
    if (mode == 1) r0 = 256 * (n0 >> 7) + (n0 & 127);
    else if (mode == 2) r0 = 256 * (n0 >> 7) + 128 + (n0 & 127);
    else if (mode == 3) { if (n0 < 1536) { const int pn = n0 >> 8, rem = n0 & 255; r0 = 256 * pn + 128 * ((rem & 63) >> 5) + 32 * (rem >> 6); }
                          else if (n0 < 2048) { const int n1 = n0 - 1536; r0 = 256 * (6 + (n1 >> 7)) + (n1 & 127); }
                          else { const int n1 = n0 - 2048; r0 = 256 * (6 + (n1 >> 7)) + 128 + (n1 & 127); } }
    { f32x4 v[8];
#pragma unroll
      for (int i = 0; i < 8; ++i) v[i] = *(const f32x4*)(W + (size_t)(k0 + 8 * i + (lane >> 3)) * ldw + n0 + 4 * (lane & 7));
#pragma unroll
      for (int i = 0; i < 8; ++i) { LAS float* d = scr + (8 * i + (lane >> 3)) * 33 + 4 * (lane & 7); d[0] = v[i].x; d[1] = v[i].y; d[2] = v[i].z; d[3] = v[i].w; } }
    LDS_WAIT(); asm volatile("" ::: "memory");
    const int c = lane & 7;
#pragma unroll
    for (int j = 0; j < 4; ++j) { const int n = (lane >> 3) + 8 * j; const LAS float* s = scr + (8 * c) * 33 + n;
        v4u o; o.x = cvtpk(s[0 * 33], s[1 * 33]); o.y = cvtpk(s[2 * 33], s[3 * 33]); o.z = cvtpk(s[4 * 33], s[5 * 33]); o.w = cvtpk(s[6 * 33], s[7 * 33]);
        *(GAS v4u*)(WT + (size_t)(r0 + n) * K + k0 + 8 * c) = o;
        if (colmax || pmax) { float mx = fmaxf(fmaxf(fmaxf(fabsf(s[0 * 33]), fabsf(s[1 * 33])), fmaxf(fabsf(s[2 * 33]), fabsf(s[3 * 33]))), fmaxf(fmaxf(fabsf(s[4 * 33]), fabsf(s[5 * 33])), fmaxf(fabsf(s[6 * 33]), fabsf(s[7 * 33]))));
            mx = fmaxf(mx, __shfl_xor(mx, 1)); mx = fmaxf(mx, __shfl_xor(mx, 2)); mx = fmaxf(mx, __shfl_xor(mx, 4));
            if (c == 0) { if (colmax) __hip_atomic_fetch_max(colmax + r0 + n, __builtin_bit_cast(unsigned, mx), RLX_AGENT); else pmax[(size_t)(r0 + n) * (K / 64) + kb] = mx; } } }
    LDS_WAIT(); asm volatile("" ::: "memory");
}
constexpr int CV_IM = 16 * 112, CV_IM2 = 56 * 32, CV_NMOE = NE * (2 * CV_IM + CV_IM2);
__device__ __forceinline__ void p0_convert(const Args& A, LAS unsigned char* lds, int gw, int NGW, int wave, int lane) {
    LAS float* scr = (LAS float*)(lds + wave * 16384);
    unsigned char* ws = A.ws;
    constexpr int I0 = 16 * 80, I1 = 16 * 32, I2 = 16 * 88, I3 = 44 * 32, I4 = 16 * 32, I5 = 16 * 32;
    constexpr int NSMALL = I0 + I1 + 2 * I2 + I3 + I4 + 2 * I5;
    for (int it = gw; it < NSMALL; it += NGW) {
        int r = it;
        if (r < I0) { cvt_item(A.in[I_MIXWIN], D, MIXIN, MIXIN, (bf16*)(ws + WS_WIN), 3, r, scr, lane, nullptr, (float*)(ws + WS_PMAX)); continue; } r -= I0;
        if (r < I1) { cvt_item(A.in[I_MIXWOUT], D, D, D, (bf16*)(ws + WS_WOUT), 0, r, scr, lane); continue; } r -= I1;
        if (r < I2) { cvt_item(A.in[I_FW1], D, FFN, FFN, (bf16*)(ws + WS_W13), 1, r, scr, lane, nullptr, (float*)(ws + WS_PMAX) + MIXIN * 16); continue; } r -= I2;
        if (r < I2) { cvt_item(A.in[I_FW3], D, FFN, FFN, (bf16*)(ws + WS_W13), 2, r, scr, lane, nullptr, (float*)(ws + WS_PMAX) + MIXIN * 16); continue; } r -= I2;
        if (r < I3) { cvt_item(A.in[I_FW2], FFN, D, D, (bf16*)(ws + WS_W2), 0, r, scr, lane); continue; } r -= I3;
        if (r < I4) { cvt_item(A.in[I_SWIN], D, D, D, (bf16*)(ws + WS_SIN), 0, r, scr, lane); continue; } r -= I4;
        if (r < I5) { cvt_item(A.in[I_SWOUT], D, D, 2 * D, (bf16*)(ws + WS_SOUT), 1, r, scr, lane); continue; } r -= I5;
        cvt_item(A.in[I_SWOUT] + D, D, D, 2 * D, (bf16*)(ws + WS_SOUT), 2, r, scr, lane);
    }
}
constexpr int CV_NQ = NE * 2 * (ED / 64), CV_NW2 = NE * (CV_IM2 / 16), CV_NUNITS = CV_NQ + CV_NW2, CQ_P = 514;
__device__ __forceinline__ void moe_convert(const Args& A, LAS unsigned char* lds, int first, int count, int wgi, int nwg, int tid, int wave, int lane) {
    LAS unsigned* T = (LAS unsigned*)lds; LAS float* scr = (LAS float*)(lds + wave * 16384);
    unsigned char* ws = A.ws;
    const int last = (first + count) < CV_NUNITS ? (first + count) : CV_NUNITS;
    const int c = tid & 15, rr = tid >> 4;
    f32x4 v[32];
#define CQ_LOAD(u_) do { const int e_ = (u_) / 112, r_ = (u_) - e_ * 112, wh_ = r_ / 56, nb_ = r_ - wh_ * 56; const float* W_ = (wh_ ? A.in[I_MW3] : A.in[I_MW1]) + (size_t)e_ * D * ED + 64 * nb_ + 4 * c; \
        _Pragma("unroll") for (int i = 0; i < 32; ++i) v[i] = *(const f32x4*)(W_ + (size_t)(2 * rr + (i & 1) + 64 * (i >> 1)) * ED); } while (0)
    int u = first + wgi;
    if (u < last && u < CV_NQ) CQ_LOAD(u);
    for (; u < last; u += nwg) {
        __syncthreads();
        if (u < CV_NQ) {
#pragma unroll
            for (int j = 0; j < 16; ++j)
#pragma unroll
                for (int q = 0; q < 4; ++q) T[(4 * c + q) * CQ_P + rr + 32 * j] = cvtpk(v[2 * j][q], v[2 * j + 1][q]);
            __syncthreads();
            const int un = u + nwg; if (un < last && un < CV_NQ) CQ_LOAD(un);
            const int e = u / 112, r = u - e * 112, wh = r / 56, n0 = 64 * (r - wh * 56), r0 = e * 2 * ED + 256 * (n0 >> 7) + 128 * wh + (n0 & 127) + 8 * wave;
#pragma unroll 4
            for (int q = 0; q < 8; ++q) { const LAS unsigned* col = T + (8 * wave + q) * CQ_P + 2 * lane;
                const v2u d0 = *(const LAS v2u*)col, d1 = *(const LAS v2u*)(col + 128), d2 = *(const LAS v2u*)(col + 256), d3 = *(const LAS v2u*)(col + 384);
                const float x[16] = {bflo(d0.x), bfhi(d0.x), bflo(d0.y), bfhi(d0.y), bflo(d1.x), bfhi(d1.x), bflo(d1.y), bfhi(d1.y), bflo(d2.x), bfhi(d2.x), bflo(d2.y), bfhi(d2.y), bflo(d3.x), bfhi(d3.x), bflo(d3.y), bfhi(d3.y)};
                float am = 0.f;
#pragma unroll
                for (int i = 0; i < 16; ++i) am = fmaxf(am, fabsf(x[i]));
                am = wave_max(am); const float inv = am > 0.f ? 127.0f / am : 0.f;
                unsigned char* dst = ws + WS_MW13 + (size_t)(r0 + q) * 1024 + 4 * lane;
                *(unsigned*)dst = q8pack(x[0] * inv, x[1] * inv, x[2] * inv, x[3] * inv); *(unsigned*)(dst + 256) = q8pack(x[4] * inv, x[5] * inv, x[6] * inv, x[7] * inv);
                *(unsigned*)(dst + 512) = q8pack(x[8] * inv, x[9] * inv, x[10] * inv, x[11] * inv); *(unsigned*)(dst + 768) = q8pack(x[12] * inv, x[13] * inv, x[14] * inv, x[15] * inv);
                if (lane == 0) ((float*)(ws + WS_COLSC))[r0 + q] = am * (1.0f / 127.0f); }
        } else {
            const int g = u - CV_NQ, e = g / (CV_IM2 / 16), gi = g - e * (CV_IM2 / 16);
#pragma unroll 1
            for (int i = 0; i < 2; ++i) cvt_item(A.in[I_MW2] + (size_t)e * ED * D, ED, D, D, (bf16*)(ws + WS_MW2) + (size_t)e * D * ED, 0, 16 * gi + 2 * wave + i, scr, lane);
        }
    }
#undef CQ_LOAD
}
__device__ __forceinline__ void shw_rows(const bf16* WT, int N, const float* sh, float* out, int widx, int nw, LAS unsigned char* lds, int tid, int lane, const float* colscale = nullptr) {
    LAS float* shl = (LAS float*)lds;
    __syncthreads();
    { float tv[18];
#pragma unroll
      for (int j = 0; j < 18; ++j) { const int i = tid + NWAVES * 64 * j; tv[j] = sh[(size_t)(i >> 10) * 6144 + (i & 1023)]; }
#pragma unroll
      for (int j = 0; j < 18; ++j) shl[tid + NWAVES * 64 * j] = tv[j]; }
    __syncthreads();
    for (int pb = widx; pb < N; pb += 4 * nw) {
        v4u qa[4], qb[4]; float cs[4];
#pragma unroll
        for (int r = 0; r < 4; ++r) { const int p = (pb + r * nw < N) ? pb + r * nw : pb;
            if (colscale) { qa[r] = *(const v4u*)((const unsigned char*)(WT + (size_t)p * D) + 16 * lane); qb[r] = qa[r]; cs[r] = colscale[p]; }
            else { qa[r] = *(const v4u*)(WT + (size_t)p * D + 16 * lane); qb[r] = *(const v4u*)(WT + (size_t)p * D + 16 * lane + 8); cs[r] = 1.f; } }
#pragma unroll
        for (int r = 0; r < 4; ++r) { const int p = pb + r * nw; if (p < N) {
            float w[16];
            if (colscale) { const unsigned qq[4] = {qa[r].x, qa[r].y, qa[r].z, qa[r].w};
#pragma unroll
                for (int i = 0; i < 16; ++i) w[i] = (float)(int)(signed char)((qq[i >> 2] >> (8 * (i & 3))) & 255u) * cs[r]; }
            else { const v4u w0 = qa[r], w1 = qb[r];
                const float t[16] = {bflo(w0.x), bfhi(w0.x), bflo(w0.y), bfhi(w0.y), bflo(w0.z), bfhi(w0.z), bflo(w0.w), bfhi(w0.w), bflo(w1.x), bfhi(w1.x), bflo(w1.y), bfhi(w1.y), bflo(w1.z), bfhi(w1.z), bflo(w1.w), bfhi(w1.w)};
#pragma unroll
                for (int i = 0; i < 16; ++i) w[i] = t[i]; }
            float sm[9];
#pragma unroll
            for (int b = 0; b < 9; ++b) { const LAS f32x4* sp = (const LAS f32x4*)(shl + b * 1024 + 16 * lane); float a = 0.f;
#pragma unroll
                for (int q = 0; q < 4; ++q) { const f32x4 v = sp[q]; a += (v.x * w[4 * q] + v.y * w[4 * q + 1]) + (v.z * w[4 * q + 2] + v.w * w[4 * q + 3]); }
                sm[b] = a; }
#pragma unroll
            for (int b = 0; b < 9; ++b) sm[b] = wave_sum(sm[b]);
            if (lane < 9) { float v = sm[0];
#pragma unroll
                for (int b = 1; b < 9; ++b) v = (lane == b) ? sm[b] : v;
                out[(size_t)lane * N + p] = v; } } }
    }
    __syncthreads();
}
__device__ __forceinline__ void quant_rows_inplace(bf16* W, unsigned* colmax, int nrows, int gw, int NGW, int lane) {
    for (int r0 = gw; r0 < nrows; r0 += 2 * NGW) {
        const int r1 = (r0 + NGW < nrows) ? r0 + NGW : r0; const int nr = (r0 + NGW < nrows) ? 2 : 1;
        v4u a[2][2]; float mx[2];
#pragma unroll
        for (int u = 0; u < 2; ++u) { const int r = u ? r1 : r0; const bf16* rp = W + (size_t)r * 1024 + 16 * lane; a[u][0] = *(const v4u*)rp; a[u][1] = *(const v4u*)(rp + 8); mx[u] = __builtin_bit_cast(float, colmax[r]); }
        asm volatile("s_waitcnt vmcnt(0)" ::: "memory");
#pragma unroll
        for (int u = 0; u < 2; ++u) { if (u < nr) { const int r = u ? r1 : r0; const float inv = mx[u] > 0.f ? 127.0f / mx[u] : 0.f; v4u o;
            o.x = q8pack(bflo(a[u][0].x) * inv, bfhi(a[u][0].x) * inv, bflo(a[u][0].y) * inv, bfhi(a[u][0].y) * inv); o.y = q8pack(bflo(a[u][0].z) * inv, bfhi(a[u][0].z) * inv, bflo(a[u][0].w) * inv, bfhi(a[u][0].w) * inv);
            o.z = q8pack(bflo(a[u][1].x) * inv, bfhi(a[u][1].x) * inv, bflo(a[u][1].y) * inv, bfhi(a[u][1].y) * inv); o.w = q8pack(bflo(a[u][1].z) * inv, bfhi(a[u][1].z) * inv, bflo(a[u][1].w) * inv, bfhi(a[u][1].w) * inv);
            *(v4u*)((unsigned char*)(W + (size_t)r * 1024) + 16 * lane) = o;
            if (lane == 0) ((float*)colmax)[r] = mx[u] * (1.0f / 127.0f); } }
    }
}
__device__ __forceinline__ void quant_rows_f8_inplace(bf16* W, float* scale, int nrows, int gw, int NGW, int lane) {
    for (int r0 = gw; r0 < nrows; r0 += 2 * NGW) {
        const int r1 = (r0 + NGW < nrows) ? r0 + NGW : r0; const int nr = (r0 + NGW < nrows) ? 2 : 1;
        v4u a[2][7];
#pragma unroll
        for (int u = 0; u < 2; ++u) { const bf16* rp = W + (size_t)(u ? r1 : r0) * 3584 + 8 * lane;
#pragma unroll
            for (int c = 0; c < 7; ++c) a[u][c] = *(const v4u*)(rp + 512 * c); }
        asm volatile("s_waitcnt vmcnt(0)" ::: "memory");
#pragma unroll
        for (int u = 0; u < 2; ++u) { if (u < nr) { const int r = u ? r1 : r0; float am = 0.f;
#pragma unroll
            for (int c = 0; c < 7; ++c) { am = fmaxf(am, fmaxf(fmaxf(fabsf(bflo(a[u][c].x)), fabsf(bfhi(a[u][c].x))), fmaxf(fabsf(bflo(a[u][c].y)), fabsf(bfhi(a[u][c].y)))));
                am = fmaxf(am, fmaxf(fmaxf(fabsf(bflo(a[u][c].z)), fabsf(bfhi(a[u][c].z))), fmaxf(fabsf(bflo(a[u][c].w)), fabsf(bfhi(a[u][c].w))))); }
            am = wave_max(am); const float inv = am > 0.f ? 448.0f / am : 0.f;
#pragma unroll
            for (int c = 0; c < 7; ++c) { v2u o;
                o.x = pg8::f8pack4((f32x4){bflo(a[u][c].x), bfhi(a[u][c].x), bflo(a[u][c].y), bfhi(a[u][c].y)} * inv); o.y = pg8::f8pack4((f32x4){bflo(a[u][c].z), bfhi(a[u][c].z), bflo(a[u][c].w), bfhi(a[u][c].w)} * inv);
                *(v2u*)((unsigned char*)(W + (size_t)r * 3584) + 8 * lane + 512 * c) = o; }
            if (lane == 0) scale[r] = am * (1.0f / 448.0f); } }
    }
}
__device__ __forceinline__ void quant_rows_f8_1k(bf16* W, float* scale, int nrows, int gw, int NGW, int lane) {
    for (int r = gw; r < nrows; r += NGW) {
        const bf16* rp = W + (size_t)r * 1024 + 16 * lane; const v4u a0 = *(const v4u*)rp, a1 = *(const v4u*)(rp + 8);
        asm volatile("s_waitcnt vmcnt(0)" ::: "memory");
        const f32x4 v0 = (f32x4){bflo(a0.x), bfhi(a0.x), bflo(a0.y), bfhi(a0.y)}, v1 = (f32x4){bflo(a0.z), bfhi(a0.z), bflo(a0.w), bfhi(a0.w)}, v2 = (f32x4){bflo(a1.x), bfhi(a1.x), bflo(a1.y), bfhi(a1.y)}, v3 = (f32x4){bflo(a1.z), bfhi(a1.z), bflo(a1.w), bfhi(a1.w)};
        float am = 0.f;
#pragma unroll
        for (int i = 0; i < 4; ++i) am = fmaxf(am, fmaxf(fmaxf(fabsf(v0[i]), fabsf(v1[i])), fmaxf(fabsf(v2[i]), fabsf(v3[i]))));
        am = wave_max(am); const float inv = am > 0.f ? 448.0f / am : 0.f;
        v4u o; o.x = pg8::f8pack4(v0 * inv); o.y = pg8::f8pack4(v1 * inv); o.z = pg8::f8pack4(v2 * inv); o.w = pg8::f8pack4(v3 * inv);
        *(v4u*)((unsigned char*)(W + (size_t)r * 1024) + 16 * lane) = o;
        if (lane == 0) scale[r] = am * (1.0f / 448.0f);
    }
}
__device__ __forceinline__ void quant_rows_inplace_p(bf16* W, const float* pmax, float* colscale, int nrows, int gw, int NGW, int lane) {
    for (int r = gw; r < nrows; r += NGW) {
        const bf16* rp = W + (size_t)r * 1024 + 16 * lane; const v4u a0 = *(const v4u*)rp, a1 = *(const v4u*)(rp + 8);
        const float mx = wave_max(pmax[(size_t)r * 16 + (lane & 15)]);
        asm volatile("s_waitcnt vmcnt(0)" ::: "memory");
        const float inv = mx > 0.f ? 127.0f / mx : 0.f; v4u o;
        o.x = q8pack(bflo(a0.x) * inv, bfhi(a0.x) * inv, bflo(a0.y) * inv, bfhi(a0.y) * inv); o.y = q8pack(bflo(a0.z) * inv, bfhi(a0.z) * inv, bflo(a0.w) * inv, bfhi(a0.w) * inv);
        o.z = q8pack(bflo(a1.x) * inv, bfhi(a1.x) * inv, bflo(a1.y) * inv, bfhi(a1.y) * inv); o.w = q8pack(bflo(a1.z) * inv, bfhi(a1.z) * inv, bflo(a1.w) * inv, bfhi(a1.w) * inv);
        *(v4u*)((unsigned char*)(W + (size_t)r * 1024) + 16 * lane) = o;
        if (lane == 0) colscale[r] = mx * (1.0f / 127.0f);
    }
}
__device__ __forceinline__ void quant_act_rows(const bf16* XLp, const bf16* XCp, const float* ngain, const float* nscale, unsigned char* Hq, const float* rowss, float* rowfac, LAS unsigned char* lds, int tid, int gw, int NGW, int lane) {
    LAS float* gsl = (LAS float*)lds;
    __syncthreads();
    for (int i = tid; i < 9 * 1024; i += NWAVES * 64) gsl[i] = ngain[i & 1023] * (1.0f + nscale[(size_t)(i >> 10) * 6144 + (i & 1023)]);
    __syncthreads();
    for (int r0 = gw; r0 < MT; r0 += 2 * NGW) {
        const int r1 = (r0 + NGW < MT) ? r0 + NGW : r0; const int nr = (r0 + NGW < MT) ? 2 : 1;
        v4u a[2][2]; float ssq[2];
#pragma unroll
        for (int u = 0; u < 2; ++u) { const int r = u ? r1 : r0; const bf16* rp = (r < ML ? XLp + (size_t)r * 1024 : XCp + (size_t)(r - ML) * 1024) + 16 * lane; a[u][0] = *(const v4u*)rp; a[u][1] = *(const v4u*)(rp + 8); ssq[u] = rowss[(size_t)r * 16 + (lane & 15)]; }
#pragma unroll
        for (int u = 0; u < 2; ++u) { if (u < nr) { const int r = u ? r1 : r0; const LAS f32x4* gp = (const LAS f32x4*)(gsl + (r < ML ? (r >> 11) : 8) * 1024 + 16 * lane);
            const f32x4 g0 = gp[0], g1 = gp[1], g2 = gp[2], g3 = gp[3];
            const float v[16] = {bflo(a[u][0].x) * g0[0], bfhi(a[u][0].x) * g0[1], bflo(a[u][0].y) * g0[2], bfhi(a[u][0].y) * g0[3], bflo(a[u][0].z) * g1[0], bfhi(a[u][0].z) * g1[1], bflo(a[u][0].w) * g1[2], bfhi(a[u][0].w) * g1[3],
                                 bflo(a[u][1].x) * g2[0], bfhi(a[u][1].x) * g2[1], bflo(a[u][1].y) * g2[2], bfhi(a[u][1].y) * g2[3], bflo(a[u][1].z) * g3[0], bfhi(a[u][1].z) * g3[1], bflo(a[u][1].w) * g3[2], bfhi(a[u][1].w) * g3[3]};
            float am = 0.f;
#pragma unroll
            for (int i = 0; i < 16; ++i) am = fmaxf(am, fabsf(v[i]));
            am = wave_max(am); const float inv = am > 0.f ? 127.0f / am : 0.f;
            float sq = (lane < 16) ? ssq[u] : 0.f; sq = wave_sum(sq);
            v4u o; o.x = q8pack(v[0] * inv, v[1] * inv, v[2] * inv, v[3] * inv); o.y = q8pack(v[4] * inv, v[5] * inv, v[6] * inv, v[7] * inv);
            o.z = q8pack(v[8] * inv, v[9] * inv, v[10] * inv, v[11] * inv); o.w = q8pack(v[12] * inv, v[13] * inv, v[14] * inv, v[15] * inv);
            *(v4u*)(Hq + (size_t)r * 2048 + 16 * lane) = o;
            if (lane == 0) rowfac[r] = rsqrtf(sq * (1.0f / 1024.0f) + EPS) * am * (1.0f / 127.0f); } }
    }
}
__device__ __forceinline__ void p1_quant_weights(unsigned char* ws, int gw, int NGW, int lane) {
    bf16* WI = (bf16*)(ws + WS_WIN); bf16* W13 = (bf16*)(ws + WS_W13); bf16* WS_ = (bf16*)(ws + WS_SOUT);
    const float* pmI = (const float*)(ws + WS_PMAX); const float* pm13 = pmI + MIXIN * 16; float* csI = (float*)(ws + WS_COLSCD); float* cs13 = csI + MIXIN; float* csS = (float*)(ws + WS_COLSCS);
    for (int it = 0; ; ++it) {
        int rr[6]; bool ok[6];
#pragma unroll
        for (int i = 0; i < 2; ++i) { rr[i] = gw + NGW * (2 * it + i); ok[i] = rr[i] < MIXIN; }
#pragma unroll
        for (int i = 0; i < 3; ++i) { rr[2 + i] = gw + NGW * (3 * it + i); ok[2 + i] = rr[2 + i] < 2 * FFN; }
        rr[5] = gw + NGW * it; ok[5] = rr[5] < 2 * D;
        if (!(ok[0] || ok[2] || ok[5])) break;
        v4u a[6][2]; float pm[5];
#pragma unroll
        for (int i = 0; i < 6; ++i) { bf16* W = i < 2 ? WI : (i < 5 ? W13 : WS_); const int r = ok[i] ? rr[i] : 0; const bf16* rp = W + (size_t)r * 1024 + 16 * lane; a[i][0] = *(const v4u*)rp; a[i][1] = *(const v4u*)(rp + 8);
            if (i < 5) pm[i] = (i < 2 ? pmI : pm13)[(size_t)r * 16 + (lane & 15)]; }
        asm volatile("s_waitcnt vmcnt(0)" ::: "memory");
#pragma unroll
        for (int i = 0; i < 6; ++i) { if (ok[i]) { bf16* W = i < 2 ? WI : (i < 5 ? W13 : WS_); const int r = rr[i];
            const f32x4 v0 = (f32x4){bflo(a[i][0].x), bfhi(a[i][0].x), bflo(a[i][0].y), bfhi(a[i][0].y)}, v1 = (f32x4){bflo(a[i][0].z), bfhi(a[i][0].z), bflo(a[i][0].w), bfhi(a[i][0].w)},
                        v2 = (f32x4){bflo(a[i][1].x), bfhi(a[i][1].x), bflo(a[i][1].y), bfhi(a[i][1].y)}, v3 = (f32x4){bflo(a[i][1].z), bfhi(a[i][1].z), bflo(a[i][1].w), bfhi(a[i][1].w)};
            v4u o;
            if (i < 5) { const float mx = wave_max(pm[i]), inv = mx > 0.f ? 127.0f / mx : 0.f;
                o.x = q8pack(v0[0] * inv, v0[1] * inv, v0[2] * inv, v0[3] * inv); o.y = q8pack(v1[0] * inv, v1[1] * inv, v1[2] * inv, v1[3] * inv);
                o.z = q8pack(v2[0] * inv, v2[1] * inv, v2[2] * inv, v2[3] * inv); o.w = q8pack(v3[0] * inv, v3[1] * inv, v3[2] * inv, v3[3] * inv);
                if (lane == 0) (i < 2 ? csI : cs13)[r] = mx * (1.0f / 127.0f); }
            else { float am = 0.f;
#pragma unroll
                for (int q = 0; q < 4; ++q) am = fmaxf(am, fmaxf(fmaxf(fabsf(v0[q]), fabsf(v1[q])), fmaxf(fabsf(v2[q]), fabsf(v3[q]))));
                am = wave_max(am); const float inv = am > 0.f ? 448.0f / am : 0.f;
                o.x = pg8::f8pack4(v0 * inv); o.y = pg8::f8pack4(v1 * inv); o.z = pg8::f8pack4(v2 * inv); o.w = pg8::f8pack4(v3 * inv);
                if (lane == 0) csS[r] = am * (1.0f / 448.0f); }
            *(v4u*)((unsigned char*)(W + (size_t)r * 1024) + 16 * lane) = o; } }
    }
}
__device__ __forceinline__ void quant_act_rows_wg(const bf16* XLp, const bf16* XCp, const float* ngain, const float* nscale, unsigned char* Hq, const float* rowss, float* rowfac, LAS unsigned char* lds, int tid, int bx, int wave, int lane) {
    LAS float* gsl = (LAS float*)lds;
    __syncthreads();
    for (int i = tid; i < 2 * 1024; i += NWAVES * 64) gsl[i] = ngain[i & 1023] * (1.0f + nscale[(size_t)(i < 1024 ? (bx >> 5) : 8) * 6144 + (i & 1023)]);
    __syncthreads();
#pragma unroll 1
    for (int p = 0; p < 5; ++p) {
        const int nr = p < 4 ? 2 : 1; const int r0 = p < 4 ? 64 * bx + 8 * wave + 2 * p : ML + 8 * bx + wave, r1 = nr == 2 ? r0 + 1 : r0;
        v4u a[2][2]; float ssq[2];
#pragma unroll
        for (int u = 0; u < 2; ++u) { const int r = u ? r1 : r0; const bf16* rp = (r < ML ? XLp + (size_t)r * 1024 : XCp + (size_t)(r - ML) * 1024) + 16 * lane; a[u][0] = *(const v4u*)rp; a[u][1] = *(const v4u*)(rp + 8); ssq[u] = rowss[(size_t)r * 16 + (lane & 15)]; }
#pragma unroll
        for (int u = 0; u < 2; ++u) { if (u < nr) { const int r = u ? r1 : r0; const LAS f32x4* gp = (const LAS f32x4*)(gsl + (r < ML ? 0 : 1024) + 16 * lane);
            const f32x4 g0 = gp[0], g1 = gp[1], g2 = gp[2], g3 = gp[3];
            const float v[16] = {bflo(a[u][0].x) * g0[0], bfhi(a[u][0].x) * g0[1], bflo(a[u][0].y) * g0[2], bfhi(a[u][0].y) * g0[3], bflo(a[u][0].z) * g1[0], bfhi(a[u][0].z) * g1[1], bflo(a[u][0].w) * g1[2], bfhi(a[u][0].w) * g1[3],
                                 bflo(a[u][1].x) * g2[0], bfhi(a[u][1].x) * g2[1], bflo(a[u][1].y) * g2[2], bfhi(a[u][1].y) * g2[3], bflo(a[u][1].z) * g3[0], bfhi(a[u][1].z) * g3[1], bflo(a[u][1].w) * g3[2], bfhi(a[u][1].w) * g3[3]};
            float am = 0.f;
#pragma unroll
            for (int i = 0; i < 16; ++i) am = fmaxf(am, fabsf(v[i]));
            am = wave_max(am); const float inv = am > 0.f ? 127.0f / am : 0.f;
            float sq = (lane < 16) ? ssq[u] : 0.f; sq = wave_sum(sq);
            v4u o; o.x = q8pack(v[0] * inv, v[1] * inv, v[2] * inv, v[3] * inv); o.y = q8pack(v[4] * inv, v[5] * inv, v[6] * inv, v[7] * inv);
            o.z = q8pack(v[8] * inv, v[9] * inv, v[10] * inv, v[11] * inv); o.w = q8pack(v[12] * inv, v[13] * inv, v[14] * inv, v[15] * inv);
            *(v4u*)(Hq + (size_t)r * 2048 + 16 * lane) = o;
            if (lane == 0) rowfac[r] = rsqrtf(sq * (1.0f / 1024.0f) + EPS) * am * (1.0f / 127.0f); } }
    }
}
template <int NPART> __device__ __forceinline__ void norm_row_finish(const f32x4 (&v)[4], int row, const float* gain, const float* mod, int shc, int scc, bf16* H, int lane) {
    const float* mp = mod + (size_t)(row < ML ? (row >> 11) : 8) * 6144; float ss = 0.f;
#pragma unroll
    for (int j = 0; j < 4; ++j) ss += (v[j].x * v[j].x + v[j].y * v[j].y) + (v[j].z * v[j].z + v[j].w * v[j].w);
    const float rstd = rsqrtf(wave_sum(ss) * (1.0f / D) + EPS);
#pragma unroll
    for (int j = 0; j < 4; ++j) { const int k = 4 * lane + 256 * j; const f32x4 gg = *(const f32x4*)(gain + k); f32x4 sc = *(const f32x4*)(mp + scc * 1024 + k), sh = *(const f32x4*)(mp + shc * 1024 + k);
#pragma unroll
        for (int q = 1; q < NPART; ++q) { sc = sc + *(const f32x4*)(mp + (size_t)q * MOD_N + scc * 1024 + k); sh = sh + *(const f32x4*)(mp + (size_t)q * MOD_N + shc * 1024 + k); }
        const f32x4 h = v[j] * rstd * gg * (sc + 1.0f) + sh;
        v2u o; o.x = cvtpk(h.x, h.y); o.y = cvtpk(h.z, h.w); *(v2u*)(H + (size_t)row * D + k) = o; }
}
__device__ __forceinline__ void norm_rows_lds(const float* xL, const float* xC, int nrows, const float* gain, const LAS float* ms, bf16* H, float* rowfac, int gw, int NGW, int lane) {
    for (int row = gw; row < nrows; row += 2 * NGW) {
        const int row1 = row + NGW; const bool two = row1 < nrows; const int r1 = two ? row1 : row;
        const float* xa = row < ML ? xL + (size_t)row * D : xC + (size_t)(row - ML) * D; const float* xb = r1 < ML ? xL + (size_t)r1 * D : xC + (size_t)(r1 - ML) * D;
        f32x4 vv[2][4];
#pragma unroll
        for (int j = 0; j < 4; ++j) { vv[0][j] = *(const f32x4*)(xa + 4 * lane + 256 * j); vv[1][j] = *(const f32x4*)(xb + 4 * lane + 256 * j); }
#pragma unroll
        for (int u = 0; u < 2; ++u) { if (u == 1 && !two) break; const int rw = u ? row1 : row; const LAS float* mp = ms + (rw < ML ? (rw >> 11) : 8) * 2048; float ss = 0.f;
#pragma unroll
            for (int j = 0; j < 4; ++j) ss += (vv[u][j].x * vv[u][j].x + vv[u][j].y * vv[u][j].y) + (vv[u][j].z * vv[u][j].z + vv[u][j].w * vv[u][j].w);
            const float rstd = rsqrtf(wave_sum(ss) * (1.0f / D) + EPS);
            f32x4 hq[4]; float am = 0.f;
#pragma unroll
            for (int j = 0; j < 4; ++j) { const int k = 4 * lane + 256 * j; const f32x4 gg = *(const f32x4*)(gain + k), sh = *(const LAS f32x4*)(mp + k), sc = *(const LAS f32x4*)(mp + 1024 + k);
                const f32x4 h = vv[u][j] * rstd * gg * (sc + 1.0f) + sh; hq[j] = h; am = fmaxf(am, fmaxf(fmaxf(fabsf(h.x), fabsf(h.y)), fmaxf(fabsf(h.z), fabsf(h.w)))); }
            am = wave_max(am); const float inv = am > 0.f ? 127.0f / am : 0.f;
#pragma unroll
            for (int j = 0; j < 4; ++j) *(unsigned*)((unsigned char*)H + (size_t)rw * D + 4 * lane + 256 * j) = q8pack(hq[j].x * inv, hq[j].y * inv, hq[j].z * inv, hq[j].w * inv);
            if (lane == 0) rowfac[rw] = am * (1.0f / 127.0f); }
    }
}
__device__ __forceinline__ void norm_rows_lds_wg(const float* xL, const float* xC, const float* gain, const LAS float* ms2, bf16* H, float* rowfac, int bx, int wave, int lane) {
    f32x4 gg[4];
#pragma unroll
    for (int j = 0; j < 4; ++j) gg[j] = *(const f32x4*)(gain + 4 * lane + 256 * j);
#pragma unroll 1
    for (int p = 0; p < 5; ++p) {
        const bool two = p < 4; const int ra = p < 4 ? 64 * bx + 8 * wave + 2 * p : ML + 8 * bx + wave, rb = two ? ra + 1 : ra;
        const float* xa = ra < ML ? xL + (size_t)ra * D : xC + (size_t)(ra - ML) * D; const float* xb = rb < ML ? xL + (size_t)rb * D : xC + (size_t)(rb - ML) * D;
        f32x4 vv[2][4];
#pragma unroll
        for (int j = 0; j < 4; ++j) { vv[0][j] = *(const f32x4*)(xa + 4 * lane + 256 * j); vv[1][j] = *(const f32x4*)(xb + 4 * lane + 256 * j); }
#pragma unroll
        for (int u = 0; u < 2; ++u) { if (u == 1 && !two) break; const int rw = u ? rb : ra; const LAS float* mp = ms2 + (rw < ML ? 0 : 2048); float ss = 0.f;
#pragma unroll
            for (int j = 0; j < 4; ++j) ss += (vv[u][j].x * vv[u][j].x + vv[u][j].y * vv[u][j].y) + (vv[u][j].z * vv[u][j].z + vv[u][j].w * vv[u][j].w);
            const float rstd = rsqrtf(wave_sum(ss) * (1.0f / D) + EPS);
            f32x4 hq[4]; float am = 0.f;
#pragma unroll
            for (int j = 0; j < 4; ++j) { const int k = 4 * lane + 256 * j; const f32x4 sh = *(const LAS f32x4*)(mp + k), sc = *(const LAS f32x4*)(mp + 1024 + k);
                const f32x4 h = vv[u][j] * rstd * gg[j] * (sc + 1.0f) + sh; hq[j] = h; am = fmaxf(am, fmaxf(fmaxf(fabsf(h.x), fabsf(h.y)), fmaxf(fabsf(h.z), fabsf(h.w)))); }
            am = wave_max(am); const float inv = am > 0.f ? 127.0f / am : 0.f;
#pragma unroll
            for (int j = 0; j < 4; ++j) *(unsigned*)((unsigned char*)H + (size_t)rw * D + 4 * lane + 256 * j) = q8pack(hq[j].x * inv, hq[j].y * inv, hq[j].z * inv, hq[j].w * inv);
            if (lane == 0) rowfac[rw] = am * (1.0f / 127.0f); }
    }
}
template <int NPART> __device__ __forceinline__ void norm_rows(const float* xL, const float* xC, int nrows, const float* gain, const float* mod, int shc, int scc, bf16* H, int gw, int NGW, int lane) {
    for (int row = gw; row < nrows; row += 2 * NGW) {
        const int row1 = row + NGW; const bool two = row1 < nrows; const int r1 = two ? row1 : row;
        const float* xa = row < ML ? xL + (size_t)row * D : xC + (size_t)(row - ML) * D; const float* xb = r1 < ML ? xL + (size_t)r1 * D : xC + (size_t)(r1 - ML) * D;
        f32x4 va[4], vb[4];
#pragma unroll
        for (int j = 0; j < 4; ++j) { va[j] = *(const f32x4*)(xa + 4 * lane + 256 * j); vb[j] = *(const f32x4*)(xb + 4 * lane + 256 * j); }
        norm_row_finish<NPART>(va, row, gain, mod, shc, scc, H, lane);
        if (two) norm_row_finish<NPART>(vb, row1, gain, mod, shc, scc, H, lane);
    }
}
constexpr int VSTR = 144;
__device__ __forceinline__ void attn_unit(const bf16* QKVU, bf16* MIX, int wu, LAS unsigned char* vl, LAS unsigned char* ql, const LAS float* rpbl, float bnd, int lane) {
    const bool isctx = wu >= 2048;
    int b, h, r = 0, qrow0;
    if (!isctx) { h = wu & 7; r = (wu >> 3) & 31; b = wu >> 8; qrow0 = b * SEQ + r * 64; }
    else { const int w = wu - 2048; h = w & 7; b = w >> 5; qrow0 = ML + b * NCTX + 64 * ((w >> 3) & 3); }
    const int c = lane & 31, hh = lane >> 5;
    const int rs = r < 4 ? 0 : (r > 28 ? 24 : r - 4);
    const int csA = c < 8 ? 0 : c - 8;
    const int csB = c > 24 ? 48 : c + 24;
    const LAS unsigned char* vtb = vl + (4 * hh + ((lane & 15) >> 2)) * VSTR + 32 * ((lane >> 4) & 1) + 8 * (lane & 3);
    LAS unsigned char* qs = ql + c * 128 + 16 * hh;
    bf16x8 qreg[8];
    { const bf16* qp = QKVU + (size_t)(qrow0 + c) * 2048 + h * 64 + 8 * hh;
#pragma unroll
      for (int s = 0; s < 4; ++s) { qreg[s] = *(const bf16x8*)(qp + 16 * s); qreg[4 + s] = *(const bf16x8*)(qp + (size_t)32 * 2048 + 16 * s); } }
    f32x16 oA0, oA1, oB0, oB1;
#pragma unroll
    for (int i = 0; i < 16; ++i) { oA0[i] = 0.f; oA1[i] = 0.f; oB0[i] = 0.f; oB1[i] = 0.f; }
    float lsA = 0.f, lsB = 0.f;
    const int nblk = isctx ? 8 : 24;
    const bf16* kbase = QKVU + 512 + h * 64 + 8 * hh + (size_t)c * 2048;
    const bf16* vbase = QKVU + 1024 + h * 64 + 8 * (lane & 7) + (size_t)(lane >> 3) * 2048;
#define ATT_KROW0(kb_) (((!isctx) && (kb_) < 16) ? (b * SEQ + (rs + ((kb_) >> 1)) * 64 + 32 * ((kb_) & 1)) : (ML + b * NCTX + 32 * (isctx ? (kb_) : (kb_) - 16)))
#define ATT_LOADK(KF, kb_) do { const int kq_ = (kb_) < nblk ? (kb_) : nblk - 1; const size_t ro_ = (size_t)ATT_KROW0(kq_) * 2048; \
        _Pragma("unroll") for (int s_ = 0; s_ < 4; ++s_) KF[s_] = *(const bf16x8*)(kbase + ro_ + 16 * s_); } while (0)
#define ATT_LOADV(VF, kb_) do { const int kq_ = (kb_) < nblk ? (kb_) : nblk - 1; const size_t ro_ = (size_t)ATT_KROW0(kq_) * 2048; \
        _Pragma("unroll") for (int i_ = 0; i_ < 4; ++i_) VF[i_] = *(const v4u*)(vbase + ro_ + (size_t)i_ * 8 * 2048); } while (0)
#define ATT_PACK(PF, P) do { _Pragma("unroll") for (int s = 0; s < 2; ++s) { v4u w; w.x = cvtpk(P[8 * s], P[8 * s + 1]); w.y = cvtpk(P[8 * s + 2], P[8 * s + 3]); w.z = cvtpk(P[8 * s + 4], P[8 * s + 5]); w.w = cvtpk(P[8 * s + 6], P[8 * s + 7]); PF[s] = __builtin_bit_cast(bf16x8, w); } } while (0)
#define ATT_BLOCK(KF, VF, kb_) do { const int kb = (kb_); const bool live = kb < nblk; const bool band = (!isctx) && kb < 16; const int kr = rs + (kb >> 1); \
        _Pragma("unroll") for (int i = 0; i < 4; ++i) { const int id = lane + 64 * i; *(LAS v4u*)(vl + (id >> 3) * VSTR + (id & 7) * 16) = VF[i]; } \
        ATT_LOADV(VF, kb + 1);              \
        f32x16 sA, sB; \
        _Pragma("unroll") for (int i = 0; i < 16; ++i) { sA[i] = 0.f; sB[i] = 0.f; } \
        _Pragma("unroll") for (int s = 0; s < 4; ++s) { sA = __builtin_amdgcn_mfma_f32_32x32x16_bf16(KF[s], *(const LAS bf16x8*)(qs + 32 * s), sA, 0, 0, 0); \
                                                        sB = __builtin_amdgcn_mfma_f32_32x32x16_bf16(KF[s], *(const LAS bf16x8*)(qs + 4096 + 32 * s), sB, 0, 0, 0); } \
        ATT_LOADK(KF, kb + 1);              \
        float pA[16], pB[16]; \
        if (band) { const int kc0 = 32 * (kb & 1) + 4 * hh; const LAS float* rb = rpbl + h * 465 + (kr - r + 7) * 31 + (kc0 - c); \
              \
            float bA[16], bB[16]; \
            _Pragma("unroll") for (int i = 0; i < 16; ++i) { bA[i] = rb[15 + (i & 3) + 8 * (i >> 2)]; bB[i] = rb[(i & 3) + 8 * (i >> 2) - 17]; } \
            const int tA = kc0 - csA, tB = kc0 - csB; \
            _Pragma("unroll") for (int i = 0; i < 16; ++i) { const int o = (i & 3) + 8 * (i >> 2); \
                { const bool ok = (unsigned)(tA + o) < 16u; const float e = __builtin_amdgcn_exp2f(sA[i] * 0.18033688f + bA[i]); pA[i] = ok ? e : 0.f; } \
                { const bool ok = (unsigned)(tB + o) < 16u; const float e = __builtin_amdgcn_exp2f(sB[i] * 0.18033688f + bB[i]); pB[i] = ok ? e : 0.f; } } \
        } else { \
            _Pragma("unroll") for (int i = 0; i < 16; ++i) { const float ea = __builtin_amdgcn_exp2f(sA[i] * 0.18033688f - bnd), eb = __builtin_amdgcn_exp2f(sB[i] * 0.18033688f - bnd); pA[i] = live ? ea : 0.f; pB[i] = live ? eb : 0.f; } } \
        _Pragma("unroll") for (int i = 0; i < 16; ++i) { lsA += pA[i]; lsB += pB[i]; } \
        bf16x8 fA[2], fB[2]; ATT_PACK(fA, pA); ATT_PACK(fB, pB); \
        LDS_WAIT(); \
        _Pragma("unroll") for (int dt = 0; dt < 2; ++dt) \
            _Pragma("unroll") for (int s = 0; s < 2; ++s) { \
                const s16x4 lo = vtr(vtb + (16 * s) * VSTR + 64 * dt), hi = vtr(vtb + (16 * s + 8) * VSTR + 64 * dt); \
                const bf16x8 af = (bf16x8){lo[0], lo[1], lo[2], lo[3], hi[0], hi[1], hi[2], hi[3]}; \
                if (dt == 0) { oA0 = __builtin_amdgcn_mfma_f32_32x32x16_bf16(af, fA[s], oA0, 0, 0, 0); oB0 = __builtin_amdgcn_mfma_f32_32x32x16_bf16(af, fB[s], oB0, 0, 0, 0); } \
                else { oA1 = __builtin_amdgcn_mfma_f32_32x32x16_bf16(af, fA[s], oA1, 0, 0, 0); oB1 = __builtin_amdgcn_mfma_f32_32x32x16_bf16(af, fB[s], oB1, 0, 0, 0); } } \
        } while (0)
    bf16x8 kA[4]; v4u vA[4];
    ATT_LOADK(kA, 0); ATT_LOADV(vA, 0);
#pragma unroll
    for (int s = 0; s < 4; ++s) { *(LAS bf16x8*)(qs + 32 * s) = qreg[s]; *(LAS bf16x8*)(qs + 4096 + 32 * s) = qreg[4 + s]; }
    for (int kb1 = 0; kb1 < nblk; ++kb1) ATT_BLOCK(kA, vA, kb1);
#undef ATT_KROW0
#undef ATT_LOADK
#undef ATT_LOADV
#undef ATT_PACK
#undef ATT_BLOCK
    lsA += __shfl_xor(lsA, 32); lsB += __shfl_xor(lsB, 32);
    const float iA = 1.0f / lsA, iB = 1.0f / lsB;
    bf16* op = MIX + (size_t)(qrow0 + c) * D + h * 64 + 4 * hh; bf16* oq = op + (size_t)32 * D;
#pragma unroll
    for (int i4 = 0; i4 < 4; ++i4) {
        v2u w0; w0.x = cvtpk(oA0[4 * i4] * iA, oA0[4 * i4 + 1] * iA); w0.y = cvtpk(oA0[4 * i4 + 2] * iA, oA0[4 * i4 + 3] * iA); *(v2u*)(op + 8 * i4) = w0;
        v2u w1; w1.x = cvtpk(oA1[4 * i4] * iA, oA1[4 * i4 + 1] * iA); w1.y = cvtpk(oA1[4 * i4 + 2] * iA, oA1[4 * i4 + 3] * iA); *(v2u*)(op + 32 + 8 * i4) = w1;
        v2u w2; w2.x = cvtpk(oB0[4 * i4] * iB, oB0[4 * i4 + 1] * iB); w2.y = cvtpk(oB0[4 * i4 + 2] * iB, oB0[4 * i4 + 3] * iB); *(v2u*)(oq + 8 * i4) = w2;
        v2u w3; w3.x = cvtpk(oB1[4 * i4] * iB, oB1[4 * i4 + 1] * iB); w3.y = cvtpk(oB1[4 * i4 + 2] * iB, oB1[4 * i4 + 3] * iB); *(v2u*)(oq + 32 + 8 * i4) = w3; }
}
template <int P0, int NP> __device__ __forceinline__ void conv_chunk(float (&acc)[32], const float (&w)[31], const LAS unsigned short* tile, int ch) {
    float v[NP];
#pragma unroll
    for (int i = 0; i < NP; ++i) v[i] = bf2f(tile[(P0 + i) * 512 + ch]);
#pragma unroll
    for (int i = 0; i < NP; ++i)
#pragma unroll
        for (int tt = 0; tt < 32; ++tt) { if (P0 + i - tt >= 0 && P0 + i - tt <= 30) acc[tt] += v[i] * w[(P0 + i - tt >= 0 && P0 + i - tt <= 30) ? P0 + i - tt : 0]; }
}
__device__ __forceinline__ void conv_item(const Args& A, const bf16* QKVU, bf16* MIX, int item, const float (&w)[31], float bias, LAS unsigned char* lds0, LAS float* cv, int tid, int wave, int lane) {
    __syncthreads();
    int rowbase, len, t0;
    if (item < 512) { rowbase = (item >> 6) * SEQ; len = SEQ; t0 = 32 * (item & 63); } else { const int i2 = item - 512; rowbase = ML + (i2 >> 3) * NCTX; len = NCTX; t0 = 32 * (i2 & 7); }
    const int ch = tid;
    LAS unsigned short* tile = (LAS unsigned short*)lds0;
    const f32x4 g0 = *(const f32x4*)(A.in[I_LNG] + 8 * lane), g1 = *(const f32x4*)(A.in[I_LNG] + 8 * lane + 4), b0 = *(const f32x4*)(A.in[I_LNB] + 8 * lane), b1 = *(const f32x4*)(A.in[I_LNB] + 8 * lane + 4);
    { v4u x[8];
#pragma unroll
      for (int i = 0; i < 8; ++i) { const int ri = wave + 8 * i, t = t0 - 15 + ri, tc = t < 0 ? 0 : (t >= len ? len - 1 : t); x[i] = *(const v4u*)(QKVU + (size_t)(rowbase + tc) * 2048 + 1536 + 8 * lane); if (t != tc) x[i] = (v4u){0u, 0u, 0u, 0u}; }
#pragma unroll
      for (int i = 0; i < 8; ++i) { const int ri = wave + 8 * i; if (ri < 62) *(LAS v4u*)(tile + ri * 512 + 8 * lane) = x[i]; } }
    float acc[32];
#pragma unroll
    for (int t = 0; t < 32; ++t) acc[t] = bias;
    __syncthreads();
    conv_chunk<0, 16>(acc, w, tile, ch); conv_chunk<16, 16>(acc, w, tile, ch); conv_chunk<32, 16>(acc, w, tile, ch); conv_chunk<48, 14>(acc, w, tile, ch);
#pragma unroll
    for (int t = 0; t < 32; ++t) cv[t * 512 + ch] = acc[t];
    __syncthreads();
#pragma unroll
    for (int q = 0; q < 4; ++q) { const int tt = 4 * wave + q;
        f32x4 x0 = *(const LAS f32x4*)(cv + tt * 512 + 8 * lane), x1 = *(const LAS f32x4*)(cv + tt * 512 + 8 * lane + 4);
        const float mean = wave_sum((x0.x + x0.y) + (x0.z + x0.w) + (x1.x + x1.y) + (x1.z + x1.w)) * (1.0f / 512.0f);
        x0 = x0 - mean; x1 = x1 - mean;
        const float var = wave_sum((x0.x * x0.x + x0.y * x0.y) + (x0.z * x0.z + x0.w * x0.w) + (x1.x * x1.x + x1.y * x1.y) + (x1.z * x1.z + x1.w * x1.w)) * (1.0f / 512.0f);
        const float rstd = rsqrtf(var + EPS);
        f32x4 y0 = x0 * rstd * g0 + b0, y1 = x1 * rstd * g1 + b1;
        y0 = (f32x4){y0.x * sigm(y0.x), y0.y * sigm(y0.y), y0.z * sigm(y0.z), y0.w * sigm(y0.w)}; y1 = (f32x4){y1.x * sigm(y1.x), y1.y * sigm(y1.y), y1.z * sigm(y1.z), y1.w * sigm(y1.w)};
        v4u o; o.x = cvtpk(y0.x, y0.y); o.y = cvtpk(y0.z, y0.w); o.z = cvtpk(y1.x, y1.y); o.w = cvtpk(y1.z, y1.w);
        *(v4u*)(MIX + (size_t)(rowbase + t0 + tt) * D + 512 + 8 * lane) = o; }
    __syncthreads();
}
__device__ __forceinline__ void s5_scan(const Args& A, int gt) {
    if (gt >= NB * 64 * 2 * 64) return;
    const int p = gt & 63, d = (gt >> 6) & 1, g = (gt >> 7) & 63, b = gt >> 13;
    const int ix = (d * 64 + g) * 64 + p;
    const float ar = A.in[I_ARE][ix], ai = A.in[I_AIM][ix], dt = __expf(A.in[I_LOGDT][d * 64 + g]);
    const float zr = ar * dt, zi = ai * dt, mag = __expf(zr); float lr = mag * cosf(zi), li = mag * sinf(zi);
#pragma unroll
    for (int k = 0; k < 5; ++k) { const float nr = lr * lr - li * li, ni = 2.f * lr * li; lr = nr; li = ni; }
    const float* E = (const float*)(A.ws + WS_E) + (size_t)g * 768 * 256 + d * 128 + p;
    bf16* UC = (bf16*)(A.ws + WS_UC) + (size_t)g * 768 * 768 + 512 + d * 128 + p;
    float sr = 0.f, si = 0.f;
    for (int s0 = 0; s0 < 72; s0 += 24) {
        float er[24], ei[24]; int bcs[24];
#pragma unroll
        for (int k = 0; k < 24; ++k) { const int step = s0 + k; int bc;
            if (step < 8) bc = 512 + 8 * b + (d == 0 ? step : 7 - step); else bc = 64 * b + (d == 0 ? step - 8 : 71 - step);
            bcs[k] = bc; er[k] = E[(size_t)bc * 256]; ei[k] = E[(size_t)bc * 256 + 64]; }
#pragma unroll
        for (int k = 0; k < 24; ++k) {
            if (s0 + k >= 8) { UC[(size_t)bcs[k] * 768] = (bf16)f2bf(sr); UC[(size_t)bcs[k] * 768 + 64] = (bf16)f2bf(si); }
            const float nr = lr * sr - li * si + er[k], ni = lr * si + li * sr + ei[k]; sr = nr; si = ni; }
    }
}
constexpr int RW = 5;
__device__ __forceinline__ void moe_route(const Args& A, const bf16* X, const float* mod, bf16* H, int chunk, LAS unsigned* lcnt, LAS float* wl, int qrows, int qw, int qnw, int tid, int wave, int lane) {
    unsigned char* tok = A.ws + WS_TOK;
    int* tokE = (int*)(tok + TOK_E); float* tokW = (float*)(tok + TOK_W); int* tokRank = (int*)(tok + TOK_RANK); int* wgbase = (int*)(tok + TOK_WGBASE);
    const float* gain = A.in[I_N2G] + D; const float* wr = A.in[I_ROUTER];
    __syncthreads();
    if (tid < 8) lcnt[tid] = 0u;
#pragma unroll 1
    for (int jb = 0; jb < 16; jb += 8) { float wv[8];
#pragma unroll
      for (int j = 0; j < 8; ++j) wv[j] = wr[tid + NWAVES * 64 * (jb + j)];
#pragma unroll
      for (int j = 0; j < 8; ++j) { const int i = tid + NWAVES * 64 * (jb + j); wl[(i & 7) * 1024 + (i >> 3)] = wv[j]; } }
    f32x4 g2[4], sh4[4];
    { const float* mp = mod + (size_t)((chunk * 64) >> 11) * 6144;
#pragma unroll
      for (int j = 0; j < 4; ++j) { const int k = 4 * lane + 256 * j; g2[j] = *(const f32x4*)(gain + k) * (*(const f32x4*)(mp + 4 * 1024 + k) + 1.0f); sh4[j] = *(const f32x4*)(mp + 3 * 1024 + k); } }
    __syncthreads();
    if (wave >= RW) { if (qrows > 0) quant_rows_f8_inplace((bf16*)(A.ws + WS_MW2), (float*)(A.ws + WS_COLSC2), qrows, qw * (NWAVES - RW) + (wave - RW), qnw * (NWAVES - RW), lane); }
    else
    for (int q0 = wave; q0 < 64; q0 += 2 * RW) {
        const bool two = q0 + RW < 64; const int qq[2] = {q0, two ? q0 + RW : q0};
        f32x4 vv[2][4];
#pragma unroll
        for (int u = 0; u < 2; ++u) { const bf16* xr = X + (size_t)(chunk * 64 + qq[u]) * D;
#pragma unroll
            for (int j = 0; j < 4; ++j) { const v2u xw = *(const v2u*)(xr + 4 * lane + 256 * j); vv[u][j] = (f32x4){bflo(xw.x), bfhi(xw.x), bflo(xw.y), bfhi(xw.y)}; } }
#pragma unroll
        for (int u = 0; u < 2; ++u) { if (u == 1 && !two) break;
        const int row = chunk * 64 + qq[u];
        float ss = 0.f;
#pragma unroll
        for (int j = 0; j < 4; ++j) ss += (vv[u][j].x * vv[u][j].x + vv[u][j].y * vv[u][j].y) + (vv[u][j].z * vv[u][j].z + vv[u][j].w * vv[u][j].w);
        const float rstd = rsqrtf(wave_sum(ss) * (1.0f / D) + EPS);
        float lg[8]; f32x4 hq[4];
#pragma unroll
        for (int e = 0; e < 8; ++e) lg[e] = 0.f;
#pragma unroll
        for (int j = 0; j < 4; ++j) { const int k = 4 * lane + 256 * j;
            const f32x4 h = vv[u][j] * rstd * g2[j] + sh4[j]; hq[j] = h;
#pragma unroll
            for (int e = 0; e < 8; ++e) { const f32x4 w4 = *(const LAS f32x4*)(wl + e * 1024 + k);
                lg[e] += h.x * w4.x; lg[e] += h.y * w4.y; lg[e] += h.z * w4.z; lg[e] += h.w * w4.w; } }
        {
            float am = 0.f;
#pragma unroll
            for (int j = 0; j < 4; ++j) am = fmaxf(am, fmaxf(fmaxf(fabsf(hq[j].x), fabsf(hq[j].y)), fmaxf(fabsf(hq[j].z), fabsf(hq[j].w))));
            am = wave_max(am); const float inv = am > 0.f ? 127.0f / am : 0.f;
#pragma unroll
            for (int j = 0; j < 4; ++j) *(unsigned*)((unsigned char*)H + (size_t)row * D + 4 * lane + 256 * j) = q8pack(hq[j].x * inv, hq[j].y * inv, hq[j].z * inv, hq[j].w * inv);
            if (lane == 0) ((float*)(A.ws + WS_ROWSC))[row] = am * (1.0f / 127.0f); }
#pragma unroll
        for (int e = 0; e < 8; ++e) lg[e] = wave_sum(lg[e]);
        int e0 = 0; float v0 = lg[0];
#pragma unroll
        for (int e = 1; e < 8; ++e) if (lg[e] > v0) { v0 = lg[e]; e0 = e; }
        int e1 = -1; float v1 = -3.0e38f;
#pragma unroll
        for (int e = 0; e < 8; ++e) if (e != e0 && lg[e] > v1) { v1 = lg[e]; e1 = e; }
        const float ex = __expf(v1 - v0), w0 = 1.0f / (1.0f + ex), w1 = ex * w0;
        if (lane == 0) { const unsigned r0 = __hip_atomic_fetch_add(&lcnt[e0], 1u, __ATOMIC_RELAXED, __HIP_MEMORY_SCOPE_WORKGROUP), r1 = __hip_atomic_fetch_add(&lcnt[e1], 1u, __ATOMIC_RELAXED, __HIP_MEMORY_SCOPE_WORKGROUP);
            tokE[2 * row] = e0; tokE[2 * row + 1] = e1; tokW[2 * row] = w0; tokW[2 * row + 1] = w1; tokRank[2 * row] = (int)r0; tokRank[2 * row + 1] = (int)r1; }
        }
    }
    __syncthreads();
    if (tid < 8) { const unsigned n = lcnt[tid]; const unsigned base = __hip_atomic_fetch_add((unsigned*)(A.ws + WS_CTL) + CW_GCNT + 64 * tid, n, RLX_AGENT); wgbase[chunk * 8 + tid] = (int)base; }
    __syncthreads();
}
constexpr int NPHASE = 18;
__device__ __forceinline__ void moe_offsets(const unsigned char* ws, int (&toff)[9]) {
    const unsigned* gc = (const unsigned*)(ws + WS_CTL) + CW_GCNT; int acc = 0;
#pragma unroll
    for (int e = 0; e < 8; ++e) { toff[e] = acc; const unsigned n = (unsigned)__builtin_amdgcn_readfirstlane((int)__hip_atomic_load(gc + 64 * e, RLX_AGENT)); acc += (int)((n + 255u) >> 8); }
    toff[8] = acc;
}
#define TAIL_CONVERT(nunits, first, count) do { const int rounds_ = ((nunits) + G - 1) / G, nlast_ = (nunits) - (rounds_ - 1) * G; \
        if (bx >= nlast_) moe_convert(args, lds, (first), (count), bx - nlast_, G - nlast_, tid, wave, lane); } while (0)
constexpr int CVQ4 = 224, CVQ6 = 112, CVQ7 = 560, CVQ9 = 672, CVQS1 = 128, CVQS2 = CV_NUNITS - CVQ4 - CVQ6 - CVQ7 - CVQ9 - CVQS1;
__global__ void __launch_bounds__(NWAVES * 64, 2) fwd_kernel(Args args) {
    extern __shared__ __attribute__((aligned(16))) unsigned char lds_raw[];
    LAS unsigned char* lds = (LAS unsigned char*)lds_raw;
    volatile LAS unsigned* MISC = (volatile LAS unsigned*)(lds + MISC_OFF);
    const int tid = threadIdx.x, lane = tid & 63, wave = __builtin_amdgcn_readfirstlane(tid >> 6);
    const int G = gridDim.x, bx = blockIdx.x;
    const int gw = bx * NWAVES + wave, NGW = G * NWAVES;
    unsigned char* ws = args.ws;
    for (int u = tid; u < (LDS_BYTES - LDSCTL_OFF) / 4; u += NWAVES * 64) ((LAS unsigned*)(lds + LDSCTL_OFF))[u] = 0u;
    __syncthreads();
    const int lo = args.ph_lo, hi = args.ph_hi;
    XcdBarrier bar; bar.bar = (unsigned*)(ws + WS_CTL) + CW_BAR; bar.x = 0; bar.st = nullptr;
    if (hi - lo > 1) bar = xcd_barrier_post((unsigned*)(ws + WS_CTL) + CW_BAR, MISC + 8);
#define IN(k) (lo <= (k) && (k) < hi)
#define SEAM(k) do { if (IN((k) + 1)) xcd_barrier(bar); } while (0)
    float* mod = (float*)(ws + WS_MOD);
    bf16* XL = (bf16*)(ws + WS_XL); bf16* XC = (bf16*)(ws + WS_XC);
    bf16* H = (bf16*)(ws + WS_H);

    if (IN(0)) {
        for (int u = bx; u < 192; u += G) { if (args.sub & 1) p0_adaln(args, u, lds, tid, wave, lane); }
        if (args.sub & 4) p0_convert(args, lds, gw, NGW, wave, lane);
        SEAM(0);
    }
    if (IN(1)) {
        { const float* modp = (const float*)(ws + WS_MODP);
          for (int i = bx * (NWAVES * 64) + tid; i < MOD_N; i += G * NWAVES * 64) mod[i] = ((modp[i] + modp[MOD_N + i]) + modp[2 * MOD_N + i]) + modp[3 * MOD_N + i]; }
        { const float* modp = (const float*)(ws + WS_MODP); LAS float* ms = (LAS float*)lds;
          if (G == 256) {
#pragma unroll 1
              for (int jb = 0; jb < 8; jb += 4) { float pv[4][4];
#pragma unroll
                  for (int j = 0; j < 4; ++j) { const int i = tid + NWAVES * 64 * (jb + j), r = i < 2048 ? (bx >> 5) : 8, o = r * 6144 + (i & 2047);
#pragma unroll
                      for (int q = 0; q < 4; ++q) pv[j][q] = modp[(size_t)q * MOD_N + o]; }
#pragma unroll
                  for (int j = 0; j < 4; ++j) ms[tid + NWAVES * 64 * (jb + j)] = ((pv[j][0] + pv[j][1]) + pv[j][2]) + pv[j][3]; }
              __syncthreads(); norm_rows_lds_wg(args.in[I_X], args.in[I_CTX], args.in[I_N1G], ms, H, (float*)(ws + WS_ROWFAC1), bx, wave, lane);
          } else {
          for (int i = tid; i < 9 * 2048; i += NWAVES * 64) { const int r = i >> 11, o = r * 6144 + (i & 2047); ms[i] = ((modp[o] + modp[MOD_N + o]) + modp[2 * MOD_N + o]) + modp[3 * MOD_N + o]; }
          __syncthreads(); norm_rows_lds(args.in[I_X], args.in[I_CTX], MT, args.in[I_N1G], ms, H, (float*)(ws + WS_ROWFAC1), gw, NGW, lane); } }
        p1_quant_weights(ws, gw, NGW, lane);
        SEAM(1); }
    if (IN(2)) {
        pg8::Gemm g{H, (const bf16*)(ws + WS_WIN), MT, MIXIN, D / 2, D / 2, D}; pg8::StaticOrder S; S.init(MT, MIXIN, G, bx);
        pg8::EpiQKVUq E{(bf16*)(ws + WS_QKVU), args.in[I_QG], args.in[I_KG], EPS, (const float*)(ws + WS_ROWFAC1), (const float*)(ws + WS_COLSCD)};
        pg8::gemm_phase<pg8::EpiQKVUq, pg8::StaticOrder, true, true>(lds + RING_OFF, g, S, E);
        SEAM(2);
    }
    if (IN(3)) {
        const bf16* QKVU = (const bf16*)(ws + WS_QKVU); bf16* MIX = (bf16*)(ws + WS_MIX);
        LAS float* rpbl = (LAS float*)(lds + 40960); LAS float* cv = (LAS float*)(lds + 65536);
        float mq = 0.f, mk = 0.f, mb = 0.f, rv[8];
        mq = fabsf(args.in[I_QG][lane]); mk = fabsf(args.in[I_KG][lane]);
#pragma unroll
        for (int j = 0; j < 8; ++j) { const int i = tid + NWAVES * 64 * j; rv[j] = i < 8 * 465 ? args.in[I_RPB][i] : 0.f; mb = fmaxf(mb, fabsf(rv[j])); }
        { LAS float* wm = (LAS float*)(lds + 40960 + 16384); mb = wave_max(mb); if (lane == 0) wm[wave] = mb; __syncthreads();
#pragma unroll
          for (int w = 0; w < NWAVES; ++w) mb = fmaxf(mb, wm[w]); }
        const float bnd = (8.2f * wave_max(mq) * wave_max(mk) + mb) * 1.44269504f;
#pragma unroll
        for (int j = 0; j < 8; ++j) { const int i = tid + NWAVES * 64 * j; if (i < 8 * 465) rpbl[i] = rv[j] * 1.44269504f - bnd; }
        __syncthreads();
        const int nbw = (G % 8 == 0) ? G / 8 : G, xb0 = (G % 8 == 0) ? (bx & 7) : 0, xbn = (G % 8 == 0) ? xb0 + 1 : 8, j0 = (G % 8 == 0) ? (bx >> 3) : bx;
        for (int x = xb0; x < xbn; ++x)
            for (int k = j0; k < 36; k += nbw) {
                if (!(args.sub & (k < 32 ? 8 : 16))) continue;
                const int wu = k < 32 ? (x * 32 + k) * 8 + wave : 2048 + (x * 4 + (k - 32)) * 8 + wave;
                attn_unit(QKVU, MIX, wu, lds + wave * 5120, lds + 57344 + wave * 8192, rpbl, bnd, lane);
            }
        if (args.sub & 32) {
            float cw[31];
            { const __amdgpu_buffer_rsrc_t wrs = __builtin_amdgcn_make_buffer_rsrc((void*)args.in[I_DWW], 0, 31 * 512 * 4, 0x00020000);
#pragma unroll
              for (int q = 0; q < 31; ++q) cw[q] = __builtin_bit_cast(float, __builtin_amdgcn_raw_buffer_load_b32(wrs, 4 * tid, q * 2048, 0)); }
            const float cbias = args.in[I_DWB][tid];
            for (int x = xb0; x < xbn; ++x)
                for (int k = j0 + ((36 - j0 + nbw - 1) / nbw) * nbw; k < 128; k += nbw) {
                    const int ci = k < 64 ? k - 36 : (k < 96 ? k - 36 : (k >= 100 && k < 112 ? k - 40 : -1)); if (ci < 0) continue;
                    conv_item(args, QKVU, MIX, ci < 64 ? x * 64 + ci : 512 + x * 8 + (ci - 64), cw, cbias, lds, cv, tid, wave, lane);
                }
        }
        SEAM(3);
    }
    if (IN(4)) {
        pg8::Gemm g{(const bf16*)(ws + WS_MIX), (const bf16*)(ws + WS_WOUT), MT, D, D, D, D}; pg8::StaticOrder S; S.init(MT, D, G, bx);
        pg8::EpiResidN<true, false> E{args.in[I_X], args.in[I_CTX], XL, XC, mod + 2 * 1024, H, (float*)(ws + WS_ROWSS), args.in[I_N2G], mod + 4 * 1024};
        pg8::gemm_phase<pg8::EpiResidN<true, false>, pg8::StaticOrder, true, true>(lds + RING_OFF, g, S, E);
        {
            const int nun = (MT / 256) * (D / 256), rounds = (nun + G - 1) / G, nlast = nun - (rounds - 1) * G, nidle = G - nlast, ii = bx - nlast;
            if (ii >= 0 && !(args.sub & 64)) {
                shw_rows((const bf16*)(ws + WS_W13), 2 * FFN, mod + 3 * 1024, (float*)(ws + WS_SHW13), ii * NWAVES + wave, nidle * NWAVES, lds, tid, lane, (const float*)(ws + WS_COLSCD) + MIXIN);
                shw_rows((const bf16*)(ws + WS_SIN), D, mod + 9 * 6144, (float*)(ws + WS_SHWS), ii * NWAVES + wave, nidle * NWAVES, lds, tid, lane);
                moe_convert(args, lds, 0, CVQ4, ii, nidle, tid, wave, lane); }
            if (nidle <= 0) { shw_rows((const bf16*)(ws + WS_W13), 2 * FFN, mod + 3 * 1024, (float*)(ws + WS_SHW13), gw, NGW, lds, tid, lane, (const float*)(ws + WS_COLSCD) + MIXIN); shw_rows((const bf16*)(ws + WS_SIN), D, mod + 9 * 6144, (float*)(ws + WS_SHWS), gw, NGW, lds, tid, lane);
                moe_convert(args, lds, 0, CVQ4, bx, G, tid, wave, lane); }
        }
        SEAM(4);
    }
    if (IN(5)) { if (G == 256) quant_act_rows_wg(XL, XC, args.in[I_N2G], mod + 4 * 1024, (unsigned char*)H, (const float*)(ws + WS_ROWSS), (float*)(ws + WS_ROWFAC1), lds, tid, bx, wave, lane);
                 else quant_act_rows(XL, XC, args.in[I_N2G], mod + 4 * 1024, (unsigned char*)H, (const float*)(ws + WS_ROWSS), (float*)(ws + WS_ROWFAC1), lds, tid, gw, NGW, lane); SEAM(5); }
    if (IN(6)) {
        pg8::Gemm g{H, (const bf16*)(ws + WS_W13), MT, 2 * FFN, D / 2, D, D}; pg8::StaticOrder S; S.init(MT, 2 * FFN, G, bx);
        LAS float* rt = (LAS float*)(lds + RING_BYTES); pg8::rowfac_prepass(S, (const float*)(ws + WS_ROWFAC1), rt, tid);
        pg8::EpiSwiGLUNq E{(bf16*)(ws + WS_ACT), FFN, rt, (const float*)(ws + WS_SHW13), 2 * FFN, (const float*)(ws + WS_COLSCD) + MIXIN};
        pg8::gemm_phase<pg8::EpiSwiGLUNq, pg8::StaticOrder, true, true>(lds + RING_OFF, g, S, E);
        TAIL_CONVERT((MT / 256) * (2 * FFN / 256), CVQ4, CVQ6);
        SEAM(6);
    }
    if (IN(7)) {
        pg8::Gemm g{(const bf16*)(ws + WS_ACT), (const bf16*)(ws + WS_W2), MT, D, FFN, FFN, FFN}; pg8::StaticOrder S; S.init(MT, D, G, bx);
        const bool dry = (args.sub & 64) != 0;
        unsigned char* dead = (unsigned char*)args.out;
        bf16* XLo = dry ? (bf16*)dead : XL; bf16* XCo = dry ? (bf16*)(dead + 32 * MiB) : XC; bf16* Ho = dry ? (bf16*)dead : H; float* rso = dry ? (float*)(dead + 40 * MiB) : (float*)(ws + WS_ROWSS);
        pg8::EpiResidN<false> E{XL, XC, XLo, XCo, mod + 5 * 1024, Ho, rso, args.in[I_N1G] + D, mod + 9 * 6144 + 1 * 1024};
        pg8::gemm_phase<pg8::EpiResidN<false>, pg8::StaticOrder, true, true>(lds + RING_OFF, g, S, E);
        {
            const int nun = (MT / 256) * (D / 256), rounds = (nun + G - 1) / G, nlast = nun - (rounds - 1) * G, nidle = G - nlast, ii = bx - nlast;
            if (ii >= 0) {
                if (nidle > 128) { if (ii < 128) { if ((args.sub & 2) && !((args.sub & 128) && (ii & 1))) p0_s5gen(args, ii >> 1, ii & 1, lds, tid); }   else moe_convert(args, lds, CVQ4 + CVQ6, CVQ7, ii - 128, nidle - 128, tid, wave, lane); }
                else { if (args.sub & 2) for (int u = ii; u < 128; u += nidle) p0_s5gen(args, u >> 1, u & 1, lds, tid); moe_convert(args, lds, CVQ4 + CVQ6, CVQ7, ii, nidle, tid, wave, lane); } }
            if (nidle <= 0) { for (int u = bx; u < 128; u += G) p0_s5gen(args, u >> 1, u & 1, lds, tid); moe_convert(args, lds, CVQ4 + CVQ6, CVQ7, bx, G, tid, wave, lane); }
        }
        SEAM(7);
    }
    float* mod1 = mod + 9 * 6144;
    if (IN(8)) {
        pg8::Gemm g{H, (const bf16*)(ws + WS_SIN), MT, D, D, D, D}; pg8::StaticOrder S; S.init(MT, D, G, bx);
        LAS float* rt = (LAS float*)(lds + RING_BYTES); pg8::rstd_prepass(S, (const float*)(ws + WS_ROWSS), rt, EPS, tid);
        pg8::EpiUC E{(bf16*)(ws + WS_UC), rt, (const float*)(ws + WS_SHWS)};
        pg8::gemm_phase<pg8::EpiUC, pg8::StaticOrder, true, true>(lds + RING_OFF, g, S, E);
        TAIL_CONVERT((MT / 256) * (D / 256), CVQ4 + CVQ6 + CVQ7, CVQ9);
        SEAM(8);
    }
    if (IN(9)) {
        pg8::Gemm g{(const bf16*)(ws + WS_UC), (const bf16*)(ws + WS_WEND), 64 * 768, 64 * 256, 512, 768, 512}; pg8::OrderS5E S{G, bx};
        pg8::EpiE E{(float*)(ws + WS_E)};
        pg8::gemm_phase<pg8::EpiE, pg8::OrderS5E, true, true>(lds + RING_OFF, g, S, E);
        if (G == 256) { if ((bx >> 3) >= 24) moe_convert(args, lds, CVQ4 + CVQ6 + CVQ7 + CVQ9, CVQS1, ((bx >> 3) - 24) * 8 + (bx & 7), 64, tid, wave, lane); }
        else moe_convert(args, lds, CVQ4 + CVQ6 + CVQ7 + CVQ9, CVQS1, bx, G, tid, wave, lane);
        SEAM(9);
    }
    if (IN(10)) { s5_scan(args, bx * (NWAVES * 64) + tid);
        if (G > 128) { if (bx >= 128) moe_convert(args, lds, CVQ4 + CVQ6 + CVQ7 + CVQ9 + CVQS1, CVQS2, bx - 128, G - 128, tid, wave, lane); }
        else moe_convert(args, lds, CVQ4 + CVQ6 + CVQ7 + CVQ9 + CVQS1, CVQS2, bx, G, tid, wave, lane);
        SEAM(10); }
    if (IN(11)) {
        pg8::Gemm g{(const bf16*)(ws + WS_UC), (const bf16*)(ws + WS_BTOUT), 64 * 768, 64 * 512, 768, 768, 768}; pg8::OrderS5Y S{G, bx};
        pg8::EpiY E{ws + WS_Y};
        pg8::gemm_phase<pg8::EpiY, pg8::OrderS5Y, true, true>(lds + RING_OFF, g, S, E);
        SEAM(11);
    }
    if (IN(12)) {
        pg8::Gemm g{(const bf16*)(ws + WS_Y), (const bf16*)(ws + WS_SOUT), ML, 2 * D, D / 2, D / 2, D}; pg8::StaticOrder S; S.init(ML, 2 * D, G, bx);
        pg8::EpiGLURes E{XL, mod1 + 2 * 1024, (const float*)(ws + WS_COLSCS)};
        pg8::gemm_phase<pg8::EpiGLURes, pg8::StaticOrder, true, true>(lds + RING_OFF, g, S, E);
        SEAM(12);
    }
    unsigned char* tok = ws + WS_TOK;
    if (IN(13)) {
        int* rowsrc = (int*)(tok + TOK_ROWSRC); int* rowinfo = (int*)(tok + TOK_ROWINFO); float* rowgate = (float*)(tok + TOK_ROWGATE);
        for (int i = bx * (NWAVES * 64) + tid; i < MOE_TILES * 256; i += G * NWAVES * 64) { rowsrc[i] = 0; rowinfo[i] = -1; rowgate[i] = 0.f; ((float*)(ws + WS_POSSC))[i] = 0.f; }
        for (int ch = bx; ch < ML / 64; ch += G) moe_route(args, XL, mod1, H, ch, (LAS unsigned*)lds, (LAS float*)(lds + 1024), ch < G ? NE * D : 0, bx, G < ML / 64 ? G : ML / 64, tid, wave, lane);
        SEAM(13);
    }
    if (IN(14)) {
        int toff[9]; moe_offsets(ws, toff);
        const int* tokE = (const int*)(tok + TOK_E); const float* tokW = (const float*)(tok + TOK_W); const int* tokRank = (const int*)(tok + TOK_RANK); const int* wgbase = (const int*)(tok + TOK_WGBASE);
        int* rowsrc = (int*)(tok + TOK_ROWSRC); int* rowinfo = (int*)(tok + TOK_ROWINFO); float* rowgate = (float*)(tok + TOK_ROWGATE); int* tokPos = (int*)(tok + TOK_POS);
        for (int i = bx * (NWAVES * 64) + tid; i < 2 * ML; i += G * NWAVES * 64) { const int t = i >> 1, e = tokE[i]; int to = 0;
#pragma unroll
            for (int q = 0; q < 8; ++q) to = (e == q) ? toff[q] : to;
            const int pos = to * 256 + wgbase[(t >> 6) * 8 + e] + tokRank[i];
            rowsrc[pos] = t; rowinfo[pos] = i; rowgate[pos] = tokW[i]; tokPos[i] = pos; ((float*)(ws + WS_POSSC))[pos] = ((const float*)(ws + WS_ROWSC))[t]; }
        SEAM(14);
    }
    if (IN(15)) {
        pg8::OrderMoE S; S.G = G; S.c = bx; S.nN = 2 * ED / 256; S.tmax = 1 << 30; S.fix = (args.sub >> 7) & 1; moe_offsets(ws, S.toff);
        pg8::Gemm g{H, (const bf16*)(ws + WS_MW13), MOE_TILES * 256, NE * 2 * ED, D / 2, D / 2, D / 2, (const int*)(tok + TOK_ROWSRC)};
        pg8::EpiSwiGLUq E{ws + WS_ACTM, ED, 2 * ED / 256, (const float*)(ws + WS_POSSC), (const float*)(ws + WS_COLSC)};
        pg8::gemm_phase<pg8::EpiSwiGLUq, pg8::OrderMoE, true, true, true>(lds + RING_OFF, g, S, E);
        SEAM(15);
    }
    if (IN(16)) {
        pg8::OrderMoE S; S.G = G; S.c = bx; S.nN = D / 256; S.tmax = 128; S.fix = 0; moe_offsets(ws, S.toff);
        pg8::Gemm g{(const bf16*)(ws + WS_ACTM), (const bf16*)(ws + WS_MW2), MOE_TILES * 256, NE * D, ED / 2, ED / 2, ED};
        pg8::EpiMoE2 E{(bf16*)args.out, (const float*)(tok + TOK_ROWGATE), (const int*)(tok + TOK_ROWINFO), (const float*)(ws + WS_COLSC2)};
        pg8::gemm_phase<pg8::EpiMoE2, pg8::OrderMoE, true, true>(lds + RING_OFF, g, S, E);
        pg8::OrderMoEx Sx; Sx.G = G; Sx.c = bx;
#pragma unroll
        for (int q = 0; q < 9; ++q) Sx.toff[q] = S.toff[q];
        pg8::Gemm gx{(const bf16*)(ws + WS_ACTM), (const bf16*)(ws + WS_MW2), MOE_TILES * 256, NE * D, 512, ED / 2, ED};
        pg8::EpiMoE2x Ex{(float*)(ws + WS_PX), (const float*)(tok + TOK_ROWGATE), (const float*)(ws + WS_COLSC2)};
        pg8::gemm_phase<pg8::EpiMoE2x, pg8::OrderMoEx, true, false>(lds + RING_OFF, gx, Sx, Ex);
        SEAM(16);
    }
    if (IN(17)) {
        const unsigned bad = __hip_atomic_load((unsigned*)(ws + WS_CTL) + CW_BAR + XB_TMO, RLX_AGENT);
        const int* tokPos = (const int*)(tok + TOK_POS); const float* PX = (const float*)(ws + WS_PX);
        for (int tb = gw; tb < ML; tb += 2 * NGW) {
            const int tt[2] = {tb, (tb + NGW < ML) ? tb + NGW : tb}; const int ntk = (tb + NGW < ML) ? 2 : 1;
            v2u a[2][4], b[2][4], xw[2][4]; f32x4 gv[2][4]; int p0[2], p1[2];
#pragma unroll
            for (int u = 0; u < 2; ++u) { const int t = tt[u]; const bf16* y0 = (const bf16*)(args.out + (size_t)t * D); const bf16* y1 = y0 + D; const float* gp = mod1 + (size_t)(t >> 11) * 6144 + 5 * 1024;
                p0[u] = tokPos[2 * t] - 128 * 256; p1[u] = tokPos[2 * t + 1] - 128 * 256;
#pragma unroll
                for (int j = 0; j < 4; ++j) { const int c = 4 * lane + 256 * j; a[u][j] = *(const v2u*)(y0 + c); b[u][j] = *(const v2u*)(y1 + c); xw[u][j] = *(const v2u*)(XL + (size_t)t * D + c); gv[u][j] = *(const f32x4*)(gp + c); } }
            asm volatile("s_waitcnt vmcnt(0)" ::: "memory");
#pragma unroll
            for (int u = 0; u < 2; ++u) { if (u < ntk) { const int t = tt[u];
#pragma unroll
                for (int j = 0; j < 4; ++j) { const int c = 4 * lane + 256 * j;
                    f32x4 ya = (f32x4){bflo(a[u][j].x), bfhi(a[u][j].x), bflo(a[u][j].y), bfhi(a[u][j].y)}, yb = (f32x4){bflo(b[u][j].x), bfhi(b[u][j].x), bflo(b[u][j].y), bfhi(b[u][j].y)};
                    if (p0[u] >= 0) { const float* q = PX + (size_t)p0[u] * D + c; ya = ((*(const f32x4*)q + *(const f32x4*)(q + (size_t)2048 * D)) + *(const f32x4*)(q + (size_t)4096 * D)) + *(const f32x4*)(q + (size_t)6144 * D); }
                    if (p1[u] >= 0) { const float* q = PX + (size_t)p1[u] * D + c; yb = ((*(const f32x4*)q + *(const f32x4*)(q + (size_t)2048 * D)) + *(const f32x4*)(q + (size_t)4096 * D)) + *(const f32x4*)(q + (size_t)6144 * D); }
                    const f32x4 xv = (f32x4){bflo(xw[u][j].x), bfhi(xw[u][j].x), bflo(xw[u][j].y), bfhi(xw[u][j].y)};
                    f32x4 o = xv + gv[u][j] * (ya + yb); if (bad) o = (f32x4){__builtin_nanf(""), __builtin_nanf(""), __builtin_nanf(""), __builtin_nanf("")};
                    *(f32x4*)(args.out + (size_t)t * D + c) = o; } } }
        }
    }
#undef IN
#undef SEAM
}

extern "C" void kernel_launch(void* const* d_in, const int* in_sizes, int n_in, void* d_out, int out_size, void* d_ws, size_t ws_size, hipStream_t stream) {
    static int grid = 0;
    if (grid == 0) {
        if (n_in != N_IN || out_size != ML * D || ws_size < WS_END) { fprintf(stderr, "kernel_launch: unexpected problem (n_in %d, out %d, ws %zu); nothing launched\n", n_in, out_size, ws_size); grid = -1; return; }
        int dev = 0, cus = 0, per_cu = 0;
        if (hipGetDevice(&dev) != hipSuccess || hipDeviceGetAttribute(&cus, hipDeviceAttributeMultiprocessorCount, dev) != hipSuccess) { grid = -1; return; }
        if (hipFuncSetAttribute((const void*)fwd_kernel, hipFuncAttributeMaxDynamicSharedMemorySize, LDS_BYTES) != hipSuccess) { fprintf(stderr, "kernel_launch: hipFuncSetAttribute failed\n"); grid = -1; return; }
        if (hipOccupancyMaxActiveBlocksPerMultiprocessor(&per_cu, (const void*)fwd_kernel, NWAVES * 64, LDS_BYTES) != hipSuccess || per_cu < 1) { fprintf(stderr, "kernel_launch: occupancy query says %d blocks per CU\n", per_cu); (void)hipGetLastError(); grid = -1; return; }
        grid = cus;
    }
    if (grid < 0) return;
    if (hipMemsetAsync((char*)d_ws + WS_CTL, 0, CTL_ZERO_BYTES, stream) != hipSuccess) return;
    Args a{};
    for (int i = 0; i < N_IN; ++i) a.in[i] = (const float*)d_in[i];
    a.out = (float*)d_out; a.ws = (unsigned char*)d_ws; a.sub = 63;
#if MK_N_LAUNCHES == 1
    a.ph_lo = 0; a.ph_hi = NPHASE;
    hipLaunchKernelGGL(fwd_kernel, dim3(grid), dim3(NWAVES * 64), LDS_BYTES, stream, a);
#else
    for (int p = 0; p < NPHASE; ++p) { const int nrep = ((MK_REPEAT_MASK >> p) & 1u) ? 2 : 1;
        for (int r = 0; r < nrep; ++r) { a.ph_lo = p; a.ph_hi = p + 1; a.sub = (r == 0) ? 63 : MK_REPEAT_SUB; hipLaunchKernelGGL(fwd_kernel, dim3(grid), dim3(NWAVES * 64), LDS_BYTES, stream, a); } }
#endif
}
```
